# Optimizing an MI355X kernel written in HIP

```python
import math
import jax, jax.numpy as jnp
from jax import lax
import numpy as np

D_MODEL = 1024
BATCH = 32
SEQ = 2048
DEPTH = 4

HEAD_DIM = 64
NSA_HEADS = 16
NSA_GROUPS = 2
NSA_HPG = NSA_HEADS // NSA_GROUPS
NSA_WIDTH = NSA_HEADS * HEAD_DIM
CMP_BLOCK = 32
CMP_STRIDE = 16
CMP_HIDDEN = 2 * HEAD_DIM
SEL_BLOCK = 64
SEL_TOPK = 8
WINDOW = 512
SEL_Q_BLOCK = 64
FOX_HEADS = 16
FOX_WIDTH = FOX_HEADS * HEAD_DIM
Q_BLOCK = 128
ROPE_THETA = 10000.0
RMS_EPS = 1e-6
NEG_INF = -1e30
FORCED_SCORE = 1e4

SPLITS = (
    NSA_WIDTH,
    3 * 2 * NSA_GROUPS * HEAD_DIM,
    3 * NSA_HEADS,
    NSA_WIDTH,
    FOX_WIDTH,
    FOX_WIDTH,
    FOX_WIDTH,
    FOX_HEADS,
    FOX_WIDTH,
    2 * D_MODEL,
)
IN_COLS = sum(SPLITS)

kernel_name = 'nsa_fox_gated_hybrid'


def rms_norm(x, g):
    xf = x.astype(jnp.float32)
    y = xf * lax.rsqrt(jnp.mean(xf * xf, axis=-1, keepdims=True) + RMS_EPS)
    return (y * g.astype(jnp.float32)).astype(x.dtype)


def rope_tables(T, dtype):
    inv = ROPE_THETA ** (-jnp.arange(0, HEAD_DIM, 2, dtype=jnp.float32) / HEAD_DIM)
    ang = jnp.arange(T, dtype=jnp.float32)[:, None] * inv[None, :]
    return jnp.cos(ang).astype(dtype), jnp.sin(ang).astype(dtype)


def rope(x, cos, sin):
    d2 = HEAD_DIM // 2
    shape = (1, x.shape[1]) + (1,) * (x.ndim - 3) + (d2,)
    c, s = cos.reshape(shape), sin.reshape(shape)
    x1, x2 = x[..., :d2], x[..., d2:]
    return jnp.concatenate([x1 * c - x2 * s, x2 * c + x1 * s], axis=-1)


def masked_softmax(s, mask):
    p = jax.nn.softmax(jnp.where(mask, s, NEG_INF), axis=-1)
    return jnp.where(mask, p, 0.0)


def compress(k, pe, w1, w2):
    T = k.shape[1]
    n_cmp = (T - CMP_BLOCK) // CMP_STRIDE + 1
    idx = np.arange(n_cmp)[:, None] * CMP_STRIDE + np.arange(CMP_BLOCK)[None, :]
    blk = k[:, idx] + pe[None, None, :, None, :]
    hid = jax.nn.silu(jnp.einsum('bnlgd,ldh->bngh', blk, w1.reshape(CMP_BLOCK, HEAD_DIM, CMP_HIDDEN)))
    return jnp.einsum('bngh,hd->bngd', hid, w2)


def nsa_mixer(q, kv, gate_logits, pe_k, w1_k, w2_k, pe_v, w1_v, w2_v, cos, sin):
    B, T = q.shape[0], q.shape[1]
    G, HPG, D = NSA_GROUPS, NSA_HPG, HEAD_DIM
    scale = D ** -0.5
    q = q.reshape(B, T, NSA_HEADS, D)
    kv = kv.reshape(B, T, 6, G, D)
    k_c, v_c, k_s, v_s, k_w, v_w = [kv[:, :, i] for i in range(6)]
    t = jnp.arange(T)

    k_cmp = compress(k_c, pe_k, w1_k, w2_k)
    v_cmp = compress(v_c, pe_v, w1_v, w2_v)
    n_cmp = k_cmp.shape[1]
    qg = q.reshape(B, T, G, HPG, D)
    s_cmp = jnp.einsum('btghd,bngd->bghtn', qg, k_cmp).astype(jnp.float32) * scale
    blk_end = jnp.arange(n_cmp) * CMP_STRIDE + CMP_BLOCK - 1
    cmp_mask = blk_end[None, :] <= t[:, None]
    p_cmp = masked_softmax(s_cmp, cmp_mask)
    o_cmp = jnp.einsum('bghtn,bngd->btghd', p_cmp.astype(v_cmp.dtype), v_cmp)

    n_sel = T // SEL_BLOCK
    ci = np.arange(n_cmp)[:, None] * CMP_STRIDE
    sj = np.arange(n_sel)[None, :] * SEL_BLOCK
    overlap = jnp.asarray(((ci < sj + SEL_BLOCK) & (ci + CMP_BLOCK > sj)).astype(np.float32))
    imp = jnp.einsum('bghtn,nj->bgtj', p_cmp, overlap)
    sel_ids = jnp.arange(n_sel)
    cur = t // SEL_BLOCK
    forced = (sel_ids[None, :] == 0) | (sel_ids[None, :] == cur[:, None]) | (sel_ids[None, :] == cur[:, None] - 1)
    valid = sel_ids[None, :] * SEL_BLOCK <= t[:, None]
    score = jnp.where(forced, FORCED_SCORE, jnp.where(valid, imp, -1.0))
    k_top = min(SEL_TOPK, n_sel)
    _, sel_idx = lax.top_k(score, k_top)

    qr = rope(q, cos, sin).reshape(B, T, G, HPG, D)
    kb = rope(k_s, cos, sin).reshape(B, n_sel, SEL_BLOCK, G, D).transpose(0, 3, 1, 2, 4)
    vb = v_s.reshape(B, n_sel, SEL_BLOCK, G, D).transpose(0, 3, 1, 2, 4)
    n_qs = T // SEL_Q_BLOCK
    q_chunks = jnp.moveaxis(qr.reshape(B, n_qs, SEL_Q_BLOCK, G, HPG, D), 1, 0)
    idx_chunks = jnp.moveaxis(sel_idx.reshape(B, G, n_qs, SEL_Q_BLOCK, k_top), 2, 0)
    t_chunks = t.reshape(n_qs, SEL_Q_BLOCK)
    bi = jnp.arange(B)[:, None, None, None]
    gi = jnp.arange(G)[None, :, None, None]

    def sel_step(args):
        qc, ic, tc = args
        kg = kb[bi, gi, ic]
        vg = vb[bi, gi, ic]
        s = jnp.einsum('bqghd,bgqnld->bghqnl', qc, kg).astype(jnp.float32) * scale
        tok = ic[..., None] * SEL_BLOCK + jnp.arange(SEL_BLOCK)
        mask = (tok <= tc[None, None, :, None, None])[:, :, None]
        p = masked_softmax(s.reshape(B, G, HPG, SEL_Q_BLOCK, k_top * SEL_BLOCK),
                           mask.reshape(B, G, 1, SEL_Q_BLOCK, k_top * SEL_BLOCK))
        p = p.reshape(B, G, HPG, SEL_Q_BLOCK, k_top, SEL_BLOCK)
        return jnp.einsum('bghqnl,bgqnld->bqghd', p.astype(vg.dtype), vg)

    o_slc = lax.map(sel_step, (q_chunks, idx_chunks, t_chunks))
    o_slc = jnp.moveaxis(o_slc, 0, 1).reshape(B, T, G, HPG, D)

    kwp = jnp.pad(rope(k_w, cos, sin), ((0, 0), (WINDOW, 0), (0, 0), (0, 0)))
    vwp = jnp.pad(v_w, ((0, 0), (WINDOW, 0), (0, 0), (0, 0)))
    n_qw = T // Q_BLOCK
    qw_chunks = jnp.moveaxis(qr.reshape(B, n_qw, Q_BLOCK, G, HPG, D), 1, 0)
    starts = jnp.arange(n_qw, dtype=jnp.int32) * Q_BLOCK

    def win_step(args):
        qc, s0 = args
        kc = lax.dynamic_slice_in_dim(kwp, s0, WINDOW + Q_BLOCK, axis=1)
        vc = lax.dynamic_slice_in_dim(vwp, s0, WINDOW + Q_BLOCK, axis=1)
        tq = s0 + jnp.arange(Q_BLOCK)
        sk = s0 - WINDOW + jnp.arange(WINDOW + Q_BLOCK)
        mask = (sk[None, :] <= tq[:, None]) & (sk[None, :] > tq[:, None] - WINDOW) & (sk[None, :] >= 0)
        s = jnp.einsum('bqghd,bkgd->bghqk', qc, kc).astype(jnp.float32) * scale
        p = masked_softmax(s, mask)
        return jnp.einsum('bghqk,bkgd->bqghd', p.astype(vc.dtype), vc)

    o_win = lax.map(win_step, (qw_chunks, starts))
    o_win = jnp.moveaxis(o_win, 0, 1).reshape(B, T, G, HPG, D)

    g = jax.nn.sigmoid(gate_logits).reshape(B, T, 3, G, HPG)[..., None]
    o = g[:, :, 0] * o_cmp + g[:, :, 1] * o_slc + g[:, :, 2] * o_win
    return o.reshape(B, T, NSA_WIDTH)


def fox_mixer(q, k, v, f_logits, b_f):
    B, T = q.shape[0], q.shape[1]
    H, D = FOX_HEADS, HEAD_DIM
    scale = D ** -0.5
    q = q.reshape(B, T, H, D)
    k = k.reshape(B, T, H, D)
    v = v.reshape(B, T, H, D)
    log_f = jax.nn.log_sigmoid(f_logits.astype(jnp.float32) + b_f.astype(jnp.float32))
    F = jnp.cumsum(log_f, axis=1).transpose(0, 2, 1)
    n_q = T // Q_BLOCK
    q_chunks = jnp.moveaxis(q.reshape(B, n_q, Q_BLOCK, H, D), 1, 0)
    F_chunks = jnp.moveaxis(F.reshape(B, H, n_q, Q_BLOCK), 2, 0)
    starts = jnp.arange(n_q, dtype=jnp.int32) * Q_BLOCK
    key_pos = jnp.arange(T)

    def fox_step(args):
        qc, Fq, s0 = args
        s = jnp.einsum('bqhd,bkhd->bhqk', qc, k).astype(jnp.float32) * scale
        s = s + Fq[..., None] - F[:, :, None, :]
        mask = key_pos[None, :] <= (s0 + jnp.arange(Q_BLOCK))[:, None]
        p = masked_softmax(s, mask)
        return jnp.einsum('bhqk,bkhd->bqhd', p.astype(v.dtype), v)

    o = lax.map(fox_step, (q_chunks, F_chunks, starts))
    return jnp.moveaxis(o, 0, 1).reshape(B, T, FOX_WIDTH)


def setup_inputs(seed: int = 0) -> dict:
    key = jax.random.key(seed)
    ks = jax.random.split(key, 14)
    f32 = jnp.float32

    def nrm(k, shape, scale):
        return jax.random.normal(k, shape, f32) * scale

    return {
        'x': nrm(ks[0], (BATCH, SEQ, D_MODEL), 1.0),
        'norm_g': 1.0 + nrm(ks[1], (DEPTH, D_MODEL), 0.01),
        'w_in': nrm(ks[2], (DEPTH, D_MODEL, IN_COLS), D_MODEL ** -0.5),
        'b_forget': jax.random.uniform(ks[3], (DEPTH, FOX_HEADS), f32, 1.0, 5.0),
        'cmp_pe_k': nrm(ks[4], (DEPTH, CMP_BLOCK, HEAD_DIM), 0.1),
        'cmp_w1_k': nrm(ks[5], (DEPTH, CMP_BLOCK * HEAD_DIM, CMP_HIDDEN), (CMP_BLOCK * HEAD_DIM) ** -0.5),
        'cmp_w2_k': nrm(ks[6], (DEPTH, CMP_HIDDEN, HEAD_DIM), CMP_HIDDEN ** -0.5),
        'cmp_pe_v': nrm(ks[7], (DEPTH, CMP_BLOCK, HEAD_DIM), 0.1),
        'cmp_w1_v': nrm(ks[8], (DEPTH, CMP_BLOCK * HEAD_DIM, CMP_HIDDEN), (CMP_BLOCK * HEAD_DIM) ** -0.5),
        'cmp_w2_v': nrm(ks[9], (DEPTH, CMP_HIDDEN, HEAD_DIM), CMP_HIDDEN ** -0.5),
        'w_proj_nsa': nrm(ks[10], (DEPTH, NSA_WIDTH, D_MODEL), NSA_WIDTH ** -0.5),
        'w_proj_fox': nrm(ks[11], (DEPTH, FOX_WIDTH, D_MODEL), FOX_WIDTH ** -0.5),
        'w_out': nrm(ks[12], (DEPTH, D_MODEL, D_MODEL), D_MODEL ** -0.5),
        'final_g': 1.0 + nrm(ks[13], (D_MODEL,), 0.01),
    }


def reference(x, norm_g, w_in, b_forget, cmp_pe_k, cmp_w1_k, cmp_w2_k, cmp_pe_v, cmp_w1_v, cmp_w2_v,
              w_proj_nsa, w_proj_fox, w_out, final_g):
    T = x.shape[1]
    cos, sin = rope_tables(T, x.dtype)
    split_at = np.cumsum(SPLITS)[:-1].tolist()
    for l in range(DEPTH):
        h = rms_norm(x, norm_g[l])
        proj = jnp.einsum('btd,dc->btc', h, w_in[l])
        q_a, kv_a, g_a, z_a, q_b, k_b, v_b, f_b, z_b, merge = jnp.split(proj, split_at, axis=-1)
        y_a = nsa_mixer(q_a, kv_a, g_a, cmp_pe_k[l], cmp_w1_k[l], cmp_w2_k[l],
                        cmp_pe_v[l], cmp_w1_v[l], cmp_w2_v[l], cos, sin) * jax.nn.silu(z_a)
        y_b = fox_mixer(q_b, k_b, v_b, f_b, b_forget[l]) * jax.nn.silu(z_b)
        r_a, r_b = jnp.split(merge, 2, axis=-1)
        merged = (jax.nn.sigmoid(r_a) * jnp.einsum('btc,cd->btd', y_a, w_proj_nsa[l])
                  + jax.nn.sigmoid(r_b) * jnp.einsum('btc,cd->btd', y_b, w_proj_fox[l]))
        x = x + jnp.einsum('btd,de->bte', merged, w_out[l])
    return rms_norm(x, final_g)
```

```cpp
#include <hip/hip_runtime.h>
#include <hip/hip_cooperative_groups.h>
#include <cstdio>
namespace cg = cooperative_groups;

typedef __attribute__((ext_vector_type(8))) __bf16 bf16x8;
typedef __attribute__((ext_vector_type(16))) float f32x16;
typedef unsigned short u16;

#define TSEQ 2048
#define DM 1024
#define INC 9024
#define INCP 9088
#define C_QA 0
#define C_KV 1024
#define C_GA 1792
#define C_ZA 1840
#define C_QB 2864
#define C_KB 3888
#define C_VB 4912
#define C_QR 4912
#define C_FB 5936
#define C_ZB 5952
#define C_RA 6976
#define C_RB 8000
#define NTHREADS 256
#define ATT_STAGE 16640
#define LOG2E 1.4426950408889634f

struct Params {
  const float* x_in; const float* norm_g; const float* w_in; const float* b_forget;
  const float* pe_k; const float* w1_k; const float* w2_k;
  const float* pe_v; const float* w1_v; const float* w2_v;
  const float* w_pa; const float* w_pb; const float* w_out; const float* final_g;
  float* out;
  u16* WinT; u16* WpaT; u16* WpbT; u16* WoT; u16* W1T; u16* W2T;
  float* bias1p; float* ropec; float* ropes;
  u16* h; u16* proj; u16* vbt; u16* vst; u16* vwt;
  float* flog; float* F2; u16* kcmp; u16* vcmpt; unsigned* sel;
  u16* ya; u16* yb; unsigned* ctr;
  int NB; int nchunk;
};

__device__ __forceinline__ unsigned pk2(float a, float b) {
  typedef __attribute__((ext_vector_type(2))) float f2_t;
  typedef __attribute__((ext_vector_type(2))) __bf16 b2_t;
  f2_t v = {a, b};
  b2_t r = __builtin_convertvector(v, b2_t);
  return __builtin_bit_cast(unsigned, r);
}
__device__ __forceinline__ u16 f2bf(float a) { return (u16)(pk2(a, 0.f) & 0xffffu); }
__device__ __forceinline__ float bf2f(u16 u) { return __uint_as_float(((unsigned)u) << 16); }
__device__ __forceinline__ float bflo(unsigned u) { return __uint_as_float(u << 16); }
__device__ __forceinline__ float bfhi(unsigned u) { return __uint_as_float(u & 0xffff0000u); }
__device__ __forceinline__ float sigmoidf_(float x) { return 1.f / (1.f + __expf(-x)); }
__device__ __forceinline__ float siluf_(float x) { return x / (1.f + __expf(-x)); }
__device__ __forceinline__ f32x16 mfma32(bf16x8 a, bf16x8 b, f32x16 c) {
  return __builtin_amdgcn_mfma_f32_32x32x16_bf16(a, b, c, 0, 0, 0);
}
__device__ __forceinline__ int opaque_tid() { int t = threadIdx.x; asm volatile("" : "+v"(t)); return t; }
__device__ __forceinline__ bf16x8 ldfrag(const void* p) {
  return __builtin_bit_cast(bf16x8, *(const uint4*)p);
}

__device__ void transpose_tile(const float* __restrict__ src, u16* __restrict__ dst, int K, int N,
                               int k0, int n0, float* tile, const int tid) {
#pragma unroll
  for (int j = 0; j < 4; j++) {
    int r = (tid >> 4) + 16 * j, c4 = (tid & 15) * 4;
    float4 v = *(const float4*)(src + (size_t)(k0 + r) * N + n0 + c4);
    tile[r * 65 + c4] = v.x; tile[r * 65 + c4 + 1] = v.y; tile[r * 65 + c4 + 2] = v.z; tile[r * 65 + c4 + 3] = v.w;
  }
  __syncthreads();
#pragma unroll
  for (int j = 0; j < 2; j++) {
    int c = tid + 256 * j, n = c >> 3, kc = c & 7;
    const float* tp = tile + (kc * 8) * 65 + n;
    uint4 o;
    o.x = pk2(tp[0], tp[65]); o.y = pk2(tp[130], tp[195]); o.z = pk2(tp[260], tp[325]); o.w = pk2(tp[390], tp[455]);
    *(uint4*)(dst + (size_t)(n0 + n) * K + k0 + kc * 8) = o;
  }
  __syncthreads();
}

__device__ void phase0(const Params& P, char* smem) {
  const int tid = opaque_tid();
  float* tile = (float*)smem;
  const int n0_ = 4 * 16 * 141, n1_ = 4 * 16 * 16, n2_ = 4 * 32 * 2, n3_ = 4 * 2 * 1;
  const int nT = n0_ + 3 * n1_ + 2 * n2_ + 2 * n3_;
  const int nBias = 64, nRope = 256;
  const int total = nT + nBias + nRope + 1;
  for (int it = blockIdx.x; it < total; it += gridDim.x) {
    if (it < nT) {
      int t = it;
      if (t < n0_) {
        int l = t / (16 * 141), rem = t % (16 * 141);
        transpose_tile(P.w_in + (size_t)l * DM * INC, P.WinT + (size_t)l * INCP * DM, DM, INC, (rem / 141) * 64, (rem % 141) * 64, tile, tid);
        continue;
      }
      t -= n0_;
      if (t < 3 * n1_) {
        int which = t / n1_; t %= n1_;
        int l = t / 256, rem = t % 256;
        const float* s = which == 0 ? P.w_pa : (which == 1 ? P.w_pb : P.w_out);
        u16* d = which == 0 ? P.WpaT : (which == 1 ? P.WpbT : P.WoT);
        transpose_tile(s + (size_t)l * DM * DM, d + (size_t)l * DM * DM, DM, DM, (rem >> 4) * 64, (rem & 15) * 64, tile, tid);
        continue;
      }
      t -= 3 * n1_;
      if (t < 2 * n2_) {
        int kv = t / n2_; t %= n2_;
        int l = t / 64, rem = t % 64;
        const float* s = kv ? P.w1_v : P.w1_k;
        transpose_tile(s + (size_t)l * 2048 * 128, P.W1T + (size_t)(l * 2 + kv) * 128 * 2048, 2048, 128, (rem >> 1) * 64, (rem & 1) * 64, tile, tid);
        continue;
      }
      t -= 2 * n2_;
      {
        int kv = t / n3_; t %= n3_;
        int l = t / 2, rem = t % 2;
        const float* s = kv ? P.w2_v : P.w2_k;
        transpose_tile(s + (size_t)l * 128 * 64, P.W2T + (size_t)(l * 2 + kv) * 64 * 128, 128, 64, rem * 64, 0, tile, tid);
      }
    } else if (it < nT + nBias) {
      int j = it - nT;
      int l = j >> 4, kv = (j >> 3) & 1, kq = j & 7;
      const float* pe = (kv ? P.pe_v : P.pe_k) + (size_t)l * 2048;
      const float* w1 = (kv ? P.w1_v : P.w1_k) + (size_t)l * 2048 * 128;
      int hid = tid & 127, kh = tid >> 7;
      int kbeg = kq * 256 + kh * 128;
      float s = 0.f;
#pragma unroll 8
      for (int k = 0; k < 128; k++) s += pe[kbeg + k] * w1[(size_t)(kbeg + k) * 128 + hid];
      float* part = (float*)smem;
      part[tid] = s;
      __syncthreads();
      if (tid < 128) P.bias1p[((l * 2 + kv) * 8 + kq) * 128 + hid] = part[tid] + part[tid + 128];
      __syncthreads();
    } else if (it < nT + nBias + nRope) {
      int idx = (it - nT - nBias) * 256 + tid;
      int t = idx >> 5, j = idx & 31;
      double inv = 1.0;
      for (int q = 0; q < j; q++) inv *= 0.7498942093324558;
      float invf = (float)inv;
      float angf = (float)t * invf;
      double a = (double)angf;
      double kq = rint(a * 0.15915494309189535);
      double rr = a - kq * 6.283185307179586;
      double r2 = rr * rr;
      double sterm = rr, cterm = 1.0, ssum = rr, csum = 1.0;
#pragma unroll 1
      for (int n = 1; n <= 15; n++) {
        cterm *= -r2 / (double)((2 * n - 1) * (2 * n));
        sterm *= -r2 / (double)((2 * n) * (2 * n + 1));
        csum += cterm; ssum += sterm;
      }
      P.ropec[idx] = (float)csum;
      P.ropes[idx] = (float)ssum;
    } else {
      if (tid < 64) P.ctr[tid] = 0u;
    }
  }
}

__device__ void norm_phase(const float* __restrict__ xsrc, const float* __restrict__ g, u16* __restrict__ hdst, int nrows) {
  const int tid = opaque_tid();
  const int lane = tid & 63;
  const int gw = blockIdx.x * 4 + (tid >> 6), nw = gridDim.x * 4;
  float4 gv[4];
#pragma unroll
  for (int j = 0; j < 4; j++) gv[j] = *(const float4*)(g + lane * 4 + 256 * j);
  for (int row = gw; row < nrows; row += nw) {
    const float* xr = xsrc + (size_t)row * DM;
    float4 v[4];
    float ss = 0.f;
#pragma unroll
    for (int j = 0; j < 4; j++) {
      v[j] = *(const float4*)(xr + lane * 4 + 256 * j);
      ss += v[j].x * v[j].x + v[j].y * v[j].y + v[j].z * v[j].z + v[j].w * v[j].w;
    }
#pragma unroll
    for (int o = 32; o >= 1; o >>= 1) ss += __shfl_xor(ss, o);
    float rstd = rsqrtf(ss * (1.f / DM) + 1e-6f);
#pragma unroll
    for (int j = 0; j < 4; j++) {
      uint2 o;
      o.x = pk2(v[j].x * rstd * gv[j].x, v[j].y * rstd * gv[j].y);
      o.y = pk2(v[j].z * rstd * gv[j].z, v[j].w * rstd * gv[j].w);
      *(uint2*)(hdst + (size_t)row * DM + lane * 4 + 256 * j) = o;
    }
  }
}

__device__ void final_norm_phase(float* __restrict__ x, const float* __restrict__ g, int row0, int nrows) {
  const int tid = opaque_tid();
  const int lane = tid & 63;
  const int gw = blockIdx.x * 4 + (tid >> 6), nw = gridDim.x * 4;
  float4 gv[4];
#pragma unroll
  for (int j = 0; j < 4; j++) gv[j] = *(const float4*)(g + lane * 4 + 256 * j);
  for (int row = gw; row < nrows; row += nw) {
    float* xr = x + (size_t)(row0 + row) * DM;
    float4 v[4];
    float ss = 0.f;
#pragma unroll
    for (int j = 0; j < 4; j++) {
      v[j] = *(const float4*)(xr + lane * 4 + 256 * j);
      ss += v[j].x * v[j].x + v[j].y * v[j].y + v[j].z * v[j].z + v[j].w * v[j].w;
    }
#pragma unroll
    for (int o = 32; o >= 1; o >>= 1) ss += __shfl_xor(ss, o);
    float rstd = rsqrtf(ss * (1.f / DM) + 1e-6f);
#pragma unroll
    for (int j = 0; j < 4; j++) {
      float4 o;
      o.x = v[j].x * rstd * gv[j].x; o.y = v[j].y * rstd * gv[j].y;
      o.z = v[j].z * rstd * gv[j].z; o.w = v[j].w * rstd * gv[j].w;
      *(float4*)(xr + lane * 4 + 256 * j) = o;
    }
  }
}

struct ARow {
  const u16* p; int ld;
  __device__ __forceinline__ const u16* operator()(int row, int k) const { return p + (size_t)row * ld + k; }
};
struct ACmp {
  const u16* p;
  __device__ __forceinline__ const u16* operator()(int row, int k) const {
    int t = 16 * row + (k >> 6); t = t > (TSEQ - 1) ? (TSEQ - 1) : t;
    return p + (size_t)t * INC + (k & 63);
  }
};

template <class AF>
__device__ __forceinline__ void gemm_mainloop(AF af, const u16* __restrict__ Bt, int ldb, int K, char* smem,
                                              f32x16 (&acc)[2][2], const int tid) {
  const int lane = tid & 63, r = lane & 31, h = lane >> 5, w = tid >> 6;
  const int wm = w >> 1, wn = w & 1;
  const int lrow = tid >> 3, lch = tid & 7;
  uint4 ra[4], rb[4];
  const int nk = K >> 6;
#pragma unroll
  for (int j = 0; j < 4; j++) {
    int row = lrow + 32 * j;
    ra[j] = *(const uint4*)af(row, lch * 8);
    rb[j] = *(const uint4*)(Bt + (size_t)row * ldb + lch * 8);
  }
#pragma unroll
  for (int j = 0; j < 4; j++) {
    int row = lrow + 32 * j;
    int off = row * 128 + ((lch ^ ((row >> 1) & 7)) << 4);
    *(uint4*)(smem + off) = ra[j];
    *(uint4*)(smem + 16384 + off) = rb[j];
  }
  __syncthreads();
  for (int it = 0; it < nk; it++) {
    const bool more = (it + 1) < nk;
    if (more) {
      const int k0 = (it + 1) * 64;
#pragma unroll
      for (int j = 0; j < 4; j++) {
        int row = lrow + 32 * j;
        ra[j] = *(const uint4*)af(row, k0 + lch * 8);
        rb[j] = *(const uint4*)(Bt + (size_t)row * ldb + k0 + lch * 8);
      }
    }
    const char* sa = smem + (it & 1) * 32768;
    const char* sb = sa + 16384;
#pragma unroll
    for (int kk = 0; kk < 4; kk++) {
      bf16x8 a[2], b[2];
#pragma unroll
      for (int mi = 0; mi < 2; mi++) {
        int row = wm * 64 + mi * 32 + r;
        a[mi] = ldfrag(sa + row * 128 + (((kk * 2 + h) ^ ((row >> 1) & 7)) << 4));
      }
#pragma unroll
      for (int ni = 0; ni < 2; ni++) {
        int row = wn * 64 + ni * 32 + r;
        b[ni] = ldfrag(sb + row * 128 + (((kk * 2 + h) ^ ((row >> 1) & 7)) << 4));
      }
#pragma unroll
      for (int mi = 0; mi < 2; mi++)
#pragma unroll
        for (int ni = 0; ni < 2; ni++) acc[mi][ni] = mfma32(a[mi], b[ni], acc[mi][ni]);
    }
    if (more) {
      char* sd = smem + ((it + 1) & 1) * 32768;
#pragma unroll
      for (int j = 0; j < 4; j++) {
        int row = lrow + 32 * j;
        int off = row * 128 + ((lch ^ ((row >> 1) & 7)) << 4);
        *(uint4*)(sd + off) = ra[j];
        *(uint4*)(sd + 16384 + off) = rb[j];
      }
    }
    __syncthreads();
  }
}

__device__ __forceinline__ void zero_acc(f32x16 (&acc)[2][2]) {
#pragma unroll
  for (int a = 0; a < 2; a++)
#pragma unroll
    for (int b = 0; b < 2; b++)
#pragma unroll
      for (int i = 0; i < 16; i++) acc[a][b][i] = 0.f;
}

__device__ __forceinline__ bool tile_map(int t, int MT, int NT, int& m, int& n) {
  int x = t & 7, s = t >> 3, wv = s & 63;
  int S = (s >> 6) * 8 + x;
  int NS = (NT + 7) >> 3;
  int nSuper = (MT >> 3) * NS;
  if (S >= nSuper) return false;
  int mS = S / NS, nS = S % NS;
  m = mS * 8 + (wv & 7);
  n = nS * 8 + (wv >> 3);
  return n < NT;
}
__device__ __forceinline__ int tile_slots(int MT, int NT) {
  int NS = (NT + 7) >> 3;
  int nSuper = (MT >> 3) * NS;
  return ((nSuper + 7) >> 3) * 8 * 64;
}

__device__ void gemm1_phase(const Params& P, int layer, char* smem) {
  const int CT = P.NB * TSEQ;
  const int MT = CT >> 7, NT = 71;
  const u16* Bt = P.WinT + (size_t)layer * INCP * DM;
  const int slots = tile_slots(MT, NT);
  for (int t = blockIdx.x; t < slots; t += gridDim.x) {
    int m, n;
    const int tid = opaque_tid(), lane = tid & 63, r = lane & 31, h = lane >> 5, w = tid >> 6;
    const int wm = w >> 1, wn = w & 1;
    if (!tile_map(t, MT, NT, m, n)) continue;
    f32x16 acc[2][2];
    zero_acc(acc);
    ARow af{P.h + (size_t)(m * 128) * DM, DM};
    gemm_mainloop(af, Bt + (size_t)(n * 128) * DM, DM, DM, smem, acc, tid);
    const int cbase = n * 128 + wn * 64;
    const int rbase = m * 128 + wm * 64;
    if (cbase >= INC) continue;
    const bool rope_q = cbase < 1024;
    const bool rope_k = (cbase >= C_KV + 256 && cbase < C_KV + 384) || (cbase >= C_KV + 512 && cbase < C_KV + 640);
    if (rope_q || rope_k) {
#pragma unroll
      for (int mi = 0; mi < 2; mi++) {
#pragma unroll
        for (int i = 0; i < 16; i++) {
          int row = rbase + mi * 32 + 8 * (i >> 2) + 4 * h + (i & 3);
          int tt = row & (TSEQ - 1);
          float c = P.ropec[tt * 32 + r], s = P.ropes[tt * 32 + r];
          float x1 = acc[mi][0][i], x2 = acc[mi][1][i];
          float r1 = x1 * c - x2 * s, r2 = x2 * c + x1 * s;
          u16* pr = P.proj + (size_t)row * INC;
          if (rope_q) {
            pr[cbase + r] = f2bf(x1); pr[cbase + 32 + r] = f2bf(x2);
            pr[C_QR + cbase + r] = f2bf(r1); pr[C_QR + cbase + 32 + r] = f2bf(r2);
          } else {
            pr[cbase + r] = f2bf(r1); pr[cbase + 32 + r] = f2bf(r2);
          }
        }
      }
    } else {
#pragma unroll
      for (int ni = 0; ni < 2; ni++) {
        const int c = cbase + ni * 32 + r;
        int kind = 0;
        u16* vt = nullptr;
        int vcol = 0;
        if (c >= INC) kind = 3;
        else if (c >= C_VB && c < C_FB) { kind = 1; vcol = c - C_VB; vt = P.vbt; }
        else if (c >= C_FB && c < C_ZB) kind = 2;
        else if (c >= C_KV + 384 && c < C_KV + 512) { kind = 1; vcol = c - (C_KV + 384); vt = P.vst; }
        else if (c >= C_KV + 640 && c < C_KV + 768) { kind = 1; vcol = c - (C_KV + 640); vt = P.vwt; }
        const int nh = (vt == P.vbt) ? 16 : 2;
#pragma unroll
        for (int mi = 0; mi < 2; mi++) {
          if (kind == 0) {
#pragma unroll
            for (int i = 0; i < 16; i++) {
              int row = rbase + mi * 32 + 8 * (i >> 2) + 4 * h + (i & 3);
              P.proj[(size_t)row * INC + c] = f2bf(acc[mi][ni][i]);
            }
          } else if (kind == 1) {
#pragma unroll
            for (int gq = 0; gq < 4; gq++) {
              int row = rbase + mi * 32 + 8 * gq + 4 * h;
              int bl = row >> 11, tt = row & (TSEQ - 1);
              uint2 o;
              o.x = pk2(acc[mi][ni][gq * 4 + 0], acc[mi][ni][gq * 4 + 1]);
              o.y = pk2(acc[mi][ni][gq * 4 + 2], acc[mi][ni][gq * 4 + 3]);
              *(uint2*)(vt + ((size_t)(bl * nh + (vcol >> 6)) * 64 + (vcol & 63)) * TSEQ + tt) = o;
            }
          } else if (kind == 2) {
#pragma unroll
            for (int i = 0; i < 16; i++) {
              int row = rbase + mi * 32 + 8 * (i >> 2) + 4 * h + (i & 3);
              P.flog[(size_t)row * 16 + (c - C_FB)] = acc[mi][ni][i];
            }
          }
        }
      }
    }
  }
}

__device__ void gemm2_phase(const Params& P, int layer, char* smem) {
  const int CT = P.NB * TSEQ;
  const int MT = CT >> 7, NT = 8;
  const int slots = tile_slots(MT, NT);
  for (int t = blockIdx.x; t < slots; t += gridDim.x) {
    int m, n;
    const int tid = opaque_tid(), lane = tid & 63, r = lane & 31, h = lane >> 5, w = tid >> 6;
    const int wm = w >> 1, wn = w & 1;
    if (!tile_map(t, MT, NT, m, n)) continue;
    f32x16 acc[2][2];
    zero_acc(acc);
    {
      ARow af{P.ya + (size_t)(m * 128) * DM, DM};
      gemm_mainloop(af, P.WpaT + (size_t)layer * DM * DM + (size_t)(n * 128) * DM, DM, DM, smem, acc, tid);
    }
    const int cbase = n * 128 + wn * 64, rbase = m * 128 + wm * 64;
    __builtin_amdgcn_sched_barrier(0);
#pragma unroll
    for (int mi = 0; mi < 2; mi++)
#pragma unroll
      for (int ni = 0; ni < 2; ni++) {
        const u16* pp = P.proj + (size_t)(rbase + mi * 32 + 4 * h) * INC + cbase + ni * 32 + r;
#pragma unroll
        for (int i = 0; i < 16; i++) {
          const int ro = 8 * (i >> 2) + (i & 3);
          float ra_ = bf2f(pp[ro * INC + C_RA]);
          float rb_ = bf2f(pp[ro * INC + C_RB]);
          acc[mi][ni][i] *= (1.f + __expf(-rb_)) / (1.f + __expf(-ra_));
        }
        __builtin_amdgcn_sched_barrier(0);
      }
    {
      ARow af{P.yb + (size_t)(m * 128) * DM, DM};
      gemm_mainloop(af, P.WpbT + (size_t)layer * DM * DM + (size_t)(n * 128) * DM, DM, DM, smem, acc, tid);
    }
#pragma unroll
    for (int mi = 0; mi < 2; mi++)
#pragma unroll
      for (int ni = 0; ni < 2; ni++) {
        const int tid2 = opaque_tid(), r2 = tid2 & 31, h2 = (tid2 >> 5) & 1;
        const u16* pp = P.proj + (size_t)(rbase + mi * 32 + 4 * h2) * INC + cbase + ni * 32 + r2;
        u16* hp = P.h + (size_t)(rbase + mi * 32 + 4 * h2) * DM + cbase + ni * 32 + r2;
#pragma unroll
        for (int i = 0; i < 16; i++) {
          const int ro = 8 * (i >> 2) + (i & 3);
          float gb = sigmoidf_(bf2f(pp[ro * INC + C_RB]));
          hp[ro * DM] = f2bf(acc[mi][ni][i] * gb);
        }
        __builtin_amdgcn_sched_barrier(0);
      }
  }
}

__device__ void gemm3_phase(const Params& P, int layer, int chunk, char* smem) {
  const int CT = P.NB * TSEQ;
  const int MT = CT >> 7, NT = 8;
  const float* xs = (layer == 0 ? P.x_in : P.out) + (size_t)chunk * CT * DM;
  float* xd = P.out + (size_t)chunk * CT * DM;
  const int slots = tile_slots(MT, NT);
  for (int t = blockIdx.x; t < slots; t += gridDim.x) {
    int m, n;
    const int tid = opaque_tid(), lane = tid & 63, r = lane & 31, h = lane >> 5, w = tid >> 6;
    const int wm = w >> 1, wn = w & 1;
    if (!tile_map(t, MT, NT, m, n)) continue;
    f32x16 acc[2][2];
    zero_acc(acc);
    ARow af{P.h + (size_t)(m * 128) * DM, DM};
    gemm_mainloop(af, P.WoT + (size_t)layer * DM * DM + (size_t)(n * 128) * DM, DM, DM, smem, acc, tid);
    const int cbase = n * 128 + wn * 64, rbase = m * 128 + wm * 64;
#pragma unroll
    for (int mi = 0; mi < 2; mi++)
#pragma unroll
      for (int ni = 0; ni < 2; ni++)
#pragma unroll
        for (int i = 0; i < 16; i++) {
          int row = rbase + mi * 32 + 8 * (i >> 2) + 4 * h + (i & 3);
          int c = cbase + ni * 32 + r;
          xd[(size_t)row * DM + c] = xs[(size_t)row * DM + c] + acc[mi][ni][i];
        }
  }
}

__device__ void pb_phase(const Params& P, int layer, char* smem) {
  const int tid = opaque_tid(),  lane = tid & 63, r = lane & 31, h = lane >> 5, w = tid >> 6;
  const int wm = w >> 1, wn = w & 1;
  const int nCmp = P.NB * 4;
  const int nScan = P.NB * 4;
  for (int it = blockIdx.x; it < nCmp + nScan; it += gridDim.x) {
    if (it < nCmp) {
      const int bl = it >> 2, g = (it >> 1) & 1, kv = it & 1;
      f32x16 acc[2][2];
      zero_acc(acc);
      ACmp af{P.proj + (size_t)bl * TSEQ * INC + C_KV + kv * 128 + g * 64};
      gemm_mainloop(af, P.W1T + (size_t)(layer * 2 + kv) * 128 * 2048, 2048, 2048, smem, acc, tid);
      const float* bp = P.bias1p + (size_t)((layer * 2 + kv) * 8) * 128;
#pragma unroll
      for (int ni = 0; ni < 2; ni++) {
        int hc = wn * 64 + ni * 32 + r;
        float b1 = 0.f;
#pragma unroll
        for (int q = 0; q < 8; q++) b1 += bp[q * 128 + hc];
#pragma unroll
        for (int mi = 0; mi < 2; mi++)
#pragma unroll
          for (int i = 0; i < 16; i++) {
            int n = wm * 64 + mi * 32 + 8 * (i >> 2) + 4 * h + (i & 3);
            float v = siluf_(acc[mi][ni][i] + b1);
            *(u16*)(smem + n * 256 + (((hc >> 3) ^ (n & 15)) << 4) + (hc & 7) * 2) = f2bf(v);
          }
      }
      __syncthreads();
      const u16* w2t = P.W2T + (size_t)(layer * 2 + kv) * 64 * 128;
      f32x16 o2[2];
#pragma unroll
      for (int dt = 0; dt < 2; dt++)
#pragma unroll
        for (int i = 0; i < 16; i++) o2[dt][i] = 0.f;
#pragma unroll
      for (int kk = 0; kk < 8; kk++) {
        int n = w * 32 + r;
        bf16x8 a = ldfrag(smem + n * 256 + (((kk * 2 + h) ^ (n & 15)) << 4));
#pragma unroll
        for (int dt = 0; dt < 2; dt++) {
          bf16x8 b = ldfrag(w2t + (size_t)(dt * 32 + r) * 128 + kk * 16 + h * 8);
          o2[dt] = mfma32(a, b, o2[dt]);
        }
      }
#pragma unroll
      for (int dt = 0; dt < 2; dt++) {
        int d = dt * 32 + r;
        if (kv == 0) {
#pragma unroll
          for (int i = 0; i < 16; i++) {
            int n = w * 32 + 8 * (i >> 2) + 4 * h + (i & 3);
            P.kcmp[((size_t)(bl * 2 + g) * 128 + n) * 64 + d] = f2bf(o2[dt][i]);
          }
        } else {
#pragma unroll
          for (int gq = 0; gq < 4; gq++) {
            int n0 = w * 32 + 8 * gq + 4 * h;
            uint2 o;
            o.x = pk2(o2[dt][gq * 4 + 0], o2[dt][gq * 4 + 1]);
            o.y = pk2(o2[dt][gq * 4 + 2], o2[dt][gq * 4 + 3]);
            *(uint2*)(P.vcmpt + ((size_t)(bl * 2 + g) * 64 + d) * 128 + n0) = o;
          }
        }
      }
      __syncthreads();
    } else {
      const int sidx = (it - nCmp) * 4 + w;
      const int bl = sidx >> 4, hh = sidx & 15;
      const float bf = P.b_forget[layer * 16 + hh];
      const float* fl = P.flog + ((size_t)bl * TSEQ + lane * 32) * 16 + hh;
      float loc = 0.f;
#pragma unroll 8
      for (int j = 0; j < 32; j++) {
        float x = fl[j * 16] + bf;
        float ls = (x >= 0.f) ? -log1pf(__expf(-x)) : (x - log1pf(__expf(x)));
        loc += ls;
      }
      float incl = loc;
#pragma unroll
      for (int o = 1; o < 64; o <<= 1) {
        float v = __shfl_up(incl, o);
        if (lane >= o) incl += v;
      }
      float run = incl - loc;
      float* fo = P.F2 + ((size_t)bl * 16 + hh) * TSEQ + lane * 32;
#pragma unroll 8
      for (int j = 0; j < 32; j++) {
        float x = fl[j * 16] + bf;
        float ls = (x >= 0.f) ? -log1pf(__expf(-x)) : (x - log1pf(__expf(x)));
        run += ls;
        fo[j] = run * LOG2E;
      }
    }
  }
}

__device__ void pc1_phase(const Params& P, char* smem) {
  const int tid = opaque_tid(),  lane = tid & 63, r = lane & 31, h = lane >> 5, w = tid >> 6;
  const int nItems = P.NB * 2 * 16;
  const float c1 = 0.125f * LOG2E;
  for (int it = blockIdx.x; it < nItems; it += gridDim.x) {
    const int qt = it & 15, g = (it >> 4) & 1, bl = it >> 5;
    __syncthreads();
#pragma unroll
    for (int j = 0; j < 4; j++) {
      int c = tid + 256 * j;
      {
        int n = c >> 3, ch = c & 7;
        uint4 v = *(const uint4*)(P.kcmp + ((size_t)(bl * 2 + g) * 128 + n) * 64 + ch * 8);
        *(uint4*)(smem + n * 128 + ((ch ^ ((n >> 1) & 7)) << 4)) = v;
      }
      {
        int d = c >> 4, ch = c & 15;
        uint4 v = *(const uint4*)(P.vcmpt + ((size_t)(bl * 2 + g) * 64 + d) * 128 + ch * 8);
        int sw = d & 31;
        *(uint2*)(smem + 16384 + d * 256 + (((2 * ch) ^ sw) << 3)) = make_uint2(v.x, v.y);
        *(uint2*)(smem + 16384 + d * 256 + (((2 * ch + 1) ^ sw) << 3)) = make_uint2(v.z, v.w);
      }
    }
    __syncthreads();
    const int qw_lo = qt * 128 + w * 32;
    const int qtok = qw_lo + r;
    const size_t rowg = (size_t)bl * TSEQ + qtok;
    const int tq = qtok - 31 - 64 * h;
    float sumacc[16], lastacc[16];
#pragma unroll
    for (int s = 0; s < 16; s++) { sumacc[s] = 0.f; lastacc[s] = 0.f; }
#pragma unroll 1
    for (int hh = 0; hh < 8; hh++) {
      const int head = g * 8 + hh;
      bf16x8 qf[4];
#pragma unroll
      for (int kk = 0; kk < 4; kk++) qf[kk] = ldfrag(P.proj + rowg * INC + C_QA + head * 64 + kk * 16 + h * 8);
      f32x16 s[4];
#pragma unroll
      for (int nt = 0; nt < 4; nt++) {
#pragma unroll
        for (int i = 0; i < 16; i++) s[nt][i] = 0.f;
#pragma unroll
        for (int kk = 0; kk < 4; kk++) {
          int row = nt * 32 + r;
          bf16x8 a = ldfrag(smem + row * 128 + (((kk * 2 + h) ^ ((row >> 1) & 7)) << 4));
          s[nt] = mfma32(a, qf[kk], s[nt]);
        }
        __builtin_amdgcn_sched_barrier(0);
      }
      float mx = -3.0e38f;
#pragma unroll
      for (int nt = 0; nt < 4; nt++)
#pragma unroll
        for (int i = 0; i < 16; i++) {
          bool ok = (16 * (nt * 32 + 8 * (i >> 2) + (i & 3))) <= tq;
          float v = ok ? s[nt][i] * c1 : -3.0e38f;
          s[nt][i] = v;
          mx = fmaxf(mx, v);
        }
      mx = fmaxf(mx, __shfl_xor(mx, 32));
      const bool anyv = mx > -1.0e37f;
      float mref = anyv ? mx : 0.f;
      float l = 0.f;
#pragma unroll
      for (int nt = 0; nt < 4; nt++)
#pragma unroll
        for (int i = 0; i < 16; i++) {
          float p = __builtin_amdgcn_exp2f(s[nt][i] - mref);
          s[nt][i] = p;
          l += p;
        }
      l += __shfl_xor(l, 32);
      const float inv = (anyv && l > 0.f) ? 1.f / l : 0.f;
#pragma unroll
      for (int nt = 0; nt < 4; nt++)
#pragma unroll
        for (int i = 0; i < 16; i++) s[nt][i] *= inv;
#pragma unroll
      for (int nt = 0; nt < 4; nt++)
#pragma unroll
        for (int gq = 0; gq < 4; gq++) {
          sumacc[nt * 4 + gq] += (s[nt][gq * 4] + s[nt][gq * 4 + 1]) + (s[nt][gq * 4 + 2] + s[nt][gq * 4 + 3]);
          lastacc[nt * 4 + gq] += s[nt][gq * 4 + 3];
        }
      uint4 pbv[8];
#pragma unroll
      for (int ks = 0; ks < 8; ks++) {
        const int nt = ks >> 1, hb = (ks & 1) * 8;
        pbv[ks].x = pk2(s[nt][hb + 0], s[nt][hb + 1]); pbv[ks].y = pk2(s[nt][hb + 2], s[nt][hb + 3]);
        pbv[ks].z = pk2(s[nt][hb + 4], s[nt][hb + 5]); pbv[ks].w = pk2(s[nt][hb + 6], s[nt][hb + 7]);
      }
      const float g0 = sigmoidf_(bf2f(P.proj[rowg * INC + C_GA + head]));
#pragma unroll
      for (int dt = 0; dt < 2; dt++) {
        f32x16 o;
#pragma unroll
        for (int i = 0; i < 16; i++) o[i] = 0.f;
        const int d = dt * 32 + r, sw = d & 31;
#pragma unroll
        for (int ks = 0; ks < 8; ks++) {
          uint2 lo = *(const uint2*)(smem + 16384 + d * 256 + (((ks * 4 + h) ^ sw) << 3));
          uint2 hi = *(const uint2*)(smem + 16384 + d * 256 + (((ks * 4 + 2 + h) ^ sw) << 3));
          uint4 au = make_uint4(lo.x, lo.y, hi.x, hi.y);
          o = mfma32(__builtin_bit_cast(bf16x8, au), __builtin_bit_cast(bf16x8, pbv[ks]), o);
        }
#pragma unroll
        for (int gq = 0; gq < 4; gq++) {
          int d0 = dt * 32 + 8 * gq + 4 * h;
          uint2 ov;
          ov.x = pk2(o[gq * 4 + 0] * g0, o[gq * 4 + 1] * g0);
          ov.y = pk2(o[gq * 4 + 2] * g0, o[gq * 4 + 3] * g0);
          *(uint2*)(P.ya + rowg * DM + head * 64 + d0) = ov;
        }
        __builtin_amdgcn_sched_barrier(0);
      }
    }
    float sc[16];
#pragma unroll
    for (int s = 0; s < 16; s++) {
      float prev = (s == 0) ? 0.f : lastacc[s - 1];
      float sendv = h ? prev : lastacc[s];
      float recv = __shfl_xor(sendv, 32);
      float imp = sumacc[s] + recv;
      int j = (s >> 2) * 8 + (s & 3) * 2 + h;
      int cur = qtok >> 6;
      bool forced = (j == 0) || (j == cur) || (j == cur - 1);
      bool valid = j <= cur;
      sc[s] = forced ? 1.0e4f : (valid ? imp : -1.0f);
    }
    unsigned mask = 0u;
#pragma unroll 1
    for (int rd = 0; rd < 8; rd++) {
      float best = -2.0f; int bj = 0;
#pragma unroll
      for (int s = 0; s < 16; s++) {
        int j = (s >> 2) * 8 + (s & 3) * 2 + h;
        if (sc[s] > best) { best = sc[s]; bj = j; }
      }
      float ob = __shfl_xor(best, 32);
      int oj = __shfl_xor(bj, 32);
      bool mine = (best > ob) || (best == ob && bj < oj);
      int wj = mine ? bj : oj;
      mask |= 1u << wj;
#pragma unroll
      for (int s = 0; s < 16; s++) {
        int j = (s >> 2) * 8 + (s & 3) * 2 + h;
        if (j == wj) sc[s] = -3.0f;
      }
    }
    if (h == 0) P.sel[(size_t)(bl * 2 + g) * TSEQ + qtok] = mask;
  }
}

#define ATT_GLOAD(KT)                                                                              \
  {                                                                                                \
    kreg0 = *(const uint4*)(Kg + (size_t)((KT) * 64 + lk) * ldk + lch * 8);                        \
    kreg1 = *(const uint4*)(Kg + (size_t)((KT) * 64 + lk + 32) * ldk + lch * 8);                   \
    vreg0 = *(const uint4*)(Vtg + (size_t)lk * TSEQ + (KT) * 64 + lch * 8);                        \
    vreg1 = *(const uint4*)(Vtg + (size_t)(lk + 32) * TSEQ + (KT) * 64 + lch * 8);                 \
    if (MODE == 0 && tid < 16) freg = *(const float4*)(F2g + (KT) * 64 + tid * 4);                 \
  }
#define ATT_SSTORE(ST)                                                                             \
  {                                                                                                \
    char* base_ = smem + (ST) * ATT_STAGE;                                                         \
    *(uint4*)(base_ + koff0) = kreg0;                                                              \
    *(uint4*)(base_ + koff0 + 4096) = kreg1;                                                       \
    *(uint2*)(base_ + voffa) = make_uint2(vreg0.x, vreg0.y);                                       \
    *(uint2*)(base_ + voffb) = make_uint2(vreg0.z, vreg0.w);                                       \
    *(uint2*)(base_ + voffa + 4096) = make_uint2(vreg1.x, vreg1.y);                                \
    *(uint2*)(base_ + voffb + 4096) = make_uint2(vreg1.z, vreg1.w);                                \
    if (MODE == 0 && tid < 16) *(float4*)(base_ + 16384 + tid * 16) = freg;                        \
  }

template <int MODE>
__device__ __forceinline__ void attn_pass(const u16* __restrict__ Kg, int ldk, const u16* __restrict__ Vtg,
                                          const float* __restrict__ F2g, int kt_lo, int kt_hi,
                                          const u16* __restrict__ qptr, int qtok, int qw_lo, unsigned selm,
                                          f32x16 (&o)[2], float& m, float& l, char* smem, const int tid) {
  const int lane = tid & 63, r = lane & 31, h = lane >> 5;
  const int lk = tid >> 3, lch = tid & 7;
  const float c1 = 0.125f * LOG2E;
  uint4 kreg0, kreg1, vreg0, vreg1;
  const int koff0 = lk * 128 + ((lch ^ ((lk >> 1) & 7)) << 4);
  const int voffa = 8192 + lk * 128 + (((2 * lch) ^ ((lk >> 1) & 15)) << 3);
  const int voffb = 8192 + lk * 128 + (((2 * lch + 1) ^ ((lk >> 1) & 15)) << 3);
  float4 freg = make_float4(0.f, 0.f, 0.f, 0.f);
  if (kt_lo >= kt_hi) return;
  const bf16x8 qf0 = ldfrag(qptr), qf1 = ldfrag(qptr + 16), qf2 = ldfrag(qptr + 32), qf3 = ldfrag(qptr + 48);
  ATT_GLOAD(kt_lo);
  ATT_SSTORE(0);
  __syncthreads();
  for (int kt = kt_lo; kt < kt_hi; kt++) {
    const int st = (kt - kt_lo) & 1;
    const bool more = (kt + 1) < kt_hi;
    if (more) ATT_GLOAD(kt + 1);
    const int kb = kt * 64;
    bool active = kb <= qw_lo + 31;
    bool selbit = true;
    if (MODE == 1) {
      selbit = (selm >> kt) & 1u;
      active = active && (__ballot(selbit) != 0ull);
    }
    if (MODE == 2) active = active && (kb + 63 + 511 >= qw_lo);
    if (active) {
      const char* sb = smem + st * ATT_STAGE;
      f32x16 s[2];
#pragma unroll
      for (int nt = 0; nt < 2; nt++) {
#pragma unroll
        for (int i = 0; i < 16; i++) s[nt][i] = 0.f;
#pragma unroll
        for (int kk = 0; kk < 4; kk++) {
          int row = nt * 32 + r;
          bf16x8 a = ldfrag(sb + row * 128 + (((kk * 2 + h) ^ ((row >> 1) & 7)) << 4));
          s[nt] = mfma32(a, kk == 0 ? qf0 : (kk == 1 ? qf1 : (kk == 2 ? qf2 : qf3)), s[nt]);
        }
      }
#pragma unroll
      for (int nt = 0; nt < 2; nt++)
#pragma unroll
        for (int gq = 0; gq < 4; gq++) {
          if (MODE == 0) {
            float4 fk = *(const float4*)(sb + 16384 + (nt * 32 + gq * 8 + h * 4) * 4);
            s[nt][gq * 4 + 0] = s[nt][gq * 4 + 0] * c1 - fk.x;
            s[nt][gq * 4 + 1] = s[nt][gq * 4 + 1] * c1 - fk.y;
            s[nt][gq * 4 + 2] = s[nt][gq * 4 + 2] * c1 - fk.z;
            s[nt][gq * 4 + 3] = s[nt][gq * 4 + 3] * c1 - fk.w;
          } else {
#pragma unroll
            for (int e = 0; e < 4; e++) s[nt][gq * 4 + e] *= c1;
          }
        }
      bool need_mask;
      if (MODE == 0) need_mask = (kb + 63 > qw_lo);
      else if (MODE == 1) need_mask = (kb + 63 > qw_lo) || (__ballot(!selbit) != 0ull);
      else need_mask = (kb + 63 > qw_lo) || (kb + 512 <= qw_lo + 31);
      if (need_mask) {
        const int td = qtok - kb - 4 * h;
#pragma unroll
        for (int nt = 0; nt < 2; nt++)
#pragma unroll
          for (int i = 0; i < 16; i++) {
            const int kc = nt * 32 + 8 * (i >> 2) + (i & 3);
            bool ok = kc <= td;
            if (MODE == 1) ok = ok && selbit;
            if (MODE == 2) ok = ok && (kc + 512 > td);
            s[nt][i] = ok ? s[nt][i] : -3.0e38f;
          }
      }
      float mx = s[0][0];
#pragma unroll
      for (int nt = 0; nt < 2; nt++)
#pragma unroll
        for (int i = 0; i < 16; i++) mx = fmaxf(mx, s[nt][i]);
      mx = fmaxf(mx, __shfl_xor(mx, 32));
      const float mn = fmaxf(m, mx);
      const float alpha = __builtin_amdgcn_exp2f(m - mn);
      float rs = 0.f;
#pragma unroll
      for (int nt = 0; nt < 2; nt++)
#pragma unroll
        for (int i = 0; i < 16; i++) {
          float p = __builtin_amdgcn_exp2f(s[nt][i] - mn);
          s[nt][i] = p;
          rs += p;
        }
      rs += __shfl_xor(rs, 32);
      l = l * alpha + rs;
      m = mn;
#pragma unroll
      for (int dt = 0; dt < 2; dt++)
#pragma unroll
        for (int i = 0; i < 16; i++) o[dt][i] *= alpha;
#pragma unroll
      for (int ks = 0; ks < 4; ks++) {
        const int nt = ks >> 1, hb = (ks & 1) * 8;
        uint4 pu;
        pu.x = pk2(s[nt][hb + 0], s[nt][hb + 1]); pu.y = pk2(s[nt][hb + 2], s[nt][hb + 3]);
        pu.z = pk2(s[nt][hb + 4], s[nt][hb + 5]); pu.w = pk2(s[nt][hb + 6], s[nt][hb + 7]);
        bf16x8 pb = __builtin_bit_cast(bf16x8, pu);
#pragma unroll
        for (int dt = 0; dt < 2; dt++) {
          int d = dt * 32 + r, sw = (d >> 1) & 15;
          uint2 lo = *(const uint2*)(sb + 8192 + d * 128 + (((ks * 4 + h) ^ sw) << 3));
          uint2 hi = *(const uint2*)(sb + 8192 + d * 128 + (((ks * 4 + 2 + h) ^ sw) << 3));
          uint4 au = make_uint4(lo.x, lo.y, hi.x, hi.y);
          o[dt] = mfma32(__builtin_bit_cast(bf16x8, au), pb, o[dt]);
        }
      }
    }
    if (more) ATT_SSTORE(st ^ 1);
    __syncthreads();
  }
}

__device__ void pc2_phase(const Params& P, int layer, int chunk, char* smem, int* s_item) {
  const int tid = opaque_tid(),  lane = tid & 63, r = lane & 31, h = lane >> 5, w = tid >> 6;
  const int perq = 2 * P.NB * 16;
  const int nItems = 16 * perq;
  unsigned* ctr = P.ctr + (chunk * 4 + layer);
  while (true) {
    __syncthreads();
    if (tid == 0) *s_item = (int)atomicAdd(ctr, 1u);
    __syncthreads();
    const int it = *s_item;
    if (it >= nItems) break;
    const int qt = 15 - it / perq;
    const int rem = it % perq;
    const int type = rem & 1;
    const int bh = rem >> 1;
    const int bl = bh >> 4, head = bh & 15;
    const int qw_lo = qt * 128 + w * 32;
    const int qtok = qw_lo + r;
    const size_t rowg = (size_t)bl * TSEQ + qtok;
    const u16* pb_ = P.proj + (size_t)bl * TSEQ * INC;
    f32x16 o[2];
#pragma unroll
    for (int dt = 0; dt < 2; dt++)
#pragma unroll
      for (int i = 0; i < 16; i++) o[dt][i] = 0.f;
    float m = -1.0e30f, l = 0.f;
    if (type == 0) {
      const u16* qf = P.proj + rowg * INC + C_QB + head * 64 + h * 8;
      attn_pass<0>(pb_ + C_KB + head * 64, INC, P.vbt + (size_t)(bl * 16 + head) * 64 * TSEQ,
                   P.F2 + (size_t)(bl * 16 + head) * TSEQ, 0, 2 * qt + 2, qf, qtok, qw_lo, 0u, o, m, l, smem, tid);
      const float inv = 1.f / l;
#pragma unroll
      for (int dt = 0; dt < 2; dt++)
#pragma unroll
        for (int gq = 0; gq < 4; gq++) {
          int d0 = dt * 32 + 8 * gq + 4 * h;
          uint2 zz = *(const uint2*)(P.proj + rowg * INC + C_ZB + head * 64 + d0);
          uint2 ov;
          ov.x = pk2(o[dt][gq * 4 + 0] * inv * siluf_(bflo(zz.x)), o[dt][gq * 4 + 1] * inv * siluf_(bfhi(zz.x)));
          ov.y = pk2(o[dt][gq * 4 + 2] * inv * siluf_(bflo(zz.y)), o[dt][gq * 4 + 3] * inv * siluf_(bfhi(zz.y)));
          *(uint2*)(P.yb + rowg * DM + head * 64 + d0) = ov;
        }
    } else {
      const int g = head >> 3;
      const u16* qf = P.proj + rowg * INC + C_QR + head * 64 + h * 8;
      const unsigned selm = P.sel[(size_t)(bl * 2 + g) * TSEQ + qtok];
      attn_pass<1>(pb_ + C_KV + 256 + g * 64, INC, P.vst + (size_t)(bl * 2 + g) * 64 * TSEQ, nullptr,
                   0, 2 * qt + 2, qf, qtok, qw_lo, selm, o, m, l, smem, tid);
      f32x16 tot[2];
      {
        const float g1 = sigmoidf_(bf2f(P.proj[rowg * INC + C_GA + 16 + head]));
        const float sc1 = g1 / l;
#pragma unroll
        for (int dt = 0; dt < 2; dt++)
#pragma unroll
          for (int i = 0; i < 16; i++) { tot[dt][i] = o[dt][i] * sc1; o[dt][i] = 0.f; }
      }
      m = -1.0e30f; l = 0.f;
      const int klo = (2 * qt - 8) > 0 ? (2 * qt - 8) : 0;
      attn_pass<2>(pb_ + C_KV + 512 + g * 64, INC, P.vwt + (size_t)(bl * 2 + g) * 64 * TSEQ, nullptr,
                   klo, 2 * qt + 2, qf, qtok, qw_lo, 0u, o, m, l, smem, tid);
      const float g2 = sigmoidf_(bf2f(P.proj[rowg * INC + C_GA + 32 + head]));
      const float sc2 = g2 / l;
#pragma unroll
      for (int dt = 0; dt < 2; dt++)
#pragma unroll
        for (int gq = 0; gq < 4; gq++) {
          int d0 = dt * 32 + 8 * gq + 4 * h;
          uint2 zz = *(const uint2*)(P.proj + rowg * INC + C_ZA + head * 64 + d0);
          uint2 oc = *(const uint2*)(P.ya + rowg * DM + head * 64 + d0);
          float v0 = (tot[dt][gq * 4 + 0] + o[dt][gq * 4 + 0] * sc2 + bflo(oc.x)) * siluf_(bflo(zz.x));
          float v1 = (tot[dt][gq * 4 + 1] + o[dt][gq * 4 + 1] * sc2 + bfhi(oc.x)) * siluf_(bfhi(zz.x));
          float v2 = (tot[dt][gq * 4 + 2] + o[dt][gq * 4 + 2] * sc2 + bflo(oc.y)) * siluf_(bflo(zz.y));
          float v3 = (tot[dt][gq * 4 + 3] + o[dt][gq * 4 + 3] * sc2 + bfhi(oc.y)) * siluf_(bfhi(zz.y));
          uint2 ov;
          ov.x = pk2(v0, v1); ov.y = pk2(v2, v3);
          *(uint2*)(P.ya + rowg * DM + head * 64 + d0) = ov;
        }
    }
  }
}

__global__ void __launch_bounds__(NTHREADS, 2) mega_kernel(Params P) {
  __shared__ __attribute__((aligned(16))) char smem[65536];
  cg::grid_group grid = cg::this_grid();
  const int CT = P.NB * TSEQ;
  phase0(P, smem);
  grid.sync();
  for (int chunk = 0; chunk < P.nchunk; chunk++) {
    for (int layer = 0; layer < 4; layer++) {
      const float* xs = (layer == 0 ? P.x_in : P.out) + (size_t)chunk * CT * DM;
      norm_phase(xs, P.norm_g + layer * DM, P.h, CT);
      if (layer == 0 && chunk > 0) final_norm_phase(P.out, P.final_g, (chunk - 1) * CT, CT);
      grid.sync();
      gemm1_phase(P, layer, smem);
      grid.sync();
      pb_phase(P, layer, smem);
      grid.sync();
      pc1_phase(P, smem);
      grid.sync();
      pc2_phase(P, layer, chunk, smem, (int*)(smem + 40000));
      grid.sync();
      gemm2_phase(P, layer, smem);
      grid.sync();
      gemm3_phase(P, layer, chunk, smem);
      grid.sync();
    }
  }
  final_norm_phase(P.out, P.final_g, (P.nchunk - 1) * CT, CT);
}

static inline size_t al256(size_t x) { return (x + 255) & ~(size_t)255; }

extern "C" void kernel_launch(void* const* d_in, const int* in_sizes, int n_in, void* d_out, int out_size,
                              void* d_ws, size_t ws_size, hipStream_t stream) {
  (void)in_sizes; (void)n_in; (void)out_size;
  Params P{};
  P.x_in = (const float*)d_in[0]; P.norm_g = (const float*)d_in[1]; P.w_in = (const float*)d_in[2];
  P.b_forget = (const float*)d_in[3];
  P.pe_k = (const float*)d_in[4]; P.w1_k = (const float*)d_in[5]; P.w2_k = (const float*)d_in[6];
  P.pe_v = (const float*)d_in[7]; P.w1_v = (const float*)d_in[8]; P.w2_v = (const float*)d_in[9];
  P.w_pa = (const float*)d_in[10]; P.w_pb = (const float*)d_in[11]; P.w_out = (const float*)d_in[12];
  P.final_g = (const float*)d_in[13];
  P.out = (float*)d_out;
  int NB = 16;
  char* base = (char*)d_ws;
  for (;;) {
    const size_t CT = (size_t)NB * TSEQ;
    size_t off = 0;
    auto take = [&](size_t bytes) { size_t o = off; off = al256(off + bytes); return o; };
    size_t oWin = take((size_t)4 * INCP * DM * 2), oWpa = take((size_t)4 * DM * DM * 2), oWpb = take((size_t)4 * DM * DM * 2),
           oWo = take((size_t)4 * DM * DM * 2), oW1 = take((size_t)8 * 128 * 2048 * 2), oW2 = take((size_t)8 * 64 * 128 * 2),
           oB1 = take((size_t)64 * 128 * 4), oRc = take((size_t)TSEQ * 32 * 4), oRs = take((size_t)TSEQ * 32 * 4),
           oH = take(CT * DM * 2), oProj = take(CT * INC * 2 + 4096), oVbt = take(CT * DM * 2),
           oVst = take(CT * 128 * 2), oVwt = take(CT * 128 * 2), oFl = take(CT * 16 * 4), oF2 = take(CT * 16 * 4),
           oKc = take((size_t)NB * 2 * 128 * 64 * 2), oVc = take((size_t)NB * 2 * 64 * 128 * 2), oSel = take(CT * 2 * 4),
           oYa = take(CT * DM * 2), oYb = take(CT * DM * 2), oCtr = take(256);
    if (off > ws_size && NB > 1) { NB >>= 1; continue; }
    P.WinT = (u16*)(base + oWin); P.WpaT = (u16*)(base + oWpa); P.WpbT = (u16*)(base + oWpb); P.WoT = (u16*)(base + oWo);
    P.W1T = (u16*)(base + oW1); P.W2T = (u16*)(base + oW2); P.bias1p = (float*)(base + oB1);
    P.ropec = (float*)(base + oRc); P.ropes = (float*)(base + oRs);
    P.h = (u16*)(base + oH); P.proj = (u16*)(base + oProj); P.vbt = (u16*)(base + oVbt);
    P.vst = (u16*)(base + oVst); P.vwt = (u16*)(base + oVwt); P.flog = (float*)(base + oFl); P.F2 = (float*)(base + oF2);
    P.kcmp = (u16*)(base + oKc); P.vcmpt = (u16*)(base + oVc); P.sel = (unsigned*)(base + oSel);
    P.ya = (u16*)(base + oYa); P.yb = (u16*)(base + oYb); P.ctr = (unsigned*)(base + oCtr);
    break;
  }
  P.NB = NB; P.nchunk = 32 / NB;
  static int grid_blocks = 0;
  if (!grid_blocks) {
    int dev = 0, cus = 0, per_cu = 0;
    hipGetDevice(&dev);
    hipDeviceGetAttribute(&cus, hipDeviceAttributeMultiprocessorCount, dev);
    hipOccupancyMaxActiveBlocksPerMultiprocessor(&per_cu, mega_kernel, NTHREADS, 0);
    if (per_cu > 2) per_cu = 2;
    if (per_cu < 1) per_cu = 1;
    grid_blocks = cus * per_cu;
  }
  void* args[] = {&P};
  hipError_t e = hipLaunchCooperativeKernel((void*)mega_kernel, dim3(grid_blocks), dim3(NTHREADS), args, 0, stream);
  if (e != hipSuccess) fprintf(stderr, "cooperative launch failed: %s (grid %d)\n", hipGetErrorString(e), grid_blocks);
}
```

```cpp
#include <hip/hip_runtime.h>
#include <hip/hip_cooperative_groups.h>
#include <cstdio>
namespace cg = cooperative_groups;

typedef __attribute__((ext_vector_type(8))) __bf16 bf16x8;
typedef __attribute__((ext_vector_type(16))) float f32x16;
typedef __attribute__((ext_vector_type(4))) float f32x4;
typedef unsigned short u16;

#define TSEQ 2048
#define DM 1024
#define INC 9024
#define INCP 9216
#define C_QA 0
#define C_KV 1024
#define C_GA 1792
#define C_ZA 1840
#define C_QB 2864
#define C_KB 3888
#define C_VB 4912
#define C_QR 4912
#define C_FB 5936
#define C_ZB 5952
#define C_RA 6976
#define C_RB 8000
#define NTHREADS 512
#define ATT_STAGE 16640
#define LOG2E 1.4426950408889634f

struct Params {
  const float* x_in; const float* norm_g; const float* w_in; const float* b_forget;
  const float* pe_k; const float* w1_k; const float* w2_k;
  const float* pe_v; const float* w1_v; const float* w2_v;
  const float* w_pa; const float* w_pb; const float* w_out; const float* final_g;
  float* out;
  u16* WinT; u16* WpaT; u16* WpbT; u16* WoT; u16* W1T; u16* W2T;
  float* bias1p; float* ropec; float* ropes;
  u16* h; u16* proj; u16* vbt; u16* vst; u16* vwt;
  float* flog; float* F2; u16* kcmp; u16* vcmpt; unsigned* sel;
  u16* ya; u16* yb; unsigned* ctr;
  int NB; int nchunk;
};

__device__ __forceinline__ unsigned pk2(float a, float b) {
  typedef __attribute__((ext_vector_type(2))) float f2_t;
  typedef __attribute__((ext_vector_type(2))) __bf16 b2_t;
  f2_t v = {a, b};
  b2_t r = __builtin_convertvector(v, b2_t);
  return __builtin_bit_cast(unsigned, r);
}
__device__ __forceinline__ u16 f2bf(float a) { return (u16)(pk2(a, 0.f) & 0xffffu); }
__device__ __forceinline__ float bf2f(u16 u) { return __uint_as_float(((unsigned)u) << 16); }
__device__ __forceinline__ float bflo(unsigned u) { return __uint_as_float(u << 16); }
__device__ __forceinline__ float bfhi(unsigned u) { return __uint_as_float(u & 0xffff0000u); }
__device__ __forceinline__ float sigmoidf_(float x) { return 1.f / (1.f + __expf(-x)); }
__device__ __forceinline__ float siluf_(float x) { return x / (1.f + __expf(-x)); }
__device__ __forceinline__ f32x16 mfma32(bf16x8 a, bf16x8 b, f32x16 c) {
  return __builtin_amdgcn_mfma_f32_32x32x16_bf16(a, b, c, 0, 0, 0);
}
__device__ __forceinline__ int opaque_tid() { int t = threadIdx.x; asm volatile("" : "+v"(t)); return t; }
__device__ __forceinline__ bf16x8 ldfrag(const void* p) {
  return __builtin_bit_cast(bf16x8, *(const uint4*)p);
}

__device__ void transpose_tile(const float* __restrict__ src, u16* __restrict__ dst, int K, int N,
                               int k0, int n0, float* tile, const int tid) {
#pragma unroll
  for (int j = 0; j < 2; j++) {
    int r = (tid >> 4) + 32 * j, c4 = (tid & 15) * 4;
    float4 v = *(const float4*)(src + (size_t)(k0 + r) * N + n0 + c4);
    tile[r * 65 + c4] = v.x; tile[r * 65 + c4 + 1] = v.y; tile[r * 65 + c4 + 2] = v.z; tile[r * 65 + c4 + 3] = v.w;
  }
  __syncthreads();
  {
    int c = tid, n = c >> 3, kc = c & 7;
    const float* tp = tile + (kc * 8) * 65 + n;
    uint4 o;
    o.x = pk2(tp[0], tp[65]); o.y = pk2(tp[130], tp[195]); o.z = pk2(tp[260], tp[325]); o.w = pk2(tp[390], tp[455]);
    *(uint4*)(dst + (size_t)(n0 + n) * K + k0 + kc * 8) = o;
  }
  __syncthreads();
}

__device__ void phase0(const Params& P, char* smem) {
  const int tid = opaque_tid();
  float* tile = (float*)smem;
  const int n0_ = 4 * 16 * 141, n1_ = 4 * 16 * 16, n2_ = 4 * 32 * 2, n3_ = 4 * 2 * 1;
  const int nT = n0_ + 3 * n1_ + 2 * n2_ + 2 * n3_;
  const int nBias = 64, nRope = 128;
  const int total = nT + nBias + nRope + 1;
  for (int it = blockIdx.x; it < total; it += gridDim.x) {
    if (it < nT) {
      int t = it;
      if (t < n0_) {
        int l = t / (16 * 141), rem = t % (16 * 141);
        transpose_tile(P.w_in + (size_t)l * DM * INC, P.WinT + (size_t)l * INCP * DM, DM, INC, (rem / 141) * 64, (rem % 141) * 64, tile, tid);
        continue;
      }
      t -= n0_;
      if (t < 3 * n1_) {
        int which = t / n1_; t %= n1_;
        int l = t / 256, rem = t % 256;
        const float* s = which == 0 ? P.w_pa : (which == 1 ? P.w_pb : P.w_out);
        u16* d = which == 0 ? P.WpaT : (which == 1 ? P.WpbT : P.WoT);
        transpose_tile(s + (size_t)l * DM * DM, d + (size_t)l * DM * DM, DM, DM, (rem >> 4) * 64, (rem & 15) * 64, tile, tid);
        continue;
      }
      t -= 3 * n1_;
      if (t < 2 * n2_) {
        int kv = t / n2_; t %= n2_;
        int l = t / 64, rem = t % 64;
        const float* s = kv ? P.w1_v : P.w1_k;
        transpose_tile(s + (size_t)l * 2048 * 128, P.W1T + (size_t)(l * 2 + kv) * 128 * 2048, 2048, 128, (rem >> 1) * 64, (rem & 1) * 64, tile, tid);
        continue;
      }
      t -= 2 * n2_;
      {
        int kv = t / n3_; t %= n3_;
        int l = t / 2, rem = t % 2;
        const float* s = kv ? P.w2_v : P.w2_k;
        transpose_tile(s + (size_t)l * 128 * 64, P.W2T + (size_t)(l * 2 + kv) * 64 * 128, 128, 64, rem * 64, 0, tile, tid);
      }
    } else if (it < nT + nBias) {
      int j = it - nT;
      int l = j >> 4, kv = (j >> 3) & 1, kq = j & 7;
      const float* pe = (kv ? P.pe_v : P.pe_k) + (size_t)l * 2048;
      const float* w1 = (kv ? P.w1_v : P.w1_k) + (size_t)l * 2048 * 128;
      int hid = tid & 127, kh = tid >> 7;
      int kbeg = kq * 256 + kh * 64;
      float s = 0.f;
#pragma unroll 8
      for (int k = 0; k < 64; k++) s += pe[kbeg + k] * w1[(size_t)(kbeg + k) * 128 + hid];
      float* part = (float*)smem;
      part[tid] = s;
      __syncthreads();
      if (tid < 128) P.bias1p[((l * 2 + kv) * 8 + kq) * 128 + hid] = (part[tid] + part[tid + 128]) + (part[tid + 256] + part[tid + 384]);
      __syncthreads();
    } else if (it < nT + nBias + nRope) {
      int idx = (it - nT - nBias) * 512 + tid;
      int t = idx >> 5, j = idx & 31;
      double inv = 1.0;
      for (int q = 0; q < j; q++) inv *= 0.7498942093324558;
      float invf = (float)inv;
      float angf = (float)t * invf;
      double a = (double)angf;
      double kq = rint(a * 0.15915494309189535);
      double rr = a - kq * 6.283185307179586;
      double r2 = rr * rr;
      double sterm = rr, cterm = 1.0, ssum = rr, csum = 1.0;
#pragma unroll 1
      for (int n = 1; n <= 15; n++) {
        cterm *= -r2 / (double)((2 * n - 1) * (2 * n));
        sterm *= -r2 / (double)((2 * n) * (2 * n + 1));
        csum += cterm; ssum += sterm;
      }
      P.ropec[idx] = (float)csum;
      P.ropes[idx] = (float)ssum;
    } else {
      if (tid < 64) P.ctr[tid] = 0u;
    }
  }
}

__device__ void norm_phase(const float* __restrict__ xsrc, const float* __restrict__ g, u16* __restrict__ hdst, int nrows) {
  const int tid = opaque_tid();
  const int lane = tid & 63;
  const int gw = blockIdx.x * 8 + (tid >> 6), nw = gridDim.x * 8;
  float4 gv[4];
#pragma unroll
  for (int j = 0; j < 4; j++) gv[j] = *(const float4*)(g + lane * 4 + 256 * j);
  for (int row = gw; row < nrows; row += nw) {
    const float* xr = xsrc + (size_t)row * DM;
    float4 v[4];
    float ss = 0.f;
#pragma unroll
    for (int j = 0; j < 4; j++) {
      v[j] = *(const float4*)(xr + lane * 4 + 256 * j);
      ss += v[j].x * v[j].x + v[j].y * v[j].y + v[j].z * v[j].z + v[j].w * v[j].w;
    }
#pragma unroll
    for (int o = 32; o >= 1; o >>= 1) ss += __shfl_xor(ss, o);
    float rstd = rsqrtf(ss * (1.f / DM) + 1e-6f);
#pragma unroll
    for (int j = 0; j < 4; j++) {
      uint2 o;
      o.x = pk2(v[j].x * rstd * gv[j].x, v[j].y * rstd * gv[j].y);
      o.y = pk2(v[j].z * rstd * gv[j].z, v[j].w * rstd * gv[j].w);
      *(uint2*)(hdst + (size_t)row * DM + lane * 4 + 256 * j) = o;
    }
  }
}

__device__ void final_norm_phase(float* __restrict__ x, const float* __restrict__ g, int row0, int nrows) {
  const int tid = opaque_tid();
  const int lane = tid & 63;
  const int gw = blockIdx.x * 8 + (tid >> 6), nw = gridDim.x * 8;
  float4 gv[4];
#pragma unroll
  for (int j = 0; j < 4; j++) gv[j] = *(const float4*)(g + lane * 4 + 256 * j);
  for (int row = gw; row < nrows; row += nw) {
    float* xr = x + (size_t)(row0 + row) * DM;
    float4 v[4];
    float ss = 0.f;
#pragma unroll
    for (int j = 0; j < 4; j++) {
      v[j] = *(const float4*)(xr + lane * 4 + 256 * j);
      ss += v[j].x * v[j].x + v[j].y * v[j].y + v[j].z * v[j].z + v[j].w * v[j].w;
    }
#pragma unroll
    for (int o = 32; o >= 1; o >>= 1) ss += __shfl_xor(ss, o);
    float rstd = rsqrtf(ss * (1.f / DM) + 1e-6f);
#pragma unroll
    for (int j = 0; j < 4; j++) {
      float4 o;
      o.x = v[j].x * rstd * gv[j].x; o.y = v[j].y * rstd * gv[j].y;
      o.z = v[j].z * rstd * gv[j].z; o.w = v[j].w * rstd * gv[j].w;
      *(float4*)(xr + lane * 4 + 256 * j) = o;
    }
  }
}

struct ARow {
  const u16* p; int ld;
  __device__ __forceinline__ const u16* operator()(int row, int k) const { return p + (size_t)row * ld + k; }
};
struct ACmp {
  const u16* p;
  __device__ __forceinline__ const u16* operator()(int row, int k) const {
    int t = 16 * row + (k >> 6); t = t > (TSEQ - 1) ? (TSEQ - 1) : t;
    return p + (size_t)t * INC + (k & 63);
  }
};

template <class AF>
__device__ __forceinline__ void gemm_mainloop(AF af, const u16* __restrict__ Bt, int ldb, int K, char* smem,
                                              f32x16 (&acc)[2][2], const int tid) {
  const int lane = tid & 63, r = lane & 31, h = lane >> 5, w = tid >> 6;
  const int wm = w >> 1, wn = w & 1;
  const int lrow = tid >> 3, lch = tid & 7;
  uint4 ra[4], rb[4];
  const int nk = K >> 6;
#pragma unroll
  for (int j = 0; j < 4; j++) {
    int row = lrow + 32 * j;
    ra[j] = *(const uint4*)af(row, lch * 8);
    rb[j] = *(const uint4*)(Bt + (size_t)row * ldb + lch * 8);
  }
#pragma unroll
  for (int j = 0; j < 4; j++) {
    int row = lrow + 32 * j;
    int off = row * 128 + ((lch ^ ((row >> 1) & 7)) << 4);
    *(uint4*)(smem + off) = ra[j];
    *(uint4*)(smem + 16384 + off) = rb[j];
  }
  __syncthreads();
  for (int it = 0; it < nk; it++) {
    const bool more = (it + 1) < nk;
    if (more) {
      const int k0 = (it + 1) * 64;
#pragma unroll
      for (int j = 0; j < 4; j++) {
        int row = lrow + 32 * j;
        ra[j] = *(const uint4*)af(row, k0 + lch * 8);
        rb[j] = *(const uint4*)(Bt + (size_t)row * ldb + k0 + lch * 8);
      }
    }
    const char* sa = smem + (it & 1) * 32768;
    const char* sb = sa + 16384;
#pragma unroll
    for (int kk = 0; kk < 4; kk++) {
      bf16x8 a[2], b[2];
#pragma unroll
      for (int mi = 0; mi < 2; mi++) {
        int row = wm * 64 + mi * 32 + r;
        a[mi] = ldfrag(sa + row * 128 + (((kk * 2 + h) ^ ((row >> 1) & 7)) << 4));
      }
#pragma unroll
      for (int ni = 0; ni < 2; ni++) {
        int row = wn * 64 + ni * 32 + r;
        b[ni] = ldfrag(sb + row * 128 + (((kk * 2 + h) ^ ((row >> 1) & 7)) << 4));
      }
#pragma unroll
      for (int mi = 0; mi < 2; mi++)
#pragma unroll
        for (int ni = 0; ni < 2; ni++) acc[mi][ni] = mfma32(a[mi], b[ni], acc[mi][ni]);
    }
    if (more) {
      char* sd = smem + ((it + 1) & 1) * 32768;
#pragma unroll
      for (int j = 0; j < 4; j++) {
        int row = lrow + 32 * j;
        int off = row * 128 + ((lch ^ ((row >> 1) & 7)) << 4);
        *(uint4*)(sd + off) = ra[j];
        *(uint4*)(sd + 16384 + off) = rb[j];
      }
    }
    __syncthreads();
  }
}

__device__ __forceinline__ void zero_acc(f32x16 (&acc)[2][2]) {
#pragma unroll
  for (int a = 0; a < 2; a++)
#pragma unroll
    for (int b = 0; b < 2; b++)
#pragma unroll
      for (int i = 0; i < 16; i++) acc[a][b][i] = 0.f;
}

typedef __attribute__((ext_vector_type(8))) short s16x8;
#define G_TILE_B 32768
#define G_STAGE_B 65536
__device__ __forceinline__ int g_lds_byte(int r, int c) {
  int st = (r >> 4) * 2 + (c >> 5), ob = (r & 15) * 64 + (c & 31) * 2;
  return st * 1024 + (ob ^ (((ob >> 9) & 1) << 5));
}
__device__ __forceinline__ void g_stage_rc(int b, int& R, int& C) {
  int st = b >> 10, sb = b & 1023, swz = sb ^ (((sb >> 9) & 1) << 5);
  R = (st >> 1) * 16 + swz / 64;
  C = (st & 1) * 32 + (swz % 64) / 2;
}
#define G_WAIT_V0() asm volatile("s_waitcnt vmcnt(0)" ::: "memory")

struct GTile { int pm, pn; };
__device__ __forceinline__ bool g_next(int i, int G, int c, int nM, int nN, GTile& u) {
  const int nwg = nM * nN;
  const long L = (long)i * G + c;
  if (L >= nwg) return false;
  int wgid = (int)L;
  { const int q = nwg / 8, r = nwg % 8, xcd = wgid % 8, off = wgid / 8; wgid = (xcd < r ? xcd * (q + 1) : r * (q + 1) + (xcd - r) * q) + off; }
  const int nig = 8 * nN, gid = wgid / nig, fm = gid * 8, gsz = (nM - fm) < 8 ? (nM - fm) : 8;
  u.pm = fm + ((wgid % nig) % gsz);
  u.pn = (wgid % nig) / gsz;
  return true;
}

__device__ __forceinline__ void g_kloop(const u16* __restrict__ Ab, const u16* __restrict__ Bb, const int K, char* smem,
                                        f32x4 (&acc)[8][4], const int tid) {
  const int wid = tid >> 6, lane = tid & 63, wr = wid >> 2, wc = wid & 3, fr = lane & 15, fq = lane >> 4;
  int sR0, sC0, sR1, sC1, sR2, sC2, sR3, sC3;
  g_stage_rc(wid * 1024 + 0 * 8192 + lane * 16, sR0, sC0);
  g_stage_rc(wid * 1024 + 1 * 8192 + lane * 16, sR1, sC1);
  g_stage_rc(wid * 1024 + 2 * 8192 + lane * 16, sR2, sC2);
  g_stage_rc(wid * 1024 + 3 * 8192 + lane * 16, sR3, sC3);
  const long o0 = (long)sR0 * K + sC0, o1 = (long)sR1 * K + sC1, o2 = (long)sR2 * K + sC2, o3 = (long)sR3 * K + sC3;
#define G_STAGE(buf, kt)                                                                                              \
  {                                                                                                                  \
    char* sa_ = smem + (buf) * G_STAGE_B + wid * 1024;                                                               \
    char* sb_ = sa_ + G_TILE_B;                                                                                      \
    const u16* ga_ = Ab + (kt) * 64;                                                                                 \
    const u16* gb_ = Bb + (kt) * 64;                                                                                 \
    __builtin_amdgcn_global_load_lds((const unsigned*)(ga_ + o0), (unsigned*)(sa_), 16, 0, 0);                       \
    __builtin_amdgcn_global_load_lds((const unsigned*)(gb_ + o0), (unsigned*)(sb_), 16, 0, 0);                       \
    __builtin_amdgcn_global_load_lds((const unsigned*)(ga_ + o1), (unsigned*)(sa_ + 8192), 16, 0, 0);                \
    __builtin_amdgcn_global_load_lds((const unsigned*)(gb_ + o1), (unsigned*)(sb_ + 8192), 16, 0, 0);                \
    __builtin_amdgcn_global_load_lds((const unsigned*)(ga_ + o2), (unsigned*)(sa_ + 16384), 16, 0, 0);               \
    __builtin_amdgcn_global_load_lds((const unsigned*)(gb_ + o2), (unsigned*)(sb_ + 16384), 16, 0, 0);               \
    __builtin_amdgcn_global_load_lds((const unsigned*)(ga_ + o3), (unsigned*)(sa_ + 24576), 16, 0, 0);               \
    __builtin_amdgcn_global_load_lds((const unsigned*)(gb_ + o3), (unsigned*)(sb_ + 24576), 16, 0, 0);               \
  }
  const int nt = K >> 6;
  G_STAGE(0, 0);
  G_WAIT_V0();
  __syncthreads();
  for (int t = 0; t < nt; ++t) {
    const int cur = t & 1;
    if (t + 1 < nt) G_STAGE(cur ^ 1, t + 1);
    const char* sa = smem + cur * G_STAGE_B;
    const char* sb = sa + G_TILE_B;
#pragma unroll
    for (int ks = 0; ks < 2; ++ks) {
      s16x8 At[8], Bf[4];
#pragma unroll
      for (int m = 0; m < 8; ++m) At[m] = *(const s16x8*)(sa + g_lds_byte(wr * 128 + m * 16 + fr, ks * 32 + fq * 8));
#pragma unroll
      for (int n = 0; n < 4; ++n) Bf[n] = *(const s16x8*)(sb + g_lds_byte(wc * 64 + n * 16 + fr, ks * 32 + fq * 8));
#pragma unroll
      for (int m = 0; m < 8; ++m)
#pragma unroll
        for (int n = 0; n < 4; ++n)
          acc[m][n] = __builtin_amdgcn_mfma_f32_16x16x32_bf16(__builtin_bit_cast(bf16x8, Bf[n]), __builtin_bit_cast(bf16x8, At[m]), acc[m][n], 0, 0, 0);
      __builtin_amdgcn_sched_barrier(0);
    }
    G_WAIT_V0();
    __syncthreads();
  }
}

__device__ __forceinline__ void g_zero(f32x4 (&acc)[8][4]) {
#pragma unroll
  for (int m = 0; m < 8; m++)
#pragma unroll
    for (int n = 0; n < 4; n++) acc[m][n] = (f32x4){0.f, 0.f, 0.f, 0.f};
}
__device__ __forceinline__ uint2 pk4(f32x4 v) { return make_uint2(pk2(v[0], v[1]), pk2(v[2], v[3])); }

__device__ void gemm1_phase(const Params& P, int layer, char* smem) {
  const int CT = P.NB * TSEQ;
  const int nM = CT >> 8, nN = INCP >> 8;
  const u16* Bt = P.WinT + (size_t)layer * INCP * DM;
  u16* p_vbt = P.vbt; u16* p_vst = P.vst; u16* p_vwt = P.vwt;
  asm volatile("" : "+s"(p_vbt), "+s"(p_vst), "+s"(p_vwt));
  for (int i = 0;; i++) {
    GTile u;
    if (!g_next(i, gridDim.x, blockIdx.x, nM, nN, u)) break;
    const int tid = opaque_tid(), wid = tid >> 6, lane = tid & 63, wr = wid >> 2, wc = wid & 3, fr = lane & 15, fq = lane >> 4;
    f32x4 acc[8][4];
    g_zero(acc);
    g_kloop(P.h + (size_t)(u.pm * 256) * DM, Bt + (size_t)(u.pn * 256) * DM, DM, smem, acc, tid);
    const int cw = u.pn * 256 + wc * 64;
    const int row0 = u.pm * 256 + wr * 128 + fr;
    if (cw >= INC) continue;
    const bool rope_q = cw < 1024;
    const bool rope_k = (cw >= C_KV + 256 && cw < C_KV + 384) || (cw >= C_KV + 512 && cw < C_KV + 640);
    if (rope_q || rope_k) {
#pragma unroll
      for (int m = 0; m < 8; m++) {
        const int row = row0 + m * 16;
        const int tt = row & (TSEQ - 1);
        u16* pr = P.proj + (size_t)row * INC + cw + fq * 4;
#pragma unroll
        for (int n = 0; n < 2; n++) {
          const float4 c = *(const float4*)(P.ropec + tt * 32 + n * 16 + fq * 4);
          const float4 sn = *(const float4*)(P.ropes + tt * 32 + n * 16 + fq * 4);
          const f32x4 x1 = acc[m][n], x2 = acc[m][n + 2];
          f32x4 r1, r2;
          r1[0] = x1[0] * c.x - x2[0] * sn.x; r2[0] = x2[0] * c.x + x1[0] * sn.x;
          r1[1] = x1[1] * c.y - x2[1] * sn.y; r2[1] = x2[1] * c.y + x1[1] * sn.y;
          r1[2] = x1[2] * c.z - x2[2] * sn.z; r2[2] = x2[2] * c.z + x1[2] * sn.z;
          r1[3] = x1[3] * c.w - x2[3] * sn.w; r2[3] = x2[3] * c.w + x1[3] * sn.w;
          if (rope_q) {
            *(uint2*)(pr + n * 16) = pk4(x1);
            *(uint2*)(pr + n * 16 + 32) = pk4(x2);
            *(uint2*)(pr + C_QR + n * 16) = pk4(r1);
            *(uint2*)(pr + C_QR + n * 16 + 32) = pk4(r2);
          } else {
            *(uint2*)(pr + n * 16) = pk4(r1);
            *(uint2*)(pr + n * 16 + 32) = pk4(r2);
          }
        }
        __builtin_amdgcn_sched_barrier(0);
      }
    } else {
#pragma unroll
      for (int n = 0; n < 4; n++) {
        const int c0 = cw + n * 16 + fq * 4;
        int kind = 0;
        u16* vt = p_vbt;
        int vcol = 0, nh = 16;
        if (c0 >= C_VB && c0 < C_FB) { kind = 1; vcol = c0 - C_VB; }
        else if (c0 >= C_FB && c0 < C_ZB) kind = 2;
        else if (c0 >= C_KV + 384 && c0 < C_KV + 512) { kind = 1; vcol = c0 - (C_KV + 384); vt = p_vst; nh = 2; }
        else if (c0 >= C_KV + 640 && c0 < C_KV + 768) { kind = 1; vcol = c0 - (C_KV + 640); vt = p_vwt; nh = 2; }
        if (kind == 0) {
#pragma unroll
          for (int m = 0; m < 8; m++) *(uint2*)(P.proj + (size_t)(row0 + m * 16) * INC + c0) = pk4(acc[m][n]);
        } else if (kind == 1) {
#pragma unroll
          for (int m = 0; m < 8; m++) {
            const int row = row0 + m * 16;
            const int bl = row >> 11, tt = row & (TSEQ - 1);
            u16* vp = vt + ((size_t)(bl * nh + (vcol >> 6)) * 64 + (vcol & 63)) * TSEQ + tt;
            vp[0] = f2bf(acc[m][n][0]); vp[TSEQ] = f2bf(acc[m][n][1]);
            vp[2 * TSEQ] = f2bf(acc[m][n][2]); vp[3 * TSEQ] = f2bf(acc[m][n][3]);
          }
        } else {
#pragma unroll
          for (int m = 0; m < 8; m++)
            *(float4*)(P.flog + (size_t)(row0 + m * 16) * 16 + (c0 - C_FB)) = make_float4(acc[m][n][0], acc[m][n][1], acc[m][n][2], acc[m][n][3]);
        }
        __builtin_amdgcn_sched_barrier(0);
      }
    }
  }
}

__device__ void gemm2_phase(const Params& P, int layer, char* smem) {
  const int CT = P.NB * TSEQ;
  const int nM = CT >> 8, nN = 4;
  const u16* p_ya = P.ya; const u16* p_yb = P.yb; const u16* p_wa = P.WpaT; const u16* p_wb = P.WpbT;
  for (int i = 0;; i++) {
    GTile u;
    if (!g_next(i, gridDim.x, blockIdx.x, nM, nN, u)) break;
    const int tid = opaque_tid(), wid = tid >> 6, lane = tid & 63, wr = wid >> 2, wc = wid & 3, fr = lane & 15, fq = lane >> 4;
    f32x4 acc[8][4];
    g_zero(acc);
#pragma unroll 1
    for (int pass = 0; pass < 2; pass++) {
      const u16* Ap = (pass ? p_yb : p_ya) + (size_t)(u.pm * 256) * DM;
      const u16* Bp = (pass ? p_wb : p_wa) + (size_t)layer * DM * DM + (size_t)(u.pn * 256) * DM;
      g_kloop(Ap, Bp, DM, smem, acc, tid);
      __builtin_amdgcn_sched_barrier(0);
      if (pass == 0) {
        const int tid1 = opaque_tid(), wid1 = tid1 >> 6, lane1 = tid1 & 63, wr1 = wid1 >> 2, wc1 = wid1 & 3, fr1 = lane1 & 15, fq1 = lane1 >> 4;
        const u16* pp = P.proj + (size_t)(u.pm * 256 + wr1 * 128 + fr1) * INC + u.pn * 256 + wc1 * 64 + fq1 * 4;
#pragma unroll
        for (int m = 0; m < 8; m++) {
#pragma unroll
          for (int n = 0; n < 4; n++) {
            const uint2 ra = *(const uint2*)(pp + (size_t)(m * 16) * INC + C_RA + n * 16);
            const uint2 rb = *(const uint2*)(pp + (size_t)(m * 16) * INC + C_RB + n * 16);
            acc[m][n][0] *= (1.f + __expf(-bflo(rb.x))) / (1.f + __expf(-bflo(ra.x)));
            acc[m][n][1] *= (1.f + __expf(-bfhi(rb.x))) / (1.f + __expf(-bfhi(ra.x)));
            acc[m][n][2] *= (1.f + __expf(-bflo(rb.y))) / (1.f + __expf(-bflo(ra.y)));
            acc[m][n][3] *= (1.f + __expf(-bfhi(rb.y))) / (1.f + __expf(-bfhi(ra.y)));
          }
          __builtin_amdgcn_sched_barrier(0);
        }
      }
    }
    {
      const int tid2 = opaque_tid(), wid2 = tid2 >> 6, lane2 = tid2 & 63, wr2 = wid2 >> 2, wc2 = wid2 & 3, fr2 = lane2 & 15, fq2 = lane2 >> 4;
      const u16* pp = P.proj + (size_t)(u.pm * 256 + wr2 * 128 + fr2) * INC + u.pn * 256 + wc2 * 64 + fq2 * 4;
      u16* hp = P.h + (size_t)(u.pm * 256 + wr2 * 128 + fr2) * DM + u.pn * 256 + wc2 * 64 + fq2 * 4;
#pragma unroll
      for (int m = 0; m < 8; m++) {
#pragma unroll
        for (int n = 0; n < 4; n++) {
          const uint2 rb = *(const uint2*)(pp + (size_t)(m * 16) * INC + C_RB + n * 16);
          f32x4 v = acc[m][n];
          v[0] *= sigmoidf_(bflo(rb.x)); v[1] *= sigmoidf_(bfhi(rb.x));
          v[2] *= sigmoidf_(bflo(rb.y)); v[3] *= sigmoidf_(bfhi(rb.y));
          *(uint2*)(hp + (size_t)(m * 16) * DM + n * 16) = pk4(v);
        }
        __builtin_amdgcn_sched_barrier(0);
      }
    }
  }
}

__device__ void gemm3_phase(const Params& P, int layer, int chunk, char* smem) {
  const int CT = P.NB * TSEQ;
  const int nM = CT >> 8, nN = 4;
  const float* xs = (layer == 0 ? P.x_in : P.out) + (size_t)chunk * CT * DM;
  float* xd = P.out + (size_t)chunk * CT * DM;
  for (int i = 0;; i++) {
    GTile u;
    if (!g_next(i, gridDim.x, blockIdx.x, nM, nN, u)) break;
    const int tid = opaque_tid(), wid = tid >> 6, lane = tid & 63, wr = wid >> 2, wc = wid & 3, fr = lane & 15, fq = lane >> 4;
    f32x4 acc[8][4];
    g_zero(acc);
    g_kloop(P.h + (size_t)(u.pm * 256) * DM, P.WoT + (size_t)layer * DM * DM + (size_t)(u.pn * 256) * DM, DM, smem, acc, tid);
    const size_t off = (size_t)(u.pm * 256 + wr * 128 + fr) * DM + u.pn * 256 + wc * 64 + fq * 4;
#pragma unroll
    for (int m = 0; m < 8; m++) {
#pragma unroll
      for (int n = 0; n < 4; n++) {
        const float4 xo = *(const float4*)(xs + off + (size_t)(m * 16) * DM + n * 16);
        *(float4*)(xd + off + (size_t)(m * 16) * DM + n * 16) =
            make_float4(xo.x + acc[m][n][0], xo.y + acc[m][n][1], xo.z + acc[m][n][2], xo.w + acc[m][n][3]);
      }
      __builtin_amdgcn_sched_barrier(0);
    }
  }
}

__device__ void pb_phase(const Params& P, int layer, char* smem_all) {
  const int tid_all = opaque_tid();
  const int half = tid_all >> 8, tid = tid_all & 255;
  char* smem = smem_all + half * 65536;
  const int lane = tid & 63, r = lane & 31, h = lane >> 5, w = tid >> 6;
  const int wm = w >> 1, wn = w & 1;
  const int nCmp = P.NB * 2;
  const int nScan = P.NB * 2;
  for (int it = blockIdx.x; it < nCmp + nScan; it += gridDim.x) {
    if (it < nCmp) {
      const int unit = it * 2 + half;
      const int bl = unit >> 2, g = (unit >> 1) & 1, kv = unit & 1;
      f32x16 acc[2][2];
      zero_acc(acc);
      ACmp af{P.proj + (size_t)bl * TSEQ * INC + C_KV + kv * 128 + g * 64};
      gemm_mainloop(af, P.W1T + (size_t)(layer * 2 + kv) * 128 * 2048, 2048, 2048, smem, acc, tid);
      const float* bp = P.bias1p + (size_t)((layer * 2 + kv) * 8) * 128;
#pragma unroll
      for (int ni = 0; ni < 2; ni++) {
        int hc = wn * 64 + ni * 32 + r;
        float b1 = 0.f;
#pragma unroll
        for (int q = 0; q < 8; q++) b1 += bp[q * 128 + hc];
#pragma unroll
        for (int mi = 0; mi < 2; mi++)
#pragma unroll
          for (int i = 0; i < 16; i++) {
            int n = wm * 64 + mi * 32 + 8 * (i >> 2) + 4 * h + (i & 3);
            float v = siluf_(acc[mi][ni][i] + b1);
            *(u16*)(smem + n * 256 + (((hc >> 3) ^ (n & 15)) << 4) + (hc & 7) * 2) = f2bf(v);
          }
      }
      __syncthreads();
      const u16* w2t = P.W2T + (size_t)(layer * 2 + kv) * 64 * 128;
      f32x16 o2[2];
#pragma unroll
      for (int dt = 0; dt < 2; dt++)
#pragma unroll
        for (int i = 0; i < 16; i++) o2[dt][i] = 0.f;
#pragma unroll
      for (int kk = 0; kk < 8; kk++) {
        int n = w * 32 + r;
        bf16x8 a = ldfrag(smem + n * 256 + (((kk * 2 + h) ^ (n & 15)) << 4));
#pragma unroll
        for (int dt = 0; dt < 2; dt++) {
          bf16x8 b = ldfrag(w2t + (size_t)(dt * 32 + r) * 128 + kk * 16 + h * 8);
          o2[dt] = mfma32(a, b, o2[dt]);
        }
      }
#pragma unroll
      for (int dt = 0; dt < 2; dt++) {
        int d = dt * 32 + r;
        if (kv == 0) {
#pragma unroll
          for (int i = 0; i < 16; i++) {
            int n = w * 32 + 8 * (i >> 2) + 4 * h + (i & 3);
            P.kcmp[((size_t)(bl * 2 + g) * 128 + n) * 64 + d] = f2bf(o2[dt][i]);
          }
        } else {
#pragma unroll
          for (int gq = 0; gq < 4; gq++) {
            int n0 = w * 32 + 8 * gq + 4 * h;
            uint2 o;
            o.x = pk2(o2[dt][gq * 4 + 0], o2[dt][gq * 4 + 1]);
            o.y = pk2(o2[dt][gq * 4 + 2], o2[dt][gq * 4 + 3]);
            *(uint2*)(P.vcmpt + ((size_t)(bl * 2 + g) * 64 + d) * 128 + n0) = o;
          }
        }
      }
      __syncthreads();
    } else {
      const int sidx = (it - nCmp) * 8 + (tid_all >> 6);
      const int bl = sidx >> 4, hh = sidx & 15;
      const float bf = P.b_forget[layer * 16 + hh];
      const float* fl = P.flog + ((size_t)bl * TSEQ + lane * 32) * 16 + hh;
      float loc = 0.f;
#pragma unroll 8
      for (int j = 0; j < 32; j++) {
        float x = fl[j * 16] + bf;
        float ls = (x >= 0.f) ? -log1pf(__expf(-x)) : (x - log1pf(__expf(x)));
        loc += ls;
      }
      float incl = loc;
#pragma unroll
      for (int o = 1; o < 64; o <<= 1) {
        float v = __shfl_up(incl, o);
        if (lane >= o) incl += v;
      }
      float run = incl - loc;
      float* fo = P.F2 + ((size_t)bl * 16 + hh) * TSEQ + lane * 32;
#pragma unroll 8
      for (int j = 0; j < 32; j++) {
        float x = fl[j * 16] + bf;
        float ls = (x >= 0.f) ? -log1pf(__expf(-x)) : (x - log1pf(__expf(x)));
        run += ls;
        fo[j] = run * LOG2E;
      }
    }
  }
}

__device__ void pc1_phase(const Params& P, char* smem) {
  const int tid = opaque_tid(),  lane = tid & 63, r = lane & 31, h = lane >> 5, w = tid >> 6;
  const int nItems = P.NB * 2 * 8;
  const float c1 = 0.125f * LOG2E;
  for (int it = blockIdx.x; it < nItems; it += gridDim.x) {
    const int qt = it & 7, g = (it >> 3) & 1, bl = it >> 4;
    __syncthreads();
#pragma unroll
    for (int j = 0; j < 2; j++) {
      int c = tid + 512 * j;
      {
        int n = c >> 3, ch = c & 7;
        uint4 v = *(const uint4*)(P.kcmp + ((size_t)(bl * 2 + g) * 128 + n) * 64 + ch * 8);
        *(uint4*)(smem + n * 128 + ((ch ^ ((n >> 1) & 7)) << 4)) = v;
      }
      {
        int d = c >> 4, ch = c & 15;
        uint4 v = *(const uint4*)(P.vcmpt + ((size_t)(bl * 2 + g) * 64 + d) * 128 + ch * 8);
        int sw = d & 31;
        *(uint2*)(smem + 16384 + d * 256 + (((2 * ch) ^ sw) << 3)) = make_uint2(v.x, v.y);
        *(uint2*)(smem + 16384 + d * 256 + (((2 * ch + 1) ^ sw) << 3)) = make_uint2(v.z, v.w);
      }
    }
    __syncthreads();
    const int qw_lo = qt * 256 + w * 32;
    const int qtok = qw_lo + r;
    const size_t rowg = (size_t)bl * TSEQ + qtok;
    const int tq = qtok - 31 - 64 * h;
    float sumacc[16], lastacc[16];
#pragma unroll
    for (int s = 0; s < 16; s++) { sumacc[s] = 0.f; lastacc[s] = 0.f; }
#pragma unroll 1
    for (int hh = 0; hh < 8; hh++) {
      const int head = g * 8 + hh;
      bf16x8 qf[4];
#pragma unroll
      for (int kk = 0; kk < 4; kk++) qf[kk] = ldfrag(P.proj + rowg * INC + C_QA + head * 64 + kk * 16 + h * 8);
      f32x16 s[4];
#pragma unroll
      for (int nt = 0; nt < 4; nt++) {
#pragma unroll
        for (int i = 0; i < 16; i++) s[nt][i] = 0.f;
#pragma unroll
        for (int kk = 0; kk < 4; kk++) {
          int row = nt * 32 + r;
          bf16x8 a = ldfrag(smem + row * 128 + (((kk * 2 + h) ^ ((row >> 1) & 7)) << 4));
          s[nt] = mfma32(a, qf[kk], s[nt]);
        }
        __builtin_amdgcn_sched_barrier(0);
      }
      float mx = -3.0e38f;
#pragma unroll
      for (int nt = 0; nt < 4; nt++)
#pragma unroll
        for (int i = 0; i < 16; i++) {
          bool ok = (16 * (nt * 32 + 8 * (i >> 2) + (i & 3))) <= tq;
          float v = ok ? s[nt][i] * c1 : -3.0e38f;
          s[nt][i] = v;
          mx = fmaxf(mx, v);
        }
      mx = fmaxf(mx, __shfl_xor(mx, 32));
      const bool anyv = mx > -1.0e37f;
      float mref = anyv ? mx : 0.f;
      float l = 0.f;
#pragma unroll
      for (int nt = 0; nt < 4; nt++)
#pragma unroll
        for (int i = 0; i < 16; i++) {
          float p = __builtin_amdgcn_exp2f(s[nt][i] - mref);
          s[nt][i] = p;
          l += p;
        }
      l += __shfl_xor(l, 32);
      const float inv = (anyv && l > 0.f) ? 1.f / l : 0.f;
#pragma unroll
      for (int nt = 0; nt < 4; nt++)
#pragma unroll
        for (int i = 0; i < 16; i++) s[nt][i] *= inv;
#pragma unroll
      for (int nt = 0; nt < 4; nt++)
#pragma unroll
        for (int gq = 0; gq < 4; gq++) {
          sumacc[nt * 4 + gq] += (s[nt][gq * 4] + s[nt][gq * 4 + 1]) + (s[nt][gq * 4 + 2] + s[nt][gq * 4 + 3]);
          lastacc[nt * 4 + gq] += s[nt][gq * 4 + 3];
        }
      uint4 pbv[8];
#pragma unroll
      for (int ks = 0; ks < 8; ks++) {
        const int nt = ks >> 1, hb = (ks & 1) * 8;
        pbv[ks].x = pk2(s[nt][hb + 0], s[nt][hb + 1]); pbv[ks].y = pk2(s[nt][hb + 2], s[nt][hb + 3]);
        pbv[ks].z = pk2(s[nt][hb + 4], s[nt][hb + 5]); pbv[ks].w = pk2(s[nt][hb + 6], s[nt][hb + 7]);
      }
      const float g0 = sigmoidf_(bf2f(P.proj[rowg * INC + C_GA + head]));
#pragma unroll
      for (int dt = 0; dt < 2; dt++) {
        f32x16 o;
#pragma unroll
        for (int i = 0; i < 16; i++) o[i] = 0.f;
        const int d = dt * 32 + r, sw = d & 31;
#pragma unroll
        for (int ks = 0; ks < 8; ks++) {
          uint2 lo = *(const uint2*)(smem + 16384 + d * 256 + (((ks * 4 + h) ^ sw) << 3));
          uint2 hi = *(const uint2*)(smem + 16384 + d * 256 + (((ks * 4 + 2 + h) ^ sw) << 3));
          uint4 au = make_uint4(lo.x, lo.y, hi.x, hi.y);
          o = mfma32(__builtin_bit_cast(bf16x8, au), __builtin_bit_cast(bf16x8, pbv[ks]), o);
        }
#pragma unroll
        for (int gq = 0; gq < 4; gq++) {
          int d0 = dt * 32 + 8 * gq + 4 * h;
          uint2 ov;
          ov.x = pk2(o[gq * 4 + 0] * g0, o[gq * 4 + 1] * g0);
          ov.y = pk2(o[gq * 4 + 2] * g0, o[gq * 4 + 3] * g0);
          *(uint2*)(P.ya + rowg * DM + head * 64 + d0) = ov;
        }
        __builtin_amdgcn_sched_barrier(0);
      }
    }
    float sc[16];
#pragma unroll
    for (int s = 0; s < 16; s++) {
      float prev = (s == 0) ? 0.f : lastacc[s - 1];
      float sendv = h ? prev : lastacc[s];
      float recv = __shfl_xor(sendv, 32);
      float imp = sumacc[s] + recv;
      int j = (s >> 2) * 8 + (s & 3) * 2 + h;
      int cur = qtok >> 6;
      bool forced = (j == 0) || (j == cur) || (j == cur - 1);
      bool valid = j <= cur;
      sc[s] = forced ? 1.0e4f : (valid ? imp : -1.0f);
    }
    unsigned mask = 0u;
#pragma unroll 1
    for (int rd = 0; rd < 8; rd++) {
      float best = -2.0f; int bj = 0;
#pragma unroll
      for (int s = 0; s < 16; s++) {
        int j = (s >> 2) * 8 + (s & 3) * 2 + h;
        if (sc[s] > best) { best = sc[s]; bj = j; }
      }
      float ob = __shfl_xor(best, 32);
      int oj = __shfl_xor(bj, 32);
      bool mine = (best > ob) || (best == ob && bj < oj);
      int wj = mine ? bj : oj;
      mask |= 1u << wj;
#pragma unroll
      for (int s = 0; s < 16; s++) {
        int j = (s >> 2) * 8 + (s & 3) * 2 + h;
        if (j == wj) sc[s] = -3.0f;
      }
    }
    if (h == 0) P.sel[(size_t)(bl * 2 + g) * TSEQ + qtok] = mask;
  }
}

#define ATT_GLOAD(KT)                                                                              \
  {                                                                                                \
    kreg0 = *(const uint4*)(Kg + (size_t)((KT) * 64 + lk) * ldk + lch * 8);                        \
    vreg0 = *(const uint4*)(Vtg + (size_t)lk * TSEQ + (KT) * 64 + lch * 8);                        \
    if (MODE == 0 && tid < 16) freg = *(const float4*)(F2g + (KT) * 64 + tid * 4);                 \
  }
#define ATT_SSTORE(ST)                                                                             \
  {                                                                                                \
    char* base_ = smem + (ST) * ATT_STAGE;                                                         \
    *(uint4*)(base_ + koff0) = kreg0;                                                              \
    *(uint2*)(base_ + voffa) = make_uint2(vreg0.x, vreg0.y);                                       \
    *(uint2*)(base_ + voffb) = make_uint2(vreg0.z, vreg0.w);                                       \
    if (MODE == 0 && tid < 16) *(float4*)(base_ + 16384 + tid * 16) = freg;                        \
  }

template <int MODE>
__device__ __forceinline__ void attn_pass(const u16* __restrict__ Kg, int ldk, const u16* __restrict__ Vtg,
                                          const float* __restrict__ F2g, int kt_lo, int kt_hi,
                                          const u16* __restrict__ qptr, int qtok, int qw_lo, unsigned selm,
                                          f32x16 (&o)[2], float& m, float& l, char* smem, const int tid) {
  const int lane = tid & 63, r = lane & 31, h = lane >> 5;
  const int lk = tid >> 3, lch = tid & 7;
  const float c1 = 0.125f * LOG2E;
  uint4 kreg0, vreg0;
  const int koff0 = lk * 128 + ((lch ^ ((lk >> 1) & 7)) << 4);
  const int voffa = 8192 + lk * 128 + (((2 * lch) ^ ((lk >> 1) & 15)) << 3);
  const int voffb = 8192 + lk * 128 + (((2 * lch + 1) ^ ((lk >> 1) & 15)) << 3);
  float4 freg = make_float4(0.f, 0.f, 0.f, 0.f);
  if (kt_lo >= kt_hi) return;
  const bf16x8 qf0 = ldfrag(qptr), qf1 = ldfrag(qptr + 16), qf2 = ldfrag(qptr + 32), qf3 = ldfrag(qptr + 48);
  ATT_GLOAD(kt_lo);
  ATT_SSTORE(0);
  __syncthreads();
  for (int kt = kt_lo; kt < kt_hi; kt++) {
    const int st = (kt - kt_lo) & 1;
    const bool more = (kt + 1) < kt_hi;
    if (more) ATT_GLOAD(kt + 1);
    const int kb = kt * 64;
    bool active = kb <= qw_lo + 31;
    bool selbit = true;
    if (MODE == 1) {
      selbit = (selm >> kt) & 1u;
      active = active && (__ballot(selbit) != 0ull);
    }
    if (MODE == 2) active = active && (kb + 63 + 511 >= qw_lo);
    if (active) {
      const char* sb = smem + st * ATT_STAGE;
      f32x16 s[2];
#pragma unroll
      for (int nt = 0; nt < 2; nt++) {
#pragma unroll
        for (int i = 0; i < 16; i++) s[nt][i] = 0.f;
#pragma unroll
        for (int kk = 0; kk < 4; kk++) {
          int row = nt * 32 + r;
          bf16x8 a = ldfrag(sb + row * 128 + (((kk * 2 + h) ^ ((row >> 1) & 7)) << 4));
          s[nt] = mfma32(a, kk == 0 ? qf0 : (kk == 1 ? qf1 : (kk == 2 ? qf2 : qf3)), s[nt]);
        }
      }
#pragma unroll
      for (int nt = 0; nt < 2; nt++)
#pragma unroll
        for (int gq = 0; gq < 4; gq++) {
          if (MODE == 0) {
            float4 fk = *(const float4*)(sb + 16384 + (nt * 32 + gq * 8 + h * 4) * 4);
            s[nt][gq * 4 + 0] = s[nt][gq * 4 + 0] * c1 - fk.x;
            s[nt][gq * 4 + 1] = s[nt][gq * 4 + 1] * c1 - fk.y;
            s[nt][gq * 4 + 2] = s[nt][gq * 4 + 2] * c1 - fk.z;
            s[nt][gq * 4 + 3] = s[nt][gq * 4 + 3] * c1 - fk.w;
          } else {
#pragma unroll
            for (int e = 0; e < 4; e++) s[nt][gq * 4 + e] *= c1;
          }
        }
      bool need_mask;
      if (MODE == 0) need_mask = (kb + 63 > qw_lo);
      else if (MODE == 1) need_mask = (kb + 63 > qw_lo) || (__ballot(!selbit) != 0ull);
      else need_mask = (kb + 63 > qw_lo) || (kb + 512 <= qw_lo + 31);
      if (need_mask) {
        const int td = qtok - kb - 4 * h;
#pragma unroll
        for (int nt = 0; nt < 2; nt++)
#pragma unroll
          for (int i = 0; i < 16; i++) {
            const int kc = nt * 32 + 8 * (i >> 2) + (i & 3);
            bool ok = kc <= td;
            if (MODE == 1) ok = ok && selbit;
            if (MODE == 2) ok = ok && (kc + 512 > td);
            s[nt][i] = ok ? s[nt][i] : -3.0e38f;
          }
      }
      float mx = s[0][0];
#pragma unroll
      for (int nt = 0; nt < 2; nt++)
#pragma unroll
        for (int i = 0; i < 16; i++) mx = fmaxf(mx, s[nt][i]);
      mx = fmaxf(mx, __shfl_xor(mx, 32));
      const float mn = fmaxf(m, mx);
      const float alpha = __builtin_amdgcn_exp2f(m - mn);
      float rs = 0.f;
#pragma unroll
      for (int nt = 0; nt < 2; nt++)
#pragma unroll
        for (int i = 0; i < 16; i++) {
          float p = __builtin_amdgcn_exp2f(s[nt][i] - mn);
          s[nt][i] = p;
          rs += p;
        }
      rs += __shfl_xor(rs, 32);
      l = l * alpha + rs;
      m = mn;
#pragma unroll
      for (int dt = 0; dt < 2; dt++)
#pragma unroll
        for (int i = 0; i < 16; i++) o[dt][i] *= alpha;
#pragma unroll
      for (int ks = 0; ks < 4; ks++) {
        const int nt = ks >> 1, hb = (ks & 1) * 8;
        uint4 pu;
        pu.x = pk2(s[nt][hb + 0], s[nt][hb + 1]); pu.y = pk2(s[nt][hb + 2], s[nt][hb + 3]);
        pu.z = pk2(s[nt][hb + 4], s[nt][hb + 5]); pu.w = pk2(s[nt][hb + 6], s[nt][hb + 7]);
        bf16x8 pb = __builtin_bit_cast(bf16x8, pu);
#pragma unroll
        for (int dt = 0; dt < 2; dt++) {
          int d = dt * 32 + r, sw = (d >> 1) & 15;
          uint2 lo = *(const uint2*)(sb + 8192 + d * 128 + (((ks * 4 + h) ^ sw) << 3));
          uint2 hi = *(const uint2*)(sb + 8192 + d * 128 + (((ks * 4 + 2 + h) ^ sw) << 3));
          uint4 au = make_uint4(lo.x, lo.y, hi.x, hi.y);
          o[dt] = mfma32(__builtin_bit_cast(bf16x8, au), pb, o[dt]);
        }
      }
    }
    if (more) ATT_SSTORE(st ^ 1);
    __syncthreads();
  }
}

__device__ void pc2_phase(const Params& P, int layer, int chunk, char* smem, int* s_item) {
  const int tid = opaque_tid(),  lane = tid & 63, r = lane & 31, h = lane >> 5, w = tid >> 6;
  const int perq = 2 * P.NB * 16;
  const int nItems = 8 * perq;
  unsigned* ctr = P.ctr + (chunk * 4 + layer);
  while (true) {
    __syncthreads();
    if (tid == 0) *s_item = (int)atomicAdd(ctr, 1u);
    __syncthreads();
    const int it = *s_item;
    if (it >= nItems) break;
    const int qt = 7 - it / perq;
    const int rem = it % perq;
    const int type = rem & 1;
    const int bh = rem >> 1;
    const int bl = bh >> 4, head = bh & 15;
    const int qw_lo = qt * 256 + w * 32;
    const int qtok = qw_lo + r;
    const size_t rowg = (size_t)bl * TSEQ + qtok;
    const u16* pb_ = P.proj + (size_t)bl * TSEQ * INC;
    f32x16 o[2];
#pragma unroll
    for (int dt = 0; dt < 2; dt++)
#pragma unroll
      for (int i = 0; i < 16; i++) o[dt][i] = 0.f;
    float m = -1.0e30f, l = 0.f;
    if (type == 0) {
      const u16* qf = P.proj + rowg * INC + C_QB + head * 64 + h * 8;
      attn_pass<0>(pb_ + C_KB + head * 64, INC, P.vbt + (size_t)(bl * 16 + head) * 64 * TSEQ,
                   P.F2 + (size_t)(bl * 16 + head) * TSEQ, 0, 4 * qt + 4, qf, qtok, qw_lo, 0u, o, m, l, smem, tid);
      const float inv = 1.f / l;
#pragma unroll
      for (int dt = 0; dt < 2; dt++)
#pragma unroll
        for (int gq = 0; gq < 4; gq++) {
          int d0 = dt * 32 + 8 * gq + 4 * h;
          uint2 zz = *(const uint2*)(P.proj + rowg * INC + C_ZB + head * 64 + d0);
          uint2 ov;
          ov.x = pk2(o[dt][gq * 4 + 0] * inv * siluf_(bflo(zz.x)), o[dt][gq * 4 + 1] * inv * siluf_(bfhi(zz.x)));
          ov.y = pk2(o[dt][gq * 4 + 2] * inv * siluf_(bflo(zz.y)), o[dt][gq * 4 + 3] * inv * siluf_(bfhi(zz.y)));
          *(uint2*)(P.yb + rowg * DM + head * 64 + d0) = ov;
        }
    } else {
      const int g = head >> 3;
      const u16* qf = P.proj + rowg * INC + C_QR + head * 64 + h * 8;
      const unsigned selm = P.sel[(size_t)(bl * 2 + g) * TSEQ + qtok];
      attn_pass<1>(pb_ + C_KV + 256 + g * 64, INC, P.vst + (size_t)(bl * 2 + g) * 64 * TSEQ, nullptr,
                   0, 4 * qt + 4, qf, qtok, qw_lo, selm, o, m, l, smem, tid);
      f32x16 tot[2];
      {
        const float g1 = sigmoidf_(bf2f(P.proj[rowg * INC + C_GA + 16 + head]));
        const float sc1 = g1 / l;
#pragma unroll
        for (int dt = 0; dt < 2; dt++)
#pragma unroll
          for (int i = 0; i < 16; i++) { tot[dt][i] = o[dt][i] * sc1; o[dt][i] = 0.f; }
      }
      m = -1.0e30f; l = 0.f;
      const int klo = (4 * qt - 8) > 0 ? (4 * qt - 8) : 0;
      attn_pass<2>(pb_ + C_KV + 512 + g * 64, INC, P.vwt + (size_t)(bl * 2 + g) * 64 * TSEQ, nullptr,
                   klo, 4 * qt + 4, qf, qtok, qw_lo, 0u, o, m, l, smem, tid);
      const float g2 = sigmoidf_(bf2f(P.proj[rowg * INC + C_GA + 32 + head]));
      const float sc2 = g2 / l;
#pragma unroll
      for (int dt = 0; dt < 2; dt++)
#pragma unroll
        for (int gq = 0; gq < 4; gq++) {
          int d0 = dt * 32 + 8 * gq + 4 * h;
          uint2 zz = *(const uint2*)(P.proj + rowg * INC + C_ZA + head * 64 + d0);
          uint2 oc = *(const uint2*)(P.ya + rowg * DM + head * 64 + d0);
          float v0 = (tot[dt][gq * 4 + 0] + o[dt][gq * 4 + 0] * sc2 + bflo(oc.x)) * siluf_(bflo(zz.x));
          float v1 = (tot[dt][gq * 4 + 1] + o[dt][gq * 4 + 1] * sc2 + bfhi(oc.x)) * siluf_(bfhi(zz.x));
          float v2 = (tot[dt][gq * 4 + 2] + o[dt][gq * 4 + 2] * sc2 + bflo(oc.y)) * siluf_(bflo(zz.y));
          float v3 = (tot[dt][gq * 4 + 3] + o[dt][gq * 4 + 3] * sc2 + bfhi(oc.y)) * siluf_(bfhi(zz.y));
          uint2 ov;
          ov.x = pk2(v0, v1); ov.y = pk2(v2, v3);
          *(uint2*)(P.ya + rowg * DM + head * 64 + d0) = ov;
        }
    }
  }
}

__global__ void __launch_bounds__(NTHREADS, 2) mega_kernel(Params P) {
  __shared__ __attribute__((aligned(1024))) char smem[131072];
  cg::grid_group grid = cg::this_grid();
  const int CT = P.NB * TSEQ;
  phase0(P, smem);
  grid.sync();
  for (int chunk = 0; chunk < P.nchunk; chunk++) {
    for (int layer = 0; layer < 4; layer++) {
      const float* xs = (layer == 0 ? P.x_in : P.out) + (size_t)chunk * CT * DM;
      norm_phase(xs, P.norm_g + layer * DM, P.h, CT);
      if (layer == 0 && chunk > 0) final_norm_phase(P.out, P.final_g, (chunk - 1) * CT, CT);
      grid.sync();
      gemm1_phase(P, layer, smem);
      grid.sync();
      pb_phase(P, layer, smem);
      grid.sync();
      pc1_phase(P, smem);
      grid.sync();
      pc2_phase(P, layer, chunk, smem, (int*)(smem + 40000));
      grid.sync();
      gemm2_phase(P, layer, smem);
      grid.sync();
      gemm3_phase(P, layer, chunk, smem);
      grid.sync();
    }
  }
  final_norm_phase(P.out, P.final_g, (P.nchunk - 1) * CT, CT);
}

static inline size_t al256(size_t x) { return (x + 255) & ~(size_t)255; }

extern "C" void kernel_launch(void* const* d_in, const int* in_sizes, int n_in, void* d_out, int out_size,
                              void* d_ws, size_t ws_size, hipStream_t stream) {
  (void)in_sizes; (void)n_in; (void)out_size;
  Params P{};
  P.x_in = (const float*)d_in[0]; P.norm_g = (const float*)d_in[1]; P.w_in = (const float*)d_in[2];
  P.b_forget = (const float*)d_in[3];
  P.pe_k = (const float*)d_in[4]; P.w1_k = (const float*)d_in[5]; P.w2_k = (const float*)d_in[6];
  P.pe_v = (const float*)d_in[7]; P.w1_v = (const float*)d_in[8]; P.w2_v = (const float*)d_in[9];
  P.w_pa = (const float*)d_in[10]; P.w_pb = (const float*)d_in[11]; P.w_out = (const float*)d_in[12];
  P.final_g = (const float*)d_in[13];
  P.out = (float*)d_out;
  int NB = 16;
  char* base = (char*)d_ws;
  for (;;) {
    const size_t CT = (size_t)NB * TSEQ;
    size_t off = 0;
    auto take = [&](size_t bytes) { size_t o = off; off = al256(off + bytes); return o; };
    size_t oWin = take((size_t)4 * INCP * DM * 2), oWpa = take((size_t)4 * DM * DM * 2), oWpb = take((size_t)4 * DM * DM * 2),
           oWo = take((size_t)4 * DM * DM * 2), oW1 = take((size_t)8 * 128 * 2048 * 2), oW2 = take((size_t)8 * 64 * 128 * 2),
           oB1 = take((size_t)64 * 128 * 4), oRc = take((size_t)TSEQ * 32 * 4), oRs = take((size_t)TSEQ * 32 * 4),
           oH = take(CT * DM * 2), oProj = take(CT * INC * 2 + 4096), oVbt = take(CT * DM * 2),
           oVst = take(CT * 128 * 2), oVwt = take(CT * 128 * 2), oFl = take(CT * 16 * 4), oF2 = take(CT * 16 * 4),
           oKc = take((size_t)NB * 2 * 128 * 64 * 2), oVc = take((size_t)NB * 2 * 64 * 128 * 2), oSel = take(CT * 2 * 4),
           oYa = take(CT * DM * 2), oYb = take(CT * DM * 2), oCtr = take(256);
    if (off > ws_size && NB > 1) { NB >>= 1; continue; }
    P.WinT = (u16*)(base + oWin); P.WpaT = (u16*)(base + oWpa); P.WpbT = (u16*)(base + oWpb); P.WoT = (u16*)(base + oWo);
    P.W1T = (u16*)(base + oW1); P.W2T = (u16*)(base + oW2); P.bias1p = (float*)(base + oB1);
    P.ropec = (float*)(base + oRc); P.ropes = (float*)(base + oRs);
    P.h = (u16*)(base + oH); P.proj = (u16*)(base + oProj); P.vbt = (u16*)(base + oVbt);
    P.vst = (u16*)(base + oVst); P.vwt = (u16*)(base + oVwt); P.flog = (float*)(base + oFl); P.F2 = (float*)(base + oF2);
    P.kcmp = (u16*)(base + oKc); P.vcmpt = (u16*)(base + oVc); P.sel = (unsigned*)(base + oSel);
    P.ya = (u16*)(base + oYa); P.yb = (u16*)(base + oYb); P.ctr = (unsigned*)(base + oCtr);
    break;
  }
  P.NB = NB; P.nchunk = 32 / NB;
  static int grid_blocks = 0;
  if (!grid_blocks) {
    int dev = 0, cus = 0, per_cu = 0;
    hipGetDevice(&dev);
    hipDeviceGetAttribute(&cus, hipDeviceAttributeMultiprocessorCount, dev);
    hipOccupancyMaxActiveBlocksPerMultiprocessor(&per_cu, mega_kernel, NTHREADS, 0);
    if (per_cu > 1) per_cu = 1;
    if (per_cu < 1) per_cu = 1;
    grid_blocks = cus * per_cu;
  }
  void* args[] = {&P};
  hipError_t e = hipLaunchCooperativeKernel((void*)mega_kernel, dim3(grid_blocks), dim3(NTHREADS), args, 0, stream);
  if (e != hipSuccess) fprintf(stderr, "cooperative launch failed: %s (grid %d)\n", hipGetErrorString(e), grid_blocks);
}
```

```cpp
#include <hip/hip_runtime.h>
#include <hip/hip_cooperative_groups.h>
#include <cstdio>
namespace cg = cooperative_groups;

typedef __attribute__((ext_vector_type(8))) __bf16 bf16x8;
typedef __attribute__((ext_vector_type(16))) float f32x16;
typedef __attribute__((ext_vector_type(4))) float f32x4;
typedef unsigned short u16;

#define TSEQ 2048
#define DM 1024
#define INC 9024
#define INCP 9216
#define C_QA 0
#define C_KV 1024
#define C_GA 1792
#define C_ZA 1840
#define C_QB 2864
#define C_KB 3888
#define C_VB 4912
#define C_QR 4912
#define C_FB 5936
#define C_ZB 5952
#define C_RA 6976
#define C_RB 8000
#define NTHREADS 512
#define ATT_STAGE 16640
#define LOG2E 1.4426950408889634f

struct Params {
  const float* x_in; const float* norm_g; const float* w_in; const float* b_forget;
  const float* pe_k; const float* w1_k; const float* w2_k;
  const float* pe_v; const float* w1_v; const float* w2_v;
  const float* w_pa; const float* w_pb; const float* w_out; const float* final_g;
  float* out;
  u16* WinT; u16* WpaT; u16* WpbT; u16* WoT; u16* W1T; u16* W2T;
  float* bias1p; float* ropec; float* ropes;
  u16* h; u16* proj; u16* vbt; u16* vst; u16* vwt;
  float* flog; float* F2; u16* kcmp; u16* vcmpt; unsigned* sel;
  u16* ya; u16* yb; unsigned* ctr;
  int NB; int nchunk;
};

__device__ __forceinline__ unsigned pk2(float a, float b) {
  typedef __attribute__((ext_vector_type(2))) float f2_t;
  typedef __attribute__((ext_vector_type(2))) __bf16 b2_t;
  f2_t v = {a, b};
  b2_t r = __builtin_convertvector(v, b2_t);
  return __builtin_bit_cast(unsigned, r);
}
__device__ __forceinline__ u16 f2bf(float a) { return (u16)(pk2(a, 0.f) & 0xffffu); }
__device__ __forceinline__ float bf2f(u16 u) { return __uint_as_float(((unsigned)u) << 16); }
__device__ __forceinline__ float bflo(unsigned u) { return __uint_as_float(u << 16); }
__device__ __forceinline__ float bfhi(unsigned u) { return __uint_as_float(u & 0xffff0000u); }
__device__ __forceinline__ float sigmoidf_(float x) { return 1.f / (1.f + __expf(-x)); }
__device__ __forceinline__ float siluf_(float x) { return x / (1.f + __expf(-x)); }
__device__ __forceinline__ f32x16 mfma32(bf16x8 a, bf16x8 b, f32x16 c) {
  return __builtin_amdgcn_mfma_f32_32x32x16_bf16(a, b, c, 0, 0, 0);
}
__device__ __forceinline__ int opaque_tid() { int t = threadIdx.x; asm volatile("" : "+v"(t)); return t; }
__device__ __forceinline__ bf16x8 ldfrag(const void* p) {
  return __builtin_bit_cast(bf16x8, *(const uint4*)p);
}

__device__ void transpose_tile(const float* __restrict__ src, u16* __restrict__ dst, int K, int N,
                               int k0, int n0, float* tile, const int tid) {
#pragma unroll
  for (int j = 0; j < 2; j++) {
    int r = (tid >> 4) + 32 * j, c4 = (tid & 15) * 4;
    float4 v = *(const float4*)(src + (size_t)(k0 + r) * N + n0 + c4);
    tile[r * 65 + c4] = v.x; tile[r * 65 + c4 + 1] = v.y; tile[r * 65 + c4 + 2] = v.z; tile[r * 65 + c4 + 3] = v.w;
  }
  __syncthreads();
  {
    int c = tid, n = c >> 3, kc = c & 7;
    const float* tp = tile + (kc * 8) * 65 + n;
    uint4 o;
    o.x = pk2(tp[0], tp[65]); o.y = pk2(tp[130], tp[195]); o.z = pk2(tp[260], tp[325]); o.w = pk2(tp[390], tp[455]);
    *(uint4*)(dst + (size_t)(n0 + n) * K + k0 + kc * 8) = o;
  }
  __syncthreads();
}

__device__ void phase0(const Params& P, char* smem) {
  const int tid = opaque_tid();
  float* tile = (float*)smem;
  const int n0_ = 4 * 16 * 141, n1_ = 4 * 16 * 16, n2_ = 4 * 32 * 2, n3_ = 4 * 2 * 1;
  const int nT = n0_ + 3 * n1_ + 2 * n2_ + 2 * n3_;
  const int nBias = 64, nRope = 128;
  const int total = nT + nBias + nRope + 1;
  for (int it = blockIdx.x; it < total; it += gridDim.x) {
    if (it < nT) {
      int t = it;
      if (t < n0_) {
        int l = t / (16 * 141), rem = t % (16 * 141);
        transpose_tile(P.w_in + (size_t)l * DM * INC, P.WinT + (size_t)l * INCP * DM, DM, INC, (rem / 141) * 64, (rem % 141) * 64, tile, tid);
        continue;
      }
      t -= n0_;
      if (t < 3 * n1_) {
        int which = t / n1_; t %= n1_;
        int l = t / 256, rem = t % 256;
        const float* s = which == 0 ? P.w_pa : (which == 1 ? P.w_pb : P.w_out);
        u16* d = which == 0 ? P.WpaT : (which == 1 ? P.WpbT : P.WoT);
        transpose_tile(s + (size_t)l * DM * DM, d + (size_t)l * DM * DM, DM, DM, (rem >> 4) * 64, (rem & 15) * 64, tile, tid);
        continue;
      }
      t -= 3 * n1_;
      if (t < 2 * n2_) {
        int kv = t / n2_; t %= n2_;
        int l = t / 64, rem = t % 64;
        const float* s = kv ? P.w1_v : P.w1_k;
        transpose_tile(s + (size_t)l * 2048 * 128, P.W1T + (size_t)(l * 2 + kv) * 128 * 2048, 2048, 128, (rem >> 1) * 64, (rem & 1) * 64, tile, tid);
        continue;
      }
      t -= 2 * n2_;
      {
        int kv = t / n3_; t %= n3_;
        int l = t / 2, rem = t % 2;
        const float* s = kv ? P.w2_v : P.w2_k;
        transpose_tile(s + (size_t)l * 128 * 64, P.W2T + (size_t)(l * 2 + kv) * 64 * 128, 128, 64, rem * 64, 0, tile, tid);
      }
    } else if (it < nT + nBias) {
      int j = it - nT;
      int l = j >> 4, kv = (j >> 3) & 1, kq = j & 7;
      const float* pe = (kv ? P.pe_v : P.pe_k) + (size_t)l * 2048;
      const float* w1 = (kv ? P.w1_v : P.w1_k) + (size_t)l * 2048 * 128;
      int hid = tid & 127, kh = tid >> 7;
      int kbeg = kq * 256 + kh * 64;
      float s = 0.f;
#pragma unroll 8
      for (int k = 0; k < 64; k++) s += pe[kbeg + k] * w1[(size_t)(kbeg + k) * 128 + hid];
      float* part = (float*)smem;
      part[tid] = s;
      __syncthreads();
      if (tid < 128) P.bias1p[((l * 2 + kv) * 8 + kq) * 128 + hid] = (part[tid] + part[tid + 128]) + (part[tid + 256] + part[tid + 384]);
      __syncthreads();
    } else if (it < nT + nBias + nRope) {
      int idx = (it - nT - nBias) * 512 + tid;
      int t = idx >> 5, j = idx & 31;
      double inv = 1.0;
      for (int q = 0; q < j; q++) inv *= 0.7498942093324558;
      float invf = (float)inv;
      float angf = (float)t * invf;
      double a = (double)angf;
      double kq = rint(a * 0.15915494309189535);
      double rr = a - kq * 6.283185307179586;
      double r2 = rr * rr;
      double sterm = rr, cterm = 1.0, ssum = rr, csum = 1.0;
#pragma unroll 1
      for (int n = 1; n <= 15; n++) {
        cterm *= -r2 / (double)((2 * n - 1) * (2 * n));
        sterm *= -r2 / (double)((2 * n) * (2 * n + 1));
        csum += cterm; ssum += sterm;
      }
      P.ropec[idx] = (float)csum;
      P.ropes[idx] = (float)ssum;
    } else {
      if (tid < 64) P.ctr[tid] = 0u;
    }
  }
}

__device__ void norm_phase(const float* __restrict__ xsrc, const float* __restrict__ g, u16* __restrict__ hdst, int nrows) {
  const int tid = opaque_tid();
  const int lane = tid & 63;
  const int gw = blockIdx.x * 8 + (tid >> 6), nw = gridDim.x * 8;
  float4 gv[4];
#pragma unroll
  for (int j = 0; j < 4; j++) gv[j] = *(const float4*)(g + lane * 4 + 256 * j);
  for (int row = gw; row < nrows; row += nw) {
    const float* xr = xsrc + (size_t)row * DM;
    float4 v[4];
    float ss = 0.f;
#pragma unroll
    for (int j = 0; j < 4; j++) {
      v[j] = *(const float4*)(xr + lane * 4 + 256 * j);
      ss += v[j].x * v[j].x + v[j].y * v[j].y + v[j].z * v[j].z + v[j].w * v[j].w;
    }
#pragma unroll
    for (int o = 32; o >= 1; o >>= 1) ss += __shfl_xor(ss, o);
    float rstd = rsqrtf(ss * (1.f / DM) + 1e-6f);
#pragma unroll
    for (int j = 0; j < 4; j++) {
      uint2 o;
      o.x = pk2(v[j].x * rstd * gv[j].x, v[j].y * rstd * gv[j].y);
      o.y = pk2(v[j].z * rstd * gv[j].z, v[j].w * rstd * gv[j].w);
      *(uint2*)(hdst + (size_t)row * DM + lane * 4 + 256 * j) = o;
    }
  }
}

__device__ void final_norm_phase(float* __restrict__ x, const float* __restrict__ g, int row0, int nrows) {
  const int tid = opaque_tid();
  const int lane = tid & 63;
  const int gw = blockIdx.x * 8 + (tid >> 6), nw = gridDim.x * 8;
  float4 gv[4];
#pragma unroll
  for (int j = 0; j < 4; j++) gv[j] = *(const float4*)(g + lane * 4 + 256 * j);
  for (int row = gw; row < nrows; row += nw) {
    float* xr = x + (size_t)(row0 + row) * DM;
    float4 v[4];
    float ss = 0.f;
#pragma unroll
    for (int j = 0; j < 4; j++) {
      v[j] = *(const float4*)(xr + lane * 4 + 256 * j);
      ss += v[j].x * v[j].x + v[j].y * v[j].y + v[j].z * v[j].z + v[j].w * v[j].w;
    }
#pragma unroll
    for (int o = 32; o >= 1; o >>= 1) ss += __shfl_xor(ss, o);
    float rstd = rsqrtf(ss * (1.f / DM) + 1e-6f);
#pragma unroll
    for (int j = 0; j < 4; j++) {
      float4 o;
      o.x = v[j].x * rstd * gv[j].x; o.y = v[j].y * rstd * gv[j].y;
      o.z = v[j].z * rstd * gv[j].z; o.w = v[j].w * rstd * gv[j].w;
      *(float4*)(xr + lane * 4 + 256 * j) = o;
    }
  }
}

struct ARow {
  const u16* p; int ld;
  __device__ __forceinline__ const u16* operator()(int row, int k) const { return p + (size_t)row * ld + k; }
};
struct ACmp {
  const u16* p;
  __device__ __forceinline__ const u16* operator()(int row, int k) const {
    int t = 16 * row + (k >> 6); t = t > (TSEQ - 1) ? (TSEQ - 1) : t;
    return p + (size_t)t * INC + (k & 63);
  }
};

template <class AF>
__device__ __forceinline__ void gemm_mainloop(AF af, const u16* __restrict__ Bt, int ldb, int K, char* smem,
                                              f32x16 (&acc)[2][2], const int tid) {
  const int lane = tid & 63, r = lane & 31, h = lane >> 5, w = tid >> 6;
  const int wm = w >> 1, wn = w & 1;
  const int lrow = tid >> 3, lch = tid & 7;
  uint4 ra[4], rb[4];
  const int nk = K >> 6;
#pragma unroll
  for (int j = 0; j < 4; j++) {
    int row = lrow + 32 * j;
    ra[j] = *(const uint4*)af(row, lch * 8);
    rb[j] = *(const uint4*)(Bt + (size_t)row * ldb + lch * 8);
  }
#pragma unroll
  for (int j = 0; j < 4; j++) {
    int row = lrow + 32 * j;
    int off = row * 128 + ((lch ^ ((row >> 1) & 7)) << 4);
    *(uint4*)(smem + off) = ra[j];
    *(uint4*)(smem + 16384 + off) = rb[j];
  }
  __syncthreads();
  for (int it = 0; it < nk; it++) {
    const bool more = (it + 1) < nk;
    if (more) {
      const int k0 = (it + 1) * 64;
#pragma unroll
      for (int j = 0; j < 4; j++) {
        int row = lrow + 32 * j;
        ra[j] = *(const uint4*)af(row, k0 + lch * 8);
        rb[j] = *(const uint4*)(Bt + (size_t)row * ldb + k0 + lch * 8);
      }
    }
    const char* sa = smem + (it & 1) * 32768;
    const char* sb = sa + 16384;
#pragma unroll
    for (int kk = 0; kk < 4; kk++) {
      bf16x8 a[2], b[2];
#pragma unroll
      for (int mi = 0; mi < 2; mi++) {
        int row = wm * 64 + mi * 32 + r;
        a[mi] = ldfrag(sa + row * 128 + (((kk * 2 + h) ^ ((row >> 1) & 7)) << 4));
      }
#pragma unroll
      for (int ni = 0; ni < 2; ni++) {
        int row = wn * 64 + ni * 32 + r;
        b[ni] = ldfrag(sb + row * 128 + (((kk * 2 + h) ^ ((row >> 1) & 7)) << 4));
      }
#pragma unroll
      for (int mi = 0; mi < 2; mi++)
#pragma unroll
        for (int ni = 0; ni < 2; ni++) acc[mi][ni] = mfma32(a[mi], b[ni], acc[mi][ni]);
    }
    if (more) {
      char* sd = smem + ((it + 1) & 1) * 32768;
#pragma unroll
      for (int j = 0; j < 4; j++) {
        int row = lrow + 32 * j;
        int off = row * 128 + ((lch ^ ((row >> 1) & 7)) << 4);
        *(uint4*)(sd + off) = ra[j];
        *(uint4*)(sd + 16384 + off) = rb[j];
      }
    }
    __syncthreads();
  }
}

__device__ __forceinline__ void zero_acc(f32x16 (&acc)[2][2]) {
#pragma unroll
  for (int a = 0; a < 2; a++)
#pragma unroll
    for (int b = 0; b < 2; b++)
#pragma unroll
      for (int i = 0; i < 16; i++) acc[a][b][i] = 0.f;
}

typedef __attribute__((ext_vector_type(8))) short s16x8;
#define G_TILE_B 32768
#define G_STAGE_B 65536
__device__ __forceinline__ int g_lds_byte(int r, int c) {
  int st = (r >> 4) * 2 + (c >> 5), ob = (r & 15) * 64 + (c & 31) * 2;
  return st * 1024 + (ob ^ (((ob >> 9) & 1) << 5));
}
__device__ __forceinline__ void g_stage_rc(int b, int& R, int& C) {
  int st = b >> 10, sb = b & 1023, swz = sb ^ (((sb >> 9) & 1) << 5);
  R = (st >> 1) * 16 + swz / 64;
  C = (st & 1) * 32 + (swz % 64) / 2;
}
#define G_WAIT_V0() asm volatile("s_waitcnt vmcnt(0)" ::: "memory")

struct GTile { int pm, pn; };
__device__ __forceinline__ bool g_next(int i, int G, int c, int nM, int nN, GTile& u) {
  const int nwg = nM * nN;
  const long L = (long)i * G + c;
  if (L >= nwg) return false;
  int wgid = (int)L;
  { const int q = nwg / 8, r = nwg % 8, xcd = wgid % 8, off = wgid / 8; wgid = (xcd < r ? xcd * (q + 1) : r * (q + 1) + (xcd - r) * q) + off; }
  const int nig = 8 * nN, gid = wgid / nig, fm = gid * 8, gsz = (nM - fm) < 8 ? (nM - fm) : 8;
  u.pm = fm + ((wgid % nig) % gsz);
  u.pn = (wgid % nig) / gsz;
  return true;
}

__device__ __forceinline__ void g_kloop(const u16* __restrict__ Ab, const u16* __restrict__ Bb, const int K, char* smem,
                                        f32x4 (&acc)[8][4], const int tid) {
  const int wid = tid >> 6, lane = tid & 63, wr = wid >> 2, wc = wid & 3, fr = lane & 15, fq = lane >> 4;
  int sR0, sC0, sR1, sC1, sR2, sC2, sR3, sC3;
  g_stage_rc(wid * 1024 + 0 * 8192 + lane * 16, sR0, sC0);
  g_stage_rc(wid * 1024 + 1 * 8192 + lane * 16, sR1, sC1);
  g_stage_rc(wid * 1024 + 2 * 8192 + lane * 16, sR2, sC2);
  g_stage_rc(wid * 1024 + 3 * 8192 + lane * 16, sR3, sC3);
  const long o0 = (long)sR0 * K + sC0, o1 = (long)sR1 * K + sC1, o2 = (long)sR2 * K + sC2, o3 = (long)sR3 * K + sC3;
#define G_STAGE(buf, kt)                                                                                              \
  {                                                                                                                  \
    char* sa_ = smem + (buf) * G_STAGE_B + wid * 1024;                                                               \
    char* sb_ = sa_ + G_TILE_B;                                                                                      \
    const u16* ga_ = Ab + (kt) * 64;                                                                                 \
    const u16* gb_ = Bb + (kt) * 64;                                                                                 \
    __builtin_amdgcn_global_load_lds((const unsigned*)(ga_ + o0), (unsigned*)(sa_), 16, 0, 0);                       \
    __builtin_amdgcn_global_load_lds((const unsigned*)(gb_ + o0), (unsigned*)(sb_), 16, 0, 0);                       \
    __builtin_amdgcn_global_load_lds((const unsigned*)(ga_ + o1), (unsigned*)(sa_ + 8192), 16, 0, 0);                \
    __builtin_amdgcn_global_load_lds((const unsigned*)(gb_ + o1), (unsigned*)(sb_ + 8192), 16, 0, 0);                \
    __builtin_amdgcn_global_load_lds((const unsigned*)(ga_ + o2), (unsigned*)(sa_ + 16384), 16, 0, 0);               \
    __builtin_amdgcn_global_load_lds((const unsigned*)(gb_ + o2), (unsigned*)(sb_ + 16384), 16, 0, 0);               \
    __builtin_amdgcn_global_load_lds((const unsigned*)(ga_ + o3), (unsigned*)(sa_ + 24576), 16, 0, 0);               \
    __builtin_amdgcn_global_load_lds((const unsigned*)(gb_ + o3), (unsigned*)(sb_ + 24576), 16, 0, 0);               \
  }
  const int nt = K >> 6;
  G_STAGE(0, 0);
  G_WAIT_V0();
  __syncthreads();
  for (int t = 0; t < nt; ++t) {
    const int cur = t & 1;
    if (t + 1 < nt) G_STAGE(cur ^ 1, t + 1);
    const char* sa = smem + cur * G_STAGE_B;
    const char* sb = sa + G_TILE_B;
#pragma unroll
    for (int ks = 0; ks < 2; ++ks) {
      s16x8 At[8], Bf[4];
#pragma unroll
      for (int m = 0; m < 8; ++m) At[m] = *(const s16x8*)(sa + g_lds_byte(wr * 128 + m * 16 + fr, ks * 32 + fq * 8));
#pragma unroll
      for (int n = 0; n < 4; ++n) Bf[n] = *(const s16x8*)(sb + g_lds_byte(wc * 64 + n * 16 + fr, ks * 32 + fq * 8));
#pragma unroll
      for (int m = 0; m < 8; ++m)
#pragma unroll
        for (int n = 0; n < 4; ++n)
          acc[m][n] = __builtin_amdgcn_mfma_f32_16x16x32_bf16(__builtin_bit_cast(bf16x8, Bf[n]), __builtin_bit_cast(bf16x8, At[m]), acc[m][n], 0, 0, 0);
      __builtin_amdgcn_sched_barrier(0);
    }
    G_WAIT_V0();
    __syncthreads();
  }
}

__device__ __forceinline__ void g_zero(f32x4 (&acc)[8][4]) {
#pragma unroll
  for (int m = 0; m < 8; m++)
#pragma unroll
    for (int n = 0; n < 4; n++) acc[m][n] = (f32x4){0.f, 0.f, 0.f, 0.f};
}
__device__ __forceinline__ uint2 pk4(f32x4 v) { return make_uint2(pk2(v[0], v[1]), pk2(v[2], v[3])); }

__device__ __forceinline__ void wave_store_rows(char* wsm, u16* gbase, const size_t ld, const f32x4 (&acc)[8][4], const int lane) {
  const int fr = lane & 15, fq = lane >> 4;
#pragma unroll
  for (int m = 0; m < 8; m++)
#pragma unroll
    for (int n = 0; n < 4; n++) {
      const int row = m * 16 + fr, chunk = n * 2 + (fq >> 1);
      *(uint2*)(wsm + row * 128 + ((chunk ^ (fr & 7)) << 4) + (fq & 1) * 8) = pk4(acc[m][n]);
    }
  const int rr = lane >> 3, ch = lane & 7;
#pragma unroll
  for (int i = 0; i < 16; i++) {
    const int row = i * 8 + rr;
    const uint4 v = *(const uint4*)(wsm + row * 128 + ((ch ^ (row & 7)) << 4));
    *(uint4*)(gbase + (size_t)row * ld + ch * 8) = v;
  }
}
__device__ __forceinline__ void wave_store_cols(char* wsm, u16* vt, const int vcol0, const int nh, const int bl, const int t0,
                                                const f32x4 (&acc)[8][4], const int lane) {
  const int fr = lane & 15, fq = lane >> 4;
#pragma unroll
  for (int m = 0; m < 8; m++)
#pragma unroll
    for (int n = 0; n < 4; n++)
#pragma unroll
      for (int j = 0; j < 4; j++) {
        const int d = n * 16 + fq * 4 + j, t = m * 16 + fr;
        *(u16*)(wsm + d * 256 + (((t >> 3) ^ (d & 15)) << 4) + (t & 7) * 2) = f2bf(acc[m][n][j]);
      }
  const int dd = lane >> 4, ch = lane & 15;
#pragma unroll
  for (int i = 0; i < 16; i++) {
    const int d = i * 4 + dd;
    const uint4 v = *(const uint4*)(wsm + d * 256 + ((ch ^ (d & 15)) << 4));
    const int vcol = vcol0 + d;
    *(uint4*)(vt + ((size_t)(bl * nh + (vcol >> 6)) * 64 + (vcol & 63)) * TSEQ + t0 + ch * 8) = v;
  }
}

__device__ void gemm1_phase(const Params& P, int layer, char* smem) {
  const int CT = P.NB * TSEQ;
  const int nM = CT >> 8, nN = INCP >> 8;
  const u16* Bt = P.WinT + (size_t)layer * INCP * DM;
  u16* p_vbt = P.vbt; u16* p_vst = P.vst; u16* p_vwt = P.vwt;
  asm volatile("" : "+s"(p_vbt), "+s"(p_vst), "+s"(p_vwt));
  for (int i = 0;; i++) {
    GTile u;
    if (!g_next(i, gridDim.x, blockIdx.x, nM, nN, u)) break;
    const int tid = opaque_tid(), wid = tid >> 6, lane = tid & 63, wr = wid >> 2, wc = wid & 3, fr = lane & 15, fq = lane >> 4;
    f32x4 acc[8][4];
    g_zero(acc);
    g_kloop(P.h + (size_t)(u.pm * 256) * DM, Bt + (size_t)(u.pn * 256) * DM, DM, smem, acc, tid);
    const int cw = u.pn * 256 + wc * 64;
    const int row0 = u.pm * 256 + wr * 128 + fr;
    char* wsm = smem + wid * 16384;
    const int rowb = u.pm * 256 + wr * 128;
    const bool rope_q = cw < 1024;
    const bool rope_k = (cw >= C_KV + 256 && cw < C_KV + 384) || (cw >= C_KV + 512 && cw < C_KV + 640);
    const bool mixed = (cw == 4864) || (cw == 5888);
    const bool pure_vb = (cw >= 4928 && cw < 5888);
    const bool pure_vs = (cw >= C_KV + 384 && cw < C_KV + 512);
    const bool pure_vw = (cw >= C_KV + 640 && cw < C_KV + 768);
    if (cw >= INC) {
    } else if (rope_q || rope_k) {
      if (rope_q) wave_store_rows(wsm, P.proj + (size_t)rowb * INC + cw, INC, acc, lane);
#pragma unroll
      for (int m = 0; m < 8; m++) {
        const int tt = (row0 + m * 16) & (TSEQ - 1);
#pragma unroll
        for (int n = 0; n < 2; n++) {
          const float4 c = *(const float4*)(P.ropec + tt * 32 + n * 16 + fq * 4);
          const float4 sn = *(const float4*)(P.ropes + tt * 32 + n * 16 + fq * 4);
          const f32x4 x1 = acc[m][n], x2 = acc[m][n + 2];
          f32x4 r1, r2;
          r1[0] = x1[0] * c.x - x2[0] * sn.x; r2[0] = x2[0] * c.x + x1[0] * sn.x;
          r1[1] = x1[1] * c.y - x2[1] * sn.y; r2[1] = x2[1] * c.y + x1[1] * sn.y;
          r1[2] = x1[2] * c.z - x2[2] * sn.z; r2[2] = x2[2] * c.z + x1[2] * sn.z;
          r1[3] = x1[3] * c.w - x2[3] * sn.w; r2[3] = x2[3] * c.w + x1[3] * sn.w;
          acc[m][n] = r1; acc[m][n + 2] = r2;
        }
      }
      wave_store_rows(wsm, P.proj + (size_t)rowb * INC + (rope_q ? C_QR : 0) + cw, INC, acc, lane);
    } else if (pure_vb || pure_vs || pure_vw) {
      u16* vt = pure_vb ? p_vbt : (pure_vs ? p_vst : p_vwt);
      const int vcol0 = pure_vb ? (cw - C_VB) : (pure_vs ? (cw - (C_KV + 384)) : (cw - (C_KV + 640)));
      wave_store_cols(wsm, vt, vcol0, pure_vb ? 16 : 2, rowb >> 11, rowb & (TSEQ - 1), acc, lane);
    } else if (!mixed) {
      wave_store_rows(wsm, P.proj + (size_t)rowb * INC + cw, INC, acc, lane);
    } else {
#pragma unroll
      for (int n = 0; n < 4; n++) {
        const int c0 = cw + n * 16 + fq * 4;
        int kind = 0;
        if (c0 >= C_VB && c0 < C_FB) kind = 1;
        else if (c0 >= C_FB && c0 < C_ZB) kind = 2;
        const int vcol = c0 - C_VB;
        if (kind == 0) {
#pragma unroll
          for (int m = 0; m < 8; m++) *(uint2*)(P.proj + (size_t)(row0 + m * 16) * INC + c0) = pk4(acc[m][n]);
        } else if (kind == 1) {
#pragma unroll
          for (int m = 0; m < 8; m++) {
            const int row = row0 + m * 16;
            const int bl = row >> 11, tt = row & (TSEQ - 1);
            u16* vp = p_vbt + ((size_t)(bl * 16 + (vcol >> 6)) * 64 + (vcol & 63)) * TSEQ + tt;
            vp[0] = f2bf(acc[m][n][0]); vp[TSEQ] = f2bf(acc[m][n][1]);
            vp[2 * TSEQ] = f2bf(acc[m][n][2]); vp[3 * TSEQ] = f2bf(acc[m][n][3]);
          }
        } else {
#pragma unroll
          for (int m = 0; m < 8; m++)
            *(float4*)(P.flog + (size_t)(row0 + m * 16) * 16 + (c0 - C_FB)) = make_float4(acc[m][n][0], acc[m][n][1], acc[m][n][2], acc[m][n][3]);
        }
        __builtin_amdgcn_sched_barrier(0);
      }
    }
    __syncthreads();
  }
}

__device__ void gemm2_phase(const Params& P, int layer, char* smem) {
  const int CT = P.NB * TSEQ;
  const int nM = CT >> 8, nN = 4;
  const u16* p_ya = P.ya; const u16* p_yb = P.yb; const u16* p_wa = P.WpaT; const u16* p_wb = P.WpbT;
  for (int i = 0;; i++) {
    GTile u;
    if (!g_next(i, gridDim.x, blockIdx.x, nM, nN, u)) break;
    const int tid = opaque_tid(), wid = tid >> 6, lane = tid & 63, wr = wid >> 2, wc = wid & 3, fr = lane & 15, fq = lane >> 4;
    f32x4 acc[8][4];
    g_zero(acc);
#pragma unroll 1
    for (int pass = 0; pass < 2; pass++) {
      const u16* Ap = (pass ? p_yb : p_ya) + (size_t)(u.pm * 256) * DM;
      const u16* Bp = (pass ? p_wb : p_wa) + (size_t)layer * DM * DM + (size_t)(u.pn * 256) * DM;
      g_kloop(Ap, Bp, DM, smem, acc, tid);
      __builtin_amdgcn_sched_barrier(0);
      if (pass == 0) {
        const int tid1 = opaque_tid(), wid1 = tid1 >> 6, lane1 = tid1 & 63, wr1 = wid1 >> 2, wc1 = wid1 & 3, fr1 = lane1 & 15, fq1 = lane1 >> 4;
        const u16* pp = P.proj + (size_t)(u.pm * 256 + wr1 * 128 + fr1) * INC + u.pn * 256 + wc1 * 64 + fq1 * 4;
#pragma unroll
        for (int m = 0; m < 8; m++) {
#pragma unroll
          for (int n = 0; n < 4; n++) {
            const uint2 ra = *(const uint2*)(pp + (size_t)(m * 16) * INC + C_RA + n * 16);
            const uint2 rb = *(const uint2*)(pp + (size_t)(m * 16) * INC + C_RB + n * 16);
            acc[m][n][0] *= (1.f + __expf(-bflo(rb.x))) / (1.f + __expf(-bflo(ra.x)));
            acc[m][n][1] *= (1.f + __expf(-bfhi(rb.x))) / (1.f + __expf(-bfhi(ra.x)));
            acc[m][n][2] *= (1.f + __expf(-bflo(rb.y))) / (1.f + __expf(-bflo(ra.y)));
            acc[m][n][3] *= (1.f + __expf(-bfhi(rb.y))) / (1.f + __expf(-bfhi(ra.y)));
          }
          __builtin_amdgcn_sched_barrier(0);
        }
      }
    }
    {
      const int tid2 = opaque_tid(), wid2 = tid2 >> 6, lane2 = tid2 & 63, wr2 = wid2 >> 2, wc2 = wid2 & 3, fr2 = lane2 & 15, fq2 = lane2 >> 4;
      const u16* pp = P.proj + (size_t)(u.pm * 256 + wr2 * 128 + fr2) * INC + u.pn * 256 + wc2 * 64 + fq2 * 4;
#pragma unroll
      for (int m = 0; m < 8; m++) {
#pragma unroll
        for (int n = 0; n < 4; n++) {
          const uint2 rb = *(const uint2*)(pp + (size_t)(m * 16) * INC + C_RB + n * 16);
          acc[m][n][0] *= sigmoidf_(bflo(rb.x)); acc[m][n][1] *= sigmoidf_(bfhi(rb.x));
          acc[m][n][2] *= sigmoidf_(bflo(rb.y)); acc[m][n][3] *= sigmoidf_(bfhi(rb.y));
        }
        __builtin_amdgcn_sched_barrier(0);
      }
      wave_store_rows(smem + wid2 * 16384, P.h + (size_t)(u.pm * 256 + wr2 * 128) * DM + u.pn * 256 + wc2 * 64, DM, acc, lane2);
    }
    __syncthreads();
  }
}

__device__ void gemm3_phase(const Params& P, int layer, int chunk, char* smem) {
  const int CT = P.NB * TSEQ;
  const int nM = CT >> 8, nN = 4;
  const float* xs = (layer == 0 ? P.x_in : P.out) + (size_t)chunk * CT * DM;
  float* xd = P.out + (size_t)chunk * CT * DM;
  for (int i = 0;; i++) {
    GTile u;
    if (!g_next(i, gridDim.x, blockIdx.x, nM, nN, u)) break;
    const int tid = opaque_tid(), wid = tid >> 6, lane = tid & 63, wr = wid >> 2, wc = wid & 3, fr = lane & 15, fq = lane >> 4;
    f32x4 acc[8][4];
    g_zero(acc);
    g_kloop(P.h + (size_t)(u.pm * 256) * DM, P.WoT + (size_t)layer * DM * DM + (size_t)(u.pn * 256) * DM, DM, smem, acc, tid);
    const size_t off = (size_t)(u.pm * 256 + wr * 128 + fr) * DM + u.pn * 256 + wc * 64 + fq * 4;
#pragma unroll
    for (int m = 0; m < 8; m++) {
#pragma unroll
      for (int n = 0; n < 4; n++) {
        const float4 xo = *(const float4*)(xs + off + (size_t)(m * 16) * DM + n * 16);
        *(float4*)(xd + off + (size_t)(m * 16) * DM + n * 16) =
            make_float4(xo.x + acc[m][n][0], xo.y + acc[m][n][1], xo.z + acc[m][n][2], xo.w + acc[m][n][3]);
      }
      __builtin_amdgcn_sched_barrier(0);
    }
  }
}

__device__ void pb_phase(const Params& P, int layer, char* smem_all) {
  const int tid_all = opaque_tid();
  const int half = tid_all >> 8, tid = tid_all & 255;
  char* smem = smem_all + half * 65536;
  const int lane = tid & 63, r = lane & 31, h = lane >> 5, w = tid >> 6;
  const int wm = w >> 1, wn = w & 1;
  const int nCmp = P.NB * 2;
  const int nScan = P.NB * 2;
  for (int it = blockIdx.x; it < nCmp + nScan; it += gridDim.x) {
    if (it < nCmp) {
      const int unit = it * 2 + half;
      const int bl = unit >> 2, g = (unit >> 1) & 1, kv = unit & 1;
      f32x16 acc[2][2];
      zero_acc(acc);
      ACmp af{P.proj + (size_t)bl * TSEQ * INC + C_KV + kv * 128 + g * 64};
      gemm_mainloop(af, P.W1T + (size_t)(layer * 2 + kv) * 128 * 2048, 2048, 2048, smem, acc, tid);
      const float* bp = P.bias1p + (size_t)((layer * 2 + kv) * 8) * 128;
#pragma unroll
      for (int ni = 0; ni < 2; ni++) {
        int hc = wn * 64 + ni * 32 + r;
        float b1 = 0.f;
#pragma unroll
        for (int q = 0; q < 8; q++) b1 += bp[q * 128 + hc];
#pragma unroll
        for (int mi = 0; mi < 2; mi++)
#pragma unroll
          for (int i = 0; i < 16; i++) {
            int n = wm * 64 + mi * 32 + 8 * (i >> 2) + 4 * h + (i & 3);
            float v = siluf_(acc[mi][ni][i] + b1);
            *(u16*)(smem + n * 256 + (((hc >> 3) ^ (n & 15)) << 4) + (hc & 7) * 2) = f2bf(v);
          }
      }
      __syncthreads();
      const u16* w2t = P.W2T + (size_t)(layer * 2 + kv) * 64 * 128;
      f32x16 o2[2];
#pragma unroll
      for (int dt = 0; dt < 2; dt++)
#pragma unroll
        for (int i = 0; i < 16; i++) o2[dt][i] = 0.f;
#pragma unroll
      for (int kk = 0; kk < 8; kk++) {
        int n = w * 32 + r;
        bf16x8 a = ldfrag(smem + n * 256 + (((kk * 2 + h) ^ (n & 15)) << 4));
#pragma unroll
        for (int dt = 0; dt < 2; dt++) {
          bf16x8 b = ldfrag(w2t + (size_t)(dt * 32 + r) * 128 + kk * 16 + h * 8);
          o2[dt] = mfma32(a, b, o2[dt]);
        }
      }
#pragma unroll
      for (int dt = 0; dt < 2; dt++) {
        int d = dt * 32 + r;
        if (kv == 0) {
#pragma unroll
          for (int i = 0; i < 16; i++) {
            int n = w * 32 + 8 * (i >> 2) + 4 * h + (i & 3);
            P.kcmp[((size_t)(bl * 2 + g) * 128 + n) * 64 + d] = f2bf(o2[dt][i]);
          }
        } else {
#pragma unroll
          for (int gq = 0; gq < 4; gq++) {
            int n0 = w * 32 + 8 * gq + 4 * h;
            uint2 o;
            o.x = pk2(o2[dt][gq * 4 + 0], o2[dt][gq * 4 + 1]);
            o.y = pk2(o2[dt][gq * 4 + 2], o2[dt][gq * 4 + 3]);
            *(uint2*)(P.vcmpt + ((size_t)(bl * 2 + g) * 64 + d) * 128 + n0) = o;
          }
        }
      }
      __syncthreads();
    } else {
      const int sidx = (it - nCmp) * 8 + (tid_all >> 6);
      const int bl = sidx >> 4, hh = sidx & 15;
      const float bf = P.b_forget[layer * 16 + hh];
      const float* fl = P.flog + ((size_t)bl * TSEQ + lane * 32) * 16 + hh;
      float loc = 0.f;
#pragma unroll 8
      for (int j = 0; j < 32; j++) {
        float x = fl[j * 16] + bf;
        float ls = (x >= 0.f) ? -log1pf(__expf(-x)) : (x - log1pf(__expf(x)));
        loc += ls;
      }
      float incl = loc;
#pragma unroll
      for (int o = 1; o < 64; o <<= 1) {
        float v = __shfl_up(incl, o);
        if (lane >= o) incl += v;
      }
      float run = incl - loc;
      float* fo = P.F2 + ((size_t)bl * 16 + hh) * TSEQ + lane * 32;
#pragma unroll 8
      for (int j = 0; j < 32; j++) {
        float x = fl[j * 16] + bf;
        float ls = (x >= 0.f) ? -log1pf(__expf(-x)) : (x - log1pf(__expf(x)));
        run += ls;
        fo[j] = run * LOG2E;
      }
    }
  }
}

__device__ void pc1_phase(const Params& P, char* smem) {
  const int tid = opaque_tid(),  lane = tid & 63, r = lane & 31, h = lane >> 5, w = tid >> 6;
  const int nItems = P.NB * 2 * 8;
  const float c1 = 0.125f * LOG2E;
  for (int it = blockIdx.x; it < nItems; it += gridDim.x) {
    const int qt = it & 7, g = (it >> 3) & 1, bl = it >> 4;
    __syncthreads();
#pragma unroll
    for (int j = 0; j < 2; j++) {
      int c = tid + 512 * j;
      {
        int n = c >> 3, ch = c & 7;
        uint4 v = *(const uint4*)(P.kcmp + ((size_t)(bl * 2 + g) * 128 + n) * 64 + ch * 8);
        *(uint4*)(smem + n * 128 + ((ch ^ ((n >> 1) & 7)) << 4)) = v;
      }
      {
        int d = c >> 4, ch = c & 15;
        uint4 v = *(const uint4*)(P.vcmpt + ((size_t)(bl * 2 + g) * 64 + d) * 128 + ch * 8);
        int sw = d & 31;
        *(uint2*)(smem + 16384 + d * 256 + (((2 * ch) ^ sw) << 3)) = make_uint2(v.x, v.y);
        *(uint2*)(smem + 16384 + d * 256 + (((2 * ch + 1) ^ sw) << 3)) = make_uint2(v.z, v.w);
      }
    }
    __syncthreads();
    const int qw_lo = qt * 256 + w * 32;
    const int qtok = qw_lo + r;
    const size_t rowg = (size_t)bl * TSEQ + qtok;
    const int tq = qtok - 31 - 64 * h;
    float sumacc[16], lastacc[16];
#pragma unroll
    for (int s = 0; s < 16; s++) { sumacc[s] = 0.f; lastacc[s] = 0.f; }
#pragma unroll 1
    for (int hh = 0; hh < 8; hh++) {
      const int head = g * 8 + hh;
      bf16x8 qf[4];
#pragma unroll
      for (int kk = 0; kk < 4; kk++) qf[kk] = ldfrag(P.proj + rowg * INC + C_QA + head * 64 + kk * 16 + h * 8);
      f32x16 s[4];
#pragma unroll
      for (int nt = 0; nt < 4; nt++) {
#pragma unroll
        for (int i = 0; i < 16; i++) s[nt][i] = 0.f;
#pragma unroll
        for (int kk = 0; kk < 4; kk++) {
          int row = nt * 32 + r;
          bf16x8 a = ldfrag(smem + row * 128 + (((kk * 2 + h) ^ ((row >> 1) & 7)) << 4));
          s[nt] = mfma32(a, qf[kk], s[nt]);
        }
        __builtin_amdgcn_sched_barrier(0);
      }
      float mx = -3.0e38f;
#pragma unroll
      for (int nt = 0; nt < 4; nt++)
#pragma unroll
        for (int i = 0; i < 16; i++) {
          bool ok = (16 * (nt * 32 + 8 * (i >> 2) + (i & 3))) <= tq;
          float v = ok ? s[nt][i] * c1 : -3.0e38f;
          s[nt][i] = v;
          mx = fmaxf(mx, v);
        }
      mx = fmaxf(mx, __shfl_xor(mx, 32));
      const bool anyv = mx > -1.0e37f;
      float mref = anyv ? mx : 0.f;
      float l = 0.f;
#pragma unroll
      for (int nt = 0; nt < 4; nt++)
#pragma unroll
        for (int i = 0; i < 16; i++) {
          float p = __builtin_amdgcn_exp2f(s[nt][i] - mref);
          s[nt][i] = p;
          l += p;
        }
      l += __shfl_xor(l, 32);
      const float inv = (anyv && l > 0.f) ? 1.f / l : 0.f;
#pragma unroll
      for (int nt = 0; nt < 4; nt++)
#pragma unroll
        for (int i = 0; i < 16; i++) s[nt][i] *= inv;
#pragma unroll
      for (int nt = 0; nt < 4; nt++)
#pragma unroll
        for (int gq = 0; gq < 4; gq++) {
          sumacc[nt * 4 + gq] += (s[nt][gq * 4] + s[nt][gq * 4 + 1]) + (s[nt][gq * 4 + 2] + s[nt][gq * 4 + 3]);
          lastacc[nt * 4 + gq] += s[nt][gq * 4 + 3];
        }
      uint4 pbv[8];
#pragma unroll
      for (int ks = 0; ks < 8; ks++) {
        const int nt = ks >> 1, hb = (ks & 1) * 8;
        pbv[ks].x = pk2(s[nt][hb + 0], s[nt][hb + 1]); pbv[ks].y = pk2(s[nt][hb + 2], s[nt][hb + 3]);
        pbv[ks].z = pk2(s[nt][hb + 4], s[nt][hb + 5]); pbv[ks].w = pk2(s[nt][hb + 6], s[nt][hb + 7]);
      }
      const float g0 = sigmoidf_(bf2f(P.proj[rowg * INC + C_GA + head]));
#pragma unroll
      for (int dt = 0; dt < 2; dt++) {
        f32x16 o;
#pragma unroll
        for (int i = 0; i < 16; i++) o[i] = 0.f;
        const int d = dt * 32 + r, sw = d & 31;
#pragma unroll
        for (int ks = 0; ks < 8; ks++) {
          uint2 lo = *(const uint2*)(smem + 16384 + d * 256 + (((ks * 4 + h) ^ sw) << 3));
          uint2 hi = *(const uint2*)(smem + 16384 + d * 256 + (((ks * 4 + 2 + h) ^ sw) << 3));
          uint4 au = make_uint4(lo.x, lo.y, hi.x, hi.y);
          o = mfma32(__builtin_bit_cast(bf16x8, au), __builtin_bit_cast(bf16x8, pbv[ks]), o);
        }
#pragma unroll
        for (int gq = 0; gq < 4; gq++) {
          int d0 = dt * 32 + 8 * gq + 4 * h;
          uint2 ov;
          ov.x = pk2(o[gq * 4 + 0] * g0, o[gq * 4 + 1] * g0);
          ov.y = pk2(o[gq * 4 + 2] * g0, o[gq * 4 + 3] * g0);
          *(uint2*)(P.ya + rowg * DM + head * 64 + d0) = ov;
        }
        __builtin_amdgcn_sched_barrier(0);
      }
    }
    float sc[16];
#pragma unroll
    for (int s = 0; s < 16; s++) {
      float prev = (s == 0) ? 0.f : lastacc[s - 1];
      float sendv = h ? prev : lastacc[s];
      float recv = __shfl_xor(sendv, 32);
      float imp = sumacc[s] + recv;
      int j = (s >> 2) * 8 + (s & 3) * 2 + h;
      int cur = qtok >> 6;
      bool forced = (j == 0) || (j == cur) || (j == cur - 1);
      bool valid = j <= cur;
      sc[s] = forced ? 1.0e4f : (valid ? imp : -1.0f);
    }
    unsigned mask = 0u;
#pragma unroll 1
    for (int rd = 0; rd < 8; rd++) {
      float best = -2.0f; int bj = 0;
#pragma unroll
      for (int s = 0; s < 16; s++) {
        int j = (s >> 2) * 8 + (s & 3) * 2 + h;
        if (sc[s] > best) { best = sc[s]; bj = j; }
      }
      float ob = __shfl_xor(best, 32);
      int oj = __shfl_xor(bj, 32);
      bool mine = (best > ob) || (best == ob && bj < oj);
      int wj = mine ? bj : oj;
      mask |= 1u << wj;
#pragma unroll
      for (int s = 0; s < 16; s++) {
        int j = (s >> 2) * 8 + (s & 3) * 2 + h;
        if (j == wj) sc[s] = -3.0f;
      }
    }
    if (h == 0) P.sel[(size_t)(bl * 2 + g) * TSEQ + qtok] = mask;
  }
}

#define ATT_GLOAD(KT)                                                                              \
  {                                                                                                \
    kreg0 = *(const uint4*)(Kg + (size_t)((KT) * 64 + lk) * ldk + lch * 8);                        \
    vreg0 = *(const uint4*)(Vtg + (size_t)lk * TSEQ + (KT) * 64 + lch * 8);                        \
    if (MODE == 0 && tid < 16) freg = *(const float4*)(F2g + (KT) * 64 + tid * 4);                 \
  }
#define ATT_SSTORE(ST)                                                                             \
  {                                                                                                \
    char* base_ = smem + (ST) * ATT_STAGE;                                                         \
    *(uint4*)(base_ + koff0) = kreg0;                                                              \
    *(uint2*)(base_ + voffa) = make_uint2(vreg0.x, vreg0.y);                                       \
    *(uint2*)(base_ + voffb) = make_uint2(vreg0.z, vreg0.w);                                       \
    if (MODE == 0 && tid < 16) *(float4*)(base_ + 16384 + tid * 16) = freg;                        \
  }

template <int MODE>
__device__ __forceinline__ void attn_pass(const u16* __restrict__ Kg, int ldk, const u16* __restrict__ Vtg,
                                          const float* __restrict__ F2g, int kt_lo, int kt_hi,
                                          const u16* __restrict__ qptr, int qtok, int qw_lo, unsigned selm,
                                          f32x16 (&o)[2], float& m, float& l, char* smem, const int tid) {
  const int lane = tid & 63, r = lane & 31, h = lane >> 5;
  const int lk = tid >> 3, lch = tid & 7;
  const float c1 = 0.125f * LOG2E;
  uint4 kreg0, vreg0;
  const int koff0 = lk * 128 + ((lch ^ ((lk >> 1) & 7)) << 4);
  const int voffa = 8192 + lk * 128 + (((2 * lch) ^ ((lk >> 1) & 15)) << 3);
  const int voffb = 8192 + lk * 128 + (((2 * lch + 1) ^ ((lk >> 1) & 15)) << 3);
  float4 freg = make_float4(0.f, 0.f, 0.f, 0.f);
  if (kt_lo >= kt_hi) return;
  const bf16x8 qf0 = ldfrag(qptr), qf1 = ldfrag(qptr + 16), qf2 = ldfrag(qptr + 32), qf3 = ldfrag(qptr + 48);
  ATT_GLOAD(kt_lo);
  ATT_SSTORE(0);
  __syncthreads();
  for (int kt = kt_lo; kt < kt_hi; kt++) {
    const int st = (kt - kt_lo) & 1;
    const bool more = (kt + 1) < kt_hi;
    if (more) ATT_GLOAD(kt + 1);
    const int kb = kt * 64;
    bool active = kb <= qw_lo + 31;
    bool selbit = true;
    if (MODE == 1) {
      selbit = (selm >> kt) & 1u;
      active = active && (__ballot(selbit) != 0ull);
    }
    if (MODE == 2) active = active && (kb + 63 + 511 >= qw_lo);
    if (active) {
      const char* sb = smem + st * ATT_STAGE;
      f32x16 s[2];
#pragma unroll
      for (int nt = 0; nt < 2; nt++) {
#pragma unroll
        for (int i = 0; i < 16; i++) s[nt][i] = 0.f;
#pragma unroll
        for (int kk = 0; kk < 4; kk++) {
          int row = nt * 32 + r;
          bf16x8 a = ldfrag(sb + row * 128 + (((kk * 2 + h) ^ ((row >> 1) & 7)) << 4));
          s[nt] = mfma32(a, kk == 0 ? qf0 : (kk == 1 ? qf1 : (kk == 2 ? qf2 : qf3)), s[nt]);
        }
      }
#pragma unroll
      for (int nt = 0; nt < 2; nt++)
#pragma unroll
        for (int gq = 0; gq < 4; gq++) {
          if (MODE == 0) {
            float4 fk = *(const float4*)(sb + 16384 + (nt * 32 + gq * 8 + h * 4) * 4);
            s[nt][gq * 4 + 0] = s[nt][gq * 4 + 0] * c1 - fk.x;
            s[nt][gq * 4 + 1] = s[nt][gq * 4 + 1] * c1 - fk.y;
            s[nt][gq * 4 + 2] = s[nt][gq * 4 + 2] * c1 - fk.z;
            s[nt][gq * 4 + 3] = s[nt][gq * 4 + 3] * c1 - fk.w;
          } else {
#pragma unroll
            for (int e = 0; e < 4; e++) s[nt][gq * 4 + e] *= c1;
          }
        }
      bool need_mask;
      if (MODE == 0) need_mask = (kb + 63 > qw_lo);
      else if (MODE == 1) need_mask = (kb + 63 > qw_lo) || (__ballot(!selbit) != 0ull);
      else need_mask = (kb + 63 > qw_lo) || (kb + 512 <= qw_lo + 31);
      if (need_mask) {
        const int td = qtok - kb - 4 * h;
#pragma unroll
        for (int nt = 0; nt < 2; nt++)
#pragma unroll
          for (int i = 0; i < 16; i++) {
            const int kc = nt * 32 + 8 * (i >> 2) + (i & 3);
            bool ok = kc <= td;
            if (MODE == 1) ok = ok && selbit;
            if (MODE == 2) ok = ok && (kc + 512 > td);
            s[nt][i] = ok ? s[nt][i] : -3.0e38f;
          }
      }
      float mx = s[0][0];
#pragma unroll
      for (int nt = 0; nt < 2; nt++)
#pragma unroll
        for (int i = 0; i < 16; i++) mx = fmaxf(mx, s[nt][i]);
      mx = fmaxf(mx, __shfl_xor(mx, 32));
      const float mn = fmaxf(m, mx);
      const float alpha = __builtin_amdgcn_exp2f(m - mn);
      float rs = 0.f;
#pragma unroll
      for (int nt = 0; nt < 2; nt++)
#pragma unroll
        for (int i = 0; i < 16; i++) {
          float p = __builtin_amdgcn_exp2f(s[nt][i] - mn);
          s[nt][i] = p;
          rs += p;
        }
      rs += __shfl_xor(rs, 32);
      l = l * alpha + rs;
      m = mn;
#pragma unroll
      for (int dt = 0; dt < 2; dt++)
#pragma unroll
        for (int i = 0; i < 16; i++) o[dt][i] *= alpha;
#pragma unroll
      for (int ks = 0; ks < 4; ks++) {
        const int nt = ks >> 1, hb = (ks & 1) * 8;
        uint4 pu;
        pu.x = pk2(s[nt][hb + 0], s[nt][hb + 1]); pu.y = pk2(s[nt][hb + 2], s[nt][hb + 3]);
        pu.z = pk2(s[nt][hb + 4], s[nt][hb + 5]); pu.w = pk2(s[nt][hb + 6], s[nt][hb + 7]);
        bf16x8 pb = __builtin_bit_cast(bf16x8, pu);
#pragma unroll
        for (int dt = 0; dt < 2; dt++) {
          int d = dt * 32 + r, sw = (d >> 1) & 15;
          uint2 lo = *(const uint2*)(sb + 8192 + d * 128 + (((ks * 4 + h) ^ sw) << 3));
          uint2 hi = *(const uint2*)(sb + 8192 + d * 128 + (((ks * 4 + 2 + h) ^ sw) << 3));
          uint4 au = make_uint4(lo.x, lo.y, hi.x, hi.y);
          o[dt] = mfma32(__builtin_bit_cast(bf16x8, au), pb, o[dt]);
        }
      }
    }
    if (more) ATT_SSTORE(st ^ 1);
    __syncthreads();
  }
}

__device__ void pc2_phase(const Params& P, int layer, int chunk, char* smem, int* s_item) {
  const int tid = opaque_tid(),  lane = tid & 63, r = lane & 31, h = lane >> 5, w = tid >> 6;
  const int perq = 2 * P.NB * 16;
  const int nItems = 8 * perq;
  unsigned* ctr = P.ctr + (chunk * 4 + layer);
  while (true) {
    __syncthreads();
    if (tid == 0) *s_item = (int)atomicAdd(ctr, 1u);
    __syncthreads();
    const int it = *s_item;
    if (it >= nItems) break;
    const int qt = 7 - it / perq;
    const int rem = it % perq;
    const int type = rem & 1;
    const int bh = rem >> 1;
    const int bl = bh >> 4, head = bh & 15;
    const int qw_lo = qt * 256 + w * 32;
    const int qtok = qw_lo + r;
    const size_t rowg = (size_t)bl * TSEQ + qtok;
    const u16* pb_ = P.proj + (size_t)bl * TSEQ * INC;
    f32x16 o[2];
#pragma unroll
    for (int dt = 0; dt < 2; dt++)
#pragma unroll
      for (int i = 0; i < 16; i++) o[dt][i] = 0.f;
    float m = -1.0e30f, l = 0.f;
    if (type == 0) {
      const u16* qf = P.proj + rowg * INC + C_QB + head * 64 + h * 8;
      attn_pass<0>(pb_ + C_KB + head * 64, INC, P.vbt + (size_t)(bl * 16 + head) * 64 * TSEQ,
                   P.F2 + (size_t)(bl * 16 + head) * TSEQ, 0, 4 * qt + 4, qf, qtok, qw_lo, 0u, o, m, l, smem, tid);
      const float inv = 1.f / l;
#pragma unroll
      for (int dt = 0; dt < 2; dt++)
#pragma unroll
        for (int gq = 0; gq < 4; gq++) {
          int d0 = dt * 32 + 8 * gq + 4 * h;
          uint2 zz = *(const uint2*)(P.proj + rowg * INC + C_ZB + head * 64 + d0);
          uint2 ov;
          ov.x = pk2(o[dt][gq * 4 + 0] * inv * siluf_(bflo(zz.x)), o[dt][gq * 4 + 1] * inv * siluf_(bfhi(zz.x)));
          ov.y = pk2(o[dt][gq * 4 + 2] * inv * siluf_(bflo(zz.y)), o[dt][gq * 4 + 3] * inv * siluf_(bfhi(zz.y)));
          *(uint2*)(P.yb + rowg * DM + head * 64 + d0) = ov;
        }
    } else {
      const int g = head >> 3;
      const u16* qf = P.proj + rowg * INC + C_QR + head * 64 + h * 8;
      const unsigned selm = P.sel[(size_t)(bl * 2 + g) * TSEQ + qtok];
      attn_pass<1>(pb_ + C_KV + 256 + g * 64, INC, P.vst + (size_t)(bl * 2 + g) * 64 * TSEQ, nullptr,
                   0, 4 * qt + 4, qf, qtok, qw_lo, selm, o, m, l, smem, tid);
      f32x16 tot[2];
      {
        const float g1 = sigmoidf_(bf2f(P.proj[rowg * INC + C_GA + 16 + head]));
        const float sc1 = g1 / l;
#pragma unroll
        for (int dt = 0; dt < 2; dt++)
#pragma unroll
          for (int i = 0; i < 16; i++) { tot[dt][i] = o[dt][i] * sc1; o[dt][i] = 0.f; }
      }
      m = -1.0e30f; l = 0.f;
      const int klo = (4 * qt - 8) > 0 ? (4 * qt - 8) : 0;
      attn_pass<2>(pb_ + C_KV + 512 + g * 64, INC, P.vwt + (size_t)(bl * 2 + g) * 64 * TSEQ, nullptr,
                   klo, 4 * qt + 4, qf, qtok, qw_lo, 0u, o, m, l, smem, tid);
      const float g2 = sigmoidf_(bf2f(P.proj[rowg * INC + C_GA + 32 + head]));
      const float sc2 = g2 / l;
#pragma unroll
      for (int dt = 0; dt < 2; dt++)
#pragma unroll
        for (int gq = 0; gq < 4; gq++) {
          int d0 = dt * 32 + 8 * gq + 4 * h;
          uint2 zz = *(const uint2*)(P.proj + rowg * INC + C_ZA + head * 64 + d0);
          uint2 oc = *(const uint2*)(P.ya + rowg * DM + head * 64 + d0);
          float v0 = (tot[dt][gq * 4 + 0] + o[dt][gq * 4 + 0] * sc2 + bflo(oc.x)) * siluf_(bflo(zz.x));
          float v1 = (tot[dt][gq * 4 + 1] + o[dt][gq * 4 + 1] * sc2 + bfhi(oc.x)) * siluf_(bfhi(zz.x));
          float v2 = (tot[dt][gq * 4 + 2] + o[dt][gq * 4 + 2] * sc2 + bflo(oc.y)) * siluf_(bflo(zz.y));
          float v3 = (tot[dt][gq * 4 + 3] + o[dt][gq * 4 + 3] * sc2 + bfhi(oc.y)) * siluf_(bfhi(zz.y));
          uint2 ov;
          ov.x = pk2(v0, v1); ov.y = pk2(v2, v3);
          *(uint2*)(P.ya + rowg * DM + head * 64 + d0) = ov;
        }
    }
  }
}

__global__ void __launch_bounds__(NTHREADS, 2) mega_kernel(Params P) {
  __shared__ __attribute__((aligned(1024))) char smem[131072];
  cg::grid_group grid = cg::this_grid();
  const int CT = P.NB * TSEQ;
  phase0(P, smem);
  grid.sync();
  for (int chunk = 0; chunk < P.nchunk; chunk++) {
    for (int layer = 0; layer < 4; layer++) {
      const float* xs = (layer == 0 ? P.x_in : P.out) + (size_t)chunk * CT * DM;
      norm_phase(xs, P.norm_g + layer * DM, P.h, CT);
      if (layer == 0 && chunk > 0) final_norm_phase(P.out, P.final_g, (chunk - 1) * CT, CT);
      grid.sync();
      gemm1_phase(P, layer, smem);
      grid.sync();
      pb_phase(P, layer, smem);
      grid.sync();
      pc1_phase(P, smem);
      grid.sync();
      pc2_phase(P, layer, chunk, smem, (int*)(smem + 40000));
      grid.sync();
      gemm2_phase(P, layer, smem);
      grid.sync();
      gemm3_phase(P, layer, chunk, smem);
      grid.sync();
    }
  }
  final_norm_phase(P.out, P.final_g, (P.nchunk - 1) * CT, CT);
}

static inline size_t al256(size_t x) { return (x + 255) & ~(size_t)255; }

extern "C" void kernel_launch(void* const* d_in, const int* in_sizes, int n_in, void* d_out, int out_size,
                              void* d_ws, size_t ws_size, hipStream_t stream) {
  (void)in_sizes; (void)n_in; (void)out_size;
  Params P{};
  P.x_in = (const float*)d_in[0]; P.norm_g = (const float*)d_in[1]; P.w_in = (const float*)d_in[2];
  P.b_forget = (const float*)d_in[3];
  P.pe_k = (const float*)d_in[4]; P.w1_k = (const float*)d_in[5]; P.w2_k = (const float*)d_in[6];
  P.pe_v = (const float*)d_in[7]; P.w1_v = (const float*)d_in[8]; P.w2_v = (const float*)d_in[9];
  P.w_pa = (const float*)d_in[10]; P.w_pb = (const float*)d_in[11]; P.w_out = (const float*)d_in[12];
  P.final_g = (const float*)d_in[13];
  P.out = (float*)d_out;
  int NB = 16;
  char* base = (char*)d_ws;
  for (;;) {
    const size_t CT = (size_t)NB * TSEQ;
    size_t off = 0;
    auto take = [&](size_t bytes) { size_t o = off; off = al256(off + bytes); return o; };
    size_t oWin = take((size_t)4 * INCP * DM * 2), oWpa = take((size_t)4 * DM * DM * 2), oWpb = take((size_t)4 * DM * DM * 2),
           oWo = take((size_t)4 * DM * DM * 2), oW1 = take((size_t)8 * 128 * 2048 * 2), oW2 = take((size_t)8 * 64 * 128 * 2),
           oB1 = take((size_t)64 * 128 * 4), oRc = take((size_t)TSEQ * 32 * 4), oRs = take((size_t)TSEQ * 32 * 4),
           oH = take(CT * DM * 2), oProj = take(CT * INC * 2 + 4096), oVbt = take(CT * DM * 2),
           oVst = take(CT * 128 * 2), oVwt = take(CT * 128 * 2), oFl = take(CT * 16 * 4), oF2 = take(CT * 16 * 4),
           oKc = take((size_t)NB * 2 * 128 * 64 * 2), oVc = take((size_t)NB * 2 * 64 * 128 * 2), oSel = take(CT * 2 * 4),
           oYa = take(CT * DM * 2), oYb = take(CT * DM * 2), oCtr = take(256);
    if (off > ws_size && NB > 1) { NB >>= 1; continue; }
    P.WinT = (u16*)(base + oWin); P.WpaT = (u16*)(base + oWpa); P.WpbT = (u16*)(base + oWpb); P.WoT = (u16*)(base + oWo);
    P.W1T = (u16*)(base + oW1); P.W2T = (u16*)(base + oW2); P.bias1p = (float*)(base + oB1);
    P.ropec = (float*)(base + oRc); P.ropes = (float*)(base + oRs);
    P.h = (u16*)(base + oH); P.proj = (u16*)(base + oProj); P.vbt = (u16*)(base + oVbt);
    P.vst = (u16*)(base + oVst); P.vwt = (u16*)(base + oVwt); P.flog = (float*)(base + oFl); P.F2 = (float*)(base + oF2);
    P.kcmp = (u16*)(base + oKc); P.vcmpt = (u16*)(base + oVc); P.sel = (unsigned*)(base + oSel);
    P.ya = (u16*)(base + oYa); P.yb = (u16*)(base + oYb); P.ctr = (unsigned*)(base + oCtr);
    break;
  }
  P.NB = NB; P.nchunk = 32 / NB;
  static int grid_blocks = 0;
  if (!grid_blocks) {
    int dev = 0, cus = 0, per_cu = 0;
    hipGetDevice(&dev);
    hipDeviceGetAttribute(&cus, hipDeviceAttributeMultiprocessorCount, dev);
    hipOccupancyMaxActiveBlocksPerMultiprocessor(&per_cu, mega_kernel, NTHREADS, 0);
    if (per_cu > 1) per_cu = 1;
    if (per_cu < 1) per_cu = 1;
    grid_blocks = cus * per_cu;
  }
  void* args[] = {&P};
  hipError_t e = hipLaunchCooperativeKernel((void*)mega_kernel, dim3(grid_blocks), dim3(NTHREADS), args, 0, stream);
  if (e != hipSuccess) fprintf(stderr, "cooperative launch failed: %s (grid %d)\n", hipGetErrorString(e), grid_blocks);
}
```

```cpp
#include <hip/hip_runtime.h>
#include <hip/hip_cooperative_groups.h>
#include <cstdio>
namespace cg = cooperative_groups;

typedef __attribute__((ext_vector_type(8))) __bf16 bf16x8;
typedef __attribute__((ext_vector_type(16))) float f32x16;
typedef __attribute__((ext_vector_type(4))) float f32x4;
typedef __attribute__((ext_vector_type(2))) float f32x2;
typedef unsigned short u16;

#define TSEQ 2048
#define DM 1024
#define INC 9024
#define INCP 9216
#define C_QA 0
#define C_KV 1024
#define C_GA 1792
#define C_ZA 1840
#define C_QB 2864
#define C_KB 3888
#define C_VB 4912
#define C_QR 4912
#define C_FB 5936
#define C_ZB 5952
#define C_RA 6976
#define C_RB 8000
#define NTHREADS 512
#define ATT_STAGE 33280
#define LOG2E 1.4426950408889634f

struct Params {
  const float* x_in; const float* norm_g; const float* w_in; const float* b_forget;
  const float* pe_k; const float* w1_k; const float* w2_k;
  const float* pe_v; const float* w1_v; const float* w2_v;
  const float* w_pa; const float* w_pb; const float* w_out; const float* final_g;
  float* out;
  u16* WinT; u16* WpaT; u16* WpbT; u16* WoT; u16* W1T; u16* W2T;
  float* bias1p; float* ropec; float* ropes;
  u16* h; u16* proj; u16* vbt; u16* vst; u16* vwt;
  float* flog; float* F2; u16* kcmp; u16* vcmpt; unsigned* sel;
  u16* ya; u16* yb; unsigned* ctr;
  int NB; int nchunk;
};

__device__ __forceinline__ unsigned pk2(float a, float b) {
  typedef __attribute__((ext_vector_type(2))) float f2_t;
  typedef __attribute__((ext_vector_type(2))) __bf16 b2_t;
  f2_t v = {a, b};
  b2_t r = __builtin_convertvector(v, b2_t);
  return __builtin_bit_cast(unsigned, r);
}
__device__ __forceinline__ u16 f2bf(float a) { return (u16)(pk2(a, 0.f) & 0xffffu); }
__device__ __forceinline__ float bf2f(u16 u) { return __uint_as_float(((unsigned)u) << 16); }
__device__ __forceinline__ float bflo(unsigned u) { return __uint_as_float(u << 16); }
__device__ __forceinline__ float bfhi(unsigned u) { return __uint_as_float(u & 0xffff0000u); }
__device__ __forceinline__ float sigmoidf_(float x) { return 1.f / (1.f + __expf(-x)); }
__device__ __forceinline__ float siluf_(float x) { return x / (1.f + __expf(-x)); }
__device__ __forceinline__ f32x16 mfma32(bf16x8 a, bf16x8 b, f32x16 c) {
  return __builtin_amdgcn_mfma_f32_32x32x16_bf16(a, b, c, 0, 0, 0);
}
__device__ __forceinline__ int opaque_tid() { int t = threadIdx.x; asm volatile("" : "+v"(t)); return t; }
__device__ __forceinline__ bf16x8 ldfrag(const void* p) {
  return __builtin_bit_cast(bf16x8, *(const uint4*)p);
}

__device__ void transpose_tile(const float* __restrict__ src, u16* __restrict__ dst, int K, int N,
                               int k0, int n0, float* tile, const int tid) {
#pragma unroll
  for (int j = 0; j < 2; j++) {
    int r = (tid >> 4) + 32 * j, c4 = (tid & 15) * 4;
    float4 v = *(const float4*)(src + (size_t)(k0 + r) * N + n0 + c4);
    tile[r * 65 + c4] = v.x; tile[r * 65 + c4 + 1] = v.y; tile[r * 65 + c4 + 2] = v.z; tile[r * 65 + c4 + 3] = v.w;
  }
  __syncthreads();
  {
    int c = tid, n = c >> 3, kc = c & 7;
    const float* tp = tile + (kc * 8) * 65 + n;
    uint4 o;
    o.x = pk2(tp[0], tp[65]); o.y = pk2(tp[130], tp[195]); o.z = pk2(tp[260], tp[325]); o.w = pk2(tp[390], tp[455]);
    *(uint4*)(dst + (size_t)(n0 + n) * K + k0 + kc * 8) = o;
  }
  __syncthreads();
}

__device__ void phase0(const Params& P, char* smem) {
  const int tid = opaque_tid();
  float* tile = (float*)smem;
  const int n0_ = 4 * 16 * 141, n1_ = 4 * 16 * 16, n2_ = 4 * 32 * 2, n3_ = 4 * 2 * 1;
  const int nT = n0_ + 3 * n1_ + 2 * n2_ + 2 * n3_;
  const int nBias = 64, nRope = 128;
  const int total = nT + nBias + nRope + 1;
  for (int it = blockIdx.x; it < total; it += gridDim.x) {
    if (it < nT) {
      int t = it;
      if (t < n0_) {
        int l = t / (16 * 141), rem = t % (16 * 141);
        transpose_tile(P.w_in + (size_t)l * DM * INC, P.WinT + (size_t)l * INCP * DM, DM, INC, (rem / 141) * 64, (rem % 141) * 64, tile, tid);
        continue;
      }
      t -= n0_;
      if (t < 3 * n1_) {
        int which = t / n1_; t %= n1_;
        int l = t / 256, rem = t % 256;
        const float* s = which == 0 ? P.w_pa : (which == 1 ? P.w_pb : P.w_out);
        u16* d = which == 0 ? P.WpaT : (which == 1 ? P.WpbT : P.WoT);
        transpose_tile(s + (size_t)l * DM * DM, d + (size_t)l * DM * DM, DM, DM, (rem >> 4) * 64, (rem & 15) * 64, tile, tid);
        continue;
      }
      t -= 3 * n1_;
      if (t < 2 * n2_) {
        int kv = t / n2_; t %= n2_;
        int l = t / 64, rem = t % 64;
        const float* s = kv ? P.w1_v : P.w1_k;
        transpose_tile(s + (size_t)l * 2048 * 128, P.W1T + (size_t)(l * 2 + kv) * 128 * 2048, 2048, 128, (rem >> 1) * 64, (rem & 1) * 64, tile, tid);
        continue;
      }
      t -= 2 * n2_;
      {
        int kv = t / n3_; t %= n3_;
        int l = t / 2, rem = t % 2;
        const float* s = kv ? P.w2_v : P.w2_k;
        transpose_tile(s + (size_t)l * 128 * 64, P.W2T + (size_t)(l * 2 + kv) * 64 * 128, 128, 64, rem * 64, 0, tile, tid);
      }
    } else if (it < nT + nBias) {
      int j = it - nT;
      int l = j >> 4, kv = (j >> 3) & 1, kq = j & 7;
      const float* pe = (kv ? P.pe_v : P.pe_k) + (size_t)l * 2048;
      const float* w1 = (kv ? P.w1_v : P.w1_k) + (size_t)l * 2048 * 128;
      int hid = tid & 127, kh = tid >> 7;
      int kbeg = kq * 256 + kh * 64;
      float s = 0.f;
#pragma unroll 8
      for (int k = 0; k < 64; k++) s += pe[kbeg + k] * w1[(size_t)(kbeg + k) * 128 + hid];
      float* part = (float*)smem;
      part[tid] = s;
      __syncthreads();
      if (tid < 128) P.bias1p[((l * 2 + kv) * 8 + kq) * 128 + hid] = (part[tid] + part[tid + 128]) + (part[tid + 256] + part[tid + 384]);
      __syncthreads();
    } else if (it < nT + nBias + nRope) {
      int idx = (it - nT - nBias) * 512 + tid;
      int t = idx >> 5, j = idx & 31;
      double inv = 1.0;
      for (int q = 0; q < j; q++) inv *= 0.7498942093324558;
      float invf = (float)inv;
      float angf = (float)t * invf;
      double a = (double)angf;
      double kq = rint(a * 0.15915494309189535);
      double rr = a - kq * 6.283185307179586;
      double r2 = rr * rr;
      double sterm = rr, cterm = 1.0, ssum = rr, csum = 1.0;
#pragma unroll 1
      for (int n = 1; n <= 15; n++) {
        cterm *= -r2 / (double)((2 * n - 1) * (2 * n));
        sterm *= -r2 / (double)((2 * n) * (2 * n + 1));
        csum += cterm; ssum += sterm;
      }
      P.ropec[idx] = (float)csum;
      P.ropes[idx] = (float)ssum;
    } else {
      if (tid < 64) P.ctr[tid] = 0u;
    }
  }
}

__device__ void norm_phase(const float* __restrict__ xsrc, const float* __restrict__ g, u16* __restrict__ hdst, int nrows) {
  const int tid = opaque_tid();
  const int lane = tid & 63;
  const int gw = blockIdx.x * 8 + (tid >> 6), nw = gridDim.x * 8;
  float4 gv[4];
#pragma unroll
  for (int j = 0; j < 4; j++) gv[j] = *(const float4*)(g + lane * 4 + 256 * j);
  for (int row = gw; row < nrows; row += nw) {
    const float* xr = xsrc + (size_t)row * DM;
    float4 v[4];
    float ss = 0.f;
#pragma unroll
    for (int j = 0; j < 4; j++) {
      v[j] = *(const float4*)(xr + lane * 4 + 256 * j);
      ss += v[j].x * v[j].x + v[j].y * v[j].y + v[j].z * v[j].z + v[j].w * v[j].w;
    }
#pragma unroll
    for (int o = 32; o >= 1; o >>= 1) ss += __shfl_xor(ss, o);
    float rstd = rsqrtf(ss * (1.f / DM) + 1e-6f);
#pragma unroll
    for (int j = 0; j < 4; j++) {
      uint2 o;
      o.x = pk2(v[j].x * rstd * gv[j].x, v[j].y * rstd * gv[j].y);
      o.y = pk2(v[j].z * rstd * gv[j].z, v[j].w * rstd * gv[j].w);
      *(uint2*)(hdst + (size_t)row * DM + lane * 4 + 256 * j) = o;
    }
  }
}

__device__ void final_norm_phase(float* __restrict__ x, const float* __restrict__ g, int row0, int nrows) {
  const int tid = opaque_tid();
  const int lane = tid & 63;
  const int gw = blockIdx.x * 8 + (tid >> 6), nw = gridDim.x * 8;
  float4 gv[4];
#pragma unroll
  for (int j = 0; j < 4; j++) gv[j] = *(const float4*)(g + lane * 4 + 256 * j);
  for (int row = gw; row < nrows; row += nw) {
    float* xr = x + (size_t)(row0 + row) * DM;
    float4 v[4];
    float ss = 0.f;
#pragma unroll
    for (int j = 0; j < 4; j++) {
      v[j] = *(const float4*)(xr + lane * 4 + 256 * j);
      ss += v[j].x * v[j].x + v[j].y * v[j].y + v[j].z * v[j].z + v[j].w * v[j].w;
    }
#pragma unroll
    for (int o = 32; o >= 1; o >>= 1) ss += __shfl_xor(ss, o);
    float rstd = rsqrtf(ss * (1.f / DM) + 1e-6f);
#pragma unroll
    for (int j = 0; j < 4; j++) {
      float4 o;
      o.x = v[j].x * rstd * gv[j].x; o.y = v[j].y * rstd * gv[j].y;
      o.z = v[j].z * rstd * gv[j].z; o.w = v[j].w * rstd * gv[j].w;
      *(float4*)(xr + lane * 4 + 256 * j) = o;
    }
  }
}

struct ARow {
  const u16* p; int ld;
  __device__ __forceinline__ const u16* operator()(int row, int k) const { return p + (size_t)row * ld + k; }
};
struct ACmp {
  const u16* p;
  __device__ __forceinline__ const u16* operator()(int row, int k) const {
    int t = 16 * row + (k >> 6); t = t > (TSEQ - 1) ? (TSEQ - 1) : t;
    return p + (size_t)t * INC + (k & 63);
  }
};

template <class AF>
__device__ __forceinline__ void gemm_mainloop(AF af, const u16* __restrict__ Bt, int ldb, int K, char* smem,
                                              f32x16 (&acc)[2][2], const int tid) {
  const int lane = tid & 63, r = lane & 31, h = lane >> 5, w = tid >> 6;
  const int wm = w >> 1, wn = w & 1;
  const int lrow = tid >> 3, lch = tid & 7;
  uint4 ra[4], rb[4];
  const int nk = K >> 6;
#pragma unroll
  for (int j = 0; j < 4; j++) {
    int row = lrow + 32 * j;
    ra[j] = *(const uint4*)af(row, lch * 8);
    rb[j] = *(const uint4*)(Bt + (size_t)row * ldb + lch * 8);
  }
#pragma unroll
  for (int j = 0; j < 4; j++) {
    int row = lrow + 32 * j;
    int off = row * 128 + ((lch ^ ((row >> 1) & 7)) << 4);
    *(uint4*)(smem + off) = ra[j];
    *(uint4*)(smem + 16384 + off) = rb[j];
  }
  __syncthreads();
  for (int it = 0; it < nk; it++) {
    const bool more = (it + 1) < nk;
    if (more) {
      const int k0 = (it + 1) * 64;
#pragma unroll
      for (int j = 0; j < 4; j++) {
        int row = lrow + 32 * j;
        ra[j] = *(const uint4*)af(row, k0 + lch * 8);
        rb[j] = *(const uint4*)(Bt + (size_t)row * ldb + k0 + lch * 8);
      }
    }
    const char* sa = smem + (it & 1) * 32768;
    const char* sb = sa + 16384;
#pragma unroll
    for (int kk = 0; kk < 4; kk++) {
      bf16x8 a[2], b[2];
#pragma unroll
      for (int mi = 0; mi < 2; mi++) {
        int row = wm * 64 + mi * 32 + r;
        a[mi] = ldfrag(sa + row * 128 + (((kk * 2 + h) ^ ((row >> 1) & 7)) << 4));
      }
#pragma unroll
      for (int ni = 0; ni < 2; ni++) {
        int row = wn * 64 + ni * 32 + r;
        b[ni] = ldfrag(sb + row * 128 + (((kk * 2 + h) ^ ((row >> 1) & 7)) << 4));
      }
#pragma unroll
      for (int mi = 0; mi < 2; mi++)
#pragma unroll
        for (int ni = 0; ni < 2; ni++) acc[mi][ni] = mfma32(a[mi], b[ni], acc[mi][ni]);
    }
    if (more) {
      char* sd = smem + ((it + 1) & 1) * 32768;
#pragma unroll
      for (int j = 0; j < 4; j++) {
        int row = lrow + 32 * j;
        int off = row * 128 + ((lch ^ ((row >> 1) & 7)) << 4);
        *(uint4*)(sd + off) = ra[j];
        *(uint4*)(sd + 16384 + off) = rb[j];
      }
    }
    __syncthreads();
  }
}

__device__ __forceinline__ void zero_acc(f32x16 (&acc)[2][2]) {
#pragma unroll
  for (int a = 0; a < 2; a++)
#pragma unroll
    for (int b = 0; b < 2; b++)
#pragma unroll
      for (int i = 0; i < 16; i++) acc[a][b][i] = 0.f;
}

typedef __attribute__((ext_vector_type(8))) short s16x8;
#define G_TILE_B 32768
#define G_STAGE_B 65536
__device__ __forceinline__ int g_lds_byte(int r, int c) {
  int st = (r >> 4) * 2 + (c >> 5), ob = (r & 15) * 64 + (c & 31) * 2;
  return st * 1024 + (ob ^ (((ob >> 9) & 1) << 5));
}
__device__ __forceinline__ void g_stage_rc(int b, int& R, int& C) {
  int st = b >> 10, sb = b & 1023, swz = sb ^ (((sb >> 9) & 1) << 5);
  R = (st >> 1) * 16 + swz / 64;
  C = (st & 1) * 32 + (swz % 64) / 2;
}
#define G_WAIT_V0() asm volatile("s_waitcnt vmcnt(0)" ::: "memory")

struct GTile { int pm, pn; };
__device__ __forceinline__ bool g_next(int i, int G, int c, int nM, int nN, GTile& u) {
  const int nwg = nM * nN;
  const long L = (long)i * G + c;
  if (L >= nwg) return false;
  int wgid = (int)L;
  { const int q = nwg / 8, r = nwg % 8, xcd = wgid % 8, off = wgid / 8; wgid = (xcd < r ? xcd * (q + 1) : r * (q + 1) + (xcd - r) * q) + off; }
  const int nig = 8 * nN, gid = wgid / nig, fm = gid * 8, gsz = (nM - fm) < 8 ? (nM - fm) : 8;
  u.pm = fm + ((wgid % nig) % gsz);
  u.pn = (wgid % nig) / gsz;
  return true;
}

__device__ __forceinline__ void g_kloop(const u16* __restrict__ Ab, const u16* __restrict__ Bb, const int K, char* smem,
                                        f32x4 (&acc)[8][4], const int tid) {
  const int wid = tid >> 6, lane = tid & 63, wr = wid >> 2, wc = wid & 3, fr = lane & 15, fq = lane >> 4;
  int sR0, sC0, sR1, sC1, sR2, sC2, sR3, sC3;
  g_stage_rc(wid * 1024 + 0 * 8192 + lane * 16, sR0, sC0);
  g_stage_rc(wid * 1024 + 1 * 8192 + lane * 16, sR1, sC1);
  g_stage_rc(wid * 1024 + 2 * 8192 + lane * 16, sR2, sC2);
  g_stage_rc(wid * 1024 + 3 * 8192 + lane * 16, sR3, sC3);
  const long o0 = (long)sR0 * K + sC0, o1 = (long)sR1 * K + sC1, o2 = (long)sR2 * K + sC2, o3 = (long)sR3 * K + sC3;
#define G_STAGE(buf, kt)                                                                                              \
  {                                                                                                                  \
    char* sa_ = smem + (buf) * G_STAGE_B + wid * 1024;                                                               \
    char* sb_ = sa_ + G_TILE_B;                                                                                      \
    const u16* ga_ = Ab + (kt) * 64;                                                                                 \
    const u16* gb_ = Bb + (kt) * 64;                                                                                 \
    __builtin_amdgcn_global_load_lds((const unsigned*)(ga_ + o0), (unsigned*)(sa_), 16, 0, 0);                       \
    __builtin_amdgcn_global_load_lds((const unsigned*)(gb_ + o0), (unsigned*)(sb_), 16, 0, 0);                       \
    __builtin_amdgcn_global_load_lds((const unsigned*)(ga_ + o1), (unsigned*)(sa_ + 8192), 16, 0, 0);                \
    __builtin_amdgcn_global_load_lds((const unsigned*)(gb_ + o1), (unsigned*)(sb_ + 8192), 16, 0, 0);                \
    __builtin_amdgcn_global_load_lds((const unsigned*)(ga_ + o2), (unsigned*)(sa_ + 16384), 16, 0, 0);               \
    __builtin_amdgcn_global_load_lds((const unsigned*)(gb_ + o2), (unsigned*)(sb_ + 16384), 16, 0, 0);               \
    __builtin_amdgcn_global_load_lds((const unsigned*)(ga_ + o3), (unsigned*)(sa_ + 24576), 16, 0, 0);               \
    __builtin_amdgcn_global_load_lds((const unsigned*)(gb_ + o3), (unsigned*)(sb_ + 24576), 16, 0, 0);               \
  }
  const int nt = K >> 6;
  G_STAGE(0, 0);
  G_WAIT_V0();
  __syncthreads();
  for (int t = 0; t < nt; ++t) {
    const int cur = t & 1;
    if (t + 1 < nt) G_STAGE(cur ^ 1, t + 1);
    const char* sa = smem + cur * G_STAGE_B;
    const char* sb = sa + G_TILE_B;
#pragma unroll
    for (int ks = 0; ks < 2; ++ks) {
      s16x8 At[8], Bf[4];
#pragma unroll
      for (int m = 0; m < 8; ++m) At[m] = *(const s16x8*)(sa + g_lds_byte(wr * 128 + m * 16 + fr, ks * 32 + fq * 8));
#pragma unroll
      for (int n = 0; n < 4; ++n) Bf[n] = *(const s16x8*)(sb + g_lds_byte(wc * 64 + n * 16 + fr, ks * 32 + fq * 8));
#pragma unroll
      for (int m = 0; m < 8; ++m)
#pragma unroll
        for (int n = 0; n < 4; ++n)
          acc[m][n] = __builtin_amdgcn_mfma_f32_16x16x32_bf16(__builtin_bit_cast(bf16x8, Bf[n]), __builtin_bit_cast(bf16x8, At[m]), acc[m][n], 0, 0, 0);
      __builtin_amdgcn_sched_barrier(0);
    }
    G_WAIT_V0();
    __syncthreads();
  }
}

__device__ __forceinline__ void g_zero(f32x4 (&acc)[8][4]) {
#pragma unroll
  for (int m = 0; m < 8; m++)
#pragma unroll
    for (int n = 0; n < 4; n++) acc[m][n] = (f32x4){0.f, 0.f, 0.f, 0.f};
}
__device__ __forceinline__ uint2 pk4(f32x4 v) { return make_uint2(pk2(v[0], v[1]), pk2(v[2], v[3])); }

__device__ __forceinline__ void wave_store_rows(char* wsm, u16* gbase, const size_t ld, const f32x4 (&acc)[8][4], const int lane) {
  const int fr = lane & 15, fq = lane >> 4;
#pragma unroll
  for (int m = 0; m < 8; m++)
#pragma unroll
    for (int n = 0; n < 4; n++) {
      const int row = m * 16 + fr, chunk = n * 2 + (fq >> 1);
      *(uint2*)(wsm + row * 128 + ((chunk ^ (fr & 7)) << 4) + (fq & 1) * 8) = pk4(acc[m][n]);
    }
  const int rr = lane >> 3, ch = lane & 7;
#pragma unroll
  for (int i = 0; i < 16; i++) {
    const int row = i * 8 + rr;
    const uint4 v = *(const uint4*)(wsm + row * 128 + ((ch ^ (row & 7)) << 4));
    typedef __attribute__((ext_vector_type(4))) unsigned u32x4_t;
    __builtin_nontemporal_store(__builtin_bit_cast(u32x4_t, v), (u32x4_t*)(gbase + (size_t)row * ld + ch * 8));
  }
}
__device__ __forceinline__ void wave_store_cols(char* wsm, u16* vt, const int vcol0, const int nh, const int bl, const int t0,
                                                const f32x4 (&acc)[8][4], const int lane) {
  const int fr = lane & 15, fq = lane >> 4;
#pragma unroll
  for (int m = 0; m < 8; m++)
#pragma unroll
    for (int n = 0; n < 4; n++)
#pragma unroll
      for (int j = 0; j < 4; j++) {
        const int d = n * 16 + fq * 4 + j, t = m * 16 + fr;
        *(u16*)(wsm + d * 256 + (((t >> 3) ^ (d & 15)) << 4) + (t & 7) * 2) = f2bf(acc[m][n][j]);
      }
  const int dd = lane >> 4, ch = lane & 15;
#pragma unroll
  for (int i = 0; i < 16; i++) {
    const int d = i * 4 + dd;
    const uint4 v = *(const uint4*)(wsm + d * 256 + ((ch ^ (d & 15)) << 4));
    const int vcol = vcol0 + d;
    *(uint4*)(vt + ((size_t)(bl * nh + (vcol >> 6)) * 64 + (vcol & 63)) * TSEQ + t0 + ch * 8) = v;
  }
}

__device__ void gemm1_phase(const Params& P, int layer, char* smem) {
  const int CT = P.NB * TSEQ;
  const int nM = CT >> 8, nN = INCP >> 8;
  const u16* Bt = P.WinT + (size_t)layer * INCP * DM;
  u16* p_vbt = P.vbt; u16* p_vst = P.vst; u16* p_vwt = P.vwt;
  asm volatile("" : "+s"(p_vbt), "+s"(p_vst), "+s"(p_vwt));
  for (int i = 0;; i++) {
    GTile u;
    if (!g_next(i, gridDim.x, blockIdx.x, nM, nN, u)) break;
    const int tid = opaque_tid(), wid = tid >> 6, lane = tid & 63, wr = wid >> 2, wc = wid & 3, fr = lane & 15, fq = lane >> 4;
    f32x4 acc[8][4];
    g_zero(acc);
    g_kloop(P.h + (size_t)(u.pm * 256) * DM, Bt + (size_t)(u.pn * 256) * DM, DM, smem, acc, tid);
    const int cw = u.pn * 256 + wc * 64;
    const int row0 = u.pm * 256 + wr * 128 + fr;
    char* wsm = smem + wid * 16384;
    const int rowb = u.pm * 256 + wr * 128;
    const bool rope_q = cw < 1024;
    const bool rope_k = (cw >= C_KV + 256 && cw < C_KV + 384) || (cw >= C_KV + 512 && cw < C_KV + 640);
    const bool mixed = (cw == 4864) || (cw == 5888);
    const bool pure_vb = (cw >= 4928 && cw < 5888);
    const bool pure_vs = (cw >= C_KV + 384 && cw < C_KV + 512);
    const bool pure_vw = (cw >= C_KV + 640 && cw < C_KV + 768);
    if (cw >= INC) {
    } else if (rope_q || rope_k) {
      if (rope_q) wave_store_rows(wsm, P.proj + (size_t)rowb * INC + cw, INC, acc, lane);
#pragma unroll
      for (int m = 0; m < 8; m++) {
        const int tt = (row0 + m * 16) & (TSEQ - 1);
#pragma unroll
        for (int n = 0; n < 2; n++) {
          const float4 c = *(const float4*)(P.ropec + tt * 32 + n * 16 + fq * 4);
          const float4 sn = *(const float4*)(P.ropes + tt * 32 + n * 16 + fq * 4);
          const f32x4 x1 = acc[m][n], x2 = acc[m][n + 2];
          f32x4 r1, r2;
          r1[0] = x1[0] * c.x - x2[0] * sn.x; r2[0] = x2[0] * c.x + x1[0] * sn.x;
          r1[1] = x1[1] * c.y - x2[1] * sn.y; r2[1] = x2[1] * c.y + x1[1] * sn.y;
          r1[2] = x1[2] * c.z - x2[2] * sn.z; r2[2] = x2[2] * c.z + x1[2] * sn.z;
          r1[3] = x1[3] * c.w - x2[3] * sn.w; r2[3] = x2[3] * c.w + x1[3] * sn.w;
          acc[m][n] = r1; acc[m][n + 2] = r2;
        }
      }
      wave_store_rows(wsm, P.proj + (size_t)rowb * INC + (rope_q ? C_QR : 0) + cw, INC, acc, lane);
    } else if (pure_vb || pure_vs || pure_vw) {
      u16* vt = pure_vb ? p_vbt : (pure_vs ? p_vst : p_vwt);
      const int vcol0 = pure_vb ? (cw - C_VB) : (pure_vs ? (cw - (C_KV + 384)) : (cw - (C_KV + 640)));
      wave_store_cols(wsm, vt, vcol0, pure_vb ? 16 : 2, rowb >> 11, rowb & (TSEQ - 1), acc, lane);
    } else if (!mixed) {
      wave_store_rows(wsm, P.proj + (size_t)rowb * INC + cw, INC, acc, lane);
    } else {
#pragma unroll
      for (int n = 0; n < 4; n++) {
        const int c0 = cw + n * 16 + fq * 4;
        int kind = 0;
        if (c0 >= C_VB && c0 < C_FB) kind = 1;
        else if (c0 >= C_FB && c0 < C_ZB) kind = 2;
        const int vcol = c0 - C_VB;
        if (kind == 0) {
#pragma unroll
          for (int m = 0; m < 8; m++) *(uint2*)(P.proj + (size_t)(row0 + m * 16) * INC + c0) = pk4(acc[m][n]);
        } else if (kind == 1) {
#pragma unroll
          for (int m = 0; m < 8; m++) {
            const int row = row0 + m * 16;
            const int bl = row >> 11, tt = row & (TSEQ - 1);
            u16* vp = p_vbt + ((size_t)(bl * 16 + (vcol >> 6)) * 64 + (vcol & 63)) * TSEQ + tt;
            vp[0] = f2bf(acc[m][n][0]); vp[TSEQ] = f2bf(acc[m][n][1]);
            vp[2 * TSEQ] = f2bf(acc[m][n][2]); vp[3 * TSEQ] = f2bf(acc[m][n][3]);
          }
        } else {
#pragma unroll
          for (int m = 0; m < 8; m++)
            *(float4*)(P.flog + (size_t)(row0 + m * 16) * 16 + (c0 - C_FB)) = make_float4(acc[m][n][0], acc[m][n][1], acc[m][n][2], acc[m][n][3]);
        }
        __builtin_amdgcn_sched_barrier(0);
      }
    }
    __syncthreads();
  }
}

__device__ void gemm2_phase(const Params& P, int layer, char* smem) {
  const int CT = P.NB * TSEQ;
  const int nM = CT >> 8, nN = 4;
  const u16* p_ya = P.ya; const u16* p_yb = P.yb; const u16* p_wa = P.WpaT; const u16* p_wb = P.WpbT;
  for (int i = 0;; i++) {
    GTile u;
    if (!g_next(i, gridDim.x, blockIdx.x, nM, nN, u)) break;
    const int tid = opaque_tid(), wid = tid >> 6, lane = tid & 63, wr = wid >> 2, wc = wid & 3, fr = lane & 15, fq = lane >> 4;
    f32x4 acc[8][4];
    g_zero(acc);
#pragma unroll 1
    for (int pass = 0; pass < 2; pass++) {
      const u16* Ap = (pass ? p_yb : p_ya) + (size_t)(u.pm * 256) * DM;
      const u16* Bp = (pass ? p_wb : p_wa) + (size_t)layer * DM * DM + (size_t)(u.pn * 256) * DM;
      g_kloop(Ap, Bp, DM, smem, acc, tid);
      __builtin_amdgcn_sched_barrier(0);
      if (pass == 0) {
        const int tid1 = opaque_tid(), wid1 = tid1 >> 6, lane1 = tid1 & 63, wr1 = wid1 >> 2, wc1 = wid1 & 3, fr1 = lane1 & 15, fq1 = lane1 >> 4;
        const u16* pp = P.proj + (size_t)(u.pm * 256 + wr1 * 128 + fr1) * INC + u.pn * 256 + wc1 * 64 + fq1 * 4;
#pragma unroll
        for (int m = 0; m < 8; m++) {
#pragma unroll
          for (int n = 0; n < 4; n++) {
            const uint2 ra = *(const uint2*)(pp + (size_t)(m * 16) * INC + C_RA + n * 16);
            const uint2 rb = *(const uint2*)(pp + (size_t)(m * 16) * INC + C_RB + n * 16);
            acc[m][n][0] *= (1.f + __expf(-bflo(rb.x))) / (1.f + __expf(-bflo(ra.x)));
            acc[m][n][1] *= (1.f + __expf(-bfhi(rb.x))) / (1.f + __expf(-bfhi(ra.x)));
            acc[m][n][2] *= (1.f + __expf(-bflo(rb.y))) / (1.f + __expf(-bflo(ra.y)));
            acc[m][n][3] *= (1.f + __expf(-bfhi(rb.y))) / (1.f + __expf(-bfhi(ra.y)));
          }
          __builtin_amdgcn_sched_barrier(0);
        }
      }
    }
    {
      const int tid2 = opaque_tid(), wid2 = tid2 >> 6, lane2 = tid2 & 63, wr2 = wid2 >> 2, wc2 = wid2 & 3, fr2 = lane2 & 15, fq2 = lane2 >> 4;
      const u16* pp = P.proj + (size_t)(u.pm * 256 + wr2 * 128 + fr2) * INC + u.pn * 256 + wc2 * 64 + fq2 * 4;
#pragma unroll
      for (int m = 0; m < 8; m++) {
#pragma unroll
        for (int n = 0; n < 4; n++) {
          const uint2 rb = *(const uint2*)(pp + (size_t)(m * 16) * INC + C_RB + n * 16);
          acc[m][n][0] *= sigmoidf_(bflo(rb.x)); acc[m][n][1] *= sigmoidf_(bfhi(rb.x));
          acc[m][n][2] *= sigmoidf_(bflo(rb.y)); acc[m][n][3] *= sigmoidf_(bfhi(rb.y));
        }
        __builtin_amdgcn_sched_barrier(0);
      }
      wave_store_rows(smem + wid2 * 16384, P.h + (size_t)(u.pm * 256 + wr2 * 128) * DM + u.pn * 256 + wc2 * 64, DM, acc, lane2);
    }
    __syncthreads();
  }
}

__device__ void gemm3_phase(const Params& P, int layer, int chunk, char* smem) {
  const int CT = P.NB * TSEQ;
  const int nM = CT >> 8, nN = 4;
  const float* xs = (layer == 0 ? P.x_in : P.out) + (size_t)chunk * CT * DM;
  float* xd = P.out + (size_t)chunk * CT * DM;
  for (int i = 0;; i++) {
    GTile u;
    if (!g_next(i, gridDim.x, blockIdx.x, nM, nN, u)) break;
    const int tid = opaque_tid(), wid = tid >> 6, lane = tid & 63, wr = wid >> 2, wc = wid & 3, fr = lane & 15, fq = lane >> 4;
    f32x4 acc[8][4];
    g_zero(acc);
    g_kloop(P.h + (size_t)(u.pm * 256) * DM, P.WoT + (size_t)layer * DM * DM + (size_t)(u.pn * 256) * DM, DM, smem, acc, tid);
    const size_t off = (size_t)(u.pm * 256 + wr * 128 + fr) * DM + u.pn * 256 + wc * 64 + fq * 4;
#pragma unroll
    for (int m = 0; m < 8; m++) {
#pragma unroll
      for (int n = 0; n < 4; n++) {
        const float4 xo = *(const float4*)(xs + off + (size_t)(m * 16) * DM + n * 16);
        *(float4*)(xd + off + (size_t)(m * 16) * DM + n * 16) =
            make_float4(xo.x + acc[m][n][0], xo.y + acc[m][n][1], xo.z + acc[m][n][2], xo.w + acc[m][n][3]);
      }
      __builtin_amdgcn_sched_barrier(0);
    }
  }
}

__device__ void pb_phase(const Params& P, int layer, char* smem_all) {
  const int tid_all = opaque_tid();
  const int half = tid_all >> 8, tid = tid_all & 255;
  char* smem = smem_all + half * 65536;
  const int lane = tid & 63, r = lane & 31, h = lane >> 5, w = tid >> 6;
  const int wm = w >> 1, wn = w & 1;
  const int nCmp = P.NB * 2;
  const int nScan = P.NB * 2;
  for (int it = blockIdx.x; it < nCmp + nScan; it += gridDim.x) {
    if (it < nCmp) {
      const int unit = it * 2 + half;
      const int bl = unit >> 2, g = (unit >> 1) & 1, kv = unit & 1;
      f32x16 acc[2][2];
      zero_acc(acc);
      ACmp af{P.proj + (size_t)bl * TSEQ * INC + C_KV + kv * 128 + g * 64};
      gemm_mainloop(af, P.W1T + (size_t)(layer * 2 + kv) * 128 * 2048, 2048, 2048, smem, acc, tid);
      const float* bp = P.bias1p + (size_t)((layer * 2 + kv) * 8) * 128;
#pragma unroll
      for (int ni = 0; ni < 2; ni++) {
        int hc = wn * 64 + ni * 32 + r;
        float b1 = 0.f;
#pragma unroll
        for (int q = 0; q < 8; q++) b1 += bp[q * 128 + hc];
#pragma unroll
        for (int mi = 0; mi < 2; mi++)
#pragma unroll
          for (int i = 0; i < 16; i++) {
            int n = wm * 64 + mi * 32 + 8 * (i >> 2) + 4 * h + (i & 3);
            float v = siluf_(acc[mi][ni][i] + b1);
            *(u16*)(smem + n * 256 + (((hc >> 3) ^ (n & 15)) << 4) + (hc & 7) * 2) = f2bf(v);
          }
      }
      __syncthreads();
      const u16* w2t = P.W2T + (size_t)(layer * 2 + kv) * 64 * 128;
      f32x16 o2[2];
#pragma unroll
      for (int dt = 0; dt < 2; dt++)
#pragma unroll
        for (int i = 0; i < 16; i++) o2[dt][i] = 0.f;
#pragma unroll
      for (int kk = 0; kk < 8; kk++) {
        int n = w * 32 + r;
        bf16x8 a = ldfrag(smem + n * 256 + (((kk * 2 + h) ^ (n & 15)) << 4));
#pragma unroll
        for (int dt = 0; dt < 2; dt++) {
          bf16x8 b = ldfrag(w2t + (size_t)(dt * 32 + r) * 128 + kk * 16 + h * 8);
          o2[dt] = mfma32(a, b, o2[dt]);
        }
      }
#pragma unroll
      for (int dt = 0; dt < 2; dt++) {
        int d = dt * 32 + r;
        if (kv == 0) {
#pragma unroll
          for (int i = 0; i < 16; i++) {
            int n = w * 32 + 8 * (i >> 2) + 4 * h + (i & 3);
            P.kcmp[((size_t)(bl * 2 + g) * 128 + n) * 64 + d] = f2bf(o2[dt][i]);
          }
        } else {
#pragma unroll
          for (int gq = 0; gq < 4; gq++) {
            int n0 = w * 32 + 8 * gq + 4 * h;
            uint2 o;
            o.x = pk2(o2[dt][gq * 4 + 0], o2[dt][gq * 4 + 1]);
            o.y = pk2(o2[dt][gq * 4 + 2], o2[dt][gq * 4 + 3]);
            *(uint2*)(P.vcmpt + ((size_t)(bl * 2 + g) * 64 + d) * 128 + n0) = o;
          }
        }
      }
      __syncthreads();
    } else {
      const int sidx = (it - nCmp) * 8 + (tid_all >> 6);
      const int bl = sidx >> 4, hh = sidx & 15;
      const float bf = P.b_forget[layer * 16 + hh];
      const float* fl = P.flog + ((size_t)bl * TSEQ + lane * 32) * 16 + hh;
      float loc = 0.f;
#pragma unroll 8
      for (int j = 0; j < 32; j++) {
        float x = fl[j * 16] + bf;
        float ls = (x >= 0.f) ? -log1pf(__expf(-x)) : (x - log1pf(__expf(x)));
        loc += ls;
      }
      float incl = loc;
#pragma unroll
      for (int o = 1; o < 64; o <<= 1) {
        float v = __shfl_up(incl, o);
        if (lane >= o) incl += v;
      }
      float run = incl - loc;
      float* fo = P.F2 + ((size_t)bl * 16 + hh) * TSEQ + lane * 32;
#pragma unroll 8
      for (int j = 0; j < 32; j++) {
        float x = fl[j * 16] + bf;
        float ls = (x >= 0.f) ? -log1pf(__expf(-x)) : (x - log1pf(__expf(x)));
        run += ls;
        fo[j] = run * LOG2E;
      }
    }
  }
}

__device__ void pc1_phase(const Params& P, char* smem) {
  const int tid = opaque_tid(),  lane = tid & 63, r = lane & 31, h = lane >> 5, w = tid >> 6;
  const int nItems = P.NB * 2 * 8;
  const float c1 = 0.125f * LOG2E;
  for (int it = blockIdx.x; it < nItems; it += gridDim.x) {
    const int qt = it & 7, g = (it >> 3) & 1, bl = it >> 4;
    __syncthreads();
#pragma unroll
    for (int j = 0; j < 2; j++) {
      int c = tid + 512 * j;
      {
        int n = c >> 3, ch = c & 7;
        uint4 v = *(const uint4*)(P.kcmp + ((size_t)(bl * 2 + g) * 128 + n) * 64 + ch * 8);
        *(uint4*)(smem + n * 128 + ((ch ^ ((n >> 1) & 7)) << 4)) = v;
      }
      {
        int d = c >> 4, ch = c & 15;
        uint4 v = *(const uint4*)(P.vcmpt + ((size_t)(bl * 2 + g) * 64 + d) * 128 + ch * 8);
        int sw = d & 31;
        *(uint2*)(smem + 16384 + d * 256 + (((2 * ch) ^ sw) << 3)) = make_uint2(v.x, v.y);
        *(uint2*)(smem + 16384 + d * 256 + (((2 * ch + 1) ^ sw) << 3)) = make_uint2(v.z, v.w);
      }
    }
    __syncthreads();
    const int qw_lo = qt * 256 + w * 32;
    const int qtok = qw_lo + r;
    const size_t rowg = (size_t)bl * TSEQ + qtok;
    const int tq = qtok - 31 - 64 * h;
    float sumacc[16], lastacc[16];
#pragma unroll
    for (int s = 0; s < 16; s++) { sumacc[s] = 0.f; lastacc[s] = 0.f; }
#pragma unroll 1
    for (int hh = 0; hh < 8; hh++) {
      const int head = g * 8 + hh;
      bf16x8 qf[4];
#pragma unroll
      for (int kk = 0; kk < 4; kk++) qf[kk] = ldfrag(P.proj + rowg * INC + C_QA + head * 64 + kk * 16 + h * 8);
      f32x16 s[4];
#pragma unroll
      for (int nt = 0; nt < 4; nt++) {
#pragma unroll
        for (int i = 0; i < 16; i++) s[nt][i] = 0.f;
#pragma unroll
        for (int kk = 0; kk < 4; kk++) {
          int row = nt * 32 + r;
          bf16x8 a = ldfrag(smem + row * 128 + (((kk * 2 + h) ^ ((row >> 1) & 7)) << 4));
          s[nt] = mfma32(a, qf[kk], s[nt]);
        }
        __builtin_amdgcn_sched_barrier(0);
      }
      float mx = -3.0e38f;
#pragma unroll
      for (int nt = 0; nt < 4; nt++)
#pragma unroll
        for (int i = 0; i < 16; i++) {
          bool ok = (16 * (nt * 32 + 8 * (i >> 2) + (i & 3))) <= tq;
          float v = ok ? s[nt][i] * c1 : -3.0e38f;
          s[nt][i] = v;
          mx = fmaxf(mx, v);
        }
      mx = fmaxf(mx, __shfl_xor(mx, 32));
      const bool anyv = mx > -1.0e37f;
      float mref = anyv ? mx : 0.f;
      float l = 0.f;
#pragma unroll
      for (int nt = 0; nt < 4; nt++)
#pragma unroll
        for (int i = 0; i < 16; i++) {
          float p = __builtin_amdgcn_exp2f(s[nt][i] - mref);
          s[nt][i] = p;
          l += p;
        }
      l += __shfl_xor(l, 32);
      const float inv = (anyv && l > 0.f) ? 1.f / l : 0.f;
#pragma unroll
      for (int nt = 0; nt < 4; nt++)
#pragma unroll
        for (int i = 0; i < 16; i++) s[nt][i] *= inv;
#pragma unroll
      for (int nt = 0; nt < 4; nt++)
#pragma unroll
        for (int gq = 0; gq < 4; gq++) {
          sumacc[nt * 4 + gq] += (s[nt][gq * 4] + s[nt][gq * 4 + 1]) + (s[nt][gq * 4 + 2] + s[nt][gq * 4 + 3]);
          lastacc[nt * 4 + gq] += s[nt][gq * 4 + 3];
        }
      uint4 pbv[8];
#pragma unroll
      for (int ks = 0; ks < 8; ks++) {
        const int nt = ks >> 1, hb = (ks & 1) * 8;
        pbv[ks].x = pk2(s[nt][hb + 0], s[nt][hb + 1]); pbv[ks].y = pk2(s[nt][hb + 2], s[nt][hb + 3]);
        pbv[ks].z = pk2(s[nt][hb + 4], s[nt][hb + 5]); pbv[ks].w = pk2(s[nt][hb + 6], s[nt][hb + 7]);
      }
      const float g0 = sigmoidf_(bf2f(P.proj[rowg * INC + C_GA + head]));
#pragma unroll
      for (int dt = 0; dt < 2; dt++) {
        f32x16 o;
#pragma unroll
        for (int i = 0; i < 16; i++) o[i] = 0.f;
        const int d = dt * 32 + r, sw = d & 31;
#pragma unroll
        for (int ks = 0; ks < 8; ks++) {
          uint2 lo = *(const uint2*)(smem + 16384 + d * 256 + (((ks * 4 + h) ^ sw) << 3));
          uint2 hi = *(const uint2*)(smem + 16384 + d * 256 + (((ks * 4 + 2 + h) ^ sw) << 3));
          uint4 au = make_uint4(lo.x, lo.y, hi.x, hi.y);
          o = mfma32(__builtin_bit_cast(bf16x8, au), __builtin_bit_cast(bf16x8, pbv[ks]), o);
        }
#pragma unroll
        for (int gq = 0; gq < 4; gq++) {
          int d0 = dt * 32 + 8 * gq + 4 * h;
          uint2 ov;
          ov.x = pk2(o[gq * 4 + 0] * g0, o[gq * 4 + 1] * g0);
          ov.y = pk2(o[gq * 4 + 2] * g0, o[gq * 4 + 3] * g0);
          *(uint2*)(P.ya + rowg * DM + head * 64 + d0) = ov;
        }
        __builtin_amdgcn_sched_barrier(0);
      }
    }
    float sc[16];
#pragma unroll
    for (int s = 0; s < 16; s++) {
      float prev = (s == 0) ? 0.f : lastacc[s - 1];
      float sendv = h ? prev : lastacc[s];
      float recv = __shfl_xor(sendv, 32);
      float imp = sumacc[s] + recv;
      int j = (s >> 2) * 8 + (s & 3) * 2 + h;
      int cur = qtok >> 6;
      bool forced = (j == 0) || (j == cur) || (j == cur - 1);
      bool valid = j <= cur;
      sc[s] = forced ? 1.0e4f : (valid ? imp : -1.0f);
    }
    unsigned mask = 0u;
#pragma unroll 1
    for (int rd = 0; rd < 8; rd++) {
      float best = -2.0f; int bj = 0;
#pragma unroll
      for (int s = 0; s < 16; s++) {
        int j = (s >> 2) * 8 + (s & 3) * 2 + h;
        if (sc[s] > best) { best = sc[s]; bj = j; }
      }
      float ob = __shfl_xor(best, 32);
      int oj = __shfl_xor(bj, 32);
      bool mine = (best > ob) || (best == ob && bj < oj);
      int wj = mine ? bj : oj;
      mask |= 1u << wj;
#pragma unroll
      for (int s = 0; s < 16; s++) {
        int j = (s >> 2) * 8 + (s & 3) * 2 + h;
        if (j == wj) sc[s] = -3.0f;
      }
    }
    if (h == 0) P.sel[(size_t)(bl * 2 + g) * TSEQ + qtok] = mask;
  }
}

#define ATT_GLOAD(KT)                                                                              \
  {                                                                                                \
    const int ta_ = (KT), tb_ = ((KT) + 1 < kt_hi) ? (KT) + 1 : (KT);                              \
    kreg0 = *(const uint4*)(Kg + (size_t)(ta_ * 64 + lk) * ldk + lch * 8);                         \
    kreg1 = *(const uint4*)(Kg + (size_t)(tb_ * 64 + lk) * ldk + lch * 8);                         \
    vreg0 = *(const uint4*)(Vtg + (size_t)lk * TSEQ + ta_ * 64 + lch * 8);                         \
    vreg1 = *(const uint4*)(Vtg + (size_t)lk * TSEQ + tb_ * 64 + lch * 8);                         \
    if (MODE == 0 && tid < 32) freg = *(const float4*)(F2g + (tid < 16 ? ta_ : tb_) * 64 + (tid & 15) * 4); \
  }
#define ATT_SSTORE(ST)                                                                             \
  {                                                                                                \
    char* base_ = smem + (ST) * ATT_STAGE;                                                         \
    *(uint4*)(base_ + koff0) = kreg0;                                                              \
    *(uint4*)(base_ + 8192 + koff0) = kreg1;                                                       \
    *(uint2*)(base_ + voffa) = make_uint2(vreg0.x, vreg0.y);                                       \
    *(uint2*)(base_ + voffb) = make_uint2(vreg0.z, vreg0.w);                                       \
    *(uint2*)(base_ + 8192 + voffa) = make_uint2(vreg1.x, vreg1.y);                                \
    *(uint2*)(base_ + 8192 + voffb) = make_uint2(vreg1.z, vreg1.w);                                \
    if (MODE == 0 && tid < 32) *(float4*)(base_ + 32768 + tid * 16) = freg;                        \
  }

template <int MODE>
__device__ __forceinline__ void attn_pass(const u16* __restrict__ Kg, int ldk, const u16* __restrict__ Vtg,
                                          const float* __restrict__ F2g, int kt_lo, int kt_hi,
                                          const u16* __restrict__ qptr, int qtok, int qw_lo, unsigned selm,
                                          f32x16 (&o)[2], float& m, float& l, char* smem, const int tid) {
  const int lane = tid & 63, r = lane & 31, h = lane >> 5;
  const int lk = tid >> 3, lch = tid & 7;
  const float c1 = 0.125f * LOG2E;
  uint4 kreg0, kreg1, vreg0, vreg1;
  const int koff0 = lk * 128 + ((lch ^ ((lk >> 1) & 7)) << 4);
  const int voffa = 16384 + lk * 128 + (((2 * lch) ^ ((lk >> 1) & 15)) << 3);
  const int voffb = 16384 + lk * 128 + (((2 * lch + 1) ^ ((lk >> 1) & 15)) << 3);
  float4 freg = make_float4(0.f, 0.f, 0.f, 0.f);
  if (kt_lo >= kt_hi) return;
  const bf16x8 qf0 = ldfrag(qptr), qf1 = ldfrag(qptr + 16), qf2 = ldfrag(qptr + 32), qf3 = ldfrag(qptr + 48);
  ATT_GLOAD(kt_lo);
  ATT_SSTORE(0);
  __syncthreads();
  for (int kt0 = kt_lo; kt0 < kt_hi; kt0 += 2) {
    const int st = ((kt0 - kt_lo) >> 1) & 1;
    const bool more = (kt0 + 2) < kt_hi;
    if (more) ATT_GLOAD(kt0 + 2);
#pragma unroll 1
    for (int sub = 0; sub < 2; sub++) {
    const int kt = kt0 + sub;
    const int kb = kt * 64;
    bool active = (kt < kt_hi) && (kb <= qw_lo + 31);
    bool selbit = true;
    if (MODE == 1) {
      selbit = (selm >> (kt & 31)) & 1u;
      active = active && (__ballot(selbit) != 0ull);
    }
    if (MODE == 2) active = active && (kb + 63 + 511 >= qw_lo);
    if (active) {
      const char* sb = smem + st * ATT_STAGE + sub * 8192;
      const char* vb = sb + 16384;
      const char* fb = smem + st * ATT_STAGE + 32768 + sub * 256;
      f32x16 s[2];
#pragma unroll
      for (int nt = 0; nt < 2; nt++) {
#pragma unroll
        for (int i = 0; i < 16; i++) s[nt][i] = 0.f;
#pragma unroll
        for (int kk = 0; kk < 4; kk++) {
          int row = nt * 32 + r;
          bf16x8 a = ldfrag(sb + row * 128 + (((kk * 2 + h) ^ ((row >> 1) & 7)) << 4));
          s[nt] = mfma32(a, kk == 0 ? qf0 : (kk == 1 ? qf1 : (kk == 2 ? qf2 : qf3)), s[nt]);
        }
      }
      const f32x2 c1v = {c1, c1};
      if (MODE == 0) {
#pragma unroll
        for (int nt = 0; nt < 2; nt++)
#pragma unroll
          for (int gq = 0; gq < 4; gq++) {
            const float4 fk = *(const float4*)(fb + (nt * 32 + gq * 8 + h * 4) * 4);
            f32x2 a0 = {s[nt][gq * 4 + 0], s[nt][gq * 4 + 1]}, a1 = {s[nt][gq * 4 + 2], s[nt][gq * 4 + 3]};
            const f32x2 f0 = {fk.x, fk.y}, f1 = {fk.z, fk.w};
            a0 = a0 * c1v - f0; a1 = a1 * c1v - f1;
            s[nt][gq * 4 + 0] = a0.x; s[nt][gq * 4 + 1] = a0.y; s[nt][gq * 4 + 2] = a1.x; s[nt][gq * 4 + 3] = a1.y;
          }
      }
      bool need_mask;
      if (MODE == 0) need_mask = (kb + 63 > qw_lo);
      else if (MODE == 1) need_mask = (kb + 63 > qw_lo) || (__ballot(!selbit) != 0ull);
      else need_mask = (kb + 63 > qw_lo) || (kb + 512 <= qw_lo + 31);
      if (need_mask) {
        const int td = qtok - kb - 4 * h;
#pragma unroll
        for (int nt = 0; nt < 2; nt++)
#pragma unroll
          for (int i = 0; i < 16; i++) {
            const int kc = nt * 32 + 8 * (i >> 2) + (i & 3);
            bool ok = kc <= td;
            if (MODE == 1) ok = ok && selbit;
            if (MODE == 2) ok = ok && (kc + 512 > td);
            s[nt][i] = ok ? s[nt][i] : -3.0e38f;
          }
      }
      float mx = s[0][0];
#pragma unroll
      for (int nt = 0; nt < 2; nt++)
#pragma unroll
        for (int i = 0; i < 16; i++) mx = fmaxf(mx, s[nt][i]);
      mx = fmaxf(mx, __shfl_xor(mx, 32));
      if (MODE != 0) mx *= c1;
      if (__ballot(mx > m + 8.0f) != 0ull) {
        const float mn = fmaxf(m, mx);
        const float alpha = __builtin_amdgcn_exp2f(m - mn);
        const f32x2 av = {alpha, alpha};
        l *= alpha;
        m = mn;
#pragma unroll
        for (int dt = 0; dt < 2; dt++)
#pragma unroll
          for (int i = 0; i < 16; i += 2) {
            f32x2 t = {o[dt][i], o[dt][i + 1]};
            t = t * av;
            o[dt][i] = t.x; o[dt][i + 1] = t.y;
          }
      }
      {
        const f32x2 nm = {-m, -m};
        f32x2 rs2 = {0.f, 0.f};
#pragma unroll
        for (int nt = 0; nt < 2; nt++)
#pragma unroll
          for (int i = 0; i < 16; i += 2) {
            f32x2 t = {s[nt][i], s[nt][i + 1]};
            if (MODE == 0) t = t + nm; else t = t * c1v + nm;
            f32x2 p;
            p.x = __builtin_amdgcn_exp2f(t.x); p.y = __builtin_amdgcn_exp2f(t.y);
            s[nt][i] = p.x; s[nt][i + 1] = p.y;
            rs2 = rs2 + p;
          }
        float rs = rs2.x + rs2.y;
        rs += __shfl_xor(rs, 32);
        l += rs;
      }
#pragma unroll
      for (int ks = 0; ks < 4; ks++) {
        const int nt = ks >> 1, hb = (ks & 1) * 8;
        uint4 pu;
        pu.x = pk2(s[nt][hb + 0], s[nt][hb + 1]); pu.y = pk2(s[nt][hb + 2], s[nt][hb + 3]);
        pu.z = pk2(s[nt][hb + 4], s[nt][hb + 5]); pu.w = pk2(s[nt][hb + 6], s[nt][hb + 7]);
        bf16x8 pb = __builtin_bit_cast(bf16x8, pu);
#pragma unroll
        for (int dt = 0; dt < 2; dt++) {
          int d = dt * 32 + r, sw = (d >> 1) & 15;
          uint2 lo = *(const uint2*)(vb + d * 128 + (((ks * 4 + h) ^ sw) << 3));
          uint2 hi = *(const uint2*)(vb + d * 128 + (((ks * 4 + 2 + h) ^ sw) << 3));
          uint4 au = make_uint4(lo.x, lo.y, hi.x, hi.y);
          o[dt] = mfma32(__builtin_bit_cast(bf16x8, au), pb, o[dt]);
        }
      }
    }
    }
    if (more) ATT_SSTORE(st ^ 1);
    __syncthreads();
  }
}

__device__ void pc2_phase(const Params& P, int layer, int chunk, char* smem, int* s_item) {
  const int tid = opaque_tid(),  lane = tid & 63, r = lane & 31, h = lane >> 5, w = tid >> 6;
  const int perq = 2 * P.NB * 16;
  const int nItems = 8 * perq;
  unsigned* ctr = P.ctr + (chunk * 4 + layer);
  while (true) {
    __syncthreads();
    if (tid == 0) *s_item = (int)atomicAdd(ctr, 1u);
    __syncthreads();
    const int it = *s_item;
    if (it >= nItems) break;
    const int qt = 7 - it / perq;
    const int rem = it % perq;
    const int type = rem & 1;
    const int bh = rem >> 1;
    const int bl = bh >> 4, head = bh & 15;
    const int qw_lo = qt * 256 + w * 32;
    const int qtok = qw_lo + r;
    const size_t rowg = (size_t)bl * TSEQ + qtok;
    const u16* pb_ = P.proj + (size_t)bl * TSEQ * INC;
    f32x16 o[2];
#pragma unroll
    for (int dt = 0; dt < 2; dt++)
#pragma unroll
      for (int i = 0; i < 16; i++) o[dt][i] = 0.f;
    float m = -1.0e30f, l = 0.f;
    if (type == 0) {
      const u16* qf = P.proj + rowg * INC + C_QB + head * 64 + h * 8;
      attn_pass<0>(pb_ + C_KB + head * 64, INC, P.vbt + (size_t)(bl * 16 + head) * 64 * TSEQ,
                   P.F2 + (size_t)(bl * 16 + head) * TSEQ, 0, 4 * qt + 4, qf, qtok, qw_lo, 0u, o, m, l, smem, tid);
      const float inv = 1.f / l;
#pragma unroll
      for (int dt = 0; dt < 2; dt++)
#pragma unroll
        for (int gq = 0; gq < 4; gq++) {
          int d0 = dt * 32 + 8 * gq + 4 * h;
          uint2 zz = *(const uint2*)(P.proj + rowg * INC + C_ZB + head * 64 + d0);
          uint2 ov;
          ov.x = pk2(o[dt][gq * 4 + 0] * inv * siluf_(bflo(zz.x)), o[dt][gq * 4 + 1] * inv * siluf_(bfhi(zz.x)));
          ov.y = pk2(o[dt][gq * 4 + 2] * inv * siluf_(bflo(zz.y)), o[dt][gq * 4 + 3] * inv * siluf_(bfhi(zz.y)));
          *(uint2*)(P.yb + rowg * DM + head * 64 + d0) = ov;
        }
    } else {
      const int g = head >> 3;
      const u16* qf = P.proj + rowg * INC + C_QR + head * 64 + h * 8;
      const unsigned selm = P.sel[(size_t)(bl * 2 + g) * TSEQ + qtok];
      attn_pass<1>(pb_ + C_KV + 256 + g * 64, INC, P.vst + (size_t)(bl * 2 + g) * 64 * TSEQ, nullptr,
                   0, 4 * qt + 4, qf, qtok, qw_lo, selm, o, m, l, smem, tid);
      f32x16 tot[2];
      {
        const float g1 = sigmoidf_(bf2f(P.proj[rowg * INC + C_GA + 16 + head]));
        const float sc1 = g1 / l;
#pragma unroll
        for (int dt = 0; dt < 2; dt++)
#pragma unroll
          for (int i = 0; i < 16; i++) { tot[dt][i] = o[dt][i] * sc1; o[dt][i] = 0.f; }
      }
      m = -1.0e30f; l = 0.f;
      const int klo = (4 * qt - 8) > 0 ? (4 * qt - 8) : 0;
      attn_pass<2>(pb_ + C_KV + 512 + g * 64, INC, P.vwt + (size_t)(bl * 2 + g) * 64 * TSEQ, nullptr,
                   klo, 4 * qt + 4, qf, qtok, qw_lo, 0u, o, m, l, smem, tid);
      const float g2 = sigmoidf_(bf2f(P.proj[rowg * INC + C_GA + 32 + head]));
      const float sc2 = g2 / l;
#pragma unroll
      for (int dt = 0; dt < 2; dt++)
#pragma unroll
        for (int gq = 0; gq < 4; gq++) {
          int d0 = dt * 32 + 8 * gq + 4 * h;
          uint2 zz = *(const uint2*)(P.proj + rowg * INC + C_ZA + head * 64 + d0);
          uint2 oc = *(const uint2*)(P.ya + rowg * DM + head * 64 + d0);
          float v0 = (tot[dt][gq * 4 + 0] + o[dt][gq * 4 + 0] * sc2 + bflo(oc.x)) * siluf_(bflo(zz.x));
          float v1 = (tot[dt][gq * 4 + 1] + o[dt][gq * 4 + 1] * sc2 + bfhi(oc.x)) * siluf_(bfhi(zz.x));
          float v2 = (tot[dt][gq * 4 + 2] + o[dt][gq * 4 + 2] * sc2 + bflo(oc.y)) * siluf_(bflo(zz.y));
          float v3 = (tot[dt][gq * 4 + 3] + o[dt][gq * 4 + 3] * sc2 + bfhi(oc.y)) * siluf_(bfhi(zz.y));
          uint2 ov;
          ov.x = pk2(v0, v1); ov.y = pk2(v2, v3);
          *(uint2*)(P.ya + rowg * DM + head * 64 + d0) = ov;
        }
    }
  }
}

__device__ __forceinline__ void grid_bar(unsigned* ctr, unsigned& epoch) {
  asm volatile("s_waitcnt vmcnt(0) lgkmcnt(0)" ::: "memory");
  __syncthreads();
  epoch += gridDim.x;
  if (threadIdx.x == 0) {
    __builtin_amdgcn_fence(__ATOMIC_RELEASE, "agent");
    asm volatile("s_waitcnt vmcnt(0)" ::: "memory");
    __hip_atomic_fetch_add(ctr, 1u, __ATOMIC_RELAXED, __HIP_MEMORY_SCOPE_AGENT);
    while (__hip_atomic_load(ctr, __ATOMIC_RELAXED, __HIP_MEMORY_SCOPE_AGENT) < epoch) __builtin_amdgcn_s_sleep(2);
    __builtin_amdgcn_fence(__ATOMIC_ACQUIRE, "agent");
    asm volatile("s_waitcnt vmcnt(0)" ::: "memory");
  }
  __syncthreads();
}

__global__ void __launch_bounds__(NTHREADS, 2) mega_kernel(Params P) {
  __shared__ __attribute__((aligned(1024))) char smem[131072];
  cg::grid_group grid = cg::this_grid();
  const int CT = P.NB * TSEQ;
  unsigned epoch = 0u;
  phase0(P, smem);
  grid.sync();
  for (int chunk = 0; chunk < P.nchunk; chunk++) {
    for (int layer = 0; layer < 4; layer++) {
      const float* xs = (layer == 0 ? P.x_in : P.out) + (size_t)chunk * CT * DM;
      norm_phase(xs, P.norm_g + layer * DM, P.h, CT);
      if (layer == 0 && chunk > 0) final_norm_phase(P.out, P.final_g, (chunk - 1) * CT, CT);
      grid_bar(P.ctr + 48, epoch);
      gemm1_phase(P, layer, smem);
      grid_bar(P.ctr + 48, epoch);
      pb_phase(P, layer, smem);
      grid_bar(P.ctr + 48, epoch);
      pc1_phase(P, smem);
      grid_bar(P.ctr + 48, epoch);
      pc2_phase(P, layer, chunk, smem, (int*)(smem + 70000));
      grid_bar(P.ctr + 48, epoch);
      gemm2_phase(P, layer, smem);
      grid_bar(P.ctr + 48, epoch);
      gemm3_phase(P, layer, chunk, smem);
      grid_bar(P.ctr + 48, epoch);
    }
  }
  final_norm_phase(P.out, P.final_g, (P.nchunk - 1) * CT, CT);
}

static inline size_t al256(size_t x) { return (x + 255) & ~(size_t)255; }

extern "C" void kernel_launch(void* const* d_in, const int* in_sizes, int n_in, void* d_out, int out_size,
                              void* d_ws, size_t ws_size, hipStream_t stream) {
  (void)in_sizes; (void)n_in; (void)out_size;
  Params P{};
  P.x_in = (const float*)d_in[0]; P.norm_g = (const float*)d_in[1]; P.w_in = (const float*)d_in[2];
  P.b_forget = (const float*)d_in[3];
  P.pe_k = (const float*)d_in[4]; P.w1_k = (const float*)d_in[5]; P.w2_k = (const float*)d_in[6];
  P.pe_v = (const float*)d_in[7]; P.w1_v = (const float*)d_in[8]; P.w2_v = (const float*)d_in[9];
  P.w_pa = (const float*)d_in[10]; P.w_pb = (const float*)d_in[11]; P.w_out = (const float*)d_in[12];
  P.final_g = (const float*)d_in[13];
  P.out = (float*)d_out;
  int NB = 16;
  char* base = (char*)d_ws;
  for (;;) {
    const size_t CT = (size_t)NB * TSEQ;
    size_t off = 0;
    auto take = [&](size_t bytes) { size_t o = off; off = al256(off + bytes); return o; };
    size_t oWin = take((size_t)4 * INCP * DM * 2), oWpa = take((size_t)4 * DM * DM * 2), oWpb = take((size_t)4 * DM * DM * 2),
           oWo = take((size_t)4 * DM * DM * 2), oW1 = take((size_t)8 * 128 * 2048 * 2), oW2 = take((size_t)8 * 64 * 128 * 2),
           oB1 = take((size_t)64 * 128 * 4), oRc = take((size_t)TSEQ * 32 * 4), oRs = take((size_t)TSEQ * 32 * 4),
           oH = take(CT * DM * 2), oProj = take(CT * INC * 2 + 4096), oVbt = take(CT * DM * 2),
           oVst = take(CT * 128 * 2), oVwt = take(CT * 128 * 2), oFl = take(CT * 16 * 4), oF2 = take(CT * 16 * 4),
           oKc = take((size_t)NB * 2 * 128 * 64 * 2), oVc = take((size_t)NB * 2 * 64 * 128 * 2), oSel = take(CT * 2 * 4),
           oYa = take(CT * DM * 2), oYb = take(CT * DM * 2), oCtr = take(256);
    if (off > ws_size && NB > 1) { NB >>= 1; continue; }
    P.WinT = (u16*)(base + oWin); P.WpaT = (u16*)(base + oWpa); P.WpbT = (u16*)(base + oWpb); P.WoT = (u16*)(base + oWo);
    P.W1T = (u16*)(base + oW1); P.W2T = (u16*)(base + oW2); P.bias1p = (float*)(base + oB1);
    P.ropec = (float*)(base + oRc); P.ropes = (float*)(base + oRs);
    P.h = (u16*)(base + oH); P.proj = (u16*)(base + oProj); P.vbt = (u16*)(base + oVbt);
    P.vst = (u16*)(base + oVst); P.vwt = (u16*)(base + oVwt); P.flog = (float*)(base + oFl); P.F2 = (float*)(base + oF2);
    P.kcmp = (u16*)(base + oKc); P.vcmpt = (u16*)(base + oVc); P.sel = (unsigned*)(base + oSel);
    P.ya = (u16*)(base + oYa); P.yb = (u16*)(base + oYb); P.ctr = (unsigned*)(base + oCtr);
    break;
  }
  P.NB = NB; P.nchunk = 32 / NB;
  static int grid_blocks = 0;
  if (!grid_blocks) {
    int dev = 0, cus = 0, per_cu = 0;
    hipGetDevice(&dev);
    hipDeviceGetAttribute(&cus, hipDeviceAttributeMultiprocessorCount, dev);
    hipOccupancyMaxActiveBlocksPerMultiprocessor(&per_cu, mega_kernel, NTHREADS, 0);
    if (per_cu > 1) per_cu = 1;
    if (per_cu < 1) per_cu = 1;
    grid_blocks = cus * per_cu;
  }
  void* args[] = {&P};
  hipError_t e = hipLaunchCooperativeKernel((void*)mega_kernel, dim3(grid_blocks), dim3(NTHREADS), args, 0, stream);
  if (e != hipSuccess) fprintf(stderr, "cooperative launch failed: %s (grid %d)\n", hipGetErrorString(e), grid_blocks);
}
```

```cpp
#include <hip/hip_runtime.h>
#include <hip/hip_cooperative_groups.h>
#include <cstdio>
namespace cg = cooperative_groups;

typedef __attribute__((ext_vector_type(8))) __bf16 bf16x8;
typedef __attribute__((ext_vector_type(16))) float f32x16;
typedef __attribute__((ext_vector_type(4))) float f32x4;
typedef __attribute__((ext_vector_type(2))) float f32x2;
typedef unsigned short u16;

#define TSEQ 2048
#define DM 1024
#define INC 9024
#define INCP 9216
#define C_QA 0
#define C_KV 1024
#define C_GA 1792
#define C_ZA 1840
#define C_QB 2864
#define C_KB 3888
#define C_VB 4912
#define C_QR 4912
#define C_FB 5936
#define C_ZB 5952
#define C_RA 6976
#define C_RB 8000
#define NTHREADS 512
#define ATT_STAGE 33280
#define LOG2E 1.4426950408889634f

struct Params {
  const float* x_in; const float* norm_g; const float* w_in; const float* b_forget;
  const float* pe_k; const float* w1_k; const float* w2_k;
  const float* pe_v; const float* w1_v; const float* w2_v;
  const float* w_pa; const float* w_pb; const float* w_out; const float* final_g;
  float* out;
  u16* WinT; u16* WpaT; u16* WpbT; u16* WoT; u16* W1T; u16* W2T;
  float* bias1p; float* ropec; float* ropes;
  u16* h; u16* proj; u16* qr; u16* vst; u16* vwt;
  float* flog; float* F2; u16* kcmp; u16* vcmpt; unsigned* sel;
  u16* ya; u16* yb; unsigned* ctr;
  int NB; int nchunk;
};

__device__ __forceinline__ unsigned pk2(float a, float b) {
  typedef __attribute__((ext_vector_type(2))) float f2_t;
  typedef __attribute__((ext_vector_type(2))) __bf16 b2_t;
  f2_t v = {a, b};
  b2_t r = __builtin_convertvector(v, b2_t);
  return __builtin_bit_cast(unsigned, r);
}
__device__ __forceinline__ u16 f2bf(float a) { return (u16)(pk2(a, 0.f) & 0xffffu); }
__device__ __forceinline__ float bf2f(u16 u) { return __uint_as_float(((unsigned)u) << 16); }
__device__ __forceinline__ float bflo(unsigned u) { return __uint_as_float(u << 16); }
__device__ __forceinline__ float bfhi(unsigned u) { return __uint_as_float(u & 0xffff0000u); }
__device__ __forceinline__ float sigmoidf_(float x) { return 1.f / (1.f + __expf(-x)); }
__device__ __forceinline__ float siluf_(float x) { return x / (1.f + __expf(-x)); }
__device__ __forceinline__ f32x16 mfma32(bf16x8 a, bf16x8 b, f32x16 c) {
  return __builtin_amdgcn_mfma_f32_32x32x16_bf16(a, b, c, 0, 0, 0);
}
__device__ __forceinline__ int opaque_tid() { int t = threadIdx.x; asm volatile("" : "+v"(t)); return t; }
__device__ __forceinline__ bf16x8 ldfrag(const void* p) {
  return __builtin_bit_cast(bf16x8, *(const uint4*)p);
}

__device__ void transpose_tile(const float* __restrict__ src, u16* __restrict__ dst, int K, int N,
                               int k0, int n0, float* tile, const int tid) {
#pragma unroll
  for (int j = 0; j < 2; j++) {
    int r = (tid >> 4) + 32 * j, c4 = (tid & 15) * 4;
    float4 v = *(const float4*)(src + (size_t)(k0 + r) * N + n0 + c4);
    tile[r * 65 + c4] = v.x; tile[r * 65 + c4 + 1] = v.y; tile[r * 65 + c4 + 2] = v.z; tile[r * 65 + c4 + 3] = v.w;
  }
  __syncthreads();
  {
    int c = tid, n = c >> 3, kc = c & 7;
    const float* tp = tile + (kc * 8) * 65 + n;
    uint4 o;
    o.x = pk2(tp[0], tp[65]); o.y = pk2(tp[130], tp[195]); o.z = pk2(tp[260], tp[325]); o.w = pk2(tp[390], tp[455]);
    *(uint4*)(dst + (size_t)(n0 + n) * K + k0 + kc * 8) = o;
  }
  __syncthreads();
}

__device__ void phase0(const Params& P, char* smem) {
  const int tid = opaque_tid();
  float* tile = (float*)smem;
  const int n0_ = 4 * 16 * 141, n1_ = 4 * 16 * 16, n2_ = 4 * 32 * 2, n3_ = 4 * 2 * 1;
  const int nT = n0_ + 3 * n1_ + 2 * n2_ + 2 * n3_;
  const int nBias = 64, nRope = 128;
  const int total = nT + nBias + nRope + 1;
  for (int it = blockIdx.x; it < total; it += gridDim.x) {
    if (it < nT) {
      int t = it;
      if (t < n0_) {
        int l = t / (16 * 141), rem = t % (16 * 141);
        transpose_tile(P.w_in + (size_t)l * DM * INC, P.WinT + (size_t)l * INCP * DM, DM, INC, (rem / 141) * 64, (rem % 141) * 64, tile, tid);
        continue;
      }
      t -= n0_;
      if (t < 3 * n1_) {
        int which = t / n1_; t %= n1_;
        int l = t / 256, rem = t % 256;
        const float* s = which == 0 ? P.w_pa : (which == 1 ? P.w_pb : P.w_out);
        u16* d = which == 0 ? P.WpaT : (which == 1 ? P.WpbT : P.WoT);
        transpose_tile(s + (size_t)l * DM * DM, d + (size_t)l * DM * DM, DM, DM, (rem >> 4) * 64, (rem & 15) * 64, tile, tid);
        continue;
      }
      t -= 3 * n1_;
      if (t < 2 * n2_) {
        int kv = t / n2_; t %= n2_;
        int l = t / 64, rem = t % 64;
        const float* s = kv ? P.w1_v : P.w1_k;
        transpose_tile(s + (size_t)l * 2048 * 128, P.W1T + (size_t)(l * 2 + kv) * 128 * 2048, 2048, 128, (rem >> 1) * 64, (rem & 1) * 64, tile, tid);
        continue;
      }
      t -= 2 * n2_;
      {
        int kv = t / n3_; t %= n3_;
        int l = t / 2, rem = t % 2;
        const float* s = kv ? P.w2_v : P.w2_k;
        transpose_tile(s + (size_t)l * 128 * 64, P.W2T + (size_t)(l * 2 + kv) * 64 * 128, 128, 64, rem * 64, 0, tile, tid);
      }
    } else if (it < nT + nBias) {
      int j = it - nT;
      int l = j >> 4, kv = (j >> 3) & 1, kq = j & 7;
      const float* pe = (kv ? P.pe_v : P.pe_k) + (size_t)l * 2048;
      const float* w1 = (kv ? P.w1_v : P.w1_k) + (size_t)l * 2048 * 128;
      int hid = tid & 127, kh = tid >> 7;
      int kbeg = kq * 256 + kh * 64;
      float s = 0.f;
#pragma unroll 8
      for (int k = 0; k < 64; k++) s += pe[kbeg + k] * w1[(size_t)(kbeg + k) * 128 + hid];
      float* part = (float*)smem;
      part[tid] = s;
      __syncthreads();
      if (tid < 128) P.bias1p[((l * 2 + kv) * 8 + kq) * 128 + hid] = (part[tid] + part[tid + 128]) + (part[tid + 256] + part[tid + 384]);
      __syncthreads();
    } else if (it < nT + nBias + nRope) {
      int idx = (it - nT - nBias) * 512 + tid;
      int t = idx >> 5, j = idx & 31;
      double inv = 1.0;
      for (int q = 0; q < j; q++) inv *= 0.7498942093324558;
      float invf = (float)inv;
      float angf = (float)t * invf;
      double a = (double)angf;
      double kq = rint(a * 0.15915494309189535);
      double rr = a - kq * 6.283185307179586;
      double r2 = rr * rr;
      double sterm = rr, cterm = 1.0, ssum = rr, csum = 1.0;
#pragma unroll 1
      for (int n = 1; n <= 15; n++) {
        cterm *= -r2 / (double)((2 * n - 1) * (2 * n));
        sterm *= -r2 / (double)((2 * n) * (2 * n + 1));
        csum += cterm; ssum += sterm;
      }
      P.ropec[idx] = (float)csum;
      P.ropes[idx] = (float)ssum;
    } else {
      if (tid < 64) P.ctr[tid] = 0u;
    }
  }
}

__device__ void norm_phase(const float* __restrict__ xsrc, const float* __restrict__ g, u16* __restrict__ hdst, int nrows) {
  const int tid = opaque_tid();
  const int lane = tid & 63;
  const int gw = blockIdx.x * 8 + (tid >> 6), nw = gridDim.x * 8;
  float4 gv[4];
#pragma unroll
  for (int j = 0; j < 4; j++) gv[j] = *(const float4*)(g + lane * 4 + 256 * j);
  for (int row = gw; row < nrows; row += nw) {
    const float* xr = xsrc + (size_t)row * DM;
    float4 v[4];
    float ss = 0.f;
#pragma unroll
    for (int j = 0; j < 4; j++) {
      v[j] = *(const float4*)(xr + lane * 4 + 256 * j);
      ss += v[j].x * v[j].x + v[j].y * v[j].y + v[j].z * v[j].z + v[j].w * v[j].w;
    }
#pragma unroll
    for (int o = 32; o >= 1; o >>= 1) ss += __shfl_xor(ss, o);
    float rstd = rsqrtf(ss * (1.f / DM) + 1e-6f);
#pragma unroll
    for (int j = 0; j < 4; j++) {
      uint2 o;
      o.x = pk2(v[j].x * rstd * gv[j].x, v[j].y * rstd * gv[j].y);
      o.y = pk2(v[j].z * rstd * gv[j].z, v[j].w * rstd * gv[j].w);
      *(uint2*)(hdst + (size_t)row * DM + lane * 4 + 256 * j) = o;
    }
  }
}

__device__ void final_norm_phase(float* __restrict__ x, const float* __restrict__ g, int row0, int nrows) {
  const int tid = opaque_tid();
  const int lane = tid & 63;
  const int gw = blockIdx.x * 8 + (tid >> 6), nw = gridDim.x * 8;
  float4 gv[4];
#pragma unroll
  for (int j = 0; j < 4; j++) gv[j] = *(const float4*)(g + lane * 4 + 256 * j);
  for (int row = gw; row < nrows; row += nw) {
    float* xr = x + (size_t)(row0 + row) * DM;
    float4 v[4];
    float ss = 0.f;
#pragma unroll
    for (int j = 0; j < 4; j++) {
      v[j] = *(const float4*)(xr + lane * 4 + 256 * j);
      ss += v[j].x * v[j].x + v[j].y * v[j].y + v[j].z * v[j].z + v[j].w * v[j].w;
    }
#pragma unroll
    for (int o = 32; o >= 1; o >>= 1) ss += __shfl_xor(ss, o);
    float rstd = rsqrtf(ss * (1.f / DM) + 1e-6f);
#pragma unroll
    for (int j = 0; j < 4; j++) {
      float4 o;
      o.x = v[j].x * rstd * gv[j].x; o.y = v[j].y * rstd * gv[j].y;
      o.z = v[j].z * rstd * gv[j].z; o.w = v[j].w * rstd * gv[j].w;
      *(float4*)(xr + lane * 4 + 256 * j) = o;
    }
  }
}

struct ARow {
  const u16* p; int ld;
  __device__ __forceinline__ const u16* operator()(int row, int k) const { return p + (size_t)row * ld + k; }
};
struct ACmp {
  const u16* p;
  __device__ __forceinline__ const u16* operator()(int row, int k) const {
    int t = 16 * row + (k >> 6); t = t > (TSEQ - 1) ? (TSEQ - 1) : t;
    return p + (size_t)t * INC + (k & 63);
  }
};

template <class AF>
__device__ __forceinline__ void gemm_mainloop(AF af, const u16* __restrict__ Bt, int ldb, int K, char* smem,
                                              f32x16 (&acc)[2][2], const int tid) {
  const int lane = tid & 63, r = lane & 31, h = lane >> 5, w = tid >> 6;
  const int wm = w >> 1, wn = w & 1;
  const int lrow = tid >> 3, lch = tid & 7;
  uint4 ra[4], rb[4];
  const int nk = K >> 6;
#pragma unroll
  for (int j = 0; j < 4; j++) {
    int row = lrow + 32 * j;
    ra[j] = *(const uint4*)af(row, lch * 8);
    rb[j] = *(const uint4*)(Bt + (size_t)row * ldb + lch * 8);
  }
#pragma unroll
  for (int j = 0; j < 4; j++) {
    int row = lrow + 32 * j;
    int off = row * 128 + ((lch ^ ((row >> 1) & 7)) << 4);
    *(uint4*)(smem + off) = ra[j];
    *(uint4*)(smem + 16384 + off) = rb[j];
  }
  __syncthreads();
  for (int it = 0; it < nk; it++) {
    const bool more = (it + 1) < nk;
    if (more) {
      const int k0 = (it + 1) * 64;
#pragma unroll
      for (int j = 0; j < 4; j++) {
        int row = lrow + 32 * j;
        ra[j] = *(const uint4*)af(row, k0 + lch * 8);
        rb[j] = *(const uint4*)(Bt + (size_t)row * ldb + k0 + lch * 8);
      }
    }
    const char* sa = smem + (it & 1) * 32768;
    const char* sb = sa + 16384;
#pragma unroll
    for (int kk = 0; kk < 4; kk++) {
      bf16x8 a[2], b[2];
#pragma unroll
      for (int mi = 0; mi < 2; mi++) {
        int row = wm * 64 + mi * 32 + r;
        a[mi] = ldfrag(sa + row * 128 + (((kk * 2 + h) ^ ((row >> 1) & 7)) << 4));
      }
#pragma unroll
      for (int ni = 0; ni < 2; ni++) {
        int row = wn * 64 + ni * 32 + r;
        b[ni] = ldfrag(sb + row * 128 + (((kk * 2 + h) ^ ((row >> 1) & 7)) << 4));
      }
#pragma unroll
      for (int mi = 0; mi < 2; mi++)
#pragma unroll
        for (int ni = 0; ni < 2; ni++) acc[mi][ni] = mfma32(a[mi], b[ni], acc[mi][ni]);
    }
    if (more) {
      char* sd = smem + ((it + 1) & 1) * 32768;
#pragma unroll
      for (int j = 0; j < 4; j++) {
        int row = lrow + 32 * j;
        int off = row * 128 + ((lch ^ ((row >> 1) & 7)) << 4);
        *(uint4*)(sd + off) = ra[j];
        *(uint4*)(sd + 16384 + off) = rb[j];
      }
    }
    __syncthreads();
  }
}

__device__ __forceinline__ void zero_acc(f32x16 (&acc)[2][2]) {
#pragma unroll
  for (int a = 0; a < 2; a++)
#pragma unroll
    for (int b = 0; b < 2; b++)
#pragma unroll
      for (int i = 0; i < 16; i++) acc[a][b][i] = 0.f;
}

typedef __attribute__((ext_vector_type(8))) short s16x8;
#define G_TILE_B 32768
#define G_STAGE_B 65536
__device__ __forceinline__ int g_lds_byte(int r, int c) {
  int st = (r >> 4) * 2 + (c >> 5), ob = (r & 15) * 64 + (c & 31) * 2;
  return st * 1024 + (ob ^ (((ob >> 9) & 1) << 5));
}
__device__ __forceinline__ void g_stage_rc(int b, int& R, int& C) {
  int st = b >> 10, sb = b & 1023, swz = sb ^ (((sb >> 9) & 1) << 5);
  R = (st >> 1) * 16 + swz / 64;
  C = (st & 1) * 32 + (swz % 64) / 2;
}
#define G_WAIT_V0() asm volatile("s_waitcnt vmcnt(0)" ::: "memory")

struct GTile { int pm, pn; };
__device__ __forceinline__ bool g_next(int i, int G, int c, int nM, int nN, GTile& u) {
  const int nwg = nM * nN;
  const int L = i * G + c;
  if (L >= nwg) return false;
  int wgid = L;
  { const int q = nwg / 8, r = nwg % 8, xcd = wgid % 8, off = wgid / 8; wgid = (xcd < r ? xcd * (q + 1) : r * (q + 1) + (xcd - r) * q) + off; }
  const int nig = 8 * nN, gid = wgid / nig, fm = gid * 8, gsz = (nM - fm) < 8 ? (nM - fm) : 8;
  u.pm = fm + ((wgid % nig) % gsz);
  u.pn = (wgid % nig) / gsz;
  return true;
}

__device__ __forceinline__ void g_kloop(const u16* __restrict__ Ab, const u16* __restrict__ Bb, const int K, char* smem,
                                        f32x4 (&acc)[8][4], const int tid) {
  const int wid = tid >> 6, lane = tid & 63, wr = wid >> 2, wc = wid & 3, fr = lane & 15, fq = lane >> 4;
  int sR0, sC0, sR1, sC1, sR2, sC2, sR3, sC3;
  g_stage_rc(wid * 1024 + 0 * 8192 + lane * 16, sR0, sC0);
  g_stage_rc(wid * 1024 + 1 * 8192 + lane * 16, sR1, sC1);
  g_stage_rc(wid * 1024 + 2 * 8192 + lane * 16, sR2, sC2);
  g_stage_rc(wid * 1024 + 3 * 8192 + lane * 16, sR3, sC3);
  const long o0 = (long)sR0 * K + sC0, o1 = (long)sR1 * K + sC1, o2 = (long)sR2 * K + sC2, o3 = (long)sR3 * K + sC3;
#define G_STAGE(buf, kt)                                                                                              \
  {                                                                                                                  \
    char* sa_ = smem + (buf) * G_STAGE_B + wid * 1024;                                                               \
    char* sb_ = sa_ + G_TILE_B;                                                                                      \
    const u16* ga_ = Ab + (kt) * 64;                                                                                 \
    const u16* gb_ = Bb + (kt) * 64;                                                                                 \
    __builtin_amdgcn_global_load_lds((const unsigned*)(ga_ + o0), (unsigned*)(sa_), 16, 0, 0);                       \
    __builtin_amdgcn_global_load_lds((const unsigned*)(gb_ + o0), (unsigned*)(sb_), 16, 0, 0);                       \
    __builtin_amdgcn_global_load_lds((const unsigned*)(ga_ + o1), (unsigned*)(sa_ + 8192), 16, 0, 0);                \
    __builtin_amdgcn_global_load_lds((const unsigned*)(gb_ + o1), (unsigned*)(sb_ + 8192), 16, 0, 0);                \
    __builtin_amdgcn_global_load_lds((const unsigned*)(ga_ + o2), (unsigned*)(sa_ + 16384), 16, 0, 0);               \
    __builtin_amdgcn_global_load_lds((const unsigned*)(gb_ + o2), (unsigned*)(sb_ + 16384), 16, 0, 0);               \
    __builtin_amdgcn_global_load_lds((const unsigned*)(ga_ + o3), (unsigned*)(sa_ + 24576), 16, 0, 0);               \
    __builtin_amdgcn_global_load_lds((const unsigned*)(gb_ + o3), (unsigned*)(sb_ + 24576), 16, 0, 0);               \
  }
  const int nt = K >> 6;
  G_STAGE(0, 0);
  G_WAIT_V0();
  __syncthreads();
  for (int t = 0; t < nt; ++t) {
    const int cur = t & 1;
    if (t + 1 < nt) G_STAGE(cur ^ 1, t + 1);
    const char* sa = smem + cur * G_STAGE_B;
    const char* sb = sa + G_TILE_B;
#pragma unroll
    for (int ks = 0; ks < 2; ++ks) {
      s16x8 At[8], Bf[4];
#pragma unroll
      for (int m = 0; m < 8; ++m) At[m] = *(const s16x8*)(sa + g_lds_byte(wr * 128 + m * 16 + fr, ks * 32 + fq * 8));
#pragma unroll
      for (int n = 0; n < 4; ++n) Bf[n] = *(const s16x8*)(sb + g_lds_byte(wc * 64 + n * 16 + fr, ks * 32 + fq * 8));
#pragma unroll
      for (int m = 0; m < 8; ++m)
#pragma unroll
        for (int n = 0; n < 4; ++n)
          acc[m][n] = __builtin_amdgcn_mfma_f32_16x16x32_bf16(__builtin_bit_cast(bf16x8, Bf[n]), __builtin_bit_cast(bf16x8, At[m]), acc[m][n], 0, 0, 0);
      __builtin_amdgcn_sched_barrier(0);
    }
    G_WAIT_V0();
    __syncthreads();
  }
}

__device__ __forceinline__ void g_zero(f32x4 (&acc)[8][4]) {
#pragma unroll
  for (int m = 0; m < 8; m++)
#pragma unroll
    for (int n = 0; n < 4; n++) acc[m][n] = (f32x4){0.f, 0.f, 0.f, 0.f};
}
__device__ __forceinline__ uint2 pk4(f32x4 v) { return make_uint2(pk2(v[0], v[1]), pk2(v[2], v[3])); }

__device__ __forceinline__ void wave_store_rows(char* wsm, u16* gbase, const size_t ld, const f32x4 (&acc)[8][4], const int lane) {
  const int fr = lane & 15, fq = lane >> 4;
#pragma unroll
  for (int m = 0; m < 8; m++)
#pragma unroll
    for (int n = 0; n < 4; n++) {
      const int row = m * 16 + fr, chunk = n * 2 + (fq >> 1);
      *(uint2*)(wsm + row * 128 + ((chunk ^ (fr & 7)) << 4) + (fq & 1) * 8) = pk4(acc[m][n]);
    }
  const int rr = lane >> 3, ch = lane & 7;
#pragma unroll
  for (int i = 0; i < 16; i++) {
    const int row = i * 8 + rr;
    const uint4 v = *(const uint4*)(wsm + row * 128 + ((ch ^ (row & 7)) << 4));
    typedef __attribute__((ext_vector_type(4))) unsigned u32x4_t;
    __builtin_nontemporal_store(__builtin_bit_cast(u32x4_t, v), (u32x4_t*)(gbase + (size_t)row * ld + ch * 8));
  }
}
__device__ __forceinline__ void wave_store_cols(char* wsm, u16* vt, const int vcol0, const int nh, const int bl, const int t0,
                                                const f32x4 (&acc)[8][4], const int lane) {
  const int fr = lane & 15, fq = lane >> 4;
#pragma unroll
  for (int m = 0; m < 8; m++)
#pragma unroll
    for (int n = 0; n < 4; n++)
#pragma unroll
      for (int j = 0; j < 4; j++) {
        const int d = n * 16 + fq * 4 + j, t = m * 16 + fr;
        *(u16*)(wsm + d * 256 + (((t >> 3) ^ (d & 15)) << 4) + (t & 7) * 2) = f2bf(acc[m][n][j]);
      }
  const int dd = lane >> 4, ch = lane & 15;
#pragma unroll
  for (int i = 0; i < 16; i++) {
    const int d = i * 4 + dd;
    const uint4 v = *(const uint4*)(wsm + d * 256 + ((ch ^ (d & 15)) << 4));
    const int vcol = vcol0 + d;
    *(uint4*)(vt + ((size_t)(bl * nh + (vcol >> 6)) * 64 + (vcol & 63)) * TSEQ + t0 + ch * 8) = v;
  }
}

__device__ void gemm1_phase(const Params& P, int layer, char* smem) {
  const int CT = P.NB * TSEQ;
  const int nM = CT >> 8, nN = INCP >> 8;
  const u16* Bt = P.WinT + (size_t)layer * INCP * DM;
  u16* p_qr = P.qr; u16* p_proj = P.proj;
  asm volatile("" : "+s"(p_qr), "+s"(p_proj));
  for (int i = 0;; i++) {
    GTile u;
    if (!g_next(i, gridDim.x, blockIdx.x, nM, nN, u)) break;
    const int tid = opaque_tid(), wid = tid >> 6, lane = tid & 63, wr = wid >> 2, wc = wid & 3, fr = lane & 15, fq = lane >> 4;
    f32x4 acc[8][4];
    g_zero(acc);
    g_kloop(P.h + (size_t)(u.pm * 256) * DM, Bt + (size_t)(u.pn * 256) * DM, DM, smem, acc, tid);
    const int cw = u.pn * 256 + wc * 64;
    const int row0 = u.pm * 256 + wr * 128 + fr;
    char* wsm = smem + wid * 16384;
    const int rowb = u.pm * 256 + wr * 128;
    const bool rope_q = cw < 1024;
    const bool rope_k = (cw >= C_KV + 256 && cw < C_KV + 384) || (cw >= C_KV + 512 && cw < C_KV + 640);
    const bool mixed = (cw == 5888);
    if (cw >= INC) {
    } else if (rope_q || rope_k) {
      if (rope_q) wave_store_rows(wsm, p_proj + (size_t)rowb * INC + cw, INC, acc, lane);
#pragma unroll
      for (int m = 0; m < 8; m++) {
        const int tt = (row0 + m * 16) & (TSEQ - 1);
#pragma unroll
        for (int n = 0; n < 2; n++) {
          const float4 c = *(const float4*)(P.ropec + tt * 32 + n * 16 + fq * 4);
          const float4 sn = *(const float4*)(P.ropes + tt * 32 + n * 16 + fq * 4);
          const f32x4 x1 = acc[m][n], x2 = acc[m][n + 2];
          f32x4 r1, r2;
          r1[0] = x1[0] * c.x - x2[0] * sn.x; r2[0] = x2[0] * c.x + x1[0] * sn.x;
          r1[1] = x1[1] * c.y - x2[1] * sn.y; r2[1] = x2[1] * c.y + x1[1] * sn.y;
          r1[2] = x1[2] * c.z - x2[2] * sn.z; r2[2] = x2[2] * c.z + x1[2] * sn.z;
          r1[3] = x1[3] * c.w - x2[3] * sn.w; r2[3] = x2[3] * c.w + x1[3] * sn.w;
          acc[m][n] = r1; acc[m][n + 2] = r2;
        }
      }
      if (rope_q) wave_store_rows(wsm, p_qr + (size_t)rowb * DM + cw, DM, acc, lane);
      else wave_store_rows(wsm, p_proj + (size_t)rowb * INC + cw, INC, acc, lane);
    } else if (!mixed) {
      wave_store_rows(wsm, p_proj + (size_t)rowb * INC + cw, INC, acc, lane);
    } else {
#pragma unroll
      for (int n = 0; n < 4; n++) {
        const int c0 = cw + n * 16 + fq * 4;
        if (c0 < C_FB) {
#pragma unroll
          for (int m = 0; m < 8; m++) *(uint2*)(p_proj + (size_t)(row0 + m * 16) * INC + c0) = pk4(acc[m][n]);
        } else {
#pragma unroll
          for (int m = 0; m < 8; m++)
            *(float4*)(P.flog + (size_t)(row0 + m * 16) * 16 + (c0 - C_FB)) = make_float4(acc[m][n][0], acc[m][n][1], acc[m][n][2], acc[m][n][3]);
        }
        __builtin_amdgcn_sched_barrier(0);
      }
    }
    __syncthreads();
  }
}

__device__ void gemm2_phase(const Params& P, int layer, char* smem) {
  const int CT = P.NB * TSEQ;
  const int nM = CT >> 8, nN = 4;
  const u16* p_ya = P.ya; const u16* p_yb = P.yb; const u16* p_wa = P.WpaT; const u16* p_wb = P.WpbT;
  for (int i = 0;; i++) {
    GTile u;
    if (!g_next(i, gridDim.x, blockIdx.x, nM, nN, u)) break;
    const int tid = opaque_tid(), wid = tid >> 6, lane = tid & 63, wr = wid >> 2, wc = wid & 3, fr = lane & 15, fq = lane >> 4;
    f32x4 acc[8][4];
    g_zero(acc);
#pragma unroll 1
    for (int pass = 0; pass < 2; pass++) {
      const u16* Ap = (pass ? p_yb : p_ya) + (size_t)(u.pm * 256) * DM;
      const u16* Bp = (pass ? p_wb : p_wa) + (size_t)layer * DM * DM + (size_t)(u.pn * 256) * DM;
      g_kloop(Ap, Bp, DM, smem, acc, tid);
      __builtin_amdgcn_sched_barrier(0);
      if (pass == 0) {
        const int tid1 = opaque_tid(), wid1 = tid1 >> 6, lane1 = tid1 & 63, wr1 = wid1 >> 2, wc1 = wid1 & 3, fr1 = lane1 & 15, fq1 = lane1 >> 4;
        const u16* pp = P.proj + (size_t)(u.pm * 256 + wr1 * 128 + fr1) * INC + u.pn * 256 + wc1 * 64 + fq1 * 4;
#pragma unroll
        for (int m = 0; m < 8; m++) {
#pragma unroll
          for (int n = 0; n < 4; n++) {
            const uint2 ra = *(const uint2*)(pp + (size_t)(m * 16) * INC + C_RA + n * 16);
            const uint2 rb = *(const uint2*)(pp + (size_t)(m * 16) * INC + C_RB + n * 16);
            acc[m][n][0] *= (1.f + __expf(-bflo(rb.x))) / (1.f + __expf(-bflo(ra.x)));
            acc[m][n][1] *= (1.f + __expf(-bfhi(rb.x))) / (1.f + __expf(-bfhi(ra.x)));
            acc[m][n][2] *= (1.f + __expf(-bflo(rb.y))) / (1.f + __expf(-bflo(ra.y)));
            acc[m][n][3] *= (1.f + __expf(-bfhi(rb.y))) / (1.f + __expf(-bfhi(ra.y)));
          }
          __builtin_amdgcn_sched_barrier(0);
        }
      }
    }
    {
      const int tid2 = opaque_tid(), wid2 = tid2 >> 6, lane2 = tid2 & 63, wr2 = wid2 >> 2, wc2 = wid2 & 3, fr2 = lane2 & 15, fq2 = lane2 >> 4;
      const u16* pp = P.proj + (size_t)(u.pm * 256 + wr2 * 128 + fr2) * INC + u.pn * 256 + wc2 * 64 + fq2 * 4;
#pragma unroll
      for (int m = 0; m < 8; m++) {
#pragma unroll
        for (int n = 0; n < 4; n++) {
          const uint2 rb = *(const uint2*)(pp + (size_t)(m * 16) * INC + C_RB + n * 16);
          acc[m][n][0] *= sigmoidf_(bflo(rb.x)); acc[m][n][1] *= sigmoidf_(bfhi(rb.x));
          acc[m][n][2] *= sigmoidf_(bflo(rb.y)); acc[m][n][3] *= sigmoidf_(bfhi(rb.y));
        }
        __builtin_amdgcn_sched_barrier(0);
      }
      wave_store_rows(smem + wid2 * 16384, P.h + (size_t)(u.pm * 256 + wr2 * 128) * DM + u.pn * 256 + wc2 * 64, DM, acc, lane2);
    }
    __syncthreads();
  }
}

__device__ void gemm3_phase(const Params& P, int layer, int chunk, char* smem) {
  const int CT = P.NB * TSEQ;
  const int nM = CT >> 8, nN = 4;
  const float* xs = (layer == 0 ? P.x_in : P.out) + (size_t)chunk * CT * DM;
  float* xd = P.out + (size_t)chunk * CT * DM;
  for (int i = 0;; i++) {
    GTile u;
    if (!g_next(i, gridDim.x, blockIdx.x, nM, nN, u)) break;
    const int tid = opaque_tid(), wid = tid >> 6, lane = tid & 63, wr = wid >> 2, wc = wid & 3, fr = lane & 15, fq = lane >> 4;
    f32x4 acc[8][4];
    g_zero(acc);
    g_kloop(P.h + (size_t)(u.pm * 256) * DM, P.WoT + (size_t)layer * DM * DM + (size_t)(u.pn * 256) * DM, DM, smem, acc, tid);
    const size_t off = (size_t)(u.pm * 256 + wr * 128 + fr) * DM + u.pn * 256 + wc * 64 + fq * 4;
#pragma unroll
    for (int m = 0; m < 8; m++) {
#pragma unroll
      for (int n = 0; n < 4; n++) {
        const float4 xo = *(const float4*)(xs + off + (size_t)(m * 16) * DM + n * 16);
        *(float4*)(xd + off + (size_t)(m * 16) * DM + n * 16) =
            make_float4(xo.x + acc[m][n][0], xo.y + acc[m][n][1], xo.z + acc[m][n][2], xo.w + acc[m][n][3]);
      }
      __builtin_amdgcn_sched_barrier(0);
    }
  }
}

__device__ void pb_phase(const Params& P, int layer, char* smem_all) {
  const int tid_all = opaque_tid();
  const int half = tid_all >> 8, tid = tid_all & 255;
  char* smem = smem_all + half * 65536;
  const int lane = tid & 63, r = lane & 31, h = lane >> 5, w = tid >> 6;
  const int wm = w >> 1, wn = w & 1;
  const int nCmp = P.NB * 2;
  const int nScan = P.NB * 2;
  for (int it = blockIdx.x; it < nCmp + nScan; it += gridDim.x) {
    if (it < nCmp) {
      const int unit = it * 2 + half;
      const int bl = unit >> 2, g = (unit >> 1) & 1, kv = unit & 1;
      f32x16 acc[2][2];
      zero_acc(acc);
      ACmp af{P.proj + (size_t)bl * TSEQ * INC + C_KV + kv * 128 + g * 64};
      gemm_mainloop(af, P.W1T + (size_t)(layer * 2 + kv) * 128 * 2048, 2048, 2048, smem, acc, tid);
      const float* bp = P.bias1p + (size_t)((layer * 2 + kv) * 8) * 128;
#pragma unroll
      for (int ni = 0; ni < 2; ni++) {
        int hc = wn * 64 + ni * 32 + r;
        float b1 = 0.f;
#pragma unroll
        for (int q = 0; q < 8; q++) b1 += bp[q * 128 + hc];
#pragma unroll
        for (int mi = 0; mi < 2; mi++)
#pragma unroll
          for (int i = 0; i < 16; i++) {
            int n = wm * 64 + mi * 32 + 8 * (i >> 2) + 4 * h + (i & 3);
            float v = siluf_(acc[mi][ni][i] + b1);
            *(u16*)(smem + n * 256 + (((hc >> 3) ^ (n & 15)) << 4) + (hc & 7) * 2) = f2bf(v);
          }
      }
      __syncthreads();
      const u16* w2t = P.W2T + (size_t)(layer * 2 + kv) * 64 * 128;
      f32x16 o2[2];
#pragma unroll
      for (int dt = 0; dt < 2; dt++)
#pragma unroll
        for (int i = 0; i < 16; i++) o2[dt][i] = 0.f;
#pragma unroll
      for (int kk = 0; kk < 8; kk++) {
        int n = w * 32 + r;
        bf16x8 a = ldfrag(smem + n * 256 + (((kk * 2 + h) ^ (n & 15)) << 4));
#pragma unroll
        for (int dt = 0; dt < 2; dt++) {
          bf16x8 b = ldfrag(w2t + (size_t)(dt * 32 + r) * 128 + kk * 16 + h * 8);
          o2[dt] = mfma32(a, b, o2[dt]);
        }
      }
#pragma unroll
      for (int dt = 0; dt < 2; dt++) {
        int d = dt * 32 + r;
        if (kv == 0) {
#pragma unroll
          for (int i = 0; i < 16; i++) {
            int n = w * 32 + 8 * (i >> 2) + 4 * h + (i & 3);
            P.kcmp[((size_t)(bl * 2 + g) * 128 + n) * 64 + d] = f2bf(o2[dt][i]);
          }
        } else {
#pragma unroll
          for (int gq = 0; gq < 4; gq++) {
            int n0 = w * 32 + 8 * gq + 4 * h;
            uint2 o;
            o.x = pk2(o2[dt][gq * 4 + 0], o2[dt][gq * 4 + 1]);
            o.y = pk2(o2[dt][gq * 4 + 2], o2[dt][gq * 4 + 3]);
            *(uint2*)(P.vcmpt + ((size_t)(bl * 2 + g) * 64 + d) * 128 + n0) = o;
          }
        }
      }
      __syncthreads();
    } else {
      const int sidx = (it - nCmp) * 8 + (tid_all >> 6);
      const int bl = sidx >> 4, hh = sidx & 15;
      const float bf = P.b_forget[layer * 16 + hh];
      const float* fl = P.flog + ((size_t)bl * TSEQ + lane * 32) * 16 + hh;
      float loc = 0.f;
#pragma unroll 8
      for (int j = 0; j < 32; j++) {
        float x = fl[j * 16] + bf;
        float ls = (x >= 0.f) ? -log1pf(__expf(-x)) : (x - log1pf(__expf(x)));
        loc += ls;
      }
      float incl = loc;
#pragma unroll
      for (int o = 1; o < 64; o <<= 1) {
        float v = __shfl_up(incl, o);
        if (lane >= o) incl += v;
      }
      float run = incl - loc;
      float* fo = P.F2 + ((size_t)bl * 16 + hh) * TSEQ + lane * 32;
#pragma unroll 8
      for (int j = 0; j < 32; j++) {
        float x = fl[j * 16] + bf;
        float ls = (x >= 0.f) ? -log1pf(__expf(-x)) : (x - log1pf(__expf(x)));
        run += ls;
        fo[j] = -8.0f * run;
      }
    }
  }
}

__device__ void pc1_phase(const Params& P, char* smem) {
  const int tid = opaque_tid(),  lane = tid & 63, r = lane & 31, h = lane >> 5, w = tid >> 6;
  const int nItems = P.NB * 2 * 8;
  const float c1 = 0.125f * LOG2E;
  for (int it = blockIdx.x; it < nItems; it += gridDim.x) {
    const int qt = it & 7, g = (it >> 3) & 1, bl = it >> 4;
    __syncthreads();
#pragma unroll
    for (int j = 0; j < 2; j++) {
      int c = tid + 512 * j;
      {
        int n = c >> 3, ch = c & 7;
        uint4 v = *(const uint4*)(P.kcmp + ((size_t)(bl * 2 + g) * 128 + n) * 64 + ch * 8);
        *(uint4*)(smem + n * 128 + ((ch ^ ((n >> 1) & 7)) << 4)) = v;
      }
      {
        int d = c >> 4, ch = c & 15;
        uint4 v = *(const uint4*)(P.vcmpt + ((size_t)(bl * 2 + g) * 64 + d) * 128 + ch * 8);
        int sw = d & 31;
        *(uint2*)(smem + 16384 + d * 256 + (((2 * ch) ^ sw) << 3)) = make_uint2(v.x, v.y);
        *(uint2*)(smem + 16384 + d * 256 + (((2 * ch + 1) ^ sw) << 3)) = make_uint2(v.z, v.w);
      }
    }
    __syncthreads();
    const int qw_lo = qt * 256 + w * 32;
    const int qtok = qw_lo + r;
    const size_t rowg = (size_t)bl * TSEQ + qtok;
    const int tq = qtok - 31 - 64 * h;
    float sumacc[16], lastacc[16];
#pragma unroll
    for (int s = 0; s < 16; s++) { sumacc[s] = 0.f; lastacc[s] = 0.f; }
#pragma unroll 1
    for (int hh = 0; hh < 8; hh++) {
      const int head = g * 8 + hh;
      bf16x8 qf[4];
#pragma unroll
      for (int kk = 0; kk < 4; kk++) qf[kk] = ldfrag(P.proj + rowg * INC + C_QA + head * 64 + kk * 16 + h * 8);
      f32x16 s[4];
#pragma unroll
      for (int nt = 0; nt < 4; nt++) {
#pragma unroll
        for (int i = 0; i < 16; i++) s[nt][i] = 0.f;
#pragma unroll
        for (int kk = 0; kk < 4; kk++) {
          int row = nt * 32 + r;
          bf16x8 a = ldfrag(smem + row * 128 + (((kk * 2 + h) ^ ((row >> 1) & 7)) << 4));
          s[nt] = mfma32(a, qf[kk], s[nt]);
        }
        __builtin_amdgcn_sched_barrier(0);
      }
      float mx = -3.0e38f;
#pragma unroll
      for (int nt = 0; nt < 4; nt++)
#pragma unroll
        for (int i = 0; i < 16; i++) {
          bool ok = (16 * (nt * 32 + 8 * (i >> 2) + (i & 3))) <= tq;
          float v = ok ? s[nt][i] * c1 : -3.0e38f;
          s[nt][i] = v;
          mx = fmaxf(mx, v);
        }
      mx = fmaxf(mx, __shfl_xor(mx, 32));
      const bool anyv = mx > -1.0e37f;
      float mref = anyv ? mx : 0.f;
      float l = 0.f;
#pragma unroll
      for (int nt = 0; nt < 4; nt++)
#pragma unroll
        for (int i = 0; i < 16; i++) {
          float p = __builtin_amdgcn_exp2f(s[nt][i] - mref);
          s[nt][i] = p;
          l += p;
        }
      l += __shfl_xor(l, 32);
      const float inv = (anyv && l > 0.f) ? 1.f / l : 0.f;
#pragma unroll
      for (int nt = 0; nt < 4; nt++)
#pragma unroll
        for (int i = 0; i < 16; i++) s[nt][i] *= inv;
#pragma unroll
      for (int nt = 0; nt < 4; nt++)
#pragma unroll
        for (int gq = 0; gq < 4; gq++) {
          sumacc[nt * 4 + gq] += (s[nt][gq * 4] + s[nt][gq * 4 + 1]) + (s[nt][gq * 4 + 2] + s[nt][gq * 4 + 3]);
          lastacc[nt * 4 + gq] += s[nt][gq * 4 + 3];
        }
      uint4 pbv[8];
#pragma unroll
      for (int ks = 0; ks < 8; ks++) {
        const int nt = ks >> 1, hb = (ks & 1) * 8;
        pbv[ks].x = pk2(s[nt][hb + 0], s[nt][hb + 1]); pbv[ks].y = pk2(s[nt][hb + 2], s[nt][hb + 3]);
        pbv[ks].z = pk2(s[nt][hb + 4], s[nt][hb + 5]); pbv[ks].w = pk2(s[nt][hb + 6], s[nt][hb + 7]);
      }
      const float g0 = sigmoidf_(bf2f(P.proj[rowg * INC + C_GA + head]));
#pragma unroll
      for (int dt = 0; dt < 2; dt++) {
        f32x16 o;
#pragma unroll
        for (int i = 0; i < 16; i++) o[i] = 0.f;
        const int d = dt * 32 + r, sw = d & 31;
#pragma unroll
        for (int ks = 0; ks < 8; ks++) {
          uint2 lo = *(const uint2*)(smem + 16384 + d * 256 + (((ks * 4 + h) ^ sw) << 3));
          uint2 hi = *(const uint2*)(smem + 16384 + d * 256 + (((ks * 4 + 2 + h) ^ sw) << 3));
          uint4 au = make_uint4(lo.x, lo.y, hi.x, hi.y);
          o = mfma32(__builtin_bit_cast(bf16x8, au), __builtin_bit_cast(bf16x8, pbv[ks]), o);
        }
#pragma unroll
        for (int gq = 0; gq < 4; gq++) {
          int d0 = dt * 32 + 8 * gq + 4 * h;
          uint2 ov;
          ov.x = pk2(o[gq * 4 + 0] * g0, o[gq * 4 + 1] * g0);
          ov.y = pk2(o[gq * 4 + 2] * g0, o[gq * 4 + 3] * g0);
          *(uint2*)(P.ya + rowg * DM + head * 64 + d0) = ov;
        }
        __builtin_amdgcn_sched_barrier(0);
      }
    }
    float sc[16];
#pragma unroll
    for (int s = 0; s < 16; s++) {
      float prev = (s == 0) ? 0.f : lastacc[s - 1];
      float sendv = h ? prev : lastacc[s];
      float recv = __shfl_xor(sendv, 32);
      float imp = sumacc[s] + recv;
      int j = (s >> 2) * 8 + (s & 3) * 2 + h;
      int cur = qtok >> 6;
      bool forced = (j == 0) || (j == cur) || (j == cur - 1);
      bool valid = j <= cur;
      sc[s] = forced ? 1.0e4f : (valid ? imp : -1.0f);
    }
    unsigned mask = 0u;
#pragma unroll 1
    for (int rd = 0; rd < 8; rd++) {
      float best = -2.0f; int bj = 0;
#pragma unroll
      for (int s = 0; s < 16; s++) {
        int j = (s >> 2) * 8 + (s & 3) * 2 + h;
        if (sc[s] > best) { best = sc[s]; bj = j; }
      }
      float ob = __shfl_xor(best, 32);
      int oj = __shfl_xor(bj, 32);
      bool mine = (best > ob) || (best == ob && bj < oj);
      int wj = mine ? bj : oj;
      mask |= 1u << wj;
#pragma unroll
      for (int s = 0; s < 16; s++) {
        int j = (s >> 2) * 8 + (s & 3) * 2 + h;
        if (j == wj) sc[s] = -3.0f;
      }
    }
    if (h == 0) P.sel[(size_t)(bl * 2 + g) * TSEQ + qtok] = mask;
  }
}

#define A_SLOTB 8192
#define A_LDS_K 0
#define A_LDS_V 24576
#define A_LDS_WS 49152
#define A_LDS_F 51200
#define A_LDS_OST 52224
#define A_THR 8.0f
#define A_C2 (0.125f * LOG2E)
typedef __attribute__((ext_vector_type(4))) short a_s16x4;
typedef __attribute__((ext_vector_type(8))) short a_s16x8;
typedef __attribute__((ext_vector_type(4))) unsigned a_u32x4;
typedef __attribute__((address_space(3))) const char* a_lds_cptr;
typedef short a_v4i16 __attribute__((ext_vector_type(4)));
#define A_SBAR() __builtin_amdgcn_sched_barrier(0)
#define A_PIN(x) asm volatile("" : "+v"(x))
#define A_MFMA(a, b, c) __builtin_amdgcn_mfma_f32_32x32x16_bf16(a, b, c, 0, 0, 0)
template <int N> __device__ __forceinline__ void a_wait_bar() { asm volatile("s_waitcnt vmcnt(%0) lgkmcnt(0)\n\ts_barrier" ::"n"(N) : "memory"); }
__device__ __forceinline__ int a_crow(int r, int hi) { return (r & 3) + 8 * (r >> 2) + 4 * hi; }
__device__ __forceinline__ unsigned a_cvtpk(float lo, float hi) { unsigned r; asm("v_cvt_pk_bf16_f32 %0, %1, %2" : "=v"(r) : "v"(lo), "v"(hi)); return r; }
__device__ __forceinline__ void a_glds16(const void* g, unsigned lds_base) {
  unsigned sv; asm volatile("s_mov_b32 %0, m0\n\ts_mov_b32 m0, %2\n\ts_nop 0\n\tglobal_load_lds_dwordx4 %1, off\n\ts_mov_b32 m0, %0" : "=&s"(sv) : "v"(g), "s"(lds_base) : "memory"); }
__device__ __forceinline__ void a_glds4(const void* g, unsigned lds_base) {
  unsigned sv; asm volatile("s_mov_b32 %0, m0\n\ts_mov_b32 m0, %2\n\ts_nop 0\n\tglobal_load_lds_dword %1, off\n\ts_mov_b32 m0, %0" : "=&s"(sv) : "v"(g), "s"(lds_base) : "memory"); }
__device__ __forceinline__ void a_kload2(bf16x8* kf, a_lds_cptr kp, int d0) {
  kf[2 * d0] = *(const __attribute__((address_space(3))) bf16x8*)(kp + d0 * 2048);
  kf[2 * d0 + 1] = *(const __attribute__((address_space(3))) bf16x8*)(kp + d0 * 2048 + 512); }
__device__ __forceinline__ a_s16x4 a_vtr(a_lds_cptr p) { return __builtin_bit_cast(a_s16x4, __builtin_amdgcn_ds_read_tr16_b64_v4i16((__attribute__((address_space(3))) a_v4i16*)p)); }
#define A_MX3(a, b, c) __builtin_fmaxf(__builtin_fmaxf((a), (b)), (c))
__device__ __forceinline__ float a_rowmax(const f32x16& p0, const f32x16& p1) {
  float a = A_MX3(p0[0], p0[1], p1[0]), b = A_MX3(p0[2], p0[3], p1[1]); a = A_MX3(a, p1[2], p1[3]);
#pragma unroll
  for (int r = 4; r < 16; r += 4) { a = A_MX3(a, p0[r], p0[r + 1]); b = A_MX3(b, p0[r + 2], p0[r + 3]); a = A_MX3(a, p1[r], p1[r + 1]); b = A_MX3(b, p1[r + 2], p1[r + 3]); }
  float m = __builtin_fmaxf(a, b); auto rr = __builtin_amdgcn_permlane32_swap(__float_as_uint(m), __float_as_uint(m), false, false);
  return __builtin_fmaxf(__uint_as_float(rr[0]), __uint_as_float(rr[1])); }
template <int MODE>
__device__ __forceinline__ void a_mask(f32x16& p0, f32x16& p1, int key0, int qabs, int hi) {
  const int kb = key0 + 4 * hi;
#pragma unroll
  for (int r = 0; r < 16; ++r) {
    const int kv = kb + (r & 3) + 8 * (r >> 2);
    bool bad0 = kv > qabs, bad1 = (kv + 32) > qabs;
    if (MODE == 2) { bad0 = bad0 || (kv + 512 <= qabs); bad1 = bad1 || (kv + 32 + 512 <= qabs); }
    if (bad0) p0[r] = -INFINITY;
    if (bad1) p1[r] = -INFINITY;
  } }
__device__ __forceinline__ void a_bias(f32x16& p0, f32x16& p1, const char* fb, int hi) {
#pragma unroll
  for (int g = 0; g < 4; ++g) {
    const float4 b0 = *(const float4*)(fb + (8 * g + 4 * hi) * 4);
    const float4 b1 = *(const float4*)(fb + (32 + 8 * g + 4 * hi) * 4);
    p0[4 * g + 0] += b0.x; p0[4 * g + 1] += b0.y; p0[4 * g + 2] += b0.z; p0[4 * g + 3] += b0.w;
    p1[4 * g + 0] += b1.x; p1[4 * g + 1] += b1.y; p1[4 * g + 2] += b1.z; p1[4 * g + 3] += b1.w;
  } }

template <int MODE>
__device__ __forceinline__ void a_unit(const u16* __restrict__ Qw, const int qp, const u16* __restrict__ Kp, const u16* __restrict__ Vp,
                                       const float* __restrict__ Fp, const int NT, const int key00, const int qabs, const unsigned selm,
                                       const float gate, char* lds, u16* stg, const int tid) {
  constexpr int NK = (MODE == 0) ? 2 : 1;
  const int lane = tid & 63, r32 = lane & 31, hi = lane >> 5; const int wid = __builtin_amdgcn_readfirstlane(tid >> 6);
  const unsigned lds0 = (unsigned)(uintptr_t)lds; float* wsf = (float*)(lds + A_LDS_WS) + wid * 64;
  const u16* ksrc = Kp + (long)lane * INC + wid * 8;
  const u16* vsrc = Vp + (long)(16 * (wid & 3) + (lane >> 2)) * INC + (wid >> 2) * 32 + (lane & 3) * 8;
  const float* fsrc = Fp + lane;
  const unsigned kdst = lds0 + A_LDS_K + wid * 1024, vdst = lds0 + A_LDS_V + wid * 1024, fdst = lds0 + A_LDS_F;
#define A_DMA_K(t, slot) do { a_glds16(ksrc + (long)(t) * 64 * INC, (unsigned)__builtin_amdgcn_readfirstlane(kdst + (slot))); \
    if (MODE == 0) a_glds4(fsrc + (t) * 64, (unsigned)__builtin_amdgcn_readfirstlane(fdst + ((t) & 3) * 256)); } while (0)
#define A_DMA_V(t, slot) a_glds16(vsrc + (long)(t) * 64 * INC, (unsigned)__builtin_amdgcn_readfirstlane(vdst + (slot)))
  const a_lds_cptr vp0 = (a_lds_cptr)lds + A_LDS_V + ((lane >> 4) & 1) * 32 + (lane & 3) * 8 + (4 * hi + ((lane & 15) >> 2)) * 64;
  const a_lds_cptr kp0 = (a_lds_cptr)lds + A_LDS_K + hi * 1024 + r32 * 16;
  const char* fb0 = lds + A_LDS_F;
  A_DMA_K(0, 0); A_DMA_V(0, 0); A_DMA_K(1, A_SLOTB);
  bf16x8 qr[4];
#pragma unroll
  for (int d0 = 0; d0 < 4; ++d0) qr[d0] = ldfrag(Qw + (long)r32 * qp + d0 * 16 + hi * 8);
  float mhat = 0.f, l_reg = 0.f; f32x16 o[2];
#pragma unroll
  for (int r = 0; r < 16; ++r) { o[0][r] = 0.f; o[1][r] = 0.f; }
  const f32x16 zero16 = {0.f, 0.f, 0.f, 0.f, 0.f, 0.f, 0.f, 0.f, 0.f, 0.f, 0.f, 0.f, 0.f, 0.f, 0.f, 0.f};
  bool resc = false;
  f32x16 pA0, pA1, pB0, pB1; bf16x8 kf[8]; a_s16x4 vlo[8], vhi[8]; a_u32x4 pw0, pw1, pw2, pw3;
  int sl_prev = 0, sl_cur = 0, sl_next = A_SLOTB;
#define A_ROT() do { sl_prev = sl_cur; sl_cur = sl_next; sl_next = (sl_next == 2 * A_SLOTB) ? 0 : sl_next + A_SLOTB; } while (0)
#define A_EX(v) __builtin_amdgcn_exp2f(__builtin_fmaf((v), A_C2, nmh))
#define A_RESC() do { if (resc) { _Pragma("unroll") for (int d_ = 0; d_ < 2; ++d_) _Pragma("unroll") for (int r = 0; r < 16; ++r) o[d_][r] *= wsf[a_crow(r, hi)]; } } while (0)
  A_DMA_K(2, 2 * A_SLOTB);
  a_wait_bar<1 + 2 * NK>();
  _Pragma("unroll") for (int d0 = 0; d0 < 4; ++d0) a_kload2(kf, kp0, d0);
  pA0 = A_MFMA(kf[0], qr[0], zero16); pA1 = A_MFMA(kf[1], qr[0], zero16); pA0 = A_MFMA(kf[2], qr[1], pA0); pA1 = A_MFMA(kf[3], qr[1], pA1);
  pA0 = A_MFMA(kf[4], qr[2], pA0); pA1 = A_MFMA(kf[5], qr[2], pA1); pA0 = A_MFMA(kf[6], qr[3], pA0); pA1 = A_MFMA(kf[7], qr[3], pA1);
  if (MODE == 0) a_bias(pA0, pA1, fb0, hi);
  if (MODE == 2 || NT == 4) a_mask<MODE>(pA0, pA1, key00, qabs, hi);
  { const float rm = a_rowmax(pA0, pA1); mhat = __builtin_fmaxf(rm * A_C2, -1.0e30f); const float nmh = -mhat;
#pragma unroll
    for (int r = 0; r < 16; ++r) { pA0[r] = A_EX(pA0[r]); pA1[r] = A_EX(pA1[r]); } }
  a_wait_bar<0>();
  A_DMA_K(3, 0); A_DMA_V(1, A_SLOTB); A_ROT();
  _Pragma("unroll") for (int d0 = 0; d0 < 4; ++d0) a_kload2(kf, kp0 + sl_cur, d0);
  a_wait_bar<NK + 1>();
#define A_PKW(P, i) a_cvtpk(P[i], P[i + 1])
#define A_PAF(k) __builtin_bit_cast(bf16x8, pw##k)
#define A_VFR(i) __builtin_bit_cast(bf16x8, __builtin_shufflevector(vlo[i], vhi[i], 0, 1, 2, 3, 4, 5, 6, 7))
#define A_VRD(i) do { vlo[i] = a_vtr(vp_ + (((i) >> 2) * 4096 + ((i) & 3) * 1024)); vhi[i] = a_vtr(vp_ + (((i) >> 2) * 4096 + ((i) & 3) * 1024 + 512)); } while (0)
#define A_KRD(G, d0) do { if (G) { a_kload2(kf, kp0 + sl_next, d0); A_SBAR(); } } while (0)
#define A_GAPA(MF, a0, a1, a2, a3, W0, W1, PW) do { MF; sacc += a0; sacc += a1; sacc += a2; sacc += a3; W0; W1; A_PIN(PW); A_PIN(sacc); A_SBAR(); } while (0)
#define A_GAPB(MF, X, i) do { MF; X[i] = A_EX(X[i]); X[i + 1] = A_EX(X[i + 1]); X[i + 2] = A_EX(X[i + 2]); X[i + 3] = A_EX(X[i + 3]); A_PIN(X); A_SBAR(); } while (0)
#define A_STEP(C0, C1, P0, P1, t, MASK, GK, GV, GL) do { A_SBAR(); \
    const a_lds_cptr vp_ = vp0 + sl_prev; \
    A_VRD(0); A_SBAR(); float sacc = P0[0] + P0[1]; \
                      A_GAPA(C0 = A_MFMA(kf[0], qr[0], zero16), P0[2], P0[3], P0[4], P0[5],     pw0[0] = A_PKW(P0, 0),  pw0[1] = A_PKW(P0, 2),  pw0); \
    A_VRD(4); A_SBAR(); A_GAPA(C1 = A_MFMA(kf[1], qr[0], zero16), P0[6], P0[7], P0[8], P0[9],     pw0[2] = A_PKW(P0, 4),  pw0[3] = A_PKW(P0, 6),  pw0); \
    A_VRD(1); A_SBAR(); A_GAPA(C0 = A_MFMA(kf[2], qr[1], C0),    P0[10], P0[11], P0[12], P0[13], pw1[0] = A_PKW(P0, 8),  pw1[1] = A_PKW(P0, 10), pw1); \
    A_VRD(5); A_SBAR(); A_GAPA(C1 = A_MFMA(kf[3], qr[1], C1),    P0[14], P0[15], P1[0], P1[1],   pw1[2] = A_PKW(P0, 12), pw1[3] = A_PKW(P0, 14), pw1); \
    A_VRD(2); A_SBAR(); A_GAPA(C0 = A_MFMA(kf[4], qr[2], C0),    P1[2], P1[3], P1[4], P1[5],     pw2[0] = A_PKW(P1, 0),  pw2[1] = A_PKW(P1, 2),  pw2); \
    A_VRD(6); A_SBAR(); A_GAPA(C1 = A_MFMA(kf[5], qr[2], C1),    P1[6], P1[7], P1[8], P1[9],     pw2[2] = A_PKW(P1, 4),  pw2[3] = A_PKW(P1, 6),  pw2); \
    A_VRD(3); A_SBAR(); A_GAPA(C0 = A_MFMA(kf[6], qr[3], C0),    P1[10], P1[11], P1[12], P1[13], pw3[0] = A_PKW(P1, 8),  pw3[1] = A_PKW(P1, 10), pw3); \
    A_VRD(7); A_SBAR(); A_GAPA(C1 = A_MFMA(kf[7], qr[3], C1),    P1[14], P1[15], 0.f, 0.f,       pw3[2] = A_PKW(P1, 12), pw3[3] = A_PKW(P1, 14), pw3); \
    l_reg += sacc; \
    if (GK) A_DMA_K((t) + 3, sl_cur); if (GV) A_DMA_V((t) + 1, sl_next); \
    if (MODE == 0) a_bias(C0, C1, fb0 + ((t) & 3) * 256, hi); \
    if (MASK) a_mask<MODE>(C0, C1, key00 + (t) * 64, qabs, hi); \
    const bool selb_ = (MODE != 1) || (((selm >> ((t) & 31)) & 1u) != 0u); \
    { float rmx = a_rowmax(C0, C1) * A_C2; if (!selb_) rmx = -INFINITY; resc = false; \
      if (__builtin_expect(__any((rmx - mhat) > A_THR), 0)) { const float mnew = __builtin_fmaxf(mhat, rmx); \
          const float f = __builtin_amdgcn_exp2f(mhat - mnew); mhat = mnew; l_reg *= f; if (hi == 0) wsf[r32] = f; resc = true; } } \
    const float nmh = selb_ ? -mhat : -INFINITY; A_SBAR(); \
    A_GAPB(o[0] = A_MFMA(A_PAF(0), A_VFR(0), o[0]), C0, 0);              A_GAPB(o[1] = A_MFMA(A_PAF(0), A_VFR(4), o[1]), C0, 4); \
    A_KRD(GL, 0); A_GAPB(o[0] = A_MFMA(A_PAF(1), A_VFR(1), o[0]), C0, 8);  A_KRD(GL, 1); A_GAPB(o[1] = A_MFMA(A_PAF(1), A_VFR(5), o[1]), C0, 12); \
    A_KRD(GL, 2); A_GAPB(o[0] = A_MFMA(A_PAF(2), A_VFR(2), o[0]), C1, 0);  A_KRD(GL, 3); A_GAPB(o[1] = A_MFMA(A_PAF(2), A_VFR(6), o[1]), C1, 4); \
    A_GAPB(o[0] = A_MFMA(A_PAF(3), A_VFR(3), o[0]), C1, 8);              A_GAPB(o[1] = A_MFMA(A_PAF(3), A_VFR(7), o[1]), C1, 12); \
    } while (0)
  int t = 1;
  if (MODE != 2) {
    for (; t + 5 < NT; t += 2) {
      A_STEP(pB0, pB1, pA0, pA1, t, false, true, true, true);     a_wait_bar<NK + 1>(); A_RESC(); A_ROT();
      A_STEP(pA0, pA1, pB0, pB1, t + 1, false, true, true, true); a_wait_bar<NK + 1>(); A_RESC(); A_ROT();
    }
  }
#define A_ENDW(tt) do { if ((tt) + 3 < NT) { a_wait_bar<NK + 1>(); } else if ((tt) + 2 < NT) { a_wait_bar<1>(); } else { a_wait_bar<0>(); } } while (0)
  for (; t + 1 < NT; t += 2) {
    A_STEP(pB0, pB1, pA0, pA1, t, true, (t + 3 < NT), (t + 1 < NT), (t + 1 < NT));         A_ENDW(t);     A_RESC(); A_ROT();
    A_STEP(pA0, pA1, pB0, pB1, t + 1, true, (t + 4 < NT), (t + 2 < NT), (t + 2 < NT));     A_ENDW(t + 1); A_RESC(); A_ROT();
  }
  A_STEP(pB0, pB1, pA0, pA1, NT - 1, true, false, false, false); A_RESC();
  { float sacc = pB0[0] + pB0[1];
#pragma unroll
    for (int r = 2; r < 16; ++r) sacc += pB0[r];
#pragma unroll
    for (int r = 0; r < 16; ++r) sacc += pB1[r];
    l_reg += sacc;
    pw0 = (a_u32x4){A_PKW(pB0, 0), A_PKW(pB0, 2), A_PKW(pB0, 4), A_PKW(pB0, 6)}; pw1 = (a_u32x4){A_PKW(pB0, 8), A_PKW(pB0, 10), A_PKW(pB0, 12), A_PKW(pB0, 14)};
    pw2 = (a_u32x4){A_PKW(pB1, 0), A_PKW(pB1, 2), A_PKW(pB1, 4), A_PKW(pB1, 6)}; pw3 = (a_u32x4){A_PKW(pB1, 8), A_PKW(pB1, 10), A_PKW(pB1, 12), A_PKW(pB1, 14)};
    const a_lds_cptr vp_ = vp0 + sl_cur; _Pragma("unroll") for (int i = 0; i < 8; ++i) A_VRD(i);
    o[0] = A_MFMA(A_PAF(0), A_VFR(0), o[0]); o[1] = A_MFMA(A_PAF(0), A_VFR(4), o[1]); o[0] = A_MFMA(A_PAF(1), A_VFR(1), o[0]); o[1] = A_MFMA(A_PAF(1), A_VFR(5), o[1]);
    o[0] = A_MFMA(A_PAF(2), A_VFR(2), o[0]); o[1] = A_MFMA(A_PAF(2), A_VFR(6), o[1]); o[0] = A_MFMA(A_PAF(3), A_VFR(3), o[0]); o[1] = A_MFMA(A_PAF(3), A_VFR(7), o[1]); }
  { auto rr = __builtin_amdgcn_permlane32_swap(__float_as_uint(l_reg), __float_as_uint(l_reg), false, false); l_reg = __uint_as_float(rr[0]) + __uint_as_float(rr[1]); }
  if (hi == 0) wsf[32 + r32] = gate / l_reg;
  asm volatile("s_waitcnt lgkmcnt(0)" ::: "memory");
  float rli[16];
#pragma unroll
  for (int r = 0; r < 16; ++r) rli[r] = wsf[32 + a_crow(r, hi)];
#pragma unroll
  for (int r = 0; r < 16; ++r) { const int orow = a_crow(r, hi);
#pragma unroll
    for (int d0 = 0; d0 < 2; ++d0) stg[orow * 64 + d0 * 32 + r32] = f2bf(o[d0][r] * rli[r]); }
  asm volatile("s_waitcnt lgkmcnt(0)\n\ts_barrier" ::: "memory");
#undef A_DMA_K
#undef A_DMA_V
#undef A_ROT
#undef A_EX
#undef A_RESC
#undef A_PKW
#undef A_PAF
#undef A_VFR
#undef A_VRD
#undef A_KRD
#undef A_ENDW
#undef A_GAPA
#undef A_GAPB
#undef A_STEP
}

__device__ void pc2_phase(const Params& P, int layer, int chunk, char* smem, int* s_item) {
  const int perq = 2 * P.NB * 16;
  const int nItems = 8 * perq;
  unsigned* ctr = P.ctr + (chunk * 4 + layer);
  while (true) {
    const int tid = opaque_tid(), lane = tid & 63, r32 = lane & 31, w = tid >> 6;
    __syncthreads();
    if (tid == 0) *s_item = (int)atomicAdd(ctr, 1u);
    __syncthreads();
    const int it = *s_item;
    if (it >= nItems) break;
    const int qt = 7 - it / perq;
    const int rem = it % perq;
    const int type = rem & 1;
    const int bh = rem >> 1;
    const int bl = bh >> 4, head = bh & 15;
    const int q0w = qt * 256 + w * 32;
    const int qabs = q0w + r32;
    const size_t rowq = (size_t)bl * TSEQ + qabs;
    const size_t roww = (size_t)bl * TSEQ + q0w;
    const u16* pb_ = P.proj + (size_t)bl * TSEQ * INC;
    u16* stg = (u16*)(smem + A_LDS_OST) + w * 4096;
    const int er = lane >> 3, ec = (lane & 7) * 8;
    if (type == 0) {
      a_unit<0>(pb_ + roww * 0 + (size_t)q0w * INC + C_QB + head * 64, INC, pb_ + C_KB + head * 64, pb_ + C_VB + head * 64,
                P.F2 + (size_t)(bl * 16 + head) * TSEQ, 4 * qt + 4, 0, qabs, 0u, 1.0f, smem, stg, tid);
#pragma unroll
      for (int i = 0; i < 4; i++) {
        const int row = i * 8 + er;
        const uint4 ov = *(const uint4*)(stg + row * 64 + ec);
        const uint4 zz = *(const uint4*)(pb_ + (size_t)(q0w + row) * INC + C_ZB + head * 64 + ec);
        uint4 y;
        y.x = pk2(bflo(ov.x) * siluf_(bflo(zz.x)), bfhi(ov.x) * siluf_(bfhi(zz.x)));
        y.y = pk2(bflo(ov.y) * siluf_(bflo(zz.y)), bfhi(ov.y) * siluf_(bfhi(zz.y)));
        y.z = pk2(bflo(ov.z) * siluf_(bflo(zz.z)), bfhi(ov.z) * siluf_(bfhi(zz.z)));
        y.w = pk2(bflo(ov.w) * siluf_(bflo(zz.w)), bfhi(ov.w) * siluf_(bfhi(zz.w)));
        *(uint4*)(P.yb + (roww + row) * DM + head * 64 + ec) = y;
      }
    } else {
      const int g = head >> 3;
      const unsigned selm = P.sel[(size_t)(bl * 2 + g) * TSEQ + qabs];
      const float g1 = sigmoidf_(bf2f(P.proj[rowq * INC + C_GA + 16 + head]));
      const float g2 = sigmoidf_(bf2f(P.proj[rowq * INC + C_GA + 32 + head]));
      const u16* qw = P.qr + roww * DM + head * 64;
      a_unit<1>(qw, DM, pb_ + C_KV + 256 + g * 64, pb_ + C_KV + 384 + g * 64, nullptr, 4 * qt + 4, 0, qabs, selm, g1, smem, stg, tid);
      const int klo = (4 * qt - 8) > 0 ? (4 * qt - 8) : 0;
      a_unit<2>(qw, DM, pb_ + (size_t)(klo * 64) * INC + C_KV + 512 + g * 64, pb_ + (size_t)(klo * 64) * INC + C_KV + 640 + g * 64, nullptr,
                4 * qt + 4 - klo, klo * 64, qabs, 0u, g2, smem, stg + 2048, tid);
#pragma unroll
      for (int i = 0; i < 4; i++) {
        const int row = i * 8 + er;
        const uint4 o1 = *(const uint4*)(stg + row * 64 + ec);
        const uint4 o2 = *(const uint4*)(stg + 2048 + row * 64 + ec);
        const uint4 zz = *(const uint4*)(pb_ + (size_t)(q0w + row) * INC + C_ZA + head * 64 + ec);
        u16* yp = P.ya + (roww + row) * DM + head * 64 + ec;
        const uint4 oc = *(const uint4*)yp;
        uint4 y;
        y.x = pk2((bflo(o1.x) + bflo(o2.x) + bflo(oc.x)) * siluf_(bflo(zz.x)), (bfhi(o1.x) + bfhi(o2.x) + bfhi(oc.x)) * siluf_(bfhi(zz.x)));
        y.y = pk2((bflo(o1.y) + bflo(o2.y) + bflo(oc.y)) * siluf_(bflo(zz.y)), (bfhi(o1.y) + bfhi(o2.y) + bfhi(oc.y)) * siluf_(bfhi(zz.y)));
        y.z = pk2((bflo(o1.z) + bflo(o2.z) + bflo(oc.z)) * siluf_(bflo(zz.z)), (bfhi(o1.z) + bfhi(o2.z) + bfhi(oc.z)) * siluf_(bfhi(zz.z)));
        y.w = pk2((bflo(o1.w) + bflo(o2.w) + bflo(oc.w)) * siluf_(bflo(zz.w)), (bfhi(o1.w) + bfhi(o2.w) + bfhi(oc.w)) * siluf_(bfhi(zz.w)));
        *(uint4*)yp = y;
      }
    }
  }
}

__device__ __forceinline__ void grid_bar(unsigned* ctr, unsigned& epoch) {
  asm volatile("s_waitcnt vmcnt(0) lgkmcnt(0)" ::: "memory");
  __syncthreads();
  epoch += gridDim.x;
  if (threadIdx.x == 0) {
    __builtin_amdgcn_fence(__ATOMIC_RELEASE, "agent");
    asm volatile("s_waitcnt vmcnt(0)" ::: "memory");
    __hip_atomic_fetch_add(ctr, 1u, __ATOMIC_RELAXED, __HIP_MEMORY_SCOPE_AGENT);
    while (__hip_atomic_load(ctr, __ATOMIC_RELAXED, __HIP_MEMORY_SCOPE_AGENT) < epoch) __builtin_amdgcn_s_sleep(2);
    __builtin_amdgcn_fence(__ATOMIC_ACQUIRE, "agent");
    asm volatile("s_waitcnt vmcnt(0)" ::: "memory");
  }
  __syncthreads();
}

__global__ void __launch_bounds__(NTHREADS, 2) mega_kernel(Params P) {
  __shared__ __attribute__((aligned(1024))) char smem[131072];
  cg::grid_group grid = cg::this_grid();
  const int CT = P.NB * TSEQ;
  unsigned epoch = 0u;
  phase0(P, smem);
  grid.sync();
  for (int chunk = 0; chunk < P.nchunk; chunk++) {
    for (int layer = 0; layer < 4; layer++) {
      const float* xs = (layer == 0 ? P.x_in : P.out) + (size_t)chunk * CT * DM;
      norm_phase(xs, P.norm_g + layer * DM, P.h, CT);
      if (layer == 0 && chunk > 0) final_norm_phase(P.out, P.final_g, (chunk - 1) * CT, CT);
      grid_bar(P.ctr + 48, epoch);
      gemm1_phase(P, layer, smem);
      grid_bar(P.ctr + 48, epoch);
      pb_phase(P, layer, smem);
      grid_bar(P.ctr + 48, epoch);
      pc1_phase(P, smem);
      grid_bar(P.ctr + 48, epoch);
      pc2_phase(P, layer, chunk, smem, (int*)(smem + 120000));
      grid_bar(P.ctr + 48, epoch);
      gemm2_phase(P, layer, smem);
      grid_bar(P.ctr + 48, epoch);
      gemm3_phase(P, layer, chunk, smem);
      grid_bar(P.ctr + 48, epoch);
    }
  }
  final_norm_phase(P.out, P.final_g, (P.nchunk - 1) * CT, CT);
}

static inline size_t al256(size_t x) { return (x + 255) & ~(size_t)255; }

extern "C" void kernel_launch(void* const* d_in, const int* in_sizes, int n_in, void* d_out, int out_size,
                              void* d_ws, size_t ws_size, hipStream_t stream) {
  (void)in_sizes; (void)n_in; (void)out_size;
  Params P{};
  P.x_in = (const float*)d_in[0]; P.norm_g = (const float*)d_in[1]; P.w_in = (const float*)d_in[2];
  P.b_forget = (const float*)d_in[3];
  P.pe_k = (const float*)d_in[4]; P.w1_k = (const float*)d_in[5]; P.w2_k = (const float*)d_in[6];
  P.pe_v = (const float*)d_in[7]; P.w1_v = (const float*)d_in[8]; P.w2_v = (const float*)d_in[9];
  P.w_pa = (const float*)d_in[10]; P.w_pb = (const float*)d_in[11]; P.w_out = (const float*)d_in[12];
  P.final_g = (const float*)d_in[13];
  P.out = (float*)d_out;
  int NB = 16;
  char* base = (char*)d_ws;
  for (;;) {
    const size_t CT = (size_t)NB * TSEQ;
    size_t off = 0;
    auto take = [&](size_t bytes) { size_t o = off; off = al256(off + bytes); return o; };
    size_t oWin = take((size_t)4 * INCP * DM * 2), oWpa = take((size_t)4 * DM * DM * 2), oWpb = take((size_t)4 * DM * DM * 2),
           oWo = take((size_t)4 * DM * DM * 2), oW1 = take((size_t)8 * 128 * 2048 * 2), oW2 = take((size_t)8 * 64 * 128 * 2),
           oB1 = take((size_t)64 * 128 * 4), oRc = take((size_t)TSEQ * 32 * 4), oRs = take((size_t)TSEQ * 32 * 4),
           oH = take(CT * DM * 2), oProj = take(CT * INC * 2 + 4096), oVbt = take(CT * DM * 2),
           oVst = take(CT * 128 * 2), oVwt = take(CT * 128 * 2), oFl = take(CT * 16 * 4), oF2 = take(CT * 16 * 4),
           oKc = take((size_t)NB * 2 * 128 * 64 * 2), oVc = take((size_t)NB * 2 * 64 * 128 * 2), oSel = take(CT * 2 * 4),
           oYa = take(CT * DM * 2), oYb = take(CT * DM * 2), oCtr = take(256);
    if (off > ws_size && NB > 1) { NB >>= 1; continue; }
    P.WinT = (u16*)(base + oWin); P.WpaT = (u16*)(base + oWpa); P.WpbT = (u16*)(base + oWpb); P.WoT = (u16*)(base + oWo);
    P.W1T = (u16*)(base + oW1); P.W2T = (u16*)(base + oW2); P.bias1p = (float*)(base + oB1);
    P.ropec = (float*)(base + oRc); P.ropes = (float*)(base + oRs);
    P.h = (u16*)(base + oH); P.proj = (u16*)(base + oProj); P.qr = (u16*)(base + oVbt);
    P.vst = (u16*)(base + oVst); P.vwt = (u16*)(base + oVwt); P.flog = (float*)(base + oFl); P.F2 = (float*)(base + oF2);
    P.kcmp = (u16*)(base + oKc); P.vcmpt = (u16*)(base + oVc); P.sel = (unsigned*)(base + oSel);
    P.ya = (u16*)(base + oYa); P.yb = (u16*)(base + oYb); P.ctr = (unsigned*)(base + oCtr);
    break;
  }
  P.NB = NB; P.nchunk = 32 / NB;
  static int grid_blocks = 0;
  if (!grid_blocks) {
    int dev = 0, cus = 0, per_cu = 0;
    hipGetDevice(&dev);
    hipDeviceGetAttribute(&cus, hipDeviceAttributeMultiprocessorCount, dev);
    hipOccupancyMaxActiveBlocksPerMultiprocessor(&per_cu, mega_kernel, NTHREADS, 0);
    if (per_cu > 1) per_cu = 1;
    if (per_cu < 1) per_cu = 1;
    grid_blocks = cus * per_cu;
  }
  void* args[] = {&P};
  hipError_t e = hipLaunchCooperativeKernel((void*)mega_kernel, dim3(grid_blocks), dim3(NTHREADS), args, 0, stream);
  if (e != hipSuccess) fprintf(stderr, "cooperative launch failed: %s (grid %d)\n", hipGetErrorString(e), grid_blocks);
}
```

```cpp
#include <hip/hip_runtime.h>
#include <hip/hip_cooperative_groups.h>
#include <cstdio>
namespace cg = cooperative_groups;

typedef __attribute__((ext_vector_type(8))) __bf16 bf16x8;
typedef __attribute__((ext_vector_type(16))) float f32x16;
typedef __attribute__((ext_vector_type(4))) float f32x4;
typedef __attribute__((ext_vector_type(2))) float f32x2;
typedef unsigned short u16;

#define TSEQ 2048
#define DM 1024
#define INC 9024
#define INCP 9216
#define C_QA 0
#define C_KV 1024
#define C_GA 1792
#define C_ZA 1840
#define C_QB 2864
#define C_KB 3888
#define C_VB 4912
#define C_QR 4912
#define C_FB 5936
#define C_ZB 5952
#define C_RA 6976
#define C_RB 8000
#define NTHREADS 512
#define ATT_STAGE 33280
#define LOG2E 1.4426950408889634f

struct Params {
  const float* x_in; const float* norm_g; const float* w_in; const float* b_forget;
  const float* pe_k; const float* w1_k; const float* w2_k;
  const float* pe_v; const float* w1_v; const float* w2_v;
  const float* w_pa; const float* w_pb; const float* w_out; const float* final_g;
  float* out;
  u16* WinT; u16* WpaT; u16* WpbT; u16* WoT; u16* W1T; u16* W2T;
  float* bias1p; float* ropec; float* ropes;
  u16* h; u16* proj; u16* qr; u16* vst; u16* vwt;
  float* flog; float* F2; u16* kcmp; u16* vcmpt; unsigned* sel;
  u16* ya; u16* yb; unsigned* ctr;
  int NB; int nchunk;
};

__device__ __forceinline__ unsigned pk2(float a, float b) {
  typedef __attribute__((ext_vector_type(2))) float f2_t;
  typedef __attribute__((ext_vector_type(2))) __bf16 b2_t;
  f2_t v = {a, b};
  b2_t r = __builtin_convertvector(v, b2_t);
  return __builtin_bit_cast(unsigned, r);
}
__device__ __forceinline__ u16 f2bf(float a) { return (u16)(pk2(a, 0.f) & 0xffffu); }
__device__ __forceinline__ float bf2f(u16 u) { return __uint_as_float(((unsigned)u) << 16); }
__device__ __forceinline__ float bflo(unsigned u) { return __uint_as_float(u << 16); }
__device__ __forceinline__ float bfhi(unsigned u) { return __uint_as_float(u & 0xffff0000u); }
__device__ __forceinline__ float sigmoidf_(float x) { return 1.f / (1.f + __expf(-x)); }
__device__ __forceinline__ float siluf_(float x) { return x / (1.f + __expf(-x)); }
__device__ __forceinline__ f32x16 mfma32(bf16x8 a, bf16x8 b, f32x16 c) {
  return __builtin_amdgcn_mfma_f32_32x32x16_bf16(a, b, c, 0, 0, 0);
}
__device__ __forceinline__ int opaque_tid() { int t = threadIdx.x; asm volatile("" : "+v"(t)); return t; }
__device__ __forceinline__ bf16x8 ldfrag(const void* p) {
  return __builtin_bit_cast(bf16x8, *(const uint4*)p);
}

__device__ void transpose_tile(const float* __restrict__ src, u16* __restrict__ dst, int K, int N,
                               int k0, int n0, float* tile, const int tid) {
#pragma unroll
  for (int j = 0; j < 2; j++) {
    int r = (tid >> 4) + 32 * j, c4 = (tid & 15) * 4;
    float4 v = *(const float4*)(src + (size_t)(k0 + r) * N + n0 + c4);
    tile[r * 65 + c4] = v.x; tile[r * 65 + c4 + 1] = v.y; tile[r * 65 + c4 + 2] = v.z; tile[r * 65 + c4 + 3] = v.w;
  }
  __syncthreads();
  {
    int c = tid, n = c >> 3, kc = c & 7;
    const float* tp = tile + (kc * 8) * 65 + n;
    uint4 o;
    o.x = pk2(tp[0], tp[65]); o.y = pk2(tp[130], tp[195]); o.z = pk2(tp[260], tp[325]); o.w = pk2(tp[390], tp[455]);
    *(uint4*)(dst + (size_t)(n0 + n) * K + k0 + kc * 8) = o;
  }
  __syncthreads();
}

__device__ void phase0(const Params& P, char* smem) {
  const int tid = opaque_tid();
  float* tile = (float*)smem;
  const int n0_ = 4 * 16 * 141, n1_ = 4 * 16 * 16, n2_ = 4 * 32 * 2, n3_ = 4 * 2 * 1;
  const int nT = n0_ + 3 * n1_ + 2 * n2_ + 2 * n3_;
  const int nBias = 64, nRope = 128;
  const int total = nT + nBias + nRope + 1;
  for (int it = blockIdx.x; it < total; it += gridDim.x) {
    if (it < nT) {
      int t = it;
      if (t < n0_) {
        int l = t / (16 * 141), rem = t % (16 * 141);
        transpose_tile(P.w_in + (size_t)l * DM * INC, P.WinT + (size_t)l * INCP * DM, DM, INC, (rem / 141) * 64, (rem % 141) * 64, tile, tid);
        continue;
      }
      t -= n0_;
      if (t < 3 * n1_) {
        int which = t / n1_; t %= n1_;
        int l = t / 256, rem = t % 256;
        const float* s = which == 0 ? P.w_pa : (which == 1 ? P.w_pb : P.w_out);
        u16* d = which == 0 ? P.WpaT : (which == 1 ? P.WpbT : P.WoT);
        transpose_tile(s + (size_t)l * DM * DM, d + (size_t)l * DM * DM, DM, DM, (rem >> 4) * 64, (rem & 15) * 64, tile, tid);
        continue;
      }
      t -= 3 * n1_;
      if (t < 2 * n2_) {
        int kv = t / n2_; t %= n2_;
        int l = t / 64, rem = t % 64;
        const float* s = kv ? P.w1_v : P.w1_k;
        transpose_tile(s + (size_t)l * 2048 * 128, P.W1T + (size_t)(l * 2 + kv) * 128 * 2048, 2048, 128, (rem >> 1) * 64, (rem & 1) * 64, tile, tid);
        continue;
      }
      t -= 2 * n2_;
      {
        int kv = t / n3_; t %= n3_;
        int l = t / 2, rem = t % 2;
        const float* s = kv ? P.w2_v : P.w2_k;
        transpose_tile(s + (size_t)l * 128 * 64, P.W2T + (size_t)(l * 2 + kv) * 64 * 128, 128, 64, rem * 64, 0, tile, tid);
      }
    } else if (it < nT + nBias) {
      int j = it - nT;
      int l = j >> 4, kv = (j >> 3) & 1, kq = j & 7;
      const float* pe = (kv ? P.pe_v : P.pe_k) + (size_t)l * 2048;
      const float* w1 = (kv ? P.w1_v : P.w1_k) + (size_t)l * 2048 * 128;
      int hid = tid & 127, kh = tid >> 7;
      int kbeg = kq * 256 + kh * 64;
      float s = 0.f;
#pragma unroll 8
      for (int k = 0; k < 64; k++) s += pe[kbeg + k] * w1[(size_t)(kbeg + k) * 128 + hid];
      float* part = (float*)smem;
      part[tid] = s;
      __syncthreads();
      if (tid < 128) P.bias1p[((l * 2 + kv) * 8 + kq) * 128 + hid] = (part[tid] + part[tid + 128]) + (part[tid + 256] + part[tid + 384]);
      __syncthreads();
    } else if (it < nT + nBias + nRope) {
      int idx = (it - nT - nBias) * 512 + tid;
      int t = idx >> 5, j = idx & 31;
      double inv = 1.0;
      for (int q = 0; q < j; q++) inv *= 0.7498942093324558;
      float invf = (float)inv;
      float angf = (float)t * invf;
      double a = (double)angf;
      double kq = rint(a * 0.15915494309189535);
      double rr = a - kq * 6.283185307179586;
      double r2 = rr * rr;
      double sterm = rr, cterm = 1.0, ssum = rr, csum = 1.0;
#pragma unroll 1
      for (int n = 1; n <= 15; n++) {
        cterm *= -r2 / (double)((2 * n - 1) * (2 * n));
        sterm *= -r2 / (double)((2 * n) * (2 * n + 1));
        csum += cterm; ssum += sterm;
      }
      P.ropec[idx] = (float)csum;
      P.ropes[idx] = (float)ssum;
    } else {
      if (tid < 64) P.ctr[tid] = 0u;
    }
  }
}

__device__ void norm_phase(const float* __restrict__ xsrc, const float* __restrict__ g, u16* __restrict__ hdst, int nrows) {
  const int tid = opaque_tid();
  const int lane = tid & 63;
  const int gw = blockIdx.x * 8 + (tid >> 6), nw = gridDim.x * 8;
  float4 gv[4];
#pragma unroll
  for (int j = 0; j < 4; j++) gv[j] = *(const float4*)(g + lane * 4 + 256 * j);
  for (int row = gw; row < nrows; row += nw) {
    const float* xr = xsrc + (size_t)row * DM;
    float4 v[4];
    float ss = 0.f;
#pragma unroll
    for (int j = 0; j < 4; j++) {
      v[j] = *(const float4*)(xr + lane * 4 + 256 * j);
      ss += v[j].x * v[j].x + v[j].y * v[j].y + v[j].z * v[j].z + v[j].w * v[j].w;
    }
#pragma unroll
    for (int o = 32; o >= 1; o >>= 1) ss += __shfl_xor(ss, o);
    float rstd = rsqrtf(ss * (1.f / DM) + 1e-6f);
#pragma unroll
    for (int j = 0; j < 4; j++) {
      uint2 o;
      o.x = pk2(v[j].x * rstd * gv[j].x, v[j].y * rstd * gv[j].y);
      o.y = pk2(v[j].z * rstd * gv[j].z, v[j].w * rstd * gv[j].w);
      *(uint2*)(hdst + (size_t)row * DM + lane * 4 + 256 * j) = o;
    }
  }
}

__device__ void final_norm_phase(float* __restrict__ x, const float* __restrict__ g, int row0, int nrows) {
  const int tid = opaque_tid();
  const int lane = tid & 63;
  const int gw = blockIdx.x * 8 + (tid >> 6), nw = gridDim.x * 8;
  float4 gv[4];
#pragma unroll
  for (int j = 0; j < 4; j++) gv[j] = *(const float4*)(g + lane * 4 + 256 * j);
  for (int row = gw; row < nrows; row += nw) {
    float* xr = x + (size_t)(row0 + row) * DM;
    float4 v[4];
    float ss = 0.f;
#pragma unroll
    for (int j = 0; j < 4; j++) {
      v[j] = *(const float4*)(xr + lane * 4 + 256 * j);
      ss += v[j].x * v[j].x + v[j].y * v[j].y + v[j].z * v[j].z + v[j].w * v[j].w;
    }
#pragma unroll
    for (int o = 32; o >= 1; o >>= 1) ss += __shfl_xor(ss, o);
    float rstd = rsqrtf(ss * (1.f / DM) + 1e-6f);
#pragma unroll
    for (int j = 0; j < 4; j++) {
      float4 o;
      o.x = v[j].x * rstd * gv[j].x; o.y = v[j].y * rstd * gv[j].y;
      o.z = v[j].z * rstd * gv[j].z; o.w = v[j].w * rstd * gv[j].w;
      *(float4*)(xr + lane * 4 + 256 * j) = o;
    }
  }
}

struct ARow {
  const u16* p; int ld;
  __device__ __forceinline__ const u16* operator()(int row, int k) const { return p + (size_t)row * ld + k; }
};
struct ACmp {
  const u16* p;
  __device__ __forceinline__ const u16* operator()(int row, int k) const {
    int t = 16 * row + (k >> 6); t = t > (TSEQ - 1) ? (TSEQ - 1) : t;
    return p + (size_t)t * INC + (k & 63);
  }
};

template <class AF>
__device__ __forceinline__ void gemm_mainloop(AF af, const u16* __restrict__ Bt, int ldb, int K, char* smem,
                                              f32x16 (&acc)[2][2], const int tid) {
  const int lane = tid & 63, r = lane & 31, h = lane >> 5, w = tid >> 6;
  const int wm = w >> 1, wn = w & 1;
  const int lrow = tid >> 3, lch = tid & 7;
  uint4 ra[4], rb[4];
  const int nk = K >> 6;
#pragma unroll
  for (int j = 0; j < 4; j++) {
    int row = lrow + 32 * j;
    ra[j] = *(const uint4*)af(row, lch * 8);
    rb[j] = *(const uint4*)(Bt + (size_t)row * ldb + lch * 8);
  }
#pragma unroll
  for (int j = 0; j < 4; j++) {
    int row = lrow + 32 * j;
    int off = row * 128 + ((lch ^ ((row >> 1) & 7)) << 4);
    *(uint4*)(smem + off) = ra[j];
    *(uint4*)(smem + 16384 + off) = rb[j];
  }
  __syncthreads();
  for (int it = 0; it < nk; it++) {
    const bool more = (it + 1) < nk;
    if (more) {
      const int k0 = (it + 1) * 64;
#pragma unroll
      for (int j = 0; j < 4; j++) {
        int row = lrow + 32 * j;
        ra[j] = *(const uint4*)af(row, k0 + lch * 8);
        rb[j] = *(const uint4*)(Bt + (size_t)row * ldb + k0 + lch * 8);
      }
    }
    const char* sa = smem + (it & 1) * 32768;
    const char* sb = sa + 16384;
#pragma unroll
    for (int kk = 0; kk < 4; kk++) {
      bf16x8 a[2], b[2];
#pragma unroll
      for (int mi = 0; mi < 2; mi++) {
        int row = wm * 64 + mi * 32 + r;
        a[mi] = ldfrag(sa + row * 128 + (((kk * 2 + h) ^ ((row >> 1) & 7)) << 4));
      }
#pragma unroll
      for (int ni = 0; ni < 2; ni++) {
        int row = wn * 64 + ni * 32 + r;
        b[ni] = ldfrag(sb + row * 128 + (((kk * 2 + h) ^ ((row >> 1) & 7)) << 4));
      }
#pragma unroll
      for (int mi = 0; mi < 2; mi++)
#pragma unroll
        for (int ni = 0; ni < 2; ni++) acc[mi][ni] = mfma32(a[mi], b[ni], acc[mi][ni]);
    }
    if (more) {
      char* sd = smem + ((it + 1) & 1) * 32768;
#pragma unroll
      for (int j = 0; j < 4; j++) {
        int row = lrow + 32 * j;
        int off = row * 128 + ((lch ^ ((row >> 1) & 7)) << 4);
        *(uint4*)(sd + off) = ra[j];
        *(uint4*)(sd + 16384 + off) = rb[j];
      }
    }
    __syncthreads();
  }
}

__device__ __forceinline__ void zero_acc(f32x16 (&acc)[2][2]) {
#pragma unroll
  for (int a = 0; a < 2; a++)
#pragma unroll
    for (int b = 0; b < 2; b++)
#pragma unroll
      for (int i = 0; i < 16; i++) acc[a][b][i] = 0.f;
}

typedef __attribute__((ext_vector_type(8))) short s16x8;
#define G_TILE_B 32768
#define G_STAGE_B 65536
__device__ __forceinline__ int g_lds_byte(int r, int c) {
  int st = (r >> 4) * 2 + (c >> 5), ob = (r & 15) * 64 + (c & 31) * 2;
  return st * 1024 + (ob ^ (((ob >> 9) & 1) << 5));
}
__device__ __forceinline__ void g_stage_rc(int b, int& R, int& C) {
  int st = b >> 10, sb = b & 1023, swz = sb ^ (((sb >> 9) & 1) << 5);
  R = (st >> 1) * 16 + swz / 64;
  C = (st & 1) * 32 + (swz % 64) / 2;
}
#define G_WAIT_V0() asm volatile("s_waitcnt vmcnt(0)" ::: "memory")

struct GTile { int pm, pn; };
__device__ __forceinline__ bool g_next(int i, int G, int c, int nM, int nN, GTile& u) {
  const int nwg = nM * nN;
  const int L = i * G + c;
  if (L >= nwg) return false;
  int wgid = L;
  { const int q = nwg / 8, r = nwg % 8, xcd = wgid % 8, off = wgid / 8; wgid = (xcd < r ? xcd * (q + 1) : r * (q + 1) + (xcd - r) * q) + off; }
  const int nig = 8 * nN, gid = wgid / nig, fm = gid * 8, gsz = (nM - fm) < 8 ? (nM - fm) : 8;
  u.pm = fm + ((wgid % nig) % gsz);
  u.pn = (wgid % nig) / gsz;
  return true;
}

__device__ __forceinline__ void g_kloop(const u16* __restrict__ Ab, const u16* __restrict__ Bb, const int K, char* smem,
                                        f32x4 (&acc)[8][4], const int tid) {
  const int wid = tid >> 6, lane = tid & 63, wr = wid >> 2, wc = wid & 3, fr = lane & 15, fq = lane >> 4;
  int sR0, sC0, sR1, sC1, sR2, sC2, sR3, sC3;
  g_stage_rc(wid * 1024 + 0 * 8192 + lane * 16, sR0, sC0);
  g_stage_rc(wid * 1024 + 1 * 8192 + lane * 16, sR1, sC1);
  g_stage_rc(wid * 1024 + 2 * 8192 + lane * 16, sR2, sC2);
  g_stage_rc(wid * 1024 + 3 * 8192 + lane * 16, sR3, sC3);
  const long o0 = (long)sR0 * K + sC0, o1 = (long)sR1 * K + sC1, o2 = (long)sR2 * K + sC2, o3 = (long)sR3 * K + sC3;
#define G_STAGE(buf, kt)                                                                                              \
  {                                                                                                                  \
    char* sa_ = smem + (buf) * G_STAGE_B + wid * 1024;                                                               \
    char* sb_ = sa_ + G_TILE_B;                                                                                      \
    const u16* ga_ = Ab + (kt) * 64;                                                                                 \
    const u16* gb_ = Bb + (kt) * 64;                                                                                 \
    __builtin_amdgcn_global_load_lds((const unsigned*)(ga_ + o0), (unsigned*)(sa_), 16, 0, 0);                       \
    __builtin_amdgcn_global_load_lds((const unsigned*)(gb_ + o0), (unsigned*)(sb_), 16, 0, 0);                       \
    __builtin_amdgcn_global_load_lds((const unsigned*)(ga_ + o1), (unsigned*)(sa_ + 8192), 16, 0, 0);                \
    __builtin_amdgcn_global_load_lds((const unsigned*)(gb_ + o1), (unsigned*)(sb_ + 8192), 16, 0, 0);                \
    __builtin_amdgcn_global_load_lds((const unsigned*)(ga_ + o2), (unsigned*)(sa_ + 16384), 16, 0, 0);               \
    __builtin_amdgcn_global_load_lds((const unsigned*)(gb_ + o2), (unsigned*)(sb_ + 16384), 16, 0, 0);               \
    __builtin_amdgcn_global_load_lds((const unsigned*)(ga_ + o3), (unsigned*)(sa_ + 24576), 16, 0, 0);               \
    __builtin_amdgcn_global_load_lds((const unsigned*)(gb_ + o3), (unsigned*)(sb_ + 24576), 16, 0, 0);               \
  }
  const int nt = K >> 6;
  G_STAGE(0, 0);
  G_WAIT_V0();
  __syncthreads();
  for (int t = 0; t < nt; ++t) {
    const int cur = t & 1;
    if (t + 1 < nt) G_STAGE(cur ^ 1, t + 1);
    const char* sa = smem + cur * G_STAGE_B;
    const char* sb = sa + G_TILE_B;
#pragma unroll
    for (int ks = 0; ks < 2; ++ks) {
      s16x8 At[8], Bf[4];
#pragma unroll
      for (int m = 0; m < 8; ++m) At[m] = *(const s16x8*)(sa + g_lds_byte(wr * 128 + m * 16 + fr, ks * 32 + fq * 8));
#pragma unroll
      for (int n = 0; n < 4; ++n) Bf[n] = *(const s16x8*)(sb + g_lds_byte(wc * 64 + n * 16 + fr, ks * 32 + fq * 8));
#pragma unroll
      for (int m = 0; m < 8; ++m)
#pragma unroll
        for (int n = 0; n < 4; ++n)
          acc[m][n] = __builtin_amdgcn_mfma_f32_16x16x32_bf16(__builtin_bit_cast(bf16x8, Bf[n]), __builtin_bit_cast(bf16x8, At[m]), acc[m][n], 0, 0, 0);
      __builtin_amdgcn_sched_barrier(0);
    }
    G_WAIT_V0();
    __syncthreads();
  }
}

__device__ __forceinline__ void g_zero(f32x4 (&acc)[8][4]) {
#pragma unroll
  for (int m = 0; m < 8; m++)
#pragma unroll
    for (int n = 0; n < 4; n++) acc[m][n] = (f32x4){0.f, 0.f, 0.f, 0.f};
}
__device__ __forceinline__ uint2 pk4(f32x4 v) { return make_uint2(pk2(v[0], v[1]), pk2(v[2], v[3])); }

__device__ __forceinline__ void wave_store_rows(char* wsm, u16* gbase, const size_t ld, const f32x4 (&acc)[8][4], const int lane) {
  const int fr = lane & 15, fq = lane >> 4;
#pragma unroll
  for (int m = 0; m < 8; m++)
#pragma unroll
    for (int n = 0; n < 4; n++) {
      const int row = m * 16 + fr, chunk = n * 2 + (fq >> 1);
      *(uint2*)(wsm + row * 128 + ((chunk ^ (fr & 7)) << 4) + (fq & 1) * 8) = pk4(acc[m][n]);
    }
  const int rr = lane >> 3, ch = lane & 7;
#pragma unroll
  for (int i = 0; i < 16; i++) {
    const int row = i * 8 + rr;
    const uint4 v = *(const uint4*)(wsm + row * 128 + ((ch ^ (row & 7)) << 4));
    typedef __attribute__((ext_vector_type(4))) unsigned u32x4_t;
    __builtin_nontemporal_store(__builtin_bit_cast(u32x4_t, v), (u32x4_t*)(gbase + (size_t)row * ld + ch * 8));
  }
}
__device__ __forceinline__ void wave_store_cols(char* wsm, u16* vt, const int vcol0, const int nh, const int bl, const int t0,
                                                const f32x4 (&acc)[8][4], const int lane) {
  const int fr = lane & 15, fq = lane >> 4;
#pragma unroll
  for (int m = 0; m < 8; m++)
#pragma unroll
    for (int n = 0; n < 4; n++)
#pragma unroll
      for (int j = 0; j < 4; j++) {
        const int d = n * 16 + fq * 4 + j, t = m * 16 + fr;
        *(u16*)(wsm + d * 256 + (((t >> 3) ^ (d & 15)) << 4) + (t & 7) * 2) = f2bf(acc[m][n][j]);
      }
  const int dd = lane >> 4, ch = lane & 15;
#pragma unroll
  for (int i = 0; i < 16; i++) {
    const int d = i * 4 + dd;
    const uint4 v = *(const uint4*)(wsm + d * 256 + ((ch ^ (d & 15)) << 4));
    const int vcol = vcol0 + d;
    *(uint4*)(vt + ((size_t)(bl * nh + (vcol >> 6)) * 64 + (vcol & 63)) * TSEQ + t0 + ch * 8) = v;
  }
}

__device__ void gemm1_phase(const Params& P, int layer, char* smem) {
  const int CT = P.NB * TSEQ;
  const int nM = CT >> 8, nN = INCP >> 8;
  const u16* Bt = P.WinT + (size_t)layer * INCP * DM;
  u16* p_qr = P.qr; u16* p_proj = P.proj;
  asm volatile("" : "+s"(p_qr), "+s"(p_proj));
  for (int i = 0;; i++) {
    GTile u;
    if (!g_next(i, gridDim.x, blockIdx.x, nM, nN, u)) break;
    const int tid = opaque_tid(), wid = tid >> 6, lane = tid & 63, wr = wid >> 2, wc = wid & 3, fr = lane & 15, fq = lane >> 4;
    f32x4 acc[8][4];
    g_zero(acc);
    g_kloop(P.h + (size_t)(u.pm * 256) * DM, Bt + (size_t)(u.pn * 256) * DM, DM, smem, acc, tid);
    const int cw = u.pn * 256 + wc * 64;
    const int row0 = u.pm * 256 + wr * 128 + fr;
    char* wsm = smem + wid * 16384;
    const int rowb = u.pm * 256 + wr * 128;
    const bool rope_q = cw < 1024;
    const bool rope_k = (cw >= C_KV + 256 && cw < C_KV + 384) || (cw >= C_KV + 512 && cw < C_KV + 640);
    const bool mixed = (cw == 5888);
    if (cw >= INC) {
    } else if (rope_q || rope_k) {
      if (rope_q) wave_store_rows(wsm, p_proj + (size_t)rowb * INC + cw, INC, acc, lane);
#pragma unroll
      for (int m = 0; m < 8; m++) {
        const int tt = (row0 + m * 16) & (TSEQ - 1);
#pragma unroll
        for (int n = 0; n < 2; n++) {
          const float4 c = *(const float4*)(P.ropec + tt * 32 + n * 16 + fq * 4);
          const float4 sn = *(const float4*)(P.ropes + tt * 32 + n * 16 + fq * 4);
          const f32x4 x1 = acc[m][n], x2 = acc[m][n + 2];
          f32x4 r1, r2;
          r1[0] = x1[0] * c.x - x2[0] * sn.x; r2[0] = x2[0] * c.x + x1[0] * sn.x;
          r1[1] = x1[1] * c.y - x2[1] * sn.y; r2[1] = x2[1] * c.y + x1[1] * sn.y;
          r1[2] = x1[2] * c.z - x2[2] * sn.z; r2[2] = x2[2] * c.z + x1[2] * sn.z;
          r1[3] = x1[3] * c.w - x2[3] * sn.w; r2[3] = x2[3] * c.w + x1[3] * sn.w;
          acc[m][n] = r1; acc[m][n + 2] = r2;
        }
      }
      if (rope_q) wave_store_rows(wsm, p_qr + (size_t)rowb * DM + cw, DM, acc, lane);
      else wave_store_rows(wsm, p_proj + (size_t)rowb * INC + cw, INC, acc, lane);
    } else if (!mixed) {
      wave_store_rows(wsm, p_proj + (size_t)rowb * INC + cw, INC, acc, lane);
    } else {
#pragma unroll
      for (int n = 0; n < 4; n++) {
        const int c0 = cw + n * 16 + fq * 4;
        if (c0 < C_FB) {
#pragma unroll
          for (int m = 0; m < 8; m++) *(uint2*)(p_proj + (size_t)(row0 + m * 16) * INC + c0) = pk4(acc[m][n]);
        } else {
#pragma unroll
          for (int m = 0; m < 8; m++)
            *(float4*)(P.flog + (size_t)(row0 + m * 16) * 16 + (c0 - C_FB)) = make_float4(acc[m][n][0], acc[m][n][1], acc[m][n][2], acc[m][n][3]);
        }
        __builtin_amdgcn_sched_barrier(0);
      }
    }
    __syncthreads();
  }
}

__device__ void gemm2_phase(const Params& P, int layer, char* smem) {
  const int CT = P.NB * TSEQ;
  const int nM = CT >> 8, nN = 4;
  const u16* p_ya = P.ya; const u16* p_yb = P.yb; const u16* p_wa = P.WpaT; const u16* p_wb = P.WpbT;
  for (int i = 0;; i++) {
    GTile u;
    if (!g_next(i, gridDim.x, blockIdx.x, nM, nN, u)) break;
    const int tid = opaque_tid(), wid = tid >> 6, lane = tid & 63, wr = wid >> 2, wc = wid & 3, fr = lane & 15, fq = lane >> 4;
    f32x4 acc[8][4];
    g_zero(acc);
#pragma unroll 1
    for (int pass = 0; pass < 2; pass++) {
      const u16* Ap = (pass ? p_yb : p_ya) + (size_t)(u.pm * 256) * DM;
      const u16* Bp = (pass ? p_wb : p_wa) + (size_t)layer * DM * DM + (size_t)(u.pn * 256) * DM;
      g_kloop(Ap, Bp, DM, smem, acc, tid);
      __builtin_amdgcn_sched_barrier(0);
      if (pass == 0) {
        const int tid1 = opaque_tid(), wid1 = tid1 >> 6, lane1 = tid1 & 63, wr1 = wid1 >> 2, wc1 = wid1 & 3, fr1 = lane1 & 15, fq1 = lane1 >> 4;
        const u16* pp = P.proj + (size_t)(u.pm * 256 + wr1 * 128 + fr1) * INC + u.pn * 256 + wc1 * 64 + fq1 * 4;
#pragma unroll
        for (int m = 0; m < 8; m++) {
#pragma unroll
          for (int n = 0; n < 4; n++) {
            const uint2 ra = *(const uint2*)(pp + (size_t)(m * 16) * INC + C_RA + n * 16);
            const uint2 rb = *(const uint2*)(pp + (size_t)(m * 16) * INC + C_RB + n * 16);
            acc[m][n][0] *= (1.f + __expf(-bflo(rb.x))) / (1.f + __expf(-bflo(ra.x)));
            acc[m][n][1] *= (1.f + __expf(-bfhi(rb.x))) / (1.f + __expf(-bfhi(ra.x)));
            acc[m][n][2] *= (1.f + __expf(-bflo(rb.y))) / (1.f + __expf(-bflo(ra.y)));
            acc[m][n][3] *= (1.f + __expf(-bfhi(rb.y))) / (1.f + __expf(-bfhi(ra.y)));
          }
          __builtin_amdgcn_sched_barrier(0);
        }
      }
    }
    {
      const int tid2 = opaque_tid(), wid2 = tid2 >> 6, lane2 = tid2 & 63, wr2 = wid2 >> 2, wc2 = wid2 & 3, fr2 = lane2 & 15, fq2 = lane2 >> 4;
      const u16* pp = P.proj + (size_t)(u.pm * 256 + wr2 * 128 + fr2) * INC + u.pn * 256 + wc2 * 64 + fq2 * 4;
#pragma unroll
      for (int m = 0; m < 8; m++) {
#pragma unroll
        for (int n = 0; n < 4; n++) {
          const uint2 rb = *(const uint2*)(pp + (size_t)(m * 16) * INC + C_RB + n * 16);
          acc[m][n][0] *= sigmoidf_(bflo(rb.x)); acc[m][n][1] *= sigmoidf_(bfhi(rb.x));
          acc[m][n][2] *= sigmoidf_(bflo(rb.y)); acc[m][n][3] *= sigmoidf_(bfhi(rb.y));
        }
        __builtin_amdgcn_sched_barrier(0);
      }
      wave_store_rows(smem + wid2 * 16384, P.h + (size_t)(u.pm * 256 + wr2 * 128) * DM + u.pn * 256 + wc2 * 64, DM, acc, lane2);
    }
    __syncthreads();
  }
}

__device__ void gemm3_phase(const Params& P, int layer, int chunk, char* smem) {
  const int CT = P.NB * TSEQ;
  const int nM = CT >> 8, nN = 4;
  const float* xs = (layer == 0 ? P.x_in : P.out) + (size_t)chunk * CT * DM;
  float* xd = P.out + (size_t)chunk * CT * DM;
  for (int i = 0;; i++) {
    GTile u;
    if (!g_next(i, gridDim.x, blockIdx.x, nM, nN, u)) break;
    const int tid = opaque_tid(), wid = tid >> 6, lane = tid & 63, wr = wid >> 2, wc = wid & 3, fr = lane & 15, fq = lane >> 4;
    f32x4 acc[8][4];
    g_zero(acc);
    g_kloop(P.h + (size_t)(u.pm * 256) * DM, P.WoT + (size_t)layer * DM * DM + (size_t)(u.pn * 256) * DM, DM, smem, acc, tid);
    const size_t off = (size_t)(u.pm * 256 + wr * 128 + fr) * DM + u.pn * 256 + wc * 64 + fq * 4;
#pragma unroll
    for (int m = 0; m < 8; m++) {
#pragma unroll
      for (int n = 0; n < 4; n++) {
        const float4 xo = *(const float4*)(xs + off + (size_t)(m * 16) * DM + n * 16);
        *(float4*)(xd + off + (size_t)(m * 16) * DM + n * 16) =
            make_float4(xo.x + acc[m][n][0], xo.y + acc[m][n][1], xo.z + acc[m][n][2], xo.w + acc[m][n][3]);
      }
      __builtin_amdgcn_sched_barrier(0);
    }
  }
}

__device__ __forceinline__ void compress_item(const Params& P, const int layer, const int it, char* smem_all, const int tid_all) {
  const int half = tid_all >> 8, tid = tid_all & 255;
  char* smem = smem_all + half * 65536;
  const int lane = tid & 63, r = lane & 31, h = lane >> 5, w = tid >> 6;
  const int wm = w >> 1, wn = w & 1;
  const int unit = it * 2 + half;
  const int bl = unit >> 2, g = (unit >> 1) & 1, kv = unit & 1;
  f32x16 acc[2][2];
  zero_acc(acc);
  ACmp af{P.proj + (size_t)bl * TSEQ * INC + C_KV + kv * 128 + g * 64};
  gemm_mainloop(af, P.W1T + (size_t)(layer * 2 + kv) * 128 * 2048, 2048, 2048, smem, acc, tid);
  const float* bp = P.bias1p + (size_t)((layer * 2 + kv) * 8) * 128;
#pragma unroll
  for (int ni = 0; ni < 2; ni++) {
    int hc = wn * 64 + ni * 32 + r;
    float b1 = 0.f;
#pragma unroll
    for (int q = 0; q < 8; q++) b1 += bp[q * 128 + hc];
#pragma unroll
    for (int mi = 0; mi < 2; mi++)
#pragma unroll
      for (int i = 0; i < 16; i++) {
        int n = wm * 64 + mi * 32 + 8 * (i >> 2) + 4 * h + (i & 3);
        float v = siluf_(acc[mi][ni][i] + b1);
        *(u16*)(smem + n * 256 + (((hc >> 3) ^ (n & 15)) << 4) + (hc & 7) * 2) = f2bf(v);
      }
  }
  __syncthreads();
  const u16* w2t = P.W2T + (size_t)(layer * 2 + kv) * 64 * 128;
  f32x16 o2[2];
#pragma unroll
  for (int dt = 0; dt < 2; dt++)
#pragma unroll
    for (int i = 0; i < 16; i++) o2[dt][i] = 0.f;
#pragma unroll
  for (int kk = 0; kk < 8; kk++) {
    int n = w * 32 + r;
    bf16x8 a = ldfrag(smem + n * 256 + (((kk * 2 + h) ^ (n & 15)) << 4));
#pragma unroll
    for (int dt = 0; dt < 2; dt++) {
      bf16x8 b = ldfrag(w2t + (size_t)(dt * 32 + r) * 128 + kk * 16 + h * 8);
      o2[dt] = mfma32(a, b, o2[dt]);
    }
  }
#pragma unroll
  for (int dt = 0; dt < 2; dt++) {
    int d = dt * 32 + r;
    if (kv == 0) {
#pragma unroll
      for (int i = 0; i < 16; i++) {
        int n = w * 32 + 8 * (i >> 2) + 4 * h + (i & 3);
        P.kcmp[((size_t)(bl * 2 + g) * 128 + n) * 64 + d] = f2bf(o2[dt][i]);
      }
    } else {
#pragma unroll
      for (int gq = 0; gq < 4; gq++) {
        int n0 = w * 32 + 8 * gq + 4 * h;
        uint2 o;
        o.x = pk2(o2[dt][gq * 4 + 0], o2[dt][gq * 4 + 1]);
        o.y = pk2(o2[dt][gq * 4 + 2], o2[dt][gq * 4 + 3]);
        *(uint2*)(P.vcmpt + ((size_t)(bl * 2 + g) * 64 + d) * 128 + n0) = o;
      }
    }
  }
  __syncthreads();
}

__device__ void pb_phase(const Params& P, int layer, char* smem_all) {
  const int tid_all = opaque_tid();
  const int lane = tid_all & 63;
  const int nScan = P.NB * 2;
  for (int it = blockIdx.x; it < nScan; it += gridDim.x) {
    {
      const int sidx = it * 8 + (tid_all >> 6);
      const int bl = sidx >> 4, hh = sidx & 15;
      const float bf = P.b_forget[layer * 16 + hh];
      const float* fl = P.flog + ((size_t)bl * TSEQ + lane * 32) * 16 + hh;
      float loc = 0.f;
#pragma unroll 8
      for (int j = 0; j < 32; j++) {
        float x = fl[j * 16] + bf;
        float ls = (x >= 0.f) ? -log1pf(__expf(-x)) : (x - log1pf(__expf(x)));
        loc += ls;
      }
      float incl = loc;
#pragma unroll
      for (int o = 1; o < 64; o <<= 1) {
        float v = __shfl_up(incl, o);
        if (lane >= o) incl += v;
      }
      float run = incl - loc;
      float* fo = P.F2 + ((size_t)bl * 16 + hh) * TSEQ + lane * 32;
#pragma unroll 8
      for (int j = 0; j < 32; j++) {
        float x = fl[j * 16] + bf;
        float ls = (x >= 0.f) ? -log1pf(__expf(-x)) : (x - log1pf(__expf(x)));
        run += ls;
        fo[j] = -8.0f * run;
      }
    }
  }
}

__device__ void pc1_phase(const Params& P, char* smem) {
  const int tid = opaque_tid(),  lane = tid & 63, r = lane & 31, h = lane >> 5, w = tid >> 6;
  const int nItems = P.NB * 2 * 8;
  const float c1 = 0.125f * LOG2E;
  for (int it = blockIdx.x; it < nItems; it += gridDim.x) {
    const int qt = it & 7, g = (it >> 3) & 1, bl = it >> 4;
    __syncthreads();
#pragma unroll
    for (int j = 0; j < 2; j++) {
      int c = tid + 512 * j;
      {
        int n = c >> 3, ch = c & 7;
        uint4 v = *(const uint4*)(P.kcmp + ((size_t)(bl * 2 + g) * 128 + n) * 64 + ch * 8);
        *(uint4*)(smem + n * 128 + ((ch ^ ((n >> 1) & 7)) << 4)) = v;
      }
      {
        int d = c >> 4, ch = c & 15;
        uint4 v = *(const uint4*)(P.vcmpt + ((size_t)(bl * 2 + g) * 64 + d) * 128 + ch * 8);
        int sw = d & 31;
        *(uint2*)(smem + 16384 + d * 256 + (((2 * ch) ^ sw) << 3)) = make_uint2(v.x, v.y);
        *(uint2*)(smem + 16384 + d * 256 + (((2 * ch + 1) ^ sw) << 3)) = make_uint2(v.z, v.w);
      }
    }
    __syncthreads();
    const int qw_lo = qt * 256 + w * 32;
    const int qtok = qw_lo + r;
    const size_t rowg = (size_t)bl * TSEQ + qtok;
    const int tq = qtok - 31 - 64 * h;
    float sumacc[16], lastacc[16];
#pragma unroll
    for (int s = 0; s < 16; s++) { sumacc[s] = 0.f; lastacc[s] = 0.f; }
#pragma unroll 1
    for (int hh = 0; hh < 8; hh++) {
      const int head = g * 8 + hh;
      bf16x8 qf[4];
#pragma unroll
      for (int kk = 0; kk < 4; kk++) qf[kk] = ldfrag(P.proj + rowg * INC + C_QA + head * 64 + kk * 16 + h * 8);
      f32x16 s[4];
#pragma unroll
      for (int nt = 0; nt < 4; nt++) {
#pragma unroll
        for (int i = 0; i < 16; i++) s[nt][i] = 0.f;
#pragma unroll
        for (int kk = 0; kk < 4; kk++) {
          int row = nt * 32 + r;
          bf16x8 a = ldfrag(smem + row * 128 + (((kk * 2 + h) ^ ((row >> 1) & 7)) << 4));
          s[nt] = mfma32(a, qf[kk], s[nt]);
        }
        __builtin_amdgcn_sched_barrier(0);
      }
      float mx = -3.0e38f;
#pragma unroll
      for (int nt = 0; nt < 4; nt++)
#pragma unroll
        for (int i = 0; i < 16; i++) {
          bool ok = (16 * (nt * 32 + 8 * (i >> 2) + (i & 3))) <= tq;
          float v = ok ? s[nt][i] * c1 : -3.0e38f;
          s[nt][i] = v;
          mx = fmaxf(mx, v);
        }
      mx = fmaxf(mx, __shfl_xor(mx, 32));
      const bool anyv = mx > -1.0e37f;
      float mref = anyv ? mx : 0.f;
      float l = 0.f;
#pragma unroll
      for (int nt = 0; nt < 4; nt++)
#pragma unroll
        for (int i = 0; i < 16; i++) {
          float p = __builtin_amdgcn_exp2f(s[nt][i] - mref);
          s[nt][i] = p;
          l += p;
        }
      l += __shfl_xor(l, 32);
      const float inv = (anyv && l > 0.f) ? 1.f / l : 0.f;
#pragma unroll
      for (int nt = 0; nt < 4; nt++)
#pragma unroll
        for (int i = 0; i < 16; i++) s[nt][i] *= inv;
#pragma unroll
      for (int nt = 0; nt < 4; nt++)
#pragma unroll
        for (int gq = 0; gq < 4; gq++) {
          sumacc[nt * 4 + gq] += (s[nt][gq * 4] + s[nt][gq * 4 + 1]) + (s[nt][gq * 4 + 2] + s[nt][gq * 4 + 3]);
          lastacc[nt * 4 + gq] += s[nt][gq * 4 + 3];
        }
      uint4 pbv[8];
#pragma unroll
      for (int ks = 0; ks < 8; ks++) {
        const int nt = ks >> 1, hb = (ks & 1) * 8;
        pbv[ks].x = pk2(s[nt][hb + 0], s[nt][hb + 1]); pbv[ks].y = pk2(s[nt][hb + 2], s[nt][hb + 3]);
        pbv[ks].z = pk2(s[nt][hb + 4], s[nt][hb + 5]); pbv[ks].w = pk2(s[nt][hb + 6], s[nt][hb + 7]);
      }
      const float g0 = sigmoidf_(bf2f(P.proj[rowg * INC + C_GA + head]));
#pragma unroll
      for (int dt = 0; dt < 2; dt++) {
        f32x16 o;
#pragma unroll
        for (int i = 0; i < 16; i++) o[i] = 0.f;
        const int d = dt * 32 + r, sw = d & 31;
#pragma unroll
        for (int ks = 0; ks < 8; ks++) {
          uint2 lo = *(const uint2*)(smem + 16384 + d * 256 + (((ks * 4 + h) ^ sw) << 3));
          uint2 hi = *(const uint2*)(smem + 16384 + d * 256 + (((ks * 4 + 2 + h) ^ sw) << 3));
          uint4 au = make_uint4(lo.x, lo.y, hi.x, hi.y);
          o = mfma32(__builtin_bit_cast(bf16x8, au), __builtin_bit_cast(bf16x8, pbv[ks]), o);
        }
#pragma unroll
        for (int gq = 0; gq < 4; gq++) {
          int d0 = dt * 32 + 8 * gq + 4 * h;
          uint2 ov;
          ov.x = pk2(o[gq * 4 + 0] * g0, o[gq * 4 + 1] * g0);
          ov.y = pk2(o[gq * 4 + 2] * g0, o[gq * 4 + 3] * g0);
          *(uint2*)(P.ya + rowg * DM + head * 64 + d0) = ov;
        }
        __builtin_amdgcn_sched_barrier(0);
      }
    }
    float sc[16];
#pragma unroll
    for (int s = 0; s < 16; s++) {
      float prev = (s == 0) ? 0.f : lastacc[s - 1];
      float sendv = h ? prev : lastacc[s];
      float recv = __shfl_xor(sendv, 32);
      float imp = sumacc[s] + recv;
      int j = (s >> 2) * 8 + (s & 3) * 2 + h;
      int cur = qtok >> 6;
      bool forced = (j == 0) || (j == cur) || (j == cur - 1);
      bool valid = j <= cur;
      sc[s] = forced ? 1.0e4f : (valid ? imp : -1.0f);
    }
    unsigned mask = 0u;
#pragma unroll 1
    for (int rd = 0; rd < 8; rd++) {
      float best = -2.0f; int bj = 0;
#pragma unroll
      for (int s = 0; s < 16; s++) {
        int j = (s >> 2) * 8 + (s & 3) * 2 + h;
        if (sc[s] > best) { best = sc[s]; bj = j; }
      }
      float ob = __shfl_xor(best, 32);
      int oj = __shfl_xor(bj, 32);
      bool mine = (best > ob) || (best == ob && bj < oj);
      int wj = mine ? bj : oj;
      mask |= 1u << wj;
#pragma unroll
      for (int s = 0; s < 16; s++) {
        int j = (s >> 2) * 8 + (s & 3) * 2 + h;
        if (j == wj) sc[s] = -3.0f;
      }
    }
    if (h == 0) P.sel[(size_t)(bl * 2 + g) * TSEQ + qtok] = mask;
  }
}

#define A_SLOTB 8192
#define A_LDS_K 0
#define A_LDS_V 24576
#define A_LDS_WS 49152
#define A_LDS_F 51200
#define A_LDS_OST 52224
#define A_THR 8.0f
#define A_C2 (0.125f * LOG2E)
typedef __attribute__((ext_vector_type(4))) short a_s16x4;
typedef __attribute__((ext_vector_type(8))) short a_s16x8;
typedef __attribute__((ext_vector_type(4))) unsigned a_u32x4;
typedef __attribute__((address_space(3))) const char* a_lds_cptr;
typedef short a_v4i16 __attribute__((ext_vector_type(4)));
#define A_SBAR() __builtin_amdgcn_sched_barrier(0)
#define A_PIN(x) asm volatile("" : "+v"(x))
#define A_MFMA(a, b, c) __builtin_amdgcn_mfma_f32_32x32x16_bf16(a, b, c, 0, 0, 0)
template <int N> __device__ __forceinline__ void a_wait_bar() { asm volatile("s_waitcnt vmcnt(%0) lgkmcnt(0)\n\ts_barrier" ::"n"(N) : "memory"); }
__device__ __forceinline__ int a_crow(int r, int hi) { return (r & 3) + 8 * (r >> 2) + 4 * hi; }
__device__ __forceinline__ unsigned a_cvtpk(float lo, float hi) { unsigned r; asm("v_cvt_pk_bf16_f32 %0, %1, %2" : "=v"(r) : "v"(lo), "v"(hi)); return r; }
__device__ __forceinline__ void a_glds16(const void* g, unsigned lds_base) {
  unsigned sv; asm volatile("s_mov_b32 %0, m0\n\ts_mov_b32 m0, %2\n\ts_nop 0\n\tglobal_load_lds_dwordx4 %1, off\n\ts_mov_b32 m0, %0" : "=&s"(sv) : "v"(g), "s"(lds_base) : "memory"); }
__device__ __forceinline__ void a_glds4(const void* g, unsigned lds_base) {
  unsigned sv; asm volatile("s_mov_b32 %0, m0\n\ts_mov_b32 m0, %2\n\ts_nop 0\n\tglobal_load_lds_dword %1, off\n\ts_mov_b32 m0, %0" : "=&s"(sv) : "v"(g), "s"(lds_base) : "memory"); }
__device__ __forceinline__ void a_kload2(bf16x8* kf, a_lds_cptr kp, int d0) {
  kf[2 * d0] = *(const __attribute__((address_space(3))) bf16x8*)(kp + d0 * 2048);
  kf[2 * d0 + 1] = *(const __attribute__((address_space(3))) bf16x8*)(kp + d0 * 2048 + 512); }
__device__ __forceinline__ a_s16x4 a_vtr(a_lds_cptr p) { return __builtin_bit_cast(a_s16x4, __builtin_amdgcn_ds_read_tr16_b64_v4i16((__attribute__((address_space(3))) a_v4i16*)p)); }
#define A_MX3(a, b, c) __builtin_fmaxf(__builtin_fmaxf((a), (b)), (c))
__device__ __forceinline__ float a_rowmax(const f32x16& p0, const f32x16& p1) {
  float a = A_MX3(p0[0], p0[1], p1[0]), b = A_MX3(p0[2], p0[3], p1[1]); a = A_MX3(a, p1[2], p1[3]);
#pragma unroll
  for (int r = 4; r < 16; r += 4) { a = A_MX3(a, p0[r], p0[r + 1]); b = A_MX3(b, p0[r + 2], p0[r + 3]); a = A_MX3(a, p1[r], p1[r + 1]); b = A_MX3(b, p1[r + 2], p1[r + 3]); }
  float m = __builtin_fmaxf(a, b); auto rr = __builtin_amdgcn_permlane32_swap(__float_as_uint(m), __float_as_uint(m), false, false);
  return __builtin_fmaxf(__uint_as_float(rr[0]), __uint_as_float(rr[1])); }
template <int MODE>
__device__ __forceinline__ void a_mask(f32x16& p0, f32x16& p1, int key0, int qabs, int hi) {
  const int kb = key0 + 4 * hi;
#pragma unroll
  for (int r = 0; r < 16; ++r) {
    const int kv = kb + (r & 3) + 8 * (r >> 2);
    bool bad0 = kv > qabs, bad1 = (kv + 32) > qabs;
    if (MODE == 2) { bad0 = bad0 || (kv + 512 <= qabs); bad1 = bad1 || (kv + 32 + 512 <= qabs); }
    if (bad0) p0[r] = -INFINITY;
    if (bad1) p1[r] = -INFINITY;
  } }
__device__ __forceinline__ void a_bias(f32x16& p0, f32x16& p1, const char* fb, int hi) {
#pragma unroll
  for (int g = 0; g < 4; ++g) {
    const float4 b0 = *(const float4*)(fb + (8 * g + 4 * hi) * 4);
    const float4 b1 = *(const float4*)(fb + (32 + 8 * g + 4 * hi) * 4);
    p0[4 * g + 0] += b0.x; p0[4 * g + 1] += b0.y; p0[4 * g + 2] += b0.z; p0[4 * g + 3] += b0.w;
    p1[4 * g + 0] += b1.x; p1[4 * g + 1] += b1.y; p1[4 * g + 2] += b1.z; p1[4 * g + 3] += b1.w;
  } }

template <int MODE>
__device__ __forceinline__ void a_unit(const u16* __restrict__ Qw, const int qp, const u16* __restrict__ Kp, const u16* __restrict__ Vp,
                                       const float* __restrict__ Fp, const int NT, const int key00, const int qabs, const unsigned selm,
                                       const float gate, char* lds, u16* stg, const int tid) {
  constexpr int NK = (MODE == 0) ? 2 : 1;
  const int lane = tid & 63, r32 = lane & 31, hi = lane >> 5; const int wid = __builtin_amdgcn_readfirstlane(tid >> 6);
  const unsigned lds0 = (unsigned)(uintptr_t)lds; float* wsf = (float*)(lds + A_LDS_WS) + wid * 64;
  const u16* ksrc = Kp + (long)lane * INC + wid * 8;
  const u16* vsrc = Vp + (long)(16 * (wid & 3) + (lane >> 2)) * INC + (wid >> 2) * 32 + (lane & 3) * 8;
  const float* fsrc = Fp + lane;
  const unsigned kdst = lds0 + A_LDS_K + wid * 1024, vdst = lds0 + A_LDS_V + wid * 1024, fdst = lds0 + A_LDS_F;
#define A_DMA_K(t, slot) do { a_glds16(ksrc + (long)(t) * 64 * INC, (unsigned)__builtin_amdgcn_readfirstlane(kdst + (slot))); \
    if (MODE == 0) a_glds4(fsrc + (t) * 64, (unsigned)__builtin_amdgcn_readfirstlane(fdst + ((t) & 3) * 256)); } while (0)
#define A_DMA_V(t, slot) a_glds16(vsrc + (long)(t) * 64 * INC, (unsigned)__builtin_amdgcn_readfirstlane(vdst + (slot)))
  const a_lds_cptr vp0 = (a_lds_cptr)lds + A_LDS_V + ((lane >> 4) & 1) * 32 + (lane & 3) * 8 + (4 * hi + ((lane & 15) >> 2)) * 64;
  const a_lds_cptr kp0 = (a_lds_cptr)lds + A_LDS_K + hi * 1024 + r32 * 16;
  const char* fb0 = lds + A_LDS_F;
  A_DMA_K(0, 0); A_DMA_V(0, 0); A_DMA_K(1, A_SLOTB);
  bf16x8 qr[4];
#pragma unroll
  for (int d0 = 0; d0 < 4; ++d0) qr[d0] = ldfrag(Qw + (long)r32 * qp + d0 * 16 + hi * 8);
  float mhat = 0.f, l_reg = 0.f; f32x16 o[2];
#pragma unroll
  for (int r = 0; r < 16; ++r) { o[0][r] = 0.f; o[1][r] = 0.f; }
  const f32x16 zero16 = {0.f, 0.f, 0.f, 0.f, 0.f, 0.f, 0.f, 0.f, 0.f, 0.f, 0.f, 0.f, 0.f, 0.f, 0.f, 0.f};
  bool resc = false;
  f32x16 pA0, pA1, pB0, pB1; bf16x8 kf[8]; a_s16x4 vlo[8], vhi[8]; a_u32x4 pw0, pw1, pw2, pw3;
  int sl_prev = 0, sl_cur = 0, sl_next = A_SLOTB;
#define A_ROT() do { sl_prev = sl_cur; sl_cur = sl_next; sl_next = (sl_next == 2 * A_SLOTB) ? 0 : sl_next + A_SLOTB; } while (0)
#define A_EX(v) __builtin_amdgcn_exp2f(__builtin_fmaf((v), A_C2, nmh))
#define A_RESC() do { if (resc) { _Pragma("unroll") for (int d_ = 0; d_ < 2; ++d_) _Pragma("unroll") for (int r = 0; r < 16; ++r) o[d_][r] *= wsf[a_crow(r, hi)]; } } while (0)
  A_DMA_K(2, 2 * A_SLOTB);
  a_wait_bar<1 + 2 * NK>();
  _Pragma("unroll") for (int d0 = 0; d0 < 4; ++d0) a_kload2(kf, kp0, d0);
  pA0 = A_MFMA(kf[0], qr[0], zero16); pA1 = A_MFMA(kf[1], qr[0], zero16); pA0 = A_MFMA(kf[2], qr[1], pA0); pA1 = A_MFMA(kf[3], qr[1], pA1);
  pA0 = A_MFMA(kf[4], qr[2], pA0); pA1 = A_MFMA(kf[5], qr[2], pA1); pA0 = A_MFMA(kf[6], qr[3], pA0); pA1 = A_MFMA(kf[7], qr[3], pA1);
  if (MODE == 0) a_bias(pA0, pA1, fb0, hi);
  if (MODE == 2 || NT == 4) a_mask<MODE>(pA0, pA1, key00, qabs, hi);
  { const float rm = a_rowmax(pA0, pA1); mhat = __builtin_fmaxf(rm * A_C2, -1.0e30f); const float nmh = -mhat;
#pragma unroll
    for (int r = 0; r < 16; ++r) { pA0[r] = A_EX(pA0[r]); pA1[r] = A_EX(pA1[r]); } }
  a_wait_bar<0>();
  A_DMA_K(3, 0); A_DMA_V(1, A_SLOTB); A_ROT();
  _Pragma("unroll") for (int d0 = 0; d0 < 4; ++d0) a_kload2(kf, kp0 + sl_cur, d0);
  a_wait_bar<NK + 1>();
#define A_PKW(P, i) a_cvtpk(P[i], P[i + 1])
#define A_PAF(k) __builtin_bit_cast(bf16x8, pw##k)
#define A_VFR(i) __builtin_bit_cast(bf16x8, __builtin_shufflevector(vlo[i], vhi[i], 0, 1, 2, 3, 4, 5, 6, 7))
#define A_VRD(i) do { vlo[i] = a_vtr(vp_ + (((i) >> 2) * 4096 + ((i) & 3) * 1024)); vhi[i] = a_vtr(vp_ + (((i) >> 2) * 4096 + ((i) & 3) * 1024 + 512)); } while (0)
#define A_KRD(G, d0) do { if (G) { a_kload2(kf, kp0 + sl_next, d0); A_SBAR(); } } while (0)
#define A_GAPA(MF, a0, a1, a2, a3, W0, W1, PW) do { MF; sacc += a0; sacc += a1; sacc += a2; sacc += a3; W0; W1; A_PIN(PW); A_PIN(sacc); A_SBAR(); } while (0)
#define A_GAPB(MF, X, i) do { MF; X[i] = A_EX(X[i]); X[i + 1] = A_EX(X[i + 1]); X[i + 2] = A_EX(X[i + 2]); X[i + 3] = A_EX(X[i + 3]); A_PIN(X); A_SBAR(); } while (0)
#define A_STEP(C0, C1, P0, P1, t, MASK, GK, GV, GL) do { A_SBAR(); \
    const a_lds_cptr vp_ = vp0 + sl_prev; \
    A_VRD(0); A_SBAR(); float sacc = P0[0] + P0[1]; \
                      A_GAPA(C0 = A_MFMA(kf[0], qr[0], zero16), P0[2], P0[3], P0[4], P0[5],     pw0[0] = A_PKW(P0, 0),  pw0[1] = A_PKW(P0, 2),  pw0); \
    A_VRD(4); A_SBAR(); A_GAPA(C1 = A_MFMA(kf[1], qr[0], zero16), P0[6], P0[7], P0[8], P0[9],     pw0[2] = A_PKW(P0, 4),  pw0[3] = A_PKW(P0, 6),  pw0); \
    A_VRD(1); A_SBAR(); A_GAPA(C0 = A_MFMA(kf[2], qr[1], C0),    P0[10], P0[11], P0[12], P0[13], pw1[0] = A_PKW(P0, 8),  pw1[1] = A_PKW(P0, 10), pw1); \
    A_VRD(5); A_SBAR(); A_GAPA(C1 = A_MFMA(kf[3], qr[1], C1),    P0[14], P0[15], P1[0], P1[1],   pw1[2] = A_PKW(P0, 12), pw1[3] = A_PKW(P0, 14), pw1); \
    A_VRD(2); A_SBAR(); A_GAPA(C0 = A_MFMA(kf[4], qr[2], C0),    P1[2], P1[3], P1[4], P1[5],     pw2[0] = A_PKW(P1, 0),  pw2[1] = A_PKW(P1, 2),  pw2); \
    A_VRD(6); A_SBAR(); A_GAPA(C1 = A_MFMA(kf[5], qr[2], C1),    P1[6], P1[7], P1[8], P1[9],     pw2[2] = A_PKW(P1, 4),  pw2[3] = A_PKW(P1, 6),  pw2); \
    A_VRD(3); A_SBAR(); A_GAPA(C0 = A_MFMA(kf[6], qr[3], C0),    P1[10], P1[11], P1[12], P1[13], pw3[0] = A_PKW(P1, 8),  pw3[1] = A_PKW(P1, 10), pw3); \
    A_VRD(7); A_SBAR(); A_GAPA(C1 = A_MFMA(kf[7], qr[3], C1),    P1[14], P1[15], 0.f, 0.f,       pw3[2] = A_PKW(P1, 12), pw3[3] = A_PKW(P1, 14), pw3); \
    l_reg += sacc; \
    if (GK) A_DMA_K((t) + 3, sl_cur); if (GV) A_DMA_V((t) + 1, sl_next); \
    if (MODE == 0) a_bias(C0, C1, fb0 + ((t) & 3) * 256, hi); \
    if (MASK) a_mask<MODE>(C0, C1, key00 + (t) * 64, qabs, hi); \
    const bool selb_ = (MODE != 1) || (((selm >> ((t) & 31)) & 1u) != 0u); \
    { float rmx = a_rowmax(C0, C1) * A_C2; if (!selb_) rmx = -INFINITY; resc = false; \
      if (__builtin_expect(__any((rmx - mhat) > A_THR), 0)) { const float mnew = __builtin_fmaxf(mhat, rmx); \
          const float f = __builtin_amdgcn_exp2f(mhat - mnew); mhat = mnew; l_reg *= f; if (hi == 0) wsf[r32] = f; resc = true; } } \
    const float nmh = selb_ ? -mhat : -INFINITY; A_SBAR(); \
    A_GAPB(o[0] = A_MFMA(A_PAF(0), A_VFR(0), o[0]), C0, 0);              A_GAPB(o[1] = A_MFMA(A_PAF(0), A_VFR(4), o[1]), C0, 4); \
    A_KRD(GL, 0); A_GAPB(o[0] = A_MFMA(A_PAF(1), A_VFR(1), o[0]), C0, 8);  A_KRD(GL, 1); A_GAPB(o[1] = A_MFMA(A_PAF(1), A_VFR(5), o[1]), C0, 12); \
    A_KRD(GL, 2); A_GAPB(o[0] = A_MFMA(A_PAF(2), A_VFR(2), o[0]), C1, 0);  A_KRD(GL, 3); A_GAPB(o[1] = A_MFMA(A_PAF(2), A_VFR(6), o[1]), C1, 4); \
    A_GAPB(o[0] = A_MFMA(A_PAF(3), A_VFR(3), o[0]), C1, 8);              A_GAPB(o[1] = A_MFMA(A_PAF(3), A_VFR(7), o[1]), C1, 12); \
    } while (0)
  int t = 1;
  if (MODE != 2) {
    for (; t + 5 < NT; t += 2) {
      A_STEP(pB0, pB1, pA0, pA1, t, false, true, true, true);     a_wait_bar<NK + 1>(); A_RESC(); A_ROT();
      A_STEP(pA0, pA1, pB0, pB1, t + 1, false, true, true, true); a_wait_bar<NK + 1>(); A_RESC(); A_ROT();
    }
  }
#define A_ENDW(tt) do { if ((tt) + 3 < NT) { a_wait_bar<NK + 1>(); } else if ((tt) + 2 < NT) { a_wait_bar<1>(); } else { a_wait_bar<0>(); } } while (0)
  for (; t + 1 < NT; t += 2) {
    A_STEP(pB0, pB1, pA0, pA1, t, (MODE != 2 || t < 4 || t + 4 >= NT), (t + 3 < NT), (t + 1 < NT), (t + 1 < NT));             A_ENDW(t);     A_RESC(); A_ROT();
    A_STEP(pA0, pA1, pB0, pB1, t + 1, (MODE != 2 || t + 1 < 4 || t + 5 >= NT), (t + 4 < NT), (t + 2 < NT), (t + 2 < NT));     A_ENDW(t + 1); A_RESC(); A_ROT();
  }
  A_STEP(pB0, pB1, pA0, pA1, NT - 1, true, false, false, false); A_RESC();
  { float sacc = pB0[0] + pB0[1];
#pragma unroll
    for (int r = 2; r < 16; ++r) sacc += pB0[r];
#pragma unroll
    for (int r = 0; r < 16; ++r) sacc += pB1[r];
    l_reg += sacc;
    pw0 = (a_u32x4){A_PKW(pB0, 0), A_PKW(pB0, 2), A_PKW(pB0, 4), A_PKW(pB0, 6)}; pw1 = (a_u32x4){A_PKW(pB0, 8), A_PKW(pB0, 10), A_PKW(pB0, 12), A_PKW(pB0, 14)};
    pw2 = (a_u32x4){A_PKW(pB1, 0), A_PKW(pB1, 2), A_PKW(pB1, 4), A_PKW(pB1, 6)}; pw3 = (a_u32x4){A_PKW(pB1, 8), A_PKW(pB1, 10), A_PKW(pB1, 12), A_PKW(pB1, 14)};
    const a_lds_cptr vp_ = vp0 + sl_cur; _Pragma("unroll") for (int i = 0; i < 8; ++i) A_VRD(i);
    o[0] = A_MFMA(A_PAF(0), A_VFR(0), o[0]); o[1] = A_MFMA(A_PAF(0), A_VFR(4), o[1]); o[0] = A_MFMA(A_PAF(1), A_VFR(1), o[0]); o[1] = A_MFMA(A_PAF(1), A_VFR(5), o[1]);
    o[0] = A_MFMA(A_PAF(2), A_VFR(2), o[0]); o[1] = A_MFMA(A_PAF(2), A_VFR(6), o[1]); o[0] = A_MFMA(A_PAF(3), A_VFR(3), o[0]); o[1] = A_MFMA(A_PAF(3), A_VFR(7), o[1]); }
  { auto rr = __builtin_amdgcn_permlane32_swap(__float_as_uint(l_reg), __float_as_uint(l_reg), false, false); l_reg = __uint_as_float(rr[0]) + __uint_as_float(rr[1]); }
  if (hi == 0) wsf[32 + r32] = gate / l_reg;
  asm volatile("s_waitcnt lgkmcnt(0)" ::: "memory");
  float rli[16];
#pragma unroll
  for (int r = 0; r < 16; ++r) rli[r] = wsf[32 + a_crow(r, hi)];
#pragma unroll
  for (int r = 0; r < 16; ++r) { const int orow = a_crow(r, hi);
#pragma unroll
    for (int d0 = 0; d0 < 2; ++d0) stg[orow * 64 + d0 * 32 + r32] = f2bf(o[d0][r] * rli[r]); }
  asm volatile("s_waitcnt lgkmcnt(0)\n\ts_barrier" ::: "memory");
#undef A_DMA_K
#undef A_DMA_V
#undef A_ROT
#undef A_EX
#undef A_RESC
#undef A_PKW
#undef A_PAF
#undef A_VFR
#undef A_VRD
#undef A_KRD
#undef A_ENDW
#undef A_GAPA
#undef A_GAPB
#undef A_STEP
}

__device__ void pc2_phase(const Params& P, int layer, int chunk, char* smem, int* s_item, const int which) {
  const int perq = P.NB * 16;
  const int nCmp = which ? 0 : P.NB * 2;
  const int nItems = nCmp + 8 * perq;
  unsigned* ctr = P.ctr + (chunk * 4 + layer) + which * 16;
  while (true) {
    const int tid = opaque_tid(), lane = tid & 63, r32 = lane & 31, w = tid >> 6;
    __syncthreads();
    if (tid == 0) *s_item = (int)atomicAdd(ctr, 1u);
    __syncthreads();
    const int it0 = *s_item;
    if (it0 >= nItems) break;
    if (it0 < nCmp) { compress_item(P, layer, it0, smem, tid); continue; }
    const int it = it0 - nCmp;
    const int qt = 7 - it / perq;
    const int bh = it % perq;
    const int type = which;
    const int bl = bh >> 4, head = bh & 15;
    const int q0w = qt * 256 + w * 32;
    const int qabs = q0w + r32;
    const size_t rowq = (size_t)bl * TSEQ + qabs;
    const size_t roww = (size_t)bl * TSEQ + q0w;
    const u16* pb_ = P.proj + (size_t)bl * TSEQ * INC;
    u16* stg = (u16*)(smem + A_LDS_OST) + w * 4096;
    const int er = lane >> 3, ec = (lane & 7) * 8;
    if (type == 0) {
      a_unit<0>(pb_ + roww * 0 + (size_t)q0w * INC + C_QB + head * 64, INC, pb_ + C_KB + head * 64, pb_ + C_VB + head * 64,
                P.F2 + (size_t)(bl * 16 + head) * TSEQ, 4 * qt + 4, 0, qabs, 0u, 1.0f, smem, stg, tid);
#pragma unroll
      for (int i = 0; i < 4; i++) {
        const int row = i * 8 + er;
        const uint4 ov = *(const uint4*)(stg + row * 64 + ec);
        const uint4 zz = *(const uint4*)(pb_ + (size_t)(q0w + row) * INC + C_ZB + head * 64 + ec);
        uint4 y;
        y.x = pk2(bflo(ov.x) * siluf_(bflo(zz.x)), bfhi(ov.x) * siluf_(bfhi(zz.x)));
        y.y = pk2(bflo(ov.y) * siluf_(bflo(zz.y)), bfhi(ov.y) * siluf_(bfhi(zz.y)));
        y.z = pk2(bflo(ov.z) * siluf_(bflo(zz.z)), bfhi(ov.z) * siluf_(bfhi(zz.z)));
        y.w = pk2(bflo(ov.w) * siluf_(bflo(zz.w)), bfhi(ov.w) * siluf_(bfhi(zz.w)));
        *(uint4*)(P.yb + (roww + row) * DM + head * 64 + ec) = y;
      }
    } else {
      const int g = head >> 3;
      const unsigned selm = P.sel[(size_t)(bl * 2 + g) * TSEQ + qabs];
      const float g1 = sigmoidf_(bf2f(P.proj[rowq * INC + C_GA + 16 + head]));
      const float g2 = sigmoidf_(bf2f(P.proj[rowq * INC + C_GA + 32 + head]));
      const u16* qw = P.qr + roww * DM + head * 64;
      a_unit<1>(qw, DM, pb_ + C_KV + 256 + g * 64, pb_ + C_KV + 384 + g * 64, nullptr, 4 * qt + 4, 0, qabs, selm, g1, smem, stg, tid);
      const int klo = (4 * qt - 8) > 0 ? (4 * qt - 8) : 0;
      a_unit<2>(qw, DM, pb_ + (size_t)(klo * 64) * INC + C_KV + 512 + g * 64, pb_ + (size_t)(klo * 64) * INC + C_KV + 640 + g * 64, nullptr,
                4 * qt + 4 - klo, klo * 64, qabs, 0u, g2, smem, stg + 2048, tid);
#pragma unroll
      for (int i = 0; i < 4; i++) {
        const int row = i * 8 + er;
        const uint4 o1 = *(const uint4*)(stg + row * 64 + ec);
        const uint4 o2 = *(const uint4*)(stg + 2048 + row * 64 + ec);
        const uint4 zz = *(const uint4*)(pb_ + (size_t)(q0w + row) * INC + C_ZA + head * 64 + ec);
        u16* yp = P.ya + (roww + row) * DM + head * 64 + ec;
        const uint4 oc = *(const uint4*)yp;
        uint4 y;
        y.x = pk2((bflo(o1.x) + bflo(o2.x) + bflo(oc.x)) * siluf_(bflo(zz.x)), (bfhi(o1.x) + bfhi(o2.x) + bfhi(oc.x)) * siluf_(bfhi(zz.x)));
        y.y = pk2((bflo(o1.y) + bflo(o2.y) + bflo(oc.y)) * siluf_(bflo(zz.y)), (bfhi(o1.y) + bfhi(o2.y) + bfhi(oc.y)) * siluf_(bfhi(zz.y)));
        y.z = pk2((bflo(o1.z) + bflo(o2.z) + bflo(oc.z)) * siluf_(bflo(zz.z)), (bfhi(o1.z) + bfhi(o2.z) + bfhi(oc.z)) * siluf_(bfhi(zz.z)));
        y.w = pk2((bflo(o1.w) + bflo(o2.w) + bflo(oc.w)) * siluf_(bflo(zz.w)), (bfhi(o1.w) + bfhi(o2.w) + bfhi(oc.w)) * siluf_(bfhi(zz.w)));
        *(uint4*)yp = y;
      }
    }
  }
}

__device__ __forceinline__ void grid_bar(unsigned* ctr, unsigned& epoch) {
  asm volatile("s_waitcnt vmcnt(0) lgkmcnt(0)" ::: "memory");
  __syncthreads();
  epoch += gridDim.x;
  if (threadIdx.x == 0) {
    __builtin_amdgcn_fence(__ATOMIC_RELEASE, "agent");
    asm volatile("s_waitcnt vmcnt(0)" ::: "memory");
    __hip_atomic_fetch_add(ctr, 1u, __ATOMIC_RELAXED, __HIP_MEMORY_SCOPE_AGENT);
    while (__hip_atomic_load(ctr, __ATOMIC_RELAXED, __HIP_MEMORY_SCOPE_AGENT) < epoch) __builtin_amdgcn_s_sleep(2);
    __builtin_amdgcn_fence(__ATOMIC_ACQUIRE, "agent");
    asm volatile("s_waitcnt vmcnt(0)" ::: "memory");
  }
  __syncthreads();
}

__global__ void __launch_bounds__(NTHREADS, 2) mega_kernel(Params P) {
  __shared__ __attribute__((aligned(1024))) char smem[163840];
  cg::grid_group grid = cg::this_grid();
  const int CT = P.NB * TSEQ;
  unsigned epoch = 0u;
  phase0(P, smem);
  grid.sync();
  for (int chunk = 0; chunk < P.nchunk; chunk++) {
    for (int layer = 0; layer < 4; layer++) {
      const float* xs = (layer == 0 ? P.x_in : P.out) + (size_t)chunk * CT * DM;
      norm_phase(xs, P.norm_g + layer * DM, P.h, CT);
      if (layer == 0 && chunk > 0) final_norm_phase(P.out, P.final_g, (chunk - 1) * CT, CT);
      grid_bar(P.ctr + 48, epoch);
      gemm1_phase(P, layer, smem);
      grid_bar(P.ctr + 48, epoch);
      pb_phase(P, layer, smem);
      grid_bar(P.ctr + 48, epoch);
      pc2_phase(P, layer, chunk, smem, (int*)(smem + 140000), 0);
      grid_bar(P.ctr + 48, epoch);
      pc1_phase(P, smem);
      grid_bar(P.ctr + 48, epoch);
      pc2_phase(P, layer, chunk, smem, (int*)(smem + 140000), 1);
      grid_bar(P.ctr + 48, epoch);
      gemm2_phase(P, layer, smem);
      grid_bar(P.ctr + 48, epoch);
      gemm3_phase(P, layer, chunk, smem);
      grid_bar(P.ctr + 48, epoch);
    }
  }
  final_norm_phase(P.out, P.final_g, (P.nchunk - 1) * CT, CT);
}

static inline size_t al256(size_t x) { return (x + 255) & ~(size_t)255; }

extern "C" void kernel_launch(void* const* d_in, const int* in_sizes, int n_in, void* d_out, int out_size,
                              void* d_ws, size_t ws_size, hipStream_t stream) {
  (void)in_sizes; (void)n_in; (void)out_size;
  Params P{};
  P.x_in = (const float*)d_in[0]; P.norm_g = (const float*)d_in[1]; P.w_in = (const float*)d_in[2];
  P.b_forget = (const float*)d_in[3];
  P.pe_k = (const float*)d_in[4]; P.w1_k = (const float*)d_in[5]; P.w2_k = (const float*)d_in[6];
  P.pe_v = (const float*)d_in[7]; P.w1_v = (const float*)d_in[8]; P.w2_v = (const float*)d_in[9];
  P.w_pa = (const float*)d_in[10]; P.w_pb = (const float*)d_in[11]; P.w_out = (const float*)d_in[12];
  P.final_g = (const float*)d_in[13];
  P.out = (float*)d_out;
  int NB = 16;
  char* base = (char*)d_ws;
  for (;;) {
    const size_t CT = (size_t)NB * TSEQ;
    size_t off = 0;
    auto take = [&](size_t bytes) { size_t o = off; off = al256(off + bytes); return o; };
    size_t oWin = take((size_t)4 * INCP * DM * 2), oWpa = take((size_t)4 * DM * DM * 2), oWpb = take((size_t)4 * DM * DM * 2),
           oWo = take((size_t)4 * DM * DM * 2), oW1 = take((size_t)8 * 128 * 2048 * 2), oW2 = take((size_t)8 * 64 * 128 * 2),
           oB1 = take((size_t)64 * 128 * 4), oRc = take((size_t)TSEQ * 32 * 4), oRs = take((size_t)TSEQ * 32 * 4),
           oH = take(CT * DM * 2), oProj = take(CT * INC * 2 + 4096), oVbt = take(CT * DM * 2),
           oVst = take(CT * 128 * 2), oVwt = take(CT * 128 * 2), oFl = take(CT * 16 * 4), oF2 = take(CT * 16 * 4),
           oKc = take((size_t)NB * 2 * 128 * 64 * 2), oVc = take((size_t)NB * 2 * 64 * 128 * 2), oSel = take(CT * 2 * 4),
           oYa = take(CT * DM * 2), oYb = take(CT * DM * 2), oCtr = take(256);
    if (off > ws_size && NB > 1) { NB >>= 1; continue; }
    P.WinT = (u16*)(base + oWin); P.WpaT = (u16*)(base + oWpa); P.WpbT = (u16*)(base + oWpb); P.WoT = (u16*)(base + oWo);
    P.W1T = (u16*)(base + oW1); P.W2T = (u16*)(base + oW2); P.bias1p = (float*)(base + oB1);
    P.ropec = (float*)(base + oRc); P.ropes = (float*)(base + oRs);
    P.h = (u16*)(base + oH); P.proj = (u16*)(base + oProj); P.qr = (u16*)(base + oVbt);
    P.vst = (u16*)(base + oVst); P.vwt = (u16*)(base + oVwt); P.flog = (float*)(base + oFl); P.F2 = (float*)(base + oF2);
    P.kcmp = (u16*)(base + oKc); P.vcmpt = (u16*)(base + oVc); P.sel = (unsigned*)(base + oSel);
    P.ya = (u16*)(base + oYa); P.yb = (u16*)(base + oYb); P.ctr = (unsigned*)(base + oCtr);
    break;
  }
  P.NB = NB; P.nchunk = 32 / NB;
  static int grid_blocks = 0;
  if (!grid_blocks) {
    int dev = 0, cus = 0, per_cu = 0;
    hipGetDevice(&dev);
    hipDeviceGetAttribute(&cus, hipDeviceAttributeMultiprocessorCount, dev);
    hipOccupancyMaxActiveBlocksPerMultiprocessor(&per_cu, mega_kernel, NTHREADS, 0);
    if (per_cu > 1) per_cu = 1;
    if (per_cu < 1) per_cu = 1;
    grid_blocks = cus * per_cu;
  }
  void* args[] = {&P};
  hipError_t e = hipLaunchCooperativeKernel((void*)mega_kernel, dim3(grid_blocks), dim3(NTHREADS), args, 0, stream);
  if (e != hipSuccess) fprintf(stderr, "cooperative launch failed: %s (grid %d)\n", hipGetErrorString(e), grid_blocks);
}
```

```cpp
#include <hip/hip_runtime.h>
#include <hip/hip_cooperative_groups.h>
#include <cstdio>
namespace cg = cooperative_groups;

typedef __attribute__((ext_vector_type(8))) __bf16 bf16x8;
typedef __attribute__((ext_vector_type(16))) float f32x16;
typedef __attribute__((ext_vector_type(4))) float f32x4;
typedef __attribute__((ext_vector_type(2))) float f32x2;
typedef unsigned short u16;

#define TSEQ 2048
#define DM 1024
#define INC 9024
#define INCP 9216
#define C_QA 0
#define C_KV 1024
#define C_GA 1792
#define C_ZA 1840
#define C_QB 2864
#define C_KB 3888
#define C_VB 4912
#define C_QR 4912
#define C_FB 5936
#define C_ZB 5952
#define C_RA 6976
#define C_RB 8000
#define NTHREADS 512
#define ATT_STAGE 33280
#define LOG2E 1.4426950408889634f

struct Params {
  const float* x_in; const float* norm_g; const float* w_in; const float* b_forget;
  const float* pe_k; const float* w1_k; const float* w2_k;
  const float* pe_v; const float* w1_v; const float* w2_v;
  const float* w_pa; const float* w_pb; const float* w_out; const float* final_g;
  float* out;
  u16* WinT; u16* WpaT; u16* WpbT; u16* WoT; u16* W1T; u16* W2T;
  float* bias1p; float* ropec; float* ropes;
  u16* h; u16* proj; u16* qr; u16* vst; u16* vwt;
  float* flog; float* F2; u16* kcmp; u16* vcmpt; unsigned* sel;
  u16* ya; u16* yb; unsigned* ctr;
  int NB; int nchunk;
};

__device__ __forceinline__ unsigned pk2(float a, float b) {
  typedef __attribute__((ext_vector_type(2))) float f2_t;
  typedef __attribute__((ext_vector_type(2))) __bf16 b2_t;
  f2_t v = {a, b};
  b2_t r = __builtin_convertvector(v, b2_t);
  return __builtin_bit_cast(unsigned, r);
}
__device__ __forceinline__ u16 f2bf(float a) { return (u16)(pk2(a, 0.f) & 0xffffu); }
__device__ __forceinline__ float bf2f(u16 u) { return __uint_as_float(((unsigned)u) << 16); }
__device__ __forceinline__ float bflo(unsigned u) { return __uint_as_float(u << 16); }
__device__ __forceinline__ float bfhi(unsigned u) { return __uint_as_float(u & 0xffff0000u); }
__device__ __forceinline__ float sigmoidf_(float x) { return 1.f / (1.f + __expf(-x)); }
__device__ __forceinline__ float siluf_(float x) { return x / (1.f + __expf(-x)); }
__device__ __forceinline__ f32x16 mfma32(bf16x8 a, bf16x8 b, f32x16 c) {
  return __builtin_amdgcn_mfma_f32_32x32x16_bf16(a, b, c, 0, 0, 0);
}
__device__ __forceinline__ int opaque_tid() { int t = threadIdx.x; asm volatile("" : "+v"(t)); return t; }
__device__ __forceinline__ bf16x8 ldfrag(const void* p) {
  return __builtin_bit_cast(bf16x8, *(const uint4*)p);
}

__device__ void transpose_tile(const float* __restrict__ src, u16* __restrict__ dst, int K, int N,
                               int k0, int n0, float* tile, const int tid) {
#pragma unroll
  for (int j = 0; j < 2; j++) {
    int r = (tid >> 4) + 32 * j, c4 = (tid & 15) * 4;
    float4 v = *(const float4*)(src + (size_t)(k0 + r) * N + n0 + c4);
    tile[r * 65 + c4] = v.x; tile[r * 65 + c4 + 1] = v.y; tile[r * 65 + c4 + 2] = v.z; tile[r * 65 + c4 + 3] = v.w;
  }
  __syncthreads();
  {
    int c = tid, n = c >> 3, kc = c & 7;
    const float* tp = tile + (kc * 8) * 65 + n;
    uint4 o;
    o.x = pk2(tp[0], tp[65]); o.y = pk2(tp[130], tp[195]); o.z = pk2(tp[260], tp[325]); o.w = pk2(tp[390], tp[455]);
    *(uint4*)(dst + (size_t)(n0 + n) * K + k0 + kc * 8) = o;
  }
  __syncthreads();
}

__device__ void phase0(const Params& P, char* smem) {
  const int tid = opaque_tid();
  float* tile = (float*)smem;
  const int n0_ = 4 * 16 * 141, n1_ = 4 * 16 * 16, n2_ = 4 * 32 * 2, n3_ = 4 * 2 * 1;
  const int nT = n0_ + 3 * n1_ + 2 * n2_ + 2 * n3_;
  const int nBias = 64, nRope = 128;
  const int total = nT + nBias + nRope + 1;
  for (int it = blockIdx.x; it < total; it += gridDim.x) {
    if (it < nT) {
      int t = it;
      if (t < n0_) {
        int l = t / (16 * 141), rem = t % (16 * 141);
        transpose_tile(P.w_in + (size_t)l * DM * INC, P.WinT + (size_t)l * INCP * DM, DM, INC, (rem / 141) * 64, (rem % 141) * 64, tile, tid);
        continue;
      }
      t -= n0_;
      if (t < 3 * n1_) {
        int which = t / n1_; t %= n1_;
        int l = t / 256, rem = t % 256;
        const float* s = which == 0 ? P.w_pa : (which == 1 ? P.w_pb : P.w_out);
        u16* d = which == 0 ? P.WpaT : (which == 1 ? P.WpbT : P.WoT);
        transpose_tile(s + (size_t)l * DM * DM, d + (size_t)l * DM * DM, DM, DM, (rem >> 4) * 64, (rem & 15) * 64, tile, tid);
        continue;
      }
      t -= 3 * n1_;
      if (t < 2 * n2_) {
        int kv = t / n2_; t %= n2_;
        int l = t / 64, rem = t % 64;
        const float* s = kv ? P.w1_v : P.w1_k;
        transpose_tile(s + (size_t)l * 2048 * 128, P.W1T + (size_t)(l * 2 + kv) * 128 * 2048, 2048, 128, (rem >> 1) * 64, (rem & 1) * 64, tile, tid);
        continue;
      }
      t -= 2 * n2_;
      {
        int kv = t / n3_; t %= n3_;
        int l = t / 2, rem = t % 2;
        const float* s = kv ? P.w2_v : P.w2_k;
        transpose_tile(s + (size_t)l * 128 * 64, P.W2T + (size_t)(l * 2 + kv) * 64 * 128, 128, 64, rem * 64, 0, tile, tid);
      }
    } else if (it < nT + nBias) {
      int j = it - nT;
      int l = j >> 4, kv = (j >> 3) & 1, kq = j & 7;
      const float* pe = (kv ? P.pe_v : P.pe_k) + (size_t)l * 2048;
      const float* w1 = (kv ? P.w1_v : P.w1_k) + (size_t)l * 2048 * 128;
      int hid = tid & 127, kh = tid >> 7;
      int kbeg = kq * 256 + kh * 64;
      float s = 0.f;
#pragma unroll 8
      for (int k = 0; k < 64; k++) s += pe[kbeg + k] * w1[(size_t)(kbeg + k) * 128 + hid];
      float* part = (float*)smem;
      part[tid] = s;
      __syncthreads();
      if (tid < 128) P.bias1p[((l * 2 + kv) * 8 + kq) * 128 + hid] = (part[tid] + part[tid + 128]) + (part[tid + 256] + part[tid + 384]);
      __syncthreads();
    } else if (it < nT + nBias + nRope) {
      int idx = (it - nT - nBias) * 512 + tid;
      int t = idx >> 5, j = idx & 31;
      double inv = 1.0;
      for (int q = 0; q < j; q++) inv *= 0.7498942093324558;
      float invf = (float)inv;
      float angf = (float)t * invf;
      double a = (double)angf;
      double kq = rint(a * 0.15915494309189535);
      double rr = a - kq * 6.283185307179586;
      double r2 = rr * rr;
      double sterm = rr, cterm = 1.0, ssum = rr, csum = 1.0;
#pragma unroll 1
      for (int n = 1; n <= 15; n++) {
        cterm *= -r2 / (double)((2 * n - 1) * (2 * n));
        sterm *= -r2 / (double)((2 * n) * (2 * n + 1));
        csum += cterm; ssum += sterm;
      }
      P.ropec[idx] = (float)csum;
      P.ropes[idx] = (float)ssum;
    } else {
      if (tid < 64) P.ctr[tid] = 0u;
    }
  }
}

__device__ void norm_phase(const float* __restrict__ xsrc, const float* __restrict__ g, u16* __restrict__ hdst, int nrows) {
  const int tid = opaque_tid();
  const int lane = tid & 63;
  const int gw = blockIdx.x * 8 + (tid >> 6), nw = gridDim.x * 8;
  float4 gv[4];
#pragma unroll
  for (int j = 0; j < 4; j++) gv[j] = *(const float4*)(g + lane * 4 + 256 * j);
  for (int row = gw; row < nrows; row += nw) {
    const float* xr = xsrc + (size_t)row * DM;
    float4 v[4];
    float ss = 0.f;
#pragma unroll
    for (int j = 0; j < 4; j++) {
      v[j] = *(const float4*)(xr + lane * 4 + 256 * j);
      ss += v[j].x * v[j].x + v[j].y * v[j].y + v[j].z * v[j].z + v[j].w * v[j].w;
    }
#pragma unroll
    for (int o = 32; o >= 1; o >>= 1) ss += __shfl_xor(ss, o);
    float rstd = rsqrtf(ss * (1.f / DM) + 1e-6f);
#pragma unroll
    for (int j = 0; j < 4; j++) {
      uint2 o;
      o.x = pk2(v[j].x * rstd * gv[j].x, v[j].y * rstd * gv[j].y);
      o.y = pk2(v[j].z * rstd * gv[j].z, v[j].w * rstd * gv[j].w);
      *(uint2*)(hdst + (size_t)row * DM + lane * 4 + 256 * j) = o;
    }
  }
}

__device__ void final_norm_phase(float* __restrict__ x, const float* __restrict__ g, int row0, int nrows) {
  const int tid = opaque_tid();
  const int lane = tid & 63;
  const int gw = blockIdx.x * 8 + (tid >> 6), nw = gridDim.x * 8;
  float4 gv[4];
#pragma unroll
  for (int j = 0; j < 4; j++) gv[j] = *(const float4*)(g + lane * 4 + 256 * j);
  for (int row = gw; row < nrows; row += nw) {
    float* xr = x + (size_t)(row0 + row) * DM;
    float4 v[4];
    float ss = 0.f;
#pragma unroll
    for (int j = 0; j < 4; j++) {
      v[j] = *(const float4*)(xr + lane * 4 + 256 * j);
      ss += v[j].x * v[j].x + v[j].y * v[j].y + v[j].z * v[j].z + v[j].w * v[j].w;
    }
#pragma unroll
    for (int o = 32; o >= 1; o >>= 1) ss += __shfl_xor(ss, o);
    float rstd = rsqrtf(ss * (1.f / DM) + 1e-6f);
#pragma unroll
    for (int j = 0; j < 4; j++) {
      float4 o;
      o.x = v[j].x * rstd * gv[j].x; o.y = v[j].y * rstd * gv[j].y;
      o.z = v[j].z * rstd * gv[j].z; o.w = v[j].w * rstd * gv[j].w;
      *(float4*)(xr + lane * 4 + 256 * j) = o;
    }
  }
}

struct ARow {
  const u16* p; int ld;
  __device__ __forceinline__ const u16* operator()(int row, int k) const { return p + (size_t)row * ld + k; }
};
struct ACmp {
  const u16* p;
  __device__ __forceinline__ const u16* operator()(int row, int k) const {
    int t = 16 * row + (k >> 6); t = t > (TSEQ - 1) ? (TSEQ - 1) : t;
    return p + (size_t)t * INC + (k & 63);
  }
};

template <class AF>
__device__ __forceinline__ void gemm_mainloop(AF af, const u16* __restrict__ Bt, int ldb, int K, char* smem,
                                              f32x16 (&acc)[2][2], const int tid) {
  const int lane = tid & 63, r = lane & 31, h = lane >> 5, w = tid >> 6;
  const int wm = w >> 1, wn = w & 1;
  const int lrow = tid >> 3, lch = tid & 7;
  uint4 ra[4], rb[4];
  const int nk = K >> 6;
#pragma unroll
  for (int j = 0; j < 4; j++) {
    int row = lrow + 32 * j;
    ra[j] = *(const uint4*)af(row, lch * 8);
    rb[j] = *(const uint4*)(Bt + (size_t)row * ldb + lch * 8);
  }
#pragma unroll
  for (int j = 0; j < 4; j++) {
    int row = lrow + 32 * j;
    int off = row * 128 + ((lch ^ ((row >> 1) & 7)) << 4);
    *(uint4*)(smem + off) = ra[j];
    *(uint4*)(smem + 16384 + off) = rb[j];
  }
  __syncthreads();
  for (int it = 0; it < nk; it++) {
    const bool more = (it + 1) < nk;
    if (more) {
      const int k0 = (it + 1) * 64;
#pragma unroll
      for (int j = 0; j < 4; j++) {
        int row = lrow + 32 * j;
        ra[j] = *(const uint4*)af(row, k0 + lch * 8);
        rb[j] = *(const uint4*)(Bt + (size_t)row * ldb + k0 + lch * 8);
      }
    }
    const char* sa = smem + (it & 1) * 32768;
    const char* sb = sa + 16384;
#pragma unroll
    for (int kk = 0; kk < 4; kk++) {
      bf16x8 a[2], b[2];
#pragma unroll
      for (int mi = 0; mi < 2; mi++) {
        int row = wm * 64 + mi * 32 + r;
        a[mi] = ldfrag(sa + row * 128 + (((kk * 2 + h) ^ ((row >> 1) & 7)) << 4));
      }
#pragma unroll
      for (int ni = 0; ni < 2; ni++) {
        int row = wn * 64 + ni * 32 + r;
        b[ni] = ldfrag(sb + row * 128 + (((kk * 2 + h) ^ ((row >> 1) & 7)) << 4));
      }
#pragma unroll
      for (int mi = 0; mi < 2; mi++)
#pragma unroll
        for (int ni = 0; ni < 2; ni++) acc[mi][ni] = mfma32(a[mi], b[ni], acc[mi][ni]);
    }
    if (more) {
      char* sd = smem + ((it + 1) & 1) * 32768;
#pragma unroll
      for (int j = 0; j < 4; j++) {
        int row = lrow + 32 * j;
        int off = row * 128 + ((lch ^ ((row >> 1) & 7)) << 4);
        *(uint4*)(sd + off) = ra[j];
        *(uint4*)(sd + 16384 + off) = rb[j];
      }
    }
    __syncthreads();
  }
}

__device__ __forceinline__ void zero_acc(f32x16 (&acc)[2][2]) {
#pragma unroll
  for (int a = 0; a < 2; a++)
#pragma unroll
    for (int b = 0; b < 2; b++)
#pragma unroll
      for (int i = 0; i < 16; i++) acc[a][b][i] = 0.f;
}

typedef __attribute__((ext_vector_type(8))) short s16x8;
#define G_TILE_B 32768
#define G_STAGE_B 65536
__device__ __forceinline__ int g_lds_byte(int r, int c) {
  int st = (r >> 4) * 2 + (c >> 5), ob = (r & 15) * 64 + (c & 31) * 2;
  return st * 1024 + (ob ^ (((ob >> 9) & 1) << 5));
}
__device__ __forceinline__ void g_stage_rc(int b, int& R, int& C) {
  int st = b >> 10, sb = b & 1023, swz = sb ^ (((sb >> 9) & 1) << 5);
  R = (st >> 1) * 16 + swz / 64;
  C = (st & 1) * 32 + (swz % 64) / 2;
}
#define G_WAIT_V0() asm volatile("s_waitcnt vmcnt(0)" ::: "memory")

struct GTile { int pm, pn; };
__device__ __forceinline__ bool g_next(int i, int G, int c, int nM, int nN, GTile& u) {
  const int nwg = nM * nN;
  const int L = i * G + c;
  if (L >= nwg) return false;
  int wgid = L;
  { const int q = nwg / 8, r = nwg % 8, xcd = wgid % 8, off = wgid / 8; wgid = (xcd < r ? xcd * (q + 1) : r * (q + 1) + (xcd - r) * q) + off; }
  const int nig = 8 * nN, gid = wgid / nig, fm = gid * 8, gsz = (nM - fm) < 8 ? (nM - fm) : 8;
  u.pm = fm + ((wgid % nig) % gsz);
  u.pn = (wgid % nig) / gsz;
  return true;
}

__device__ __forceinline__ void g_kloop(const u16* __restrict__ Ab, const u16* __restrict__ Bb, const int K, char* smem,
                                        f32x4 (&acc)[8][4], const int tid, const bool pre, const u16* __restrict__ nA,
                                        const u16* __restrict__ nB, const bool has_next) {
  const int wid = tid >> 6, lane = tid & 63, wr = wid >> 2, wc = wid & 3, fr = lane & 15, fq = lane >> 4;
  int sR0, sC0, sR1, sC1, sR2, sC2, sR3, sC3;
  g_stage_rc(wid * 1024 + 0 * 8192 + lane * 16, sR0, sC0);
  g_stage_rc(wid * 1024 + 1 * 8192 + lane * 16, sR1, sC1);
  g_stage_rc(wid * 1024 + 2 * 8192 + lane * 16, sR2, sC2);
  g_stage_rc(wid * 1024 + 3 * 8192 + lane * 16, sR3, sC3);
  const long o0 = (long)sR0 * K + sC0, o1 = (long)sR1 * K + sC1, o2 = (long)sR2 * K + sC2, o3 = (long)sR3 * K + sC3;
#define G_STAGE(buf, kt)                                                                                              \
  {                                                                                                                  \
    char* sa_ = smem + (buf) * G_STAGE_B + wid * 1024;                                                               \
    char* sb_ = sa_ + G_TILE_B;                                                                                      \
    const u16* ga_ = Ab + (kt) * 64;                                                                                 \
    const u16* gb_ = Bb + (kt) * 64;                                                                                 \
    __builtin_amdgcn_global_load_lds((const unsigned*)(ga_ + o0), (unsigned*)(sa_), 16, 0, 0);                       \
    __builtin_amdgcn_global_load_lds((const unsigned*)(gb_ + o0), (unsigned*)(sb_), 16, 0, 0);                       \
    __builtin_amdgcn_global_load_lds((const unsigned*)(ga_ + o1), (unsigned*)(sa_ + 8192), 16, 0, 0);                \
    __builtin_amdgcn_global_load_lds((const unsigned*)(gb_ + o1), (unsigned*)(sb_ + 8192), 16, 0, 0);                \
    __builtin_amdgcn_global_load_lds((const unsigned*)(ga_ + o2), (unsigned*)(sa_ + 16384), 16, 0, 0);               \
    __builtin_amdgcn_global_load_lds((const unsigned*)(gb_ + o2), (unsigned*)(sb_ + 16384), 16, 0, 0);               \
    __builtin_amdgcn_global_load_lds((const unsigned*)(ga_ + o3), (unsigned*)(sa_ + 24576), 16, 0, 0);               \
    __builtin_amdgcn_global_load_lds((const unsigned*)(gb_ + o3), (unsigned*)(sb_ + 24576), 16, 0, 0);               \
  }
  const int nt = K >> 6;
  if (!pre) {
    G_STAGE(0, 0);
    G_WAIT_V0();
    __syncthreads();
  }
  for (int t = 0; t < nt; ++t) {
    const int cur = t & 1;
    if (t + 1 < nt) G_STAGE(cur ^ 1, t + 1)
    else if (has_next) {
      char* sa_ = smem + wid * 1024;
      char* sb_ = sa_ + G_TILE_B;
      __builtin_amdgcn_global_load_lds((const unsigned*)(nA + o0), (unsigned*)(sa_), 16, 0, 0);
      __builtin_amdgcn_global_load_lds((const unsigned*)(nB + o0), (unsigned*)(sb_), 16, 0, 0);
      __builtin_amdgcn_global_load_lds((const unsigned*)(nA + o1), (unsigned*)(sa_ + 8192), 16, 0, 0);
      __builtin_amdgcn_global_load_lds((const unsigned*)(nB + o1), (unsigned*)(sb_ + 8192), 16, 0, 0);
      __builtin_amdgcn_global_load_lds((const unsigned*)(nA + o2), (unsigned*)(sa_ + 16384), 16, 0, 0);
      __builtin_amdgcn_global_load_lds((const unsigned*)(nB + o2), (unsigned*)(sb_ + 16384), 16, 0, 0);
      __builtin_amdgcn_global_load_lds((const unsigned*)(nA + o3), (unsigned*)(sa_ + 24576), 16, 0, 0);
      __builtin_amdgcn_global_load_lds((const unsigned*)(nB + o3), (unsigned*)(sb_ + 24576), 16, 0, 0);
    }
    const char* sa = smem + cur * G_STAGE_B;
    const char* sb = sa + G_TILE_B;
#pragma unroll
    for (int ks = 0; ks < 2; ++ks) {
      s16x8 At[8], Bf[4];
#pragma unroll
      for (int m = 0; m < 8; ++m) At[m] = *(const s16x8*)(sa + g_lds_byte(wr * 128 + m * 16 + fr, ks * 32 + fq * 8));
#pragma unroll
      for (int n = 0; n < 4; ++n) Bf[n] = *(const s16x8*)(sb + g_lds_byte(wc * 64 + n * 16 + fr, ks * 32 + fq * 8));
#pragma unroll
      for (int m = 0; m < 8; ++m)
#pragma unroll
        for (int n = 0; n < 4; ++n)
          acc[m][n] = __builtin_amdgcn_mfma_f32_16x16x32_bf16(__builtin_bit_cast(bf16x8, Bf[n]), __builtin_bit_cast(bf16x8, At[m]), acc[m][n], 0, 0, 0);
      __builtin_amdgcn_sched_barrier(0);
    }
    G_WAIT_V0();
    __syncthreads();
  }
}

__device__ __forceinline__ void g_zero(f32x4 (&acc)[8][4]) {
#pragma unroll
  for (int m = 0; m < 8; m++)
#pragma unroll
    for (int n = 0; n < 4; n++) acc[m][n] = (f32x4){0.f, 0.f, 0.f, 0.f};
}
__device__ __forceinline__ uint2 pk4(f32x4 v) { return make_uint2(pk2(v[0], v[1]), pk2(v[2], v[3])); }

__device__ __forceinline__ void wave_store_rows(char* wsm, u16* gbase, const size_t ld, const f32x4 (&acc)[8][4], const int lane) {
  const int fr = lane & 15, fq = lane >> 4;
  const int rr = lane >> 3, ch = lane & 7;
  typedef __attribute__((ext_vector_type(4))) unsigned u32x4_t;
#pragma unroll
  for (int hf = 0; hf < 2; hf++) {
#pragma unroll
    for (int m = 0; m < 4; m++)
#pragma unroll
      for (int n = 0; n < 4; n++) {
        const int row = m * 16 + fr, chunk = n * 2 + (fq >> 1);
        *(uint2*)(wsm + row * 128 + ((chunk ^ (fr & 7)) << 4) + (fq & 1) * 8) = pk4(acc[hf * 4 + m][n]);
      }
#pragma unroll
    for (int i = 0; i < 8; i++) {
      const int row = i * 8 + rr;
      const uint4 v = *(const uint4*)(wsm + row * 128 + ((ch ^ (row & 7)) << 4));
      __builtin_nontemporal_store(__builtin_bit_cast(u32x4_t, v), (u32x4_t*)(gbase + (size_t)(hf * 64 + row) * ld + ch * 8));
    }
  }
}
__device__ __forceinline__ void wave_store_cols(char* wsm, u16* vt, const int vcol0, const int nh, const int bl, const int t0,
                                                const f32x4 (&acc)[8][4], const int lane) {
  const int fr = lane & 15, fq = lane >> 4;
#pragma unroll
  for (int m = 0; m < 8; m++)
#pragma unroll
    for (int n = 0; n < 4; n++)
#pragma unroll
      for (int j = 0; j < 4; j++) {
        const int d = n * 16 + fq * 4 + j, t = m * 16 + fr;
        *(u16*)(wsm + d * 256 + (((t >> 3) ^ (d & 15)) << 4) + (t & 7) * 2) = f2bf(acc[m][n][j]);
      }
  const int dd = lane >> 4, ch = lane & 15;
#pragma unroll
  for (int i = 0; i < 16; i++) {
    const int d = i * 4 + dd;
    const uint4 v = *(const uint4*)(wsm + d * 256 + ((ch ^ (d & 15)) << 4));
    const int vcol = vcol0 + d;
    *(uint4*)(vt + ((size_t)(bl * nh + (vcol >> 6)) * 64 + (vcol & 63)) * TSEQ + t0 + ch * 8) = v;
  }
}

__device__ void gemm1_phase(const Params& P, int layer, char* smem) {
  const int CT = P.NB * TSEQ;
  const int nM = CT >> 8, nN = INCP >> 8;
  const u16* Bt = P.WinT + (size_t)layer * INCP * DM;
  u16* p_qr = P.qr; u16* p_proj = P.proj;
  asm volatile("" : "+s"(p_qr), "+s"(p_proj));
  for (int i = 0;; i++) {
    GTile u, un;
    if (!g_next(i, gridDim.x, blockIdx.x, nM, nN, u)) break;
    const bool hn = g_next(i + 1, gridDim.x, blockIdx.x, nM, nN, un);
    const int tid = opaque_tid(), wid = tid >> 6, lane = tid & 63, wr = wid >> 2, wc = wid & 3, fr = lane & 15, fq = lane >> 4;
    f32x4 acc[8][4];
    g_zero(acc);
    g_kloop(P.h + (size_t)(u.pm * 256) * DM, Bt + (size_t)(u.pn * 256) * DM, DM, smem, acc, tid, i > 0,
            P.h + (size_t)(un.pm * 256) * DM, Bt + (size_t)(un.pn * 256) * DM, hn);
    const int cw = u.pn * 256 + wc * 64;
    const int row0 = u.pm * 256 + wr * 128 + fr;
    char* wsm = smem + G_STAGE_B + wid * 8192;
    const int rowb = u.pm * 256 + wr * 128;
    const bool rope_q = cw < 1024;
    const bool rope_k = (cw >= C_KV + 256 && cw < C_KV + 384) || (cw >= C_KV + 512 && cw < C_KV + 640);
    const bool mixed = (cw == 5888);
    if (cw >= INC) {
    } else if (rope_q || rope_k) {
      if (rope_q) wave_store_rows(wsm, p_proj + (size_t)rowb * INC + cw, INC, acc, lane);
#pragma unroll
      for (int m = 0; m < 8; m++) {
        const int tt = (row0 + m * 16) & (TSEQ - 1);
#pragma unroll
        for (int n = 0; n < 2; n++) {
          const float4 c = *(const float4*)(P.ropec + tt * 32 + n * 16 + fq * 4);
          const float4 sn = *(const float4*)(P.ropes + tt * 32 + n * 16 + fq * 4);
          const f32x4 x1 = acc[m][n], x2 = acc[m][n + 2];
          f32x4 r1, r2;
          r1[0] = x1[0] * c.x - x2[0] * sn.x; r2[0] = x2[0] * c.x + x1[0] * sn.x;
          r1[1] = x1[1] * c.y - x2[1] * sn.y; r2[1] = x2[1] * c.y + x1[1] * sn.y;
          r1[2] = x1[2] * c.z - x2[2] * sn.z; r2[2] = x2[2] * c.z + x1[2] * sn.z;
          r1[3] = x1[3] * c.w - x2[3] * sn.w; r2[3] = x2[3] * c.w + x1[3] * sn.w;
          acc[m][n] = r1; acc[m][n + 2] = r2;
        }
      }
      if (rope_q) wave_store_rows(wsm, p_qr + (size_t)rowb * DM + cw, DM, acc, lane);
      else wave_store_rows(wsm, p_proj + (size_t)rowb * INC + cw, INC, acc, lane);
    } else if (!mixed) {
      wave_store_rows(wsm, p_proj + (size_t)rowb * INC + cw, INC, acc, lane);
    } else {
#pragma unroll
      for (int n = 0; n < 4; n++) {
        const int c0 = cw + n * 16 + fq * 4;
        if (c0 < C_FB) {
#pragma unroll
          for (int m = 0; m < 8; m++) *(uint2*)(p_proj + (size_t)(row0 + m * 16) * INC + c0) = pk4(acc[m][n]);
        } else {
#pragma unroll
          for (int m = 0; m < 8; m++)
            *(float4*)(P.flog + (size_t)(row0 + m * 16) * 16 + (c0 - C_FB)) = make_float4(acc[m][n][0], acc[m][n][1], acc[m][n][2], acc[m][n][3]);
        }
        __builtin_amdgcn_sched_barrier(0);
      }
    }
    __syncthreads();
  }
}

__device__ void gemm2_phase(const Params& P, int layer, char* smem) {
  const int CT = P.NB * TSEQ;
  const int nM = CT >> 8, nN = 4;
  const u16* p_ya = P.ya; const u16* p_yb = P.yb; const u16* p_wa = P.WpaT; const u16* p_wb = P.WpbT;
  for (int i = 0;; i++) {
    GTile u, un;
    if (!g_next(i, gridDim.x, blockIdx.x, nM, nN, u)) break;
    const bool hn = g_next(i + 1, gridDim.x, blockIdx.x, nM, nN, un);
    const int tid = opaque_tid(), wid = tid >> 6, lane = tid & 63, wr = wid >> 2, wc = wid & 3, fr = lane & 15, fq = lane >> 4;
    f32x4 acc[8][4];
    g_zero(acc);
#pragma unroll 1
    for (int pass = 0; pass < 2; pass++) {
      const u16* Ap = (pass ? p_yb : p_ya) + (size_t)(u.pm * 256) * DM;
      const u16* Bp = (pass ? p_wb : p_wa) + (size_t)layer * DM * DM + (size_t)(u.pn * 256) * DM;
      const u16* nAp = pass ? (p_ya + (size_t)(un.pm * 256) * DM) : (p_yb + (size_t)(u.pm * 256) * DM);
      const u16* nBp = pass ? (p_wa + (size_t)layer * DM * DM + (size_t)(un.pn * 256) * DM) : (p_wb + (size_t)layer * DM * DM + (size_t)(u.pn * 256) * DM);
      g_kloop(Ap, Bp, DM, smem, acc, tid, (i > 0) || (pass > 0), nAp, nBp, pass ? hn : true);
      __builtin_amdgcn_sched_barrier(0);
      if (pass == 0) {
        const int tid1 = opaque_tid(), wid1 = tid1 >> 6, lane1 = tid1 & 63, wr1 = wid1 >> 2, wc1 = wid1 & 3, fr1 = lane1 & 15, fq1 = lane1 >> 4;
        const u16* pp = P.proj + (size_t)(u.pm * 256 + wr1 * 128 + fr1) * INC + u.pn * 256 + wc1 * 64 + fq1 * 4;
#pragma unroll
        for (int m = 0; m < 8; m++) {
#pragma unroll
          for (int n = 0; n < 4; n++) {
            const uint2 ra = *(const uint2*)(pp + (size_t)(m * 16) * INC + C_RA + n * 16);
            const uint2 rb = *(const uint2*)(pp + (size_t)(m * 16) * INC + C_RB + n * 16);
            acc[m][n][0] *= (1.f + __expf(-bflo(rb.x))) / (1.f + __expf(-bflo(ra.x)));
            acc[m][n][1] *= (1.f + __expf(-bfhi(rb.x))) / (1.f + __expf(-bfhi(ra.x)));
            acc[m][n][2] *= (1.f + __expf(-bflo(rb.y))) / (1.f + __expf(-bflo(ra.y)));
            acc[m][n][3] *= (1.f + __expf(-bfhi(rb.y))) / (1.f + __expf(-bfhi(ra.y)));
          }
          __builtin_amdgcn_sched_barrier(0);
        }
      }
    }
    {
      const int tid2 = opaque_tid(), wid2 = tid2 >> 6, lane2 = tid2 & 63, wr2 = wid2 >> 2, wc2 = wid2 & 3, fr2 = lane2 & 15, fq2 = lane2 >> 4;
      const u16* pp = P.proj + (size_t)(u.pm * 256 + wr2 * 128 + fr2) * INC + u.pn * 256 + wc2 * 64 + fq2 * 4;
#pragma unroll
      for (int m = 0; m < 8; m++) {
#pragma unroll
        for (int n = 0; n < 4; n++) {
          const uint2 rb = *(const uint2*)(pp + (size_t)(m * 16) * INC + C_RB + n * 16);
          acc[m][n][0] *= sigmoidf_(bflo(rb.x)); acc[m][n][1] *= sigmoidf_(bfhi(rb.x));
          acc[m][n][2] *= sigmoidf_(bflo(rb.y)); acc[m][n][3] *= sigmoidf_(bfhi(rb.y));
        }
        __builtin_amdgcn_sched_barrier(0);
      }
      wave_store_rows(smem + G_STAGE_B + wid2 * 8192, P.h + (size_t)(u.pm * 256 + wr2 * 128) * DM + u.pn * 256 + wc2 * 64, DM, acc, lane2);
    }
    __syncthreads();
  }
}

__device__ void gemm3_phase(const Params& P, int layer, int chunk, char* smem) {
  const int CT = P.NB * TSEQ;
  const int nM = CT >> 8, nN = 4;
  const float* xs = (layer == 0 ? P.x_in : P.out) + (size_t)chunk * CT * DM;
  float* xd = P.out + (size_t)chunk * CT * DM;
  for (int i = 0;; i++) {
    GTile u, un;
    if (!g_next(i, gridDim.x, blockIdx.x, nM, nN, u)) break;
    const bool hn = g_next(i + 1, gridDim.x, blockIdx.x, nM, nN, un);
    const int tid = opaque_tid(), wid = tid >> 6, lane = tid & 63, wr = wid >> 2, wc = wid & 3, fr = lane & 15, fq = lane >> 4;
    f32x4 acc[8][4];
    g_zero(acc);
    g_kloop(P.h + (size_t)(u.pm * 256) * DM, P.WoT + (size_t)layer * DM * DM + (size_t)(u.pn * 256) * DM, DM, smem, acc, tid, i > 0,
            P.h + (size_t)(un.pm * 256) * DM, P.WoT + (size_t)layer * DM * DM + (size_t)(un.pn * 256) * DM, hn);
    const size_t off = (size_t)(u.pm * 256 + wr * 128 + fr) * DM + u.pn * 256 + wc * 64 + fq * 4;
#pragma unroll
    for (int m = 0; m < 8; m++) {
#pragma unroll
      for (int n = 0; n < 4; n++) {
        const float4 xo = *(const float4*)(xs + off + (size_t)(m * 16) * DM + n * 16);
        *(float4*)(xd + off + (size_t)(m * 16) * DM + n * 16) =
            make_float4(xo.x + acc[m][n][0], xo.y + acc[m][n][1], xo.z + acc[m][n][2], xo.w + acc[m][n][3]);
      }
      __builtin_amdgcn_sched_barrier(0);
    }
  }
}

__device__ __forceinline__ void compress_item(const Params& P, const int layer, const int it, char* smem_all, const int tid_all) {
  const int half = tid_all >> 8, tid = tid_all & 255;
  char* smem = smem_all + half * 65536;
  const int lane = tid & 63, r = lane & 31, h = lane >> 5, w = tid >> 6;
  const int wm = w >> 1, wn = w & 1;
  const int unit = it * 2 + half;
  const int bl = unit >> 2, g = (unit >> 1) & 1, kv = unit & 1;
  f32x16 acc[2][2];
  zero_acc(acc);
  ACmp af{P.proj + (size_t)bl * TSEQ * INC + C_KV + kv * 128 + g * 64};
  gemm_mainloop(af, P.W1T + (size_t)(layer * 2 + kv) * 128 * 2048, 2048, 2048, smem, acc, tid);
  const float* bp = P.bias1p + (size_t)((layer * 2 + kv) * 8) * 128;
#pragma unroll
  for (int ni = 0; ni < 2; ni++) {
    int hc = wn * 64 + ni * 32 + r;
    float b1 = 0.f;
#pragma unroll
    for (int q = 0; q < 8; q++) b1 += bp[q * 128 + hc];
#pragma unroll
    for (int mi = 0; mi < 2; mi++)
#pragma unroll
      for (int i = 0; i < 16; i++) {
        int n = wm * 64 + mi * 32 + 8 * (i >> 2) + 4 * h + (i & 3);
        float v = siluf_(acc[mi][ni][i] + b1);
        *(u16*)(smem + n * 256 + (((hc >> 3) ^ (n & 15)) << 4) + (hc & 7) * 2) = f2bf(v);
      }
  }
  __syncthreads();
  const u16* w2t = P.W2T + (size_t)(layer * 2 + kv) * 64 * 128;
  f32x16 o2[2];
#pragma unroll
  for (int dt = 0; dt < 2; dt++)
#pragma unroll
    for (int i = 0; i < 16; i++) o2[dt][i] = 0.f;
#pragma unroll
  for (int kk = 0; kk < 8; kk++) {
    int n = w * 32 + r;
    bf16x8 a = ldfrag(smem + n * 256 + (((kk * 2 + h) ^ (n & 15)) << 4));
#pragma unroll
    for (int dt = 0; dt < 2; dt++) {
      bf16x8 b = ldfrag(w2t + (size_t)(dt * 32 + r) * 128 + kk * 16 + h * 8);
      o2[dt] = mfma32(a, b, o2[dt]);
    }
  }
#pragma unroll
  for (int dt = 0; dt < 2; dt++) {
    int d = dt * 32 + r;
    if (kv == 0) {
#pragma unroll
      for (int i = 0; i < 16; i++) {
        int n = w * 32 + 8 * (i >> 2) + 4 * h + (i & 3);
        P.kcmp[((size_t)(bl * 2 + g) * 128 + n) * 64 + d] = f2bf(o2[dt][i]);
      }
    } else {
#pragma unroll
      for (int gq = 0; gq < 4; gq++) {
        int n0 = w * 32 + 8 * gq + 4 * h;
        uint2 o;
        o.x = pk2(o2[dt][gq * 4 + 0], o2[dt][gq * 4 + 1]);
        o.y = pk2(o2[dt][gq * 4 + 2], o2[dt][gq * 4 + 3]);
        *(uint2*)(P.vcmpt + ((size_t)(bl * 2 + g) * 64 + d) * 128 + n0) = o;
      }
    }
  }
  __syncthreads();
}

__device__ void pb_phase(const Params& P, int layer, char* smem_all) {
  const int tid = opaque_tid();
  const int lane = tid & 63, w = tid >> 6;
  float* wsum = (float*)smem_all;
  const int nScan = P.NB * 16;
  for (int it = blockIdx.x; it < nScan; it += gridDim.x) {
    const int bl = it >> 4, hh = it & 15;
    const float bf = P.b_forget[layer * 16 + hh];
    const float* fl = P.flog + ((size_t)bl * TSEQ + tid * 4) * 16 + hh;
    float ls[4];
#pragma unroll
    for (int j = 0; j < 4; j++) {
      const float x = fl[j * 16] + bf;
      ls[j] = (x >= 0.f) ? -log1pf(__expf(-x)) : (x - log1pf(__expf(x)));
    }
    const float loc = (ls[0] + ls[1]) + (ls[2] + ls[3]);
    float incl = loc;
#pragma unroll
    for (int o = 1; o < 64; o <<= 1) {
      const float v = __shfl_up(incl, o);
      if (lane >= o) incl += v;
    }
    __syncthreads();
    if (lane == 63) wsum[w] = incl;
    __syncthreads();
    float base = 0.f;
#pragma unroll
    for (int q = 0; q < 8; q++) base += (q < w) ? wsum[q] : 0.f;
    float run = base + incl - loc;
    float4 o4;
    run += ls[0]; o4.x = -8.0f * run;
    run += ls[1]; o4.y = -8.0f * run;
    run += ls[2]; o4.z = -8.0f * run;
    run += ls[3]; o4.w = -8.0f * run;
    *(float4*)(P.F2 + ((size_t)bl * 16 + hh) * TSEQ + tid * 4) = o4;
  }
}

__device__ void pc1_phase(const Params& P, char* smem) {
  const int tid = opaque_tid(),  lane = tid & 63, r = lane & 31, h = lane >> 5, w = tid >> 6;
  const int nItems = P.NB * 2 * 8;
  const float c1 = 0.125f * LOG2E;
  for (int it = blockIdx.x; it < nItems; it += gridDim.x) {
    const int qt = it & 7, g = (it >> 3) & 1, bl = it >> 4;
    __syncthreads();
#pragma unroll
    for (int j = 0; j < 2; j++) {
      int c = tid + 512 * j;
      {
        int n = c >> 3, ch = c & 7;
        uint4 v = *(const uint4*)(P.kcmp + ((size_t)(bl * 2 + g) * 128 + n) * 64 + ch * 8);
        *(uint4*)(smem + n * 128 + ((ch ^ ((n >> 1) & 7)) << 4)) = v;
      }
      {
        int d = c >> 4, ch = c & 15;
        uint4 v = *(const uint4*)(P.vcmpt + ((size_t)(bl * 2 + g) * 64 + d) * 128 + ch * 8);
        int sw = d & 31;
        *(uint2*)(smem + 16384 + d * 256 + (((2 * ch) ^ sw) << 3)) = make_uint2(v.x, v.y);
        *(uint2*)(smem + 16384 + d * 256 + (((2 * ch + 1) ^ sw) << 3)) = make_uint2(v.z, v.w);
      }
    }
    __syncthreads();
    const int qw_lo = qt * 256 + w * 32;
    const int qtok = qw_lo + r;
    const size_t rowg = (size_t)bl * TSEQ + qtok;
    const int tq = qtok - 31 - 64 * h;
    float sumacc[16], lastacc[16];
#pragma unroll
    for (int s = 0; s < 16; s++) { sumacc[s] = 0.f; lastacc[s] = 0.f; }
#pragma unroll 1
    for (int hh = 0; hh < 8; hh++) {
      const int head = g * 8 + hh;
      bf16x8 qf[4];
#pragma unroll
      for (int kk = 0; kk < 4; kk++) qf[kk] = ldfrag(P.proj + rowg * INC + C_QA + head * 64 + kk * 16 + h * 8);
      f32x16 s[4];
#pragma unroll
      for (int nt = 0; nt < 4; nt++) {
#pragma unroll
        for (int i = 0; i < 16; i++) s[nt][i] = 0.f;
#pragma unroll
        for (int kk = 0; kk < 4; kk++) {
          int row = nt * 32 + r;
          bf16x8 a = ldfrag(smem + row * 128 + (((kk * 2 + h) ^ ((row >> 1) & 7)) << 4));
          s[nt] = mfma32(a, qf[kk], s[nt]);
        }
        __builtin_amdgcn_sched_barrier(0);
      }
      float mx = -3.0e38f;
#pragma unroll
      for (int nt = 0; nt < 4; nt++)
#pragma unroll
        for (int i = 0; i < 16; i++) {
          bool ok = (16 * (nt * 32 + 8 * (i >> 2) + (i & 3))) <= tq;
          float v = ok ? s[nt][i] * c1 : -3.0e38f;
          s[nt][i] = v;
          mx = fmaxf(mx, v);
        }
      mx = fmaxf(mx, __shfl_xor(mx, 32));
      const bool anyv = mx > -1.0e37f;
      float mref = anyv ? mx : 0.f;
      float l = 0.f;
#pragma unroll
      for (int nt = 0; nt < 4; nt++)
#pragma unroll
        for (int i = 0; i < 16; i++) {
          float p = __builtin_amdgcn_exp2f(s[nt][i] - mref);
          s[nt][i] = p;
          l += p;
        }
      l += __shfl_xor(l, 32);
      const float inv = (anyv && l > 0.f) ? 1.f / l : 0.f;
#pragma unroll
      for (int nt = 0; nt < 4; nt++)
#pragma unroll
        for (int i = 0; i < 16; i++) s[nt][i] *= inv;
#pragma unroll
      for (int nt = 0; nt < 4; nt++)
#pragma unroll
        for (int gq = 0; gq < 4; gq++) {
          sumacc[nt * 4 + gq] += (s[nt][gq * 4] + s[nt][gq * 4 + 1]) + (s[nt][gq * 4 + 2] + s[nt][gq * 4 + 3]);
          lastacc[nt * 4 + gq] += s[nt][gq * 4 + 3];
        }
      uint4 pbv[8];
#pragma unroll
      for (int ks = 0; ks < 8; ks++) {
        const int nt = ks >> 1, hb = (ks & 1) * 8;
        pbv[ks].x = pk2(s[nt][hb + 0], s[nt][hb + 1]); pbv[ks].y = pk2(s[nt][hb + 2], s[nt][hb + 3]);
        pbv[ks].z = pk2(s[nt][hb + 4], s[nt][hb + 5]); pbv[ks].w = pk2(s[nt][hb + 6], s[nt][hb + 7]);
      }
      const float g0 = sigmoidf_(bf2f(P.proj[rowg * INC + C_GA + head]));
#pragma unroll
      for (int dt = 0; dt < 2; dt++) {
        f32x16 o;
#pragma unroll
        for (int i = 0; i < 16; i++) o[i] = 0.f;
        const int d = dt * 32 + r, sw = d & 31;
#pragma unroll
        for (int ks = 0; ks < 8; ks++) {
          uint2 lo = *(const uint2*)(smem + 16384 + d * 256 + (((ks * 4 + h) ^ sw) << 3));
          uint2 hi = *(const uint2*)(smem + 16384 + d * 256 + (((ks * 4 + 2 + h) ^ sw) << 3));
          uint4 au = make_uint4(lo.x, lo.y, hi.x, hi.y);
          o = mfma32(__builtin_bit_cast(bf16x8, au), __builtin_bit_cast(bf16x8, pbv[ks]), o);
        }
#pragma unroll
        for (int gq = 0; gq < 4; gq++) {
          int d0 = dt * 32 + 8 * gq + 4 * h;
          uint2 ov;
          ov.x = pk2(o[gq * 4 + 0] * g0, o[gq * 4 + 1] * g0);
          ov.y = pk2(o[gq * 4 + 2] * g0, o[gq * 4 + 3] * g0);
          *(uint2*)(P.ya + rowg * DM + head * 64 + d0) = ov;
        }
        __builtin_amdgcn_sched_barrier(0);
      }
    }
    float sc[16];
#pragma unroll
    for (int s = 0; s < 16; s++) {
      float prev = (s == 0) ? 0.f : lastacc[s - 1];
      float sendv = h ? prev : lastacc[s];
      float recv = __shfl_xor(sendv, 32);
      float imp = sumacc[s] + recv;
      int j = (s >> 2) * 8 + (s & 3) * 2 + h;
      int cur = qtok >> 6;
      bool forced = (j == 0) || (j == cur) || (j == cur - 1);
      bool valid = j <= cur;
      sc[s] = forced ? 1.0e4f : (valid ? imp : -1.0f);
    }
    unsigned mask = 0u;
#pragma unroll 1
    for (int rd = 0; rd < 8; rd++) {
      float best = -2.0f; int bj = 0;
#pragma unroll
      for (int s = 0; s < 16; s++) {
        int j = (s >> 2) * 8 + (s & 3) * 2 + h;
        if (sc[s] > best) { best = sc[s]; bj = j; }
      }
      float ob = __shfl_xor(best, 32);
      int oj = __shfl_xor(bj, 32);
      bool mine = (best > ob) || (best == ob && bj < oj);
      int wj = mine ? bj : oj;
      mask |= 1u << wj;
#pragma unroll
      for (int s = 0; s < 16; s++) {
        int j = (s >> 2) * 8 + (s & 3) * 2 + h;
        if (j == wj) sc[s] = -3.0f;
      }
    }
    if (h == 0) P.sel[(size_t)(bl * 2 + g) * TSEQ + qtok] = mask;
  }
}

#define A_SLOTB 8192
#define A_LDS_K 0
#define A_LDS_V 24576
#define A_LDS_WS 49152
#define A_LDS_F 51200
#define A_LDS_OST 52224
#define A_THR 8.0f
#define A_C2 (0.125f * LOG2E)
typedef __attribute__((ext_vector_type(4))) short a_s16x4;
typedef __attribute__((ext_vector_type(8))) short a_s16x8;
typedef __attribute__((ext_vector_type(4))) unsigned a_u32x4;
typedef __attribute__((address_space(3))) const char* a_lds_cptr;
typedef short a_v4i16 __attribute__((ext_vector_type(4)));
#define A_SBAR() __builtin_amdgcn_sched_barrier(0)
#define A_PIN(x) asm volatile("" : "+v"(x))
#define A_MFMA(a, b, c) __builtin_amdgcn_mfma_f32_32x32x16_bf16(a, b, c, 0, 0, 0)
template <int N> __device__ __forceinline__ void a_wait_bar() { asm volatile("s_waitcnt vmcnt(%0) lgkmcnt(0)\n\ts_barrier" ::"n"(N) : "memory"); }
__device__ __forceinline__ int a_crow(int r, int hi) { return (r & 3) + 8 * (r >> 2) + 4 * hi; }
__device__ __forceinline__ unsigned a_cvtpk(float lo, float hi) { unsigned r; asm("v_cvt_pk_bf16_f32 %0, %1, %2" : "=v"(r) : "v"(lo), "v"(hi)); return r; }
__device__ __forceinline__ void a_glds16(const void* g, unsigned lds_base) {
  unsigned sv; asm volatile("s_mov_b32 %0, m0\n\ts_mov_b32 m0, %2\n\ts_nop 0\n\tglobal_load_lds_dwordx4 %1, off\n\ts_mov_b32 m0, %0" : "=&s"(sv) : "v"(g), "s"(lds_base) : "memory"); }
__device__ __forceinline__ void a_glds4(const void* g, unsigned lds_base) {
  unsigned sv; asm volatile("s_mov_b32 %0, m0\n\ts_mov_b32 m0, %2\n\ts_nop 0\n\tglobal_load_lds_dword %1, off\n\ts_mov_b32 m0, %0" : "=&s"(sv) : "v"(g), "s"(lds_base) : "memory"); }
__device__ __forceinline__ void a_kload2(bf16x8* kf, a_lds_cptr kp, int d0) {
  kf[2 * d0] = *(const __attribute__((address_space(3))) bf16x8*)(kp + d0 * 2048);
  kf[2 * d0 + 1] = *(const __attribute__((address_space(3))) bf16x8*)(kp + d0 * 2048 + 512); }
__device__ __forceinline__ a_s16x4 a_vtr(a_lds_cptr p) { return __builtin_bit_cast(a_s16x4, __builtin_amdgcn_ds_read_tr16_b64_v4i16((__attribute__((address_space(3))) a_v4i16*)p)); }
#define A_MX3(a, b, c) __builtin_fmaxf(__builtin_fmaxf((a), (b)), (c))
__device__ __forceinline__ float a_rowmax(const f32x16& p0, const f32x16& p1) {
  float a = A_MX3(p0[0], p0[1], p1[0]), b = A_MX3(p0[2], p0[3], p1[1]); a = A_MX3(a, p1[2], p1[3]);
#pragma unroll
  for (int r = 4; r < 16; r += 4) { a = A_MX3(a, p0[r], p0[r + 1]); b = A_MX3(b, p0[r + 2], p0[r + 3]); a = A_MX3(a, p1[r], p1[r + 1]); b = A_MX3(b, p1[r + 2], p1[r + 3]); }
  float m = __builtin_fmaxf(a, b); auto rr = __builtin_amdgcn_permlane32_swap(__float_as_uint(m), __float_as_uint(m), false, false);
  return __builtin_fmaxf(__uint_as_float(rr[0]), __uint_as_float(rr[1])); }
template <int MODE>
__device__ __forceinline__ void a_mask(f32x16& p0, f32x16& p1, int key0, int qabs, int hi) {
  const int kb = key0 + 4 * hi;
#pragma unroll
  for (int r = 0; r < 16; ++r) {
    const int kv = kb + (r & 3) + 8 * (r >> 2);
    bool bad0 = kv > qabs, bad1 = (kv + 32) > qabs;
    if (MODE == 2) { bad0 = bad0 || (kv + 512 <= qabs); bad1 = bad1 || (kv + 32 + 512 <= qabs); }
    if (bad0) p0[r] = -INFINITY;
    if (bad1) p1[r] = -INFINITY;
  } }
__device__ __forceinline__ void a_bias(f32x16& p0, f32x16& p1, const char* fb, int hi) {
#pragma unroll
  for (int g = 0; g < 4; ++g) {
    const float4 b0 = *(const float4*)(fb + (8 * g + 4 * hi) * 4);
    const float4 b1 = *(const float4*)(fb + (32 + 8 * g + 4 * hi) * 4);
    p0[4 * g + 0] += b0.x; p0[4 * g + 1] += b0.y; p0[4 * g + 2] += b0.z; p0[4 * g + 3] += b0.w;
    p1[4 * g + 0] += b1.x; p1[4 * g + 1] += b1.y; p1[4 * g + 2] += b1.z; p1[4 * g + 3] += b1.w;
  } }

template <int MODE>
__device__ __forceinline__ void a_unit(const u16* __restrict__ Qw, const int qp, const u16* __restrict__ Kp, const u16* __restrict__ Vp,
                                       const float* __restrict__ Fp, const int NT, const int key00, const int qabs, const unsigned selm,
                                       const float gate, char* lds, u16* stg, const int tid) {
  constexpr int NK = (MODE == 0) ? 2 : 1;
  const int lane = tid & 63, r32 = lane & 31, hi = lane >> 5; const int wid = __builtin_amdgcn_readfirstlane(tid >> 6);
  const unsigned lds0 = (unsigned)(uintptr_t)lds; float* wsf = (float*)(lds + A_LDS_WS) + wid * 64;
  const u16* ksrc = Kp + (long)lane * INC + wid * 8;
  const u16* vsrc = Vp + (long)(16 * (wid & 3) + (lane >> 2)) * INC + (wid >> 2) * 32 + (lane & 3) * 8;
  const float* fsrc = Fp + lane;
  const unsigned kdst = lds0 + A_LDS_K + wid * 1024, vdst = lds0 + A_LDS_V + wid * 1024, fdst = lds0 + A_LDS_F;
#define A_DMA_K(t, slot) do { a_glds16(ksrc + (long)(t) * 64 * INC, (unsigned)__builtin_amdgcn_readfirstlane(kdst + (slot))); \
    if (MODE == 0) a_glds4(fsrc + (t) * 64, (unsigned)__builtin_amdgcn_readfirstlane(fdst + ((t) & 3) * 256)); } while (0)
#define A_DMA_V(t, slot) a_glds16(vsrc + (long)(t) * 64 * INC, (unsigned)__builtin_amdgcn_readfirstlane(vdst + (slot)))
  const a_lds_cptr vp0 = (a_lds_cptr)lds + A_LDS_V + ((lane >> 4) & 1) * 32 + (lane & 3) * 8 + (4 * hi + ((lane & 15) >> 2)) * 64;
  const a_lds_cptr kp0 = (a_lds_cptr)lds + A_LDS_K + hi * 1024 + r32 * 16;
  const char* fb0 = lds + A_LDS_F;
  A_DMA_K(0, 0); A_DMA_V(0, 0); A_DMA_K(1, A_SLOTB);
  bf16x8 qr[4];
#pragma unroll
  for (int d0 = 0; d0 < 4; ++d0) qr[d0] = ldfrag(Qw + (long)r32 * qp + d0 * 16 + hi * 8);
  float mhat = 0.f, l_reg = 0.f; f32x16 o[2];
#pragma unroll
  for (int r = 0; r < 16; ++r) { o[0][r] = 0.f; o[1][r] = 0.f; }
  const f32x16 zero16 = {0.f, 0.f, 0.f, 0.f, 0.f, 0.f, 0.f, 0.f, 0.f, 0.f, 0.f, 0.f, 0.f, 0.f, 0.f, 0.f};
  bool resc = false;
  f32x16 pA0, pA1, pB0, pB1; bf16x8 kf[8]; a_s16x4 vlo[8], vhi[8]; a_u32x4 pw0, pw1, pw2, pw3;
  int sl_prev = 0, sl_cur = 0, sl_next = A_SLOTB;
#define A_ROT() do { sl_prev = sl_cur; sl_cur = sl_next; sl_next = (sl_next == 2 * A_SLOTB) ? 0 : sl_next + A_SLOTB; } while (0)
#define A_EX(v) __builtin_amdgcn_exp2f(__builtin_fmaf((v), A_C2, nmh))
#define A_RESC() do { if (resc) { _Pragma("unroll") for (int d_ = 0; d_ < 2; ++d_) _Pragma("unroll") for (int r = 0; r < 16; ++r) o[d_][r] *= wsf[a_crow(r, hi)]; } } while (0)
  A_DMA_K(2, 2 * A_SLOTB);
  a_wait_bar<1 + 2 * NK>();
  _Pragma("unroll") for (int d0 = 0; d0 < 4; ++d0) a_kload2(kf, kp0, d0);
  pA0 = A_MFMA(kf[0], qr[0], zero16); pA1 = A_MFMA(kf[1], qr[0], zero16); pA0 = A_MFMA(kf[2], qr[1], pA0); pA1 = A_MFMA(kf[3], qr[1], pA1);
  pA0 = A_MFMA(kf[4], qr[2], pA0); pA1 = A_MFMA(kf[5], qr[2], pA1); pA0 = A_MFMA(kf[6], qr[3], pA0); pA1 = A_MFMA(kf[7], qr[3], pA1);
  if (MODE == 0) a_bias(pA0, pA1, fb0, hi);
  if (MODE == 2 || NT == 4) a_mask<MODE>(pA0, pA1, key00, qabs, hi);
  { const float rm = a_rowmax(pA0, pA1); mhat = __builtin_fmaxf(rm * A_C2, -1.0e30f); const float nmh = -mhat;
#pragma unroll
    for (int r = 0; r < 16; ++r) { pA0[r] = A_EX(pA0[r]); pA1[r] = A_EX(pA1[r]); } }
  a_wait_bar<0>();
  A_DMA_K(3, 0); A_DMA_V(1, A_SLOTB); A_ROT();
  _Pragma("unroll") for (int d0 = 0; d0 < 4; ++d0) a_kload2(kf, kp0 + sl_cur, d0);
  a_wait_bar<NK + 1>();
#define A_PKW(P, i) a_cvtpk(P[i], P[i + 1])
#define A_PAF(k) __builtin_bit_cast(bf16x8, pw##k)
#define A_VFR(i) __builtin_bit_cast(bf16x8, __builtin_shufflevector(vlo[i], vhi[i], 0, 1, 2, 3, 4, 5, 6, 7))
#define A_VRD(i) do { vlo[i] = a_vtr(vp_ + (((i) >> 2) * 4096 + ((i) & 3) * 1024)); vhi[i] = a_vtr(vp_ + (((i) >> 2) * 4096 + ((i) & 3) * 1024 + 512)); } while (0)
#define A_KRD(G, d0) do { if (G) { a_kload2(kf, kp0 + sl_next, d0); A_SBAR(); } } while (0)
#define A_GAPA(MF, a0, a1, a2, a3, W0, W1, PW) do { MF; sacc += a0; sacc += a1; sacc += a2; sacc += a3; W0; W1; A_PIN(PW); A_PIN(sacc); A_SBAR(); } while (0)
#define A_GAPB(MF, X, i) do { MF; X[i] = A_EX(X[i]); X[i + 1] = A_EX(X[i + 1]); X[i + 2] = A_EX(X[i + 2]); X[i + 3] = A_EX(X[i + 3]); A_PIN(X); A_SBAR(); } while (0)
#define A_STEP(C0, C1, P0, P1, t, MASK, GK, GV, GL) do { A_SBAR(); \
    const a_lds_cptr vp_ = vp0 + sl_prev; \
    A_VRD(0); A_SBAR(); float sacc = P0[0] + P0[1]; \
                      A_GAPA(C0 = A_MFMA(kf[0], qr[0], zero16), P0[2], P0[3], P0[4], P0[5],     pw0[0] = A_PKW(P0, 0),  pw0[1] = A_PKW(P0, 2),  pw0); \
    A_VRD(4); A_SBAR(); A_GAPA(C1 = A_MFMA(kf[1], qr[0], zero16), P0[6], P0[7], P0[8], P0[9],     pw0[2] = A_PKW(P0, 4),  pw0[3] = A_PKW(P0, 6),  pw0); \
    A_VRD(1); A_SBAR(); A_GAPA(C0 = A_MFMA(kf[2], qr[1], C0),    P0[10], P0[11], P0[12], P0[13], pw1[0] = A_PKW(P0, 8),  pw1[1] = A_PKW(P0, 10), pw1); \
    A_VRD(5); A_SBAR(); A_GAPA(C1 = A_MFMA(kf[3], qr[1], C1),    P0[14], P0[15], P1[0], P1[1],   pw1[2] = A_PKW(P0, 12), pw1[3] = A_PKW(P0, 14), pw1); \
    A_VRD(2); A_SBAR(); A_GAPA(C0 = A_MFMA(kf[4], qr[2], C0),    P1[2], P1[3], P1[4], P1[5],     pw2[0] = A_PKW(P1, 0),  pw2[1] = A_PKW(P1, 2),  pw2); \
    A_VRD(6); A_SBAR(); A_GAPA(C1 = A_MFMA(kf[5], qr[2], C1),    P1[6], P1[7], P1[8], P1[9],     pw2[2] = A_PKW(P1, 4),  pw2[3] = A_PKW(P1, 6),  pw2); \
    A_VRD(3); A_SBAR(); A_GAPA(C0 = A_MFMA(kf[6], qr[3], C0),    P1[10], P1[11], P1[12], P1[13], pw3[0] = A_PKW(P1, 8),  pw3[1] = A_PKW(P1, 10), pw3); \
    A_VRD(7); A_SBAR(); A_GAPA(C1 = A_MFMA(kf[7], qr[3], C1),    P1[14], P1[15], 0.f, 0.f,       pw3[2] = A_PKW(P1, 12), pw3[3] = A_PKW(P1, 14), pw3); \
    l_reg += sacc; \
    if (GK) A_DMA_K((t) + 3, sl_cur); if (GV) A_DMA_V((t) + 1, sl_next); \
    if (MODE == 0) a_bias(C0, C1, fb0 + ((t) & 3) * 256, hi); \
    if (MASK) a_mask<MODE>(C0, C1, key00 + (t) * 64, qabs, hi); \
    const bool selb_ = (MODE != 1) || (((selm >> ((t) & 31)) & 1u) != 0u); \
    { float rmx = a_rowmax(C0, C1) * A_C2; if (!selb_) rmx = -INFINITY; resc = false; \
      if (__builtin_expect(__any((rmx - mhat) > A_THR), 0)) { const float mnew = __builtin_fmaxf(mhat, rmx); \
          const float f = __builtin_amdgcn_exp2f(mhat - mnew); mhat = mnew; l_reg *= f; if (hi == 0) wsf[r32] = f; resc = true; } } \
    const float nmh = selb_ ? -mhat : -INFINITY; A_SBAR(); \
    A_GAPB(o[0] = A_MFMA(A_PAF(0), A_VFR(0), o[0]), C0, 0);              A_GAPB(o[1] = A_MFMA(A_PAF(0), A_VFR(4), o[1]), C0, 4); \
    A_KRD(GL, 0); A_GAPB(o[0] = A_MFMA(A_PAF(1), A_VFR(1), o[0]), C0, 8);  A_KRD(GL, 1); A_GAPB(o[1] = A_MFMA(A_PAF(1), A_VFR(5), o[1]), C0, 12); \
    A_KRD(GL, 2); A_GAPB(o[0] = A_MFMA(A_PAF(2), A_VFR(2), o[0]), C1, 0);  A_KRD(GL, 3); A_GAPB(o[1] = A_MFMA(A_PAF(2), A_VFR(6), o[1]), C1, 4); \
    A_GAPB(o[0] = A_MFMA(A_PAF(3), A_VFR(3), o[0]), C1, 8);              A_GAPB(o[1] = A_MFMA(A_PAF(3), A_VFR(7), o[1]), C1, 12); \
    } while (0)
  int t = 1;
  if (MODE != 2) {
    for (; t + 5 < NT; t += 2) {
      A_STEP(pB0, pB1, pA0, pA1, t, false, true, true, true);     a_wait_bar<NK + 1>(); A_RESC(); A_ROT();
      A_STEP(pA0, pA1, pB0, pB1, t + 1, false, true, true, true); a_wait_bar<NK + 1>(); A_RESC(); A_ROT();
    }
  }
#define A_ENDW(tt) do { if ((tt) + 3 < NT) { a_wait_bar<NK + 1>(); } else if ((tt) + 2 < NT) { a_wait_bar<1>(); } else { a_wait_bar<0>(); } } while (0)
  for (; t + 1 < NT; t += 2) {
    A_STEP(pB0, pB1, pA0, pA1, t, (MODE != 2 || t < 4 || t + 4 >= NT), (t + 3 < NT), (t + 1 < NT), (t + 1 < NT));             A_ENDW(t);     A_RESC(); A_ROT();
    A_STEP(pA0, pA1, pB0, pB1, t + 1, (MODE != 2 || t + 1 < 4 || t + 5 >= NT), (t + 4 < NT), (t + 2 < NT), (t + 2 < NT));     A_ENDW(t + 1); A_RESC(); A_ROT();
  }
  A_STEP(pB0, pB1, pA0, pA1, NT - 1, true, false, false, false); A_RESC();
  { float sacc = pB0[0] + pB0[1];
#pragma unroll
    for (int r = 2; r < 16; ++r) sacc += pB0[r];
#pragma unroll
    for (int r = 0; r < 16; ++r) sacc += pB1[r];
    l_reg += sacc;
    pw0 = (a_u32x4){A_PKW(pB0, 0), A_PKW(pB0, 2), A_PKW(pB0, 4), A_PKW(pB0, 6)}; pw1 = (a_u32x4){A_PKW(pB0, 8), A_PKW(pB0, 10), A_PKW(pB0, 12), A_PKW(pB0, 14)};
    pw2 = (a_u32x4){A_PKW(pB1, 0), A_PKW(pB1, 2), A_PKW(pB1, 4), A_PKW(pB1, 6)}; pw3 = (a_u32x4){A_PKW(pB1, 8), A_PKW(pB1, 10), A_PKW(pB1, 12), A_PKW(pB1, 14)};
    const a_lds_cptr vp_ = vp0 + sl_cur; _Pragma("unroll") for (int i = 0; i < 8; ++i) A_VRD(i);
    o[0] = A_MFMA(A_PAF(0), A_VFR(0), o[0]); o[1] = A_MFMA(A_PAF(0), A_VFR(4), o[1]); o[0] = A_MFMA(A_PAF(1), A_VFR(1), o[0]); o[1] = A_MFMA(A_PAF(1), A_VFR(5), o[1]);
    o[0] = A_MFMA(A_PAF(2), A_VFR(2), o[0]); o[1] = A_MFMA(A_PAF(2), A_VFR(6), o[1]); o[0] = A_MFMA(A_PAF(3), A_VFR(3), o[0]); o[1] = A_MFMA(A_PAF(3), A_VFR(7), o[1]); }
  { auto rr = __builtin_amdgcn_permlane32_swap(__float_as_uint(l_reg), __float_as_uint(l_reg), false, false); l_reg = __uint_as_float(rr[0]) + __uint_as_float(rr[1]); }
  if (hi == 0) wsf[32 + r32] = gate / l_reg;
  asm volatile("s_waitcnt lgkmcnt(0)" ::: "memory");
  float rli[16];
#pragma unroll
  for (int r = 0; r < 16; ++r) rli[r] = wsf[32 + a_crow(r, hi)];
#pragma unroll
  for (int r = 0; r < 16; ++r) { const int orow = a_crow(r, hi);
#pragma unroll
    for (int d0 = 0; d0 < 2; ++d0) stg[orow * 64 + d0 * 32 + r32] = f2bf(o[d0][r] * rli[r]); }
  asm volatile("s_waitcnt lgkmcnt(0)\n\ts_barrier" ::: "memory");
#undef A_DMA_K
#undef A_DMA_V
#undef A_ROT
#undef A_EX
#undef A_RESC
#undef A_PKW
#undef A_PAF
#undef A_VFR
#undef A_VRD
#undef A_KRD
#undef A_ENDW
#undef A_GAPA
#undef A_GAPB
#undef A_STEP
}

__device__ void pc2_phase(const Params& P, int layer, int chunk, char* smem, int* s_item, const int which) {
  const int perq = P.NB * 16;
  const int nCmp = which ? 0 : P.NB * 2;
  const int nItems = nCmp + 8 * perq;
  unsigned* ctr = P.ctr + (chunk * 4 + layer) + which * 16;
  while (true) {
    const int tid = opaque_tid(), lane = tid & 63, r32 = lane & 31, w = tid >> 6;
    __syncthreads();
    if (tid == 0) *s_item = (int)atomicAdd(ctr, 1u);
    __syncthreads();
    const int it0 = *s_item;
    if (it0 >= nItems) break;
    if (it0 < nCmp) { compress_item(P, layer, it0, smem, tid); continue; }
    const int it = it0 - nCmp;
    const int qt = 7 - it / perq;
    const int bh = it % perq;
    const int type = which;
    const int bl = bh >> 4, head = bh & 15;
    const int q0w = qt * 256 + w * 32;
    const int qabs = q0w + r32;
    const size_t rowq = (size_t)bl * TSEQ + qabs;
    const size_t roww = (size_t)bl * TSEQ + q0w;
    const u16* pb_ = P.proj + (size_t)bl * TSEQ * INC;
    u16* stg = (u16*)(smem + A_LDS_OST) + w * 4096;
    const int er = lane >> 3, ec = (lane & 7) * 8;
    if (type == 0) {
      a_unit<0>(pb_ + roww * 0 + (size_t)q0w * INC + C_QB + head * 64, INC, pb_ + C_KB + head * 64, pb_ + C_VB + head * 64,
                P.F2 + (size_t)(bl * 16 + head) * TSEQ, 4 * qt + 4, 0, qabs, 0u, 1.0f, smem, stg, tid);
#pragma unroll
      for (int i = 0; i < 4; i++) {
        const int row = i * 8 + er;
        const uint4 ov = *(const uint4*)(stg + row * 64 + ec);
        const uint4 zz = *(const uint4*)(pb_ + (size_t)(q0w + row) * INC + C_ZB + head * 64 + ec);
        uint4 y;
        y.x = pk2(bflo(ov.x) * siluf_(bflo(zz.x)), bfhi(ov.x) * siluf_(bfhi(zz.x)));
        y.y = pk2(bflo(ov.y) * siluf_(bflo(zz.y)), bfhi(ov.y) * siluf_(bfhi(zz.y)));
        y.z = pk2(bflo(ov.z) * siluf_(bflo(zz.z)), bfhi(ov.z) * siluf_(bfhi(zz.z)));
        y.w = pk2(bflo(ov.w) * siluf_(bflo(zz.w)), bfhi(ov.w) * siluf_(bfhi(zz.w)));
        *(uint4*)(P.yb + (roww + row) * DM + head * 64 + ec) = y;
      }
    } else {
      const int g = head >> 3;
      const unsigned selm = P.sel[(size_t)(bl * 2 + g) * TSEQ + qabs];
      const float g1 = sigmoidf_(bf2f(P.proj[rowq * INC + C_GA + 16 + head]));
      const float g2 = sigmoidf_(bf2f(P.proj[rowq * INC + C_GA + 32 + head]));
      const u16* qw = P.qr + roww * DM + head * 64;
      a_unit<1>(qw, DM, pb_ + C_KV + 256 + g * 64, pb_ + C_KV + 384 + g * 64, nullptr, 4 * qt + 4, 0, qabs, selm, g1, smem, stg, tid);
      const int klo = (4 * qt - 8) > 0 ? (4 * qt - 8) : 0;
      a_unit<2>(qw, DM, pb_ + (size_t)(klo * 64) * INC + C_KV + 512 + g * 64, pb_ + (size_t)(klo * 64) * INC + C_KV + 640 + g * 64, nullptr,
                4 * qt + 4 - klo, klo * 64, qabs, 0u, g2, smem, stg + 2048, tid);
#pragma unroll
      for (int i = 0; i < 4; i++) {
        const int row = i * 8 + er;
        const uint4 o1 = *(const uint4*)(stg + row * 64 + ec);
        const uint4 o2 = *(const uint4*)(stg + 2048 + row * 64 + ec);
        const uint4 zz = *(const uint4*)(pb_ + (size_t)(q0w + row) * INC + C_ZA + head * 64 + ec);
        u16* yp = P.ya + (roww + row) * DM + head * 64 + ec;
        const uint4 oc = *(const uint4*)yp;
        uint4 y;
        y.x = pk2((bflo(o1.x) + bflo(o2.x) + bflo(oc.x)) * siluf_(bflo(zz.x)), (bfhi(o1.x) + bfhi(o2.x) + bfhi(oc.x)) * siluf_(bfhi(zz.x)));
        y.y = pk2((bflo(o1.y) + bflo(o2.y) + bflo(oc.y)) * siluf_(bflo(zz.y)), (bfhi(o1.y) + bfhi(o2.y) + bfhi(oc.y)) * siluf_(bfhi(zz.y)));
        y.z = pk2((bflo(o1.z) + bflo(o2.z) + bflo(oc.z)) * siluf_(bflo(zz.z)), (bfhi(o1.z) + bfhi(o2.z) + bfhi(oc.z)) * siluf_(bfhi(zz.z)));
        y.w = pk2((bflo(o1.w) + bflo(o2.w) + bflo(oc.w)) * siluf_(bflo(zz.w)), (bfhi(o1.w) + bfhi(o2.w) + bfhi(oc.w)) * siluf_(bfhi(zz.w)));
        *(uint4*)yp = y;
      }
    }
  }
}

__device__ __forceinline__ void grid_bar(unsigned* ctr, unsigned& epoch) {
  asm volatile("s_waitcnt vmcnt(0) lgkmcnt(0)" ::: "memory");
  __syncthreads();
  epoch += gridDim.x;
  if (threadIdx.x == 0) {
    __builtin_amdgcn_fence(__ATOMIC_RELEASE, "agent");
    asm volatile("s_waitcnt vmcnt(0)" ::: "memory");
    __hip_atomic_fetch_add(ctr, 1u, __ATOMIC_RELAXED, __HIP_MEMORY_SCOPE_AGENT);
    while (__hip_atomic_load(ctr, __ATOMIC_RELAXED, __HIP_MEMORY_SCOPE_AGENT) < epoch) __builtin_amdgcn_s_sleep(2);
    __builtin_amdgcn_fence(__ATOMIC_ACQUIRE, "agent");
    asm volatile("s_waitcnt vmcnt(0)" ::: "memory");
  }
  __syncthreads();
}

__global__ void __launch_bounds__(NTHREADS, 2) mega_kernel(Params P) {
  __shared__ __attribute__((aligned(1024))) char smem[163840];
  cg::grid_group grid = cg::this_grid();
  const int CT = P.NB * TSEQ;
  unsigned epoch = 0u;
  phase0(P, smem);
  grid.sync();
  for (int chunk = 0; chunk < P.nchunk; chunk++) {
    for (int layer = 0; layer < 4; layer++) {
      const float* xs = (layer == 0 ? P.x_in : P.out) + (size_t)chunk * CT * DM;
      norm_phase(xs, P.norm_g + layer * DM, P.h, CT);
      if (layer == 0 && chunk > 0) final_norm_phase(P.out, P.final_g, (chunk - 1) * CT, CT);
      grid_bar(P.ctr + 48, epoch);
      gemm1_phase(P, layer, smem);
      grid_bar(P.ctr + 48, epoch);
      pb_phase(P, layer, smem);
      grid_bar(P.ctr + 48, epoch);
      pc2_phase(P, layer, chunk, smem, (int*)(smem + 140000), 0);
      grid_bar(P.ctr + 48, epoch);
      pc1_phase(P, smem);
      grid_bar(P.ctr + 48, epoch);
      pc2_phase(P, layer, chunk, smem, (int*)(smem + 140000), 1);
      grid_bar(P.ctr + 48, epoch);
      gemm2_phase(P, layer, smem);
      grid_bar(P.ctr + 48, epoch);
      gemm3_phase(P, layer, chunk, smem);
      grid_bar(P.ctr + 48, epoch);
    }
  }
  final_norm_phase(P.out, P.final_g, (P.nchunk - 1) * CT, CT);
}

static inline size_t al256(size_t x) { return (x + 255) & ~(size_t)255; }

extern "C" void kernel_launch(void* const* d_in, const int* in_sizes, int n_in, void* d_out, int out_size,
                              void* d_ws, size_t ws_size, hipStream_t stream) {
  (void)in_sizes; (void)n_in; (void)out_size;
  Params P{};
  P.x_in = (const float*)d_in[0]; P.norm_g = (const float*)d_in[1]; P.w_in = (const float*)d_in[2];
  P.b_forget = (const float*)d_in[3];
  P.pe_k = (const float*)d_in[4]; P.w1_k = (const float*)d_in[5]; P.w2_k = (const float*)d_in[6];
  P.pe_v = (const float*)d_in[7]; P.w1_v = (const float*)d_in[8]; P.w2_v = (const float*)d_in[9];
  P.w_pa = (const float*)d_in[10]; P.w_pb = (const float*)d_in[11]; P.w_out = (const float*)d_in[12];
  P.final_g = (const float*)d_in[13];
  P.out = (float*)d_out;
  int NB = 16;
  char* base = (char*)d_ws;
  for (;;) {
    const size_t CT = (size_t)NB * TSEQ;
    size_t off = 0;
    auto take = [&](size_t bytes) { size_t o = off; off = al256(off + bytes); return o; };
    size_t oWin = take((size_t)4 * INCP * DM * 2), oWpa = take((size_t)4 * DM * DM * 2), oWpb = take((size_t)4 * DM * DM * 2),
           oWo = take((size_t)4 * DM * DM * 2), oW1 = take((size_t)8 * 128 * 2048 * 2), oW2 = take((size_t)8 * 64 * 128 * 2),
           oB1 = take((size_t)64 * 128 * 4), oRc = take((size_t)TSEQ * 32 * 4), oRs = take((size_t)TSEQ * 32 * 4),
           oH = take(CT * DM * 2), oProj = take(CT * INC * 2 + 4096), oVbt = take(CT * DM * 2),
           oVst = take(CT * 128 * 2), oVwt = take(CT * 128 * 2), oFl = take(CT * 16 * 4), oF2 = take(CT * 16 * 4),
           oKc = take((size_t)NB * 2 * 128 * 64 * 2), oVc = take((size_t)NB * 2 * 64 * 128 * 2), oSel = take(CT * 2 * 4),
           oYa = take(CT * DM * 2), oYb = take(CT * DM * 2), oCtr = take(256);
    if (off > ws_size && NB > 1) { NB >>= 1; continue; }
    P.WinT = (u16*)(base + oWin); P.WpaT = (u16*)(base + oWpa); P.WpbT = (u16*)(base + oWpb); P.WoT = (u16*)(base + oWo);
    P.W1T = (u16*)(base + oW1); P.W2T = (u16*)(base + oW2); P.bias1p = (float*)(base + oB1);
    P.ropec = (float*)(base + oRc); P.ropes = (float*)(base + oRs);
    P.h = (u16*)(base + oH); P.proj = (u16*)(base + oProj); P.qr = (u16*)(base + oVbt);
    P.vst = (u16*)(base + oVst); P.vwt = (u16*)(base + oVwt); P.flog = (float*)(base + oFl); P.F2 = (float*)(base + oF2);
    P.kcmp = (u16*)(base + oKc); P.vcmpt = (u16*)(base + oVc); P.sel = (unsigned*)(base + oSel);
    P.ya = (u16*)(base + oYa); P.yb = (u16*)(base + oYb); P.ctr = (unsigned*)(base + oCtr);
    break;
  }
  P.NB = NB; P.nchunk = 32 / NB;
  static int grid_blocks = 0;
  if (!grid_blocks) {
    int dev = 0, cus = 0, per_cu = 0;
    hipGetDevice(&dev);
    hipDeviceGetAttribute(&cus, hipDeviceAttributeMultiprocessorCount, dev);
    hipOccupancyMaxActiveBlocksPerMultiprocessor(&per_cu, mega_kernel, NTHREADS, 0);
    if (per_cu > 1) per_cu = 1;
    if (per_cu < 1) per_cu = 1;
    grid_blocks = cus * per_cu;
  }
  void* args[] = {&P};
  hipError_t e = hipLaunchCooperativeKernel((void*)mega_kernel, dim3(grid_blocks), dim3(NTHREADS), args, 0, stream);
  if (e != hipSuccess) fprintf(stderr, "cooperative launch failed: %s (grid %d)\n", hipGetErrorString(e), grid_blocks);
}
```

```cpp
#include <hip/hip_runtime.h>
#include <hip/hip_cooperative_groups.h>
#include <cstdio>
namespace cg = cooperative_groups;

typedef __attribute__((ext_vector_type(8))) __bf16 bf16x8;
typedef __attribute__((ext_vector_type(16))) float f32x16;
typedef __attribute__((ext_vector_type(4))) float f32x4;
typedef __attribute__((ext_vector_type(2))) float f32x2;
typedef unsigned short u16;

#define TSEQ 2048
#define DM 1024
#define INC 9024
#define INCP 9216
#define C_QA 0
#define C_KV 1024
#define C_GA 1792
#define C_ZA 1840
#define C_QB 2864
#define C_KB 3888
#define C_VB 4912
#define C_QR 4912
#define C_FB 5936
#define C_ZB 5952
#define C_RA 6976
#define C_RB 8000
#define NTHREADS 512
#define ATT_STAGE 33280
#define LOG2E 1.4426950408889634f
#define XB_WORDS 3200

struct Params {
  const float* x_in; const float* norm_g; const float* w_in; const float* b_forget;
  const float* pe_k; const float* w1_k; const float* w2_k;
  const float* pe_v; const float* w1_v; const float* w2_v;
  const float* w_pa; const float* w_pb; const float* w_out; const float* final_g;
  float* out;
  u16* WinT; u16* WpaT; u16* WpbT; u16* WoT; u16* W1T; u16* W2T;
  float* bias1p; float* ropec; float* ropes;
  u16* h; u16* proj; u16* qr; u16* vst; u16* vwt;
  float* flog; float* F2; u16* kcmp; u16* vcmpt; unsigned* sel;
  u16* ya; u16* yb; unsigned* ctr; unsigned* xbar;
  int NB; int nchunk;
};

__device__ __forceinline__ unsigned pk2(float a, float b) {
  typedef __attribute__((ext_vector_type(2))) float f2_t;
  typedef __attribute__((ext_vector_type(2))) __bf16 b2_t;
  f2_t v = {a, b};
  b2_t r = __builtin_convertvector(v, b2_t);
  return __builtin_bit_cast(unsigned, r);
}
__device__ __forceinline__ u16 f2bf(float a) { return (u16)(pk2(a, 0.f) & 0xffffu); }
__device__ __forceinline__ float bf2f(u16 u) { return __uint_as_float(((unsigned)u) << 16); }
__device__ __forceinline__ float bflo(unsigned u) { return __uint_as_float(u << 16); }
__device__ __forceinline__ float bfhi(unsigned u) { return __uint_as_float(u & 0xffff0000u); }
__device__ __forceinline__ float sigmoidf_(float x) { return 1.f / (1.f + __expf(-x)); }
__device__ __forceinline__ float siluf_(float x) { return x / (1.f + __expf(-x)); }
__device__ __forceinline__ f32x16 mfma32(bf16x8 a, bf16x8 b, f32x16 c) {
  return __builtin_amdgcn_mfma_f32_32x32x16_bf16(a, b, c, 0, 0, 0);
}
__device__ __forceinline__ int opaque_tid() { int t = threadIdx.x; asm volatile("" : "+v"(t)); return t; }
__device__ __forceinline__ bf16x8 ldfrag(const void* p) {
  return __builtin_bit_cast(bf16x8, *(const uint4*)p);
}

__device__ void transpose_tile(const float* __restrict__ src, u16* __restrict__ dst, int K, int N,
                               int k0, int n0, float* tile, const int tid) {
#pragma unroll
  for (int j = 0; j < 2; j++) {
    int r = (tid >> 4) + 32 * j, c4 = (tid & 15) * 4;
    float4 v = *(const float4*)(src + (size_t)(k0 + r) * N + n0 + c4);
    tile[r * 65 + c4] = v.x; tile[r * 65 + c4 + 1] = v.y; tile[r * 65 + c4 + 2] = v.z; tile[r * 65 + c4 + 3] = v.w;
  }
  __syncthreads();
  {
    int c = tid, n = c >> 3, kc = c & 7;
    const float* tp = tile + (kc * 8) * 65 + n;
    uint4 o;
    o.x = pk2(tp[0], tp[65]); o.y = pk2(tp[130], tp[195]); o.z = pk2(tp[260], tp[325]); o.w = pk2(tp[390], tp[455]);
    *(uint4*)(dst + (size_t)(n0 + n) * K + k0 + kc * 8) = o;
  }
  __syncthreads();
}

__device__ void phase0(const Params& P, char* smem) {
  const int tid = opaque_tid();
  float* tile = (float*)smem;
  const int n0_ = 4 * 16 * 141, n1_ = 4 * 16 * 16, n2_ = 4 * 32 * 2, n3_ = 4 * 2 * 1;
  const int nT = n0_ + 3 * n1_ + 2 * n2_ + 2 * n3_;
  const int nBias = 64, nRope = 128;
  const int total = nT + nBias + nRope + 1;
  for (int it = blockIdx.x; it < total; it += gridDim.x) {
    if (it < nT) {
      int t = it;
      if (t < n0_) {
        int l = t / (16 * 141), rem = t % (16 * 141);
        transpose_tile(P.w_in + (size_t)l * DM * INC, P.WinT + (size_t)l * INCP * DM, DM, INC, (rem / 141) * 64, (rem % 141) * 64, tile, tid);
        continue;
      }
      t -= n0_;
      if (t < 3 * n1_) {
        int which = t / n1_; t %= n1_;
        int l = t / 256, rem = t % 256;
        const float* s = which == 0 ? P.w_pa : (which == 1 ? P.w_pb : P.w_out);
        u16* d = which == 0 ? P.WpaT : (which == 1 ? P.WpbT : P.WoT);
        transpose_tile(s + (size_t)l * DM * DM, d + (size_t)l * DM * DM, DM, DM, (rem >> 4) * 64, (rem & 15) * 64, tile, tid);
        continue;
      }
      t -= 3 * n1_;
      if (t < 2 * n2_) {
        int kv = t / n2_; t %= n2_;
        int l = t / 64, rem = t % 64;
        const float* s = kv ? P.w1_v : P.w1_k;
        transpose_tile(s + (size_t)l * 2048 * 128, P.W1T + (size_t)(l * 2 + kv) * 128 * 2048, 2048, 128, (rem >> 1) * 64, (rem & 1) * 64, tile, tid);
        continue;
      }
      t -= 2 * n2_;
      {
        int kv = t / n3_; t %= n3_;
        int l = t / 2, rem = t % 2;
        const float* s = kv ? P.w2_v : P.w2_k;
        transpose_tile(s + (size_t)l * 128 * 64, P.W2T + (size_t)(l * 2 + kv) * 64 * 128, 128, 64, rem * 64, 0, tile, tid);
      }
    } else if (it < nT + nBias) {
      int j = it - nT;
      int l = j >> 4, kv = (j >> 3) & 1, kq = j & 7;
      const float* pe = (kv ? P.pe_v : P.pe_k) + (size_t)l * 2048;
      const float* w1 = (kv ? P.w1_v : P.w1_k) + (size_t)l * 2048 * 128;
      int hid = tid & 127, kh = tid >> 7;
      int kbeg = kq * 256 + kh * 64;
      float s = 0.f;
#pragma unroll 8
      for (int k = 0; k < 64; k++) s += pe[kbeg + k] * w1[(size_t)(kbeg + k) * 128 + hid];
      float* part = (float*)smem;
      part[tid] = s;
      __syncthreads();
      if (tid < 128) P.bias1p[((l * 2 + kv) * 8 + kq) * 128 + hid] = (part[tid] + part[tid + 128]) + (part[tid + 256] + part[tid + 384]);
      __syncthreads();
    } else if (it < nT + nBias + nRope) {
      int idx = (it - nT - nBias) * 512 + tid;
      int t = idx >> 5, j = idx & 31;
      double inv = 1.0;
      for (int q = 0; q < j; q++) inv *= 0.7498942093324558;
      float invf = (float)inv;
      float angf = (float)t * invf;
      double a = (double)angf;
      double kq = rint(a * 0.15915494309189535);
      double rr = a - kq * 6.283185307179586;
      double r2 = rr * rr;
      double sterm = rr, cterm = 1.0, ssum = rr, csum = 1.0;
#pragma unroll 1
      for (int n = 1; n <= 15; n++) {
        cterm *= -r2 / (double)((2 * n - 1) * (2 * n));
        sterm *= -r2 / (double)((2 * n) * (2 * n + 1));
        csum += cterm; ssum += sterm;
      }
      P.ropec[idx] = (float)csum;
      P.ropes[idx] = (float)ssum;
    } else {
      if (tid < 64) P.ctr[tid] = 0u;
      for (int i = tid; i < XB_WORDS; i += NTHREADS) P.xbar[i] = 0u;
    }
  }
}

__device__ void norm_phase(const float* __restrict__ xsrc, const float* __restrict__ g, u16* __restrict__ hdst, int nrows) {
  const int tid = opaque_tid();
  const int lane = tid & 63;
  const int gw = blockIdx.x * 8 + (tid >> 6), nw = gridDim.x * 8;
  float4 gv[4];
#pragma unroll
  for (int j = 0; j < 4; j++) gv[j] = *(const float4*)(g + lane * 4 + 256 * j);
  for (int row = gw; row < nrows; row += nw) {
    const float* xr = xsrc + (size_t)row * DM;
    float4 v[4];
    float ss = 0.f;
#pragma unroll
    for (int j = 0; j < 4; j++) {
      v[j] = *(const float4*)(xr + lane * 4 + 256 * j);
      ss += v[j].x * v[j].x + v[j].y * v[j].y + v[j].z * v[j].z + v[j].w * v[j].w;
    }
#pragma unroll
    for (int o = 32; o >= 1; o >>= 1) ss += __shfl_xor(ss, o);
    float rstd = rsqrtf(ss * (1.f / DM) + 1e-6f);
#pragma unroll
    for (int j = 0; j < 4; j++) {
      uint2 o;
      o.x = pk2(v[j].x * rstd * gv[j].x, v[j].y * rstd * gv[j].y);
      o.y = pk2(v[j].z * rstd * gv[j].z, v[j].w * rstd * gv[j].w);
      *(uint2*)(hdst + (size_t)row * DM + lane * 4 + 256 * j) = o;
    }
  }
}

__device__ void final_norm_phase(float* __restrict__ x, const float* __restrict__ g, int row0, int nrows) {
  const int tid = opaque_tid();
  const int lane = tid & 63;
  const int gw = blockIdx.x * 8 + (tid >> 6), nw = gridDim.x * 8;
  float4 gv[4];
#pragma unroll
  for (int j = 0; j < 4; j++) gv[j] = *(const float4*)(g + lane * 4 + 256 * j);
  for (int row = gw; row < nrows; row += nw) {
    float* xr = x + (size_t)(row0 + row) * DM;
    float4 v[4];
    float ss = 0.f;
#pragma unroll
    for (int j = 0; j < 4; j++) {
      v[j] = *(const float4*)(xr + lane * 4 + 256 * j);
      ss += v[j].x * v[j].x + v[j].y * v[j].y + v[j].z * v[j].z + v[j].w * v[j].w;
    }
#pragma unroll
    for (int o = 32; o >= 1; o >>= 1) ss += __shfl_xor(ss, o);
    float rstd = rsqrtf(ss * (1.f / DM) + 1e-6f);
#pragma unroll
    for (int j = 0; j < 4; j++) {
      float4 o;
      o.x = v[j].x * rstd * gv[j].x; o.y = v[j].y * rstd * gv[j].y;
      o.z = v[j].z * rstd * gv[j].z; o.w = v[j].w * rstd * gv[j].w;
      *(float4*)(xr + lane * 4 + 256 * j) = o;
    }
  }
}

struct ARow {
  const u16* p; int ld;
  __device__ __forceinline__ const u16* operator()(int row, int k) const { return p + (size_t)row * ld + k; }
};
struct ACmp {
  const u16* p;
  __device__ __forceinline__ const u16* operator()(int row, int k) const {
    int t = 16 * row + (k >> 6); t = t > (TSEQ - 1) ? (TSEQ - 1) : t;
    return p + (size_t)t * INC + (k & 63);
  }
};

template <class AF>
__device__ __forceinline__ void gemm_mainloop(AF af, const u16* __restrict__ Bt, int ldb, int K, char* smem,
                                              f32x16 (&acc)[2][2], const int tid) {
  const int lane = tid & 63, r = lane & 31, h = lane >> 5, w = tid >> 6;
  const int wm = w >> 1, wn = w & 1;
  const int lrow = tid >> 3, lch = tid & 7;
  uint4 ra[4], rb[4];
  const int nk = K >> 6;
#pragma unroll
  for (int j = 0; j < 4; j++) {
    int row = lrow + 32 * j;
    ra[j] = *(const uint4*)af(row, lch * 8);
    rb[j] = *(const uint4*)(Bt + (size_t)row * ldb + lch * 8);
  }
#pragma unroll
  for (int j = 0; j < 4; j++) {
    int row = lrow + 32 * j;
    int off = row * 128 + ((lch ^ ((row >> 1) & 7)) << 4);
    *(uint4*)(smem + off) = ra[j];
    *(uint4*)(smem + 16384 + off) = rb[j];
  }
  __syncthreads();
  for (int it = 0; it < nk; it++) {
    const bool more = (it + 1) < nk;
    if (more) {
      const int k0 = (it + 1) * 64;
#pragma unroll
      for (int j = 0; j < 4; j++) {
        int row = lrow + 32 * j;
        ra[j] = *(const uint4*)af(row, k0 + lch * 8);
        rb[j] = *(const uint4*)(Bt + (size_t)row * ldb + k0 + lch * 8);
      }
    }
    const char* sa = smem + (it & 1) * 32768;
    const char* sb = sa + 16384;
#pragma unroll
    for (int kk = 0; kk < 4; kk++) {
      bf16x8 a[2], b[2];
#pragma unroll
      for (int mi = 0; mi < 2; mi++) {
        int row = wm * 64 + mi * 32 + r;
        a[mi] = ldfrag(sa + row * 128 + (((kk * 2 + h) ^ ((row >> 1) & 7)) << 4));
      }
#pragma unroll
      for (int ni = 0; ni < 2; ni++) {
        int row = wn * 64 + ni * 32 + r;
        b[ni] = ldfrag(sb + row * 128 + (((kk * 2 + h) ^ ((row >> 1) & 7)) << 4));
      }
#pragma unroll
      for (int mi = 0; mi < 2; mi++)
#pragma unroll
        for (int ni = 0; ni < 2; ni++) acc[mi][ni] = mfma32(a[mi], b[ni], acc[mi][ni]);
    }
    if (more) {
      char* sd = smem + ((it + 1) & 1) * 32768;
#pragma unroll
      for (int j = 0; j < 4; j++) {
        int row = lrow + 32 * j;
        int off = row * 128 + ((lch ^ ((row >> 1) & 7)) << 4);
        *(uint4*)(sd + off) = ra[j];
        *(uint4*)(sd + 16384 + off) = rb[j];
      }
    }
    __syncthreads();
  }
}

__device__ __forceinline__ void zero_acc(f32x16 (&acc)[2][2]) {
#pragma unroll
  for (int a = 0; a < 2; a++)
#pragma unroll
    for (int b = 0; b < 2; b++)
#pragma unroll
      for (int i = 0; i < 16; i++) acc[a][b][i] = 0.f;
}

typedef __attribute__((ext_vector_type(8))) short s16x8;
#define G_TILE_B 32768
#define G_STAGE_B 65536
__device__ __forceinline__ int g_lds_byte(int r, int c) {
  int st = (r >> 4) * 2 + (c >> 5), ob = (r & 15) * 64 + (c & 31) * 2;
  return st * 1024 + (ob ^ (((ob >> 9) & 1) << 5));
}
__device__ __forceinline__ void g_stage_rc(int b, int& R, int& C) {
  int st = b >> 10, sb = b & 1023, swz = sb ^ (((sb >> 9) & 1) << 5);
  R = (st >> 1) * 16 + swz / 64;
  C = (st & 1) * 32 + (swz % 64) / 2;
}
#define G_WAIT_V0() asm volatile("s_waitcnt vmcnt(0)" ::: "memory")

struct GTile { int pm, pn; };
__device__ __forceinline__ bool g_next(int i, int G, int c, int nM, int nN, GTile& u) {
  const int nwg = nM * nN;
  const int L = i * G + c;
  if (L >= nwg) return false;
  int wgid = L;
  { const int q = nwg / 8, r = nwg % 8, xcd = wgid % 8, off = wgid / 8; wgid = (xcd < r ? xcd * (q + 1) : r * (q + 1) + (xcd - r) * q) + off; }
  const int nig = 8 * nN, gid = wgid / nig, fm = gid * 8, gsz = (nM - fm) < 8 ? (nM - fm) : 8;
  u.pm = fm + ((wgid % nig) % gsz);
  u.pn = (wgid % nig) / gsz;
  return true;
}

__device__ __forceinline__ void g_kloop(const u16* __restrict__ Ab, const u16* __restrict__ Bb, const int K, char* smem,
                                        f32x4 (&acc)[8][4], const int tid, const bool pre, const u16* __restrict__ nA,
                                        const u16* __restrict__ nB, const bool has_next) {
  const int wid = tid >> 6, lane = tid & 63, wr = wid >> 2, wc = wid & 3, fr = lane & 15, fq = lane >> 4;
  int sR0, sC0, sR1, sC1, sR2, sC2, sR3, sC3;
  g_stage_rc(wid * 1024 + 0 * 8192 + lane * 16, sR0, sC0);
  g_stage_rc(wid * 1024 + 1 * 8192 + lane * 16, sR1, sC1);
  g_stage_rc(wid * 1024 + 2 * 8192 + lane * 16, sR2, sC2);
  g_stage_rc(wid * 1024 + 3 * 8192 + lane * 16, sR3, sC3);
  const long o0 = (long)sR0 * K + sC0, o1 = (long)sR1 * K + sC1, o2 = (long)sR2 * K + sC2, o3 = (long)sR3 * K + sC3;
#define G_STAGE(buf, kt)                                                                                              \
  {                                                                                                                  \
    char* sa_ = smem + (buf) * G_STAGE_B + wid * 1024;                                                               \
    char* sb_ = sa_ + G_TILE_B;                                                                                      \
    const u16* ga_ = Ab + (kt) * 64;                                                                                 \
    const u16* gb_ = Bb + (kt) * 64;                                                                                 \
    __builtin_amdgcn_global_load_lds((const unsigned*)(ga_ + o0), (unsigned*)(sa_), 16, 0, 0);                       \
    __builtin_amdgcn_global_load_lds((const unsigned*)(gb_ + o0), (unsigned*)(sb_), 16, 0, 0);                       \
    __builtin_amdgcn_global_load_lds((const unsigned*)(ga_ + o1), (unsigned*)(sa_ + 8192), 16, 0, 0);                \
    __builtin_amdgcn_global_load_lds((const unsigned*)(gb_ + o1), (unsigned*)(sb_ + 8192), 16, 0, 0);                \
    __builtin_amdgcn_global_load_lds((const unsigned*)(ga_ + o2), (unsigned*)(sa_ + 16384), 16, 0, 0);               \
    __builtin_amdgcn_global_load_lds((const unsigned*)(gb_ + o2), (unsigned*)(sb_ + 16384), 16, 0, 0);               \
    __builtin_amdgcn_global_load_lds((const unsigned*)(ga_ + o3), (unsigned*)(sa_ + 24576), 16, 0, 0);               \
    __builtin_amdgcn_global_load_lds((const unsigned*)(gb_ + o3), (unsigned*)(sb_ + 24576), 16, 0, 0);               \
  }
  const int nt = K >> 6;
  if (!pre) {
    G_STAGE(0, 0);
    G_WAIT_V0();
    __syncthreads();
  }
  for (int t = 0; t < nt; ++t) {
    const int cur = t & 1;
    if (t + 1 < nt) G_STAGE(cur ^ 1, t + 1)
    else if (has_next) {
      char* sa_ = smem + wid * 1024;
      char* sb_ = sa_ + G_TILE_B;
      __builtin_amdgcn_global_load_lds((const unsigned*)(nA + o0), (unsigned*)(sa_), 16, 0, 0);
      __builtin_amdgcn_global_load_lds((const unsigned*)(nB + o0), (unsigned*)(sb_), 16, 0, 0);
      __builtin_amdgcn_global_load_lds((const unsigned*)(nA + o1), (unsigned*)(sa_ + 8192), 16, 0, 0);
      __builtin_amdgcn_global_load_lds((const unsigned*)(nB + o1), (unsigned*)(sb_ + 8192), 16, 0, 0);
      __builtin_amdgcn_global_load_lds((const unsigned*)(nA + o2), (unsigned*)(sa_ + 16384), 16, 0, 0);
      __builtin_amdgcn_global_load_lds((const unsigned*)(nB + o2), (unsigned*)(sb_ + 16384), 16, 0, 0);
      __builtin_amdgcn_global_load_lds((const unsigned*)(nA + o3), (unsigned*)(sa_ + 24576), 16, 0, 0);
      __builtin_amdgcn_global_load_lds((const unsigned*)(nB + o3), (unsigned*)(sb_ + 24576), 16, 0, 0);
    }
    const char* sa = smem + cur * G_STAGE_B;
    const char* sb = sa + G_TILE_B;
#pragma unroll
    for (int ks = 0; ks < 2; ++ks) {
      s16x8 At[8], Bf[4];
#pragma unroll
      for (int m = 0; m < 8; ++m) At[m] = *(const s16x8*)(sa + g_lds_byte(wr * 128 + m * 16 + fr, ks * 32 + fq * 8));
#pragma unroll
      for (int n = 0; n < 4; ++n) Bf[n] = *(const s16x8*)(sb + g_lds_byte(wc * 64 + n * 16 + fr, ks * 32 + fq * 8));
#pragma unroll
      for (int m = 0; m < 8; ++m)
#pragma unroll
        for (int n = 0; n < 4; ++n)
          acc[m][n] = __builtin_amdgcn_mfma_f32_16x16x32_bf16(__builtin_bit_cast(bf16x8, Bf[n]), __builtin_bit_cast(bf16x8, At[m]), acc[m][n], 0, 0, 0);
      __builtin_amdgcn_sched_barrier(0);
    }
    G_WAIT_V0();
    __syncthreads();
  }
}

__device__ __forceinline__ void g_zero(f32x4 (&acc)[8][4]) {
#pragma unroll
  for (int m = 0; m < 8; m++)
#pragma unroll
    for (int n = 0; n < 4; n++) acc[m][n] = (f32x4){0.f, 0.f, 0.f, 0.f};
}
__device__ __forceinline__ uint2 pk4(f32x4 v) { return make_uint2(pk2(v[0], v[1]), pk2(v[2], v[3])); }

__device__ __forceinline__ void wave_store_rows(char* wsm, u16* gbase, const size_t ld, const f32x4 (&acc)[8][4], const int lane) {
  const int fr = lane & 15, fq = lane >> 4;
  const int rr = lane >> 3, ch = lane & 7;
  typedef __attribute__((ext_vector_type(4))) unsigned u32x4_t;
#pragma unroll
  for (int hf = 0; hf < 2; hf++) {
#pragma unroll
    for (int m = 0; m < 4; m++)
#pragma unroll
      for (int n = 0; n < 4; n++) {
        const int row = m * 16 + fr, chunk = n * 2 + (fq >> 1);
        *(uint2*)(wsm + row * 128 + ((chunk ^ (fr & 7)) << 4) + (fq & 1) * 8) = pk4(acc[hf * 4 + m][n]);
      }
#pragma unroll
    for (int i = 0; i < 8; i++) {
      const int row = i * 8 + rr;
      const uint4 v = *(const uint4*)(wsm + row * 128 + ((ch ^ (row & 7)) << 4));
      __builtin_nontemporal_store(__builtin_bit_cast(u32x4_t, v), (u32x4_t*)(gbase + (size_t)(hf * 64 + row) * ld + ch * 8));
    }
  }
}
__device__ __forceinline__ void wave_store_cols(char* wsm, u16* vt, const int vcol0, const int nh, const int bl, const int t0,
                                                const f32x4 (&acc)[8][4], const int lane) {
  const int fr = lane & 15, fq = lane >> 4;
#pragma unroll
  for (int m = 0; m < 8; m++)
#pragma unroll
    for (int n = 0; n < 4; n++)
#pragma unroll
      for (int j = 0; j < 4; j++) {
        const int d = n * 16 + fq * 4 + j, t = m * 16 + fr;
        *(u16*)(wsm + d * 256 + (((t >> 3) ^ (d & 15)) << 4) + (t & 7) * 2) = f2bf(acc[m][n][j]);
      }
  const int dd = lane >> 4, ch = lane & 15;
#pragma unroll
  for (int i = 0; i < 16; i++) {
    const int d = i * 4 + dd;
    const uint4 v = *(const uint4*)(wsm + d * 256 + ((ch ^ (d & 15)) << 4));
    const int vcol = vcol0 + d;
    *(uint4*)(vt + ((size_t)(bl * nh + (vcol >> 6)) * 64 + (vcol & 63)) * TSEQ + t0 + ch * 8) = v;
  }
}

__device__ void gemm1_phase(const Params& P, int layer, char* smem) {
  const int CT = P.NB * TSEQ;
  const int nM = CT >> 8, nN = INCP >> 8;
  const u16* Bt = P.WinT + (size_t)layer * INCP * DM;
  u16* p_qr = P.qr; u16* p_proj = P.proj;
  asm volatile("" : "+s"(p_qr), "+s"(p_proj));
  for (int i = 0;; i++) {
    GTile u, un;
    if (!g_next(i, gridDim.x, blockIdx.x, nM, nN, u)) break;
    const bool hn = g_next(i + 1, gridDim.x, blockIdx.x, nM, nN, un);
    const int tid = opaque_tid(), wid = tid >> 6, lane = tid & 63, wr = wid >> 2, wc = wid & 3, fr = lane & 15, fq = lane >> 4;
    f32x4 acc[8][4];
    g_zero(acc);
    g_kloop(P.h + (size_t)(u.pm * 256) * DM, Bt + (size_t)(u.pn * 256) * DM, DM, smem, acc, tid, i > 0,
            P.h + (size_t)(un.pm * 256) * DM, Bt + (size_t)(un.pn * 256) * DM, hn);
    const int cw = u.pn * 256 + wc * 64;
    const int row0 = u.pm * 256 + wr * 128 + fr;
    char* wsm = smem + G_STAGE_B + wid * 8192;
    const int rowb = u.pm * 256 + wr * 128;
    const bool rope_q = cw < 1024;
    const bool rope_k = (cw >= C_KV + 256 && cw < C_KV + 384) || (cw >= C_KV + 512 && cw < C_KV + 640);
    const bool mixed = (cw == 5888);
    if (cw >= INC) {
    } else if (rope_q || rope_k) {
      if (rope_q) wave_store_rows(wsm, p_proj + (size_t)rowb * INC + cw, INC, acc, lane);
#pragma unroll
      for (int m = 0; m < 8; m++) {
        const int tt = (row0 + m * 16) & (TSEQ - 1);
#pragma unroll
        for (int n = 0; n < 2; n++) {
          const float4 c = *(const float4*)(P.ropec + tt * 32 + n * 16 + fq * 4);
          const float4 sn = *(const float4*)(P.ropes + tt * 32 + n * 16 + fq * 4);
          const f32x4 x1 = acc[m][n], x2 = acc[m][n + 2];
          f32x4 r1, r2;
          r1[0] = x1[0] * c.x - x2[0] * sn.x; r2[0] = x2[0] * c.x + x1[0] * sn.x;
          r1[1] = x1[1] * c.y - x2[1] * sn.y; r2[1] = x2[1] * c.y + x1[1] * sn.y;
          r1[2] = x1[2] * c.z - x2[2] * sn.z; r2[2] = x2[2] * c.z + x1[2] * sn.z;
          r1[3] = x1[3] * c.w - x2[3] * sn.w; r2[3] = x2[3] * c.w + x1[3] * sn.w;
          acc[m][n] = r1; acc[m][n + 2] = r2;
        }
      }
      if (rope_q) wave_store_rows(wsm, p_qr + (size_t)rowb * DM + cw, DM, acc, lane);
      else wave_store_rows(wsm, p_proj + (size_t)rowb * INC + cw, INC, acc, lane);
    } else if (!mixed) {
      wave_store_rows(wsm, p_proj + (size_t)rowb * INC + cw, INC, acc, lane);
    } else {
#pragma unroll
      for (int n = 0; n < 4; n++) {
        const int c0 = cw + n * 16 + fq * 4;
        if (c0 < C_FB) {
#pragma unroll
          for (int m = 0; m < 8; m++) *(uint2*)(p_proj + (size_t)(row0 + m * 16) * INC + c0) = pk4(acc[m][n]);
        } else {
#pragma unroll
          for (int m = 0; m < 8; m++)
            *(float4*)(P.flog + (size_t)(row0 + m * 16) * 16 + (c0 - C_FB)) = make_float4(acc[m][n][0], acc[m][n][1], acc[m][n][2], acc[m][n][3]);
        }
        __builtin_amdgcn_sched_barrier(0);
      }
    }
    __syncthreads();
  }
}

__device__ void gemm2_phase(const Params& P, int layer, char* smem) {
  const int CT = P.NB * TSEQ;
  const int nM = CT >> 8, nN = 4;
  const u16* p_ya = P.ya; const u16* p_yb = P.yb; const u16* p_wa = P.WpaT; const u16* p_wb = P.WpbT;
  for (int i = 0;; i++) {
    GTile u, un;
    if (!g_next(i, gridDim.x, blockIdx.x, nM, nN, u)) break;
    const bool hn = g_next(i + 1, gridDim.x, blockIdx.x, nM, nN, un);
    const int tid = opaque_tid(), wid = tid >> 6, lane = tid & 63, wr = wid >> 2, wc = wid & 3, fr = lane & 15, fq = lane >> 4;
    f32x4 acc[8][4];
    g_zero(acc);
#pragma unroll 1
    for (int pass = 0; pass < 2; pass++) {
      const u16* Ap = (pass ? p_yb : p_ya) + (size_t)(u.pm * 256) * DM;
      const u16* Bp = (pass ? p_wb : p_wa) + (size_t)layer * DM * DM + (size_t)(u.pn * 256) * DM;
      const u16* nAp = pass ? (p_ya + (size_t)(un.pm * 256) * DM) : (p_yb + (size_t)(u.pm * 256) * DM);
      const u16* nBp = pass ? (p_wa + (size_t)layer * DM * DM + (size_t)(un.pn * 256) * DM) : (p_wb + (size_t)layer * DM * DM + (size_t)(u.pn * 256) * DM);
      g_kloop(Ap, Bp, DM, smem, acc, tid, (i > 0) || (pass > 0), nAp, nBp, pass ? hn : true);
      __builtin_amdgcn_sched_barrier(0);
      if (pass == 0) {
        const int tid1 = opaque_tid(), wid1 = tid1 >> 6, lane1 = tid1 & 63, wr1 = wid1 >> 2, wc1 = wid1 & 3, fr1 = lane1 & 15, fq1 = lane1 >> 4;
        const u16* pp = P.proj + (size_t)(u.pm * 256 + wr1 * 128 + fr1) * INC + u.pn * 256 + wc1 * 64 + fq1 * 4;
#pragma unroll
        for (int m = 0; m < 8; m++) {
#pragma unroll
          for (int n = 0; n < 4; n++) {
            const uint2 ra = *(const uint2*)(pp + (size_t)(m * 16) * INC + C_RA + n * 16);
            const uint2 rb = *(const uint2*)(pp + (size_t)(m * 16) * INC + C_RB + n * 16);
            acc[m][n][0] *= (1.f + __expf(-bflo(rb.x))) / (1.f + __expf(-bflo(ra.x)));
            acc[m][n][1] *= (1.f + __expf(-bfhi(rb.x))) / (1.f + __expf(-bfhi(ra.x)));
            acc[m][n][2] *= (1.f + __expf(-bflo(rb.y))) / (1.f + __expf(-bflo(ra.y)));
            acc[m][n][3] *= (1.f + __expf(-bfhi(rb.y))) / (1.f + __expf(-bfhi(ra.y)));
          }
          __builtin_amdgcn_sched_barrier(0);
        }
      }
    }
    {
      const int tid2 = opaque_tid(), wid2 = tid2 >> 6, lane2 = tid2 & 63, wr2 = wid2 >> 2, wc2 = wid2 & 3, fr2 = lane2 & 15, fq2 = lane2 >> 4;
      const u16* pp = P.proj + (size_t)(u.pm * 256 + wr2 * 128 + fr2) * INC + u.pn * 256 + wc2 * 64 + fq2 * 4;
#pragma unroll
      for (int m = 0; m < 8; m++) {
#pragma unroll
        for (int n = 0; n < 4; n++) {
          const uint2 rb = *(const uint2*)(pp + (size_t)(m * 16) * INC + C_RB + n * 16);
          acc[m][n][0] *= sigmoidf_(bflo(rb.x)); acc[m][n][1] *= sigmoidf_(bfhi(rb.x));
          acc[m][n][2] *= sigmoidf_(bflo(rb.y)); acc[m][n][3] *= sigmoidf_(bfhi(rb.y));
        }
        __builtin_amdgcn_sched_barrier(0);
      }
      wave_store_rows(smem + G_STAGE_B + wid2 * 8192, P.h + (size_t)(u.pm * 256 + wr2 * 128) * DM + u.pn * 256 + wc2 * 64, DM, acc, lane2);
    }
    __syncthreads();
  }
}

__device__ void gemm3_phase(const Params& P, int layer, int chunk, char* smem) {
  const int CT = P.NB * TSEQ;
  const int nM = CT >> 8, nN = 4;
  const float* xs = (layer == 0 ? P.x_in : P.out) + (size_t)chunk * CT * DM;
  float* xd = P.out + (size_t)chunk * CT * DM;
  for (int i = 0;; i++) {
    GTile u, un;
    if (!g_next(i, gridDim.x, blockIdx.x, nM, nN, u)) break;
    const bool hn = g_next(i + 1, gridDim.x, blockIdx.x, nM, nN, un);
    const int tid = opaque_tid(), wid = tid >> 6, lane = tid & 63, wr = wid >> 2, wc = wid & 3, fr = lane & 15, fq = lane >> 4;
    f32x4 acc[8][4];
    g_zero(acc);
    g_kloop(P.h + (size_t)(u.pm * 256) * DM, P.WoT + (size_t)layer * DM * DM + (size_t)(u.pn * 256) * DM, DM, smem, acc, tid, i > 0,
            P.h + (size_t)(un.pm * 256) * DM, P.WoT + (size_t)layer * DM * DM + (size_t)(un.pn * 256) * DM, hn);
    const size_t off = (size_t)(u.pm * 256 + wr * 128 + fr) * DM + u.pn * 256 + wc * 64 + fq * 4;
#pragma unroll
    for (int m = 0; m < 8; m++) {
#pragma unroll
      for (int n = 0; n < 4; n++) {
        const float4 xo = *(const float4*)(xs + off + (size_t)(m * 16) * DM + n * 16);
        *(float4*)(xd + off + (size_t)(m * 16) * DM + n * 16) =
            make_float4(xo.x + acc[m][n][0], xo.y + acc[m][n][1], xo.z + acc[m][n][2], xo.w + acc[m][n][3]);
      }
      __builtin_amdgcn_sched_barrier(0);
    }
  }
}

__device__ __forceinline__ void compress_item(const Params& P, const int layer, const int it, char* smem_all, const int tid_all) {
  const int half = tid_all >> 8, tid = tid_all & 255;
  char* smem = smem_all + half * 65536;
  const int lane = tid & 63, r = lane & 31, h = lane >> 5, w = tid >> 6;
  const int wm = w >> 1, wn = w & 1;
  const int unit = it * 2 + half;
  const int bl = unit >> 2, g = (unit >> 1) & 1, kv = unit & 1;
  f32x16 acc[2][2];
  zero_acc(acc);
  ACmp af{P.proj + (size_t)bl * TSEQ * INC + C_KV + kv * 128 + g * 64};
  gemm_mainloop(af, P.W1T + (size_t)(layer * 2 + kv) * 128 * 2048, 2048, 2048, smem, acc, tid);
  const float* bp = P.bias1p + (size_t)((layer * 2 + kv) * 8) * 128;
#pragma unroll
  for (int ni = 0; ni < 2; ni++) {
    int hc = wn * 64 + ni * 32 + r;
    float b1 = 0.f;
#pragma unroll
    for (int q = 0; q < 8; q++) b1 += bp[q * 128 + hc];
#pragma unroll
    for (int mi = 0; mi < 2; mi++)
#pragma unroll
      for (int i = 0; i < 16; i++) {
        int n = wm * 64 + mi * 32 + 8 * (i >> 2) + 4 * h + (i & 3);
        float v = siluf_(acc[mi][ni][i] + b1);
        *(u16*)(smem + n * 256 + (((hc >> 3) ^ (n & 15)) << 4) + (hc & 7) * 2) = f2bf(v);
      }
  }
  __syncthreads();
  const u16* w2t = P.W2T + (size_t)(layer * 2 + kv) * 64 * 128;
  f32x16 o2[2];
#pragma unroll
  for (int dt = 0; dt < 2; dt++)
#pragma unroll
    for (int i = 0; i < 16; i++) o2[dt][i] = 0.f;
#pragma unroll
  for (int kk = 0; kk < 8; kk++) {
    int n = w * 32 + r;
    bf16x8 a = ldfrag(smem + n * 256 + (((kk * 2 + h) ^ (n & 15)) << 4));
#pragma unroll
    for (int dt = 0; dt < 2; dt++) {
      bf16x8 b = ldfrag(w2t + (size_t)(dt * 32 + r) * 128 + kk * 16 + h * 8);
      o2[dt] = mfma32(a, b, o2[dt]);
    }
  }
#pragma unroll
  for (int dt = 0; dt < 2; dt++) {
    int d = dt * 32 + r;
    if (kv == 0) {
#pragma unroll
      for (int i = 0; i < 16; i++) {
        int n = w * 32 + 8 * (i >> 2) + 4 * h + (i & 3);
        P.kcmp[((size_t)(bl * 2 + g) * 128 + n) * 64 + d] = f2bf(o2[dt][i]);
      }
    } else {
#pragma unroll
      for (int gq = 0; gq < 4; gq++) {
        int n0 = w * 32 + 8 * gq + 4 * h;
        uint2 o;
        o.x = pk2(o2[dt][gq * 4 + 0], o2[dt][gq * 4 + 1]);
        o.y = pk2(o2[dt][gq * 4 + 2], o2[dt][gq * 4 + 3]);
        *(uint2*)(P.vcmpt + ((size_t)(bl * 2 + g) * 64 + d) * 128 + n0) = o;
      }
    }
  }
  __syncthreads();
}

__device__ void pb_phase(const Params& P, int layer, char* smem_all) {
  const int tid = opaque_tid();
  const int lane = tid & 63, w = tid >> 6;
  float* wsum = (float*)smem_all;
  const int nScan = P.NB * 16;
  for (int it = blockIdx.x; it < nScan; it += gridDim.x) {
    const int bl = it >> 4, hh = it & 15;
    const float bf = P.b_forget[layer * 16 + hh];
    const float* fl = P.flog + ((size_t)bl * TSEQ + tid * 4) * 16 + hh;
    float ls[4];
#pragma unroll
    for (int j = 0; j < 4; j++) {
      const float x = fl[j * 16] + bf;
      ls[j] = (x >= 0.f) ? -log1pf(__expf(-x)) : (x - log1pf(__expf(x)));
    }
    const float loc = (ls[0] + ls[1]) + (ls[2] + ls[3]);
    float incl = loc;
#pragma unroll
    for (int o = 1; o < 64; o <<= 1) {
      const float v = __shfl_up(incl, o);
      if (lane >= o) incl += v;
    }
    __syncthreads();
    if (lane == 63) wsum[w] = incl;
    __syncthreads();
    float base = 0.f;
#pragma unroll
    for (int q = 0; q < 8; q++) base += (q < w) ? wsum[q] : 0.f;
    float run = base + incl - loc;
    float4 o4;
    run += ls[0]; o4.x = -8.0f * run;
    run += ls[1]; o4.y = -8.0f * run;
    run += ls[2]; o4.z = -8.0f * run;
    run += ls[3]; o4.w = -8.0f * run;
    *(float4*)(P.F2 + ((size_t)bl * 16 + hh) * TSEQ + tid * 4) = o4;
  }
}

__device__ void pc1_phase(const Params& P, char* smem) {
  const int tid = opaque_tid(),  lane = tid & 63, r = lane & 31, h = lane >> 5, w = tid >> 6;
  const int nItems = P.NB * 2 * 8;
  const float c1 = 0.125f * LOG2E;
  for (int it = blockIdx.x; it < nItems; it += gridDim.x) {
    const int qt = it & 7, g = (it >> 3) & 1, bl = it >> 4;
    __syncthreads();
#pragma unroll
    for (int j = 0; j < 2; j++) {
      int c = tid + 512 * j;
      {
        int n = c >> 3, ch = c & 7;
        uint4 v = *(const uint4*)(P.kcmp + ((size_t)(bl * 2 + g) * 128 + n) * 64 + ch * 8);
        *(uint4*)(smem + n * 128 + ((ch ^ ((n >> 1) & 7)) << 4)) = v;
      }
      {
        int d = c >> 4, ch = c & 15;
        uint4 v = *(const uint4*)(P.vcmpt + ((size_t)(bl * 2 + g) * 64 + d) * 128 + ch * 8);
        int sw = d & 31;
        *(uint2*)(smem + 16384 + d * 256 + (((2 * ch) ^ sw) << 3)) = make_uint2(v.x, v.y);
        *(uint2*)(smem + 16384 + d * 256 + (((2 * ch + 1) ^ sw) << 3)) = make_uint2(v.z, v.w);
      }
    }
    __syncthreads();
    const int qw_lo = qt * 256 + w * 32;
    const int qtok = qw_lo + r;
    const size_t rowg = (size_t)bl * TSEQ + qtok;
    const int tq = qtok - 31 - 64 * h;
    float sumacc[16], lastacc[16];
#pragma unroll
    for (int s = 0; s < 16; s++) { sumacc[s] = 0.f; lastacc[s] = 0.f; }
#pragma unroll 1
    for (int hh = 0; hh < 8; hh++) {
      const int head = g * 8 + hh;
      bf16x8 qf[4];
#pragma unroll
      for (int kk = 0; kk < 4; kk++) qf[kk] = ldfrag(P.proj + rowg * INC + C_QA + head * 64 + kk * 16 + h * 8);
      f32x16 s[4];
#pragma unroll
      for (int nt = 0; nt < 4; nt++) {
#pragma unroll
        for (int i = 0; i < 16; i++) s[nt][i] = 0.f;
#pragma unroll
        for (int kk = 0; kk < 4; kk++) {
          int row = nt * 32 + r;
          bf16x8 a = ldfrag(smem + row * 128 + (((kk * 2 + h) ^ ((row >> 1) & 7)) << 4));
          s[nt] = mfma32(a, qf[kk], s[nt]);
        }
        __builtin_amdgcn_sched_barrier(0);
      }
      float mx = -3.0e38f;
#pragma unroll
      for (int nt = 0; nt < 4; nt++)
#pragma unroll
        for (int i = 0; i < 16; i++) {
          bool ok = (16 * (nt * 32 + 8 * (i >> 2) + (i & 3))) <= tq;
          float v = ok ? s[nt][i] * c1 : -3.0e38f;
          s[nt][i] = v;
          mx = fmaxf(mx, v);
        }
      mx = fmaxf(mx, __shfl_xor(mx, 32));
      const bool anyv = mx > -1.0e37f;
      float mref = anyv ? mx : 0.f;
      float l = 0.f;
#pragma unroll
      for (int nt = 0; nt < 4; nt++)
#pragma unroll
        for (int i = 0; i < 16; i++) {
          float p = __builtin_amdgcn_exp2f(s[nt][i] - mref);
          s[nt][i] = p;
          l += p;
        }
      l += __shfl_xor(l, 32);
      const float inv = (anyv && l > 0.f) ? 1.f / l : 0.f;
#pragma unroll
      for (int nt = 0; nt < 4; nt++)
#pragma unroll
        for (int i = 0; i < 16; i++) s[nt][i] *= inv;
#pragma unroll
      for (int nt = 0; nt < 4; nt++)
#pragma unroll
        for (int gq = 0; gq < 4; gq++) {
          sumacc[nt * 4 + gq] += (s[nt][gq * 4] + s[nt][gq * 4 + 1]) + (s[nt][gq * 4 + 2] + s[nt][gq * 4 + 3]);
          lastacc[nt * 4 + gq] += s[nt][gq * 4 + 3];
        }
      uint4 pbv[8];
#pragma unroll
      for (int ks = 0; ks < 8; ks++) {
        const int nt = ks >> 1, hb = (ks & 1) * 8;
        pbv[ks].x = pk2(s[nt][hb + 0], s[nt][hb + 1]); pbv[ks].y = pk2(s[nt][hb + 2], s[nt][hb + 3]);
        pbv[ks].z = pk2(s[nt][hb + 4], s[nt][hb + 5]); pbv[ks].w = pk2(s[nt][hb + 6], s[nt][hb + 7]);
      }
      const float g0 = sigmoidf_(bf2f(P.proj[rowg * INC + C_GA + head]));
#pragma unroll
      for (int dt = 0; dt < 2; dt++) {
        f32x16 o;
#pragma unroll
        for (int i = 0; i < 16; i++) o[i] = 0.f;
        const int d = dt * 32 + r, sw = d & 31;
#pragma unroll
        for (int ks = 0; ks < 8; ks++) {
          uint2 lo = *(const uint2*)(smem + 16384 + d * 256 + (((ks * 4 + h) ^ sw) << 3));
          uint2 hi = *(const uint2*)(smem + 16384 + d * 256 + (((ks * 4 + 2 + h) ^ sw) << 3));
          uint4 au = make_uint4(lo.x, lo.y, hi.x, hi.y);
          o = mfma32(__builtin_bit_cast(bf16x8, au), __builtin_bit_cast(bf16x8, pbv[ks]), o);
        }
#pragma unroll
        for (int gq = 0; gq < 4; gq++) {
          int d0 = dt * 32 + 8 * gq + 4 * h;
          uint2 ov;
          ov.x = pk2(o[gq * 4 + 0] * g0, o[gq * 4 + 1] * g0);
          ov.y = pk2(o[gq * 4 + 2] * g0, o[gq * 4 + 3] * g0);
          *(uint2*)(P.ya + rowg * DM + head * 64 + d0) = ov;
        }
        __builtin_amdgcn_sched_barrier(0);
      }
    }
    float sc[16];
#pragma unroll
    for (int s = 0; s < 16; s++) {
      float prev = (s == 0) ? 0.f : lastacc[s - 1];
      float sendv = h ? prev : lastacc[s];
      float recv = __shfl_xor(sendv, 32);
      float imp = sumacc[s] + recv;
      int j = (s >> 2) * 8 + (s & 3) * 2 + h;
      int cur = qtok >> 6;
      bool forced = (j == 0) || (j == cur) || (j == cur - 1);
      bool valid = j <= cur;
      sc[s] = forced ? 1.0e4f : (valid ? imp : -1.0f);
    }
    unsigned mask = 0u;
#pragma unroll 1
    for (int rd = 0; rd < 8; rd++) {
      float best = -2.0f; int bj = 0;
#pragma unroll
      for (int s = 0; s < 16; s++) {
        int j = (s >> 2) * 8 + (s & 3) * 2 + h;
        if (sc[s] > best) { best = sc[s]; bj = j; }
      }
      float ob = __shfl_xor(best, 32);
      int oj = __shfl_xor(bj, 32);
      bool mine = (best > ob) || (best == ob && bj < oj);
      int wj = mine ? bj : oj;
      mask |= 1u << wj;
#pragma unroll
      for (int s = 0; s < 16; s++) {
        int j = (s >> 2) * 8 + (s & 3) * 2 + h;
        if (j == wj) sc[s] = -3.0f;
      }
    }
    if (h == 0) P.sel[(size_t)(bl * 2 + g) * TSEQ + qtok] = mask;
  }
}

#define A_SLOTB 8192
#define A_LDS_K 0
#define A_LDS_V 24576
#define A_LDS_WS 49152
#define A_LDS_F 51200
#define A_LDS_OST 52224
#define A_THR 8.0f
#define A_C2 (0.125f * LOG2E)
typedef __attribute__((ext_vector_type(4))) short a_s16x4;
typedef __attribute__((ext_vector_type(8))) short a_s16x8;
typedef __attribute__((ext_vector_type(4))) unsigned a_u32x4;
typedef __attribute__((address_space(3))) const char* a_lds_cptr;
typedef short a_v4i16 __attribute__((ext_vector_type(4)));
#define A_SBAR() __builtin_amdgcn_sched_barrier(0)
#define A_PIN(x) asm volatile("" : "+v"(x))
#define A_MFMA(a, b, c) __builtin_amdgcn_mfma_f32_32x32x16_bf16(a, b, c, 0, 0, 0)
template <int N> __device__ __forceinline__ void a_wait_bar() { asm volatile("s_waitcnt vmcnt(%0) lgkmcnt(0)\n\ts_barrier" ::"n"(N) : "memory"); }
__device__ __forceinline__ int a_crow(int r, int hi) { return (r & 3) + 8 * (r >> 2) + 4 * hi; }
__device__ __forceinline__ unsigned a_cvtpk(float lo, float hi) { unsigned r; asm("v_cvt_pk_bf16_f32 %0, %1, %2" : "=v"(r) : "v"(lo), "v"(hi)); return r; }
__device__ __forceinline__ void a_glds16(const void* g, unsigned lds_base) {
  unsigned sv; asm volatile("s_mov_b32 %0, m0\n\ts_mov_b32 m0, %2\n\ts_nop 0\n\tglobal_load_lds_dwordx4 %1, off\n\ts_mov_b32 m0, %0" : "=&s"(sv) : "v"(g), "s"(lds_base) : "memory"); }
__device__ __forceinline__ void a_glds4(const void* g, unsigned lds_base) {
  unsigned sv; asm volatile("s_mov_b32 %0, m0\n\ts_mov_b32 m0, %2\n\ts_nop 0\n\tglobal_load_lds_dword %1, off\n\ts_mov_b32 m0, %0" : "=&s"(sv) : "v"(g), "s"(lds_base) : "memory"); }
__device__ __forceinline__ void a_kload2(bf16x8* kf, a_lds_cptr kp, int d0) {
  kf[2 * d0] = *(const __attribute__((address_space(3))) bf16x8*)(kp + d0 * 2048);
  kf[2 * d0 + 1] = *(const __attribute__((address_space(3))) bf16x8*)(kp + d0 * 2048 + 512); }
__device__ __forceinline__ a_s16x4 a_vtr(a_lds_cptr p) { return __builtin_bit_cast(a_s16x4, __builtin_amdgcn_ds_read_tr16_b64_v4i16((__attribute__((address_space(3))) a_v4i16*)p)); }
#define A_MX3(a, b, c) __builtin_fmaxf(__builtin_fmaxf((a), (b)), (c))
__device__ __forceinline__ float a_rowmax(const f32x16& p0, const f32x16& p1) {
  float a = A_MX3(p0[0], p0[1], p1[0]), b = A_MX3(p0[2], p0[3], p1[1]); a = A_MX3(a, p1[2], p1[3]);
#pragma unroll
  for (int r = 4; r < 16; r += 4) { a = A_MX3(a, p0[r], p0[r + 1]); b = A_MX3(b, p0[r + 2], p0[r + 3]); a = A_MX3(a, p1[r], p1[r + 1]); b = A_MX3(b, p1[r + 2], p1[r + 3]); }
  float m = __builtin_fmaxf(a, b); auto rr = __builtin_amdgcn_permlane32_swap(__float_as_uint(m), __float_as_uint(m), false, false);
  return __builtin_fmaxf(__uint_as_float(rr[0]), __uint_as_float(rr[1])); }
template <int MODE>
__device__ __forceinline__ void a_mask(f32x16& p0, f32x16& p1, int key0, int qabs, int hi) {
  const int kb = key0 + 4 * hi;
#pragma unroll
  for (int r = 0; r < 16; ++r) {
    const int kv = kb + (r & 3) + 8 * (r >> 2);
    bool bad0 = kv > qabs, bad1 = (kv + 32) > qabs;
    if (MODE == 2) { bad0 = bad0 || (kv + 512 <= qabs); bad1 = bad1 || (kv + 32 + 512 <= qabs); }
    if (bad0) p0[r] = -INFINITY;
    if (bad1) p1[r] = -INFINITY;
  } }
__device__ __forceinline__ void a_bias(f32x16& p0, f32x16& p1, const char* fb, int hi) {
#pragma unroll
  for (int g = 0; g < 4; ++g) {
    const float4 b0 = *(const float4*)(fb + (8 * g + 4 * hi) * 4);
    const float4 b1 = *(const float4*)(fb + (32 + 8 * g + 4 * hi) * 4);
    p0[4 * g + 0] += b0.x; p0[4 * g + 1] += b0.y; p0[4 * g + 2] += b0.z; p0[4 * g + 3] += b0.w;
    p1[4 * g + 0] += b1.x; p1[4 * g + 1] += b1.y; p1[4 * g + 2] += b1.z; p1[4 * g + 3] += b1.w;
  } }

template <int MODE>
__device__ __forceinline__ void a_unit(const u16* __restrict__ Qw, const int qp, const u16* __restrict__ Kp, const u16* __restrict__ Vp,
                                       const float* __restrict__ Fp, const int NT, const int key00, const int qabs, const unsigned selm,
                                       const float gate, char* lds, u16* stg, const int tid) {
  constexpr int NK = (MODE == 0) ? 2 : 1;
  const int lane = tid & 63, r32 = lane & 31, hi = lane >> 5; const int wid = __builtin_amdgcn_readfirstlane(tid >> 6);
  const unsigned lds0 = (unsigned)(uintptr_t)lds; float* wsf = (float*)(lds + A_LDS_WS) + wid * 64;
  const u16* ksrc = Kp + (long)lane * INC + wid * 8;
  const u16* vsrc = Vp + (long)(16 * (wid & 3) + (lane >> 2)) * INC + (wid >> 2) * 32 + (lane & 3) * 8;
  const float* fsrc = Fp + lane;
  const unsigned kdst = lds0 + A_LDS_K + wid * 1024, vdst = lds0 + A_LDS_V + wid * 1024, fdst = lds0 + A_LDS_F;
#define A_DMA_K(t, slot) do { a_glds16(ksrc + (long)(t) * 64 * INC, (unsigned)__builtin_amdgcn_readfirstlane(kdst + (slot))); \
    if (MODE == 0) a_glds4(fsrc + (t) * 64, (unsigned)__builtin_amdgcn_readfirstlane(fdst + ((t) & 3) * 256)); } while (0)
#define A_DMA_V(t, slot) a_glds16(vsrc + (long)(t) * 64 * INC, (unsigned)__builtin_amdgcn_readfirstlane(vdst + (slot)))
  const a_lds_cptr vp0 = (a_lds_cptr)lds + A_LDS_V + ((lane >> 4) & 1) * 32 + (lane & 3) * 8 + (4 * hi + ((lane & 15) >> 2)) * 64;
  const a_lds_cptr kp0 = (a_lds_cptr)lds + A_LDS_K + hi * 1024 + r32 * 16;
  const char* fb0 = lds + A_LDS_F;
  A_DMA_K(0, 0); A_DMA_V(0, 0); A_DMA_K(1, A_SLOTB);
  bf16x8 qr[4];
#pragma unroll
  for (int d0 = 0; d0 < 4; ++d0) qr[d0] = ldfrag(Qw + (long)r32 * qp + d0 * 16 + hi * 8);
  float mhat = 0.f, l_reg = 0.f; f32x16 o[2];
#pragma unroll
  for (int r = 0; r < 16; ++r) { o[0][r] = 0.f; o[1][r] = 0.f; }
  const f32x16 zero16 = {0.f, 0.f, 0.f, 0.f, 0.f, 0.f, 0.f, 0.f, 0.f, 0.f, 0.f, 0.f, 0.f, 0.f, 0.f, 0.f};
  bool resc = false;
  f32x16 pA0, pA1, pB0, pB1; bf16x8 kf[8]; a_s16x4 vlo[8], vhi[8]; a_u32x4 pw0, pw1, pw2, pw3;
  int sl_prev = 0, sl_cur = 0, sl_next = A_SLOTB;
#define A_ROT() do { sl_prev = sl_cur; sl_cur = sl_next; sl_next = (sl_next == 2 * A_SLOTB) ? 0 : sl_next + A_SLOTB; } while (0)
#define A_EX(v) __builtin_amdgcn_exp2f(__builtin_fmaf((v), A_C2, nmh))
#define A_RESC() do { if (resc) { _Pragma("unroll") for (int d_ = 0; d_ < 2; ++d_) _Pragma("unroll") for (int r = 0; r < 16; ++r) o[d_][r] *= wsf[a_crow(r, hi)]; } } while (0)
  A_DMA_K(2, 2 * A_SLOTB);
  a_wait_bar<1 + 2 * NK>();
  _Pragma("unroll") for (int d0 = 0; d0 < 4; ++d0) a_kload2(kf, kp0, d0);
  pA0 = A_MFMA(kf[0], qr[0], zero16); pA1 = A_MFMA(kf[1], qr[0], zero16); pA0 = A_MFMA(kf[2], qr[1], pA0); pA1 = A_MFMA(kf[3], qr[1], pA1);
  pA0 = A_MFMA(kf[4], qr[2], pA0); pA1 = A_MFMA(kf[5], qr[2], pA1); pA0 = A_MFMA(kf[6], qr[3], pA0); pA1 = A_MFMA(kf[7], qr[3], pA1);
  if (MODE == 0) a_bias(pA0, pA1, fb0, hi);
  if (MODE == 2 || NT == 4) a_mask<MODE>(pA0, pA1, key00, qabs, hi);
  { const float rm = a_rowmax(pA0, pA1); mhat = __builtin_fmaxf(rm * A_C2, -1.0e30f); const float nmh = -mhat;
#pragma unroll
    for (int r = 0; r < 16; ++r) { pA0[r] = A_EX(pA0[r]); pA1[r] = A_EX(pA1[r]); } }
  a_wait_bar<0>();
  A_DMA_K(3, 0); A_DMA_V(1, A_SLOTB); A_ROT();
  _Pragma("unroll") for (int d0 = 0; d0 < 4; ++d0) a_kload2(kf, kp0 + sl_cur, d0);
  a_wait_bar<NK + 1>();
#define A_PKW(P, i) a_cvtpk(P[i], P[i + 1])
#define A_PAF(k) __builtin_bit_cast(bf16x8, pw##k)
#define A_VFR(i) __builtin_bit_cast(bf16x8, __builtin_shufflevector(vlo[i], vhi[i], 0, 1, 2, 3, 4, 5, 6, 7))
#define A_VRD(i) do { vlo[i] = a_vtr(vp_ + (((i) >> 2) * 4096 + ((i) & 3) * 1024)); vhi[i] = a_vtr(vp_ + (((i) >> 2) * 4096 + ((i) & 3) * 1024 + 512)); } while (0)
#define A_KRD(G, d0) do { if (G) { a_kload2(kf, kp0 + sl_next, d0); A_SBAR(); } } while (0)
#define A_GAPA(MF, a0, a1, a2, a3, W0, W1, PW) do { MF; sacc += a0; sacc += a1; sacc += a2; sacc += a3; W0; W1; A_PIN(PW); A_PIN(sacc); A_SBAR(); } while (0)
#define A_GAPB(MF, X, i) do { MF; X[i] = A_EX(X[i]); X[i + 1] = A_EX(X[i + 1]); X[i + 2] = A_EX(X[i + 2]); X[i + 3] = A_EX(X[i + 3]); A_PIN(X); A_SBAR(); } while (0)
#define A_STEP(C0, C1, P0, P1, t, MASK, GK, GV, GL) do { A_SBAR(); \
    const a_lds_cptr vp_ = vp0 + sl_prev; \
    A_VRD(0); A_SBAR(); float sacc = P0[0] + P0[1]; \
                      A_GAPA(C0 = A_MFMA(kf[0], qr[0], zero16), P0[2], P0[3], P0[4], P0[5],     pw0[0] = A_PKW(P0, 0),  pw0[1] = A_PKW(P0, 2),  pw0); \
    A_VRD(4); A_SBAR(); A_GAPA(C1 = A_MFMA(kf[1], qr[0], zero16), P0[6], P0[7], P0[8], P0[9],     pw0[2] = A_PKW(P0, 4),  pw0[3] = A_PKW(P0, 6),  pw0); \
    A_VRD(1); A_SBAR(); A_GAPA(C0 = A_MFMA(kf[2], qr[1], C0),    P0[10], P0[11], P0[12], P0[13], pw1[0] = A_PKW(P0, 8),  pw1[1] = A_PKW(P0, 10), pw1); \
    A_VRD(5); A_SBAR(); A_GAPA(C1 = A_MFMA(kf[3], qr[1], C1),    P0[14], P0[15], P1[0], P1[1],   pw1[2] = A_PKW(P0, 12), pw1[3] = A_PKW(P0, 14), pw1); \
    A_VRD(2); A_SBAR(); A_GAPA(C0 = A_MFMA(kf[4], qr[2], C0),    P1[2], P1[3], P1[4], P1[5],     pw2[0] = A_PKW(P1, 0),  pw2[1] = A_PKW(P1, 2),  pw2); \
    A_VRD(6); A_SBAR(); A_GAPA(C1 = A_MFMA(kf[5], qr[2], C1),    P1[6], P1[7], P1[8], P1[9],     pw2[2] = A_PKW(P1, 4),  pw2[3] = A_PKW(P1, 6),  pw2); \
    A_VRD(3); A_SBAR(); A_GAPA(C0 = A_MFMA(kf[6], qr[3], C0),    P1[10], P1[11], P1[12], P1[13], pw3[0] = A_PKW(P1, 8),  pw3[1] = A_PKW(P1, 10), pw3); \
    A_VRD(7); A_SBAR(); A_GAPA(C1 = A_MFMA(kf[7], qr[3], C1),    P1[14], P1[15], 0.f, 0.f,       pw3[2] = A_PKW(P1, 12), pw3[3] = A_PKW(P1, 14), pw3); \
    l_reg += sacc; \
    if (GK) A_DMA_K((t) + 3, sl_cur); if (GV) A_DMA_V((t) + 1, sl_next); \
    if (MODE == 0) a_bias(C0, C1, fb0 + ((t) & 3) * 256, hi); \
    if (MASK) a_mask<MODE>(C0, C1, key00 + (t) * 64, qabs, hi); \
    const bool selb_ = (MODE != 1) || (((selm >> ((t) & 31)) & 1u) != 0u); \
    { float rmx = a_rowmax(C0, C1) * A_C2; if (!selb_) rmx = -INFINITY; resc = false; \
      if (__builtin_expect(__any((rmx - mhat) > A_THR), 0)) { const float mnew = __builtin_fmaxf(mhat, rmx); \
          const float f = __builtin_amdgcn_exp2f(mhat - mnew); mhat = mnew; l_reg *= f; if (hi == 0) wsf[r32] = f; resc = true; } } \
    const float nmh = selb_ ? -mhat : -INFINITY; A_SBAR(); \
    A_GAPB(o[0] = A_MFMA(A_PAF(0), A_VFR(0), o[0]), C0, 0);              A_GAPB(o[1] = A_MFMA(A_PAF(0), A_VFR(4), o[1]), C0, 4); \
    A_KRD(GL, 0); A_GAPB(o[0] = A_MFMA(A_PAF(1), A_VFR(1), o[0]), C0, 8);  A_KRD(GL, 1); A_GAPB(o[1] = A_MFMA(A_PAF(1), A_VFR(5), o[1]), C0, 12); \
    A_KRD(GL, 2); A_GAPB(o[0] = A_MFMA(A_PAF(2), A_VFR(2), o[0]), C1, 0);  A_KRD(GL, 3); A_GAPB(o[1] = A_MFMA(A_PAF(2), A_VFR(6), o[1]), C1, 4); \
    A_GAPB(o[0] = A_MFMA(A_PAF(3), A_VFR(3), o[0]), C1, 8);              A_GAPB(o[1] = A_MFMA(A_PAF(3), A_VFR(7), o[1]), C1, 12); \
    } while (0)
  int t = 1;
  if (MODE != 2) {
    for (; t + 5 < NT; t += 2) {
      A_STEP(pB0, pB1, pA0, pA1, t, false, true, true, true);     a_wait_bar<NK + 1>(); A_RESC(); A_ROT();
      A_STEP(pA0, pA1, pB0, pB1, t + 1, false, true, true, true); a_wait_bar<NK + 1>(); A_RESC(); A_ROT();
    }
  }
#define A_ENDW(tt) do { if ((tt) + 3 < NT) { a_wait_bar<NK + 1>(); } else if ((tt) + 2 < NT) { a_wait_bar<1>(); } else { a_wait_bar<0>(); } } while (0)
  for (; t + 1 < NT; t += 2) {
    A_STEP(pB0, pB1, pA0, pA1, t, (MODE != 2 || t < 4 || t + 4 >= NT), (t + 3 < NT), (t + 1 < NT), (t + 1 < NT));             A_ENDW(t);     A_RESC(); A_ROT();
    A_STEP(pA0, pA1, pB0, pB1, t + 1, (MODE != 2 || t + 1 < 4 || t + 5 >= NT), (t + 4 < NT), (t + 2 < NT), (t + 2 < NT));     A_ENDW(t + 1); A_RESC(); A_ROT();
  }
  A_STEP(pB0, pB1, pA0, pA1, NT - 1, true, false, false, false); A_RESC();
  { float sacc = pB0[0] + pB0[1];
#pragma unroll
    for (int r = 2; r < 16; ++r) sacc += pB0[r];
#pragma unroll
    for (int r = 0; r < 16; ++r) sacc += pB1[r];
    l_reg += sacc;
    pw0 = (a_u32x4){A_PKW(pB0, 0), A_PKW(pB0, 2), A_PKW(pB0, 4), A_PKW(pB0, 6)}; pw1 = (a_u32x4){A_PKW(pB0, 8), A_PKW(pB0, 10), A_PKW(pB0, 12), A_PKW(pB0, 14)};
    pw2 = (a_u32x4){A_PKW(pB1, 0), A_PKW(pB1, 2), A_PKW(pB1, 4), A_PKW(pB1, 6)}; pw3 = (a_u32x4){A_PKW(pB1, 8), A_PKW(pB1, 10), A_PKW(pB1, 12), A_PKW(pB1, 14)};
    const a_lds_cptr vp_ = vp0 + sl_cur; _Pragma("unroll") for (int i = 0; i < 8; ++i) A_VRD(i);
    o[0] = A_MFMA(A_PAF(0), A_VFR(0), o[0]); o[1] = A_MFMA(A_PAF(0), A_VFR(4), o[1]); o[0] = A_MFMA(A_PAF(1), A_VFR(1), o[0]); o[1] = A_MFMA(A_PAF(1), A_VFR(5), o[1]);
    o[0] = A_MFMA(A_PAF(2), A_VFR(2), o[0]); o[1] = A_MFMA(A_PAF(2), A_VFR(6), o[1]); o[0] = A_MFMA(A_PAF(3), A_VFR(3), o[0]); o[1] = A_MFMA(A_PAF(3), A_VFR(7), o[1]); }
  { auto rr = __builtin_amdgcn_permlane32_swap(__float_as_uint(l_reg), __float_as_uint(l_reg), false, false); l_reg = __uint_as_float(rr[0]) + __uint_as_float(rr[1]); }
  if (hi == 0) wsf[32 + r32] = gate / l_reg;
  asm volatile("s_waitcnt lgkmcnt(0)" ::: "memory");
  float rli[16];
#pragma unroll
  for (int r = 0; r < 16; ++r) rli[r] = wsf[32 + a_crow(r, hi)];
#pragma unroll
  for (int r = 0; r < 16; ++r) { const int orow = a_crow(r, hi);
#pragma unroll
    for (int d0 = 0; d0 < 2; ++d0) stg[orow * 64 + d0 * 32 + r32] = f2bf(o[d0][r] * rli[r]); }
  asm volatile("s_waitcnt lgkmcnt(0)\n\ts_barrier" ::: "memory");
#undef A_DMA_K
#undef A_DMA_V
#undef A_ROT
#undef A_EX
#undef A_RESC
#undef A_PKW
#undef A_PAF
#undef A_VFR
#undef A_VRD
#undef A_KRD
#undef A_ENDW
#undef A_GAPA
#undef A_GAPB
#undef A_STEP
}

__device__ void pc2_phase(const Params& P, int layer, int chunk, char* smem, int* s_item, const int which) {
  const int perq = P.NB * 16;
  const int nCmp = which ? 0 : P.NB * 2;
  const int nItems = nCmp + 8 * perq;
  unsigned* ctr = P.ctr + (chunk * 4 + layer) + which * 16;
  while (true) {
    const int tid = opaque_tid(), lane = tid & 63, r32 = lane & 31, w = tid >> 6;
    __syncthreads();
    if (tid == 0) *s_item = (int)atomicAdd(ctr, 1u);
    __syncthreads();
    const int it0 = *s_item;
    if (it0 >= nItems) break;
    if (it0 < nCmp) { compress_item(P, layer, it0, smem, tid); continue; }
    const int it = it0 - nCmp;
    const int qt = 7 - it / perq;
    const int bh = it % perq;
    const int type = which;
    const int bl = bh >> 4, head = bh & 15;
    const int q0w = qt * 256 + w * 32;
    const int qabs = q0w + r32;
    const size_t rowq = (size_t)bl * TSEQ + qabs;
    const size_t roww = (size_t)bl * TSEQ + q0w;
    const u16* pb_ = P.proj + (size_t)bl * TSEQ * INC;
    u16* stg = (u16*)(smem + A_LDS_OST) + w * 4096;
    const int er = lane >> 3, ec = (lane & 7) * 8;
    if (type == 0) {
      a_unit<0>(pb_ + roww * 0 + (size_t)q0w * INC + C_QB + head * 64, INC, pb_ + C_KB + head * 64, pb_ + C_VB + head * 64,
                P.F2 + (size_t)(bl * 16 + head) * TSEQ, 4 * qt + 4, 0, qabs, 0u, 1.0f, smem, stg, tid);
#pragma unroll
      for (int i = 0; i < 4; i++) {
        const int row = i * 8 + er;
        const uint4 ov = *(const uint4*)(stg + row * 64 + ec);
        const uint4 zz = *(const uint4*)(pb_ + (size_t)(q0w + row) * INC + C_ZB + head * 64 + ec);
        uint4 y;
        y.x = pk2(bflo(ov.x) * siluf_(bflo(zz.x)), bfhi(ov.x) * siluf_(bfhi(zz.x)));
        y.y = pk2(bflo(ov.y) * siluf_(bflo(zz.y)), bfhi(ov.y) * siluf_(bfhi(zz.y)));
        y.z = pk2(bflo(ov.z) * siluf_(bflo(zz.z)), bfhi(ov.z) * siluf_(bfhi(zz.z)));
        y.w = pk2(bflo(ov.w) * siluf_(bflo(zz.w)), bfhi(ov.w) * siluf_(bfhi(zz.w)));
        *(uint4*)(P.yb + (roww + row) * DM + head * 64 + ec) = y;
      }
    } else {
      const int g = head >> 3;
      const unsigned selm = P.sel[(size_t)(bl * 2 + g) * TSEQ + qabs];
      const float g1 = sigmoidf_(bf2f(P.proj[rowq * INC + C_GA + 16 + head]));
      const float g2 = sigmoidf_(bf2f(P.proj[rowq * INC + C_GA + 32 + head]));
      const u16* qw = P.qr + roww * DM + head * 64;
      a_unit<1>(qw, DM, pb_ + C_KV + 256 + g * 64, pb_ + C_KV + 384 + g * 64, nullptr, 4 * qt + 4, 0, qabs, selm, g1, smem, stg, tid);
      const int klo = (4 * qt - 8) > 0 ? (4 * qt - 8) : 0;
      a_unit<2>(qw, DM, pb_ + (size_t)(klo * 64) * INC + C_KV + 512 + g * 64, pb_ + (size_t)(klo * 64) * INC + C_KV + 640 + g * 64, nullptr,
                4 * qt + 4 - klo, klo * 64, qabs, 0u, g2, smem, stg + 2048, tid);
#pragma unroll
      for (int i = 0; i < 4; i++) {
        const int row = i * 8 + er;
        const uint4 o1 = *(const uint4*)(stg + row * 64 + ec);
        const uint4 o2 = *(const uint4*)(stg + 2048 + row * 64 + ec);
        const uint4 zz = *(const uint4*)(pb_ + (size_t)(q0w + row) * INC + C_ZA + head * 64 + ec);
        u16* yp = P.ya + (roww + row) * DM + head * 64 + ec;
        const uint4 oc = *(const uint4*)yp;
        uint4 y;
        y.x = pk2((bflo(o1.x) + bflo(o2.x) + bflo(oc.x)) * siluf_(bflo(zz.x)), (bfhi(o1.x) + bfhi(o2.x) + bfhi(oc.x)) * siluf_(bfhi(zz.x)));
        y.y = pk2((bflo(o1.y) + bflo(o2.y) + bflo(oc.y)) * siluf_(bflo(zz.y)), (bfhi(o1.y) + bfhi(o2.y) + bfhi(oc.y)) * siluf_(bfhi(zz.y)));
        y.z = pk2((bflo(o1.z) + bflo(o2.z) + bflo(oc.z)) * siluf_(bflo(zz.z)), (bfhi(o1.z) + bfhi(o2.z) + bfhi(oc.z)) * siluf_(bfhi(zz.z)));
        y.w = pk2((bflo(o1.w) + bflo(o2.w) + bflo(oc.w)) * siluf_(bflo(zz.w)), (bfhi(o1.w) + bfhi(o2.w) + bfhi(oc.w)) * siluf_(bfhi(zz.w)));
        *(uint4*)yp = y;
      }
    }
  }
}

#define XB_XCNT(j) (64 * (j))
#define XB_XSUB(j) (1024 + 64 * (j))
#define XB_XGEN(j) (2048 + 64 * (j))
#define XB_TOP 3072
#define XB_TOPGEN 3136
#define XB_LDS_OFF 150000
__device__ __forceinline__ unsigned xb_ld(unsigned* p) { return __hip_atomic_load(p, __ATOMIC_RELAXED, __HIP_MEMORY_SCOPE_AGENT); }
__device__ __forceinline__ unsigned xb_add(unsigned* p, unsigned v) { return __hip_atomic_fetch_add(p, v, __ATOMIC_RELAXED, __HIP_MEMORY_SCOPE_AGENT); }
__device__ __forceinline__ unsigned xb_xcc_id() { return (unsigned)__builtin_amdgcn_s_getreg((3 << 11) | 20) & 0xFu; }
__device__ __forceinline__ void grid_bar(unsigned* bar, char* smem) {
  asm volatile("s_waitcnt vmcnt(0) lgkmcnt(0)" ::: "memory");
  __syncthreads();
  if (threadIdx.x == 0) {
    volatile unsigned* st = (volatile unsigned*)(smem + XB_LDS_OFF);
    const unsigned nloc = st[0], nx = st[1], x = st[2];
    const unsigned old = xb_add(&bar[XB_XSUB(x)], 1u);
    const unsigned gen = old / nloc;
    if (old + 1u == (gen + 1u) * nloc) {
      __builtin_amdgcn_fence(__ATOMIC_RELEASE, "agent");
      asm volatile("s_waitcnt vmcnt(0)" ::: "memory");
      const unsigned og = xb_add(&bar[XB_TOP], 1u);
      const unsigned tg = og / nx;
      if (og + 1u == (tg + 1u) * nx) xb_add(&bar[XB_TOPGEN], 1u);
      else { while (xb_ld(&bar[XB_TOPGEN]) == tg) __builtin_amdgcn_s_sleep(1); }
      __builtin_amdgcn_fence(__ATOMIC_ACQUIRE, "agent");
      xb_add(&bar[XB_XGEN(x)], 1u);
      asm volatile("s_waitcnt vmcnt(0)" ::: "memory");
    } else {
      while (xb_ld(&bar[XB_XGEN(x)]) == gen) __builtin_amdgcn_s_sleep(1);
      __builtin_amdgcn_fence(__ATOMIC_ACQUIRE, "agent");
      asm volatile("s_waitcnt vmcnt(0)" ::: "memory");
    }
  }
  __syncthreads();
}

__global__ void __launch_bounds__(NTHREADS, 2) mega_kernel(Params P) {
  __shared__ __attribute__((aligned(1024))) char smem[163840];
  cg::grid_group grid = cg::this_grid();
  const int CT = P.NB * TSEQ;
  phase0(P, smem);
  grid.sync();
  if (threadIdx.x == 0) (void)xb_add(&P.xbar[XB_XCNT(xb_xcc_id())], 1u);
  grid.sync();
  if (threadIdx.x == 0) {
    unsigned cnt = 0u, mine = 0u; const unsigned x = xb_xcc_id();
#pragma unroll 1
    for (unsigned j = 0; j < 16; ++j) { const unsigned c = xb_ld(&P.xbar[XB_XCNT(j)]); cnt += (c > 0u) ? 1u : 0u; mine = (j == x) ? c : mine; }
    volatile unsigned* st = (volatile unsigned*)(smem + XB_LDS_OFF);
    st[0] = mine > 0u ? mine : 1u; st[1] = cnt > 0u ? cnt : 1u; st[2] = x;
  }
  __syncthreads();
  for (int chunk = 0; chunk < P.nchunk; chunk++) {
    for (int layer = 0; layer < 4; layer++) {
      const float* xs = (layer == 0 ? P.x_in : P.out) + (size_t)chunk * CT * DM;
      norm_phase(xs, P.norm_g + layer * DM, P.h, CT);
      if (layer == 0 && chunk > 0) final_norm_phase(P.out, P.final_g, (chunk - 1) * CT, CT);
      grid_bar(P.xbar, smem);
      gemm1_phase(P, layer, smem);
      grid_bar(P.xbar, smem);
      pb_phase(P, layer, smem);
      grid_bar(P.xbar, smem);
      pc2_phase(P, layer, chunk, smem, (int*)(smem + 140000), 0);
      grid_bar(P.xbar, smem);
      pc1_phase(P, smem);
      grid_bar(P.xbar, smem);
      pc2_phase(P, layer, chunk, smem, (int*)(smem + 140000), 1);
      grid_bar(P.xbar, smem);
      gemm2_phase(P, layer, smem);
      grid_bar(P.xbar, smem);
      gemm3_phase(P, layer, chunk, smem);
      grid_bar(P.xbar, smem);
    }
  }
  final_norm_phase(P.out, P.final_g, (P.nchunk - 1) * CT, CT);
}

static inline size_t al256(size_t x) { return (x + 255) & ~(size_t)255; }

extern "C" void kernel_launch(void* const* d_in, const int* in_sizes, int n_in, void* d_out, int out_size,
                              void* d_ws, size_t ws_size, hipStream_t stream) {
  (void)in_sizes; (void)n_in; (void)out_size;
  Params P{};
  P.x_in = (const float*)d_in[0]; P.norm_g = (const float*)d_in[1]; P.w_in = (const float*)d_in[2];
  P.b_forget = (const float*)d_in[3];
  P.pe_k = (const float*)d_in[4]; P.w1_k = (const float*)d_in[5]; P.w2_k = (const float*)d_in[6];
  P.pe_v = (const float*)d_in[7]; P.w1_v = (const float*)d_in[8]; P.w2_v = (const float*)d_in[9];
  P.w_pa = (const float*)d_in[10]; P.w_pb = (const float*)d_in[11]; P.w_out = (const float*)d_in[12];
  P.final_g = (const float*)d_in[13];
  P.out = (float*)d_out;
  int NB = 16;
  char* base = (char*)d_ws;
  for (;;) {
    const size_t CT = (size_t)NB * TSEQ;
    size_t off = 0;
    auto take = [&](size_t bytes) { size_t o = off; off = al256(off + bytes); return o; };
    size_t oWin = take((size_t)4 * INCP * DM * 2), oWpa = take((size_t)4 * DM * DM * 2), oWpb = take((size_t)4 * DM * DM * 2),
           oWo = take((size_t)4 * DM * DM * 2), oW1 = take((size_t)8 * 128 * 2048 * 2), oW2 = take((size_t)8 * 64 * 128 * 2),
           oB1 = take((size_t)64 * 128 * 4), oRc = take((size_t)TSEQ * 32 * 4), oRs = take((size_t)TSEQ * 32 * 4),
           oH = take(CT * DM * 2), oProj = take(CT * INC * 2 + 4096), oVbt = take(CT * DM * 2),
           oVst = take(CT * 128 * 2), oVwt = take(CT * 128 * 2), oFl = take(CT * 16 * 4), oF2 = take(CT * 16 * 4),
           oKc = take((size_t)NB * 2 * 128 * 64 * 2), oVc = take((size_t)NB * 2 * 64 * 128 * 2), oSel = take(CT * 2 * 4),
           oYa = take(CT * DM * 2), oYb = take(CT * DM * 2), oCtr = take(256), oXb = take(XB_WORDS * 4);
    if (off > ws_size && NB > 1) { NB >>= 1; continue; }
    P.WinT = (u16*)(base + oWin); P.WpaT = (u16*)(base + oWpa); P.WpbT = (u16*)(base + oWpb); P.WoT = (u16*)(base + oWo);
    P.W1T = (u16*)(base + oW1); P.W2T = (u16*)(base + oW2); P.bias1p = (float*)(base + oB1);
    P.ropec = (float*)(base + oRc); P.ropes = (float*)(base + oRs);
    P.h = (u16*)(base + oH); P.proj = (u16*)(base + oProj); P.qr = (u16*)(base + oVbt);
    P.vst = (u16*)(base + oVst); P.vwt = (u16*)(base + oVwt); P.flog = (float*)(base + oFl); P.F2 = (float*)(base + oF2);
    P.kcmp = (u16*)(base + oKc); P.vcmpt = (u16*)(base + oVc); P.sel = (unsigned*)(base + oSel);
    P.ya = (u16*)(base + oYa); P.yb = (u16*)(base + oYb); P.ctr = (unsigned*)(base + oCtr); P.xbar = (unsigned*)(base + oXb);
    break;
  }
  P.NB = NB; P.nchunk = 32 / NB;
  static int grid_blocks = 0;
  if (!grid_blocks) {
    int dev = 0, cus = 0, per_cu = 0;
    hipGetDevice(&dev);
    hipDeviceGetAttribute(&cus, hipDeviceAttributeMultiprocessorCount, dev);
    hipOccupancyMaxActiveBlocksPerMultiprocessor(&per_cu, mega_kernel, NTHREADS, 0);
    if (per_cu > 1) per_cu = 1;
    if (per_cu < 1) per_cu = 1;
    grid_blocks = cus * per_cu;
  }
  void* args[] = {&P};
  hipError_t e = hipLaunchCooperativeKernel((void*)mega_kernel, dim3(grid_blocks), dim3(NTHREADS), args, 0, stream);
  if (e != hipSuccess) fprintf(stderr, "cooperative launch failed: %s (grid %d)\n", hipGetErrorString(e), grid_blocks);
}
```

```cpp
#include <hip/hip_runtime.h>
#include <hip/hip_cooperative_groups.h>
#include <cstdio>
namespace cg = cooperative_groups;

typedef __attribute__((ext_vector_type(8))) __bf16 bf16x8;
typedef __attribute__((ext_vector_type(16))) float f32x16;
typedef __attribute__((ext_vector_type(4))) float f32x4;
typedef __attribute__((ext_vector_type(2))) float f32x2;
typedef unsigned short u16;

#define TSEQ 2048
#define DM 1024
#define INC 9024
#define INCP 9216
#define C_QA 0
#define C_KV 1024
#define C_GA 1792
#define C_ZA 1840
#define C_QB 2864
#define C_KB 3888
#define C_VB 4912
#define C_QR 4912
#define C_FB 5936
#define C_ZB 5952
#define C_RA 6976
#define C_RB 8000
#define NTHREADS 512
#define ATT_STAGE 33280
#define LOG2E 1.4426950408889634f
#define XB_WORDS 3200
#define XB_LDS_OFF 150000

struct Params {
  const float* x_in; const float* norm_g; const float* w_in; const float* b_forget;
  const float* pe_k; const float* w1_k; const float* w2_k;
  const float* pe_v; const float* w1_v; const float* w2_v;
  const float* w_pa; const float* w_pb; const float* w_out; const float* final_g;
  float* out;
  u16* WinT; u16* WpaT; u16* WpbT; u16* WoT; u16* W1T; u16* W2T;
  float* bias1p; float* ropec; float* ropes;
  u16* h; u16* proj; u16* qr; u16* vst; u16* vwt;
  float* flog; float* F2; u16* kcmp; u16* vcmpt; unsigned* sel;
  u16* ya; u16* yb; unsigned* ctr; unsigned* xbar;
  int NB; int nchunk;
};

__device__ __forceinline__ unsigned pk2(float a, float b) {
  typedef __attribute__((ext_vector_type(2))) float f2_t;
  typedef __attribute__((ext_vector_type(2))) __bf16 b2_t;
  f2_t v = {a, b};
  b2_t r = __builtin_convertvector(v, b2_t);
  return __builtin_bit_cast(unsigned, r);
}
__device__ __forceinline__ u16 f2bf(float a) { return (u16)(pk2(a, 0.f) & 0xffffu); }
__device__ __forceinline__ float bf2f(u16 u) { return __uint_as_float(((unsigned)u) << 16); }
__device__ __forceinline__ float bflo(unsigned u) { return __uint_as_float(u << 16); }
__device__ __forceinline__ float bfhi(unsigned u) { return __uint_as_float(u & 0xffff0000u); }
__device__ __forceinline__ float sigmoidf_(float x) { return 1.f / (1.f + __expf(-x)); }
__device__ __forceinline__ float siluf_(float x) { return x / (1.f + __expf(-x)); }
__device__ __forceinline__ f32x16 mfma32(bf16x8 a, bf16x8 b, f32x16 c) {
  return __builtin_amdgcn_mfma_f32_32x32x16_bf16(a, b, c, 0, 0, 0);
}
__device__ __forceinline__ int opaque_tid() { int t = threadIdx.x; asm volatile("" : "+v"(t)); return t; }
__device__ __forceinline__ bf16x8 ldfrag(const void* p) {
  return __builtin_bit_cast(bf16x8, *(const uint4*)p);
}

__device__ void transpose_tile(const float* __restrict__ src, u16* __restrict__ dst, int K, int N,
                               int k0, int n0, float* tile, const int tid) {
#pragma unroll
  for (int j = 0; j < 2; j++) {
    int r = (tid >> 4) + 32 * j, c4 = (tid & 15) * 4;
    float4 v = *(const float4*)(src + (size_t)(k0 + r) * N + n0 + c4);
    tile[r * 65 + c4] = v.x; tile[r * 65 + c4 + 1] = v.y; tile[r * 65 + c4 + 2] = v.z; tile[r * 65 + c4 + 3] = v.w;
  }
  __syncthreads();
  {
    int c = tid, n = c >> 3, kc = c & 7;
    const float* tp = tile + (kc * 8) * 65 + n;
    uint4 o;
    o.x = pk2(tp[0], tp[65]); o.y = pk2(tp[130], tp[195]); o.z = pk2(tp[260], tp[325]); o.w = pk2(tp[390], tp[455]);
    *(uint4*)(dst + (size_t)(n0 + n) * K + k0 + kc * 8) = o;
  }
  __syncthreads();
}

__device__ void phase0(const Params& P, char* smem) {
  const int tid = opaque_tid();
  float* tile = (float*)smem;
  const int n0_ = 4 * 16 * 141, n1_ = 4 * 16 * 16, n2_ = 4 * 32 * 2, n3_ = 4 * 2 * 1;
  const int nT = n0_ + 3 * n1_ + 2 * n2_ + 2 * n3_;
  const int nBias = 64, nRope = 128;
  const int total = nT + nBias + nRope + 1;
  for (int it = blockIdx.x; it < total; it += gridDim.x) {
    if (it < nT) {
      int t = it;
      if (t < n0_) {
        int l = t / (16 * 141), rem = t % (16 * 141);
        transpose_tile(P.w_in + (size_t)l * DM * INC, P.WinT + (size_t)l * INCP * DM, DM, INC, (rem / 141) * 64, (rem % 141) * 64, tile, tid);
        continue;
      }
      t -= n0_;
      if (t < 3 * n1_) {
        int which = t / n1_; t %= n1_;
        int l = t / 256, rem = t % 256;
        const float* s = which == 0 ? P.w_pa : (which == 1 ? P.w_pb : P.w_out);
        u16* d = which == 0 ? P.WpaT : (which == 1 ? P.WpbT : P.WoT);
        transpose_tile(s + (size_t)l * DM * DM, d + (size_t)l * DM * DM, DM, DM, (rem >> 4) * 64, (rem & 15) * 64, tile, tid);
        continue;
      }
      t -= 3 * n1_;
      if (t < 2 * n2_) {
        int kv = t / n2_; t %= n2_;
        int l = t / 64, rem = t % 64;
        const float* s = kv ? P.w1_v : P.w1_k;
        transpose_tile(s + (size_t)l * 2048 * 128, P.W1T + (size_t)(l * 2 + kv) * 128 * 2048, 2048, 128, (rem >> 1) * 64, (rem & 1) * 64, tile, tid);
        continue;
      }
      t -= 2 * n2_;
      {
        int kv = t / n3_; t %= n3_;
        int l = t / 2, rem = t % 2;
        const float* s = kv ? P.w2_v : P.w2_k;
        transpose_tile(s + (size_t)l * 128 * 64, P.W2T + (size_t)(l * 2 + kv) * 64 * 128, 128, 64, rem * 64, 0, tile, tid);
      }
    } else if (it < nT + nBias) {
      int j = it - nT;
      int l = j >> 4, kv = (j >> 3) & 1, kq = j & 7;
      const float* pe = (kv ? P.pe_v : P.pe_k) + (size_t)l * 2048;
      const float* w1 = (kv ? P.w1_v : P.w1_k) + (size_t)l * 2048 * 128;
      int hid = tid & 127, kh = tid >> 7;
      int kbeg = kq * 256 + kh * 64;
      float s = 0.f;
#pragma unroll 8
      for (int k = 0; k < 64; k++) s += pe[kbeg + k] * w1[(size_t)(kbeg + k) * 128 + hid];
      float* part = (float*)smem;
      part[tid] = s;
      __syncthreads();
      if (tid < 128) P.bias1p[((l * 2 + kv) * 8 + kq) * 128 + hid] = (part[tid] + part[tid + 128]) + (part[tid + 256] + part[tid + 384]);
      __syncthreads();
    } else if (it < nT + nBias + nRope) {
      int idx = (it - nT - nBias) * 512 + tid;
      int t = idx >> 5, j = idx & 31;
      double inv = 1.0;
      for (int q = 0; q < j; q++) inv *= 0.7498942093324558;
      float invf = (float)inv;
      float angf = (float)t * invf;
      double a = (double)angf;
      double kq = rint(a * 0.15915494309189535);
      double rr = a - kq * 6.283185307179586;
      double r2 = rr * rr;
      double sterm = rr, cterm = 1.0, ssum = rr, csum = 1.0;
#pragma unroll 1
      for (int n = 1; n <= 15; n++) {
        cterm *= -r2 / (double)((2 * n - 1) * (2 * n));
        sterm *= -r2 / (double)((2 * n) * (2 * n + 1));
        csum += cterm; ssum += sterm;
      }
      P.ropec[idx] = (float)csum;
      P.ropes[idx] = (float)ssum;
    } else {
      if (tid < 256) P.ctr[tid] = 0u;
      for (int i = tid; i < XB_WORDS; i += NTHREADS) P.xbar[i] = 0u;
    }
  }
}

__device__ void norm_phase(const float* __restrict__ xsrc, const float* __restrict__ g, u16* __restrict__ hdst, int nrows) {
  const int tid = opaque_tid();
  const int lane = tid & 63;
  const int gw = blockIdx.x * 8 + (tid >> 6), nw = gridDim.x * 8;
  float4 gv[4];
#pragma unroll
  for (int j = 0; j < 4; j++) gv[j] = *(const float4*)(g + lane * 4 + 256 * j);
  for (int row = gw; row < nrows; row += nw) {
    const float* xr = xsrc + (size_t)row * DM;
    float4 v[4];
    float ss = 0.f;
#pragma unroll
    for (int j = 0; j < 4; j++) {
      v[j] = *(const float4*)(xr + lane * 4 + 256 * j);
      ss += v[j].x * v[j].x + v[j].y * v[j].y + v[j].z * v[j].z + v[j].w * v[j].w;
    }
#pragma unroll
    for (int o = 32; o >= 1; o >>= 1) ss += __shfl_xor(ss, o);
    float rstd = rsqrtf(ss * (1.f / DM) + 1e-6f);
#pragma unroll
    for (int j = 0; j < 4; j++) {
      uint2 o;
      o.x = pk2(v[j].x * rstd * gv[j].x, v[j].y * rstd * gv[j].y);
      o.y = pk2(v[j].z * rstd * gv[j].z, v[j].w * rstd * gv[j].w);
      *(uint2*)(hdst + (size_t)row * DM + lane * 4 + 256 * j) = o;
    }
  }
}

__device__ void final_norm_phase(float* __restrict__ x, const float* __restrict__ g, int row0, int nrows) {
  const int tid = opaque_tid();
  const int lane = tid & 63;
  const int gw = blockIdx.x * 8 + (tid >> 6), nw = gridDim.x * 8;
  float4 gv[4];
#pragma unroll
  for (int j = 0; j < 4; j++) gv[j] = *(const float4*)(g + lane * 4 + 256 * j);
  for (int row = gw; row < nrows; row += nw) {
    float* xr = x + (size_t)(row0 + row) * DM;
    float4 v[4];
    float ss = 0.f;
#pragma unroll
    for (int j = 0; j < 4; j++) {
      v[j] = *(const float4*)(xr + lane * 4 + 256 * j);
      ss += v[j].x * v[j].x + v[j].y * v[j].y + v[j].z * v[j].z + v[j].w * v[j].w;
    }
#pragma unroll
    for (int o = 32; o >= 1; o >>= 1) ss += __shfl_xor(ss, o);
    float rstd = rsqrtf(ss * (1.f / DM) + 1e-6f);
#pragma unroll
    for (int j = 0; j < 4; j++) {
      float4 o;
      o.x = v[j].x * rstd * gv[j].x; o.y = v[j].y * rstd * gv[j].y;
      o.z = v[j].z * rstd * gv[j].z; o.w = v[j].w * rstd * gv[j].w;
      *(float4*)(xr + lane * 4 + 256 * j) = o;
    }
  }
}

struct ARow {
  const u16* p; int ld;
  __device__ __forceinline__ const u16* operator()(int row, int k) const { return p + (size_t)row * ld + k; }
};
struct ACmp {
  const u16* p;
  __device__ __forceinline__ const u16* operator()(int row, int k) const {
    int t = 16 * row + (k >> 6); t = t > (TSEQ - 1) ? (TSEQ - 1) : t;
    return p + (size_t)t * INC + (k & 63);
  }
};

template <class AF>
__device__ __forceinline__ void gemm_mainloop(AF af, const u16* __restrict__ Bt, int ldb, int K, char* smem,
                                              f32x16 (&acc)[2][2], const int tid) {
  const int lane = tid & 63, r = lane & 31, h = lane >> 5, w = tid >> 6;
  const int wm = w >> 1, wn = w & 1;
  const int lrow = tid >> 3, lch = tid & 7;
  uint4 ra[4], rb[4];
  const int nk = K >> 6;
#pragma unroll
  for (int j = 0; j < 4; j++) {
    int row = lrow + 32 * j;
    ra[j] = *(const uint4*)af(row, lch * 8);
    rb[j] = *(const uint4*)(Bt + (size_t)row * ldb + lch * 8);
  }
#pragma unroll
  for (int j = 0; j < 4; j++) {
    int row = lrow + 32 * j;
    int off = row * 128 + ((lch ^ ((row >> 1) & 7)) << 4);
    *(uint4*)(smem + off) = ra[j];
    *(uint4*)(smem + 16384 + off) = rb[j];
  }
  __syncthreads();
  for (int it = 0; it < nk; it++) {
    const bool more = (it + 1) < nk;
    if (more) {
      const int k0 = (it + 1) * 64;
#pragma unroll
      for (int j = 0; j < 4; j++) {
        int row = lrow + 32 * j;
        ra[j] = *(const uint4*)af(row, k0 + lch * 8);
        rb[j] = *(const uint4*)(Bt + (size_t)row * ldb + k0 + lch * 8);
      }
    }
    const char* sa = smem + (it & 1) * 32768;
    const char* sb = sa + 16384;
#pragma unroll
    for (int kk = 0; kk < 4; kk++) {
      bf16x8 a[2], b[2];
#pragma unroll
      for (int mi = 0; mi < 2; mi++) {
        int row = wm * 64 + mi * 32 + r;
        a[mi] = ldfrag(sa + row * 128 + (((kk * 2 + h) ^ ((row >> 1) & 7)) << 4));
      }
#pragma unroll
      for (int ni = 0; ni < 2; ni++) {
        int row = wn * 64 + ni * 32 + r;
        b[ni] = ldfrag(sb + row * 128 + (((kk * 2 + h) ^ ((row >> 1) & 7)) << 4));
      }
#pragma unroll
      for (int mi = 0; mi < 2; mi++)
#pragma unroll
        for (int ni = 0; ni < 2; ni++) acc[mi][ni] = mfma32(a[mi], b[ni], acc[mi][ni]);
    }
    if (more) {
      char* sd = smem + ((it + 1) & 1) * 32768;
#pragma unroll
      for (int j = 0; j < 4; j++) {
        int row = lrow + 32 * j;
        int off = row * 128 + ((lch ^ ((row >> 1) & 7)) << 4);
        *(uint4*)(sd + off) = ra[j];
        *(uint4*)(sd + 16384 + off) = rb[j];
      }
    }
    __syncthreads();
  }
}

__device__ __forceinline__ void zero_acc(f32x16 (&acc)[2][2]) {
#pragma unroll
  for (int a = 0; a < 2; a++)
#pragma unroll
    for (int b = 0; b < 2; b++)
#pragma unroll
      for (int i = 0; i < 16; i++) acc[a][b][i] = 0.f;
}

typedef __attribute__((ext_vector_type(8))) short s16x8;
#define G_TILE_B 32768
#define G_STAGE_B 65536
__device__ __forceinline__ int g_lds_byte(int r, int c) {
  int st = (r >> 4) * 2 + (c >> 5), ob = (r & 15) * 64 + (c & 31) * 2;
  return st * 1024 + (ob ^ (((ob >> 9) & 1) << 5));
}
__device__ __forceinline__ void g_stage_rc(int b, int& R, int& C) {
  int st = b >> 10, sb = b & 1023, swz = sb ^ (((sb >> 9) & 1) << 5);
  R = (st >> 1) * 16 + swz / 64;
  C = (st & 1) * 32 + (swz % 64) / 2;
}
#define G_WAIT_V0() asm volatile("s_waitcnt vmcnt(0)" ::: "memory")

struct GTile { int pm, pn; };
__device__ __forceinline__ bool g_next(int i, int G, int c, int nM, int nN, GTile& u) {
  const int nwg = nM * nN;
  const int L = i * G + c;
  if (L >= nwg) return false;
  int wgid = L;
  { const int q = nwg / 8, r = nwg % 8, xcd = wgid % 8, off = wgid / 8; wgid = (xcd < r ? xcd * (q + 1) : r * (q + 1) + (xcd - r) * q) + off; }
  const int nig = 8 * nN, gid = wgid / nig, fm = gid * 8, gsz = (nM - fm) < 8 ? (nM - fm) : 8;
  u.pm = fm + ((wgid % nig) % gsz);
  u.pn = (wgid % nig) / gsz;
  return true;
}

__device__ __forceinline__ void g_kloop(const u16* __restrict__ Ab, const u16* __restrict__ Bb, const int K, char* smem,
                                        f32x4 (&acc)[8][4], const int tid, const bool pre, const u16* __restrict__ nA,
                                        const u16* __restrict__ nB, const bool has_next) {
  const int wid = tid >> 6, lane = tid & 63, wr = wid >> 2, wc = wid & 3, fr = lane & 15, fq = lane >> 4;
  int sR0, sC0, sR1, sC1, sR2, sC2, sR3, sC3;
  g_stage_rc(wid * 1024 + 0 * 8192 + lane * 16, sR0, sC0);
  g_stage_rc(wid * 1024 + 1 * 8192 + lane * 16, sR1, sC1);
  g_stage_rc(wid * 1024 + 2 * 8192 + lane * 16, sR2, sC2);
  g_stage_rc(wid * 1024 + 3 * 8192 + lane * 16, sR3, sC3);
  const long o0 = (long)sR0 * K + sC0, o1 = (long)sR1 * K + sC1, o2 = (long)sR2 * K + sC2, o3 = (long)sR3 * K + sC3;
#define G_STAGE(buf, kt)                                                                                              \
  {                                                                                                                  \
    char* sa_ = smem + (buf) * G_STAGE_B + wid * 1024;                                                               \
    char* sb_ = sa_ + G_TILE_B;                                                                                      \
    const u16* ga_ = Ab + (kt) * 64;                                                                                 \
    const u16* gb_ = Bb + (kt) * 64;                                                                                 \
    __builtin_amdgcn_global_load_lds((const unsigned*)(ga_ + o0), (unsigned*)(sa_), 16, 0, 0);                       \
    __builtin_amdgcn_global_load_lds((const unsigned*)(gb_ + o0), (unsigned*)(sb_), 16, 0, 0);                       \
    __builtin_amdgcn_global_load_lds((const unsigned*)(ga_ + o1), (unsigned*)(sa_ + 8192), 16, 0, 0);                \
    __builtin_amdgcn_global_load_lds((const unsigned*)(gb_ + o1), (unsigned*)(sb_ + 8192), 16, 0, 0);                \
    __builtin_amdgcn_global_load_lds((const unsigned*)(ga_ + o2), (unsigned*)(sa_ + 16384), 16, 0, 0);               \
    __builtin_amdgcn_global_load_lds((const unsigned*)(gb_ + o2), (unsigned*)(sb_ + 16384), 16, 0, 0);               \
    __builtin_amdgcn_global_load_lds((const unsigned*)(ga_ + o3), (unsigned*)(sa_ + 24576), 16, 0, 0);               \
    __builtin_amdgcn_global_load_lds((const unsigned*)(gb_ + o3), (unsigned*)(sb_ + 24576), 16, 0, 0);               \
  }
  const int nt = K >> 6;
  if (!pre) {
    G_STAGE(0, 0);
    G_WAIT_V0();
    __syncthreads();
  }
  for (int t = 0; t < nt; ++t) {
    const int cur = t & 1;
    if (t + 1 < nt) G_STAGE(cur ^ 1, t + 1)
    else if (has_next) {
      char* sa_ = smem + wid * 1024;
      char* sb_ = sa_ + G_TILE_B;
      __builtin_amdgcn_global_load_lds((const unsigned*)(nA + o0), (unsigned*)(sa_), 16, 0, 0);
      __builtin_amdgcn_global_load_lds((const unsigned*)(nB + o0), (unsigned*)(sb_), 16, 0, 0);
      __builtin_amdgcn_global_load_lds((const unsigned*)(nA + o1), (unsigned*)(sa_ + 8192), 16, 0, 0);
      __builtin_amdgcn_global_load_lds((const unsigned*)(nB + o1), (unsigned*)(sb_ + 8192), 16, 0, 0);
      __builtin_amdgcn_global_load_lds((const unsigned*)(nA + o2), (unsigned*)(sa_ + 16384), 16, 0, 0);
      __builtin_amdgcn_global_load_lds((const unsigned*)(nB + o2), (unsigned*)(sb_ + 16384), 16, 0, 0);
      __builtin_amdgcn_global_load_lds((const unsigned*)(nA + o3), (unsigned*)(sa_ + 24576), 16, 0, 0);
      __builtin_amdgcn_global_load_lds((const unsigned*)(nB + o3), (unsigned*)(sb_ + 24576), 16, 0, 0);
    }
    const char* sa = smem + cur * G_STAGE_B;
    const char* sb = sa + G_TILE_B;
#pragma unroll
    for (int ks = 0; ks < 2; ++ks) {
      s16x8 At[8], Bf[4];
#pragma unroll
      for (int m = 0; m < 8; ++m) At[m] = *(const s16x8*)(sa + g_lds_byte(wr * 128 + m * 16 + fr, ks * 32 + fq * 8));
#pragma unroll
      for (int n = 0; n < 4; ++n) Bf[n] = *(const s16x8*)(sb + g_lds_byte(wc * 64 + n * 16 + fr, ks * 32 + fq * 8));
#pragma unroll
      for (int m = 0; m < 8; ++m)
#pragma unroll
        for (int n = 0; n < 4; ++n)
          acc[m][n] = __builtin_amdgcn_mfma_f32_16x16x32_bf16(__builtin_bit_cast(bf16x8, Bf[n]), __builtin_bit_cast(bf16x8, At[m]), acc[m][n], 0, 0, 0);
      __builtin_amdgcn_sched_barrier(0);
    }
    G_WAIT_V0();
    __syncthreads();
  }
}

__device__ __forceinline__ void g_zero(f32x4 (&acc)[8][4]) {
#pragma unroll
  for (int m = 0; m < 8; m++)
#pragma unroll
    for (int n = 0; n < 4; n++) acc[m][n] = (f32x4){0.f, 0.f, 0.f, 0.f};
}
__device__ __forceinline__ uint2 pk4(f32x4 v) { return make_uint2(pk2(v[0], v[1]), pk2(v[2], v[3])); }

__device__ __forceinline__ void wave_store_rows(char* wsm, u16* gbase, const size_t ld, const f32x4 (&acc)[8][4], const int lane) {
  const int fr = lane & 15, fq = lane >> 4;
  const int rr = lane >> 3, ch = lane & 7;
  typedef __attribute__((ext_vector_type(4))) unsigned u32x4_t;
#pragma unroll
  for (int hf = 0; hf < 2; hf++) {
#pragma unroll
    for (int m = 0; m < 4; m++)
#pragma unroll
      for (int n = 0; n < 4; n++) {
        const int row = m * 16 + fr, chunk = n * 2 + (fq >> 1);
        *(uint2*)(wsm + row * 128 + ((chunk ^ (fr & 7)) << 4) + (fq & 1) * 8) = pk4(acc[hf * 4 + m][n]);
      }
#pragma unroll
    for (int i = 0; i < 8; i++) {
      const int row = i * 8 + rr;
      const uint4 v = *(const uint4*)(wsm + row * 128 + ((ch ^ (row & 7)) << 4));
      __builtin_nontemporal_store(__builtin_bit_cast(u32x4_t, v), (u32x4_t*)(gbase + (size_t)(hf * 64 + row) * ld + ch * 8));
    }
  }
}
__device__ __forceinline__ void wave_store_cols(char* wsm, u16* vt, const int vcol0, const int nh, const int bl, const int t0,
                                                const f32x4 (&acc)[8][4], const int lane) {
  const int fr = lane & 15, fq = lane >> 4;
#pragma unroll
  for (int m = 0; m < 8; m++)
#pragma unroll
    for (int n = 0; n < 4; n++)
#pragma unroll
      for (int j = 0; j < 4; j++) {
        const int d = n * 16 + fq * 4 + j, t = m * 16 + fr;
        *(u16*)(wsm + d * 256 + (((t >> 3) ^ (d & 15)) << 4) + (t & 7) * 2) = f2bf(acc[m][n][j]);
      }
  const int dd = lane >> 4, ch = lane & 15;
#pragma unroll
  for (int i = 0; i < 16; i++) {
    const int d = i * 4 + dd;
    const uint4 v = *(const uint4*)(wsm + d * 256 + ((ch ^ (d & 15)) << 4));
    const int vcol = vcol0 + d;
    *(uint4*)(vt + ((size_t)(bl * nh + (vcol >> 6)) * 64 + (vcol & 63)) * TSEQ + t0 + ch * 8) = v;
  }
}

__device__ void gemm1_phase(const Params& P, int layer, char* smem) {
  const int CT = P.NB * TSEQ;
  const int nM = CT >> 8, nN = INCP >> 8;
  const u16* Bt = P.WinT + (size_t)layer * INCP * DM;
  u16* p_qr = P.qr; u16* p_proj = P.proj;
  asm volatile("" : "+s"(p_qr), "+s"(p_proj));
  for (int i = 0;; i++) {
    GTile u, un;
    if (!g_next(i, gridDim.x, blockIdx.x, nM, nN, u)) break;
    const bool hn = g_next(i + 1, gridDim.x, blockIdx.x, nM, nN, un);
    const int tid = opaque_tid(), wid = tid >> 6, lane = tid & 63, wr = wid >> 2, wc = wid & 3, fr = lane & 15, fq = lane >> 4;
    f32x4 acc[8][4];
    g_zero(acc);
    g_kloop(P.h + (size_t)(u.pm * 256) * DM, Bt + (size_t)(u.pn * 256) * DM, DM, smem, acc, tid, i > 0,
            P.h + (size_t)(un.pm * 256) * DM, Bt + (size_t)(un.pn * 256) * DM, hn);
    const int cw = u.pn * 256 + wc * 64;
    const int row0 = u.pm * 256 + wr * 128 + fr;
    char* wsm = smem + G_STAGE_B + wid * 8192;
    const int rowb = u.pm * 256 + wr * 128;
    const bool rope_q = cw < 1024;
    const bool rope_k = (cw >= C_KV + 256 && cw < C_KV + 384) || (cw >= C_KV + 512 && cw < C_KV + 640);
    const bool mixed = (cw == 5888);
    if (cw >= INC) {
    } else if (rope_q || rope_k) {
      if (rope_q) wave_store_rows(wsm, p_proj + (size_t)rowb * INC + cw, INC, acc, lane);
#pragma unroll
      for (int m = 0; m < 8; m++) {
        const int tt = (row0 + m * 16) & (TSEQ - 1);
#pragma unroll
        for (int n = 0; n < 2; n++) {
          const float4 c = *(const float4*)(P.ropec + tt * 32 + n * 16 + fq * 4);
          const float4 sn = *(const float4*)(P.ropes + tt * 32 + n * 16 + fq * 4);
          const f32x4 x1 = acc[m][n], x2 = acc[m][n + 2];
          f32x4 r1, r2;
          r1[0] = x1[0] * c.x - x2[0] * sn.x; r2[0] = x2[0] * c.x + x1[0] * sn.x;
          r1[1] = x1[1] * c.y - x2[1] * sn.y; r2[1] = x2[1] * c.y + x1[1] * sn.y;
          r1[2] = x1[2] * c.z - x2[2] * sn.z; r2[2] = x2[2] * c.z + x1[2] * sn.z;
          r1[3] = x1[3] * c.w - x2[3] * sn.w; r2[3] = x2[3] * c.w + x1[3] * sn.w;
          acc[m][n] = r1; acc[m][n + 2] = r2;
        }
      }
      if (rope_q) wave_store_rows(wsm, p_qr + (size_t)rowb * DM + cw, DM, acc, lane);
      else wave_store_rows(wsm, p_proj + (size_t)rowb * INC + cw, INC, acc, lane);
    } else if (!mixed) {
      wave_store_rows(wsm, p_proj + (size_t)rowb * INC + cw, INC, acc, lane);
    } else {
#pragma unroll
      for (int n = 0; n < 4; n++) {
        const int c0 = cw + n * 16 + fq * 4;
        if (c0 < C_FB) {
#pragma unroll
          for (int m = 0; m < 8; m++) *(uint2*)(p_proj + (size_t)(row0 + m * 16) * INC + c0) = pk4(acc[m][n]);
        } else {
#pragma unroll
          for (int m = 0; m < 8; m++)
            *(float4*)(P.flog + (size_t)(row0 + m * 16) * 16 + (c0 - C_FB)) = make_float4(acc[m][n][0], acc[m][n][1], acc[m][n][2], acc[m][n][3]);
        }
        __builtin_amdgcn_sched_barrier(0);
      }
    }
    __syncthreads();
  }
}

__device__ void gemm2_phase(const Params& P, int layer, char* smem) {
  const int CT = P.NB * TSEQ;
  const int nM = CT >> 8, nN = 4;
  const u16* p_ya = P.ya; const u16* p_yb = P.yb; const u16* p_wa = P.WpaT; const u16* p_wb = P.WpbT;
  for (int i = 0;; i++) {
    GTile u, un;
    if (!g_next(i, gridDim.x, blockIdx.x, nM, nN, u)) break;
    const bool hn = g_next(i + 1, gridDim.x, blockIdx.x, nM, nN, un);
    const int tid = opaque_tid(), wid = tid >> 6, lane = tid & 63, wr = wid >> 2, wc = wid & 3, fr = lane & 15, fq = lane >> 4;
    f32x4 acc[8][4];
    g_zero(acc);
#pragma unroll 1
    for (int pass = 0; pass < 2; pass++) {
      const u16* Ap = (pass ? p_yb : p_ya) + (size_t)(u.pm * 256) * DM;
      const u16* Bp = (pass ? p_wb : p_wa) + (size_t)layer * DM * DM + (size_t)(u.pn * 256) * DM;
      const u16* nAp = pass ? (p_ya + (size_t)(un.pm * 256) * DM) : (p_yb + (size_t)(u.pm * 256) * DM);
      const u16* nBp = pass ? (p_wa + (size_t)layer * DM * DM + (size_t)(un.pn * 256) * DM) : (p_wb + (size_t)layer * DM * DM + (size_t)(u.pn * 256) * DM);
      g_kloop(Ap, Bp, DM, smem, acc, tid, (i > 0) || (pass > 0), nAp, nBp, pass ? hn : true);
      __builtin_amdgcn_sched_barrier(0);
      if (pass == 0) {
        const int tid1 = opaque_tid(), wid1 = tid1 >> 6, lane1 = tid1 & 63, wr1 = wid1 >> 2, wc1 = wid1 & 3, fr1 = lane1 & 15, fq1 = lane1 >> 4;
        const u16* pp = P.proj + (size_t)(u.pm * 256 + wr1 * 128 + fr1) * INC + u.pn * 256 + wc1 * 64 + fq1 * 4;
#pragma unroll
        for (int m = 0; m < 8; m++) {
#pragma unroll
          for (int n = 0; n < 4; n++) {
            const uint2 ra = *(const uint2*)(pp + (size_t)(m * 16) * INC + C_RA + n * 16);
            const uint2 rb = *(const uint2*)(pp + (size_t)(m * 16) * INC + C_RB + n * 16);
            acc[m][n][0] *= (1.f + __expf(-bflo(rb.x))) / (1.f + __expf(-bflo(ra.x)));
            acc[m][n][1] *= (1.f + __expf(-bfhi(rb.x))) / (1.f + __expf(-bfhi(ra.x)));
            acc[m][n][2] *= (1.f + __expf(-bflo(rb.y))) / (1.f + __expf(-bflo(ra.y)));
            acc[m][n][3] *= (1.f + __expf(-bfhi(rb.y))) / (1.f + __expf(-bfhi(ra.y)));
          }
          __builtin_amdgcn_sched_barrier(0);
        }
      }
    }
    {
      const int tid2 = opaque_tid(), wid2 = tid2 >> 6, lane2 = tid2 & 63, wr2 = wid2 >> 2, wc2 = wid2 & 3, fr2 = lane2 & 15, fq2 = lane2 >> 4;
      const u16* pp = P.proj + (size_t)(u.pm * 256 + wr2 * 128 + fr2) * INC + u.pn * 256 + wc2 * 64 + fq2 * 4;
#pragma unroll
      for (int m = 0; m < 8; m++) {
#pragma unroll
        for (int n = 0; n < 4; n++) {
          const uint2 rb = *(const uint2*)(pp + (size_t)(m * 16) * INC + C_RB + n * 16);
          acc[m][n][0] *= sigmoidf_(bflo(rb.x)); acc[m][n][1] *= sigmoidf_(bfhi(rb.x));
          acc[m][n][2] *= sigmoidf_(bflo(rb.y)); acc[m][n][3] *= sigmoidf_(bfhi(rb.y));
        }
        __builtin_amdgcn_sched_barrier(0);
      }
      wave_store_rows(smem + G_STAGE_B + wid2 * 8192, P.h + (size_t)(u.pm * 256 + wr2 * 128) * DM + u.pn * 256 + wc2 * 64, DM, acc, lane2);
    }
    __syncthreads();
  }
}

__device__ void gemm3_phase(const Params& P, int layer, int chunk, char* smem) {
  const int CT = P.NB * TSEQ;
  const int nM = CT >> 8, nN = 4;
  const float* xs = (layer == 0 ? P.x_in : P.out) + (size_t)chunk * CT * DM;
  float* xd = P.out + (size_t)chunk * CT * DM;
  for (int i = 0;; i++) {
    GTile u, un;
    if (!g_next(i, gridDim.x, blockIdx.x, nM, nN, u)) break;
    const bool hn = g_next(i + 1, gridDim.x, blockIdx.x, nM, nN, un);
    const int tid = opaque_tid(), wid = tid >> 6, lane = tid & 63, wr = wid >> 2, wc = wid & 3, fr = lane & 15, fq = lane >> 4;
    f32x4 acc[8][4];
    g_zero(acc);
    g_kloop(P.h + (size_t)(u.pm * 256) * DM, P.WoT + (size_t)layer * DM * DM + (size_t)(u.pn * 256) * DM, DM, smem, acc, tid, i > 0,
            P.h + (size_t)(un.pm * 256) * DM, P.WoT + (size_t)layer * DM * DM + (size_t)(un.pn * 256) * DM, hn);
    const size_t off = (size_t)(u.pm * 256 + wr * 128 + fr) * DM + u.pn * 256 + wc * 64 + fq * 4;
#pragma unroll
    for (int m = 0; m < 8; m++) {
#pragma unroll
      for (int n = 0; n < 4; n++) {
        const float4 xo = *(const float4*)(xs + off + (size_t)(m * 16) * DM + n * 16);
        *(float4*)(xd + off + (size_t)(m * 16) * DM + n * 16) =
            make_float4(xo.x + acc[m][n][0], xo.y + acc[m][n][1], xo.z + acc[m][n][2], xo.w + acc[m][n][3]);
      }
      __builtin_amdgcn_sched_barrier(0);
    }
  }
}

__device__ __forceinline__ void compress_item(const Params& P, const int layer, const int it, char* smem_all, const int tid_all) {
  const int half = tid_all >> 8, tid = tid_all & 255;
  char* smem = smem_all + half * 65536;
  const int lane = tid & 63, r = lane & 31, h = lane >> 5, w = tid >> 6;
  const int wm = w >> 1, wn = w & 1;
  const int unit = it * 2 + half;
  const int bl = unit >> 2, g = (unit >> 1) & 1, kv = unit & 1;
  f32x16 acc[2][2];
  zero_acc(acc);
  ACmp af{P.proj + (size_t)bl * TSEQ * INC + C_KV + kv * 128 + g * 64};
  gemm_mainloop(af, P.W1T + (size_t)(layer * 2 + kv) * 128 * 2048, 2048, 2048, smem, acc, tid);
  const float* bp = P.bias1p + (size_t)((layer * 2 + kv) * 8) * 128;
#pragma unroll
  for (int ni = 0; ni < 2; ni++) {
    int hc = wn * 64 + ni * 32 + r;
    float b1 = 0.f;
#pragma unroll
    for (int q = 0; q < 8; q++) b1 += bp[q * 128 + hc];
#pragma unroll
    for (int mi = 0; mi < 2; mi++)
#pragma unroll
      for (int i = 0; i < 16; i++) {
        int n = wm * 64 + mi * 32 + 8 * (i >> 2) + 4 * h + (i & 3);
        float v = siluf_(acc[mi][ni][i] + b1);
        *(u16*)(smem + n * 256 + (((hc >> 3) ^ (n & 15)) << 4) + (hc & 7) * 2) = f2bf(v);
      }
  }
  __syncthreads();
  const u16* w2t = P.W2T + (size_t)(layer * 2 + kv) * 64 * 128;
  f32x16 o2[2];
#pragma unroll
  for (int dt = 0; dt < 2; dt++)
#pragma unroll
    for (int i = 0; i < 16; i++) o2[dt][i] = 0.f;
#pragma unroll
  for (int kk = 0; kk < 8; kk++) {
    int n = w * 32 + r;
    bf16x8 a = ldfrag(smem + n * 256 + (((kk * 2 + h) ^ (n & 15)) << 4));
#pragma unroll
    for (int dt = 0; dt < 2; dt++) {
      bf16x8 b = ldfrag(w2t + (size_t)(dt * 32 + r) * 128 + kk * 16 + h * 8);
      o2[dt] = mfma32(a, b, o2[dt]);
    }
  }
#pragma unroll
  for (int dt = 0; dt < 2; dt++) {
    int d = dt * 32 + r;
    if (kv == 0) {
#pragma unroll
      for (int i = 0; i < 16; i++) {
        int n = w * 32 + 8 * (i >> 2) + 4 * h + (i & 3);
        P.kcmp[((size_t)(bl * 2 + g) * 128 + n) * 64 + d] = f2bf(o2[dt][i]);
      }
    } else {
#pragma unroll
      for (int gq = 0; gq < 4; gq++) {
        int n0 = w * 32 + 8 * gq + 4 * h;
        uint2 o;
        o.x = pk2(o2[dt][gq * 4 + 0], o2[dt][gq * 4 + 1]);
        o.y = pk2(o2[dt][gq * 4 + 2], o2[dt][gq * 4 + 3]);
        *(uint2*)(P.vcmpt + ((size_t)(bl * 2 + g) * 64 + d) * 128 + n0) = o;
      }
    }
  }
  __syncthreads();
}

__device__ void pb_phase(const Params& P, int layer, char* smem_all) {
  const int tid = opaque_tid();
  const int lane = tid & 63, w = tid >> 6;
  float* wsum = (float*)smem_all;
  const int nScan = P.NB * 16;
  for (int it = blockIdx.x; it < nScan; it += gridDim.x) {
    const int bl = it >> 4, hh = it & 15;
    const float bf = P.b_forget[layer * 16 + hh];
    const float* fl = P.flog + ((size_t)bl * TSEQ + tid * 4) * 16 + hh;
    float ls[4];
#pragma unroll
    for (int j = 0; j < 4; j++) {
      const float x = fl[j * 16] + bf;
      ls[j] = (x >= 0.f) ? -log1pf(__expf(-x)) : (x - log1pf(__expf(x)));
    }
    const float loc = (ls[0] + ls[1]) + (ls[2] + ls[3]);
    float incl = loc;
#pragma unroll
    for (int o = 1; o < 64; o <<= 1) {
      const float v = __shfl_up(incl, o);
      if (lane >= o) incl += v;
    }
    __syncthreads();
    if (lane == 63) wsum[w] = incl;
    __syncthreads();
    float base = 0.f;
#pragma unroll
    for (int q = 0; q < 8; q++) base += (q < w) ? wsum[q] : 0.f;
    float run = base + incl - loc;
    float4 o4;
    run += ls[0]; o4.x = -8.0f * run;
    run += ls[1]; o4.y = -8.0f * run;
    run += ls[2]; o4.z = -8.0f * run;
    run += ls[3]; o4.w = -8.0f * run;
    *(float4*)(P.F2 + ((size_t)bl * 16 + hh) * TSEQ + tid * 4) = o4;
  }
}

__device__ void pc1_phase(const Params& P, char* smem) {
  const int tid = opaque_tid(),  lane = tid & 63, r = lane & 31, h = lane >> 5, w = tid >> 6;
  const int nItems = P.NB * 2 * 8;
  const float c1 = 0.125f * LOG2E;
  for (int it = blockIdx.x; it < nItems; it += gridDim.x) {
    const int qt = it & 7, g = (it >> 3) & 1, bl = it >> 4;
    __syncthreads();
#pragma unroll
    for (int j = 0; j < 2; j++) {
      int c = tid + 512 * j;
      {
        int n = c >> 3, ch = c & 7;
        uint4 v = *(const uint4*)(P.kcmp + ((size_t)(bl * 2 + g) * 128 + n) * 64 + ch * 8);
        *(uint4*)(smem + n * 128 + ((ch ^ ((n >> 1) & 7)) << 4)) = v;
      }
      {
        int d = c >> 4, ch = c & 15;
        uint4 v = *(const uint4*)(P.vcmpt + ((size_t)(bl * 2 + g) * 64 + d) * 128 + ch * 8);
        int sw = d & 31;
        *(uint2*)(smem + 16384 + d * 256 + (((2 * ch) ^ sw) << 3)) = make_uint2(v.x, v.y);
        *(uint2*)(smem + 16384 + d * 256 + (((2 * ch + 1) ^ sw) << 3)) = make_uint2(v.z, v.w);
      }
    }
    __syncthreads();
    const int qw_lo = qt * 256 + w * 32;
    const int qtok = qw_lo + r;
    const size_t rowg = (size_t)bl * TSEQ + qtok;
    const int tq = qtok - 31 - 64 * h;
    float sumacc[16], lastacc[16];
#pragma unroll
    for (int s = 0; s < 16; s++) { sumacc[s] = 0.f; lastacc[s] = 0.f; }
#pragma unroll 1
    for (int hh = 0; hh < 8; hh++) {
      const int head = g * 8 + hh;
      bf16x8 qf[4];
#pragma unroll
      for (int kk = 0; kk < 4; kk++) qf[kk] = ldfrag(P.proj + rowg * INC + C_QA + head * 64 + kk * 16 + h * 8);
      f32x16 s[4];
#pragma unroll
      for (int nt = 0; nt < 4; nt++) {
#pragma unroll
        for (int i = 0; i < 16; i++) s[nt][i] = 0.f;
#pragma unroll
        for (int kk = 0; kk < 4; kk++) {
          int row = nt * 32 + r;
          bf16x8 a = ldfrag(smem + row * 128 + (((kk * 2 + h) ^ ((row >> 1) & 7)) << 4));
          s[nt] = mfma32(a, qf[kk], s[nt]);
        }
        __builtin_amdgcn_sched_barrier(0);
      }
      float mx = -3.0e38f;
#pragma unroll
      for (int nt = 0; nt < 4; nt++)
#pragma unroll
        for (int i = 0; i < 16; i++) {
          bool ok = (16 * (nt * 32 + 8 * (i >> 2) + (i & 3))) <= tq;
          float v = ok ? s[nt][i] * c1 : -3.0e38f;
          s[nt][i] = v;
          mx = fmaxf(mx, v);
        }
      mx = fmaxf(mx, __shfl_xor(mx, 32));
      const bool anyv = mx > -1.0e37f;
      float mref = anyv ? mx : 0.f;
      float l = 0.f;
#pragma unroll
      for (int nt = 0; nt < 4; nt++)
#pragma unroll
        for (int i = 0; i < 16; i++) {
          float p = __builtin_amdgcn_exp2f(s[nt][i] - mref);
          s[nt][i] = p;
          l += p;
        }
      l += __shfl_xor(l, 32);
      const float inv = (anyv && l > 0.f) ? 1.f / l : 0.f;
#pragma unroll
      for (int nt = 0; nt < 4; nt++)
#pragma unroll
        for (int i = 0; i < 16; i++) s[nt][i] *= inv;
#pragma unroll
      for (int nt = 0; nt < 4; nt++)
#pragma unroll
        for (int gq = 0; gq < 4; gq++) {
          sumacc[nt * 4 + gq] += (s[nt][gq * 4] + s[nt][gq * 4 + 1]) + (s[nt][gq * 4 + 2] + s[nt][gq * 4 + 3]);
          lastacc[nt * 4 + gq] += s[nt][gq * 4 + 3];
        }
      uint4 pbv[8];
#pragma unroll
      for (int ks = 0; ks < 8; ks++) {
        const int nt = ks >> 1, hb = (ks & 1) * 8;
        pbv[ks].x = pk2(s[nt][hb + 0], s[nt][hb + 1]); pbv[ks].y = pk2(s[nt][hb + 2], s[nt][hb + 3]);
        pbv[ks].z = pk2(s[nt][hb + 4], s[nt][hb + 5]); pbv[ks].w = pk2(s[nt][hb + 6], s[nt][hb + 7]);
      }
      const float g0 = sigmoidf_(bf2f(P.proj[rowg * INC + C_GA + head]));
#pragma unroll
      for (int dt = 0; dt < 2; dt++) {
        f32x16 o;
#pragma unroll
        for (int i = 0; i < 16; i++) o[i] = 0.f;
        const int d = dt * 32 + r, sw = d & 31;
#pragma unroll
        for (int ks = 0; ks < 8; ks++) {
          uint2 lo = *(const uint2*)(smem + 16384 + d * 256 + (((ks * 4 + h) ^ sw) << 3));
          uint2 hi = *(const uint2*)(smem + 16384 + d * 256 + (((ks * 4 + 2 + h) ^ sw) << 3));
          uint4 au = make_uint4(lo.x, lo.y, hi.x, hi.y);
          o = mfma32(__builtin_bit_cast(bf16x8, au), __builtin_bit_cast(bf16x8, pbv[ks]), o);
        }
#pragma unroll
        for (int gq = 0; gq < 4; gq++) {
          int d0 = dt * 32 + 8 * gq + 4 * h;
          uint2 ov;
          ov.x = pk2(o[gq * 4 + 0] * g0, o[gq * 4 + 1] * g0);
          ov.y = pk2(o[gq * 4 + 2] * g0, o[gq * 4 + 3] * g0);
          *(uint2*)(P.ya + rowg * DM + head * 64 + d0) = ov;
        }
        __builtin_amdgcn_sched_barrier(0);
      }
    }
    float sc[16];
#pragma unroll
    for (int s = 0; s < 16; s++) {
      float prev = (s == 0) ? 0.f : lastacc[s - 1];
      float sendv = h ? prev : lastacc[s];
      float recv = __shfl_xor(sendv, 32);
      float imp = sumacc[s] + recv;
      int j = (s >> 2) * 8 + (s & 3) * 2 + h;
      int cur = qtok >> 6;
      bool forced = (j == 0) || (j == cur) || (j == cur - 1);
      bool valid = j <= cur;
      sc[s] = forced ? 1.0e4f : (valid ? imp : -1.0f);
    }
    unsigned mask = 0u;
#pragma unroll 1
    for (int rd = 0; rd < 8; rd++) {
      float best = -2.0f; int bj = 0;
#pragma unroll
      for (int s = 0; s < 16; s++) {
        int j = (s >> 2) * 8 + (s & 3) * 2 + h;
        if (sc[s] > best) { best = sc[s]; bj = j; }
      }
      float ob = __shfl_xor(best, 32);
      int oj = __shfl_xor(bj, 32);
      bool mine = (best > ob) || (best == ob && bj < oj);
      int wj = mine ? bj : oj;
      mask |= 1u << wj;
#pragma unroll
      for (int s = 0; s < 16; s++) {
        int j = (s >> 2) * 8 + (s & 3) * 2 + h;
        if (j == wj) sc[s] = -3.0f;
      }
    }
    if (h == 0) P.sel[(size_t)(bl * 2 + g) * TSEQ + qtok] = mask;
  }
}

#define A_SLOTB 8192
#define A_LDS_K 0
#define A_LDS_V 24576
#define A_LDS_WS 49152
#define A_LDS_F 51200
#define A_LDS_OST 52224
#define A_THR 8.0f
#define A_C2 (0.125f * LOG2E)
typedef __attribute__((ext_vector_type(4))) short a_s16x4;
typedef __attribute__((ext_vector_type(8))) short a_s16x8;
typedef __attribute__((ext_vector_type(4))) unsigned a_u32x4;
typedef __attribute__((address_space(3))) const char* a_lds_cptr;
typedef short a_v4i16 __attribute__((ext_vector_type(4)));
#define A_SBAR() __builtin_amdgcn_sched_barrier(0)
#define A_PIN(x) asm volatile("" : "+v"(x))
#define A_MFMA(a, b, c) __builtin_amdgcn_mfma_f32_32x32x16_bf16(a, b, c, 0, 0, 0)
template <int N> __device__ __forceinline__ void a_wait_bar() { asm volatile("s_waitcnt vmcnt(%0) lgkmcnt(0)\n\ts_barrier" ::"n"(N) : "memory"); }
__device__ __forceinline__ int a_crow(int r, int hi) { return (r & 3) + 8 * (r >> 2) + 4 * hi; }
__device__ __forceinline__ unsigned a_cvtpk(float lo, float hi) { unsigned r; asm("v_cvt_pk_bf16_f32 %0, %1, %2" : "=v"(r) : "v"(lo), "v"(hi)); return r; }
__device__ __forceinline__ void a_glds16(const void* g, unsigned lds_base) {
  unsigned sv; asm volatile("s_mov_b32 %0, m0\n\ts_mov_b32 m0, %2\n\ts_nop 0\n\tglobal_load_lds_dwordx4 %1, off\n\ts_mov_b32 m0, %0" : "=&s"(sv) : "v"(g), "s"(lds_base) : "memory"); }
__device__ __forceinline__ void a_glds4(const void* g, unsigned lds_base) {
  unsigned sv; asm volatile("s_mov_b32 %0, m0\n\ts_mov_b32 m0, %2\n\ts_nop 0\n\tglobal_load_lds_dword %1, off\n\ts_mov_b32 m0, %0" : "=&s"(sv) : "v"(g), "s"(lds_base) : "memory"); }
__device__ __forceinline__ void a_kload2(bf16x8* kf, a_lds_cptr kp, int d0) {
  kf[2 * d0] = *(const __attribute__((address_space(3))) bf16x8*)(kp + d0 * 2048);
  kf[2 * d0 + 1] = *(const __attribute__((address_space(3))) bf16x8*)(kp + d0 * 2048 + 512); }
__device__ __forceinline__ a_s16x4 a_vtr(a_lds_cptr p) { return __builtin_bit_cast(a_s16x4, __builtin_amdgcn_ds_read_tr16_b64_v4i16((__attribute__((address_space(3))) a_v4i16*)p)); }
#define A_MX3(a, b, c) __builtin_fmaxf(__builtin_fmaxf((a), (b)), (c))
__device__ __forceinline__ float a_rowmax(const f32x16& p0, const f32x16& p1) {
  float a = A_MX3(p0[0], p0[1], p1[0]), b = A_MX3(p0[2], p0[3], p1[1]); a = A_MX3(a, p1[2], p1[3]);
#pragma unroll
  for (int r = 4; r < 16; r += 4) { a = A_MX3(a, p0[r], p0[r + 1]); b = A_MX3(b, p0[r + 2], p0[r + 3]); a = A_MX3(a, p1[r], p1[r + 1]); b = A_MX3(b, p1[r + 2], p1[r + 3]); }
  float m = __builtin_fmaxf(a, b); auto rr = __builtin_amdgcn_permlane32_swap(__float_as_uint(m), __float_as_uint(m), false, false);
  return __builtin_fmaxf(__uint_as_float(rr[0]), __uint_as_float(rr[1])); }
template <int MODE>
__device__ __forceinline__ void a_mask(f32x16& p0, f32x16& p1, int key0, int qabs, int hi) {
  const int kb = key0 + 4 * hi;
#pragma unroll
  for (int r = 0; r < 16; ++r) {
    const int kv = kb + (r & 3) + 8 * (r >> 2);
    bool bad0 = kv > qabs, bad1 = (kv + 32) > qabs;
    if (MODE == 2) { bad0 = bad0 || (kv + 512 <= qabs); bad1 = bad1 || (kv + 32 + 512 <= qabs); }
    if (bad0) p0[r] = -INFINITY;
    if (bad1) p1[r] = -INFINITY;
  } }
__device__ __forceinline__ void a_bias(f32x16& p0, f32x16& p1, const char* fb, int hi) {
#pragma unroll
  for (int g = 0; g < 4; ++g) {
    const float4 b0 = *(const float4*)(fb + (8 * g + 4 * hi) * 4);
    const float4 b1 = *(const float4*)(fb + (32 + 8 * g + 4 * hi) * 4);
    p0[4 * g + 0] += b0.x; p0[4 * g + 1] += b0.y; p0[4 * g + 2] += b0.z; p0[4 * g + 3] += b0.w;
    p1[4 * g + 0] += b1.x; p1[4 * g + 1] += b1.y; p1[4 * g + 2] += b1.z; p1[4 * g + 3] += b1.w;
  } }

template <int MODE>
__device__ __forceinline__ void a_unit(const u16* __restrict__ Qw, const int qp, const u16* __restrict__ Kp, const u16* __restrict__ Vp,
                                       const float* __restrict__ Fp, const int NT, const int key00, const int qabs, const unsigned selm,
                                       const float gate, char* lds, u16* stg, const int tid) {
  constexpr int NK = (MODE == 0) ? 2 : 1;
  const int lane = tid & 63, r32 = lane & 31, hi = lane >> 5; const int wid = __builtin_amdgcn_readfirstlane(tid >> 6);
  const unsigned lds0 = (unsigned)(uintptr_t)lds; float* wsf = (float*)(lds + A_LDS_WS) + wid * 64;
  const u16* ksrc = Kp + (long)lane * INC + wid * 8;
  const u16* vsrc = Vp + (long)(16 * (wid & 3) + (lane >> 2)) * INC + (wid >> 2) * 32 + (lane & 3) * 8;
  const float* fsrc = Fp + lane;
  const unsigned kdst = lds0 + A_LDS_K + wid * 1024, vdst = lds0 + A_LDS_V + wid * 1024, fdst = lds0 + A_LDS_F;
#define A_DMA_K(t, slot) do { a_glds16(ksrc + (long)(t) * 64 * INC, (unsigned)__builtin_amdgcn_readfirstlane(kdst + (slot))); \
    if (MODE == 0) a_glds4(fsrc + (t) * 64, (unsigned)__builtin_amdgcn_readfirstlane(fdst + ((t) & 3) * 256)); } while (0)
#define A_DMA_V(t, slot) a_glds16(vsrc + (long)(t) * 64 * INC, (unsigned)__builtin_amdgcn_readfirstlane(vdst + (slot)))
  const a_lds_cptr vp0 = (a_lds_cptr)lds + A_LDS_V + ((lane >> 4) & 1) * 32 + (lane & 3) * 8 + (4 * hi + ((lane & 15) >> 2)) * 64;
  const a_lds_cptr kp0 = (a_lds_cptr)lds + A_LDS_K + hi * 1024 + r32 * 16;
  const char* fb0 = lds + A_LDS_F;
  A_DMA_K(0, 0); A_DMA_V(0, 0); A_DMA_K(1, A_SLOTB);
  bf16x8 qr[4];
#pragma unroll
  for (int d0 = 0; d0 < 4; ++d0) qr[d0] = ldfrag(Qw + (long)r32 * qp + d0 * 16 + hi * 8);
  float mhat = 0.f, l_reg = 0.f; f32x16 o[2];
#pragma unroll
  for (int r = 0; r < 16; ++r) { o[0][r] = 0.f; o[1][r] = 0.f; }
  const f32x16 zero16 = {0.f, 0.f, 0.f, 0.f, 0.f, 0.f, 0.f, 0.f, 0.f, 0.f, 0.f, 0.f, 0.f, 0.f, 0.f, 0.f};
  bool resc = false;
  f32x16 pA0, pA1, pB0, pB1; bf16x8 kf[8]; a_s16x4 vlo[8], vhi[8]; a_u32x4 pw0, pw1, pw2, pw3;
  int sl_prev = 0, sl_cur = 0, sl_next = A_SLOTB;
#define A_ROT() do { sl_prev = sl_cur; sl_cur = sl_next; sl_next = (sl_next == 2 * A_SLOTB) ? 0 : sl_next + A_SLOTB; } while (0)
#define A_EX(v) __builtin_amdgcn_exp2f(__builtin_fmaf((v), A_C2, nmh))
#define A_RESC() do { if (resc) { _Pragma("unroll") for (int d_ = 0; d_ < 2; ++d_) _Pragma("unroll") for (int r = 0; r < 16; ++r) o[d_][r] *= wsf[a_crow(r, hi)]; } } while (0)
  A_DMA_K(2, 2 * A_SLOTB);
  a_wait_bar<1 + 2 * NK>();
  _Pragma("unroll") for (int d0 = 0; d0 < 4; ++d0) a_kload2(kf, kp0, d0);
  pA0 = A_MFMA(kf[0], qr[0], zero16); pA1 = A_MFMA(kf[1], qr[0], zero16); pA0 = A_MFMA(kf[2], qr[1], pA0); pA1 = A_MFMA(kf[3], qr[1], pA1);
  pA0 = A_MFMA(kf[4], qr[2], pA0); pA1 = A_MFMA(kf[5], qr[2], pA1); pA0 = A_MFMA(kf[6], qr[3], pA0); pA1 = A_MFMA(kf[7], qr[3], pA1);
  if (MODE == 0) a_bias(pA0, pA1, fb0, hi);
  if (MODE == 2 || NT == 4) a_mask<MODE>(pA0, pA1, key00, qabs, hi);
  { const float rm = a_rowmax(pA0, pA1); mhat = __builtin_fmaxf(rm * A_C2, -1.0e30f); const float nmh = -mhat;
#pragma unroll
    for (int r = 0; r < 16; ++r) { pA0[r] = A_EX(pA0[r]); pA1[r] = A_EX(pA1[r]); } }
  a_wait_bar<0>();
  A_DMA_K(3, 0); A_DMA_V(1, A_SLOTB); A_ROT();
  _Pragma("unroll") for (int d0 = 0; d0 < 4; ++d0) a_kload2(kf, kp0 + sl_cur, d0);
  a_wait_bar<NK + 1>();
#define A_PKW(P, i) a_cvtpk(P[i], P[i + 1])
#define A_PAF(k) __builtin_bit_cast(bf16x8, pw##k)
#define A_VFR(i) __builtin_bit_cast(bf16x8, __builtin_shufflevector(vlo[i], vhi[i], 0, 1, 2, 3, 4, 5, 6, 7))
#define A_VRD(i) do { vlo[i] = a_vtr(vp_ + (((i) >> 2) * 4096 + ((i) & 3) * 1024)); vhi[i] = a_vtr(vp_ + (((i) >> 2) * 4096 + ((i) & 3) * 1024 + 512)); } while (0)
#define A_KRD(G, d0) do { if (G) { a_kload2(kf, kp0 + sl_next, d0); A_SBAR(); } } while (0)
#define A_GAPA(MF, a0, a1, a2, a3, W0, W1, PW) do { MF; sacc += a0; sacc += a1; sacc += a2; sacc += a3; W0; W1; A_PIN(PW); A_PIN(sacc); A_SBAR(); } while (0)
#define A_GAPB(MF, X, i) do { MF; X[i] = A_EX(X[i]); X[i + 1] = A_EX(X[i + 1]); X[i + 2] = A_EX(X[i + 2]); X[i + 3] = A_EX(X[i + 3]); A_PIN(X); A_SBAR(); } while (0)
#define A_STEP(C0, C1, P0, P1, t, MASK, GK, GV, GL) do { A_SBAR(); \
    const a_lds_cptr vp_ = vp0 + sl_prev; \
    A_VRD(0); A_SBAR(); float sacc = P0[0] + P0[1]; \
                      A_GAPA(C0 = A_MFMA(kf[0], qr[0], zero16), P0[2], P0[3], P0[4], P0[5],     pw0[0] = A_PKW(P0, 0),  pw0[1] = A_PKW(P0, 2),  pw0); \
    A_VRD(4); A_SBAR(); A_GAPA(C1 = A_MFMA(kf[1], qr[0], zero16), P0[6], P0[7], P0[8], P0[9],     pw0[2] = A_PKW(P0, 4),  pw0[3] = A_PKW(P0, 6),  pw0); \
    A_VRD(1); A_SBAR(); A_GAPA(C0 = A_MFMA(kf[2], qr[1], C0),    P0[10], P0[11], P0[12], P0[13], pw1[0] = A_PKW(P0, 8),  pw1[1] = A_PKW(P0, 10), pw1); \
    A_VRD(5); A_SBAR(); A_GAPA(C1 = A_MFMA(kf[3], qr[1], C1),    P0[14], P0[15], P1[0], P1[1],   pw1[2] = A_PKW(P0, 12), pw1[3] = A_PKW(P0, 14), pw1); \
    A_VRD(2); A_SBAR(); A_GAPA(C0 = A_MFMA(kf[4], qr[2], C0),    P1[2], P1[3], P1[4], P1[5],     pw2[0] = A_PKW(P1, 0),  pw2[1] = A_PKW(P1, 2),  pw2); \
    A_VRD(6); A_SBAR(); A_GAPA(C1 = A_MFMA(kf[5], qr[2], C1),    P1[6], P1[7], P1[8], P1[9],     pw2[2] = A_PKW(P1, 4),  pw2[3] = A_PKW(P1, 6),  pw2); \
    A_VRD(3); A_SBAR(); A_GAPA(C0 = A_MFMA(kf[6], qr[3], C0),    P1[10], P1[11], P1[12], P1[13], pw3[0] = A_PKW(P1, 8),  pw3[1] = A_PKW(P1, 10), pw3); \
    A_VRD(7); A_SBAR(); A_GAPA(C1 = A_MFMA(kf[7], qr[3], C1),    P1[14], P1[15], 0.f, 0.f,       pw3[2] = A_PKW(P1, 12), pw3[3] = A_PKW(P1, 14), pw3); \
    l_reg += sacc; \
    if (GK) A_DMA_K((t) + 3, sl_cur); if (GV) A_DMA_V((t) + 1, sl_next); \
    if (MODE == 0) a_bias(C0, C1, fb0 + ((t) & 3) * 256, hi); \
    if (MASK) a_mask<MODE>(C0, C1, key00 + (t) * 64, qabs, hi); \
    const bool selb_ = (MODE != 1) || (((selm >> ((t) & 31)) & 1u) != 0u); \
    { float rmx = a_rowmax(C0, C1) * A_C2; if (!selb_) rmx = -INFINITY; resc = false; \
      if (__builtin_expect(__any((rmx - mhat) > A_THR), 0)) { const float mnew = __builtin_fmaxf(mhat, rmx); \
          const float f = __builtin_amdgcn_exp2f(mhat - mnew); mhat = mnew; l_reg *= f; if (hi == 0) wsf[r32] = f; resc = true; } } \
    const float nmh = selb_ ? -mhat : -INFINITY; A_SBAR(); \
    A_GAPB(o[0] = A_MFMA(A_PAF(0), A_VFR(0), o[0]), C0, 0);              A_GAPB(o[1] = A_MFMA(A_PAF(0), A_VFR(4), o[1]), C0, 4); \
    A_KRD(GL, 0); A_GAPB(o[0] = A_MFMA(A_PAF(1), A_VFR(1), o[0]), C0, 8);  A_KRD(GL, 1); A_GAPB(o[1] = A_MFMA(A_PAF(1), A_VFR(5), o[1]), C0, 12); \
    A_KRD(GL, 2); A_GAPB(o[0] = A_MFMA(A_PAF(2), A_VFR(2), o[0]), C1, 0);  A_KRD(GL, 3); A_GAPB(o[1] = A_MFMA(A_PAF(2), A_VFR(6), o[1]), C1, 4); \
    A_GAPB(o[0] = A_MFMA(A_PAF(3), A_VFR(3), o[0]), C1, 8);              A_GAPB(o[1] = A_MFMA(A_PAF(3), A_VFR(7), o[1]), C1, 12); \
    } while (0)
  int t = 1;
  if (MODE != 2) {
    for (; t + 5 < NT; t += 2) {
      A_STEP(pB0, pB1, pA0, pA1, t, false, true, true, true);     a_wait_bar<NK + 1>(); A_RESC(); A_ROT();
      A_STEP(pA0, pA1, pB0, pB1, t + 1, false, true, true, true); a_wait_bar<NK + 1>(); A_RESC(); A_ROT();
    }
  }
#define A_ENDW(tt) do { if ((tt) + 3 < NT) { a_wait_bar<NK + 1>(); } else if ((tt) + 2 < NT) { a_wait_bar<1>(); } else { a_wait_bar<0>(); } } while (0)
  for (; t + 1 < NT; t += 2) {
    A_STEP(pB0, pB1, pA0, pA1, t, (MODE != 2 || t < 4 || t + 4 >= NT), (t + 3 < NT), (t + 1 < NT), (t + 1 < NT));             A_ENDW(t);     A_RESC(); A_ROT();
    A_STEP(pA0, pA1, pB0, pB1, t + 1, (MODE != 2 || t + 1 < 4 || t + 5 >= NT), (t + 4 < NT), (t + 2 < NT), (t + 2 < NT));     A_ENDW(t + 1); A_RESC(); A_ROT();
  }
  A_STEP(pB0, pB1, pA0, pA1, NT - 1, true, false, false, false); A_RESC();
  { float sacc = pB0[0] + pB0[1];
#pragma unroll
    for (int r = 2; r < 16; ++r) sacc += pB0[r];
#pragma unroll
    for (int r = 0; r < 16; ++r) sacc += pB1[r];
    l_reg += sacc;
    pw0 = (a_u32x4){A_PKW(pB0, 0), A_PKW(pB0, 2), A_PKW(pB0, 4), A_PKW(pB0, 6)}; pw1 = (a_u32x4){A_PKW(pB0, 8), A_PKW(pB0, 10), A_PKW(pB0, 12), A_PKW(pB0, 14)};
    pw2 = (a_u32x4){A_PKW(pB1, 0), A_PKW(pB1, 2), A_PKW(pB1, 4), A_PKW(pB1, 6)}; pw3 = (a_u32x4){A_PKW(pB1, 8), A_PKW(pB1, 10), A_PKW(pB1, 12), A_PKW(pB1, 14)};
    const a_lds_cptr vp_ = vp0 + sl_cur; _Pragma("unroll") for (int i = 0; i < 8; ++i) A_VRD(i);
    o[0] = A_MFMA(A_PAF(0), A_VFR(0), o[0]); o[1] = A_MFMA(A_PAF(0), A_VFR(4), o[1]); o[0] = A_MFMA(A_PAF(1), A_VFR(1), o[0]); o[1] = A_MFMA(A_PAF(1), A_VFR(5), o[1]);
    o[0] = A_MFMA(A_PAF(2), A_VFR(2), o[0]); o[1] = A_MFMA(A_PAF(2), A_VFR(6), o[1]); o[0] = A_MFMA(A_PAF(3), A_VFR(3), o[0]); o[1] = A_MFMA(A_PAF(3), A_VFR(7), o[1]); }
  { auto rr = __builtin_amdgcn_permlane32_swap(__float_as_uint(l_reg), __float_as_uint(l_reg), false, false); l_reg = __uint_as_float(rr[0]) + __uint_as_float(rr[1]); }
  if (hi == 0) wsf[32 + r32] = gate / l_reg;
  asm volatile("s_waitcnt lgkmcnt(0)" ::: "memory");
  float rli[16];
#pragma unroll
  for (int r = 0; r < 16; ++r) rli[r] = wsf[32 + a_crow(r, hi)];
#pragma unroll
  for (int r = 0; r < 16; ++r) { const int orow = a_crow(r, hi);
#pragma unroll
    for (int d0 = 0; d0 < 2; ++d0) stg[orow * 64 + d0 * 32 + r32] = f2bf(o[d0][r] * rli[r]); }
  asm volatile("s_waitcnt lgkmcnt(0)\n\ts_barrier" ::: "memory");
#undef A_DMA_K
#undef A_DMA_V
#undef A_ROT
#undef A_EX
#undef A_RESC
#undef A_PKW
#undef A_PAF
#undef A_VFR
#undef A_VRD
#undef A_KRD
#undef A_ENDW
#undef A_GAPA
#undef A_GAPB
#undef A_STEP
}

__device__ void pc2_phase(const Params& P, int layer, int chunk, char* smem, int* s_item, const int which) {
  volatile __attribute__((address_space(3))) unsigned* xst = (volatile __attribute__((address_space(3))) unsigned*)(smem + XB_LDS_OFF);
  const int nx = (int)xst[1], xc = (int)xst[2] % nx;
  const int nBH = P.NB * 16;
  const int nStr = which ? (P.NB * 2) : nBH;
  const int nLoc = (nStr - xc + nx - 1) / nx;
  const int nCmpAll = which ? 0 : P.NB * 2;
  const int nCmp = which ? 0 : (nCmpAll - xc + nx - 1) / nx;
  const int nItems = nCmp + (which ? nLoc * 64 : ((nLoc + 3) >> 2) * 32);
  unsigned* ctr = P.ctr + ((chunk * 4 + layer) * 2 + which) * 8 + xc;
  while (true) {
    const int tid = opaque_tid(), lane = tid & 63, r32 = lane & 31, w = tid >> 6;
    __syncthreads();
    if (tid == 0) *s_item = (int)atomicAdd(ctr, 1u);
    __syncthreads();
    const int it0 = *s_item;
    if (it0 >= nItems) break;
    if (it0 < nCmp) { compress_item(P, layer, xc + nx * it0, smem, tid); continue; }
    const int it = it0 - nCmp;
    int qt, bh;
    if (which) {
      const int sl = it >> 6, rem = it & 63;
      qt = 7 - (rem >> 3);
      bh = (xc + nx * sl) * 8 + (rem & 7);
    } else {
      const int grp = it >> 5, rem = it & 31;
      const int sl = grp * 4 + (rem & 3);
      qt = 7 - (rem >> 2);
      if (sl >= nLoc) continue;
      bh = xc + nx * sl;
    }
    const int type = which;
    const int bl = bh >> 4, head = bh & 15;
    const int q0w = qt * 256 + w * 32;
    const int qabs = q0w + r32;
    const size_t rowq = (size_t)bl * TSEQ + qabs;
    const size_t roww = (size_t)bl * TSEQ + q0w;
    const u16* pb_ = P.proj + (size_t)bl * TSEQ * INC;
    u16* stg = (u16*)(smem + A_LDS_OST) + w * 4096;
    const int er = lane >> 3, ec = (lane & 7) * 8;
    if (type == 0) {
      a_unit<0>(pb_ + roww * 0 + (size_t)q0w * INC + C_QB + head * 64, INC, pb_ + C_KB + head * 64, pb_ + C_VB + head * 64,
                P.F2 + (size_t)(bl * 16 + head) * TSEQ, 4 * qt + 4, 0, qabs, 0u, 1.0f, smem, stg, tid);
#pragma unroll
      for (int i = 0; i < 4; i++) {
        const int row = i * 8 + er;
        const uint4 ov = *(const uint4*)(stg + row * 64 + ec);
        const uint4 zz = *(const uint4*)(pb_ + (size_t)(q0w + row) * INC + C_ZB + head * 64 + ec);
        uint4 y;
        y.x = pk2(bflo(ov.x) * siluf_(bflo(zz.x)), bfhi(ov.x) * siluf_(bfhi(zz.x)));
        y.y = pk2(bflo(ov.y) * siluf_(bflo(zz.y)), bfhi(ov.y) * siluf_(bfhi(zz.y)));
        y.z = pk2(bflo(ov.z) * siluf_(bflo(zz.z)), bfhi(ov.z) * siluf_(bfhi(zz.z)));
        y.w = pk2(bflo(ov.w) * siluf_(bflo(zz.w)), bfhi(ov.w) * siluf_(bfhi(zz.w)));
        *(uint4*)(P.yb + (roww + row) * DM + head * 64 + ec) = y;
      }
    } else {
      const int g = head >> 3;
      const unsigned selm = P.sel[(size_t)(bl * 2 + g) * TSEQ + qabs];
      const float g1 = sigmoidf_(bf2f(P.proj[rowq * INC + C_GA + 16 + head]));
      const float g2 = sigmoidf_(bf2f(P.proj[rowq * INC + C_GA + 32 + head]));
      const u16* qw = P.qr + roww * DM + head * 64;
      a_unit<1>(qw, DM, pb_ + C_KV + 256 + g * 64, pb_ + C_KV + 384 + g * 64, nullptr, 4 * qt + 4, 0, qabs, selm, g1, smem, stg, tid);
      const int klo = (4 * qt - 8) > 0 ? (4 * qt - 8) : 0;
      a_unit<2>(qw, DM, pb_ + (size_t)(klo * 64) * INC + C_KV + 512 + g * 64, pb_ + (size_t)(klo * 64) * INC + C_KV + 640 + g * 64, nullptr,
                4 * qt + 4 - klo, klo * 64, qabs, 0u, g2, smem, stg + 2048, tid);
#pragma unroll
      for (int i = 0; i < 4; i++) {
        const int row = i * 8 + er;
        const uint4 o1 = *(const uint4*)(stg + row * 64 + ec);
        const uint4 o2 = *(const uint4*)(stg + 2048 + row * 64 + ec);
        const uint4 zz = *(const uint4*)(pb_ + (size_t)(q0w + row) * INC + C_ZA + head * 64 + ec);
        u16* yp = P.ya + (roww + row) * DM + head * 64 + ec;
        const uint4 oc = *(const uint4*)yp;
        uint4 y;
        y.x = pk2((bflo(o1.x) + bflo(o2.x) + bflo(oc.x)) * siluf_(bflo(zz.x)), (bfhi(o1.x) + bfhi(o2.x) + bfhi(oc.x)) * siluf_(bfhi(zz.x)));
        y.y = pk2((bflo(o1.y) + bflo(o2.y) + bflo(oc.y)) * siluf_(bflo(zz.y)), (bfhi(o1.y) + bfhi(o2.y) + bfhi(oc.y)) * siluf_(bfhi(zz.y)));
        y.z = pk2((bflo(o1.z) + bflo(o2.z) + bflo(oc.z)) * siluf_(bflo(zz.z)), (bfhi(o1.z) + bfhi(o2.z) + bfhi(oc.z)) * siluf_(bfhi(zz.z)));
        y.w = pk2((bflo(o1.w) + bflo(o2.w) + bflo(oc.w)) * siluf_(bflo(zz.w)), (bfhi(o1.w) + bfhi(o2.w) + bfhi(oc.w)) * siluf_(bfhi(zz.w)));
        *(uint4*)yp = y;
      }
    }
  }
}

#define XB_XCNT(j) (64 * (j))
#define XB_XSUB(j) (1024 + 64 * (j))
#define XB_XGEN(j) (2048 + 64 * (j))
#define XB_TOP 3072
#define XB_TOPGEN 3136
__device__ __forceinline__ unsigned xb_ld(unsigned* p) { return __hip_atomic_load(p, __ATOMIC_RELAXED, __HIP_MEMORY_SCOPE_AGENT); }
__device__ __forceinline__ unsigned xb_add(unsigned* p, unsigned v) { return __hip_atomic_fetch_add(p, v, __ATOMIC_RELAXED, __HIP_MEMORY_SCOPE_AGENT); }
__device__ __forceinline__ unsigned xb_xcc_id() { return (unsigned)__builtin_amdgcn_s_getreg((3 << 11) | 20) & 0xFu; }
__device__ __forceinline__ void grid_bar(unsigned* bar, char* smem) {
  asm volatile("s_waitcnt vmcnt(0) lgkmcnt(0)" ::: "memory");
  __syncthreads();
  if (threadIdx.x == 0) {
    volatile unsigned* st = (volatile unsigned*)(smem + XB_LDS_OFF);
    const unsigned nloc = st[0], nx = st[1], x = st[2];
    const unsigned old = xb_add(&bar[XB_XSUB(x)], 1u);
    const unsigned gen = old / nloc;
    if (old + 1u == (gen + 1u) * nloc) {
      __builtin_amdgcn_fence(__ATOMIC_RELEASE, "agent");
      asm volatile("s_waitcnt vmcnt(0)" ::: "memory");
      const unsigned og = xb_add(&bar[XB_TOP], 1u);
      const unsigned tg = og / nx;
      if (og + 1u == (tg + 1u) * nx) xb_add(&bar[XB_TOPGEN], 1u);
      else { while (xb_ld(&bar[XB_TOPGEN]) == tg) __builtin_amdgcn_s_sleep(1); }
      __builtin_amdgcn_fence(__ATOMIC_ACQUIRE, "agent");
      xb_add(&bar[XB_XGEN(x)], 1u);
      asm volatile("s_waitcnt vmcnt(0)" ::: "memory");
    } else {
      while (xb_ld(&bar[XB_XGEN(x)]) == gen) __builtin_amdgcn_s_sleep(1);
      __builtin_amdgcn_fence(__ATOMIC_ACQUIRE, "agent");
      asm volatile("s_waitcnt vmcnt(0)" ::: "memory");
    }
  }
  __syncthreads();
}

__global__ void __launch_bounds__(NTHREADS, 2) mega_kernel(Params P) {
  __shared__ __attribute__((aligned(1024))) char smem[163840];
  cg::grid_group grid = cg::this_grid();
  const int CT = P.NB * TSEQ;
  phase0(P, smem);
  grid.sync();
  if (threadIdx.x == 0) (void)xb_add(&P.xbar[XB_XCNT(xb_xcc_id())], 1u);
  grid.sync();
  if (threadIdx.x == 0) {
    unsigned cnt = 0u, mine = 0u; const unsigned x = xb_xcc_id();
#pragma unroll 1
    for (unsigned j = 0; j < 16; ++j) { const unsigned c = xb_ld(&P.xbar[XB_XCNT(j)]); cnt += (c > 0u) ? 1u : 0u; mine = (j == x) ? c : mine; }
    volatile unsigned* st = (volatile unsigned*)(smem + XB_LDS_OFF);
    st[0] = mine > 0u ? mine : 1u; st[1] = cnt > 0u ? cnt : 1u; st[2] = x;
  }
  __syncthreads();
  for (int chunk = 0; chunk < P.nchunk; chunk++) {
    for (int layer = 0; layer < 4; layer++) {
      const float* xs = (layer == 0 ? P.x_in : P.out) + (size_t)chunk * CT * DM;
      norm_phase(xs, P.norm_g + layer * DM, P.h, CT);
      if (layer == 0 && chunk > 0) final_norm_phase(P.out, P.final_g, (chunk - 1) * CT, CT);
      grid_bar(P.xbar, smem);
      gemm1_phase(P, layer, smem);
      grid_bar(P.xbar, smem);
      pb_phase(P, layer, smem);
      grid_bar(P.xbar, smem);
      pc2_phase(P, layer, chunk, smem, (int*)(smem + 140000), 0);
      grid_bar(P.xbar, smem);
      pc1_phase(P, smem);
      grid_bar(P.xbar, smem);
      pc2_phase(P, layer, chunk, smem, (int*)(smem + 140000), 1);
      grid_bar(P.xbar, smem);
      gemm2_phase(P, layer, smem);
      grid_bar(P.xbar, smem);
      gemm3_phase(P, layer, chunk, smem);
      grid_bar(P.xbar, smem);
    }
  }
  final_norm_phase(P.out, P.final_g, (P.nchunk - 1) * CT, CT);
}

static inline size_t al256(size_t x) { return (x + 255) & ~(size_t)255; }

extern "C" void kernel_launch(void* const* d_in, const int* in_sizes, int n_in, void* d_out, int out_size,
                              void* d_ws, size_t ws_size, hipStream_t stream) {
  (void)in_sizes; (void)n_in; (void)out_size;
  Params P{};
  P.x_in = (const float*)d_in[0]; P.norm_g = (const float*)d_in[1]; P.w_in = (const float*)d_in[2];
  P.b_forget = (const float*)d_in[3];
  P.pe_k = (const float*)d_in[4]; P.w1_k = (const float*)d_in[5]; P.w2_k = (const float*)d_in[6];
  P.pe_v = (const float*)d_in[7]; P.w1_v = (const float*)d_in[8]; P.w2_v = (const float*)d_in[9];
  P.w_pa = (const float*)d_in[10]; P.w_pb = (const float*)d_in[11]; P.w_out = (const float*)d_in[12];
  P.final_g = (const float*)d_in[13];
  P.out = (float*)d_out;
  int NB = 16;
  char* base = (char*)d_ws;
  for (;;) {
    const size_t CT = (size_t)NB * TSEQ;
    size_t off = 0;
    auto take = [&](size_t bytes) { size_t o = off; off = al256(off + bytes); return o; };
    size_t oWin = take((size_t)4 * INCP * DM * 2), oWpa = take((size_t)4 * DM * DM * 2), oWpb = take((size_t)4 * DM * DM * 2),
           oWo = take((size_t)4 * DM * DM * 2), oW1 = take((size_t)8 * 128 * 2048 * 2), oW2 = take((size_t)8 * 64 * 128 * 2),
           oB1 = take((size_t)64 * 128 * 4), oRc = take((size_t)TSEQ * 32 * 4), oRs = take((size_t)TSEQ * 32 * 4),
           oH = take(CT * DM * 2), oProj = take(CT * INC * 2 + 4096), oVbt = take(CT * DM * 2),
           oVst = take(CT * 128 * 2), oVwt = take(CT * 128 * 2), oFl = take(CT * 16 * 4), oF2 = take(CT * 16 * 4),
           oKc = take((size_t)NB * 2 * 128 * 64 * 2), oVc = take((size_t)NB * 2 * 64 * 128 * 2), oSel = take(CT * 2 * 4),
           oYa = take(CT * DM * 2), oYb = take(CT * DM * 2), oCtr = take(1024), oXb = take(XB_WORDS * 4);
    if (off > ws_size && NB > 1) { NB >>= 1; continue; }
    P.WinT = (u16*)(base + oWin); P.WpaT = (u16*)(base + oWpa); P.WpbT = (u16*)(base + oWpb); P.WoT = (u16*)(base + oWo);
    P.W1T = (u16*)(base + oW1); P.W2T = (u16*)(base + oW2); P.bias1p = (float*)(base + oB1);
    P.ropec = (float*)(base + oRc); P.ropes = (float*)(base + oRs);
    P.h = (u16*)(base + oH); P.proj = (u16*)(base + oProj); P.qr = (u16*)(base + oVbt);
    P.vst = (u16*)(base + oVst); P.vwt = (u16*)(base + oVwt); P.flog = (float*)(base + oFl); P.F2 = (float*)(base + oF2);
    P.kcmp = (u16*)(base + oKc); P.vcmpt = (u16*)(base + oVc); P.sel = (unsigned*)(base + oSel);
    P.ya = (u16*)(base + oYa); P.yb = (u16*)(base + oYb); P.ctr = (unsigned*)(base + oCtr); P.xbar = (unsigned*)(base + oXb);
    break;
  }
  P.NB = NB; P.nchunk = 32 / NB;
  static int grid_blocks = 0;
  if (!grid_blocks) {
    int dev = 0, cus = 0, per_cu = 0;
    hipGetDevice(&dev);
    hipDeviceGetAttribute(&cus, hipDeviceAttributeMultiprocessorCount, dev);
    hipOccupancyMaxActiveBlocksPerMultiprocessor(&per_cu, mega_kernel, NTHREADS, 0);
    if (per_cu > 1) per_cu = 1;
    if (per_cu < 1) per_cu = 1;
    grid_blocks = cus * per_cu;
  }
  void* args[] = {&P};
  hipError_t e = hipLaunchCooperativeKernel((void*)mega_kernel, dim3(grid_blocks), dim3(NTHREADS), args, 0, stream);
  if (e != hipSuccess) fprintf(stderr, "cooperative launch failed: %s (grid %d)\n", hipGetErrorString(e), grid_blocks);
}
```

```cpp
#include <hip/hip_runtime.h>
#include <hip/hip_cooperative_groups.h>
#include <cstdio>
namespace cg = cooperative_groups;

typedef __attribute__((ext_vector_type(8))) __bf16 bf16x8;
typedef __attribute__((ext_vector_type(16))) float f32x16;
typedef __attribute__((ext_vector_type(4))) float f32x4;
typedef __attribute__((ext_vector_type(2))) float f32x2;
typedef unsigned short u16;

#define TSEQ 2048
#define DM 1024
#define INC 9024
#define INCP 9216
#define C_QA 0
#define C_KV 1024
#define C_GA 1792
#define C_ZA 1840
#define C_QB 2864
#define C_KB 3888
#define C_VB 4912
#define C_QR 4912
#define C_FB 5936
#define C_ZB 5952
#define C_RA 6976
#define C_RB 8000
#define NTHREADS 512
#define ATT_STAGE 33280
#define LOG2E 1.4426950408889634f
#define XB_WORDS 3200
#define XB_LDS_OFF 150000

struct Params {
  const float* x_in; const float* norm_g; const float* w_in; const float* b_forget;
  const float* pe_k; const float* w1_k; const float* w2_k;
  const float* pe_v; const float* w1_v; const float* w2_v;
  const float* w_pa; const float* w_pb; const float* w_out; const float* final_g;
  float* out;
  u16* WinT; u16* WpaT; u16* WpbT; u16* WoT; u16* W1T; u16* W2T;
  float* bias1p; float* ropec; float* ropes;
  u16* h; u16* proj; u16* qr; u16* vst; u16* vwt;
  float* flog; float* F2; u16* kcmp; u16* vcmpt; unsigned* sel;
  u16* ya; u16* yb; unsigned* ctr; unsigned* xbar;
  int NB; int nchunk;
};

__device__ __forceinline__ unsigned pk2(float a, float b) {
  typedef __attribute__((ext_vector_type(2))) float f2_t;
  typedef __attribute__((ext_vector_type(2))) __bf16 b2_t;
  f2_t v = {a, b};
  b2_t r = __builtin_convertvector(v, b2_t);
  return __builtin_bit_cast(unsigned, r);
}
__device__ __forceinline__ u16 f2bf(float a) { return (u16)(pk2(a, 0.f) & 0xffffu); }
__device__ __forceinline__ float bf2f(u16 u) { return __uint_as_float(((unsigned)u) << 16); }
__device__ __forceinline__ float bflo(unsigned u) { return __uint_as_float(u << 16); }
__device__ __forceinline__ float bfhi(unsigned u) { return __uint_as_float(u & 0xffff0000u); }
__device__ __forceinline__ float sigmoidf_(float x) { return 1.f / (1.f + __expf(-x)); }
__device__ __forceinline__ float siluf_(float x) { return x / (1.f + __expf(-x)); }
__device__ __forceinline__ f32x16 mfma32(bf16x8 a, bf16x8 b, f32x16 c) {
  return __builtin_amdgcn_mfma_f32_32x32x16_bf16(a, b, c, 0, 0, 0);
}
__device__ __forceinline__ int opaque_tid() { int t = threadIdx.x; asm volatile("" : "+v"(t)); return t; }
__device__ __forceinline__ bf16x8 ldfrag(const void* p) {
  return __builtin_bit_cast(bf16x8, *(const uint4*)p);
}

__device__ void transpose_tile(const float* __restrict__ src, u16* __restrict__ dst, int K, int N,
                               int k0, int n0, float* tile, const int tid) {
#pragma unroll
  for (int j = 0; j < 2; j++) {
    int r = (tid >> 4) + 32 * j, c4 = (tid & 15) * 4;
    float4 v = *(const float4*)(src + (size_t)(k0 + r) * N + n0 + c4);
    tile[r * 65 + c4] = v.x; tile[r * 65 + c4 + 1] = v.y; tile[r * 65 + c4 + 2] = v.z; tile[r * 65 + c4 + 3] = v.w;
  }
  __syncthreads();
  {
    int c = tid, n = c >> 3, kc = c & 7;
    const float* tp = tile + (kc * 8) * 65 + n;
    uint4 o;
    o.x = pk2(tp[0], tp[65]); o.y = pk2(tp[130], tp[195]); o.z = pk2(tp[260], tp[325]); o.w = pk2(tp[390], tp[455]);
    *(uint4*)(dst + (size_t)(n0 + n) * K + k0 + kc * 8) = o;
  }
  __syncthreads();
}

__device__ void phase0(const Params& P, char* smem) {
  const int tid = opaque_tid();
  float* tile = (float*)smem;
  const int n0_ = 4 * 16 * 141, n1_ = 4 * 16 * 16, n2_ = 4 * 32 * 2, n3_ = 4 * 2 * 1;
  const int nT = n0_ + 3 * n1_ + 2 * n2_ + 2 * n3_;
  const int nBias = 64, nRope = 128;
  const int total = nT + nBias + nRope + 1;
  for (int it = blockIdx.x; it < total; it += gridDim.x) {
    if (it < nT) {
      int t = it;
      if (t < n0_) {
        int l = t / (16 * 141), rem = t % (16 * 141);
        transpose_tile(P.w_in + (size_t)l * DM * INC, P.WinT + (size_t)l * INCP * DM, DM, INC, (rem / 141) * 64, (rem % 141) * 64, tile, tid);
        continue;
      }
      t -= n0_;
      if (t < 3 * n1_) {
        int which = t / n1_; t %= n1_;
        int l = t / 256, rem = t % 256;
        const float* s = which == 0 ? P.w_pa : (which == 1 ? P.w_pb : P.w_out);
        u16* d = which == 0 ? P.WpaT : (which == 1 ? P.WpbT : P.WoT);
        transpose_tile(s + (size_t)l * DM * DM, d + (size_t)l * DM * DM, DM, DM, (rem >> 4) * 64, (rem & 15) * 64, tile, tid);
        continue;
      }
      t -= 3 * n1_;
      if (t < 2 * n2_) {
        int kv = t / n2_; t %= n2_;
        int l = t / 64, rem = t % 64;
        const float* s = kv ? P.w1_v : P.w1_k;
        transpose_tile(s + (size_t)l * 2048 * 128, P.W1T + (size_t)(l * 2 + kv) * 128 * 2048, 2048, 128, (rem >> 1) * 64, (rem & 1) * 64, tile, tid);
        continue;
      }
      t -= 2 * n2_;
      {
        int kv = t / n3_; t %= n3_;
        int l = t / 2, rem = t % 2;
        const float* s = kv ? P.w2_v : P.w2_k;
        transpose_tile(s + (size_t)l * 128 * 64, P.W2T + (size_t)(l * 2 + kv) * 64 * 128, 128, 64, rem * 64, 0, tile, tid);
      }
    } else if (it < nT + nBias) {
      int j = it - nT;
      int l = j >> 4, kv = (j >> 3) & 1, kq = j & 7;
      const float* pe = (kv ? P.pe_v : P.pe_k) + (size_t)l * 2048;
      const float* w1 = (kv ? P.w1_v : P.w1_k) + (size_t)l * 2048 * 128;
      int hid = tid & 127, kh = tid >> 7;
      int kbeg = kq * 256 + kh * 64;
      float s = 0.f;
#pragma unroll 8
      for (int k = 0; k < 64; k++) s += pe[kbeg + k] * w1[(size_t)(kbeg + k) * 128 + hid];
      float* part = (float*)smem;
      part[tid] = s;
      __syncthreads();
      if (tid < 128) P.bias1p[((l * 2 + kv) * 8 + kq) * 128 + hid] = (part[tid] + part[tid + 128]) + (part[tid + 256] + part[tid + 384]);
      __syncthreads();
    } else if (it < nT + nBias + nRope) {
      int idx = (it - nT - nBias) * 512 + tid;
      int t = idx >> 5, j = idx & 31;
      double inv = 1.0;
      for (int q = 0; q < j; q++) inv *= 0.7498942093324558;
      float invf = (float)inv;
      float angf = (float)t * invf;
      double a = (double)angf;
      double kq = rint(a * 0.15915494309189535);
      double rr = a - kq * 6.283185307179586;
      double r2 = rr * rr;
      double sterm = rr, cterm = 1.0, ssum = rr, csum = 1.0;
#pragma unroll 1
      for (int n = 1; n <= 15; n++) {
        cterm *= -r2 / (double)((2 * n - 1) * (2 * n));
        sterm *= -r2 / (double)((2 * n) * (2 * n + 1));
        csum += cterm; ssum += sterm;
      }
      P.ropec[idx] = (float)csum;
      P.ropes[idx] = (float)ssum;
    } else {
      if (tid < 256) P.ctr[tid] = 0u;
      for (int i = tid; i < XB_WORDS; i += NTHREADS) P.xbar[i] = 0u;
    }
  }
}

__device__ void norm_phase(const float* __restrict__ xsrc, const float* __restrict__ g, u16* __restrict__ hdst, int nrows) {
  const int tid = opaque_tid();
  const int lane = tid & 63;
  const int gw = blockIdx.x * 8 + (tid >> 6), nw = gridDim.x * 8;
  float4 gv[4];
#pragma unroll
  for (int j = 0; j < 4; j++) gv[j] = *(const float4*)(g + lane * 4 + 256 * j);
  for (int row = gw; row < nrows; row += 2 * nw) {
    const float* xr0 = xsrc + (size_t)row * DM;
    const float* xr1 = xsrc + (size_t)(row + nw) * DM;
    float4 v0[4], v1[4];
#pragma unroll
    for (int j = 0; j < 4; j++) { v0[j] = *(const float4*)(xr0 + lane * 4 + 256 * j); v1[j] = *(const float4*)(xr1 + lane * 4 + 256 * j); }
    float s0 = 0.f, s1 = 0.f;
#pragma unroll
    for (int j = 0; j < 4; j++) {
      s0 += v0[j].x * v0[j].x + v0[j].y * v0[j].y + v0[j].z * v0[j].z + v0[j].w * v0[j].w;
      s1 += v1[j].x * v1[j].x + v1[j].y * v1[j].y + v1[j].z * v1[j].z + v1[j].w * v1[j].w;
    }
#pragma unroll
    for (int o = 32; o >= 1; o >>= 1) { s0 += __shfl_xor(s0, o); s1 += __shfl_xor(s1, o); }
    const float r0 = rsqrtf(s0 * (1.f / DM) + 1e-6f), r1 = rsqrtf(s1 * (1.f / DM) + 1e-6f);
#pragma unroll
    for (int j = 0; j < 4; j++) {
      uint2 o;
      o.x = pk2(v0[j].x * r0 * gv[j].x, v0[j].y * r0 * gv[j].y);
      o.y = pk2(v0[j].z * r0 * gv[j].z, v0[j].w * r0 * gv[j].w);
      *(uint2*)(hdst + (size_t)row * DM + lane * 4 + 256 * j) = o;
      o.x = pk2(v1[j].x * r1 * gv[j].x, v1[j].y * r1 * gv[j].y);
      o.y = pk2(v1[j].z * r1 * gv[j].z, v1[j].w * r1 * gv[j].w);
      *(uint2*)(hdst + (size_t)(row + nw) * DM + lane * 4 + 256 * j) = o;
    }
  }
}

__device__ void final_norm_phase(float* __restrict__ x, const float* __restrict__ g, int row0, int nrows) {
  const int tid = opaque_tid();
  const int lane = tid & 63;
  const int gw = blockIdx.x * 8 + (tid >> 6), nw = gridDim.x * 8;
  float4 gv[4];
#pragma unroll
  for (int j = 0; j < 4; j++) gv[j] = *(const float4*)(g + lane * 4 + 256 * j);
  for (int row = gw; row < nrows; row += nw) {
    float* xr = x + (size_t)(row0 + row) * DM;
    float4 v[4];
    float ss = 0.f;
#pragma unroll
    for (int j = 0; j < 4; j++) {
      v[j] = *(const float4*)(xr + lane * 4 + 256 * j);
      ss += v[j].x * v[j].x + v[j].y * v[j].y + v[j].z * v[j].z + v[j].w * v[j].w;
    }
#pragma unroll
    for (int o = 32; o >= 1; o >>= 1) ss += __shfl_xor(ss, o);
    float rstd = rsqrtf(ss * (1.f / DM) + 1e-6f);
#pragma unroll
    for (int j = 0; j < 4; j++) {
      float4 o;
      o.x = v[j].x * rstd * gv[j].x; o.y = v[j].y * rstd * gv[j].y;
      o.z = v[j].z * rstd * gv[j].z; o.w = v[j].w * rstd * gv[j].w;
      *(float4*)(xr + lane * 4 + 256 * j) = o;
    }
  }
}

struct ARow {
  const u16* p; int ld;
  __device__ __forceinline__ const u16* operator()(int row, int k) const { return p + (size_t)row * ld + k; }
};
struct ACmp {
  const u16* p;
  __device__ __forceinline__ const u16* operator()(int row, int k) const {
    int t = 16 * row + (k >> 6); t = t > (TSEQ - 1) ? (TSEQ - 1) : t;
    return p + (size_t)t * INC + (k & 63);
  }
};

template <class AF>
__device__ __forceinline__ void gemm_mainloop(AF af, const u16* __restrict__ Bt, int ldb, int K, char* smem,
                                              f32x16 (&acc)[2][2], const int tid) {
  const int lane = tid & 63, r = lane & 31, h = lane >> 5, w = tid >> 6;
  const int wm = w >> 1, wn = w & 1;
  const int lrow = tid >> 3, lch = tid & 7;
  uint4 ra[4], rb[4];
  const int nk = K >> 6;
#pragma unroll
  for (int j = 0; j < 4; j++) {
    int row = lrow + 32 * j;
    ra[j] = *(const uint4*)af(row, lch * 8);
    rb[j] = *(const uint4*)(Bt + (size_t)row * ldb + lch * 8);
  }
#pragma unroll
  for (int j = 0; j < 4; j++) {
    int row = lrow + 32 * j;
    int off = row * 128 + ((lch ^ ((row >> 1) & 7)) << 4);
    *(uint4*)(smem + off) = ra[j];
    *(uint4*)(smem + 16384 + off) = rb[j];
  }
  __syncthreads();
  for (int it = 0; it < nk; it++) {
    const bool more = (it + 1) < nk;
    if (more) {
      const int k0 = (it + 1) * 64;
#pragma unroll
      for (int j = 0; j < 4; j++) {
        int row = lrow + 32 * j;
        ra[j] = *(const uint4*)af(row, k0 + lch * 8);
        rb[j] = *(const uint4*)(Bt + (size_t)row * ldb + k0 + lch * 8);
      }
    }
    const char* sa = smem + (it & 1) * 32768;
    const char* sb = sa + 16384;
#pragma unroll
    for (int kk = 0; kk < 4; kk++) {
      bf16x8 a[2], b[2];
#pragma unroll
      for (int mi = 0; mi < 2; mi++) {
        int row = wm * 64 + mi * 32 + r;
        a[mi] = ldfrag(sa + row * 128 + (((kk * 2 + h) ^ ((row >> 1) & 7)) << 4));
      }
#pragma unroll
      for (int ni = 0; ni < 2; ni++) {
        int row = wn * 64 + ni * 32 + r;
        b[ni] = ldfrag(sb + row * 128 + (((kk * 2 + h) ^ ((row >> 1) & 7)) << 4));
      }
#pragma unroll
      for (int mi = 0; mi < 2; mi++)
#pragma unroll
        for (int ni = 0; ni < 2; ni++) acc[mi][ni] = mfma32(a[mi], b[ni], acc[mi][ni]);
    }
    if (more) {
      char* sd = smem + ((it + 1) & 1) * 32768;
#pragma unroll
      for (int j = 0; j < 4; j++) {
        int row = lrow + 32 * j;
        int off = row * 128 + ((lch ^ ((row >> 1) & 7)) << 4);
        *(uint4*)(sd + off) = ra[j];
        *(uint4*)(sd + 16384 + off) = rb[j];
      }
    }
    __syncthreads();
  }
}

__device__ __forceinline__ void zero_acc(f32x16 (&acc)[2][2]) {
#pragma unroll
  for (int a = 0; a < 2; a++)
#pragma unroll
    for (int b = 0; b < 2; b++)
#pragma unroll
      for (int i = 0; i < 16; i++) acc[a][b][i] = 0.f;
}

typedef __attribute__((ext_vector_type(8))) short s16x8;
#define G_TILE_B 32768
#define G_STAGE_B 65536
__device__ __forceinline__ int g_lds_byte(int r, int c) {
  int st = (r >> 4) * 2 + (c >> 5), ob = (r & 15) * 64 + (c & 31) * 2;
  return st * 1024 + (ob ^ (((ob >> 9) & 1) << 5));
}
__device__ __forceinline__ void g_stage_rc(int b, int& R, int& C) {
  int st = b >> 10, sb = b & 1023, swz = sb ^ (((sb >> 9) & 1) << 5);
  R = (st >> 1) * 16 + swz / 64;
  C = (st & 1) * 32 + (swz % 64) / 2;
}
#define G_WAIT_V0() asm volatile("s_waitcnt vmcnt(0)" ::: "memory")

struct GTile { int pm, pn; };
__device__ __forceinline__ bool g_next(int i, int G, int c, int nM, int nN, GTile& u) {
  const int nwg = nM * nN;
  const int L = i * G + c;
  if (L >= nwg) return false;
  int wgid = L;
  { const int q = nwg / 8, r = nwg % 8, xcd = wgid % 8, off = wgid / 8; wgid = (xcd < r ? xcd * (q + 1) : r * (q + 1) + (xcd - r) * q) + off; }
  const int nig = 8 * nN, gid = wgid / nig, fm = gid * 8, gsz = (nM - fm) < 8 ? (nM - fm) : 8;
  u.pm = fm + ((wgid % nig) % gsz);
  u.pn = (wgid % nig) / gsz;
  return true;
}

__device__ __forceinline__ void g_kloop(const u16* __restrict__ Ab, const u16* __restrict__ Bb, const int K, char* smem,
                                        f32x4 (&acc)[8][4], const int tid, const bool pre, const u16* __restrict__ nA,
                                        const u16* __restrict__ nB, const bool has_next) {
  const int wid = tid >> 6, lane = tid & 63, wr = wid >> 2, wc = wid & 3, fr = lane & 15, fq = lane >> 4;
  int sR0, sC0, sR1, sC1, sR2, sC2, sR3, sC3;
  g_stage_rc(wid * 1024 + 0 * 8192 + lane * 16, sR0, sC0);
  g_stage_rc(wid * 1024 + 1 * 8192 + lane * 16, sR1, sC1);
  g_stage_rc(wid * 1024 + 2 * 8192 + lane * 16, sR2, sC2);
  g_stage_rc(wid * 1024 + 3 * 8192 + lane * 16, sR3, sC3);
  const long o0 = (long)sR0 * K + sC0, o1 = (long)sR1 * K + sC1, o2 = (long)sR2 * K + sC2, o3 = (long)sR3 * K + sC3;
#define G_STAGE(buf, kt)                                                                                              \
  {                                                                                                                  \
    char* sa_ = smem + (buf) * G_STAGE_B + wid * 1024;                                                               \
    char* sb_ = sa_ + G_TILE_B;                                                                                      \
    const u16* ga_ = Ab + (kt) * 64;                                                                                 \
    const u16* gb_ = Bb + (kt) * 64;                                                                                 \
    __builtin_amdgcn_global_load_lds((const unsigned*)(ga_ + o0), (unsigned*)(sa_), 16, 0, 0);                       \
    __builtin_amdgcn_global_load_lds((const unsigned*)(gb_ + o0), (unsigned*)(sb_), 16, 0, 0);                       \
    __builtin_amdgcn_global_load_lds((const unsigned*)(ga_ + o1), (unsigned*)(sa_ + 8192), 16, 0, 0);                \
    __builtin_amdgcn_global_load_lds((const unsigned*)(gb_ + o1), (unsigned*)(sb_ + 8192), 16, 0, 0);                \
    __builtin_amdgcn_global_load_lds((const unsigned*)(ga_ + o2), (unsigned*)(sa_ + 16384), 16, 0, 0);               \
    __builtin_amdgcn_global_load_lds((const unsigned*)(gb_ + o2), (unsigned*)(sb_ + 16384), 16, 0, 0);               \
    __builtin_amdgcn_global_load_lds((const unsigned*)(ga_ + o3), (unsigned*)(sa_ + 24576), 16, 0, 0);               \
    __builtin_amdgcn_global_load_lds((const unsigned*)(gb_ + o3), (unsigned*)(sb_ + 24576), 16, 0, 0);               \
  }
  const int nt = K >> 6;
  if (!pre) {
    G_STAGE(0, 0);
    G_WAIT_V0();
    __syncthreads();
  }
  for (int t = 0; t < nt; ++t) {
    const int cur = t & 1;
    if (t + 1 < nt) G_STAGE(cur ^ 1, t + 1)
    else if (has_next) {
      char* sa_ = smem + wid * 1024;
      char* sb_ = sa_ + G_TILE_B;
      __builtin_amdgcn_global_load_lds((const unsigned*)(nA + o0), (unsigned*)(sa_), 16, 0, 0);
      __builtin_amdgcn_global_load_lds((const unsigned*)(nB + o0), (unsigned*)(sb_), 16, 0, 0);
      __builtin_amdgcn_global_load_lds((const unsigned*)(nA + o1), (unsigned*)(sa_ + 8192), 16, 0, 0);
      __builtin_amdgcn_global_load_lds((const unsigned*)(nB + o1), (unsigned*)(sb_ + 8192), 16, 0, 0);
      __builtin_amdgcn_global_load_lds((const unsigned*)(nA + o2), (unsigned*)(sa_ + 16384), 16, 0, 0);
      __builtin_amdgcn_global_load_lds((const unsigned*)(nB + o2), (unsigned*)(sb_ + 16384), 16, 0, 0);
      __builtin_amdgcn_global_load_lds((const unsigned*)(nA + o3), (unsigned*)(sa_ + 24576), 16, 0, 0);
      __builtin_amdgcn_global_load_lds((const unsigned*)(nB + o3), (unsigned*)(sb_ + 24576), 16, 0, 0);
    }
    const char* sa = smem + cur * G_STAGE_B;
    const char* sb = sa + G_TILE_B;
#pragma unroll
    for (int ks = 0; ks < 2; ++ks) {
      s16x8 At[8], Bf[4];
#pragma unroll
      for (int m = 0; m < 8; ++m) At[m] = *(const s16x8*)(sa + g_lds_byte(wr * 128 + m * 16 + fr, ks * 32 + fq * 8));
#pragma unroll
      for (int n = 0; n < 4; ++n) Bf[n] = *(const s16x8*)(sb + g_lds_byte(wc * 64 + n * 16 + fr, ks * 32 + fq * 8));
#pragma unroll
      for (int m = 0; m < 8; ++m)
#pragma unroll
        for (int n = 0; n < 4; ++n)
          acc[m][n] = __builtin_amdgcn_mfma_f32_16x16x32_bf16(__builtin_bit_cast(bf16x8, Bf[n]), __builtin_bit_cast(bf16x8, At[m]), acc[m][n], 0, 0, 0);
      __builtin_amdgcn_sched_barrier(0);
    }
    G_WAIT_V0();
    __syncthreads();
  }
}

__device__ __forceinline__ void g_zero(f32x4 (&acc)[8][4]) {
#pragma unroll
  for (int m = 0; m < 8; m++)
#pragma unroll
    for (int n = 0; n < 4; n++) acc[m][n] = (f32x4){0.f, 0.f, 0.f, 0.f};
}
__device__ __forceinline__ uint2 pk4(f32x4 v) { return make_uint2(pk2(v[0], v[1]), pk2(v[2], v[3])); }

__device__ __forceinline__ void wave_store_rows(char* wsm, u16* gbase, const size_t ld, const f32x4 (&acc)[8][4], const int lane) {
  const int fr = lane & 15, fq = lane >> 4;
  const int rr = lane >> 3, ch = lane & 7;
  typedef __attribute__((ext_vector_type(4))) unsigned u32x4_t;
#pragma unroll
  for (int hf = 0; hf < 2; hf++) {
#pragma unroll
    for (int m = 0; m < 4; m++)
#pragma unroll
      for (int n = 0; n < 4; n++) {
        const int row = m * 16 + fr, chunk = n * 2 + (fq >> 1);
        *(uint2*)(wsm + row * 128 + ((chunk ^ (fr & 7)) << 4) + (fq & 1) * 8) = pk4(acc[hf * 4 + m][n]);
      }
#pragma unroll
    for (int i = 0; i < 8; i++) {
      const int row = i * 8 + rr;
      const uint4 v = *(const uint4*)(wsm + row * 128 + ((ch ^ (row & 7)) << 4));
      __builtin_nontemporal_store(__builtin_bit_cast(u32x4_t, v), (u32x4_t*)(gbase + (size_t)(hf * 64 + row) * ld + ch * 8));
    }
  }
}
__device__ __forceinline__ void wave_store_cols(char* wsm, u16* vt, const int vcol0, const int nh, const int bl, const int t0,
                                                const f32x4 (&acc)[8][4], const int lane) {
  const int fr = lane & 15, fq = lane >> 4;
#pragma unroll
  for (int m = 0; m < 8; m++)
#pragma unroll
    for (int n = 0; n < 4; n++)
#pragma unroll
      for (int j = 0; j < 4; j++) {
        const int d = n * 16 + fq * 4 + j, t = m * 16 + fr;
        *(u16*)(wsm + d * 256 + (((t >> 3) ^ (d & 15)) << 4) + (t & 7) * 2) = f2bf(acc[m][n][j]);
      }
  const int dd = lane >> 4, ch = lane & 15;
#pragma unroll
  for (int i = 0; i < 16; i++) {
    const int d = i * 4 + dd;
    const uint4 v = *(const uint4*)(wsm + d * 256 + ((ch ^ (d & 15)) << 4));
    const int vcol = vcol0 + d;
    *(uint4*)(vt + ((size_t)(bl * nh + (vcol >> 6)) * 64 + (vcol & 63)) * TSEQ + t0 + ch * 8) = v;
  }
}

__device__ void gemm1_phase(const Params& P, int layer, char* smem) {
  const int CT = P.NB * TSEQ;
  const int nM = CT >> 8, nN = INCP >> 8;
  const u16* Bt = P.WinT + (size_t)layer * INCP * DM;
  u16* p_qr = P.qr; u16* p_proj = P.proj;
  asm volatile("" : "+s"(p_qr), "+s"(p_proj));
  for (int i = 0;; i++) {
    GTile u, un;
    if (!g_next(i, gridDim.x, blockIdx.x, nM, nN, u)) break;
    const bool hn = g_next(i + 1, gridDim.x, blockIdx.x, nM, nN, un);
    const int tid = opaque_tid(), wid = tid >> 6, lane = tid & 63, wr = wid >> 2, wc = wid & 3, fr = lane & 15, fq = lane >> 4;
    f32x4 acc[8][4];
    g_zero(acc);
    g_kloop(P.h + (size_t)(u.pm * 256) * DM, Bt + (size_t)(u.pn * 256) * DM, DM, smem, acc, tid, i > 0,
            P.h + (size_t)(un.pm * 256) * DM, Bt + (size_t)(un.pn * 256) * DM, hn);
    const int cw = u.pn * 256 + wc * 64;
    const int row0 = u.pm * 256 + wr * 128 + fr;
    char* wsm = smem + G_STAGE_B + wid * 8192;
    const int rowb = u.pm * 256 + wr * 128;
    const bool rope_q = cw < 1024;
    const bool rope_k = (cw >= C_KV + 256 && cw < C_KV + 384) || (cw >= C_KV + 512 && cw < C_KV + 640);
    const bool mixed = (cw == 5888);
    if (cw >= INC) {
    } else if (rope_q || rope_k) {
      if (rope_q) wave_store_rows(wsm, p_proj + (size_t)rowb * INC + cw, INC, acc, lane);
#pragma unroll
      for (int m = 0; m < 8; m++) {
        const int tt = (row0 + m * 16) & (TSEQ - 1);
#pragma unroll
        for (int n = 0; n < 2; n++) {
          const float4 c = *(const float4*)(P.ropec + tt * 32 + n * 16 + fq * 4);
          const float4 sn = *(const float4*)(P.ropes + tt * 32 + n * 16 + fq * 4);
          const f32x4 x1 = acc[m][n], x2 = acc[m][n + 2];
          f32x4 r1, r2;
          r1[0] = x1[0] * c.x - x2[0] * sn.x; r2[0] = x2[0] * c.x + x1[0] * sn.x;
          r1[1] = x1[1] * c.y - x2[1] * sn.y; r2[1] = x2[1] * c.y + x1[1] * sn.y;
          r1[2] = x1[2] * c.z - x2[2] * sn.z; r2[2] = x2[2] * c.z + x1[2] * sn.z;
          r1[3] = x1[3] * c.w - x2[3] * sn.w; r2[3] = x2[3] * c.w + x1[3] * sn.w;
          acc[m][n] = r1; acc[m][n + 2] = r2;
        }
      }
      if (rope_q) wave_store_rows(wsm, p_qr + (size_t)rowb * DM + cw, DM, acc, lane);
      else wave_store_rows(wsm, p_proj + (size_t)rowb * INC + cw, INC, acc, lane);
    } else if (!mixed) {
      wave_store_rows(wsm, p_proj + (size_t)rowb * INC + cw, INC, acc, lane);
    } else {
#pragma unroll
      for (int n = 0; n < 4; n++) {
        const int c0 = cw + n * 16 + fq * 4;
        if (c0 < C_FB) {
#pragma unroll
          for (int m = 0; m < 8; m++) *(uint2*)(p_proj + (size_t)(row0 + m * 16) * INC + c0) = pk4(acc[m][n]);
        } else {
#pragma unroll
          for (int m = 0; m < 8; m++)
            *(float4*)(P.flog + (size_t)(row0 + m * 16) * 16 + (c0 - C_FB)) = make_float4(acc[m][n][0], acc[m][n][1], acc[m][n][2], acc[m][n][3]);
        }
        __builtin_amdgcn_sched_barrier(0);
      }
    }
    __syncthreads();
  }
}

__device__ void gemm2_phase(const Params& P, int layer, char* smem) {
  const int CT = P.NB * TSEQ;
  const int nM = CT >> 8, nN = 4;
  const u16* p_ya = P.ya; const u16* p_yb = P.yb; const u16* p_wa = P.WpaT; const u16* p_wb = P.WpbT;
  for (int i = 0;; i++) {
    GTile u, un;
    if (!g_next(i, gridDim.x, blockIdx.x, nM, nN, u)) break;
    const bool hn = g_next(i + 1, gridDim.x, blockIdx.x, nM, nN, un);
    const int tid = opaque_tid(), wid = tid >> 6, lane = tid & 63, wr = wid >> 2, wc = wid & 3, fr = lane & 15, fq = lane >> 4;
    f32x4 acc[8][4];
    g_zero(acc);
#pragma unroll 1
    for (int pass = 0; pass < 2; pass++) {
      const u16* Ap = (pass ? p_yb : p_ya) + (size_t)(u.pm * 256) * DM;
      const u16* Bp = (pass ? p_wb : p_wa) + (size_t)layer * DM * DM + (size_t)(u.pn * 256) * DM;
      const u16* nAp = pass ? (p_ya + (size_t)(un.pm * 256) * DM) : (p_yb + (size_t)(u.pm * 256) * DM);
      const u16* nBp = pass ? (p_wa + (size_t)layer * DM * DM + (size_t)(un.pn * 256) * DM) : (p_wb + (size_t)layer * DM * DM + (size_t)(u.pn * 256) * DM);
      g_kloop(Ap, Bp, DM, smem, acc, tid, (i > 0) || (pass > 0), nAp, nBp, pass ? hn : true);
      __builtin_amdgcn_sched_barrier(0);
      if (pass == 0) {
        const int tid1 = opaque_tid(), wid1 = tid1 >> 6, lane1 = tid1 & 63, wr1 = wid1 >> 2, wc1 = wid1 & 3, fr1 = lane1 & 15, fq1 = lane1 >> 4;
        const u16* pp = P.proj + (size_t)(u.pm * 256 + wr1 * 128 + fr1) * INC + u.pn * 256 + wc1 * 64 + fq1 * 4;
#pragma unroll
        for (int m = 0; m < 8; m++) {
#pragma unroll
          for (int n = 0; n < 4; n++) {
            const uint2 ra = *(const uint2*)(pp + (size_t)(m * 16) * INC + C_RA + n * 16);
            const uint2 rb = *(const uint2*)(pp + (size_t)(m * 16) * INC + C_RB + n * 16);
            acc[m][n][0] *= (1.f + __expf(-bflo(rb.x))) / (1.f + __expf(-bflo(ra.x)));
            acc[m][n][1] *= (1.f + __expf(-bfhi(rb.x))) / (1.f + __expf(-bfhi(ra.x)));
            acc[m][n][2] *= (1.f + __expf(-bflo(rb.y))) / (1.f + __expf(-bflo(ra.y)));
            acc[m][n][3] *= (1.f + __expf(-bfhi(rb.y))) / (1.f + __expf(-bfhi(ra.y)));
          }
          __builtin_amdgcn_sched_barrier(0);
        }
      }
    }
    {
      const int tid2 = opaque_tid(), wid2 = tid2 >> 6, lane2 = tid2 & 63, wr2 = wid2 >> 2, wc2 = wid2 & 3, fr2 = lane2 & 15, fq2 = lane2 >> 4;
      const u16* pp = P.proj + (size_t)(u.pm * 256 + wr2 * 128 + fr2) * INC + u.pn * 256 + wc2 * 64 + fq2 * 4;
#pragma unroll
      for (int m = 0; m < 8; m++) {
#pragma unroll
        for (int n = 0; n < 4; n++) {
          const uint2 rb = *(const uint2*)(pp + (size_t)(m * 16) * INC + C_RB + n * 16);
          acc[m][n][0] *= sigmoidf_(bflo(rb.x)); acc[m][n][1] *= sigmoidf_(bfhi(rb.x));
          acc[m][n][2] *= sigmoidf_(bflo(rb.y)); acc[m][n][3] *= sigmoidf_(bfhi(rb.y));
        }
        __builtin_amdgcn_sched_barrier(0);
      }
      wave_store_rows(smem + G_STAGE_B + wid2 * 8192, P.h + (size_t)(u.pm * 256 + wr2 * 128) * DM + u.pn * 256 + wc2 * 64, DM, acc, lane2);
    }
    __syncthreads();
  }
}

__device__ void gemm3_phase(const Params& P, int layer, int chunk, char* smem) {
  const int CT = P.NB * TSEQ;
  const int nM = CT >> 8, nN = 4;
  const float* xs = (layer == 0 ? P.x_in : P.out) + (size_t)chunk * CT * DM;
  float* xd = P.out + (size_t)chunk * CT * DM;
  for (int i = 0;; i++) {
    GTile u, un;
    if (!g_next(i, gridDim.x, blockIdx.x, nM, nN, u)) break;
    const bool hn = g_next(i + 1, gridDim.x, blockIdx.x, nM, nN, un);
    const int tid = opaque_tid(), wid = tid >> 6, lane = tid & 63, wr = wid >> 2, wc = wid & 3, fr = lane & 15, fq = lane >> 4;
    f32x4 acc[8][4];
    g_zero(acc);
    g_kloop(P.h + (size_t)(u.pm * 256) * DM, P.WoT + (size_t)layer * DM * DM + (size_t)(u.pn * 256) * DM, DM, smem, acc, tid, i > 0,
            P.h + (size_t)(un.pm * 256) * DM, P.WoT + (size_t)layer * DM * DM + (size_t)(un.pn * 256) * DM, hn);
    const size_t off = (size_t)(u.pm * 256 + wr * 128 + fr) * DM + u.pn * 256 + wc * 64 + fq * 4;
#pragma unroll
    for (int m = 0; m < 8; m++) {
#pragma unroll
      for (int n = 0; n < 4; n++) {
        const float4 xo = *(const float4*)(xs + off + (size_t)(m * 16) * DM + n * 16);
        *(float4*)(xd + off + (size_t)(m * 16) * DM + n * 16) =
            make_float4(xo.x + acc[m][n][0], xo.y + acc[m][n][1], xo.z + acc[m][n][2], xo.w + acc[m][n][3]);
      }
      __builtin_amdgcn_sched_barrier(0);
    }
  }
}

__device__ __forceinline__ void compress_item(const Params& P, const int layer, const int it, char* smem_all, const int tid_all) {
  const int half = tid_all >> 8, tid = tid_all & 255;
  char* smem = smem_all + half * 65536;
  const int lane = tid & 63, r = lane & 31, h = lane >> 5, w = tid >> 6;
  const int wm = w >> 1, wn = w & 1;
  const int unit = it * 2 + half;
  const int bl = unit >> 2, g = (unit >> 1) & 1, kv = unit & 1;
  f32x16 acc[2][2];
  zero_acc(acc);
  ACmp af{P.proj + (size_t)bl * TSEQ * INC + C_KV + kv * 128 + g * 64};
  gemm_mainloop(af, P.W1T + (size_t)(layer * 2 + kv) * 128 * 2048, 2048, 2048, smem, acc, tid);
  const float* bp = P.bias1p + (size_t)((layer * 2 + kv) * 8) * 128;
#pragma unroll
  for (int ni = 0; ni < 2; ni++) {
    int hc = wn * 64 + ni * 32 + r;
    float b1 = 0.f;
#pragma unroll
    for (int q = 0; q < 8; q++) b1 += bp[q * 128 + hc];
#pragma unroll
    for (int mi = 0; mi < 2; mi++)
#pragma unroll
      for (int i = 0; i < 16; i++) {
        int n = wm * 64 + mi * 32 + 8 * (i >> 2) + 4 * h + (i & 3);
        float v = siluf_(acc[mi][ni][i] + b1);
        *(u16*)(smem + n * 256 + (((hc >> 3) ^ (n & 15)) << 4) + (hc & 7) * 2) = f2bf(v);
      }
  }
  __syncthreads();
  const u16* w2t = P.W2T + (size_t)(layer * 2 + kv) * 64 * 128;
  f32x16 o2[2];
#pragma unroll
  for (int dt = 0; dt < 2; dt++)
#pragma unroll
    for (int i = 0; i < 16; i++) o2[dt][i] = 0.f;
#pragma unroll
  for (int kk = 0; kk < 8; kk++) {
    int n = w * 32 + r;
    bf16x8 a = ldfrag(smem + n * 256 + (((kk * 2 + h) ^ (n & 15)) << 4));
#pragma unroll
    for (int dt = 0; dt < 2; dt++) {
      bf16x8 b = ldfrag(w2t + (size_t)(dt * 32 + r) * 128 + kk * 16 + h * 8);
      o2[dt] = mfma32(a, b, o2[dt]);
    }
  }
#pragma unroll
  for (int dt = 0; dt < 2; dt++) {
    int d = dt * 32 + r;
    if (kv == 0) {
#pragma unroll
      for (int i = 0; i < 16; i++) {
        int n = w * 32 + 8 * (i >> 2) + 4 * h + (i & 3);
        P.kcmp[((size_t)(bl * 2 + g) * 128 + n) * 64 + d] = f2bf(o2[dt][i]);
      }
    } else {
#pragma unroll
      for (int gq = 0; gq < 4; gq++) {
        int n0 = w * 32 + 8 * gq + 4 * h;
        uint2 o;
        o.x = pk2(o2[dt][gq * 4 + 0], o2[dt][gq * 4 + 1]);
        o.y = pk2(o2[dt][gq * 4 + 2], o2[dt][gq * 4 + 3]);
        *(uint2*)(P.vcmpt + ((size_t)(bl * 2 + g) * 64 + d) * 128 + n0) = o;
      }
    }
  }
  __syncthreads();
}

__device__ void pb_phase(const Params& P, int layer, char* smem_all) {
  const int tid = opaque_tid();
  const int lane = tid & 63, w = tid >> 6;
  float* wsum = (float*)smem_all;
  const int nScan = P.NB * 16;
  for (int it = blockIdx.x; it < nScan; it += gridDim.x) {
    const int bl = it >> 4, hh = it & 15;
    const float bf = P.b_forget[layer * 16 + hh];
    const float* fl = P.flog + ((size_t)bl * TSEQ + tid * 4) * 16 + hh;
    float ls[4];
#pragma unroll
    for (int j = 0; j < 4; j++) {
      const float x = fl[j * 16] + bf;
      ls[j] = (x >= 0.f) ? -log1pf(__expf(-x)) : (x - log1pf(__expf(x)));
    }
    const float loc = (ls[0] + ls[1]) + (ls[2] + ls[3]);
    float incl = loc;
#pragma unroll
    for (int o = 1; o < 64; o <<= 1) {
      const float v = __shfl_up(incl, o);
      if (lane >= o) incl += v;
    }
    __syncthreads();
    if (lane == 63) wsum[w] = incl;
    __syncthreads();
    float base = 0.f;
#pragma unroll
    for (int q = 0; q < 8; q++) base += (q < w) ? wsum[q] : 0.f;
    float run = base + incl - loc;
    float4 o4;
    run += ls[0]; o4.x = -8.0f * run;
    run += ls[1]; o4.y = -8.0f * run;
    run += ls[2]; o4.z = -8.0f * run;
    run += ls[3]; o4.w = -8.0f * run;
    *(float4*)(P.F2 + ((size_t)bl * 16 + hh) * TSEQ + tid * 4) = o4;
  }
}

__device__ void pc1_phase(const Params& P, char* smem) {
  const int tid = opaque_tid(),  lane = tid & 63, r = lane & 31, h = lane >> 5, w = tid >> 6;
  const int nItems = P.NB * 2 * 8;
  const float c1 = 0.125f * LOG2E;
  for (int it = blockIdx.x; it < nItems; it += gridDim.x) {
    const int qt = it & 7, g = (it >> 3) & 1, bl = it >> 4;
    __syncthreads();
#pragma unroll
    for (int j = 0; j < 2; j++) {
      int c = tid + 512 * j;
      {
        int n = c >> 3, ch = c & 7;
        uint4 v = *(const uint4*)(P.kcmp + ((size_t)(bl * 2 + g) * 128 + n) * 64 + ch * 8);
        *(uint4*)(smem + n * 128 + ((ch ^ ((n >> 1) & 7)) << 4)) = v;
      }
      {
        int d = c >> 4, ch = c & 15;
        uint4 v = *(const uint4*)(P.vcmpt + ((size_t)(bl * 2 + g) * 64 + d) * 128 + ch * 8);
        int sw = d & 31;
        *(uint2*)(smem + 16384 + d * 256 + (((2 * ch) ^ sw) << 3)) = make_uint2(v.x, v.y);
        *(uint2*)(smem + 16384 + d * 256 + (((2 * ch + 1) ^ sw) << 3)) = make_uint2(v.z, v.w);
      }
    }
    __syncthreads();
    const int qw_lo = qt * 256 + w * 32;
    const int qtok = qw_lo + r;
    const size_t rowg = (size_t)bl * TSEQ + qtok;
    const int tq = qtok - 31 - 64 * h;
    float sumacc[16], lastacc[16];
#pragma unroll
    for (int s = 0; s < 16; s++) { sumacc[s] = 0.f; lastacc[s] = 0.f; }
#pragma unroll 1
    for (int hh = 0; hh < 8; hh++) {
      const int head = g * 8 + hh;
      bf16x8 qf[4];
#pragma unroll
      for (int kk = 0; kk < 4; kk++) qf[kk] = ldfrag(P.proj + rowg * INC + C_QA + head * 64 + kk * 16 + h * 8);
      f32x16 s[4];
#pragma unroll
      for (int nt = 0; nt < 4; nt++) {
#pragma unroll
        for (int i = 0; i < 16; i++) s[nt][i] = 0.f;
#pragma unroll
        for (int kk = 0; kk < 4; kk++) {
          int row = nt * 32 + r;
          bf16x8 a = ldfrag(smem + row * 128 + (((kk * 2 + h) ^ ((row >> 1) & 7)) << 4));
          s[nt] = mfma32(a, qf[kk], s[nt]);
        }
        __builtin_amdgcn_sched_barrier(0);
      }
      float mx = -3.0e38f;
#pragma unroll
      for (int nt = 0; nt < 4; nt++)
#pragma unroll
        for (int i = 0; i < 16; i++) {
          bool ok = (16 * (nt * 32 + 8 * (i >> 2) + (i & 3))) <= tq;
          float v = ok ? s[nt][i] * c1 : -3.0e38f;
          s[nt][i] = v;
          mx = fmaxf(mx, v);
        }
      mx = fmaxf(mx, __shfl_xor(mx, 32));
      const bool anyv = mx > -1.0e37f;
      float mref = anyv ? mx : 0.f;
      float l = 0.f;
#pragma unroll
      for (int nt = 0; nt < 4; nt++)
#pragma unroll
        for (int i = 0; i < 16; i++) {
          float p = __builtin_amdgcn_exp2f(s[nt][i] - mref);
          s[nt][i] = p;
          l += p;
        }
      l += __shfl_xor(l, 32);
      const float inv = (anyv && l > 0.f) ? 1.f / l : 0.f;
#pragma unroll
      for (int nt = 0; nt < 4; nt++)
#pragma unroll
        for (int i = 0; i < 16; i++) s[nt][i] *= inv;
#pragma unroll
      for (int nt = 0; nt < 4; nt++)
#pragma unroll
        for (int gq = 0; gq < 4; gq++) {
          sumacc[nt * 4 + gq] += (s[nt][gq * 4] + s[nt][gq * 4 + 1]) + (s[nt][gq * 4 + 2] + s[nt][gq * 4 + 3]);
          lastacc[nt * 4 + gq] += s[nt][gq * 4 + 3];
        }
      uint4 pbv[8];
#pragma unroll
      for (int ks = 0; ks < 8; ks++) {
        const int nt = ks >> 1, hb = (ks & 1) * 8;
        pbv[ks].x = pk2(s[nt][hb + 0], s[nt][hb + 1]); pbv[ks].y = pk2(s[nt][hb + 2], s[nt][hb + 3]);
        pbv[ks].z = pk2(s[nt][hb + 4], s[nt][hb + 5]); pbv[ks].w = pk2(s[nt][hb + 6], s[nt][hb + 7]);
      }
      const float g0 = sigmoidf_(bf2f(P.proj[rowg * INC + C_GA + head]));
#pragma unroll
      for (int dt = 0; dt < 2; dt++) {
        f32x16 o;
#pragma unroll
        for (int i = 0; i < 16; i++) o[i] = 0.f;
        const int d = dt * 32 + r, sw = d & 31;
#pragma unroll
        for (int ks = 0; ks < 8; ks++) {
          uint2 lo = *(const uint2*)(smem + 16384 + d * 256 + (((ks * 4 + h) ^ sw) << 3));
          uint2 hi = *(const uint2*)(smem + 16384 + d * 256 + (((ks * 4 + 2 + h) ^ sw) << 3));
          uint4 au = make_uint4(lo.x, lo.y, hi.x, hi.y);
          o = mfma32(__builtin_bit_cast(bf16x8, au), __builtin_bit_cast(bf16x8, pbv[ks]), o);
        }
#pragma unroll
        for (int gq = 0; gq < 4; gq++) {
          int d0 = dt * 32 + 8 * gq + 4 * h;
          uint2 ov;
          ov.x = pk2(o[gq * 4 + 0] * g0, o[gq * 4 + 1] * g0);
          ov.y = pk2(o[gq * 4 + 2] * g0, o[gq * 4 + 3] * g0);
          *(uint2*)(P.ya + rowg * DM + head * 64 + d0) = ov;
        }
        __builtin_amdgcn_sched_barrier(0);
      }
    }
    float sc[16];
#pragma unroll
    for (int s = 0; s < 16; s++) {
      float prev = (s == 0) ? 0.f : lastacc[s - 1];
      float sendv = h ? prev : lastacc[s];
      float recv = __shfl_xor(sendv, 32);
      float imp = sumacc[s] + recv;
      int j = (s >> 2) * 8 + (s & 3) * 2 + h;
      int cur = qtok >> 6;
      bool forced = (j == 0) || (j == cur) || (j == cur - 1);
      bool valid = j <= cur;
      sc[s] = forced ? 1.0e4f : (valid ? imp : -1.0f);
    }
    unsigned mask = 0u;
#pragma unroll 1
    for (int rd = 0; rd < 8; rd++) {
      float best = -2.0f; int bj = 0;
#pragma unroll
      for (int s = 0; s < 16; s++) {
        int j = (s >> 2) * 8 + (s & 3) * 2 + h;
        if (sc[s] > best) { best = sc[s]; bj = j; }
      }
      float ob = __shfl_xor(best, 32);
      int oj = __shfl_xor(bj, 32);
      bool mine = (best > ob) || (best == ob && bj < oj);
      int wj = mine ? bj : oj;
      mask |= 1u << wj;
#pragma unroll
      for (int s = 0; s < 16; s++) {
        int j = (s >> 2) * 8 + (s & 3) * 2 + h;
        if (j == wj) sc[s] = -3.0f;
      }
    }
    if (h == 0) P.sel[(size_t)(bl * 2 + g) * TSEQ + qtok] = mask;
  }
}

#define A_SLOTB 8192
#define A_LDS_K 0
#define A_LDS_V 24576
#define A_LDS_WS 49152
#define A_LDS_F 51200
#define A_LDS_OST 52224
#define A_THR 8.0f
#define A_C2 (0.125f * LOG2E)
typedef __attribute__((ext_vector_type(4))) short a_s16x4;
typedef __attribute__((ext_vector_type(8))) short a_s16x8;
typedef __attribute__((ext_vector_type(4))) unsigned a_u32x4;
typedef __attribute__((address_space(3))) const char* a_lds_cptr;
typedef short a_v4i16 __attribute__((ext_vector_type(4)));
#define A_SBAR() __builtin_amdgcn_sched_barrier(0)
#define A_PIN(x) asm volatile("" : "+v"(x))
#define A_MFMA(a, b, c) __builtin_amdgcn_mfma_f32_32x32x16_bf16(a, b, c, 0, 0, 0)
template <int N> __device__ __forceinline__ void a_wait_bar() { asm volatile("s_waitcnt vmcnt(%0) lgkmcnt(0)\n\ts_barrier" ::"n"(N) : "memory"); }
__device__ __forceinline__ int a_crow(int r, int hi) { return (r & 3) + 8 * (r >> 2) + 4 * hi; }
__device__ __forceinline__ unsigned a_cvtpk(float lo, float hi) { unsigned r; asm("v_cvt_pk_bf16_f32 %0, %1, %2" : "=v"(r) : "v"(lo), "v"(hi)); return r; }
__device__ __forceinline__ void a_glds16(const void* g, unsigned lds_base) {
  unsigned sv; asm volatile("s_mov_b32 %0, m0\n\ts_mov_b32 m0, %2\n\ts_nop 0\n\tglobal_load_lds_dwordx4 %1, off\n\ts_mov_b32 m0, %0" : "=&s"(sv) : "v"(g), "s"(lds_base) : "memory"); }
__device__ __forceinline__ void a_glds4(const void* g, unsigned lds_base) {
  unsigned sv; asm volatile("s_mov_b32 %0, m0\n\ts_mov_b32 m0, %2\n\ts_nop 0\n\tglobal_load_lds_dword %1, off\n\ts_mov_b32 m0, %0" : "=&s"(sv) : "v"(g), "s"(lds_base) : "memory"); }
__device__ __forceinline__ void a_kload2(bf16x8* kf, a_lds_cptr kp, int d0) {
  kf[2 * d0] = *(const __attribute__((address_space(3))) bf16x8*)(kp + d0 * 2048);
  kf[2 * d0 + 1] = *(const __attribute__((address_space(3))) bf16x8*)(kp + d0 * 2048 + 512); }
__device__ __forceinline__ a_s16x4 a_vtr(a_lds_cptr p) { return __builtin_bit_cast(a_s16x4, __builtin_amdgcn_ds_read_tr16_b64_v4i16((__attribute__((address_space(3))) a_v4i16*)p)); }
#define A_MX3(a, b, c) __builtin_fmaxf(__builtin_fmaxf((a), (b)), (c))
__device__ __forceinline__ float a_rowmax(const f32x16& p0, const f32x16& p1) {
  float a = A_MX3(p0[0], p0[1], p1[0]), b = A_MX3(p0[2], p0[3], p1[1]); a = A_MX3(a, p1[2], p1[3]);
#pragma unroll
  for (int r = 4; r < 16; r += 4) { a = A_MX3(a, p0[r], p0[r + 1]); b = A_MX3(b, p0[r + 2], p0[r + 3]); a = A_MX3(a, p1[r], p1[r + 1]); b = A_MX3(b, p1[r + 2], p1[r + 3]); }
  float m = __builtin_fmaxf(a, b); auto rr = __builtin_amdgcn_permlane32_swap(__float_as_uint(m), __float_as_uint(m), false, false);
  return __builtin_fmaxf(__uint_as_float(rr[0]), __uint_as_float(rr[1])); }
template <int MODE>
__device__ __forceinline__ void a_mask(f32x16& p0, f32x16& p1, int key0, int qabs, int hi) {
  const int kb = key0 + 4 * hi;
#pragma unroll
  for (int r = 0; r < 16; ++r) {
    const int kv = kb + (r & 3) + 8 * (r >> 2);
    bool bad0 = kv > qabs, bad1 = (kv + 32) > qabs;
    if (MODE == 2) { bad0 = bad0 || (kv + 512 <= qabs); bad1 = bad1 || (kv + 32 + 512 <= qabs); }
    if (bad0) p0[r] = -INFINITY;
    if (bad1) p1[r] = -INFINITY;
  } }
__device__ __forceinline__ void a_bias(f32x16& p0, f32x16& p1, const char* fb, int hi) {
#pragma unroll
  for (int g = 0; g < 4; ++g) {
    const float4 b0 = *(const float4*)(fb + (8 * g + 4 * hi) * 4);
    const float4 b1 = *(const float4*)(fb + (32 + 8 * g + 4 * hi) * 4);
    p0[4 * g + 0] += b0.x; p0[4 * g + 1] += b0.y; p0[4 * g + 2] += b0.z; p0[4 * g + 3] += b0.w;
    p1[4 * g + 0] += b1.x; p1[4 * g + 1] += b1.y; p1[4 * g + 2] += b1.z; p1[4 * g + 3] += b1.w;
  } }

template <int MODE>
__device__ __forceinline__ void a_unit(const u16* __restrict__ Qw, const int qp, const u16* __restrict__ Kp, const u16* __restrict__ Vp,
                                       const float* __restrict__ Fp, const int NT, const int key00, const int qabs, const unsigned selm,
                                       const float gate, char* lds, u16* stg, const int tid) {
  constexpr int NK = (MODE == 0) ? 2 : 1;
  const int lane = tid & 63, r32 = lane & 31, hi = lane >> 5; const int wid = __builtin_amdgcn_readfirstlane(tid >> 6);
  const unsigned lds0 = (unsigned)(uintptr_t)lds; float* wsf = (float*)(lds + A_LDS_WS) + wid * 64;
  const u16* ksrc = Kp + (long)lane * INC + wid * 8;
  const u16* vsrc = Vp + (long)(16 * (wid & 3) + (lane >> 2)) * INC + (wid >> 2) * 32 + (lane & 3) * 8;
  const float* fsrc = Fp + lane;
  const unsigned kdst = lds0 + A_LDS_K + wid * 1024, vdst = lds0 + A_LDS_V + wid * 1024, fdst = lds0 + A_LDS_F;
#define A_DMA_K(t, slot) do { a_glds16(ksrc + (long)(t) * 64 * INC, (unsigned)__builtin_amdgcn_readfirstlane(kdst + (slot))); \
    if (MODE == 0) a_glds4(fsrc + (t) * 64, (unsigned)__builtin_amdgcn_readfirstlane(fdst + ((t) & 3) * 256)); } while (0)
#define A_DMA_V(t, slot) a_glds16(vsrc + (long)(t) * 64 * INC, (unsigned)__builtin_amdgcn_readfirstlane(vdst + (slot)))
  const a_lds_cptr vp0 = (a_lds_cptr)lds + A_LDS_V + ((lane >> 4) & 1) * 32 + (lane & 3) * 8 + (4 * hi + ((lane & 15) >> 2)) * 64;
  const a_lds_cptr kp0 = (a_lds_cptr)lds + A_LDS_K + hi * 1024 + r32 * 16;
  const char* fb0 = lds + A_LDS_F;
  A_DMA_K(0, 0); A_DMA_V(0, 0); A_DMA_K(1, A_SLOTB);
  bf16x8 qr[4];
#pragma unroll
  for (int d0 = 0; d0 < 4; ++d0) qr[d0] = ldfrag(Qw + (long)r32 * qp + d0 * 16 + hi * 8);
  float mhat = 0.f, l_reg = 0.f; f32x16 o[2];
#pragma unroll
  for (int r = 0; r < 16; ++r) { o[0][r] = 0.f; o[1][r] = 0.f; }
  const f32x16 zero16 = {0.f, 0.f, 0.f, 0.f, 0.f, 0.f, 0.f, 0.f, 0.f, 0.f, 0.f, 0.f, 0.f, 0.f, 0.f, 0.f};
  bool resc = false;
  f32x16 pA0, pA1, pB0, pB1; bf16x8 kf[8]; a_s16x4 vlo[8], vhi[8]; a_u32x4 pw0, pw1, pw2, pw3;
  int sl_prev = 0, sl_cur = 0, sl_next = A_SLOTB;
#define A_ROT() do { sl_prev = sl_cur; sl_cur = sl_next; sl_next = (sl_next == 2 * A_SLOTB) ? 0 : sl_next + A_SLOTB; } while (0)
#define A_EX(v) __builtin_amdgcn_exp2f(__builtin_fmaf((v), A_C2, nmh))
#define A_RESC() do { if (resc) { _Pragma("unroll") for (int d_ = 0; d_ < 2; ++d_) _Pragma("unroll") for (int r = 0; r < 16; ++r) o[d_][r] *= wsf[a_crow(r, hi)]; } } while (0)
  A_DMA_K(2, 2 * A_SLOTB);
  a_wait_bar<1 + 2 * NK>();
  _Pragma("unroll") for (int d0 = 0; d0 < 4; ++d0) a_kload2(kf, kp0, d0);
  pA0 = A_MFMA(kf[0], qr[0], zero16); pA1 = A_MFMA(kf[1], qr[0], zero16); pA0 = A_MFMA(kf[2], qr[1], pA0); pA1 = A_MFMA(kf[3], qr[1], pA1);
  pA0 = A_MFMA(kf[4], qr[2], pA0); pA1 = A_MFMA(kf[5], qr[2], pA1); pA0 = A_MFMA(kf[6], qr[3], pA0); pA1 = A_MFMA(kf[7], qr[3], pA1);
  if (MODE == 0) a_bias(pA0, pA1, fb0, hi);
  if (MODE == 2 || NT == 4) a_mask<MODE>(pA0, pA1, key00, qabs, hi);
  { const float rm = a_rowmax(pA0, pA1); mhat = __builtin_fmaxf(rm * A_C2, -1.0e30f); const float nmh = -mhat;
#pragma unroll
    for (int r = 0; r < 16; ++r) { pA0[r] = A_EX(pA0[r]); pA1[r] = A_EX(pA1[r]); } }
  a_wait_bar<0>();
  A_DMA_K(3, 0); A_DMA_V(1, A_SLOTB); A_ROT();
  _Pragma("unroll") for (int d0 = 0; d0 < 4; ++d0) a_kload2(kf, kp0 + sl_cur, d0);
  a_wait_bar<NK + 1>();
#define A_PKW(P, i) a_cvtpk(P[i], P[i + 1])
#define A_PAF(k) __builtin_bit_cast(bf16x8, pw##k)
#define A_VFR(i) __builtin_bit_cast(bf16x8, __builtin_shufflevector(vlo[i], vhi[i], 0, 1, 2, 3, 4, 5, 6, 7))
#define A_VRD(i) do { vlo[i] = a_vtr(vp_ + (((i) >> 2) * 4096 + ((i) & 3) * 1024)); vhi[i] = a_vtr(vp_ + (((i) >> 2) * 4096 + ((i) & 3) * 1024 + 512)); } while (0)
#define A_KRD(G, d0) do { if (G) { a_kload2(kf, kp0 + sl_next, d0); A_SBAR(); } } while (0)
#define A_GAPA(MF, a0, a1, a2, a3, W0, W1, PW) do { MF; sacc += a0; sacc += a1; sacc += a2; sacc += a3; W0; W1; A_PIN(PW); A_PIN(sacc); A_SBAR(); } while (0)
#define A_GAPB(MF, X, i) do { MF; X[i] = A_EX(X[i]); X[i + 1] = A_EX(X[i + 1]); X[i + 2] = A_EX(X[i + 2]); X[i + 3] = A_EX(X[i + 3]); A_PIN(X); A_SBAR(); } while (0)
#define A_STEP(C0, C1, P0, P1, t, MASK, GK, GV, GL) do { A_SBAR(); \
    const a_lds_cptr vp_ = vp0 + sl_prev; \
    A_VRD(0); A_SBAR(); float sacc = P0[0] + P0[1]; \
                      A_GAPA(C0 = A_MFMA(kf[0], qr[0], zero16), P0[2], P0[3], P0[4], P0[5],     pw0[0] = A_PKW(P0, 0),  pw0[1] = A_PKW(P0, 2),  pw0); \
    A_VRD(4); A_SBAR(); A_GAPA(C1 = A_MFMA(kf[1], qr[0], zero16), P0[6], P0[7], P0[8], P0[9],     pw0[2] = A_PKW(P0, 4),  pw0[3] = A_PKW(P0, 6),  pw0); \
    A_VRD(1); A_SBAR(); A_GAPA(C0 = A_MFMA(kf[2], qr[1], C0),    P0[10], P0[11], P0[12], P0[13], pw1[0] = A_PKW(P0, 8),  pw1[1] = A_PKW(P0, 10), pw1); \
    A_VRD(5); A_SBAR(); A_GAPA(C1 = A_MFMA(kf[3], qr[1], C1),    P0[14], P0[15], P1[0], P1[1],   pw1[2] = A_PKW(P0, 12), pw1[3] = A_PKW(P0, 14), pw1); \
    A_VRD(2); A_SBAR(); A_GAPA(C0 = A_MFMA(kf[4], qr[2], C0),    P1[2], P1[3], P1[4], P1[5],     pw2[0] = A_PKW(P1, 0),  pw2[1] = A_PKW(P1, 2),  pw2); \
    A_VRD(6); A_SBAR(); A_GAPA(C1 = A_MFMA(kf[5], qr[2], C1),    P1[6], P1[7], P1[8], P1[9],     pw2[2] = A_PKW(P1, 4),  pw2[3] = A_PKW(P1, 6),  pw2); \
    A_VRD(3); A_SBAR(); A_GAPA(C0 = A_MFMA(kf[6], qr[3], C0),    P1[10], P1[11], P1[12], P1[13], pw3[0] = A_PKW(P1, 8),  pw3[1] = A_PKW(P1, 10), pw3); \
    A_VRD(7); A_SBAR(); A_GAPA(C1 = A_MFMA(kf[7], qr[3], C1),    P1[14], P1[15], 0.f, 0.f,       pw3[2] = A_PKW(P1, 12), pw3[3] = A_PKW(P1, 14), pw3); \
    l_reg += sacc; \
    if (GK) A_DMA_K((t) + 3, sl_cur); if (GV) A_DMA_V((t) + 1, sl_next); \
    if (MODE == 0) a_bias(C0, C1, fb0 + ((t) & 3) * 256, hi); \
    if (MASK) a_mask<MODE>(C0, C1, key00 + (t) * 64, qabs, hi); \
    const bool selb_ = (MODE != 1) || (((selm >> ((t) & 31)) & 1u) != 0u); \
    { float rmx = a_rowmax(C0, C1) * A_C2; if (!selb_) rmx = -INFINITY; resc = false; \
      if (__builtin_expect(__any((rmx - mhat) > A_THR), 0)) { const float mnew = __builtin_fmaxf(mhat, rmx); \
          const float f = __builtin_amdgcn_exp2f(mhat - mnew); mhat = mnew; l_reg *= f; if (hi == 0) wsf[r32] = f; resc = true; } } \
    const float nmh = selb_ ? -mhat : -INFINITY; A_SBAR(); \
    A_GAPB(o[0] = A_MFMA(A_PAF(0), A_VFR(0), o[0]), C0, 0);              A_GAPB(o[1] = A_MFMA(A_PAF(0), A_VFR(4), o[1]), C0, 4); \
    A_KRD(GL, 0); A_GAPB(o[0] = A_MFMA(A_PAF(1), A_VFR(1), o[0]), C0, 8);  A_KRD(GL, 1); A_GAPB(o[1] = A_MFMA(A_PAF(1), A_VFR(5), o[1]), C0, 12); \
    A_KRD(GL, 2); A_GAPB(o[0] = A_MFMA(A_PAF(2), A_VFR(2), o[0]), C1, 0);  A_KRD(GL, 3); A_GAPB(o[1] = A_MFMA(A_PAF(2), A_VFR(6), o[1]), C1, 4); \
    A_GAPB(o[0] = A_MFMA(A_PAF(3), A_VFR(3), o[0]), C1, 8);              A_GAPB(o[1] = A_MFMA(A_PAF(3), A_VFR(7), o[1]), C1, 12); \
    } while (0)
  int t = 1;
  if (MODE != 2) {
    for (; t + 5 < NT; t += 2) {
      A_STEP(pB0, pB1, pA0, pA1, t, false, true, true, true);     a_wait_bar<NK + 1>(); A_RESC(); A_ROT();
      A_STEP(pA0, pA1, pB0, pB1, t + 1, false, true, true, true); a_wait_bar<NK + 1>(); A_RESC(); A_ROT();
    }
  }
#define A_ENDW(tt) do { if ((tt) + 3 < NT) { a_wait_bar<NK + 1>(); } else if ((tt) + 2 < NT) { a_wait_bar<1>(); } else { a_wait_bar<0>(); } } while (0)
  for (; t + 1 < NT; t += 2) {
    A_STEP(pB0, pB1, pA0, pA1, t, (MODE != 2 || t < 4 || t + 4 >= NT), (t + 3 < NT), (t + 1 < NT), (t + 1 < NT));             A_ENDW(t);     A_RESC(); A_ROT();
    A_STEP(pA0, pA1, pB0, pB1, t + 1, (MODE != 2 || t + 1 < 4 || t + 5 >= NT), (t + 4 < NT), (t + 2 < NT), (t + 2 < NT));     A_ENDW(t + 1); A_RESC(); A_ROT();
  }
  A_STEP(pB0, pB1, pA0, pA1, NT - 1, true, false, false, false); A_RESC();
  { float sacc = pB0[0] + pB0[1];
#pragma unroll
    for (int r = 2; r < 16; ++r) sacc += pB0[r];
#pragma unroll
    for (int r = 0; r < 16; ++r) sacc += pB1[r];
    l_reg += sacc;
    pw0 = (a_u32x4){A_PKW(pB0, 0), A_PKW(pB0, 2), A_PKW(pB0, 4), A_PKW(pB0, 6)}; pw1 = (a_u32x4){A_PKW(pB0, 8), A_PKW(pB0, 10), A_PKW(pB0, 12), A_PKW(pB0, 14)};
    pw2 = (a_u32x4){A_PKW(pB1, 0), A_PKW(pB1, 2), A_PKW(pB1, 4), A_PKW(pB1, 6)}; pw3 = (a_u32x4){A_PKW(pB1, 8), A_PKW(pB1, 10), A_PKW(pB1, 12), A_PKW(pB1, 14)};
    const a_lds_cptr vp_ = vp0 + sl_cur; _Pragma("unroll") for (int i = 0; i < 8; ++i) A_VRD(i);
    o[0] = A_MFMA(A_PAF(0), A_VFR(0), o[0]); o[1] = A_MFMA(A_PAF(0), A_VFR(4), o[1]); o[0] = A_MFMA(A_PAF(1), A_VFR(1), o[0]); o[1] = A_MFMA(A_PAF(1), A_VFR(5), o[1]);
    o[0] = A_MFMA(A_PAF(2), A_VFR(2), o[0]); o[1] = A_MFMA(A_PAF(2), A_VFR(6), o[1]); o[0] = A_MFMA(A_PAF(3), A_VFR(3), o[0]); o[1] = A_MFMA(A_PAF(3), A_VFR(7), o[1]); }
  { auto rr = __builtin_amdgcn_permlane32_swap(__float_as_uint(l_reg), __float_as_uint(l_reg), false, false); l_reg = __uint_as_float(rr[0]) + __uint_as_float(rr[1]); }
  if (hi == 0) wsf[32 + r32] = gate / l_reg;
  asm volatile("s_waitcnt lgkmcnt(0)" ::: "memory");
  float rli[16];
#pragma unroll
  for (int r = 0; r < 16; ++r) rli[r] = wsf[32 + a_crow(r, hi)];
#pragma unroll
  for (int r = 0; r < 16; ++r) { const int orow = a_crow(r, hi);
#pragma unroll
    for (int d0 = 0; d0 < 2; ++d0) stg[orow * 64 + d0 * 32 + r32] = f2bf(o[d0][r] * rli[r]); }
  asm volatile("s_waitcnt lgkmcnt(0)\n\ts_barrier" ::: "memory");
#undef A_DMA_K
#undef A_DMA_V
#undef A_ROT
#undef A_EX
#undef A_RESC
#undef A_PKW
#undef A_PAF
#undef A_VFR
#undef A_VRD
#undef A_KRD
#undef A_ENDW
#undef A_GAPA
#undef A_GAPB
#undef A_STEP
}

__device__ void pc2_phase(const Params& P, int layer, int chunk, char* smem, int* s_item, const int which) {
  volatile __attribute__((address_space(3))) unsigned* xst = (volatile __attribute__((address_space(3))) unsigned*)(smem + XB_LDS_OFF);
  const int nx = (int)xst[1], xc = (int)xst[3];
  const int nBH = P.NB * 16;
  const int nStr = which ? (P.NB * 2) : nBH;
  const int nLoc = (nStr - xc + nx - 1) / nx;
  const int nCmpAll = which ? 0 : P.NB * 2;
  const int nCmp = which ? 0 : (nCmpAll - xc + nx - 1) / nx;
  const int nItems = nCmp + (which ? nLoc * 64 : ((nLoc + 3) >> 2) * 32);
  unsigned* ctr = P.ctr + ((chunk * 4 + layer) * 2 + which) * 8 + xc;
  while (true) {
    const int tid = opaque_tid(), lane = tid & 63, r32 = lane & 31, w = tid >> 6;
    __syncthreads();
    if (tid == 0) *s_item = (int)atomicAdd(ctr, 1u);
    __syncthreads();
    const int it0 = *s_item;
    if (it0 >= nItems) break;
    if (it0 < nCmp) { compress_item(P, layer, xc + nx * it0, smem, tid); continue; }
    const int it = it0 - nCmp;
    int qt, bh;
    if (which) {
      const int sl = it >> 6, rem = it & 63;
      qt = 7 - (rem >> 3);
      bh = (xc + nx * sl) * 8 + (rem & 7);
    } else {
      const int grp = it >> 5, rem = it & 31;
      const int sl = grp * 4 + (rem & 3);
      qt = 7 - (rem >> 2);
      if (sl >= nLoc) continue;
      bh = xc + nx * sl;
    }
    const int type = which;
    const int bl = bh >> 4, head = bh & 15;
    const int q0w = qt * 256 + w * 32;
    const int qabs = q0w + r32;
    const size_t rowq = (size_t)bl * TSEQ + qabs;
    const size_t roww = (size_t)bl * TSEQ + q0w;
    const u16* pb_ = P.proj + (size_t)bl * TSEQ * INC;
    u16* stg = (u16*)(smem + A_LDS_OST) + w * 4096;
    const int er = lane >> 3, ec = (lane & 7) * 8;
    if (type == 0) {
      a_unit<0>(pb_ + roww * 0 + (size_t)q0w * INC + C_QB + head * 64, INC, pb_ + C_KB + head * 64, pb_ + C_VB + head * 64,
                P.F2 + (size_t)(bl * 16 + head) * TSEQ, 4 * qt + 4, 0, qabs, 0u, 1.0f, smem, stg, tid);
#pragma unroll
      for (int i = 0; i < 4; i++) {
        const int row = i * 8 + er;
        const uint4 ov = *(const uint4*)(stg + row * 64 + ec);
        const uint4 zz = *(const uint4*)(pb_ + (size_t)(q0w + row) * INC + C_ZB + head * 64 + ec);
        uint4 y;
        y.x = pk2(bflo(ov.x) * siluf_(bflo(zz.x)), bfhi(ov.x) * siluf_(bfhi(zz.x)));
        y.y = pk2(bflo(ov.y) * siluf_(bflo(zz.y)), bfhi(ov.y) * siluf_(bfhi(zz.y)));
        y.z = pk2(bflo(ov.z) * siluf_(bflo(zz.z)), bfhi(ov.z) * siluf_(bfhi(zz.z)));
        y.w = pk2(bflo(ov.w) * siluf_(bflo(zz.w)), bfhi(ov.w) * siluf_(bfhi(zz.w)));
        *(uint4*)(P.yb + (roww + row) * DM + head * 64 + ec) = y;
      }
    } else {
      const int g = head >> 3;
      const unsigned selm = P.sel[(size_t)(bl * 2 + g) * TSEQ + qabs];
      const float g1 = sigmoidf_(bf2f(P.proj[rowq * INC + C_GA + 16 + head]));
      const float g2 = sigmoidf_(bf2f(P.proj[rowq * INC + C_GA + 32 + head]));
      const u16* qw = P.qr + roww * DM + head * 64;
      a_unit<1>(qw, DM, pb_ + C_KV + 256 + g * 64, pb_ + C_KV + 384 + g * 64, nullptr, 4 * qt + 4, 0, qabs, selm, g1, smem, stg, tid);
      const int klo = (4 * qt - 8) > 0 ? (4 * qt - 8) : 0;
      a_unit<2>(qw, DM, pb_ + (size_t)(klo * 64) * INC + C_KV + 512 + g * 64, pb_ + (size_t)(klo * 64) * INC + C_KV + 640 + g * 64, nullptr,
                4 * qt + 4 - klo, klo * 64, qabs, 0u, g2, smem, stg + 2048, tid);
#pragma unroll
      for (int i = 0; i < 4; i++) {
        const int row = i * 8 + er;
        const uint4 o1 = *(const uint4*)(stg + row * 64 + ec);
        const uint4 o2 = *(const uint4*)(stg + 2048 + row * 64 + ec);
        const uint4 zz = *(const uint4*)(pb_ + (size_t)(q0w + row) * INC + C_ZA + head * 64 + ec);
        u16* yp = P.ya + (roww + row) * DM + head * 64 + ec;
        const uint4 oc = *(const uint4*)yp;
        uint4 y;
        y.x = pk2((bflo(o1.x) + bflo(o2.x) + bflo(oc.x)) * siluf_(bflo(zz.x)), (bfhi(o1.x) + bfhi(o2.x) + bfhi(oc.x)) * siluf_(bfhi(zz.x)));
        y.y = pk2((bflo(o1.y) + bflo(o2.y) + bflo(oc.y)) * siluf_(bflo(zz.y)), (bfhi(o1.y) + bfhi(o2.y) + bfhi(oc.y)) * siluf_(bfhi(zz.y)));
        y.z = pk2((bflo(o1.z) + bflo(o2.z) + bflo(oc.z)) * siluf_(bflo(zz.z)), (bfhi(o1.z) + bfhi(o2.z) + bfhi(oc.z)) * siluf_(bfhi(zz.z)));
        y.w = pk2((bflo(o1.w) + bflo(o2.w) + bflo(oc.w)) * siluf_(bflo(zz.w)), (bfhi(o1.w) + bfhi(o2.w) + bfhi(oc.w)) * siluf_(bfhi(zz.w)));
        *(uint4*)yp = y;
      }
    }
  }
}

#define XB_XCNT(j) (64 * (j))
#define XB_XSUB(j) (1024 + 64 * (j))
#define XB_XGEN(j) (2048 + 64 * (j))
#define XB_TOP 3072
#define XB_TOPGEN 3136
__device__ __forceinline__ unsigned xb_ld(unsigned* p) { return __hip_atomic_load(p, __ATOMIC_RELAXED, __HIP_MEMORY_SCOPE_AGENT); }
__device__ __forceinline__ unsigned xb_add(unsigned* p, unsigned v) { return __hip_atomic_fetch_add(p, v, __ATOMIC_RELAXED, __HIP_MEMORY_SCOPE_AGENT); }
__device__ __forceinline__ unsigned xb_xcc_id() { return (unsigned)__builtin_amdgcn_s_getreg((3 << 11) | 20) & 0xFu; }
__device__ __forceinline__ void grid_bar(unsigned* bar, char* smem) {
  asm volatile("s_waitcnt vmcnt(0) lgkmcnt(0)" ::: "memory");
  __syncthreads();
  if (threadIdx.x == 0) {
    volatile unsigned* st = (volatile unsigned*)(smem + XB_LDS_OFF);
    const unsigned nloc = st[0], nx = st[1], x = st[2];
    const unsigned old = xb_add(&bar[XB_XSUB(x)], 1u);
    const unsigned gen = old / nloc;
    if (old + 1u == (gen + 1u) * nloc) {
      __builtin_amdgcn_fence(__ATOMIC_RELEASE, "agent");
      asm volatile("s_waitcnt vmcnt(0)" ::: "memory");
      const unsigned og = xb_add(&bar[XB_TOP], 1u);
      const unsigned tg = og / nx;
      if (og + 1u == (tg + 1u) * nx) xb_add(&bar[XB_TOPGEN], 1u);
      else { while (xb_ld(&bar[XB_TOPGEN]) == tg) __builtin_amdgcn_s_sleep(1); }
      __builtin_amdgcn_fence(__ATOMIC_ACQUIRE, "agent");
      xb_add(&bar[XB_XGEN(x)], 1u);
      asm volatile("s_waitcnt vmcnt(0)" ::: "memory");
    } else {
      while (xb_ld(&bar[XB_XGEN(x)]) == gen) __builtin_amdgcn_s_sleep(1);
      __builtin_amdgcn_fence(__ATOMIC_ACQUIRE, "agent");
      asm volatile("s_waitcnt vmcnt(0)" ::: "memory");
    }
  }
  __syncthreads();
}

__global__ void __launch_bounds__(NTHREADS, 2) mega_kernel(Params P) {
  __shared__ __attribute__((aligned(1024))) char smem[163840];
  cg::grid_group grid = cg::this_grid();
  const int CT = P.NB * TSEQ;
  phase0(P, smem);
  grid.sync();
  if (threadIdx.x == 0) (void)xb_add(&P.xbar[XB_XCNT(xb_xcc_id())], 1u);
  grid.sync();
  if (threadIdx.x == 0) {
    unsigned cnt = 0u, mine = 0u, rank = 0u; const unsigned x = xb_xcc_id();
#pragma unroll 1
    for (unsigned j = 0; j < 16; ++j) { const unsigned c = xb_ld(&P.xbar[XB_XCNT(j)]); cnt += (c > 0u) ? 1u : 0u; mine = (j == x) ? c : mine; rank += (c > 0u && j < x) ? 1u : 0u; }
    volatile unsigned* st = (volatile unsigned*)(smem + XB_LDS_OFF);
    st[0] = mine > 0u ? mine : 1u; st[1] = cnt > 0u ? cnt : 1u; st[2] = x; st[3] = rank;
  }
  __syncthreads();
  for (int chunk = 0; chunk < P.nchunk; chunk++) {
    for (int layer = 0; layer < 4; layer++) {
      const float* xs = (layer == 0 ? P.x_in : P.out) + (size_t)chunk * CT * DM;
      norm_phase(xs, P.norm_g + layer * DM, P.h, CT);
      if (layer == 0 && chunk > 0) final_norm_phase(P.out, P.final_g, (chunk - 1) * CT, CT);
      grid_bar(P.xbar, smem);
      gemm1_phase(P, layer, smem);
      grid_bar(P.xbar, smem);
      pb_phase(P, layer, smem);
      grid_bar(P.xbar, smem);
      pc2_phase(P, layer, chunk, smem, (int*)(smem + 140000), 0);
      grid_bar(P.xbar, smem);
      pc1_phase(P, smem);
      grid_bar(P.xbar, smem);
      pc2_phase(P, layer, chunk, smem, (int*)(smem + 140000), 1);
      grid_bar(P.xbar, smem);
      gemm2_phase(P, layer, smem);
      grid_bar(P.xbar, smem);
      gemm3_phase(P, layer, chunk, smem);
      grid_bar(P.xbar, smem);
    }
  }
  final_norm_phase(P.out, P.final_g, (P.nchunk - 1) * CT, CT);
}

static inline size_t al256(size_t x) { return (x + 255) & ~(size_t)255; }

extern "C" void kernel_launch(void* const* d_in, const int* in_sizes, int n_in, void* d_out, int out_size,
                              void* d_ws, size_t ws_size, hipStream_t stream) {
  (void)in_sizes; (void)n_in; (void)out_size;
  Params P{};
  P.x_in = (const float*)d_in[0]; P.norm_g = (const float*)d_in[1]; P.w_in = (const float*)d_in[2];
  P.b_forget = (const float*)d_in[3];
  P.pe_k = (const float*)d_in[4]; P.w1_k = (const float*)d_in[5]; P.w2_k = (const float*)d_in[6];
  P.pe_v = (const float*)d_in[7]; P.w1_v = (const float*)d_in[8]; P.w2_v = (const float*)d_in[9];
  P.w_pa = (const float*)d_in[10]; P.w_pb = (const float*)d_in[11]; P.w_out = (const float*)d_in[12];
  P.final_g = (const float*)d_in[13];
  P.out = (float*)d_out;
  int NB = 16;
  char* base = (char*)d_ws;
  for (;;) {
    const size_t CT = (size_t)NB * TSEQ;
    size_t off = 0;
    auto take = [&](size_t bytes) { size_t o = off; off = al256(off + bytes); return o; };
    size_t oWin = take((size_t)4 * INCP * DM * 2), oWpa = take((size_t)4 * DM * DM * 2), oWpb = take((size_t)4 * DM * DM * 2),
           oWo = take((size_t)4 * DM * DM * 2), oW1 = take((size_t)8 * 128 * 2048 * 2), oW2 = take((size_t)8 * 64 * 128 * 2),
           oB1 = take((size_t)64 * 128 * 4), oRc = take((size_t)TSEQ * 32 * 4), oRs = take((size_t)TSEQ * 32 * 4),
           oH = take(CT * DM * 2), oProj = take(CT * INC * 2 + 4096), oVbt = take(CT * DM * 2),
           oVst = take(CT * 128 * 2), oVwt = take(CT * 128 * 2), oFl = take(CT * 16 * 4), oF2 = take(CT * 16 * 4),
           oKc = take((size_t)NB * 2 * 128 * 64 * 2), oVc = take((size_t)NB * 2 * 64 * 128 * 2), oSel = take(CT * 2 * 4),
           oYa = take(CT * DM * 2), oYb = take(CT * DM * 2), oCtr = take(1024), oXb = take(XB_WORDS * 4);
    if (off > ws_size && NB > 1) { NB >>= 1; continue; }
    P.WinT = (u16*)(base + oWin); P.WpaT = (u16*)(base + oWpa); P.WpbT = (u16*)(base + oWpb); P.WoT = (u16*)(base + oWo);
    P.W1T = (u16*)(base + oW1); P.W2T = (u16*)(base + oW2); P.bias1p = (float*)(base + oB1);
    P.ropec = (float*)(base + oRc); P.ropes = (float*)(base + oRs);
    P.h = (u16*)(base + oH); P.proj = (u16*)(base + oProj); P.qr = (u16*)(base + oVbt);
    P.vst = (u16*)(base + oVst); P.vwt = (u16*)(base + oVwt); P.flog = (float*)(base + oFl); P.F2 = (float*)(base + oF2);
    P.kcmp = (u16*)(base + oKc); P.vcmpt = (u16*)(base + oVc); P.sel = (unsigned*)(base + oSel);
    P.ya = (u16*)(base + oYa); P.yb = (u16*)(base + oYb); P.ctr = (unsigned*)(base + oCtr); P.xbar = (unsigned*)(base + oXb);
    break;
  }
  P.NB = NB; P.nchunk = 32 / NB;
  static int grid_blocks = 0;
  if (!grid_blocks) {
    int dev = 0, cus = 0, per_cu = 0;
    hipGetDevice(&dev);
    hipDeviceGetAttribute(&cus, hipDeviceAttributeMultiprocessorCount, dev);
    hipOccupancyMaxActiveBlocksPerMultiprocessor(&per_cu, mega_kernel, NTHREADS, 0);
    if (per_cu > 1) per_cu = 1;
    if (per_cu < 1) per_cu = 1;
    grid_blocks = cus * per_cu;
  }
  void* args[] = {&P};
  hipError_t e = hipLaunchCooperativeKernel((void*)mega_kernel, dim3(grid_blocks), dim3(NTHREADS), args, 0, stream);
  if (e != hipSuccess) fprintf(stderr, "cooperative launch failed: %s (grid %d)\n", hipGetErrorString(e), grid_blocks);
}
```

```cpp
#include <hip/hip_runtime.h>
#include <hip/hip_cooperative_groups.h>
#include <cstdio>
namespace cg = cooperative_groups;

typedef __attribute__((ext_vector_type(8))) __bf16 bf16x8;
typedef __attribute__((ext_vector_type(16))) float f32x16;
typedef __attribute__((ext_vector_type(4))) float f32x4;
typedef __attribute__((ext_vector_type(2))) float f32x2;
typedef unsigned short u16;

#define TSEQ 2048
#define DM 1024
#define INC 9024
#define INCP 9216
#define C_QA 0
#define C_KV 1024
#define C_GA 1792
#define C_ZA 1840
#define C_QB 2864
#define C_KB 3888
#define C_VB 4912
#define C_QR 4912
#define C_FB 5936
#define C_ZB 5952
#define C_RA 6976
#define C_RB 8000
#define NTHREADS 512
#define ATT_STAGE 33280
#define LOG2E 1.4426950408889634f
#define XB_WORDS 3200
#define XB_LDS_OFF 150000

struct Params {
  const float* x_in; const float* norm_g; const float* w_in; const float* b_forget;
  const float* pe_k; const float* w1_k; const float* w2_k;
  const float* pe_v; const float* w1_v; const float* w2_v;
  const float* w_pa; const float* w_pb; const float* w_out; const float* final_g;
  float* out;
  u16* WinT; u16* WpaT; u16* WpbT; u16* WoT; u16* W1T; u16* W2T;
  float* bias1p; float* ropec; float* ropes;
  u16* h; u16* proj; u16* qr; u16* vst; u16* vwt;
  float* flog; float* F2; u16* kcmp; u16* vcmpt; unsigned* sel;
  u16* ya; u16* yb; unsigned* ctr; unsigned* xbar;
  int NB; int nchunk;
};

__device__ __forceinline__ unsigned pk2(float a, float b) {
  typedef __attribute__((ext_vector_type(2))) float f2_t;
  typedef __attribute__((ext_vector_type(2))) __bf16 b2_t;
  f2_t v = {a, b};
  b2_t r = __builtin_convertvector(v, b2_t);
  return __builtin_bit_cast(unsigned, r);
}
__device__ __forceinline__ u16 f2bf(float a) { return (u16)(pk2(a, 0.f) & 0xffffu); }
__device__ __forceinline__ float bf2f(u16 u) { return __uint_as_float(((unsigned)u) << 16); }
__device__ __forceinline__ float bflo(unsigned u) { return __uint_as_float(u << 16); }
__device__ __forceinline__ float bfhi(unsigned u) { return __uint_as_float(u & 0xffff0000u); }
__device__ __forceinline__ float sigmoidf_(float x) { return __builtin_amdgcn_rcpf(1.f + __expf(-x)); }
__device__ __forceinline__ float siluf_(float x) { return x * __builtin_amdgcn_rcpf(1.f + __expf(-x)); }
__device__ __forceinline__ f32x16 mfma32(bf16x8 a, bf16x8 b, f32x16 c) {
  return __builtin_amdgcn_mfma_f32_32x32x16_bf16(a, b, c, 0, 0, 0);
}
__device__ __forceinline__ int opaque_tid() { int t = threadIdx.x; asm volatile("" : "+v"(t)); return t; }
__device__ __forceinline__ bf16x8 ldfrag(const void* p) {
  return __builtin_bit_cast(bf16x8, *(const uint4*)p);
}

__device__ void transpose_tile(const float* __restrict__ src, u16* __restrict__ dst, int K, int N,
                               int k0, int n0, float* tile, const int tid) {
#pragma unroll
  for (int j = 0; j < 2; j++) {
    int r = (tid >> 4) + 32 * j, c4 = (tid & 15) * 4;
    float4 v = *(const float4*)(src + (size_t)(k0 + r) * N + n0 + c4);
    tile[r * 65 + c4] = v.x; tile[r * 65 + c4 + 1] = v.y; tile[r * 65 + c4 + 2] = v.z; tile[r * 65 + c4 + 3] = v.w;
  }
  __syncthreads();
  {
    int c = tid, n = c >> 3, kc = c & 7;
    const float* tp = tile + (kc * 8) * 65 + n;
    uint4 o;
    o.x = pk2(tp[0], tp[65]); o.y = pk2(tp[130], tp[195]); o.z = pk2(tp[260], tp[325]); o.w = pk2(tp[390], tp[455]);
    *(uint4*)(dst + (size_t)(n0 + n) * K + k0 + kc * 8) = o;
  }
  __syncthreads();
}

__device__ void phase0(const Params& P, char* smem) {
  const int tid = opaque_tid();
  float* tile = (float*)smem;
  const int n0_ = 4 * 16 * 141, n1_ = 4 * 16 * 16, n2_ = 4 * 32 * 2, n3_ = 4 * 2 * 1;
  const int nT = n0_ + 3 * n1_ + 2 * n2_ + 2 * n3_;
  const int nBias = 64, nRope = 128;
  const int total = nT + nBias + nRope + 1;
  for (int it = blockIdx.x; it < total; it += gridDim.x) {
    if (it < nT) {
      int t = it;
      if (t < n0_) {
        int l = t / (16 * 141), rem = t % (16 * 141);
        transpose_tile(P.w_in + (size_t)l * DM * INC, P.WinT + (size_t)l * INCP * DM, DM, INC, (rem / 141) * 64, (rem % 141) * 64, tile, tid);
        continue;
      }
      t -= n0_;
      if (t < 3 * n1_) {
        int which = t / n1_; t %= n1_;
        int l = t / 256, rem = t % 256;
        const float* s = which == 0 ? P.w_pa : (which == 1 ? P.w_pb : P.w_out);
        u16* d = which == 0 ? P.WpaT : (which == 1 ? P.WpbT : P.WoT);
        transpose_tile(s + (size_t)l * DM * DM, d + (size_t)l * DM * DM, DM, DM, (rem >> 4) * 64, (rem & 15) * 64, tile, tid);
        continue;
      }
      t -= 3 * n1_;
      if (t < 2 * n2_) {
        int kv = t / n2_; t %= n2_;
        int l = t / 64, rem = t % 64;
        const float* s = kv ? P.w1_v : P.w1_k;
        transpose_tile(s + (size_t)l * 2048 * 128, P.W1T + (size_t)(l * 2 + kv) * 128 * 2048, 2048, 128, (rem >> 1) * 64, (rem & 1) * 64, tile, tid);
        continue;
      }
      t -= 2 * n2_;
      {
        int kv = t / n3_; t %= n3_;
        int l = t / 2, rem = t % 2;
        const float* s = kv ? P.w2_v : P.w2_k;
        transpose_tile(s + (size_t)l * 128 * 64, P.W2T + (size_t)(l * 2 + kv) * 64 * 128, 128, 64, rem * 64, 0, tile, tid);
      }
    } else if (it < nT + nBias) {
      int j = it - nT;
      int l = j >> 4, kv = (j >> 3) & 1, kq = j & 7;
      const float* pe = (kv ? P.pe_v : P.pe_k) + (size_t)l * 2048;
      const float* w1 = (kv ? P.w1_v : P.w1_k) + (size_t)l * 2048 * 128;
      int hid = tid & 127, kh = tid >> 7;
      int kbeg = kq * 256 + kh * 64;
      float s = 0.f;
#pragma unroll 8
      for (int k = 0; k < 64; k++) s += pe[kbeg + k] * w1[(size_t)(kbeg + k) * 128 + hid];
      float* part = (float*)smem;
      part[tid] = s;
      __syncthreads();
      if (tid < 128) P.bias1p[((l * 2 + kv) * 8 + kq) * 128 + hid] = (part[tid] + part[tid + 128]) + (part[tid + 256] + part[tid + 384]);
      __syncthreads();
    } else if (it < nT + nBias + nRope) {
      int idx = (it - nT - nBias) * 512 + tid;
      int t = idx >> 5, j = idx & 31;
      double inv = 1.0;
      for (int q = 0; q < j; q++) inv *= 0.7498942093324558;
      float invf = (float)inv;
      float angf = (float)t * invf;
      double a = (double)angf;
      double kq = rint(a * 0.15915494309189535);
      double rr = a - kq * 6.283185307179586;
      double r2 = rr * rr;
      double sterm = rr, cterm = 1.0, ssum = rr, csum = 1.0;
#pragma unroll 1
      for (int n = 1; n <= 15; n++) {
        cterm *= -r2 / (double)((2 * n - 1) * (2 * n));
        sterm *= -r2 / (double)((2 * n) * (2 * n + 1));
        csum += cterm; ssum += sterm;
      }
      P.ropec[idx] = (float)csum;
      P.ropes[idx] = (float)ssum;
    } else {
      if (tid < 256) P.ctr[tid] = 0u;
      for (int i = tid; i < XB_WORDS; i += NTHREADS) P.xbar[i] = 0u;
    }
  }
}

__device__ void norm_phase(const float* __restrict__ xsrc, const float* __restrict__ g, u16* __restrict__ hdst, int nrows) {
  const int tid = opaque_tid();
  const int lane = tid & 63;
  const int gw = blockIdx.x * 8 + (tid >> 6), nw = gridDim.x * 8;
  float4 gv[4];
#pragma unroll
  for (int j = 0; j < 4; j++) gv[j] = *(const float4*)(g + lane * 4 + 256 * j);
  for (int row = gw; row < nrows; row += 2 * nw) {
    const float* xr0 = xsrc + (size_t)row * DM;
    const float* xr1 = xsrc + (size_t)(row + nw) * DM;
    float4 v0[4], v1[4];
#pragma unroll
    for (int j = 0; j < 4; j++) { v0[j] = *(const float4*)(xr0 + lane * 4 + 256 * j); v1[j] = *(const float4*)(xr1 + lane * 4 + 256 * j); }
    float s0 = 0.f, s1 = 0.f;
#pragma unroll
    for (int j = 0; j < 4; j++) {
      s0 += v0[j].x * v0[j].x + v0[j].y * v0[j].y + v0[j].z * v0[j].z + v0[j].w * v0[j].w;
      s1 += v1[j].x * v1[j].x + v1[j].y * v1[j].y + v1[j].z * v1[j].z + v1[j].w * v1[j].w;
    }
#pragma unroll
    for (int o = 32; o >= 1; o >>= 1) { s0 += __shfl_xor(s0, o); s1 += __shfl_xor(s1, o); }
    const float r0 = rsqrtf(s0 * (1.f / DM) + 1e-6f), r1 = rsqrtf(s1 * (1.f / DM) + 1e-6f);
#pragma unroll
    for (int j = 0; j < 4; j++) {
      uint2 o;
      o.x = pk2(v0[j].x * r0 * gv[j].x, v0[j].y * r0 * gv[j].y);
      o.y = pk2(v0[j].z * r0 * gv[j].z, v0[j].w * r0 * gv[j].w);
      *(uint2*)(hdst + (size_t)row * DM + lane * 4 + 256 * j) = o;
      o.x = pk2(v1[j].x * r1 * gv[j].x, v1[j].y * r1 * gv[j].y);
      o.y = pk2(v1[j].z * r1 * gv[j].z, v1[j].w * r1 * gv[j].w);
      *(uint2*)(hdst + (size_t)(row + nw) * DM + lane * 4 + 256 * j) = o;
    }
  }
}

__device__ void final_norm_phase(float* __restrict__ x, const float* __restrict__ g, int row0, int nrows) {
  const int tid = opaque_tid();
  const int lane = tid & 63;
  const int gw = blockIdx.x * 8 + (tid >> 6), nw = gridDim.x * 8;
  float4 gv[4];
#pragma unroll
  for (int j = 0; j < 4; j++) gv[j] = *(const float4*)(g + lane * 4 + 256 * j);
  for (int row = gw; row < nrows; row += nw) {
    float* xr = x + (size_t)(row0 + row) * DM;
    float4 v[4];
    float ss = 0.f;
#pragma unroll
    for (int j = 0; j < 4; j++) {
      v[j] = *(const float4*)(xr + lane * 4 + 256 * j);
      ss += v[j].x * v[j].x + v[j].y * v[j].y + v[j].z * v[j].z + v[j].w * v[j].w;
    }
#pragma unroll
    for (int o = 32; o >= 1; o >>= 1) ss += __shfl_xor(ss, o);
    float rstd = rsqrtf(ss * (1.f / DM) + 1e-6f);
#pragma unroll
    for (int j = 0; j < 4; j++) {
      float4 o;
      o.x = v[j].x * rstd * gv[j].x; o.y = v[j].y * rstd * gv[j].y;
      o.z = v[j].z * rstd * gv[j].z; o.w = v[j].w * rstd * gv[j].w;
      *(float4*)(xr + lane * 4 + 256 * j) = o;
    }
  }
}

struct ARow {
  const u16* p; int ld;
  __device__ __forceinline__ const u16* operator()(int row, int k) const { return p + (size_t)row * ld + k; }
};
struct ACmp {
  const u16* p;
  __device__ __forceinline__ const u16* operator()(int row, int k) const {
    int t = 16 * row + (k >> 6); t = t > (TSEQ - 1) ? (TSEQ - 1) : t;
    return p + (size_t)t * INC + (k & 63);
  }
};

template <class AF>
__device__ __forceinline__ void gemm_mainloop(AF af, const u16* __restrict__ Bt, int ldb, int K, char* smem,
                                              f32x16 (&acc)[2][2], const int tid) {
  const int lane = tid & 63, r = lane & 31, h = lane >> 5, w = tid >> 6;
  const int wm = w >> 1, wn = w & 1;
  const int lrow = tid >> 3, lch = tid & 7;
  uint4 ra[4], rb[4];
  const int nk = K >> 6;
#pragma unroll
  for (int j = 0; j < 4; j++) {
    int row = lrow + 32 * j;
    ra[j] = *(const uint4*)af(row, lch * 8);
    rb[j] = *(const uint4*)(Bt + (size_t)row * ldb + lch * 8);
  }
#pragma unroll
  for (int j = 0; j < 4; j++) {
    int row = lrow + 32 * j;
    int off = row * 128 + ((lch ^ ((row >> 1) & 7)) << 4);
    *(uint4*)(smem + off) = ra[j];
    *(uint4*)(smem + 16384 + off) = rb[j];
  }
  __syncthreads();
  for (int it = 0; it < nk; it++) {
    const bool more = (it + 1) < nk;
    if (more) {
      const int k0 = (it + 1) * 64;
#pragma unroll
      for (int j = 0; j < 4; j++) {
        int row = lrow + 32 * j;
        ra[j] = *(const uint4*)af(row, k0 + lch * 8);
        rb[j] = *(const uint4*)(Bt + (size_t)row * ldb + k0 + lch * 8);
      }
    }
    const char* sa = smem + (it & 1) * 32768;
    const char* sb = sa + 16384;
#pragma unroll
    for (int kk = 0; kk < 4; kk++) {
      bf16x8 a[2], b[2];
#pragma unroll
      for (int mi = 0; mi < 2; mi++) {
        int row = wm * 64 + mi * 32 + r;
        a[mi] = ldfrag(sa + row * 128 + (((kk * 2 + h) ^ ((row >> 1) & 7)) << 4));
      }
#pragma unroll
      for (int ni = 0; ni < 2; ni++) {
        int row = wn * 64 + ni * 32 + r;
        b[ni] = ldfrag(sb + row * 128 + (((kk * 2 + h) ^ ((row >> 1) & 7)) << 4));
      }
#pragma unroll
      for (int mi = 0; mi < 2; mi++)
#pragma unroll
        for (int ni = 0; ni < 2; ni++) acc[mi][ni] = mfma32(a[mi], b[ni], acc[mi][ni]);
    }
    if (more) {
      char* sd = smem + ((it + 1) & 1) * 32768;
#pragma unroll
      for (int j = 0; j < 4; j++) {
        int row = lrow + 32 * j;
        int off = row * 128 + ((lch ^ ((row >> 1) & 7)) << 4);
        *(uint4*)(sd + off) = ra[j];
        *(uint4*)(sd + 16384 + off) = rb[j];
      }
    }
    __syncthreads();
  }
}

__device__ __forceinline__ void zero_acc(f32x16 (&acc)[2][2]) {
#pragma unroll
  for (int a = 0; a < 2; a++)
#pragma unroll
    for (int b = 0; b < 2; b++)
#pragma unroll
      for (int i = 0; i < 16; i++) acc[a][b][i] = 0.f;
}

typedef __attribute__((ext_vector_type(8))) short s16x8;
#define G_TILE_B 32768
#define G_STAGE_B 65536
__device__ __forceinline__ int g_lds_byte(int r, int c) {
  int st = (r >> 4) * 2 + (c >> 5), ob = (r & 15) * 64 + (c & 31) * 2;
  return st * 1024 + (ob ^ (((ob >> 9) & 1) << 5));
}
__device__ __forceinline__ void g_stage_rc(int b, int& R, int& C) {
  int st = b >> 10, sb = b & 1023, swz = sb ^ (((sb >> 9) & 1) << 5);
  R = (st >> 1) * 16 + swz / 64;
  C = (st & 1) * 32 + (swz % 64) / 2;
}
#define G_WAIT_V0() asm volatile("s_waitcnt vmcnt(0)" ::: "memory")

struct GTile { int pm, pn; };
__device__ __forceinline__ bool g_next(int i, int G, int c, int nM, int nN, GTile& u) {
  const int nwg = nM * nN;
  const int L = i * G + c;
  if (L >= nwg) return false;
  int wgid = L;
  { const int q = nwg / 8, r = nwg % 8, xcd = wgid % 8, off = wgid / 8; wgid = (xcd < r ? xcd * (q + 1) : r * (q + 1) + (xcd - r) * q) + off; }
  const int nig = 8 * nN, gid = wgid / nig, fm = gid * 8, gsz = (nM - fm) < 8 ? (nM - fm) : 8;
  u.pm = fm + ((wgid % nig) % gsz);
  u.pn = (wgid % nig) / gsz;
  return true;
}

__device__ __forceinline__ void g_kloop(const u16* __restrict__ Ab, const u16* __restrict__ Bb, const int K, char* smem,
                                        f32x4 (&acc)[8][4], const int tid, const bool pre, const u16* __restrict__ nA,
                                        const u16* __restrict__ nB, const bool has_next) {
  const int wid = tid >> 6, lane = tid & 63, wr = wid >> 2, wc = wid & 3, fr = lane & 15, fq = lane >> 4;
  int sR0, sC0, sR1, sC1, sR2, sC2, sR3, sC3;
  g_stage_rc(wid * 1024 + 0 * 8192 + lane * 16, sR0, sC0);
  g_stage_rc(wid * 1024 + 1 * 8192 + lane * 16, sR1, sC1);
  g_stage_rc(wid * 1024 + 2 * 8192 + lane * 16, sR2, sC2);
  g_stage_rc(wid * 1024 + 3 * 8192 + lane * 16, sR3, sC3);
  const long o0 = (long)sR0 * K + sC0, o1 = (long)sR1 * K + sC1, o2 = (long)sR2 * K + sC2, o3 = (long)sR3 * K + sC3;
#define G_STAGE(buf, kt)                                                                                              \
  {                                                                                                                  \
    char* sa_ = smem + (buf) * G_STAGE_B + wid * 1024;                                                               \
    char* sb_ = sa_ + G_TILE_B;                                                                                      \
    const u16* ga_ = Ab + (kt) * 64;                                                                                 \
    const u16* gb_ = Bb + (kt) * 64;                                                                                 \
    __builtin_amdgcn_global_load_lds((const unsigned*)(ga_ + o0), (unsigned*)(sa_), 16, 0, 0);                       \
    __builtin_amdgcn_global_load_lds((const unsigned*)(gb_ + o0), (unsigned*)(sb_), 16, 0, 0);                       \
    __builtin_amdgcn_global_load_lds((const unsigned*)(ga_ + o1), (unsigned*)(sa_ + 8192), 16, 0, 0);                \
    __builtin_amdgcn_global_load_lds((const unsigned*)(gb_ + o1), (unsigned*)(sb_ + 8192), 16, 0, 0);                \
    __builtin_amdgcn_global_load_lds((const unsigned*)(ga_ + o2), (unsigned*)(sa_ + 16384), 16, 0, 0);               \
    __builtin_amdgcn_global_load_lds((const unsigned*)(gb_ + o2), (unsigned*)(sb_ + 16384), 16, 0, 0);               \
    __builtin_amdgcn_global_load_lds((const unsigned*)(ga_ + o3), (unsigned*)(sa_ + 24576), 16, 0, 0);               \
    __builtin_amdgcn_global_load_lds((const unsigned*)(gb_ + o3), (unsigned*)(sb_ + 24576), 16, 0, 0);               \
  }
  const int nt = K >> 6;
  if (!pre) {
    G_STAGE(0, 0);
    G_WAIT_V0();
    __syncthreads();
  }
  for (int t = 0; t < nt; ++t) {
    const int cur = t & 1;
    if (t + 1 < nt) G_STAGE(cur ^ 1, t + 1)
    else if (has_next) {
      char* sa_ = smem + wid * 1024;
      char* sb_ = sa_ + G_TILE_B;
      __builtin_amdgcn_global_load_lds((const unsigned*)(nA + o0), (unsigned*)(sa_), 16, 0, 0);
      __builtin_amdgcn_global_load_lds((const unsigned*)(nB + o0), (unsigned*)(sb_), 16, 0, 0);
      __builtin_amdgcn_global_load_lds((const unsigned*)(nA + o1), (unsigned*)(sa_ + 8192), 16, 0, 0);
      __builtin_amdgcn_global_load_lds((const unsigned*)(nB + o1), (unsigned*)(sb_ + 8192), 16, 0, 0);
      __builtin_amdgcn_global_load_lds((const unsigned*)(nA + o2), (unsigned*)(sa_ + 16384), 16, 0, 0);
      __builtin_amdgcn_global_load_lds((const unsigned*)(nB + o2), (unsigned*)(sb_ + 16384), 16, 0, 0);
      __builtin_amdgcn_global_load_lds((const unsigned*)(nA + o3), (unsigned*)(sa_ + 24576), 16, 0, 0);
      __builtin_amdgcn_global_load_lds((const unsigned*)(nB + o3), (unsigned*)(sb_ + 24576), 16, 0, 0);
    }
    const char* sa = smem + cur * G_STAGE_B;
    const char* sb = sa + G_TILE_B;
#pragma unroll
    for (int ks = 0; ks < 2; ++ks) {
      s16x8 At[8], Bf[4];
#pragma unroll
      for (int m = 0; m < 8; ++m) At[m] = *(const s16x8*)(sa + g_lds_byte(wr * 128 + m * 16 + fr, ks * 32 + fq * 8));
#pragma unroll
      for (int n = 0; n < 4; ++n) Bf[n] = *(const s16x8*)(sb + g_lds_byte(wc * 64 + n * 16 + fr, ks * 32 + fq * 8));
#pragma unroll
      for (int m = 0; m < 8; ++m)
#pragma unroll
        for (int n = 0; n < 4; ++n)
          acc[m][n] = __builtin_amdgcn_mfma_f32_16x16x32_bf16(__builtin_bit_cast(bf16x8, Bf[n]), __builtin_bit_cast(bf16x8, At[m]), acc[m][n], 0, 0, 0);
      __builtin_amdgcn_sched_barrier(0);
    }
    G_WAIT_V0();
    __syncthreads();
  }
}

__device__ __forceinline__ void g_zero(f32x4 (&acc)[8][4]) {
#pragma unroll
  for (int m = 0; m < 8; m++)
#pragma unroll
    for (int n = 0; n < 4; n++) acc[m][n] = (f32x4){0.f, 0.f, 0.f, 0.f};
}
__device__ __forceinline__ uint2 pk4(f32x4 v) { return make_uint2(pk2(v[0], v[1]), pk2(v[2], v[3])); }

__device__ __forceinline__ void wave_store_rows(char* wsm, u16* gbase, const size_t ld, const f32x4 (&acc)[8][4], const int lane) {
  const int fr = lane & 15, fq = lane >> 4;
  const int rr = lane >> 3, ch = lane & 7;
  typedef __attribute__((ext_vector_type(4))) unsigned u32x4_t;
#pragma unroll
  for (int hf = 0; hf < 2; hf++) {
#pragma unroll
    for (int m = 0; m < 4; m++)
#pragma unroll
      for (int n = 0; n < 4; n++) {
        const int row = m * 16 + fr, chunk = n * 2 + (fq >> 1);
        *(uint2*)(wsm + row * 128 + ((chunk ^ (fr & 7)) << 4) + (fq & 1) * 8) = pk4(acc[hf * 4 + m][n]);
      }
#pragma unroll
    for (int i = 0; i < 8; i++) {
      const int row = i * 8 + rr;
      const uint4 v = *(const uint4*)(wsm + row * 128 + ((ch ^ (row & 7)) << 4));
      __builtin_nontemporal_store(__builtin_bit_cast(u32x4_t, v), (u32x4_t*)(gbase + (size_t)(hf * 64 + row) * ld + ch * 8));
    }
  }
}
__device__ __forceinline__ void wave_store_cols(char* wsm, u16* vt, const int vcol0, const int nh, const int bl, const int t0,
                                                const f32x4 (&acc)[8][4], const int lane) {
  const int fr = lane & 15, fq = lane >> 4;
#pragma unroll
  for (int m = 0; m < 8; m++)
#pragma unroll
    for (int n = 0; n < 4; n++)
#pragma unroll
      for (int j = 0; j < 4; j++) {
        const int d = n * 16 + fq * 4 + j, t = m * 16 + fr;
        *(u16*)(wsm + d * 256 + (((t >> 3) ^ (d & 15)) << 4) + (t & 7) * 2) = f2bf(acc[m][n][j]);
      }
  const int dd = lane >> 4, ch = lane & 15;
#pragma unroll
  for (int i = 0; i < 16; i++) {
    const int d = i * 4 + dd;
    const uint4 v = *(const uint4*)(wsm + d * 256 + ((ch ^ (d & 15)) << 4));
    const int vcol = vcol0 + d;
    *(uint4*)(vt + ((size_t)(bl * nh + (vcol >> 6)) * 64 + (vcol & 63)) * TSEQ + t0 + ch * 8) = v;
  }
}

__device__ void gemm1_phase(const Params& P, int layer, char* smem) {
  const int CT = P.NB * TSEQ;
  const int nM = CT >> 8, nN = INCP >> 8;
  const u16* Bt = P.WinT + (size_t)layer * INCP * DM;
  u16* p_qr = P.qr; u16* p_proj = P.proj;
  asm volatile("" : "+s"(p_qr), "+s"(p_proj));
  for (int i = 0;; i++) {
    GTile u, un;
    if (!g_next(i, gridDim.x, blockIdx.x, nM, nN, u)) break;
    const bool hn = g_next(i + 1, gridDim.x, blockIdx.x, nM, nN, un);
    const int tid = opaque_tid(), wid = tid >> 6, lane = tid & 63, wr = wid >> 2, wc = wid & 3, fr = lane & 15, fq = lane >> 4;
    f32x4 acc[8][4];
    g_zero(acc);
    g_kloop(P.h + (size_t)(u.pm * 256) * DM, Bt + (size_t)(u.pn * 256) * DM, DM, smem, acc, tid, i > 0,
            P.h + (size_t)(un.pm * 256) * DM, Bt + (size_t)(un.pn * 256) * DM, hn);
    const int cw = u.pn * 256 + wc * 64;
    const int row0 = u.pm * 256 + wr * 128 + fr;
    char* wsm = smem + G_STAGE_B + wid * 8192;
    const int rowb = u.pm * 256 + wr * 128;
    const bool rope_q = cw < 1024;
    const bool rope_k = (cw >= C_KV + 256 && cw < C_KV + 384) || (cw >= C_KV + 512 && cw < C_KV + 640);
    const bool mixed = (cw == 5888);
    if (cw >= INC) {
    } else if (rope_q || rope_k) {
      if (rope_q) wave_store_rows(wsm, p_proj + (size_t)rowb * INC + cw, INC, acc, lane);
#pragma unroll
      for (int m = 0; m < 8; m++) {
        const int tt = (row0 + m * 16) & (TSEQ - 1);
#pragma unroll
        for (int n = 0; n < 2; n++) {
          const float4 c = *(const float4*)(P.ropec + tt * 32 + n * 16 + fq * 4);
          const float4 sn = *(const float4*)(P.ropes + tt * 32 + n * 16 + fq * 4);
          const f32x4 x1 = acc[m][n], x2 = acc[m][n + 2];
          f32x4 r1, r2;
          r1[0] = x1[0] * c.x - x2[0] * sn.x; r2[0] = x2[0] * c.x + x1[0] * sn.x;
          r1[1] = x1[1] * c.y - x2[1] * sn.y; r2[1] = x2[1] * c.y + x1[1] * sn.y;
          r1[2] = x1[2] * c.z - x2[2] * sn.z; r2[2] = x2[2] * c.z + x1[2] * sn.z;
          r1[3] = x1[3] * c.w - x2[3] * sn.w; r2[3] = x2[3] * c.w + x1[3] * sn.w;
          acc[m][n] = r1; acc[m][n + 2] = r2;
        }
      }
      if (rope_q) wave_store_rows(wsm, p_qr + (size_t)rowb * DM + cw, DM, acc, lane);
      else wave_store_rows(wsm, p_proj + (size_t)rowb * INC + cw, INC, acc, lane);
    } else if (!mixed) {
      wave_store_rows(wsm, p_proj + (size_t)rowb * INC + cw, INC, acc, lane);
    } else {
#pragma unroll
      for (int n = 0; n < 4; n++) {
        const int c0 = cw + n * 16 + fq * 4;
        if (c0 < C_FB) {
#pragma unroll
          for (int m = 0; m < 8; m++) *(uint2*)(p_proj + (size_t)(row0 + m * 16) * INC + c0) = pk4(acc[m][n]);
        } else {
#pragma unroll
          for (int m = 0; m < 8; m++)
            *(float4*)(P.flog + (size_t)(row0 + m * 16) * 16 + (c0 - C_FB)) = make_float4(acc[m][n][0], acc[m][n][1], acc[m][n][2], acc[m][n][3]);
        }
        __builtin_amdgcn_sched_barrier(0);
      }
    }
    __syncthreads();
  }
}

__device__ void gemm2_phase(const Params& P, int layer, char* smem) {
  const int CT = P.NB * TSEQ;
  const int nM = CT >> 8, nN = 4;
  const u16* p_ya = P.ya; const u16* p_yb = P.yb; const u16* p_wa = P.WpaT; const u16* p_wb = P.WpbT;
  for (int i = 0;; i++) {
    GTile u, un;
    if (!g_next(i, gridDim.x, blockIdx.x, nM, nN, u)) break;
    const bool hn = g_next(i + 1, gridDim.x, blockIdx.x, nM, nN, un);
    const int tid = opaque_tid(), wid = tid >> 6, lane = tid & 63, wr = wid >> 2, wc = wid & 3, fr = lane & 15, fq = lane >> 4;
    f32x4 acc[8][4];
    g_zero(acc);
#pragma unroll 1
    for (int pass = 0; pass < 2; pass++) {
      const u16* Ap = (pass ? p_yb : p_ya) + (size_t)(u.pm * 256) * DM;
      const u16* Bp = (pass ? p_wb : p_wa) + (size_t)layer * DM * DM + (size_t)(u.pn * 256) * DM;
      const u16* nAp = pass ? (p_ya + (size_t)(un.pm * 256) * DM) : (p_yb + (size_t)(u.pm * 256) * DM);
      const u16* nBp = pass ? (p_wa + (size_t)layer * DM * DM + (size_t)(un.pn * 256) * DM) : (p_wb + (size_t)layer * DM * DM + (size_t)(u.pn * 256) * DM);
      g_kloop(Ap, Bp, DM, smem, acc, tid, (i > 0) || (pass > 0), nAp, nBp, pass ? hn : true);
      __builtin_amdgcn_sched_barrier(0);
      if (pass == 0) {
        const int tid1 = opaque_tid(), wid1 = tid1 >> 6, lane1 = tid1 & 63, wr1 = wid1 >> 2, wc1 = wid1 & 3, fr1 = lane1 & 15, fq1 = lane1 >> 4;
        const u16* pp = P.proj + (size_t)(u.pm * 256 + wr1 * 128 + fr1) * INC + u.pn * 256 + wc1 * 64 + fq1 * 4;
#pragma unroll
        for (int m = 0; m < 8; m++) {
#pragma unroll
          for (int n = 0; n < 4; n++) {
            const uint2 ra = *(const uint2*)(pp + (size_t)(m * 16) * INC + C_RA + n * 16);
            const uint2 rb = *(const uint2*)(pp + (size_t)(m * 16) * INC + C_RB + n * 16);
            acc[m][n][0] *= (1.f + __expf(-bflo(rb.x))) * __builtin_amdgcn_rcpf(1.f + __expf(-bflo(ra.x)));
            acc[m][n][1] *= (1.f + __expf(-bfhi(rb.x))) * __builtin_amdgcn_rcpf(1.f + __expf(-bfhi(ra.x)));
            acc[m][n][2] *= (1.f + __expf(-bflo(rb.y))) * __builtin_amdgcn_rcpf(1.f + __expf(-bflo(ra.y)));
            acc[m][n][3] *= (1.f + __expf(-bfhi(rb.y))) * __builtin_amdgcn_rcpf(1.f + __expf(-bfhi(ra.y)));
          }
          __builtin_amdgcn_sched_barrier(0);
        }
      }
    }
    {
      const int tid2 = opaque_tid(), wid2 = tid2 >> 6, lane2 = tid2 & 63, wr2 = wid2 >> 2, wc2 = wid2 & 3, fr2 = lane2 & 15, fq2 = lane2 >> 4;
      const u16* pp = P.proj + (size_t)(u.pm * 256 + wr2 * 128 + fr2) * INC + u.pn * 256 + wc2 * 64 + fq2 * 4;
#pragma unroll
      for (int m = 0; m < 8; m++) {
#pragma unroll
        for (int n = 0; n < 4; n++) {
          const uint2 rb = *(const uint2*)(pp + (size_t)(m * 16) * INC + C_RB + n * 16);
          acc[m][n][0] *= sigmoidf_(bflo(rb.x)); acc[m][n][1] *= sigmoidf_(bfhi(rb.x));
          acc[m][n][2] *= sigmoidf_(bflo(rb.y)); acc[m][n][3] *= sigmoidf_(bfhi(rb.y));
        }
        __builtin_amdgcn_sched_barrier(0);
      }
      wave_store_rows(smem + G_STAGE_B + wid2 * 8192, P.h + (size_t)(u.pm * 256 + wr2 * 128) * DM + u.pn * 256 + wc2 * 64, DM, acc, lane2);
    }
    __syncthreads();
  }
}

__device__ void gemm3_phase(const Params& P, int layer, int chunk, char* smem) {
  const int CT = P.NB * TSEQ;
  const int nM = CT >> 8, nN = 4;
  const float* xs = (layer == 0 ? P.x_in : P.out) + (size_t)chunk * CT * DM;
  float* xd = P.out + (size_t)chunk * CT * DM;
  for (int i = 0;; i++) {
    GTile u, un;
    if (!g_next(i, gridDim.x, blockIdx.x, nM, nN, u)) break;
    const bool hn = g_next(i + 1, gridDim.x, blockIdx.x, nM, nN, un);
    const int tid = opaque_tid(), wid = tid >> 6, lane = tid & 63, wr = wid >> 2, wc = wid & 3, fr = lane & 15, fq = lane >> 4;
    f32x4 acc[8][4];
    g_zero(acc);
    g_kloop(P.h + (size_t)(u.pm * 256) * DM, P.WoT + (size_t)layer * DM * DM + (size_t)(u.pn * 256) * DM, DM, smem, acc, tid, i > 0,
            P.h + (size_t)(un.pm * 256) * DM, P.WoT + (size_t)layer * DM * DM + (size_t)(un.pn * 256) * DM, hn);
    const size_t off = (size_t)(u.pm * 256 + wr * 128 + fr) * DM + u.pn * 256 + wc * 64 + fq * 4;
#pragma unroll
    for (int m = 0; m < 8; m++) {
#pragma unroll
      for (int n = 0; n < 4; n++) {
        const float4 xo = *(const float4*)(xs + off + (size_t)(m * 16) * DM + n * 16);
        *(float4*)(xd + off + (size_t)(m * 16) * DM + n * 16) =
            make_float4(xo.x + acc[m][n][0], xo.y + acc[m][n][1], xo.z + acc[m][n][2], xo.w + acc[m][n][3]);
      }
      __builtin_amdgcn_sched_barrier(0);
    }
  }
}

__device__ __forceinline__ void compress_item(const Params& P, const int layer, const int it, char* smem_all, const int tid_all) {
  const int half = tid_all >> 8, tid = tid_all & 255;
  char* smem = smem_all + half * 65536;
  const int lane = tid & 63, r = lane & 31, h = lane >> 5, w = tid >> 6;
  const int wm = w >> 1, wn = w & 1;
  const int unit = it * 2 + half;
  const int bl = unit >> 2, g = (unit >> 1) & 1, kv = unit & 1;
  f32x16 acc[2][2];
  zero_acc(acc);
  ACmp af{P.proj + (size_t)bl * TSEQ * INC + C_KV + kv * 128 + g * 64};
  gemm_mainloop(af, P.W1T + (size_t)(layer * 2 + kv) * 128 * 2048, 2048, 2048, smem, acc, tid);
  const float* bp = P.bias1p + (size_t)((layer * 2 + kv) * 8) * 128;
#pragma unroll
  for (int ni = 0; ni < 2; ni++) {
    int hc = wn * 64 + ni * 32 + r;
    float b1 = 0.f;
#pragma unroll
    for (int q = 0; q < 8; q++) b1 += bp[q * 128 + hc];
#pragma unroll
    for (int mi = 0; mi < 2; mi++)
#pragma unroll
      for (int i = 0; i < 16; i++) {
        int n = wm * 64 + mi * 32 + 8 * (i >> 2) + 4 * h + (i & 3);
        float v = siluf_(acc[mi][ni][i] + b1);
        *(u16*)(smem + n * 256 + (((hc >> 3) ^ (n & 15)) << 4) + (hc & 7) * 2) = f2bf(v);
      }
  }
  __syncthreads();
  const u16* w2t = P.W2T + (size_t)(layer * 2 + kv) * 64 * 128;
  f32x16 o2[2];
#pragma unroll
  for (int dt = 0; dt < 2; dt++)
#pragma unroll
    for (int i = 0; i < 16; i++) o2[dt][i] = 0.f;
#pragma unroll
  for (int kk = 0; kk < 8; kk++) {
    int n = w * 32 + r;
    bf16x8 a = ldfrag(smem + n * 256 + (((kk * 2 + h) ^ (n & 15)) << 4));
#pragma unroll
    for (int dt = 0; dt < 2; dt++) {
      bf16x8 b = ldfrag(w2t + (size_t)(dt * 32 + r) * 128 + kk * 16 + h * 8);
      o2[dt] = mfma32(a, b, o2[dt]);
    }
  }
#pragma unroll
  for (int dt = 0; dt < 2; dt++) {
    int d = dt * 32 + r;
    if (kv == 0) {
#pragma unroll
      for (int i = 0; i < 16; i++) {
        int n = w * 32 + 8 * (i >> 2) + 4 * h + (i & 3);
        P.kcmp[((size_t)(bl * 2 + g) * 128 + n) * 64 + d] = f2bf(o2[dt][i]);
      }
    } else {
#pragma unroll
      for (int gq = 0; gq < 4; gq++) {
        int n0 = w * 32 + 8 * gq + 4 * h;
        uint2 o;
        o.x = pk2(o2[dt][gq * 4 + 0], o2[dt][gq * 4 + 1]);
        o.y = pk2(o2[dt][gq * 4 + 2], o2[dt][gq * 4 + 3]);
        *(uint2*)(P.vcmpt + ((size_t)(bl * 2 + g) * 64 + d) * 128 + n0) = o;
      }
    }
  }
  __syncthreads();
}

__device__ void pb_phase(const Params& P, int layer, char* smem_all) {
  const int tid = opaque_tid();
  const int lane = tid & 63, w = tid >> 6;
  float* wsum = (float*)smem_all;
  const int nScan = P.NB * 16;
  for (int it = blockIdx.x; it < nScan; it += gridDim.x) {
    const int bl = it >> 4, hh = it & 15;
    const float bf = P.b_forget[layer * 16 + hh];
    const float* fl = P.flog + ((size_t)bl * TSEQ + tid * 4) * 16 + hh;
    float ls[4];
#pragma unroll
    for (int j = 0; j < 4; j++) {
      const float x = fl[j * 16] + bf;
      ls[j] = (x >= 0.f) ? -log1pf(__expf(-x)) : (x - log1pf(__expf(x)));
    }
    const float loc = (ls[0] + ls[1]) + (ls[2] + ls[3]);
    float incl = loc;
#pragma unroll
    for (int o = 1; o < 64; o <<= 1) {
      const float v = __shfl_up(incl, o);
      if (lane >= o) incl += v;
    }
    __syncthreads();
    if (lane == 63) wsum[w] = incl;
    __syncthreads();
    float base = 0.f;
#pragma unroll
    for (int q = 0; q < 8; q++) base += (q < w) ? wsum[q] : 0.f;
    float run = base + incl - loc;
    float4 o4;
    run += ls[0]; o4.x = -8.0f * run;
    run += ls[1]; o4.y = -8.0f * run;
    run += ls[2]; o4.z = -8.0f * run;
    run += ls[3]; o4.w = -8.0f * run;
    *(float4*)(P.F2 + ((size_t)bl * 16 + hh) * TSEQ + tid * 4) = o4;
  }
}

__device__ void pc1_phase(const Params& P, char* smem) {
  const int tid = opaque_tid(),  lane = tid & 63, r = lane & 31, h = lane >> 5, w = tid >> 6;
  const int nItems = P.NB * 2 * 8;
  const float c1 = 0.125f * LOG2E;
  for (int it = blockIdx.x; it < nItems; it += gridDim.x) {
    const int qt = it & 7, g = (it >> 3) & 1, bl = it >> 4;
    __syncthreads();
#pragma unroll
    for (int j = 0; j < 2; j++) {
      int c = tid + 512 * j;
      {
        int n = c >> 3, ch = c & 7;
        uint4 v = *(const uint4*)(P.kcmp + ((size_t)(bl * 2 + g) * 128 + n) * 64 + ch * 8);
        *(uint4*)(smem + n * 128 + ((ch ^ ((n >> 1) & 7)) << 4)) = v;
      }
      {
        int d = c >> 4, ch = c & 15;
        uint4 v = *(const uint4*)(P.vcmpt + ((size_t)(bl * 2 + g) * 64 + d) * 128 + ch * 8);
        int sw = d & 31;
        *(uint2*)(smem + 16384 + d * 256 + (((2 * ch) ^ sw) << 3)) = make_uint2(v.x, v.y);
        *(uint2*)(smem + 16384 + d * 256 + (((2 * ch + 1) ^ sw) << 3)) = make_uint2(v.z, v.w);
      }
    }
    __syncthreads();
    const int qw_lo = qt * 256 + w * 32;
    const int qtok = qw_lo + r;
    const size_t rowg = (size_t)bl * TSEQ + qtok;
    const int tq = qtok - 31 - 64 * h;
    float sumacc[16], lastacc[16];
#pragma unroll
    for (int s = 0; s < 16; s++) { sumacc[s] = 0.f; lastacc[s] = 0.f; }
#pragma unroll 1
    for (int hh = 0; hh < 8; hh++) {
      const int head = g * 8 + hh;
      bf16x8 qf[4];
#pragma unroll
      for (int kk = 0; kk < 4; kk++) qf[kk] = ldfrag(P.proj + rowg * INC + C_QA + head * 64 + kk * 16 + h * 8);
      f32x16 s[4];
#pragma unroll
      for (int nt = 0; nt < 4; nt++) {
#pragma unroll
        for (int i = 0; i < 16; i++) s[nt][i] = 0.f;
#pragma unroll
        for (int kk = 0; kk < 4; kk++) {
          int row = nt * 32 + r;
          bf16x8 a = ldfrag(smem + row * 128 + (((kk * 2 + h) ^ ((row >> 1) & 7)) << 4));
          s[nt] = mfma32(a, qf[kk], s[nt]);
        }
        __builtin_amdgcn_sched_barrier(0);
      }
      float mx = -3.0e38f;
#pragma unroll
      for (int nt = 0; nt < 4; nt++)
#pragma unroll
        for (int i = 0; i < 16; i++) {
          bool ok = (16 * (nt * 32 + 8 * (i >> 2) + (i & 3))) <= tq;
          float v = ok ? s[nt][i] * c1 : -3.0e38f;
          s[nt][i] = v;
          mx = fmaxf(mx, v);
        }
      mx = fmaxf(mx, __shfl_xor(mx, 32));
      const bool anyv = mx > -1.0e37f;
      float mref = anyv ? mx : 0.f;
      float l = 0.f;
#pragma unroll
      for (int nt = 0; nt < 4; nt++)
#pragma unroll
        for (int i = 0; i < 16; i++) {
          float p = __builtin_amdgcn_exp2f(s[nt][i] - mref);
          s[nt][i] = p;
          l += p;
        }
      l += __shfl_xor(l, 32);
      const float inv = (anyv && l > 0.f) ? 1.f / l : 0.f;
#pragma unroll
      for (int nt = 0; nt < 4; nt++)
#pragma unroll
        for (int i = 0; i < 16; i++) s[nt][i] *= inv;
#pragma unroll
      for (int nt = 0; nt < 4; nt++)
#pragma unroll
        for (int gq = 0; gq < 4; gq++) {
          sumacc[nt * 4 + gq] += (s[nt][gq * 4] + s[nt][gq * 4 + 1]) + (s[nt][gq * 4 + 2] + s[nt][gq * 4 + 3]);
          lastacc[nt * 4 + gq] += s[nt][gq * 4 + 3];
        }
      uint4 pbv[8];
#pragma unroll
      for (int ks = 0; ks < 8; ks++) {
        const int nt = ks >> 1, hb = (ks & 1) * 8;
        pbv[ks].x = pk2(s[nt][hb + 0], s[nt][hb + 1]); pbv[ks].y = pk2(s[nt][hb + 2], s[nt][hb + 3]);
        pbv[ks].z = pk2(s[nt][hb + 4], s[nt][hb + 5]); pbv[ks].w = pk2(s[nt][hb + 6], s[nt][hb + 7]);
      }
      const float g0 = sigmoidf_(bf2f(P.proj[rowg * INC + C_GA + head]));
#pragma unroll
      for (int dt = 0; dt < 2; dt++) {
        f32x16 o;
#pragma unroll
        for (int i = 0; i < 16; i++) o[i] = 0.f;
        const int d = dt * 32 + r, sw = d & 31;
#pragma unroll
        for (int ks = 0; ks < 8; ks++) {
          uint2 lo = *(const uint2*)(smem + 16384 + d * 256 + (((ks * 4 + h) ^ sw) << 3));
          uint2 hi = *(const uint2*)(smem + 16384 + d * 256 + (((ks * 4 + 2 + h) ^ sw) << 3));
          uint4 au = make_uint4(lo.x, lo.y, hi.x, hi.y);
          o = mfma32(__builtin_bit_cast(bf16x8, au), __builtin_bit_cast(bf16x8, pbv[ks]), o);
        }
#pragma unroll
        for (int gq = 0; gq < 4; gq++) {
          int d0 = dt * 32 + 8 * gq + 4 * h;
          uint2 ov;
          ov.x = pk2(o[gq * 4 + 0] * g0, o[gq * 4 + 1] * g0);
          ov.y = pk2(o[gq * 4 + 2] * g0, o[gq * 4 + 3] * g0);
          *(uint2*)(P.ya + rowg * DM + head * 64 + d0) = ov;
        }
        __builtin_amdgcn_sched_barrier(0);
      }
    }
    float sc[16];
#pragma unroll
    for (int s = 0; s < 16; s++) {
      float prev = (s == 0) ? 0.f : lastacc[s - 1];
      float sendv = h ? prev : lastacc[s];
      float recv = __shfl_xor(sendv, 32);
      float imp = sumacc[s] + recv;
      int j = (s >> 2) * 8 + (s & 3) * 2 + h;
      int cur = qtok >> 6;
      bool forced = (j == 0) || (j == cur) || (j == cur - 1);
      bool valid = j <= cur;
      sc[s] = forced ? 1.0e4f : (valid ? imp : -1.0f);
    }
    unsigned mask = 0u;
#pragma unroll 1
    for (int rd = 0; rd < 8; rd++) {
      float best = -2.0f; int bj = 0;
#pragma unroll
      for (int s = 0; s < 16; s++) {
        int j = (s >> 2) * 8 + (s & 3) * 2 + h;
        if (sc[s] > best) { best = sc[s]; bj = j; }
      }
      float ob = __shfl_xor(best, 32);
      int oj = __shfl_xor(bj, 32);
      bool mine = (best > ob) || (best == ob && bj < oj);
      int wj = mine ? bj : oj;
      mask |= 1u << wj;
#pragma unroll
      for (int s = 0; s < 16; s++) {
        int j = (s >> 2) * 8 + (s & 3) * 2 + h;
        if (j == wj) sc[s] = -3.0f;
      }
    }
    if (h == 0) P.sel[(size_t)(bl * 2 + g) * TSEQ + qtok] = mask;
  }
}

#define A_SLOTB 8192
#define A_LDS_K 0
#define A_LDS_V 24576
#define A_LDS_WS 49152
#define A_LDS_F 51200
#define A_LDS_OST 52224
#define A_THR 8.0f
#define A_C2 (0.125f * LOG2E)
typedef __attribute__((ext_vector_type(4))) short a_s16x4;
typedef __attribute__((ext_vector_type(8))) short a_s16x8;
typedef __attribute__((ext_vector_type(4))) unsigned a_u32x4;
typedef __attribute__((address_space(3))) const char* a_lds_cptr;
typedef short a_v4i16 __attribute__((ext_vector_type(4)));
#define A_SBAR() __builtin_amdgcn_sched_barrier(0)
#define A_PIN(x) asm volatile("" : "+v"(x))
#define A_MFMA(a, b, c) __builtin_amdgcn_mfma_f32_32x32x16_bf16(a, b, c, 0, 0, 0)
template <int N> __device__ __forceinline__ void a_wait_bar() { asm volatile("s_waitcnt vmcnt(%0) lgkmcnt(0)\n\ts_barrier" ::"n"(N) : "memory"); }
__device__ __forceinline__ int a_crow(int r, int hi) { return (r & 3) + 8 * (r >> 2) + 4 * hi; }
__device__ __forceinline__ unsigned a_cvtpk(float lo, float hi) { unsigned r; asm("v_cvt_pk_bf16_f32 %0, %1, %2" : "=v"(r) : "v"(lo), "v"(hi)); return r; }
__device__ __forceinline__ void a_glds16(const void* g, unsigned lds_base) {
  unsigned sv; asm volatile("s_mov_b32 %0, m0\n\ts_mov_b32 m0, %2\n\ts_nop 0\n\tglobal_load_lds_dwordx4 %1, off\n\ts_mov_b32 m0, %0" : "=&s"(sv) : "v"(g), "s"(lds_base) : "memory"); }
__device__ __forceinline__ void a_glds4(const void* g, unsigned lds_base) {
  unsigned sv; asm volatile("s_mov_b32 %0, m0\n\ts_mov_b32 m0, %2\n\ts_nop 0\n\tglobal_load_lds_dword %1, off\n\ts_mov_b32 m0, %0" : "=&s"(sv) : "v"(g), "s"(lds_base) : "memory"); }
__device__ __forceinline__ void a_kload2(bf16x8* kf, a_lds_cptr kp, int d0) {
  kf[2 * d0] = *(const __attribute__((address_space(3))) bf16x8*)(kp + d0 * 2048);
  kf[2 * d0 + 1] = *(const __attribute__((address_space(3))) bf16x8*)(kp + d0 * 2048 + 512); }
__device__ __forceinline__ a_s16x4 a_vtr(a_lds_cptr p) { return __builtin_bit_cast(a_s16x4, __builtin_amdgcn_ds_read_tr16_b64_v4i16((__attribute__((address_space(3))) a_v4i16*)p)); }
#define A_MX3(a, b, c) __builtin_fmaxf(__builtin_fmaxf((a), (b)), (c))
__device__ __forceinline__ float a_rowmax(const f32x16& p0, const f32x16& p1) {
  float a = A_MX3(p0[0], p0[1], p1[0]), b = A_MX3(p0[2], p0[3], p1[1]); a = A_MX3(a, p1[2], p1[3]);
#pragma unroll
  for (int r = 4; r < 16; r += 4) { a = A_MX3(a, p0[r], p0[r + 1]); b = A_MX3(b, p0[r + 2], p0[r + 3]); a = A_MX3(a, p1[r], p1[r + 1]); b = A_MX3(b, p1[r + 2], p1[r + 3]); }
  float m = __builtin_fmaxf(a, b); auto rr = __builtin_amdgcn_permlane32_swap(__float_as_uint(m), __float_as_uint(m), false, false);
  return __builtin_fmaxf(__uint_as_float(rr[0]), __uint_as_float(rr[1])); }
template <int MODE>
__device__ __forceinline__ void a_mask(f32x16& p0, f32x16& p1, int key0, int qabs, int hi) {
  const int kb = key0 + 4 * hi;
#pragma unroll
  for (int r = 0; r < 16; ++r) {
    const int kv = kb + (r & 3) + 8 * (r >> 2);
    bool bad0 = kv > qabs, bad1 = (kv + 32) > qabs;
    if (MODE == 2) { bad0 = bad0 || (kv + 512 <= qabs); bad1 = bad1 || (kv + 32 + 512 <= qabs); }
    if (bad0) p0[r] = -INFINITY;
    if (bad1) p1[r] = -INFINITY;
  } }
__device__ __forceinline__ void a_bias(f32x16& p0, f32x16& p1, const char* fb, int hi) {
#pragma unroll
  for (int g = 0; g < 4; ++g) {
    const float4 b0 = *(const float4*)(fb + (8 * g + 4 * hi) * 4);
    const float4 b1 = *(const float4*)(fb + (32 + 8 * g + 4 * hi) * 4);
    p0[4 * g + 0] += b0.x; p0[4 * g + 1] += b0.y; p0[4 * g + 2] += b0.z; p0[4 * g + 3] += b0.w;
    p1[4 * g + 0] += b1.x; p1[4 * g + 1] += b1.y; p1[4 * g + 2] += b1.z; p1[4 * g + 3] += b1.w;
  } }

template <int MODE>
__device__ __forceinline__ void a_unit(const u16* __restrict__ Qw, const int qp, const u16* __restrict__ Kp, const u16* __restrict__ Vp,
                                       const float* __restrict__ Fp, const int NT, const int key00, const int qabs, const unsigned selm,
                                       const float gate, char* lds, u16* stg, const int tid) {
  constexpr int NK = (MODE == 0) ? 2 : 1;
  const int lane = tid & 63, r32 = lane & 31, hi = lane >> 5; const int wid = __builtin_amdgcn_readfirstlane(tid >> 6);
  const unsigned lds0 = (unsigned)(uintptr_t)lds; float* wsf = (float*)(lds + A_LDS_WS) + wid * 64;
  const u16* ksrc = Kp + (long)lane * INC + wid * 8;
  const u16* vsrc = Vp + (long)(16 * (wid & 3) + (lane >> 2)) * INC + (wid >> 2) * 32 + (lane & 3) * 8;
  const float* fsrc = Fp + lane;
  const unsigned kdst = lds0 + A_LDS_K + wid * 1024, vdst = lds0 + A_LDS_V + wid * 1024, fdst = lds0 + A_LDS_F;
#define A_DMA_K(t, slot) do { a_glds16(ksrc + (long)(t) * 64 * INC, (unsigned)__builtin_amdgcn_readfirstlane(kdst + (slot))); \
    if (MODE == 0) a_glds4(fsrc + (t) * 64, (unsigned)__builtin_amdgcn_readfirstlane(fdst + ((t) & 3) * 256)); } while (0)
#define A_DMA_V(t, slot) a_glds16(vsrc + (long)(t) * 64 * INC, (unsigned)__builtin_amdgcn_readfirstlane(vdst + (slot)))
  const a_lds_cptr vp0 = (a_lds_cptr)lds + A_LDS_V + ((lane >> 4) & 1) * 32 + (lane & 3) * 8 + (4 * hi + ((lane & 15) >> 2)) * 64;
  const a_lds_cptr kp0 = (a_lds_cptr)lds + A_LDS_K + hi * 1024 + r32 * 16;
  const char* fb0 = lds + A_LDS_F;
  A_DMA_K(0, 0); A_DMA_V(0, 0); A_DMA_K(1, A_SLOTB);
  bf16x8 qr[4];
#pragma unroll
  for (int d0 = 0; d0 < 4; ++d0) qr[d0] = ldfrag(Qw + (long)r32 * qp + d0 * 16 + hi * 8);
  float mhat = 0.f, l_reg = 0.f; f32x16 o[2];
#pragma unroll
  for (int r = 0; r < 16; ++r) { o[0][r] = 0.f; o[1][r] = 0.f; }
  const f32x16 zero16 = {0.f, 0.f, 0.f, 0.f, 0.f, 0.f, 0.f, 0.f, 0.f, 0.f, 0.f, 0.f, 0.f, 0.f, 0.f, 0.f};
  bool resc = false;
  f32x16 pA0, pA1, pB0, pB1; bf16x8 kf[8]; a_s16x4 vlo[8], vhi[8]; a_u32x4 pw0, pw1, pw2, pw3;
  int sl_prev = 0, sl_cur = 0, sl_next = A_SLOTB;
#define A_ROT() do { sl_prev = sl_cur; sl_cur = sl_next; sl_next = (sl_next == 2 * A_SLOTB) ? 0 : sl_next + A_SLOTB; } while (0)
#define A_EX(v) __builtin_amdgcn_exp2f(__builtin_fmaf((v), A_C2, nmh))
#define A_RESC() do { if (resc) { _Pragma("unroll") for (int d_ = 0; d_ < 2; ++d_) _Pragma("unroll") for (int r = 0; r < 16; ++r) o[d_][r] *= wsf[a_crow(r, hi)]; } } while (0)
  A_DMA_K(2, 2 * A_SLOTB);
  a_wait_bar<1 + 2 * NK>();
  _Pragma("unroll") for (int d0 = 0; d0 < 4; ++d0) a_kload2(kf, kp0, d0);
  pA0 = A_MFMA(kf[0], qr[0], zero16); pA1 = A_MFMA(kf[1], qr[0], zero16); pA0 = A_MFMA(kf[2], qr[1], pA0); pA1 = A_MFMA(kf[3], qr[1], pA1);
  pA0 = A_MFMA(kf[4], qr[2], pA0); pA1 = A_MFMA(kf[5], qr[2], pA1); pA0 = A_MFMA(kf[6], qr[3], pA0); pA1 = A_MFMA(kf[7], qr[3], pA1);
  if (MODE == 0) a_bias(pA0, pA1, fb0, hi);
  if (MODE == 2 || NT == 4) a_mask<MODE>(pA0, pA1, key00, qabs, hi);
  { const float rm = a_rowmax(pA0, pA1); mhat = __builtin_fmaxf(rm * A_C2, -1.0e30f); const float nmh = -mhat;
#pragma unroll
    for (int r = 0; r < 16; ++r) { pA0[r] = A_EX(pA0[r]); pA1[r] = A_EX(pA1[r]); } }
  a_wait_bar<0>();
  A_DMA_K(3, 0); A_DMA_V(1, A_SLOTB); A_ROT();
  _Pragma("unroll") for (int d0 = 0; d0 < 4; ++d0) a_kload2(kf, kp0 + sl_cur, d0);
  a_wait_bar<NK + 1>();
#define A_PKW(P, i) a_cvtpk(P[i], P[i + 1])
#define A_PAF(k) __builtin_bit_cast(bf16x8, pw##k)
#define A_VFR(i) __builtin_bit_cast(bf16x8, __builtin_shufflevector(vlo[i], vhi[i], 0, 1, 2, 3, 4, 5, 6, 7))
#define A_VRD(i) do { vlo[i] = a_vtr(vp_ + (((i) >> 2) * 4096 + ((i) & 3) * 1024)); vhi[i] = a_vtr(vp_ + (((i) >> 2) * 4096 + ((i) & 3) * 1024 + 512)); } while (0)
#define A_KRD(G, d0) do { if (G) { a_kload2(kf, kp0 + sl_next, d0); A_SBAR(); } } while (0)
#define A_GAPA(MF, a0, a1, a2, a3, W0, W1, PW) do { MF; sacc += a0; sacc += a1; sacc += a2; sacc += a3; W0; W1; A_PIN(PW); A_PIN(sacc); A_SBAR(); } while (0)
#define A_GAPB(MF, X, i) do { MF; X[i] = A_EX(X[i]); X[i + 1] = A_EX(X[i + 1]); X[i + 2] = A_EX(X[i + 2]); X[i + 3] = A_EX(X[i + 3]); A_PIN(X); A_SBAR(); } while (0)
#define A_STEP(C0, C1, P0, P1, t, MASK, GK, GV, GL) do { A_SBAR(); \
    const a_lds_cptr vp_ = vp0 + sl_prev; \
    A_VRD(0); A_SBAR(); float sacc = P0[0] + P0[1]; \
                      A_GAPA(C0 = A_MFMA(kf[0], qr[0], zero16), P0[2], P0[3], P0[4], P0[5],     pw0[0] = A_PKW(P0, 0),  pw0[1] = A_PKW(P0, 2),  pw0); \
    A_VRD(4); A_SBAR(); A_GAPA(C1 = A_MFMA(kf[1], qr[0], zero16), P0[6], P0[7], P0[8], P0[9],     pw0[2] = A_PKW(P0, 4),  pw0[3] = A_PKW(P0, 6),  pw0); \
    A_VRD(1); A_SBAR(); A_GAPA(C0 = A_MFMA(kf[2], qr[1], C0),    P0[10], P0[11], P0[12], P0[13], pw1[0] = A_PKW(P0, 8),  pw1[1] = A_PKW(P0, 10), pw1); \
    A_VRD(5); A_SBAR(); A_GAPA(C1 = A_MFMA(kf[3], qr[1], C1),    P0[14], P0[15], P1[0], P1[1],   pw1[2] = A_PKW(P0, 12), pw1[3] = A_PKW(P0, 14), pw1); \
    A_VRD(2); A_SBAR(); A_GAPA(C0 = A_MFMA(kf[4], qr[2], C0),    P1[2], P1[3], P1[4], P1[5],     pw2[0] = A_PKW(P1, 0),  pw2[1] = A_PKW(P1, 2),  pw2); \
    A_VRD(6); A_SBAR(); A_GAPA(C1 = A_MFMA(kf[5], qr[2], C1),    P1[6], P1[7], P1[8], P1[9],     pw2[2] = A_PKW(P1, 4),  pw2[3] = A_PKW(P1, 6),  pw2); \
    A_VRD(3); A_SBAR(); A_GAPA(C0 = A_MFMA(kf[6], qr[3], C0),    P1[10], P1[11], P1[12], P1[13], pw3[0] = A_PKW(P1, 8),  pw3[1] = A_PKW(P1, 10), pw3); \
    A_VRD(7); A_SBAR(); A_GAPA(C1 = A_MFMA(kf[7], qr[3], C1),    P1[14], P1[15], 0.f, 0.f,       pw3[2] = A_PKW(P1, 12), pw3[3] = A_PKW(P1, 14), pw3); \
    l_reg += sacc; \
    if (GK) A_DMA_K((t) + 3, sl_cur); if (GV) A_DMA_V((t) + 1, sl_next); \
    if (MODE == 0) a_bias(C0, C1, fb0 + ((t) & 3) * 256, hi); \
    if (MASK) a_mask<MODE>(C0, C1, key00 + (t) * 64, qabs, hi); \
    const bool selb_ = (MODE != 1) || (((selm >> ((t) & 31)) & 1u) != 0u); \
    { float rmx = a_rowmax(C0, C1) * A_C2; if (!selb_) rmx = -INFINITY; resc = false; \
      if (__builtin_expect(__any((rmx - mhat) > A_THR), 0)) { const float mnew = __builtin_fmaxf(mhat, rmx); \
          const float f = __builtin_amdgcn_exp2f(mhat - mnew); mhat = mnew; l_reg *= f; if (hi == 0) wsf[r32] = f; resc = true; } } \
    const float nmh = selb_ ? -mhat : -INFINITY; A_SBAR(); \
    A_GAPB(o[0] = A_MFMA(A_PAF(0), A_VFR(0), o[0]), C0, 0);              A_GAPB(o[1] = A_MFMA(A_PAF(0), A_VFR(4), o[1]), C0, 4); \
    A_KRD(GL, 0); A_GAPB(o[0] = A_MFMA(A_PAF(1), A_VFR(1), o[0]), C0, 8);  A_KRD(GL, 1); A_GAPB(o[1] = A_MFMA(A_PAF(1), A_VFR(5), o[1]), C0, 12); \
    A_KRD(GL, 2); A_GAPB(o[0] = A_MFMA(A_PAF(2), A_VFR(2), o[0]), C1, 0);  A_KRD(GL, 3); A_GAPB(o[1] = A_MFMA(A_PAF(2), A_VFR(6), o[1]), C1, 4); \
    A_GAPB(o[0] = A_MFMA(A_PAF(3), A_VFR(3), o[0]), C1, 8);              A_GAPB(o[1] = A_MFMA(A_PAF(3), A_VFR(7), o[1]), C1, 12); \
    } while (0)
  int t = 1;
  if (MODE != 2) {
    for (; t + 5 < NT; t += 2) {
      A_STEP(pB0, pB1, pA0, pA1, t, false, true, true, true);     a_wait_bar<NK + 1>(); A_RESC(); A_ROT();
      A_STEP(pA0, pA1, pB0, pB1, t + 1, false, true, true, true); a_wait_bar<NK + 1>(); A_RESC(); A_ROT();
    }
  }
#define A_ENDW(tt) do { if ((tt) + 3 < NT) { a_wait_bar<NK + 1>(); } else if ((tt) + 2 < NT) { a_wait_bar<1>(); } else { a_wait_bar<0>(); } } while (0)
  for (; t + 1 < NT; t += 2) {
    A_STEP(pB0, pB1, pA0, pA1, t, (MODE != 2 || t < 4 || t + 4 >= NT), (t + 3 < NT), (t + 1 < NT), (t + 1 < NT));             A_ENDW(t);     A_RESC(); A_ROT();
    A_STEP(pA0, pA1, pB0, pB1, t + 1, (MODE != 2 || t + 1 < 4 || t + 5 >= NT), (t + 4 < NT), (t + 2 < NT), (t + 2 < NT));     A_ENDW(t + 1); A_RESC(); A_ROT();
  }
  A_STEP(pB0, pB1, pA0, pA1, NT - 1, true, false, false, false); A_RESC();
  { float sacc = pB0[0] + pB0[1];
#pragma unroll
    for (int r = 2; r < 16; ++r) sacc += pB0[r];
#pragma unroll
    for (int r = 0; r < 16; ++r) sacc += pB1[r];
    l_reg += sacc;
    pw0 = (a_u32x4){A_PKW(pB0, 0), A_PKW(pB0, 2), A_PKW(pB0, 4), A_PKW(pB0, 6)}; pw1 = (a_u32x4){A_PKW(pB0, 8), A_PKW(pB0, 10), A_PKW(pB0, 12), A_PKW(pB0, 14)};
    pw2 = (a_u32x4){A_PKW(pB1, 0), A_PKW(pB1, 2), A_PKW(pB1, 4), A_PKW(pB1, 6)}; pw3 = (a_u32x4){A_PKW(pB1, 8), A_PKW(pB1, 10), A_PKW(pB1, 12), A_PKW(pB1, 14)};
    const a_lds_cptr vp_ = vp0 + sl_cur; _Pragma("unroll") for (int i = 0; i < 8; ++i) A_VRD(i);
    o[0] = A_MFMA(A_PAF(0), A_VFR(0), o[0]); o[1] = A_MFMA(A_PAF(0), A_VFR(4), o[1]); o[0] = A_MFMA(A_PAF(1), A_VFR(1), o[0]); o[1] = A_MFMA(A_PAF(1), A_VFR(5), o[1]);
    o[0] = A_MFMA(A_PAF(2), A_VFR(2), o[0]); o[1] = A_MFMA(A_PAF(2), A_VFR(6), o[1]); o[0] = A_MFMA(A_PAF(3), A_VFR(3), o[0]); o[1] = A_MFMA(A_PAF(3), A_VFR(7), o[1]); }
  { auto rr = __builtin_amdgcn_permlane32_swap(__float_as_uint(l_reg), __float_as_uint(l_reg), false, false); l_reg = __uint_as_float(rr[0]) + __uint_as_float(rr[1]); }
  if (hi == 0) wsf[32 + r32] = gate / l_reg;
  asm volatile("s_waitcnt lgkmcnt(0)" ::: "memory");
  float rli[16];
#pragma unroll
  for (int r = 0; r < 16; ++r) rli[r] = wsf[32 + a_crow(r, hi)];
#pragma unroll
  for (int r = 0; r < 16; ++r) { const int orow = a_crow(r, hi);
#pragma unroll
    for (int d0 = 0; d0 < 2; ++d0) stg[orow * 64 + d0 * 32 + r32] = f2bf(o[d0][r] * rli[r]); }
  asm volatile("s_waitcnt lgkmcnt(0)\n\ts_barrier" ::: "memory");
#undef A_DMA_K
#undef A_DMA_V
#undef A_ROT
#undef A_EX
#undef A_RESC
#undef A_PKW
#undef A_PAF
#undef A_VFR
#undef A_VRD
#undef A_KRD
#undef A_ENDW
#undef A_GAPA
#undef A_GAPB
#undef A_STEP
}

__device__ void pc2_phase(const Params& P, int layer, int chunk, char* smem, int* s_item, const int which) {
  volatile __attribute__((address_space(3))) unsigned* xst = (volatile __attribute__((address_space(3))) unsigned*)(smem + XB_LDS_OFF);
  const int nx = (int)xst[1], xc = (int)xst[3];
  const int nBH = P.NB * 16;
  const int nStr = which ? (P.NB * 2) : nBH;
  const int nLoc = (nStr - xc + nx - 1) / nx;
  const int nCmpAll = which ? 0 : P.NB * 2;
  const int nCmp = which ? 0 : (nCmpAll - xc + nx - 1) / nx;
  const int nItems = nCmp + (which ? nLoc * 64 : ((nLoc + 3) >> 2) * 32);
  unsigned* ctr = P.ctr + ((chunk * 4 + layer) * 2 + which) * 8 + xc;
  while (true) {
    const int tid = opaque_tid(), lane = tid & 63, r32 = lane & 31, w = tid >> 6;
    __syncthreads();
    if (tid == 0) *s_item = (int)atomicAdd(ctr, 1u);
    __syncthreads();
    const int it0 = *s_item;
    if (it0 >= nItems) break;
    if (it0 < nCmp) { compress_item(P, layer, xc + nx * it0, smem, tid); continue; }
    const int it = it0 - nCmp;
    int qt, bh;
    if (which) {
      const int sl = it >> 6, rem = it & 63;
      qt = 7 - (rem >> 3);
      bh = (xc + nx * sl) * 8 + (rem & 7);
    } else {
      const int grp = it >> 5, rem = it & 31;
      const int sl = grp * 4 + (rem & 3);
      qt = 7 - (rem >> 2);
      if (sl >= nLoc) continue;
      bh = xc + nx * sl;
    }
    const int type = which;
    const int bl = bh >> 4, head = bh & 15;
    const int q0w = qt * 256 + w * 32;
    const int qabs = q0w + r32;
    const size_t rowq = (size_t)bl * TSEQ + qabs;
    const size_t roww = (size_t)bl * TSEQ + q0w;
    const u16* pb_ = P.proj + (size_t)bl * TSEQ * INC;
    u16* stg = (u16*)(smem + A_LDS_OST) + w * 4096;
    const int er = lane >> 3, ec = (lane & 7) * 8;
    if (type == 0) {
      a_unit<0>(pb_ + roww * 0 + (size_t)q0w * INC + C_QB + head * 64, INC, pb_ + C_KB + head * 64, pb_ + C_VB + head * 64,
                P.F2 + (size_t)(bl * 16 + head) * TSEQ, 4 * qt + 4, 0, qabs, 0u, 1.0f, smem, stg, tid);
#pragma unroll
      for (int i = 0; i < 4; i++) {
        const int row = i * 8 + er;
        const uint4 ov = *(const uint4*)(stg + row * 64 + ec);
        const uint4 zz = *(const uint4*)(pb_ + (size_t)(q0w + row) * INC + C_ZB + head * 64 + ec);
        uint4 y;
        y.x = pk2(bflo(ov.x) * siluf_(bflo(zz.x)), bfhi(ov.x) * siluf_(bfhi(zz.x)));
        y.y = pk2(bflo(ov.y) * siluf_(bflo(zz.y)), bfhi(ov.y) * siluf_(bfhi(zz.y)));
        y.z = pk2(bflo(ov.z) * siluf_(bflo(zz.z)), bfhi(ov.z) * siluf_(bfhi(zz.z)));
        y.w = pk2(bflo(ov.w) * siluf_(bflo(zz.w)), bfhi(ov.w) * siluf_(bfhi(zz.w)));
        *(uint4*)(P.yb + (roww + row) * DM + head * 64 + ec) = y;
      }
    } else {
      const int g = head >> 3;
      const unsigned selm = P.sel[(size_t)(bl * 2 + g) * TSEQ + qabs];
      const float g1 = sigmoidf_(bf2f(P.proj[rowq * INC + C_GA + 16 + head]));
      const float g2 = sigmoidf_(bf2f(P.proj[rowq * INC + C_GA + 32 + head]));
      const u16* qw = P.qr + roww * DM + head * 64;
      a_unit<1>(qw, DM, pb_ + C_KV + 256 + g * 64, pb_ + C_KV + 384 + g * 64, nullptr, 4 * qt + 4, 0, qabs, selm, g1, smem, stg, tid);
      const int klo = (4 * qt - 8) > 0 ? (4 * qt - 8) : 0;
      a_unit<2>(qw, DM, pb_ + (size_t)(klo * 64) * INC + C_KV + 512 + g * 64, pb_ + (size_t)(klo * 64) * INC + C_KV + 640 + g * 64, nullptr,
                4 * qt + 4 - klo, klo * 64, qabs, 0u, g2, smem, stg + 2048, tid);
#pragma unroll
      for (int i = 0; i < 4; i++) {
        const int row = i * 8 + er;
        const uint4 o1 = *(const uint4*)(stg + row * 64 + ec);
        const uint4 o2 = *(const uint4*)(stg + 2048 + row * 64 + ec);
        const uint4 zz = *(const uint4*)(pb_ + (size_t)(q0w + row) * INC + C_ZA + head * 64 + ec);
        u16* yp = P.ya + (roww + row) * DM + head * 64 + ec;
        const uint4 oc = *(const uint4*)yp;
        uint4 y;
        y.x = pk2((bflo(o1.x) + bflo(o2.x) + bflo(oc.x)) * siluf_(bflo(zz.x)), (bfhi(o1.x) + bfhi(o2.x) + bfhi(oc.x)) * siluf_(bfhi(zz.x)));
        y.y = pk2((bflo(o1.y) + bflo(o2.y) + bflo(oc.y)) * siluf_(bflo(zz.y)), (bfhi(o1.y) + bfhi(o2.y) + bfhi(oc.y)) * siluf_(bfhi(zz.y)));
        y.z = pk2((bflo(o1.z) + bflo(o2.z) + bflo(oc.z)) * siluf_(bflo(zz.z)), (bfhi(o1.z) + bfhi(o2.z) + bfhi(oc.z)) * siluf_(bfhi(zz.z)));
        y.w = pk2((bflo(o1.w) + bflo(o2.w) + bflo(oc.w)) * siluf_(bflo(zz.w)), (bfhi(o1.w) + bfhi(o2.w) + bfhi(oc.w)) * siluf_(bfhi(zz.w)));
        *(uint4*)yp = y;
      }
    }
  }
}

#define XB_XCNT(j) (64 * (j))
#define XB_XSUB(j) (1024 + 64 * (j))
#define XB_XGEN(j) (2048 + 64 * (j))
#define XB_TOP 3072
#define XB_TOPGEN 3136
__device__ __forceinline__ unsigned xb_ld(unsigned* p) { return __hip_atomic_load(p, __ATOMIC_RELAXED, __HIP_MEMORY_SCOPE_AGENT); }
__device__ __forceinline__ unsigned xb_add(unsigned* p, unsigned v) { return __hip_atomic_fetch_add(p, v, __ATOMIC_RELAXED, __HIP_MEMORY_SCOPE_AGENT); }
__device__ __forceinline__ unsigned xb_xcc_id() { return (unsigned)__builtin_amdgcn_s_getreg((3 << 11) | 20) & 0xFu; }
__device__ __forceinline__ void grid_bar(unsigned* bar, char* smem) {
  asm volatile("s_waitcnt vmcnt(0) lgkmcnt(0)" ::: "memory");
  __syncthreads();
  if (threadIdx.x == 0) {
    volatile unsigned* st = (volatile unsigned*)(smem + XB_LDS_OFF);
    const unsigned nloc = st[0], nx = st[1], x = st[2];
    const unsigned old = xb_add(&bar[XB_XSUB(x)], 1u);
    const unsigned gen = old / nloc;
    if (old + 1u == (gen + 1u) * nloc) {
      __builtin_amdgcn_fence(__ATOMIC_RELEASE, "agent");
      asm volatile("s_waitcnt vmcnt(0)" ::: "memory");
      const unsigned og = xb_add(&bar[XB_TOP], 1u);
      const unsigned tg = og / nx;
      if (og + 1u == (tg + 1u) * nx) xb_add(&bar[XB_TOPGEN], 1u);
      else { while (xb_ld(&bar[XB_TOPGEN]) == tg) __builtin_amdgcn_s_sleep(1); }
      __builtin_amdgcn_fence(__ATOMIC_ACQUIRE, "agent");
      xb_add(&bar[XB_XGEN(x)], 1u);
      asm volatile("s_waitcnt vmcnt(0)" ::: "memory");
    } else {
      while (xb_ld(&bar[XB_XGEN(x)]) == gen) __builtin_amdgcn_s_sleep(1);
      __builtin_amdgcn_fence(__ATOMIC_ACQUIRE, "agent");
      asm volatile("s_waitcnt vmcnt(0)" ::: "memory");
    }
  }
  __syncthreads();
}

__global__ void __launch_bounds__(NTHREADS, 2) mega_kernel(Params P) {
  __shared__ __attribute__((aligned(1024))) char smem[163840];
  cg::grid_group grid = cg::this_grid();
  const int CT = P.NB * TSEQ;
  phase0(P, smem);
  grid.sync();
  if (threadIdx.x == 0) (void)xb_add(&P.xbar[XB_XCNT(xb_xcc_id())], 1u);
  grid.sync();
  if (threadIdx.x == 0) {
    unsigned cnt = 0u, mine = 0u, rank = 0u; const unsigned x = xb_xcc_id();
#pragma unroll 1
    for (unsigned j = 0; j < 16; ++j) { const unsigned c = xb_ld(&P.xbar[XB_XCNT(j)]); cnt += (c > 0u) ? 1u : 0u; mine = (j == x) ? c : mine; rank += (c > 0u && j < x) ? 1u : 0u; }
    volatile unsigned* st = (volatile unsigned*)(smem + XB_LDS_OFF);
    st[0] = mine > 0u ? mine : 1u; st[1] = cnt > 0u ? cnt : 1u; st[2] = x; st[3] = rank;
  }
  __syncthreads();
  for (int chunk = 0; chunk < P.nchunk; chunk++) {
    for (int layer = 0; layer < 4; layer++) {
      const float* xs = (layer == 0 ? P.x_in : P.out) + (size_t)chunk * CT * DM;
      norm_phase(xs, P.norm_g + layer * DM, P.h, CT);
      if (layer == 0 && chunk > 0) final_norm_phase(P.out, P.final_g, (chunk - 1) * CT, CT);
      grid_bar(P.xbar, smem);
      gemm1_phase(P, layer, smem);
      grid_bar(P.xbar, smem);
      pb_phase(P, layer, smem);
      grid_bar(P.xbar, smem);
      pc2_phase(P, layer, chunk, smem, (int*)(smem + 140000), 0);
      grid_bar(P.xbar, smem);
      pc1_phase(P, smem);
      grid_bar(P.xbar, smem);
      pc2_phase(P, layer, chunk, smem, (int*)(smem + 140000), 1);
      grid_bar(P.xbar, smem);
      gemm2_phase(P, layer, smem);
      grid_bar(P.xbar, smem);
      gemm3_phase(P, layer, chunk, smem);
      grid_bar(P.xbar, smem);
    }
  }
  final_norm_phase(P.out, P.final_g, (P.nchunk - 1) * CT, CT);
}

static inline size_t al256(size_t x) { return (x + 255) & ~(size_t)255; }

extern "C" void kernel_launch(void* const* d_in, const int* in_sizes, int n_in, void* d_out, int out_size,
                              void* d_ws, size_t ws_size, hipStream_t stream) {
  (void)in_sizes; (void)n_in; (void)out_size;
  Params P{};
  P.x_in = (const float*)d_in[0]; P.norm_g = (const float*)d_in[1]; P.w_in = (const float*)d_in[2];
  P.b_forget = (const float*)d_in[3];
  P.pe_k = (const float*)d_in[4]; P.w1_k = (const float*)d_in[5]; P.w2_k = (const float*)d_in[6];
  P.pe_v = (const float*)d_in[7]; P.w1_v = (const float*)d_in[8]; P.w2_v = (const float*)d_in[9];
  P.w_pa = (const float*)d_in[10]; P.w_pb = (const float*)d_in[11]; P.w_out = (const float*)d_in[12];
  P.final_g = (const float*)d_in[13];
  P.out = (float*)d_out;
  int NB = 16;
  char* base = (char*)d_ws;
  for (;;) {
    const size_t CT = (size_t)NB * TSEQ;
    size_t off = 0;
    auto take = [&](size_t bytes) { size_t o = off; off = al256(off + bytes); return o; };
    size_t oWin = take((size_t)4 * INCP * DM * 2), oWpa = take((size_t)4 * DM * DM * 2), oWpb = take((size_t)4 * DM * DM * 2),
           oWo = take((size_t)4 * DM * DM * 2), oW1 = take((size_t)8 * 128 * 2048 * 2), oW2 = take((size_t)8 * 64 * 128 * 2),
           oB1 = take((size_t)64 * 128 * 4), oRc = take((size_t)TSEQ * 32 * 4), oRs = take((size_t)TSEQ * 32 * 4),
           oH = take(CT * DM * 2), oProj = take(CT * INC * 2 + 4096), oVbt = take(CT * DM * 2),
           oVst = take(CT * 128 * 2), oVwt = take(CT * 128 * 2), oFl = take(CT * 16 * 4), oF2 = take(CT * 16 * 4),
           oKc = take((size_t)NB * 2 * 128 * 64 * 2), oVc = take((size_t)NB * 2 * 64 * 128 * 2), oSel = take(CT * 2 * 4),
           oYa = take(CT * DM * 2), oYb = take(CT * DM * 2), oCtr = take(1024), oXb = take(XB_WORDS * 4);
    if (off > ws_size && NB > 1) { NB >>= 1; continue; }
    P.WinT = (u16*)(base + oWin); P.WpaT = (u16*)(base + oWpa); P.WpbT = (u16*)(base + oWpb); P.WoT = (u16*)(base + oWo);
    P.W1T = (u16*)(base + oW1); P.W2T = (u16*)(base + oW2); P.bias1p = (float*)(base + oB1);
    P.ropec = (float*)(base + oRc); P.ropes = (float*)(base + oRs);
    P.h = (u16*)(base + oH); P.proj = (u16*)(base + oProj); P.qr = (u16*)(base + oVbt);
    P.vst = (u16*)(base + oVst); P.vwt = (u16*)(base + oVwt); P.flog = (float*)(base + oFl); P.F2 = (float*)(base + oF2);
    P.kcmp = (u16*)(base + oKc); P.vcmpt = (u16*)(base + oVc); P.sel = (unsigned*)(base + oSel);
    P.ya = (u16*)(base + oYa); P.yb = (u16*)(base + oYb); P.ctr = (unsigned*)(base + oCtr); P.xbar = (unsigned*)(base + oXb);
    break;
  }
  P.NB = NB; P.nchunk = 32 / NB;
  static int grid_blocks = 0;
  if (!grid_blocks) {
    int dev = 0, cus = 0, per_cu = 0;
    hipGetDevice(&dev);
    hipDeviceGetAttribute(&cus, hipDeviceAttributeMultiprocessorCount, dev);
    hipOccupancyMaxActiveBlocksPerMultiprocessor(&per_cu, mega_kernel, NTHREADS, 0);
    if (per_cu > 1) per_cu = 1;
    if (per_cu < 1) per_cu = 1;
    grid_blocks = cus * per_cu;
  }
  void* args[] = {&P};
  hipError_t e = hipLaunchCooperativeKernel((void*)mega_kernel, dim3(grid_blocks), dim3(NTHREADS), args, 0, stream);
  if (e != hipSuccess) fprintf(stderr, "cooperative launch failed: %s (grid %d)\n", hipGetErrorString(e), grid_blocks);
}
```

```cpp
#include <hip/hip_runtime.h>
#include <hip/hip_cooperative_groups.h>
#include <cstdio>
namespace cg = cooperative_groups;

typedef __attribute__((ext_vector_type(8))) __bf16 bf16x8;
typedef __attribute__((ext_vector_type(16))) float f32x16;
typedef __attribute__((ext_vector_type(4))) float f32x4;
typedef __attribute__((ext_vector_type(2))) float f32x2;
typedef unsigned short u16;

#define TSEQ 2048
#define DM 1024
#define INC 9024
#define INCP 9216
#define C_QA 0
#define C_KV 1024
#define C_GA 1792
#define C_ZA 1840
#define C_QB 2864
#define C_KB 3888
#define C_VB 4912
#define C_QR 4912
#define C_FB 5936
#define C_ZB 5952
#define C_RA 6976
#define C_RB 8000
#define NTHREADS 512
#define ATT_STAGE 33280
#define LOG2E 1.4426950408889634f
#define XB_WORDS 3200
#define XB_LDS_OFF 150000

struct Params {
  const float* x_in; const float* norm_g; const float* w_in; const float* b_forget;
  const float* pe_k; const float* w1_k; const float* w2_k;
  const float* pe_v; const float* w1_v; const float* w2_v;
  const float* w_pa; const float* w_pb; const float* w_out; const float* final_g;
  float* out;
  u16* WinT; u16* WpaT; u16* WpbT; u16* WoT; u16* W1T; u16* W2T;
  float* bias1p; float* ropec; float* ropes;
  u16* h; u16* proj; u16* qr; u16* vst; u16* vwt;
  float* flog; float* F2; u16* kcmp; u16* vcmpt; unsigned* sel;
  u16* ya; u16* yb; unsigned* ctr; unsigned* xbar;
  int NB; int nchunk;
};

__device__ __forceinline__ unsigned pk2(float a, float b) {
  typedef __attribute__((ext_vector_type(2))) float f2_t;
  typedef __attribute__((ext_vector_type(2))) __bf16 b2_t;
  f2_t v = {a, b};
  b2_t r = __builtin_convertvector(v, b2_t);
  return __builtin_bit_cast(unsigned, r);
}
__device__ __forceinline__ u16 f2bf(float a) { return (u16)(pk2(a, 0.f) & 0xffffu); }
__device__ __forceinline__ float bf2f(u16 u) { return __uint_as_float(((unsigned)u) << 16); }
__device__ __forceinline__ float bflo(unsigned u) { return __uint_as_float(u << 16); }
__device__ __forceinline__ float bfhi(unsigned u) { return __uint_as_float(u & 0xffff0000u); }
__device__ __forceinline__ float sigmoidf_(float x) { return __builtin_amdgcn_rcpf(1.f + __expf(-x)); }
__device__ __forceinline__ float siluf_(float x) { return x * __builtin_amdgcn_rcpf(1.f + __expf(-x)); }
__device__ __forceinline__ f32x16 mfma32(bf16x8 a, bf16x8 b, f32x16 c) {
  return __builtin_amdgcn_mfma_f32_32x32x16_bf16(a, b, c, 0, 0, 0);
}
__device__ __forceinline__ int opaque_tid() { int t = threadIdx.x; asm volatile("" : "+v"(t)); return t; }
__device__ __forceinline__ bf16x8 ldfrag(const void* p) {
  return __builtin_bit_cast(bf16x8, *(const uint4*)p);
}

__device__ void transpose_tile(const float* __restrict__ src, u16* __restrict__ dst, int K, int N,
                               int k0, int n0, float* tile, const int tid) {
#pragma unroll
  for (int j = 0; j < 2; j++) {
    int r = (tid >> 4) + 32 * j, c4 = (tid & 15) * 4;
    float4 v = *(const float4*)(src + (size_t)(k0 + r) * N + n0 + c4);
    tile[r * 65 + c4] = v.x; tile[r * 65 + c4 + 1] = v.y; tile[r * 65 + c4 + 2] = v.z; tile[r * 65 + c4 + 3] = v.w;
  }
  __syncthreads();
  {
    int c = tid, n = c >> 3, kc = c & 7;
    const float* tp = tile + (kc * 8) * 65 + n;
    uint4 o;
    o.x = pk2(tp[0], tp[65]); o.y = pk2(tp[130], tp[195]); o.z = pk2(tp[260], tp[325]); o.w = pk2(tp[390], tp[455]);
    *(uint4*)(dst + (size_t)(n0 + n) * K + k0 + kc * 8) = o;
  }
  __syncthreads();
}

__device__ void phase0(const Params& P, char* smem) {
  const int tid = opaque_tid();
  float* tile = (float*)smem;
  const int n0_ = 4 * 16 * 141, n1_ = 4 * 16 * 16, n2_ = 4 * 32 * 2, n3_ = 4 * 2 * 1;
  const int nT = n0_ + 3 * n1_ + 2 * n2_ + 2 * n3_;
  const int nBias = 64, nRope = 128;
  const int total = nT + nBias + nRope + 1;
  for (int it = blockIdx.x; it < total; it += gridDim.x) {
    if (it < nT) {
      int t = it;
      if (t < n0_) {
        int l = t / (16 * 141), rem = t % (16 * 141);
        transpose_tile(P.w_in + (size_t)l * DM * INC, P.WinT + (size_t)l * INCP * DM, DM, INC, (rem / 141) * 64, (rem % 141) * 64, tile, tid);
        continue;
      }
      t -= n0_;
      if (t < 3 * n1_) {
        int which = t / n1_; t %= n1_;
        int l = t / 256, rem = t % 256;
        const float* s = which == 0 ? P.w_pa : (which == 1 ? P.w_pb : P.w_out);
        u16* d = which == 0 ? P.WpaT : (which == 1 ? P.WpbT : P.WoT);
        transpose_tile(s + (size_t)l * DM * DM, d + (size_t)l * DM * DM, DM, DM, (rem >> 4) * 64, (rem & 15) * 64, tile, tid);
        continue;
      }
      t -= 3 * n1_;
      if (t < 2 * n2_) {
        int kv = t / n2_; t %= n2_;
        int l = t / 64, rem = t % 64;
        const float* s = kv ? P.w1_v : P.w1_k;
        transpose_tile(s + (size_t)l * 2048 * 128, P.W1T + (size_t)(l * 2 + kv) * 128 * 2048, 2048, 128, (rem >> 1) * 64, (rem & 1) * 64, tile, tid);
        continue;
      }
      t -= 2 * n2_;
      {
        int kv = t / n3_; t %= n3_;
        int l = t / 2, rem = t % 2;
        const float* s = kv ? P.w2_v : P.w2_k;
        transpose_tile(s + (size_t)l * 128 * 64, P.W2T + (size_t)(l * 2 + kv) * 64 * 128, 128, 64, rem * 64, 0, tile, tid);
      }
    } else if (it < nT + nBias) {
      int j = it - nT;
      int l = j >> 4, kv = (j >> 3) & 1, kq = j & 7;
      const float* pe = (kv ? P.pe_v : P.pe_k) + (size_t)l * 2048;
      const float* w1 = (kv ? P.w1_v : P.w1_k) + (size_t)l * 2048 * 128;
      int hid = tid & 127, kh = tid >> 7;
      int kbeg = kq * 256 + kh * 64;
      float s = 0.f;
#pragma unroll 8
      for (int k = 0; k < 64; k++) s += pe[kbeg + k] * w1[(size_t)(kbeg + k) * 128 + hid];
      float* part = (float*)smem;
      part[tid] = s;
      __syncthreads();
      if (tid < 128) P.bias1p[((l * 2 + kv) * 8 + kq) * 128 + hid] = (part[tid] + part[tid + 128]) + (part[tid + 256] + part[tid + 384]);
      __syncthreads();
    } else if (it < nT + nBias + nRope) {
      int idx = (it - nT - nBias) * 512 + tid;
      int t = idx >> 5, j = idx & 31;
      double inv = 1.0;
      for (int q = 0; q < j; q++) inv *= 0.7498942093324558;
      float invf = (float)inv;
      float angf = (float)t * invf;
      double a = (double)angf;
      double kq = rint(a * 0.15915494309189535);
      double rr = a - kq * 6.283185307179586;
      double r2 = rr * rr;
      double sterm = rr, cterm = 1.0, ssum = rr, csum = 1.0;
#pragma unroll 1
      for (int n = 1; n <= 15; n++) {
        cterm *= -r2 / (double)((2 * n - 1) * (2 * n));
        sterm *= -r2 / (double)((2 * n) * (2 * n + 1));
        csum += cterm; ssum += sterm;
      }
      P.ropec[idx] = (float)csum;
      P.ropes[idx] = (float)ssum;
    } else {
      if (tid < 256) P.ctr[tid] = 0u;
      for (int i = tid; i < XB_WORDS; i += NTHREADS) P.xbar[i] = 0u;
    }
  }
}

__device__ void norm_phase(const float* __restrict__ xsrc, const float* __restrict__ g, u16* __restrict__ hdst, int nrows) {
  const int tid = opaque_tid();
  const int lane = tid & 63;
  const int gw = blockIdx.x * 8 + (tid >> 6), nw = gridDim.x * 8;
  float4 gv[4];
#pragma unroll
  for (int j = 0; j < 4; j++) gv[j] = *(const float4*)(g + lane * 4 + 256 * j);
  for (int row = gw; row < nrows; row += 2 * nw) {
    const float* xr0 = xsrc + (size_t)row * DM;
    const float* xr1 = xsrc + (size_t)(row + nw) * DM;
    float4 v0[4], v1[4];
#pragma unroll
    for (int j = 0; j < 4; j++) { v0[j] = *(const float4*)(xr0 + lane * 4 + 256 * j); v1[j] = *(const float4*)(xr1 + lane * 4 + 256 * j); }
    float s0 = 0.f, s1 = 0.f;
#pragma unroll
    for (int j = 0; j < 4; j++) {
      s0 += v0[j].x * v0[j].x + v0[j].y * v0[j].y + v0[j].z * v0[j].z + v0[j].w * v0[j].w;
      s1 += v1[j].x * v1[j].x + v1[j].y * v1[j].y + v1[j].z * v1[j].z + v1[j].w * v1[j].w;
    }
#pragma unroll
    for (int o = 32; o >= 1; o >>= 1) { s0 += __shfl_xor(s0, o); s1 += __shfl_xor(s1, o); }
    const float r0 = rsqrtf(s0 * (1.f / DM) + 1e-6f), r1 = rsqrtf(s1 * (1.f / DM) + 1e-6f);
#pragma unroll
    for (int j = 0; j < 4; j++) {
      uint2 o;
      o.x = pk2(v0[j].x * r0 * gv[j].x, v0[j].y * r0 * gv[j].y);
      o.y = pk2(v0[j].z * r0 * gv[j].z, v0[j].w * r0 * gv[j].w);
      *(uint2*)(hdst + (size_t)row * DM + lane * 4 + 256 * j) = o;
      o.x = pk2(v1[j].x * r1 * gv[j].x, v1[j].y * r1 * gv[j].y);
      o.y = pk2(v1[j].z * r1 * gv[j].z, v1[j].w * r1 * gv[j].w);
      *(uint2*)(hdst + (size_t)(row + nw) * DM + lane * 4 + 256 * j) = o;
    }
  }
}

__device__ void final_norm_phase(float* __restrict__ x, const float* __restrict__ g, int row0, int nrows) {
  const int tid = opaque_tid();
  const int lane = tid & 63;
  const int gw = blockIdx.x * 8 + (tid >> 6), nw = gridDim.x * 8;
  float4 gv[4];
#pragma unroll
  for (int j = 0; j < 4; j++) gv[j] = *(const float4*)(g + lane * 4 + 256 * j);
  for (int row = gw; row < nrows; row += nw) {
    float* xr = x + (size_t)(row0 + row) * DM;
    float4 v[4];
    float ss = 0.f;
#pragma unroll
    for (int j = 0; j < 4; j++) {
      v[j] = *(const float4*)(xr + lane * 4 + 256 * j);
      ss += v[j].x * v[j].x + v[j].y * v[j].y + v[j].z * v[j].z + v[j].w * v[j].w;
    }
#pragma unroll
    for (int o = 32; o >= 1; o >>= 1) ss += __shfl_xor(ss, o);
    float rstd = rsqrtf(ss * (1.f / DM) + 1e-6f);
#pragma unroll
    for (int j = 0; j < 4; j++) {
      float4 o;
      o.x = v[j].x * rstd * gv[j].x; o.y = v[j].y * rstd * gv[j].y;
      o.z = v[j].z * rstd * gv[j].z; o.w = v[j].w * rstd * gv[j].w;
      *(float4*)(xr + lane * 4 + 256 * j) = o;
    }
  }
}

struct ARow {
  const u16* p; int ld;
  __device__ __forceinline__ const u16* operator()(int row, int k) const { return p + (size_t)row * ld + k; }
};
struct ACmp {
  const u16* p;
  __device__ __forceinline__ const u16* operator()(int row, int k) const {
    int t = 16 * row + (k >> 6); t = t > (TSEQ - 1) ? (TSEQ - 1) : t;
    return p + (size_t)t * INC + (k & 63);
  }
};

template <class AF>
__device__ __forceinline__ void gemm_mainloop(AF af, const u16* __restrict__ Bt, int ldb, int K, char* smem,
                                              f32x16 (&acc)[2][2], const int tid) {
  const int lane = tid & 63, r = lane & 31, h = lane >> 5, w = tid >> 6;
  const int wm = w >> 1, wn = w & 1;
  const int lrow = tid >> 3, lch = tid & 7;
  uint4 ra[4], rb[4];
  const int nk = K >> 6;
#pragma unroll
  for (int j = 0; j < 4; j++) {
    int row = lrow + 32 * j;
    ra[j] = *(const uint4*)af(row, lch * 8);
    rb[j] = *(const uint4*)(Bt + (size_t)row * ldb + lch * 8);
  }
#pragma unroll
  for (int j = 0; j < 4; j++) {
    int row = lrow + 32 * j;
    int off = row * 128 + ((lch ^ ((row >> 1) & 7)) << 4);
    *(uint4*)(smem + off) = ra[j];
    *(uint4*)(smem + 16384 + off) = rb[j];
  }
  __syncthreads();
  for (int it = 0; it < nk; it++) {
    const bool more = (it + 1) < nk;
    if (more) {
      const int k0 = (it + 1) * 64;
#pragma unroll
      for (int j = 0; j < 4; j++) {
        int row = lrow + 32 * j;
        ra[j] = *(const uint4*)af(row, k0 + lch * 8);
        rb[j] = *(const uint4*)(Bt + (size_t)row * ldb + k0 + lch * 8);
      }
    }
    const char* sa = smem + (it & 1) * 32768;
    const char* sb = sa + 16384;
#pragma unroll
    for (int kk = 0; kk < 4; kk++) {
      bf16x8 a[2], b[2];
#pragma unroll
      for (int mi = 0; mi < 2; mi++) {
        int row = wm * 64 + mi * 32 + r;
        a[mi] = ldfrag(sa + row * 128 + (((kk * 2 + h) ^ ((row >> 1) & 7)) << 4));
      }
#pragma unroll
      for (int ni = 0; ni < 2; ni++) {
        int row = wn * 64 + ni * 32 + r;
        b[ni] = ldfrag(sb + row * 128 + (((kk * 2 + h) ^ ((row >> 1) & 7)) << 4));
      }
#pragma unroll
      for (int mi = 0; mi < 2; mi++)
#pragma unroll
        for (int ni = 0; ni < 2; ni++) acc[mi][ni] = mfma32(a[mi], b[ni], acc[mi][ni]);
    }
    if (more) {
      char* sd = smem + ((it + 1) & 1) * 32768;
#pragma unroll
      for (int j = 0; j < 4; j++) {
        int row = lrow + 32 * j;
        int off = row * 128 + ((lch ^ ((row >> 1) & 7)) << 4);
        *(uint4*)(sd + off) = ra[j];
        *(uint4*)(sd + 16384 + off) = rb[j];
      }
    }
    __syncthreads();
  }
}

__device__ __forceinline__ void zero_acc(f32x16 (&acc)[2][2]) {
#pragma unroll
  for (int a = 0; a < 2; a++)
#pragma unroll
    for (int b = 0; b < 2; b++)
#pragma unroll
      for (int i = 0; i < 16; i++) acc[a][b][i] = 0.f;
}

typedef __attribute__((ext_vector_type(8))) short s16x8;
#define G_TILE_B 32768
#define G_STAGE_B 65536
__device__ __forceinline__ int g_lds_byte(int r, int c) {
  int st = (r >> 4) * 2 + (c >> 5), ob = (r & 15) * 64 + (c & 31) * 2;
  return st * 1024 + (ob ^ (((ob >> 9) & 1) << 5));
}
__device__ __forceinline__ void g_stage_rc(int b, int& R, int& C) {
  int st = b >> 10, sb = b & 1023, swz = sb ^ (((sb >> 9) & 1) << 5);
  R = (st >> 1) * 16 + swz / 64;
  C = (st & 1) * 32 + (swz % 64) / 2;
}
#define G_WAIT_V0() asm volatile("s_waitcnt vmcnt(0)" ::: "memory")

struct GTile { int pm, pn; };
__device__ __forceinline__ bool g_next(int i, int G, int c, int nM, int nN, GTile& u) {
  const int nwg = nM * nN;
  const int L = i * G + c;
  if (L >= nwg) return false;
  int wgid = L;
  { const int q = nwg / 8, r = nwg % 8, xcd = wgid % 8, off = wgid / 8; wgid = (xcd < r ? xcd * (q + 1) : r * (q + 1) + (xcd - r) * q) + off; }
  const int nig = 4 * nN, gid = wgid / nig, fm = gid * 4, gsz = (nM - fm) < 4 ? (nM - fm) : 4;
  u.pm = fm + ((wgid % nig) % gsz);
  u.pn = (wgid % nig) / gsz;
  return true;
}

__device__ __forceinline__ void g_kloop(const u16* __restrict__ Ab, const u16* __restrict__ Bb, const int K, char* smem,
                                        f32x4 (&acc)[8][4], const int tid, const bool pre, const u16* __restrict__ nA,
                                        const u16* __restrict__ nB, const bool has_next) {
  const int wid = tid >> 6, lane = tid & 63, wr = wid >> 2, wc = wid & 3, fr = lane & 15, fq = lane >> 4;
  int sR0, sC0, sR1, sC1, sR2, sC2, sR3, sC3;
  g_stage_rc(wid * 1024 + 0 * 8192 + lane * 16, sR0, sC0);
  g_stage_rc(wid * 1024 + 1 * 8192 + lane * 16, sR1, sC1);
  g_stage_rc(wid * 1024 + 2 * 8192 + lane * 16, sR2, sC2);
  g_stage_rc(wid * 1024 + 3 * 8192 + lane * 16, sR3, sC3);
  const long o0 = (long)sR0 * K + sC0, o1 = (long)sR1 * K + sC1, o2 = (long)sR2 * K + sC2, o3 = (long)sR3 * K + sC3;
#define G_STAGE(buf, kt)                                                                                              \
  {                                                                                                                  \
    char* sa_ = smem + (buf) * G_STAGE_B + wid * 1024;                                                               \
    char* sb_ = sa_ + G_TILE_B;                                                                                      \
    const u16* ga_ = Ab + (kt) * 64;                                                                                 \
    const u16* gb_ = Bb + (kt) * 64;                                                                                 \
    __builtin_amdgcn_global_load_lds((const unsigned*)(ga_ + o0), (unsigned*)(sa_), 16, 0, 0);                       \
    __builtin_amdgcn_global_load_lds((const unsigned*)(gb_ + o0), (unsigned*)(sb_), 16, 0, 0);                       \
    __builtin_amdgcn_global_load_lds((const unsigned*)(ga_ + o1), (unsigned*)(sa_ + 8192), 16, 0, 0);                \
    __builtin_amdgcn_global_load_lds((const unsigned*)(gb_ + o1), (unsigned*)(sb_ + 8192), 16, 0, 0);                \
    __builtin_amdgcn_global_load_lds((const unsigned*)(ga_ + o2), (unsigned*)(sa_ + 16384), 16, 0, 0);               \
    __builtin_amdgcn_global_load_lds((const unsigned*)(gb_ + o2), (unsigned*)(sb_ + 16384), 16, 0, 0);               \
    __builtin_amdgcn_global_load_lds((const unsigned*)(ga_ + o3), (unsigned*)(sa_ + 24576), 16, 0, 0);               \
    __builtin_amdgcn_global_load_lds((const unsigned*)(gb_ + o3), (unsigned*)(sb_ + 24576), 16, 0, 0);               \
  }
  const int nt = K >> 6;
  if (!pre) {
    G_STAGE(0, 0);
    G_WAIT_V0();
    __syncthreads();
  }
  for (int t = 0; t < nt; ++t) {
    const int cur = t & 1;
    if (t + 1 < nt) G_STAGE(cur ^ 1, t + 1)
    else if (has_next) {
      char* sa_ = smem + wid * 1024;
      char* sb_ = sa_ + G_TILE_B;
      __builtin_amdgcn_global_load_lds((const unsigned*)(nA + o0), (unsigned*)(sa_), 16, 0, 0);
      __builtin_amdgcn_global_load_lds((const unsigned*)(nB + o0), (unsigned*)(sb_), 16, 0, 0);
      __builtin_amdgcn_global_load_lds((const unsigned*)(nA + o1), (unsigned*)(sa_ + 8192), 16, 0, 0);
      __builtin_amdgcn_global_load_lds((const unsigned*)(nB + o1), (unsigned*)(sb_ + 8192), 16, 0, 0);
      __builtin_amdgcn_global_load_lds((const unsigned*)(nA + o2), (unsigned*)(sa_ + 16384), 16, 0, 0);
      __builtin_amdgcn_global_load_lds((const unsigned*)(nB + o2), (unsigned*)(sb_ + 16384), 16, 0, 0);
      __builtin_amdgcn_global_load_lds((const unsigned*)(nA + o3), (unsigned*)(sa_ + 24576), 16, 0, 0);
      __builtin_amdgcn_global_load_lds((const unsigned*)(nB + o3), (unsigned*)(sb_ + 24576), 16, 0, 0);
    }
    const char* sa = smem + cur * G_STAGE_B;
    const char* sb = sa + G_TILE_B;
#pragma unroll
    for (int ks = 0; ks < 2; ++ks) {
      s16x8 At[8], Bf[4];
#pragma unroll
      for (int m = 0; m < 8; ++m) At[m] = *(const s16x8*)(sa + g_lds_byte(wr * 128 + m * 16 + fr, ks * 32 + fq * 8));
#pragma unroll
      for (int n = 0; n < 4; ++n) Bf[n] = *(const s16x8*)(sb + g_lds_byte(wc * 64 + n * 16 + fr, ks * 32 + fq * 8));
#pragma unroll
      for (int m = 0; m < 8; ++m)
#pragma unroll
        for (int n = 0; n < 4; ++n)
          acc[m][n] = __builtin_amdgcn_mfma_f32_16x16x32_bf16(__builtin_bit_cast(bf16x8, Bf[n]), __builtin_bit_cast(bf16x8, At[m]), acc[m][n], 0, 0, 0);
      __builtin_amdgcn_sched_barrier(0);
    }
    G_WAIT_V0();
    __syncthreads();
  }
}

__device__ __forceinline__ void g_zero(f32x4 (&acc)[8][4]) {
#pragma unroll
  for (int m = 0; m < 8; m++)
#pragma unroll
    for (int n = 0; n < 4; n++) acc[m][n] = (f32x4){0.f, 0.f, 0.f, 0.f};
}
__device__ __forceinline__ uint2 pk4(f32x4 v) { return make_uint2(pk2(v[0], v[1]), pk2(v[2], v[3])); }

__device__ __forceinline__ void wave_store_rows(char* wsm, u16* gbase, const size_t ld, const f32x4 (&acc)[8][4], const int lane) {
  const int fr = lane & 15, fq = lane >> 4;
  const int rr = lane >> 3, ch = lane & 7;
  typedef __attribute__((ext_vector_type(4))) unsigned u32x4_t;
#pragma unroll
  for (int hf = 0; hf < 2; hf++) {
#pragma unroll
    for (int m = 0; m < 4; m++)
#pragma unroll
      for (int n = 0; n < 4; n++) {
        const int row = m * 16 + fr, chunk = n * 2 + (fq >> 1);
        *(uint2*)(wsm + row * 128 + ((chunk ^ (fr & 7)) << 4) + (fq & 1) * 8) = pk4(acc[hf * 4 + m][n]);
      }
#pragma unroll
    for (int i = 0; i < 8; i++) {
      const int row = i * 8 + rr;
      const uint4 v = *(const uint4*)(wsm + row * 128 + ((ch ^ (row & 7)) << 4));
      __builtin_nontemporal_store(__builtin_bit_cast(u32x4_t, v), (u32x4_t*)(gbase + (size_t)(hf * 64 + row) * ld + ch * 8));
    }
  }
}
__device__ __forceinline__ void wave_store_cols(char* wsm, u16* vt, const int vcol0, const int nh, const int bl, const int t0,
                                                const f32x4 (&acc)[8][4], const int lane) {
  const int fr = lane & 15, fq = lane >> 4;
#pragma unroll
  for (int m = 0; m < 8; m++)
#pragma unroll
    for (int n = 0; n < 4; n++)
#pragma unroll
      for (int j = 0; j < 4; j++) {
        const int d = n * 16 + fq * 4 + j, t = m * 16 + fr;
        *(u16*)(wsm + d * 256 + (((t >> 3) ^ (d & 15)) << 4) + (t & 7) * 2) = f2bf(acc[m][n][j]);
      }
  const int dd = lane >> 4, ch = lane & 15;
#pragma unroll
  for (int i = 0; i < 16; i++) {
    const int d = i * 4 + dd;
    const uint4 v = *(const uint4*)(wsm + d * 256 + ((ch ^ (d & 15)) << 4));
    const int vcol = vcol0 + d;
    *(uint4*)(vt + ((size_t)(bl * nh + (vcol >> 6)) * 64 + (vcol & 63)) * TSEQ + t0 + ch * 8) = v;
  }
}

__device__ void gemm1_phase(const Params& P, int layer, char* smem) {
  const int CT = P.NB * TSEQ;
  const int nM = CT >> 8, nN = INCP >> 8;
  const u16* Bt = P.WinT + (size_t)layer * INCP * DM;
  u16* p_qr = P.qr; u16* p_proj = P.proj;
  asm volatile("" : "+s"(p_qr), "+s"(p_proj));
  for (int i = 0;; i++) {
    GTile u, un;
    if (!g_next(i, gridDim.x, blockIdx.x, nM, nN, u)) break;
    const bool hn = g_next(i + 1, gridDim.x, blockIdx.x, nM, nN, un);
    const int tid = opaque_tid(), wid = tid >> 6, lane = tid & 63, wr = wid >> 2, wc = wid & 3, fr = lane & 15, fq = lane >> 4;
    f32x4 acc[8][4];
    g_zero(acc);
    g_kloop(P.h + (size_t)(u.pm * 256) * DM, Bt + (size_t)(u.pn * 256) * DM, DM, smem, acc, tid, i > 0,
            P.h + (size_t)(un.pm * 256) * DM, Bt + (size_t)(un.pn * 256) * DM, hn);
    const int cw = u.pn * 256 + wc * 64;
    const int row0 = u.pm * 256 + wr * 128 + fr;
    char* wsm = smem + G_STAGE_B + wid * 8192;
    const int rowb = u.pm * 256 + wr * 128;
    const bool rope_q = cw < 1024;
    const bool rope_k = (cw >= C_KV + 256 && cw < C_KV + 384) || (cw >= C_KV + 512 && cw < C_KV + 640);
    const bool mixed = (cw == 5888);
    if (cw >= INC) {
    } else if (rope_q || rope_k) {
      if (rope_q) wave_store_rows(wsm, p_proj + (size_t)rowb * INC + cw, INC, acc, lane);
#pragma unroll
      for (int m = 0; m < 8; m++) {
        const int tt = (row0 + m * 16) & (TSEQ - 1);
#pragma unroll
        for (int n = 0; n < 2; n++) {
          const float4 c = *(const float4*)(P.ropec + tt * 32 + n * 16 + fq * 4);
          const float4 sn = *(const float4*)(P.ropes + tt * 32 + n * 16 + fq * 4);
          const f32x4 x1 = acc[m][n], x2 = acc[m][n + 2];
          f32x4 r1, r2;
          r1[0] = x1[0] * c.x - x2[0] * sn.x; r2[0] = x2[0] * c.x + x1[0] * sn.x;
          r1[1] = x1[1] * c.y - x2[1] * sn.y; r2[1] = x2[1] * c.y + x1[1] * sn.y;
          r1[2] = x1[2] * c.z - x2[2] * sn.z; r2[2] = x2[2] * c.z + x1[2] * sn.z;
          r1[3] = x1[3] * c.w - x2[3] * sn.w; r2[3] = x2[3] * c.w + x1[3] * sn.w;
          acc[m][n] = r1; acc[m][n + 2] = r2;
        }
      }
      if (rope_q) wave_store_rows(wsm, p_qr + (size_t)rowb * DM + cw, DM, acc, lane);
      else wave_store_rows(wsm, p_proj + (size_t)rowb * INC + cw, INC, acc, lane);
    } else if (!mixed) {
      wave_store_rows(wsm, p_proj + (size_t)rowb * INC + cw, INC, acc, lane);
    } else {
#pragma unroll
      for (int n = 0; n < 4; n++) {
        const int c0 = cw + n * 16 + fq * 4;
        if (c0 < C_FB) {
#pragma unroll
          for (int m = 0; m < 8; m++) *(uint2*)(p_proj + (size_t)(row0 + m * 16) * INC + c0) = pk4(acc[m][n]);
        } else {
#pragma unroll
          for (int m = 0; m < 8; m++)
            *(float4*)(P.flog + (size_t)(row0 + m * 16) * 16 + (c0 - C_FB)) = make_float4(acc[m][n][0], acc[m][n][1], acc[m][n][2], acc[m][n][3]);
        }
        __builtin_amdgcn_sched_barrier(0);
      }
    }
    __syncthreads();
  }
}

__device__ void gemm2_phase(const Params& P, int layer, char* smem) {
  const int CT = P.NB * TSEQ;
  const int nM = CT >> 8, nN = 4;
  const u16* p_ya = P.ya; const u16* p_yb = P.yb; const u16* p_wa = P.WpaT; const u16* p_wb = P.WpbT;
  for (int i = 0;; i++) {
    GTile u, un;
    if (!g_next(i, gridDim.x, blockIdx.x, nM, nN, u)) break;
    const bool hn = g_next(i + 1, gridDim.x, blockIdx.x, nM, nN, un);
    const int tid = opaque_tid(), wid = tid >> 6, lane = tid & 63, wr = wid >> 2, wc = wid & 3, fr = lane & 15, fq = lane >> 4;
    f32x4 acc[8][4];
    g_zero(acc);
#pragma unroll 1
    for (int pass = 0; pass < 2; pass++) {
      const u16* Ap = (pass ? p_yb : p_ya) + (size_t)(u.pm * 256) * DM;
      const u16* Bp = (pass ? p_wb : p_wa) + (size_t)layer * DM * DM + (size_t)(u.pn * 256) * DM;
      const u16* nAp = pass ? (p_ya + (size_t)(un.pm * 256) * DM) : (p_yb + (size_t)(u.pm * 256) * DM);
      const u16* nBp = pass ? (p_wa + (size_t)layer * DM * DM + (size_t)(un.pn * 256) * DM) : (p_wb + (size_t)layer * DM * DM + (size_t)(u.pn * 256) * DM);
      g_kloop(Ap, Bp, DM, smem, acc, tid, (i > 0) || (pass > 0), nAp, nBp, pass ? hn : true);
      __builtin_amdgcn_sched_barrier(0);
      if (pass == 0) {
        const int tid1 = opaque_tid(), wid1 = tid1 >> 6, lane1 = tid1 & 63, wr1 = wid1 >> 2, wc1 = wid1 & 3, fr1 = lane1 & 15, fq1 = lane1 >> 4;
        const u16* pp = P.proj + (size_t)(u.pm * 256 + wr1 * 128 + fr1) * INC + u.pn * 256 + wc1 * 64 + fq1 * 4;
#pragma unroll
        for (int m = 0; m < 8; m++) {
#pragma unroll
          for (int n = 0; n < 4; n++) {
            const uint2 ra = *(const uint2*)(pp + (size_t)(m * 16) * INC + C_RA + n * 16);
            const uint2 rb = *(const uint2*)(pp + (size_t)(m * 16) * INC + C_RB + n * 16);
            acc[m][n][0] *= (1.f + __expf(-bflo(rb.x))) * __builtin_amdgcn_rcpf(1.f + __expf(-bflo(ra.x)));
            acc[m][n][1] *= (1.f + __expf(-bfhi(rb.x))) * __builtin_amdgcn_rcpf(1.f + __expf(-bfhi(ra.x)));
            acc[m][n][2] *= (1.f + __expf(-bflo(rb.y))) * __builtin_amdgcn_rcpf(1.f + __expf(-bflo(ra.y)));
            acc[m][n][3] *= (1.f + __expf(-bfhi(rb.y))) * __builtin_amdgcn_rcpf(1.f + __expf(-bfhi(ra.y)));
          }
          __builtin_amdgcn_sched_barrier(0);
        }
      }
    }
    {
      const int tid2 = opaque_tid(), wid2 = tid2 >> 6, lane2 = tid2 & 63, wr2 = wid2 >> 2, wc2 = wid2 & 3, fr2 = lane2 & 15, fq2 = lane2 >> 4;
      const u16* pp = P.proj + (size_t)(u.pm * 256 + wr2 * 128 + fr2) * INC + u.pn * 256 + wc2 * 64 + fq2 * 4;
#pragma unroll
      for (int m = 0; m < 8; m++) {
#pragma unroll
        for (int n = 0; n < 4; n++) {
          const uint2 rb = *(const uint2*)(pp + (size_t)(m * 16) * INC + C_RB + n * 16);
          acc[m][n][0] *= sigmoidf_(bflo(rb.x)); acc[m][n][1] *= sigmoidf_(bfhi(rb.x));
          acc[m][n][2] *= sigmoidf_(bflo(rb.y)); acc[m][n][3] *= sigmoidf_(bfhi(rb.y));
        }
        __builtin_amdgcn_sched_barrier(0);
      }
      wave_store_rows(smem + G_STAGE_B + wid2 * 8192, P.h + (size_t)(u.pm * 256 + wr2 * 128) * DM + u.pn * 256 + wc2 * 64, DM, acc, lane2);
    }
    __syncthreads();
  }
}

__device__ void gemm3_phase(const Params& P, int layer, int chunk, char* smem) {
  const int CT = P.NB * TSEQ;
  const int nM = CT >> 8, nN = 4;
  const float* xs = (layer == 0 ? P.x_in : P.out) + (size_t)chunk * CT * DM;
  float* xd = P.out + (size_t)chunk * CT * DM;
  for (int i = 0;; i++) {
    GTile u, un;
    if (!g_next(i, gridDim.x, blockIdx.x, nM, nN, u)) break;
    const bool hn = g_next(i + 1, gridDim.x, blockIdx.x, nM, nN, un);
    const int tid = opaque_tid(), wid = tid >> 6, lane = tid & 63, wr = wid >> 2, wc = wid & 3, fr = lane & 15, fq = lane >> 4;
    f32x4 acc[8][4];
    g_zero(acc);
    g_kloop(P.h + (size_t)(u.pm * 256) * DM, P.WoT + (size_t)layer * DM * DM + (size_t)(u.pn * 256) * DM, DM, smem, acc, tid, i > 0,
            P.h + (size_t)(un.pm * 256) * DM, P.WoT + (size_t)layer * DM * DM + (size_t)(un.pn * 256) * DM, hn);
    const size_t off = (size_t)(u.pm * 256 + wr * 128 + fr) * DM + u.pn * 256 + wc * 64 + fq * 4;
#pragma unroll
    for (int m = 0; m < 8; m++) {
#pragma unroll
      for (int n = 0; n < 4; n++) {
        const float4 xo = *(const float4*)(xs + off + (size_t)(m * 16) * DM + n * 16);
        *(float4*)(xd + off + (size_t)(m * 16) * DM + n * 16) =
            make_float4(xo.x + acc[m][n][0], xo.y + acc[m][n][1], xo.z + acc[m][n][2], xo.w + acc[m][n][3]);
      }
      __builtin_amdgcn_sched_barrier(0);
    }
  }
}

__device__ __forceinline__ void compress_item(const Params& P, const int layer, const int it, char* smem_all, const int tid_all) {
  const int half = tid_all >> 8, tid = tid_all & 255;
  char* smem = smem_all + half * 65536;
  const int lane = tid & 63, r = lane & 31, h = lane >> 5, w = tid >> 6;
  const int wm = w >> 1, wn = w & 1;
  const int unit = it * 2 + half;
  const int bl = unit >> 2, g = (unit >> 1) & 1, kv = unit & 1;
  f32x16 acc[2][2];
  zero_acc(acc);
  ACmp af{P.proj + (size_t)bl * TSEQ * INC + C_KV + kv * 128 + g * 64};
  gemm_mainloop(af, P.W1T + (size_t)(layer * 2 + kv) * 128 * 2048, 2048, 2048, smem, acc, tid);
  const float* bp = P.bias1p + (size_t)((layer * 2 + kv) * 8) * 128;
#pragma unroll
  for (int ni = 0; ni < 2; ni++) {
    int hc = wn * 64 + ni * 32 + r;
    float b1 = 0.f;
#pragma unroll
    for (int q = 0; q < 8; q++) b1 += bp[q * 128 + hc];
#pragma unroll
    for (int mi = 0; mi < 2; mi++)
#pragma unroll
      for (int i = 0; i < 16; i++) {
        int n = wm * 64 + mi * 32 + 8 * (i >> 2) + 4 * h + (i & 3);
        float v = siluf_(acc[mi][ni][i] + b1);
        *(u16*)(smem + n * 256 + (((hc >> 3) ^ (n & 15)) << 4) + (hc & 7) * 2) = f2bf(v);
      }
  }
  __syncthreads();
  const u16* w2t = P.W2T + (size_t)(layer * 2 + kv) * 64 * 128;
  f32x16 o2[2];
#pragma unroll
  for (int dt = 0; dt < 2; dt++)
#pragma unroll
    for (int i = 0; i < 16; i++) o2[dt][i] = 0.f;
#pragma unroll
  for (int kk = 0; kk < 8; kk++) {
    int n = w * 32 + r;
    bf16x8 a = ldfrag(smem + n * 256 + (((kk * 2 + h) ^ (n & 15)) << 4));
#pragma unroll
    for (int dt = 0; dt < 2; dt++) {
      bf16x8 b = ldfrag(w2t + (size_t)(dt * 32 + r) * 128 + kk * 16 + h * 8);
      o2[dt] = mfma32(a, b, o2[dt]);
    }
  }
#pragma unroll
  for (int dt = 0; dt < 2; dt++) {
    int d = dt * 32 + r;
    if (kv == 0) {
#pragma unroll
      for (int i = 0; i < 16; i++) {
        int n = w * 32 + 8 * (i >> 2) + 4 * h + (i & 3);
        P.kcmp[((size_t)(bl * 2 + g) * 128 + n) * 64 + d] = f2bf(o2[dt][i]);
      }
    } else {
#pragma unroll
      for (int gq = 0; gq < 4; gq++) {
        int n0 = w * 32 + 8 * gq + 4 * h;
        uint2 o;
        o.x = pk2(o2[dt][gq * 4 + 0], o2[dt][gq * 4 + 1]);
        o.y = pk2(o2[dt][gq * 4 + 2], o2[dt][gq * 4 + 3]);
        *(uint2*)(P.vcmpt + ((size_t)(bl * 2 + g) * 64 + d) * 128 + n0) = o;
      }
    }
  }
  __syncthreads();
}

__device__ void pb_phase(const Params& P, int layer, char* smem_all) {
  const int tid = opaque_tid();
  const int lane = tid & 63, w = tid >> 6;
  float* wsum = (float*)smem_all;
  const int nScan = P.NB * 16;
  for (int it = blockIdx.x; it < nScan; it += gridDim.x) {
    const int bl = it >> 4, hh = it & 15;
    const float bf = P.b_forget[layer * 16 + hh];
    const float* fl = P.flog + ((size_t)bl * TSEQ + tid * 4) * 16 + hh;
    float ls[4];
#pragma unroll
    for (int j = 0; j < 4; j++) {
      const float x = fl[j * 16] + bf;
      ls[j] = (x >= 0.f) ? -log1pf(__expf(-x)) : (x - log1pf(__expf(x)));
    }
    const float loc = (ls[0] + ls[1]) + (ls[2] + ls[3]);
    float incl = loc;
#pragma unroll
    for (int o = 1; o < 64; o <<= 1) {
      const float v = __shfl_up(incl, o);
      if (lane >= o) incl += v;
    }
    __syncthreads();
    if (lane == 63) wsum[w] = incl;
    __syncthreads();
    float base = 0.f;
#pragma unroll
    for (int q = 0; q < 8; q++) base += (q < w) ? wsum[q] : 0.f;
    float run = base + incl - loc;
    float4 o4;
    run += ls[0]; o4.x = -8.0f * run;
    run += ls[1]; o4.y = -8.0f * run;
    run += ls[2]; o4.z = -8.0f * run;
    run += ls[3]; o4.w = -8.0f * run;
    *(float4*)(P.F2 + ((size_t)bl * 16 + hh) * TSEQ + tid * 4) = o4;
  }
}

__device__ void pc1_phase(const Params& P, char* smem) {
  const int tid = opaque_tid(),  lane = tid & 63, r = lane & 31, h = lane >> 5, w = tid >> 6;
  const int nItems = P.NB * 2 * 8;
  const float c1 = 0.125f * LOG2E;
  for (int it = blockIdx.x; it < nItems; it += gridDim.x) {
    const int qt = it & 7, g = (it >> 3) & 1, bl = it >> 4;
    __syncthreads();
#pragma unroll
    for (int j = 0; j < 2; j++) {
      int c = tid + 512 * j;
      {
        int n = c >> 3, ch = c & 7;
        uint4 v = *(const uint4*)(P.kcmp + ((size_t)(bl * 2 + g) * 128 + n) * 64 + ch * 8);
        *(uint4*)(smem + n * 128 + ((ch ^ ((n >> 1) & 7)) << 4)) = v;
      }
      {
        int d = c >> 4, ch = c & 15;
        uint4 v = *(const uint4*)(P.vcmpt + ((size_t)(bl * 2 + g) * 64 + d) * 128 + ch * 8);
        int sw = d & 31;
        *(uint2*)(smem + 16384 + d * 256 + (((2 * ch) ^ sw) << 3)) = make_uint2(v.x, v.y);
        *(uint2*)(smem + 16384 + d * 256 + (((2 * ch + 1) ^ sw) << 3)) = make_uint2(v.z, v.w);
      }
    }
    __syncthreads();
    const int qw_lo = qt * 256 + w * 32;
    const int qtok = qw_lo + r;
    const size_t rowg = (size_t)bl * TSEQ + qtok;
    const int tq = qtok - 31 - 64 * h;
    float sumacc[16], lastacc[16];
#pragma unroll
    for (int s = 0; s < 16; s++) { sumacc[s] = 0.f; lastacc[s] = 0.f; }
#pragma unroll 1
    for (int hh = 0; hh < 8; hh++) {
      const int head = g * 8 + hh;
      bf16x8 qf[4];
#pragma unroll
      for (int kk = 0; kk < 4; kk++) qf[kk] = ldfrag(P.proj + rowg * INC + C_QA + head * 64 + kk * 16 + h * 8);
      f32x16 s[4];
#pragma unroll
      for (int nt = 0; nt < 4; nt++) {
#pragma unroll
        for (int i = 0; i < 16; i++) s[nt][i] = 0.f;
#pragma unroll
        for (int kk = 0; kk < 4; kk++) {
          int row = nt * 32 + r;
          bf16x8 a = ldfrag(smem + row * 128 + (((kk * 2 + h) ^ ((row >> 1) & 7)) << 4));
          s[nt] = mfma32(a, qf[kk], s[nt]);
        }
        __builtin_amdgcn_sched_barrier(0);
      }
      float mx = -3.0e38f;
#pragma unroll
      for (int nt = 0; nt < 4; nt++)
#pragma unroll
        for (int i = 0; i < 16; i++) {
          bool ok = (16 * (nt * 32 + 8 * (i >> 2) + (i & 3))) <= tq;
          float v = ok ? s[nt][i] * c1 : -3.0e38f;
          s[nt][i] = v;
          mx = fmaxf(mx, v);
        }
      mx = fmaxf(mx, __shfl_xor(mx, 32));
      const bool anyv = mx > -1.0e37f;
      float mref = anyv ? mx : 0.f;
      float l = 0.f;
#pragma unroll
      for (int nt = 0; nt < 4; nt++)
#pragma unroll
        for (int i = 0; i < 16; i++) {
          float p = __builtin_amdgcn_exp2f(s[nt][i] - mref);
          s[nt][i] = p;
          l += p;
        }
      l += __shfl_xor(l, 32);
      const float inv = (anyv && l > 0.f) ? 1.f / l : 0.f;
#pragma unroll
      for (int nt = 0; nt < 4; nt++)
#pragma unroll
        for (int i = 0; i < 16; i++) s[nt][i] *= inv;
#pragma unroll
      for (int nt = 0; nt < 4; nt++)
#pragma unroll
        for (int gq = 0; gq < 4; gq++) {
          sumacc[nt * 4 + gq] += (s[nt][gq * 4] + s[nt][gq * 4 + 1]) + (s[nt][gq * 4 + 2] + s[nt][gq * 4 + 3]);
          lastacc[nt * 4 + gq] += s[nt][gq * 4 + 3];
        }
      uint4 pbv[8];
#pragma unroll
      for (int ks = 0; ks < 8; ks++) {
        const int nt = ks >> 1, hb = (ks & 1) * 8;
        pbv[ks].x = pk2(s[nt][hb + 0], s[nt][hb + 1]); pbv[ks].y = pk2(s[nt][hb + 2], s[nt][hb + 3]);
        pbv[ks].z = pk2(s[nt][hb + 4], s[nt][hb + 5]); pbv[ks].w = pk2(s[nt][hb + 6], s[nt][hb + 7]);
      }
      const float g0 = sigmoidf_(bf2f(P.proj[rowg * INC + C_GA + head]));
#pragma unroll
      for (int dt = 0; dt < 2; dt++) {
        f32x16 o;
#pragma unroll
        for (int i = 0; i < 16; i++) o[i] = 0.f;
        const int d = dt * 32 + r, sw = d & 31;
#pragma unroll
        for (int ks = 0; ks < 8; ks++) {
          uint2 lo = *(const uint2*)(smem + 16384 + d * 256 + (((ks * 4 + h) ^ sw) << 3));
          uint2 hi = *(const uint2*)(smem + 16384 + d * 256 + (((ks * 4 + 2 + h) ^ sw) << 3));
          uint4 au = make_uint4(lo.x, lo.y, hi.x, hi.y);
          o = mfma32(__builtin_bit_cast(bf16x8, au), __builtin_bit_cast(bf16x8, pbv[ks]), o);
        }
#pragma unroll
        for (int gq = 0; gq < 4; gq++) {
          int d0 = dt * 32 + 8 * gq + 4 * h;
          uint2 ov;
          ov.x = pk2(o[gq * 4 + 0] * g0, o[gq * 4 + 1] * g0);
          ov.y = pk2(o[gq * 4 + 2] * g0, o[gq * 4 + 3] * g0);
          *(uint2*)(P.ya + rowg * DM + head * 64 + d0) = ov;
        }
        __builtin_amdgcn_sched_barrier(0);
      }
    }
    float sc[16];
#pragma unroll
    for (int s = 0; s < 16; s++) {
      float prev = (s == 0) ? 0.f : lastacc[s - 1];
      float sendv = h ? prev : lastacc[s];
      float recv = __shfl_xor(sendv, 32);
      float imp = sumacc[s] + recv;
      int j = (s >> 2) * 8 + (s & 3) * 2 + h;
      int cur = qtok >> 6;
      bool forced = (j == 0) || (j == cur) || (j == cur - 1);
      bool valid = j <= cur;
      sc[s] = forced ? 1.0e4f : (valid ? imp : -1.0f);
    }
    unsigned mask = 0u;
#pragma unroll 1
    for (int rd = 0; rd < 8; rd++) {
      float best = -2.0f; int bj = 0;
#pragma unroll
      for (int s = 0; s < 16; s++) {
        int j = (s >> 2) * 8 + (s & 3) * 2 + h;
        if (sc[s] > best) { best = sc[s]; bj = j; }
      }
      float ob = __shfl_xor(best, 32);
      int oj = __shfl_xor(bj, 32);
      bool mine = (best > ob) || (best == ob && bj < oj);
      int wj = mine ? bj : oj;
      mask |= 1u << wj;
#pragma unroll
      for (int s = 0; s < 16; s++) {
        int j = (s >> 2) * 8 + (s & 3) * 2 + h;
        if (j == wj) sc[s] = -3.0f;
      }
    }
    if (h == 0) P.sel[(size_t)(bl * 2 + g) * TSEQ + qtok] = mask;
  }
}

#define A_SLOTB 8192
#define A_LDS_K 0
#define A_LDS_V 24576
#define A_LDS_WS 49152
#define A_LDS_F 51200
#define A_LDS_OST 52224
#define A_THR 8.0f
#define A_C2 (0.125f * LOG2E)
typedef __attribute__((ext_vector_type(4))) short a_s16x4;
typedef __attribute__((ext_vector_type(8))) short a_s16x8;
typedef __attribute__((ext_vector_type(4))) unsigned a_u32x4;
typedef __attribute__((address_space(3))) const char* a_lds_cptr;
typedef short a_v4i16 __attribute__((ext_vector_type(4)));
#define A_SBAR() __builtin_amdgcn_sched_barrier(0)
#define A_PIN(x) asm volatile("" : "+v"(x))
#define A_MFMA(a, b, c) __builtin_amdgcn_mfma_f32_32x32x16_bf16(a, b, c, 0, 0, 0)
template <int N> __device__ __forceinline__ void a_wait_bar() { asm volatile("s_waitcnt vmcnt(%0) lgkmcnt(0)\n\ts_barrier" ::"n"(N) : "memory"); }
__device__ __forceinline__ int a_crow(int r, int hi) { return (r & 3) + 8 * (r >> 2) + 4 * hi; }
__device__ __forceinline__ unsigned a_cvtpk(float lo, float hi) { unsigned r; asm("v_cvt_pk_bf16_f32 %0, %1, %2" : "=v"(r) : "v"(lo), "v"(hi)); return r; }
__device__ __forceinline__ void a_glds16(const void* g, unsigned lds_base) {
  unsigned sv; asm volatile("s_mov_b32 %0, m0\n\ts_mov_b32 m0, %2\n\ts_nop 0\n\tglobal_load_lds_dwordx4 %1, off\n\ts_mov_b32 m0, %0" : "=&s"(sv) : "v"(g), "s"(lds_base) : "memory"); }
__device__ __forceinline__ void a_glds4(const void* g, unsigned lds_base) {
  unsigned sv; asm volatile("s_mov_b32 %0, m0\n\ts_mov_b32 m0, %2\n\ts_nop 0\n\tglobal_load_lds_dword %1, off\n\ts_mov_b32 m0, %0" : "=&s"(sv) : "v"(g), "s"(lds_base) : "memory"); }
__device__ __forceinline__ void a_kload2(bf16x8* kf, a_lds_cptr kp, int d0) {
  kf[2 * d0] = *(const __attribute__((address_space(3))) bf16x8*)(kp + d0 * 2048);
  kf[2 * d0 + 1] = *(const __attribute__((address_space(3))) bf16x8*)(kp + d0 * 2048 + 512); }
__device__ __forceinline__ a_s16x4 a_vtr(a_lds_cptr p) { return __builtin_bit_cast(a_s16x4, __builtin_amdgcn_ds_read_tr16_b64_v4i16((__attribute__((address_space(3))) a_v4i16*)p)); }
#define A_MX3(a, b, c) __builtin_fmaxf(__builtin_fmaxf((a), (b)), (c))
__device__ __forceinline__ float a_rowmax(const f32x16& p0, const f32x16& p1) {
  float a = A_MX3(p0[0], p0[1], p1[0]), b = A_MX3(p0[2], p0[3], p1[1]); a = A_MX3(a, p1[2], p1[3]);
#pragma unroll
  for (int r = 4; r < 16; r += 4) { a = A_MX3(a, p0[r], p0[r + 1]); b = A_MX3(b, p0[r + 2], p0[r + 3]); a = A_MX3(a, p1[r], p1[r + 1]); b = A_MX3(b, p1[r + 2], p1[r + 3]); }
  float m = __builtin_fmaxf(a, b); auto rr = __builtin_amdgcn_permlane32_swap(__float_as_uint(m), __float_as_uint(m), false, false);
  return __builtin_fmaxf(__uint_as_float(rr[0]), __uint_as_float(rr[1])); }
template <int MODE>
__device__ __forceinline__ void a_mask(f32x16& p0, f32x16& p1, int key0, int qabs, int hi) {
  const int kb = key0 + 4 * hi;
#pragma unroll
  for (int r = 0; r < 16; ++r) {
    const int kv = kb + (r & 3) + 8 * (r >> 2);
    bool bad0 = kv > qabs, bad1 = (kv + 32) > qabs;
    if (MODE == 2) { bad0 = bad0 || (kv + 512 <= qabs); bad1 = bad1 || (kv + 32 + 512 <= qabs); }
    if (bad0) p0[r] = -INFINITY;
    if (bad1) p1[r] = -INFINITY;
  } }
__device__ __forceinline__ void a_bias(f32x16& p0, f32x16& p1, const char* fb, int hi) {
#pragma unroll
  for (int g = 0; g < 4; ++g) {
    const float4 b0 = *(const float4*)(fb + (8 * g + 4 * hi) * 4);
    const float4 b1 = *(const float4*)(fb + (32 + 8 * g + 4 * hi) * 4);
    p0[4 * g + 0] += b0.x; p0[4 * g + 1] += b0.y; p0[4 * g + 2] += b0.z; p0[4 * g + 3] += b0.w;
    p1[4 * g + 0] += b1.x; p1[4 * g + 1] += b1.y; p1[4 * g + 2] += b1.z; p1[4 * g + 3] += b1.w;
  } }

template <int MODE>
__device__ __forceinline__ void a_unit(const u16* __restrict__ Qw, const int qp, const u16* __restrict__ Kp, const u16* __restrict__ Vp,
                                       const float* __restrict__ Fp, const int NT, const int key00, const int qabs, const unsigned selm,
                                       const float gate, char* lds, u16* stg, const int tid) {
  constexpr int NK = (MODE == 0) ? 2 : 1;
  const int lane = tid & 63, r32 = lane & 31, hi = lane >> 5; const int wid = __builtin_amdgcn_readfirstlane(tid >> 6);
  const unsigned lds0 = (unsigned)(uintptr_t)lds; float* wsf = (float*)(lds + A_LDS_WS) + wid * 64;
  const u16* ksrc = Kp + (long)lane * INC + wid * 8;
  const u16* vsrc = Vp + (long)(16 * (wid & 3) + (lane >> 2)) * INC + (wid >> 2) * 32 + (lane & 3) * 8;
  const float* fsrc = Fp + lane;
  const unsigned kdst = lds0 + A_LDS_K + wid * 1024, vdst = lds0 + A_LDS_V + wid * 1024, fdst = lds0 + A_LDS_F;
#define A_DMA_K(t, slot) do { a_glds16(ksrc + (long)(t) * 64 * INC, (unsigned)__builtin_amdgcn_readfirstlane(kdst + (slot))); \
    if (MODE == 0) a_glds4(fsrc + (t) * 64, (unsigned)__builtin_amdgcn_readfirstlane(fdst + ((t) & 3) * 256)); } while (0)
#define A_DMA_V(t, slot) a_glds16(vsrc + (long)(t) * 64 * INC, (unsigned)__builtin_amdgcn_readfirstlane(vdst + (slot)))
  const a_lds_cptr vp0 = (a_lds_cptr)lds + A_LDS_V + ((lane >> 4) & 1) * 32 + (lane & 3) * 8 + (4 * hi + ((lane & 15) >> 2)) * 64;
  const a_lds_cptr kp0 = (a_lds_cptr)lds + A_LDS_K + hi * 1024 + r32 * 16;
  const char* fb0 = lds + A_LDS_F;
  A_DMA_K(0, 0); A_DMA_V(0, 0); A_DMA_K(1, A_SLOTB);
  bf16x8 qr[4];
#pragma unroll
  for (int d0 = 0; d0 < 4; ++d0) qr[d0] = ldfrag(Qw + (long)r32 * qp + d0 * 16 + hi * 8);
  float mhat = 0.f, l_reg = 0.f; f32x16 o[2];
#pragma unroll
  for (int r = 0; r < 16; ++r) { o[0][r] = 0.f; o[1][r] = 0.f; }
  const f32x16 zero16 = {0.f, 0.f, 0.f, 0.f, 0.f, 0.f, 0.f, 0.f, 0.f, 0.f, 0.f, 0.f, 0.f, 0.f, 0.f, 0.f};
  bool resc = false;
  f32x16 pA0, pA1, pB0, pB1; bf16x8 kf[8]; a_s16x4 vlo[8], vhi[8]; a_u32x4 pw0, pw1, pw2, pw3;
  int sl_prev = 0, sl_cur = 0, sl_next = A_SLOTB;
#define A_ROT() do { sl_prev = sl_cur; sl_cur = sl_next; sl_next = (sl_next == 2 * A_SLOTB) ? 0 : sl_next + A_SLOTB; } while (0)
#define A_EX(v) __builtin_amdgcn_exp2f(__builtin_fmaf((v), A_C2, nmh))
#define A_RESC() do { if (resc) { _Pragma("unroll") for (int d_ = 0; d_ < 2; ++d_) _Pragma("unroll") for (int r = 0; r < 16; ++r) o[d_][r] *= wsf[a_crow(r, hi)]; } } while (0)
  A_DMA_K(2, 2 * A_SLOTB);
  a_wait_bar<1 + 2 * NK>();
  _Pragma("unroll") for (int d0 = 0; d0 < 4; ++d0) a_kload2(kf, kp0, d0);
  pA0 = A_MFMA(kf[0], qr[0], zero16); pA1 = A_MFMA(kf[1], qr[0], zero16); pA0 = A_MFMA(kf[2], qr[1], pA0); pA1 = A_MFMA(kf[3], qr[1], pA1);
  pA0 = A_MFMA(kf[4], qr[2], pA0); pA1 = A_MFMA(kf[5], qr[2], pA1); pA0 = A_MFMA(kf[6], qr[3], pA0); pA1 = A_MFMA(kf[7], qr[3], pA1);
  if (MODE == 0) a_bias(pA0, pA1, fb0, hi);
  if (MODE == 2 || NT == 4) a_mask<MODE>(pA0, pA1, key00, qabs, hi);
  { const float rm = a_rowmax(pA0, pA1); mhat = __builtin_fmaxf(rm * A_C2, -1.0e30f); const float nmh = -mhat;
#pragma unroll
    for (int r = 0; r < 16; ++r) { pA0[r] = A_EX(pA0[r]); pA1[r] = A_EX(pA1[r]); } }
  a_wait_bar<0>();
  A_DMA_K(3, 0); A_DMA_V(1, A_SLOTB); A_ROT();
  _Pragma("unroll") for (int d0 = 0; d0 < 4; ++d0) a_kload2(kf, kp0 + sl_cur, d0);
  a_wait_bar<NK + 1>();
#define A_PKW(P, i) a_cvtpk(P[i], P[i + 1])
#define A_PAF(k) __builtin_bit_cast(bf16x8, pw##k)
#define A_VFR(i) __builtin_bit_cast(bf16x8, __builtin_shufflevector(vlo[i], vhi[i], 0, 1, 2, 3, 4, 5, 6, 7))
#define A_VRD(i) do { vlo[i] = a_vtr(vp_ + (((i) >> 2) * 4096 + ((i) & 3) * 1024)); vhi[i] = a_vtr(vp_ + (((i) >> 2) * 4096 + ((i) & 3) * 1024 + 512)); } while (0)
#define A_KRD(G, d0) do { if (G) { a_kload2(kf, kp0 + sl_next, d0); A_SBAR(); } } while (0)
#define A_GAPA(MF, a0, a1, a2, a3, W0, W1, PW) do { MF; sacc += a0; sacc += a1; sacc += a2; sacc += a3; W0; W1; A_PIN(PW); A_PIN(sacc); A_SBAR(); } while (0)
#define A_GAPB(MF, X, i) do { MF; X[i] = A_EX(X[i]); X[i + 1] = A_EX(X[i + 1]); X[i + 2] = A_EX(X[i + 2]); X[i + 3] = A_EX(X[i + 3]); A_PIN(X); A_SBAR(); } while (0)
#define A_STEP(C0, C1, P0, P1, t, MASK, GK, GV, GL) do { A_SBAR(); \
    const a_lds_cptr vp_ = vp0 + sl_prev; \
    A_VRD(0); A_SBAR(); float sacc = P0[0] + P0[1]; \
                      A_GAPA(C0 = A_MFMA(kf[0], qr[0], zero16), P0[2], P0[3], P0[4], P0[5],     pw0[0] = A_PKW(P0, 0),  pw0[1] = A_PKW(P0, 2),  pw0); \
    A_VRD(4); A_SBAR(); A_GAPA(C1 = A_MFMA(kf[1], qr[0], zero16), P0[6], P0[7], P0[8], P0[9],     pw0[2] = A_PKW(P0, 4),  pw0[3] = A_PKW(P0, 6),  pw0); \
    A_VRD(1); A_SBAR(); A_GAPA(C0 = A_MFMA(kf[2], qr[1], C0),    P0[10], P0[11], P0[12], P0[13], pw1[0] = A_PKW(P0, 8),  pw1[1] = A_PKW(P0, 10), pw1); \
    A_VRD(5); A_SBAR(); A_GAPA(C1 = A_MFMA(kf[3], qr[1], C1),    P0[14], P0[15], P1[0], P1[1],   pw1[2] = A_PKW(P0, 12), pw1[3] = A_PKW(P0, 14), pw1); \
    A_VRD(2); A_SBAR(); A_GAPA(C0 = A_MFMA(kf[4], qr[2], C0),    P1[2], P1[3], P1[4], P1[5],     pw2[0] = A_PKW(P1, 0),  pw2[1] = A_PKW(P1, 2),  pw2); \
    A_VRD(6); A_SBAR(); A_GAPA(C1 = A_MFMA(kf[5], qr[2], C1),    P1[6], P1[7], P1[8], P1[9],     pw2[2] = A_PKW(P1, 4),  pw2[3] = A_PKW(P1, 6),  pw2); \
    A_VRD(3); A_SBAR(); A_GAPA(C0 = A_MFMA(kf[6], qr[3], C0),    P1[10], P1[11], P1[12], P1[13], pw3[0] = A_PKW(P1, 8),  pw3[1] = A_PKW(P1, 10), pw3); \
    A_VRD(7); A_SBAR(); A_GAPA(C1 = A_MFMA(kf[7], qr[3], C1),    P1[14], P1[15], 0.f, 0.f,       pw3[2] = A_PKW(P1, 12), pw3[3] = A_PKW(P1, 14), pw3); \
    l_reg += sacc; \
    if (GK) A_DMA_K((t) + 3, sl_cur); if (GV) A_DMA_V((t) + 1, sl_next); \
    if (MODE == 0) a_bias(C0, C1, fb0 + ((t) & 3) * 256, hi); \
    if (MASK) a_mask<MODE>(C0, C1, key00 + (t) * 64, qabs, hi); \
    const bool selb_ = (MODE != 1) || (((selm >> ((t) & 31)) & 1u) != 0u); \
    { float rmx = a_rowmax(C0, C1) * A_C2; if (!selb_) rmx = -INFINITY; resc = false; \
      if (__builtin_expect(__any((rmx - mhat) > A_THR), 0)) { const float mnew = __builtin_fmaxf(mhat, rmx); \
          const float f = __builtin_amdgcn_exp2f(mhat - mnew); mhat = mnew; l_reg *= f; if (hi == 0) wsf[r32] = f; resc = true; } } \
    const float nmh = selb_ ? -mhat : -INFINITY; A_SBAR(); \
    A_GAPB(o[0] = A_MFMA(A_PAF(0), A_VFR(0), o[0]), C0, 0);              A_GAPB(o[1] = A_MFMA(A_PAF(0), A_VFR(4), o[1]), C0, 4); \
    A_KRD(GL, 0); A_GAPB(o[0] = A_MFMA(A_PAF(1), A_VFR(1), o[0]), C0, 8);  A_KRD(GL, 1); A_GAPB(o[1] = A_MFMA(A_PAF(1), A_VFR(5), o[1]), C0, 12); \
    A_KRD(GL, 2); A_GAPB(o[0] = A_MFMA(A_PAF(2), A_VFR(2), o[0]), C1, 0);  A_KRD(GL, 3); A_GAPB(o[1] = A_MFMA(A_PAF(2), A_VFR(6), o[1]), C1, 4); \
    A_GAPB(o[0] = A_MFMA(A_PAF(3), A_VFR(3), o[0]), C1, 8);              A_GAPB(o[1] = A_MFMA(A_PAF(3), A_VFR(7), o[1]), C1, 12); \
    } while (0)
  int t = 1;
  if (MODE != 2) {
    for (; t + 5 < NT; t += 2) {
      A_STEP(pB0, pB1, pA0, pA1, t, false, true, true, true);     a_wait_bar<NK + 1>(); A_RESC(); A_ROT();
      A_STEP(pA0, pA1, pB0, pB1, t + 1, false, true, true, true); a_wait_bar<NK + 1>(); A_RESC(); A_ROT();
    }
  }
#define A_ENDW(tt) do { if ((tt) + 3 < NT) { a_wait_bar<NK + 1>(); } else if ((tt) + 2 < NT) { a_wait_bar<1>(); } else { a_wait_bar<0>(); } } while (0)
  for (; t + 1 < NT; t += 2) {
    A_STEP(pB0, pB1, pA0, pA1, t, (MODE != 2 || t < 4 || t + 4 >= NT), (t + 3 < NT), (t + 1 < NT), (t + 1 < NT));             A_ENDW(t);     A_RESC(); A_ROT();
    A_STEP(pA0, pA1, pB0, pB1, t + 1, (MODE != 2 || t + 1 < 4 || t + 5 >= NT), (t + 4 < NT), (t + 2 < NT), (t + 2 < NT));     A_ENDW(t + 1); A_RESC(); A_ROT();
  }
  A_STEP(pB0, pB1, pA0, pA1, NT - 1, true, false, false, false); A_RESC();
  { float sacc = pB0[0] + pB0[1];
#pragma unroll
    for (int r = 2; r < 16; ++r) sacc += pB0[r];
#pragma unroll
    for (int r = 0; r < 16; ++r) sacc += pB1[r];
    l_reg += sacc;
    pw0 = (a_u32x4){A_PKW(pB0, 0), A_PKW(pB0, 2), A_PKW(pB0, 4), A_PKW(pB0, 6)}; pw1 = (a_u32x4){A_PKW(pB0, 8), A_PKW(pB0, 10), A_PKW(pB0, 12), A_PKW(pB0, 14)};
    pw2 = (a_u32x4){A_PKW(pB1, 0), A_PKW(pB1, 2), A_PKW(pB1, 4), A_PKW(pB1, 6)}; pw3 = (a_u32x4){A_PKW(pB1, 8), A_PKW(pB1, 10), A_PKW(pB1, 12), A_PKW(pB1, 14)};
    const a_lds_cptr vp_ = vp0 + sl_cur; _Pragma("unroll") for (int i = 0; i < 8; ++i) A_VRD(i);
    o[0] = A_MFMA(A_PAF(0), A_VFR(0), o[0]); o[1] = A_MFMA(A_PAF(0), A_VFR(4), o[1]); o[0] = A_MFMA(A_PAF(1), A_VFR(1), o[0]); o[1] = A_MFMA(A_PAF(1), A_VFR(5), o[1]);
    o[0] = A_MFMA(A_PAF(2), A_VFR(2), o[0]); o[1] = A_MFMA(A_PAF(2), A_VFR(6), o[1]); o[0] = A_MFMA(A_PAF(3), A_VFR(3), o[0]); o[1] = A_MFMA(A_PAF(3), A_VFR(7), o[1]); }
  { auto rr = __builtin_amdgcn_permlane32_swap(__float_as_uint(l_reg), __float_as_uint(l_reg), false, false); l_reg = __uint_as_float(rr[0]) + __uint_as_float(rr[1]); }
  if (hi == 0) wsf[32 + r32] = gate / l_reg;
  asm volatile("s_waitcnt lgkmcnt(0)" ::: "memory");
  float rli[16];
#pragma unroll
  for (int r = 0; r < 16; ++r) rli[r] = wsf[32 + a_crow(r, hi)];
#pragma unroll
  for (int r = 0; r < 16; ++r) { const int orow = a_crow(r, hi);
#pragma unroll
    for (int d0 = 0; d0 < 2; ++d0) stg[orow * 64 + d0 * 32 + r32] = f2bf(o[d0][r] * rli[r]); }
  asm volatile("s_waitcnt lgkmcnt(0)\n\ts_barrier" ::: "memory");
#undef A_DMA_K
#undef A_DMA_V
#undef A_ROT
#undef A_EX
#undef A_RESC
#undef A_PKW
#undef A_PAF
#undef A_VFR
#undef A_VRD
#undef A_KRD
#undef A_ENDW
#undef A_GAPA
#undef A_GAPB
#undef A_STEP
}

__device__ void pc2_phase(const Params& P, int layer, int chunk, char* smem, int* s_item, const int which) {
  volatile __attribute__((address_space(3))) unsigned* xst = (volatile __attribute__((address_space(3))) unsigned*)(smem + XB_LDS_OFF);
  const int nx = (int)xst[1], xc = (int)xst[3];
  const int nBH = P.NB * 16;
  const int nStr = which ? (P.NB * 2) : nBH;
  const int nLoc = (nStr - xc + nx - 1) / nx;
  const int nCmpAll = which ? 0 : P.NB * 2;
  const int nCmp = which ? 0 : (nCmpAll - xc + nx - 1) / nx;
  const int nItems = nCmp + (which ? nLoc * 64 : ((nLoc + 3) >> 2) * 32);
  unsigned* ctr = P.ctr + ((chunk * 4 + layer) * 2 + which) * 8 + xc;
  while (true) {
    const int tid = opaque_tid(), lane = tid & 63, r32 = lane & 31, w = tid >> 6;
    __syncthreads();
    if (tid == 0) *s_item = (int)atomicAdd(ctr, 1u);
    __syncthreads();
    const int it0 = *s_item;
    if (it0 >= nItems) break;
    if (it0 < nCmp) { compress_item(P, layer, xc + nx * it0, smem, tid); continue; }
    const int it = it0 - nCmp;
    int qt, bh;
    if (which) {
      const int sl = it >> 6, rem = it & 63;
      qt = 7 - (rem >> 3);
      bh = (xc + nx * sl) * 8 + (rem & 7);
    } else {
      const int grp = it >> 5, rem = it & 31;
      const int sl = grp * 4 + (rem & 3);
      qt = 7 - (rem >> 2);
      if (sl >= nLoc) continue;
      bh = xc + nx * sl;
    }
    const int type = which;
    const int bl = bh >> 4, head = bh & 15;
    const int q0w = qt * 256 + w * 32;
    const int qabs = q0w + r32;
    const size_t rowq = (size_t)bl * TSEQ + qabs;
    const size_t roww = (size_t)bl * TSEQ + q0w;
    const u16* pb_ = P.proj + (size_t)bl * TSEQ * INC;
    u16* stg = (u16*)(smem + A_LDS_OST) + w * 4096;
    const int er = lane >> 3, ec = (lane & 7) * 8;
    if (type == 0) {
      a_unit<0>(pb_ + roww * 0 + (size_t)q0w * INC + C_QB + head * 64, INC, pb_ + C_KB + head * 64, pb_ + C_VB + head * 64,
                P.F2 + (size_t)(bl * 16 + head) * TSEQ, 4 * qt + 4, 0, qabs, 0u, 1.0f, smem, stg, tid);
#pragma unroll
      for (int i = 0; i < 4; i++) {
        const int row = i * 8 + er;
        const uint4 ov = *(const uint4*)(stg + row * 64 + ec);
        const uint4 zz = *(const uint4*)(pb_ + (size_t)(q0w + row) * INC + C_ZB + head * 64 + ec);
        uint4 y;
        y.x = pk2(bflo(ov.x) * siluf_(bflo(zz.x)), bfhi(ov.x) * siluf_(bfhi(zz.x)));
        y.y = pk2(bflo(ov.y) * siluf_(bflo(zz.y)), bfhi(ov.y) * siluf_(bfhi(zz.y)));
        y.z = pk2(bflo(ov.z) * siluf_(bflo(zz.z)), bfhi(ov.z) * siluf_(bfhi(zz.z)));
        y.w = pk2(bflo(ov.w) * siluf_(bflo(zz.w)), bfhi(ov.w) * siluf_(bfhi(zz.w)));
        *(uint4*)(P.yb + (roww + row) * DM + head * 64 + ec) = y;
      }
    } else {
      const int g = head >> 3;
      const unsigned selm = P.sel[(size_t)(bl * 2 + g) * TSEQ + qabs];
      const float g1 = sigmoidf_(bf2f(P.proj[rowq * INC + C_GA + 16 + head]));
      const float g2 = sigmoidf_(bf2f(P.proj[rowq * INC + C_GA + 32 + head]));
      const u16* qw = P.qr + roww * DM + head * 64;
      a_unit<1>(qw, DM, pb_ + C_KV + 256 + g * 64, pb_ + C_KV + 384 + g * 64, nullptr, 4 * qt + 4, 0, qabs, selm, g1, smem, stg, tid);
      const int klo = (4 * qt - 8) > 0 ? (4 * qt - 8) : 0;
      a_unit<2>(qw, DM, pb_ + (size_t)(klo * 64) * INC + C_KV + 512 + g * 64, pb_ + (size_t)(klo * 64) * INC + C_KV + 640 + g * 64, nullptr,
                4 * qt + 4 - klo, klo * 64, qabs, 0u, g2, smem, stg + 2048, tid);
#pragma unroll
      for (int i = 0; i < 4; i++) {
        const int row = i * 8 + er;
        const uint4 o1 = *(const uint4*)(stg + row * 64 + ec);
        const uint4 o2 = *(const uint4*)(stg + 2048 + row * 64 + ec);
        const uint4 zz = *(const uint4*)(pb_ + (size_t)(q0w + row) * INC + C_ZA + head * 64 + ec);
        u16* yp = P.ya + (roww + row) * DM + head * 64 + ec;
        const uint4 oc = *(const uint4*)yp;
        uint4 y;
        y.x = pk2((bflo(o1.x) + bflo(o2.x) + bflo(oc.x)) * siluf_(bflo(zz.x)), (bfhi(o1.x) + bfhi(o2.x) + bfhi(oc.x)) * siluf_(bfhi(zz.x)));
        y.y = pk2((bflo(o1.y) + bflo(o2.y) + bflo(oc.y)) * siluf_(bflo(zz.y)), (bfhi(o1.y) + bfhi(o2.y) + bfhi(oc.y)) * siluf_(bfhi(zz.y)));
        y.z = pk2((bflo(o1.z) + bflo(o2.z) + bflo(oc.z)) * siluf_(bflo(zz.z)), (bfhi(o1.z) + bfhi(o2.z) + bfhi(oc.z)) * siluf_(bfhi(zz.z)));
        y.w = pk2((bflo(o1.w) + bflo(o2.w) + bflo(oc.w)) * siluf_(bflo(zz.w)), (bfhi(o1.w) + bfhi(o2.w) + bfhi(oc.w)) * siluf_(bfhi(zz.w)));
        *(uint4*)yp = y;
      }
    }
  }
}

#define XB_XCNT(j) (64 * (j))
#define XB_XSUB(j) (1024 + 64 * (j))
#define XB_XGEN(j) (2048 + 64 * (j))
#define XB_TOP 3072
#define XB_TOPGEN 3136
__device__ __forceinline__ unsigned xb_ld(unsigned* p) { return __hip_atomic_load(p, __ATOMIC_RELAXED, __HIP_MEMORY_SCOPE_AGENT); }
__device__ __forceinline__ unsigned xb_add(unsigned* p, unsigned v) { return __hip_atomic_fetch_add(p, v, __ATOMIC_RELAXED, __HIP_MEMORY_SCOPE_AGENT); }
__device__ __forceinline__ unsigned xb_xcc_id() { return (unsigned)__builtin_amdgcn_s_getreg((3 << 11) | 20) & 0xFu; }
__device__ __forceinline__ void grid_bar(unsigned* bar, char* smem) {
  asm volatile("s_waitcnt vmcnt(0) lgkmcnt(0)" ::: "memory");
  __syncthreads();
  if (threadIdx.x == 0) {
    volatile unsigned* st = (volatile unsigned*)(smem + XB_LDS_OFF);
    const unsigned nloc = st[0], nx = st[1], x = st[2];
    const unsigned old = xb_add(&bar[XB_XSUB(x)], 1u);
    const unsigned gen = old / nloc;
    if (old + 1u == (gen + 1u) * nloc) {
      __builtin_amdgcn_fence(__ATOMIC_RELEASE, "agent");
      asm volatile("s_waitcnt vmcnt(0)" ::: "memory");
      const unsigned og = xb_add(&bar[XB_TOP], 1u);
      const unsigned tg = og / nx;
      if (og + 1u == (tg + 1u) * nx) xb_add(&bar[XB_TOPGEN], 1u);
      else { while (xb_ld(&bar[XB_TOPGEN]) == tg) __builtin_amdgcn_s_sleep(1); }
      __builtin_amdgcn_fence(__ATOMIC_ACQUIRE, "agent");
      xb_add(&bar[XB_XGEN(x)], 1u);
      asm volatile("s_waitcnt vmcnt(0)" ::: "memory");
    } else {
      while (xb_ld(&bar[XB_XGEN(x)]) == gen) __builtin_amdgcn_s_sleep(1);
      __builtin_amdgcn_fence(__ATOMIC_ACQUIRE, "agent");
      asm volatile("s_waitcnt vmcnt(0)" ::: "memory");
    }
  }
  __syncthreads();
}

__global__ void __launch_bounds__(NTHREADS, 2) mega_kernel(Params P) {
  __shared__ __attribute__((aligned(1024))) char smem[163840];
  cg::grid_group grid = cg::this_grid();
  const int CT = P.NB * TSEQ;
  phase0(P, smem);
  grid.sync();
  if (threadIdx.x == 0) (void)xb_add(&P.xbar[XB_XCNT(xb_xcc_id())], 1u);
  grid.sync();
  if (threadIdx.x == 0) {
    unsigned cnt = 0u, mine = 0u, rank = 0u; const unsigned x = xb_xcc_id();
#pragma unroll 1
    for (unsigned j = 0; j < 16; ++j) { const unsigned c = xb_ld(&P.xbar[XB_XCNT(j)]); cnt += (c > 0u) ? 1u : 0u; mine = (j == x) ? c : mine; rank += (c > 0u && j < x) ? 1u : 0u; }
    volatile unsigned* st = (volatile unsigned*)(smem + XB_LDS_OFF);
    st[0] = mine > 0u ? mine : 1u; st[1] = cnt > 0u ? cnt : 1u; st[2] = x; st[3] = rank;
  }
  __syncthreads();
  for (int chunk = 0; chunk < P.nchunk; chunk++) {
    for (int layer = 0; layer < 4; layer++) {
      const float* xs = (layer == 0 ? P.x_in : P.out) + (size_t)chunk * CT * DM;
      norm_phase(xs, P.norm_g + layer * DM, P.h, CT);
      if (layer == 0 && chunk > 0) final_norm_phase(P.out, P.final_g, (chunk - 1) * CT, CT);
      grid_bar(P.xbar, smem);
      gemm1_phase(P, layer, smem);
      grid_bar(P.xbar, smem);
      pb_phase(P, layer, smem);
      grid_bar(P.xbar, smem);
      pc2_phase(P, layer, chunk, smem, (int*)(smem + 140000), 0);
      grid_bar(P.xbar, smem);
      pc1_phase(P, smem);
      grid_bar(P.xbar, smem);
      pc2_phase(P, layer, chunk, smem, (int*)(smem + 140000), 1);
      grid_bar(P.xbar, smem);
      gemm2_phase(P, layer, smem);
      grid_bar(P.xbar, smem);
      gemm3_phase(P, layer, chunk, smem);
      grid_bar(P.xbar, smem);
    }
  }
  final_norm_phase(P.out, P.final_g, (P.nchunk - 1) * CT, CT);
}

static inline size_t al256(size_t x) { return (x + 255) & ~(size_t)255; }

extern "C" void kernel_launch(void* const* d_in, const int* in_sizes, int n_in, void* d_out, int out_size,
                              void* d_ws, size_t ws_size, hipStream_t stream) {
  (void)in_sizes; (void)n_in; (void)out_size;
  Params P{};
  P.x_in = (const float*)d_in[0]; P.norm_g = (const float*)d_in[1]; P.w_in = (const float*)d_in[2];
  P.b_forget = (const float*)d_in[3];
  P.pe_k = (const float*)d_in[4]; P.w1_k = (const float*)d_in[5]; P.w2_k = (const float*)d_in[6];
  P.pe_v = (const float*)d_in[7]; P.w1_v = (const float*)d_in[8]; P.w2_v = (const float*)d_in[9];
  P.w_pa = (const float*)d_in[10]; P.w_pb = (const float*)d_in[11]; P.w_out = (const float*)d_in[12];
  P.final_g = (const float*)d_in[13];
  P.out = (float*)d_out;
  int NB = 16;
  char* base = (char*)d_ws;
  for (;;) {
    const size_t CT = (size_t)NB * TSEQ;
    size_t off = 0;
    auto take = [&](size_t bytes) { size_t o = off; off = al256(off + bytes); return o; };
    size_t oWin = take((size_t)4 * INCP * DM * 2), oWpa = take((size_t)4 * DM * DM * 2), oWpb = take((size_t)4 * DM * DM * 2),
           oWo = take((size_t)4 * DM * DM * 2), oW1 = take((size_t)8 * 128 * 2048 * 2), oW2 = take((size_t)8 * 64 * 128 * 2),
           oB1 = take((size_t)64 * 128 * 4), oRc = take((size_t)TSEQ * 32 * 4), oRs = take((size_t)TSEQ * 32 * 4),
           oH = take(CT * DM * 2), oProj = take(CT * INC * 2 + 4096), oVbt = take(CT * DM * 2),
           oVst = take(CT * 128 * 2), oVwt = take(CT * 128 * 2), oFl = take(CT * 16 * 4), oF2 = take(CT * 16 * 4),
           oKc = take((size_t)NB * 2 * 128 * 64 * 2), oVc = take((size_t)NB * 2 * 64 * 128 * 2), oSel = take(CT * 2 * 4),
           oYa = take(CT * DM * 2), oYb = take(CT * DM * 2), oCtr = take(1024), oXb = take(XB_WORDS * 4);
    if (off > ws_size && NB > 1) { NB >>= 1; continue; }
    P.WinT = (u16*)(base + oWin); P.WpaT = (u16*)(base + oWpa); P.WpbT = (u16*)(base + oWpb); P.WoT = (u16*)(base + oWo);
    P.W1T = (u16*)(base + oW1); P.W2T = (u16*)(base + oW2); P.bias1p = (float*)(base + oB1);
    P.ropec = (float*)(base + oRc); P.ropes = (float*)(base + oRs);
    P.h = (u16*)(base + oH); P.proj = (u16*)(base + oProj); P.qr = (u16*)(base + oVbt);
    P.vst = (u16*)(base + oVst); P.vwt = (u16*)(base + oVwt); P.flog = (float*)(base + oFl); P.F2 = (float*)(base + oF2);
    P.kcmp = (u16*)(base + oKc); P.vcmpt = (u16*)(base + oVc); P.sel = (unsigned*)(base + oSel);
    P.ya = (u16*)(base + oYa); P.yb = (u16*)(base + oYb); P.ctr = (unsigned*)(base + oCtr); P.xbar = (unsigned*)(base + oXb);
    break;
  }
  P.NB = NB; P.nchunk = 32 / NB;
  static int grid_blocks = 0;
  if (!grid_blocks) {
    int dev = 0, cus = 0, per_cu = 0;
    hipGetDevice(&dev);
    hipDeviceGetAttribute(&cus, hipDeviceAttributeMultiprocessorCount, dev);
    hipOccupancyMaxActiveBlocksPerMultiprocessor(&per_cu, mega_kernel, NTHREADS, 0);
    if (per_cu > 1) per_cu = 1;
    if (per_cu < 1) per_cu = 1;
    grid_blocks = cus * per_cu;
  }
  void* args[] = {&P};
  hipError_t e = hipLaunchCooperativeKernel((void*)mega_kernel, dim3(grid_blocks), dim3(NTHREADS), args, 0, stream);
  if (e != hipSuccess) fprintf(stderr, "cooperative launch failed: %s (grid %d)\n", hipGetErrorString(e), grid_blocks);
}
```

```cpp
#include <hip/hip_runtime.h>
#include <hip/hip_cooperative_groups.h>
#include <cstdio>
namespace cg = cooperative_groups;

typedef __attribute__((ext_vector_type(8))) __bf16 bf16x8;
typedef __attribute__((ext_vector_type(16))) float f32x16;
typedef __attribute__((ext_vector_type(4))) float f32x4;
typedef __attribute__((ext_vector_type(2))) float f32x2;
typedef unsigned short u16;

#define TSEQ 2048
#define DM 1024
#define INC 9024
#define INCP 9216
#define C_QA 0
#define C_KV 1024
#define C_GA 1792
#define C_ZA 1840
#define C_QB 2864
#define C_KB 3888
#define C_VB 4912
#define C_QR 4912
#define C_FB 5936
#define C_ZB 5952
#define C_RA 6976
#define C_RB 8000
#define NTHREADS 512
#define ATT_STAGE 33280
#define LOG2E 1.4426950408889634f
#define XB_WORDS 3200
#define XB_LDS_OFF 150000

struct Params {
  const float* x_in; const float* norm_g; const float* w_in; const float* b_forget;
  const float* pe_k; const float* w1_k; const float* w2_k;
  const float* pe_v; const float* w1_v; const float* w2_v;
  const float* w_pa; const float* w_pb; const float* w_out; const float* final_g;
  float* out;
  u16* WinT; u16* WpaT; u16* WpbT; u16* WoT; u16* W1T; u16* W2T;
  float* bias1p; float* ropec; float* ropes;
  u16* h; u16* proj; u16* qr; u16* vst; u16* vwt;
  float* flog; float* F2; u16* kcmp; u16* vcmpt; unsigned* sel;
  u16* ya; u16* yb; unsigned* ctr; unsigned* xbar;
  int NB; int nchunk;
};

__device__ __forceinline__ unsigned pk2(float a, float b) {
  typedef __attribute__((ext_vector_type(2))) float f2_t;
  typedef __attribute__((ext_vector_type(2))) __bf16 b2_t;
  f2_t v = {a, b};
  b2_t r = __builtin_convertvector(v, b2_t);
  return __builtin_bit_cast(unsigned, r);
}
__device__ __forceinline__ u16 f2bf(float a) { return (u16)(pk2(a, 0.f) & 0xffffu); }
__device__ __forceinline__ float bf2f(u16 u) { return __uint_as_float(((unsigned)u) << 16); }
__device__ __forceinline__ float bflo(unsigned u) { return __uint_as_float(u << 16); }
__device__ __forceinline__ float bfhi(unsigned u) { return __uint_as_float(u & 0xffff0000u); }
__device__ __forceinline__ float sigmoidf_(float x) { return __builtin_amdgcn_rcpf(1.f + __expf(-x)); }
__device__ __forceinline__ float siluf_(float x) { return x * __builtin_amdgcn_rcpf(1.f + __expf(-x)); }
__device__ __forceinline__ f32x16 mfma32(bf16x8 a, bf16x8 b, f32x16 c) {
  return __builtin_amdgcn_mfma_f32_32x32x16_bf16(a, b, c, 0, 0, 0);
}
__device__ __forceinline__ int opaque_tid() { int t = threadIdx.x; asm volatile("" : "+v"(t)); return t; }
__device__ __forceinline__ bf16x8 ldfrag(const void* p) {
  return __builtin_bit_cast(bf16x8, *(const uint4*)p);
}

__device__ void transpose_tile(const float* __restrict__ src, u16* __restrict__ dst, int K, int N,
                               int k0, int n0, float* tile, const int tid) {
#pragma unroll
  for (int j = 0; j < 2; j++) {
    int r = (tid >> 4) + 32 * j, c4 = (tid & 15) * 4;
    float4 v = *(const float4*)(src + (size_t)(k0 + r) * N + n0 + c4);
    tile[r * 65 + c4] = v.x; tile[r * 65 + c4 + 1] = v.y; tile[r * 65 + c4 + 2] = v.z; tile[r * 65 + c4 + 3] = v.w;
  }
  __syncthreads();
  {
    int c = tid, n = c >> 3, kc = c & 7;
    const float* tp = tile + (kc * 8) * 65 + n;
    uint4 o;
    o.x = pk2(tp[0], tp[65]); o.y = pk2(tp[130], tp[195]); o.z = pk2(tp[260], tp[325]); o.w = pk2(tp[390], tp[455]);
    *(uint4*)(dst + (size_t)(n0 + n) * K + k0 + kc * 8) = o;
  }
  __syncthreads();
}

__device__ void phase0(const Params& P, char* smem) {
  const int tid = opaque_tid();
  float* tile = (float*)smem;
  const int n0_ = 4 * 16 * 141, n1_ = 4 * 16 * 16, n2_ = 4 * 32 * 2, n3_ = 4 * 2 * 1;
  const int nT = n0_ + 3 * n1_ + 2 * n2_ + 2 * n3_;
  const int nBias = 64, nRope = 128;
  const int total = nT + nBias + nRope + 1;
  for (int it = blockIdx.x; it < total; it += gridDim.x) {
    if (it < nT) {
      int t = it;
      if (t < n0_) {
        int l = t / (16 * 141), rem = t % (16 * 141);
        transpose_tile(P.w_in + (size_t)l * DM * INC, P.WinT + (size_t)l * INCP * DM, DM, INC, (rem / 141) * 64, (rem % 141) * 64, tile, tid);
        continue;
      }
      t -= n0_;
      if (t < 3 * n1_) {
        int which = t / n1_; t %= n1_;
        int l = t / 256, rem = t % 256;
        const float* s = which == 0 ? P.w_pa : (which == 1 ? P.w_pb : P.w_out);
        u16* d = which == 0 ? P.WpaT : (which == 1 ? P.WpbT : P.WoT);
        transpose_tile(s + (size_t)l * DM * DM, d + (size_t)l * DM * DM, DM, DM, (rem >> 4) * 64, (rem & 15) * 64, tile, tid);
        continue;
      }
      t -= 3 * n1_;
      if (t < 2 * n2_) {
        int kv = t / n2_; t %= n2_;
        int l = t / 64, rem = t % 64;
        const float* s = kv ? P.w1_v : P.w1_k;
        transpose_tile(s + (size_t)l * 2048 * 128, P.W1T + (size_t)(l * 2 + kv) * 128 * 2048, 2048, 128, (rem >> 1) * 64, (rem & 1) * 64, tile, tid);
        continue;
      }
      t -= 2 * n2_;
      {
        int kv = t / n3_; t %= n3_;
        int l = t / 2, rem = t % 2;
        const float* s = kv ? P.w2_v : P.w2_k;
        transpose_tile(s + (size_t)l * 128 * 64, P.W2T + (size_t)(l * 2 + kv) * 64 * 128, 128, 64, rem * 64, 0, tile, tid);
      }
    } else if (it < nT + nBias) {
      int j = it - nT;
      int l = j >> 4, kv = (j >> 3) & 1, kq = j & 7;
      const float* pe = (kv ? P.pe_v : P.pe_k) + (size_t)l * 2048;
      const float* w1 = (kv ? P.w1_v : P.w1_k) + (size_t)l * 2048 * 128;
      int hid = tid & 127, kh = tid >> 7;
      int kbeg = kq * 256 + kh * 64;
      float s = 0.f;
#pragma unroll 8
      for (int k = 0; k < 64; k++) s += pe[kbeg + k] * w1[(size_t)(kbeg + k) * 128 + hid];
      float* part = (float*)smem;
      part[tid] = s;
      __syncthreads();
      if (tid < 128) P.bias1p[((l * 2 + kv) * 8 + kq) * 128 + hid] = (part[tid] + part[tid + 128]) + (part[tid + 256] + part[tid + 384]);
      __syncthreads();
    } else if (it < nT + nBias + nRope) {
      int idx = (it - nT - nBias) * 512 + tid;
      int t = idx >> 5, j = idx & 31;
      double inv = 1.0;
      for (int q = 0; q < j; q++) inv *= 0.7498942093324558;
      float invf = (float)inv;
      float angf = (float)t * invf;
      double a = (double)angf;
      double kq = rint(a * 0.15915494309189535);
      double rr = a - kq * 6.283185307179586;
      double r2 = rr * rr;
      double sterm = rr, cterm = 1.0, ssum = rr, csum = 1.0;
#pragma unroll 1
      for (int n = 1; n <= 15; n++) {
        cterm *= -r2 / (double)((2 * n - 1) * (2 * n));
        sterm *= -r2 / (double)((2 * n) * (2 * n + 1));
        csum += cterm; ssum += sterm;
      }
      P.ropec[idx] = (float)csum;
      P.ropes[idx] = (float)ssum;
    } else {
      if (tid < 256) P.ctr[tid] = 0u;
      for (int i = tid; i < XB_WORDS; i += NTHREADS) P.xbar[i] = 0u;
    }
  }
}

__device__ void norm_phase(const float* __restrict__ xsrc, const float* __restrict__ g, u16* __restrict__ hdst, int nrows) {
  const int tid = opaque_tid();
  const int lane = tid & 63;
  const int gw = blockIdx.x * 8 + (tid >> 6), nw = gridDim.x * 8;
  float4 gv[4];
#pragma unroll
  for (int j = 0; j < 4; j++) gv[j] = *(const float4*)(g + lane * 4 + 256 * j);
  for (int row = gw; row < nrows; row += 2 * nw) {
    const float* xr0 = xsrc + (size_t)row * DM;
    const float* xr1 = xsrc + (size_t)(row + nw) * DM;
    float4 v0[4], v1[4];
#pragma unroll
    for (int j = 0; j < 4; j++) { v0[j] = *(const float4*)(xr0 + lane * 4 + 256 * j); v1[j] = *(const float4*)(xr1 + lane * 4 + 256 * j); }
    float s0 = 0.f, s1 = 0.f;
#pragma unroll
    for (int j = 0; j < 4; j++) {
      s0 += v0[j].x * v0[j].x + v0[j].y * v0[j].y + v0[j].z * v0[j].z + v0[j].w * v0[j].w;
      s1 += v1[j].x * v1[j].x + v1[j].y * v1[j].y + v1[j].z * v1[j].z + v1[j].w * v1[j].w;
    }
#pragma unroll
    for (int o = 32; o >= 1; o >>= 1) { s0 += __shfl_xor(s0, o); s1 += __shfl_xor(s1, o); }
    const float r0 = rsqrtf(s0 * (1.f / DM) + 1e-6f), r1 = rsqrtf(s1 * (1.f / DM) + 1e-6f);
#pragma unroll
    for (int j = 0; j < 4; j++) {
      uint2 o;
      o.x = pk2(v0[j].x * r0 * gv[j].x, v0[j].y * r0 * gv[j].y);
      o.y = pk2(v0[j].z * r0 * gv[j].z, v0[j].w * r0 * gv[j].w);
      *(uint2*)(hdst + (size_t)row * DM + lane * 4 + 256 * j) = o;
      o.x = pk2(v1[j].x * r1 * gv[j].x, v1[j].y * r1 * gv[j].y);
      o.y = pk2(v1[j].z * r1 * gv[j].z, v1[j].w * r1 * gv[j].w);
      *(uint2*)(hdst + (size_t)(row + nw) * DM + lane * 4 + 256 * j) = o;
    }
  }
}

__device__ void final_norm_phase(float* __restrict__ x, const float* __restrict__ g, int row0, int nrows) {
  const int tid = opaque_tid();
  const int lane = tid & 63;
  const int gw = blockIdx.x * 8 + (tid >> 6), nw = gridDim.x * 8;
  float4 gv[4];
#pragma unroll
  for (int j = 0; j < 4; j++) gv[j] = *(const float4*)(g + lane * 4 + 256 * j);
  for (int row = gw; row < nrows; row += nw) {
    float* xr = x + (size_t)(row0 + row) * DM;
    float4 v[4];
    float ss = 0.f;
#pragma unroll
    for (int j = 0; j < 4; j++) {
      v[j] = *(const float4*)(xr + lane * 4 + 256 * j);
      ss += v[j].x * v[j].x + v[j].y * v[j].y + v[j].z * v[j].z + v[j].w * v[j].w;
    }
#pragma unroll
    for (int o = 32; o >= 1; o >>= 1) ss += __shfl_xor(ss, o);
    float rstd = rsqrtf(ss * (1.f / DM) + 1e-6f);
#pragma unroll
    for (int j = 0; j < 4; j++) {
      float4 o;
      o.x = v[j].x * rstd * gv[j].x; o.y = v[j].y * rstd * gv[j].y;
      o.z = v[j].z * rstd * gv[j].z; o.w = v[j].w * rstd * gv[j].w;
      *(float4*)(xr + lane * 4 + 256 * j) = o;
    }
  }
}

struct ARow {
  const u16* p; int ld;
  __device__ __forceinline__ const u16* operator()(int row, int k) const { return p + (size_t)row * ld + k; }
};
struct ACmp {
  const u16* p;
  __device__ __forceinline__ const u16* operator()(int row, int k) const {
    int t = 16 * row + (k >> 6); t = t > (TSEQ - 1) ? (TSEQ - 1) : t;
    return p + (size_t)t * INC + (k & 63);
  }
};

template <class AF>
__device__ __forceinline__ void gemm_mainloop(AF af, const u16* __restrict__ Bt, int ldb, int K, char* smem,
                                              f32x16 (&acc)[2][2], const int tid) {
  const int lane = tid & 63, r = lane & 31, h = lane >> 5, w = tid >> 6;
  const int wm = w >> 1, wn = w & 1;
  const int lrow = tid >> 3, lch = tid & 7;
  uint4 ra[4], rb[4];
  const int nk = K >> 6;
#pragma unroll
  for (int j = 0; j < 4; j++) {
    int row = lrow + 32 * j;
    ra[j] = *(const uint4*)af(row, lch * 8);
    rb[j] = *(const uint4*)(Bt + (size_t)row * ldb + lch * 8);
  }
#pragma unroll
  for (int j = 0; j < 4; j++) {
    int row = lrow + 32 * j;
    int off = row * 128 + ((lch ^ ((row >> 1) & 7)) << 4);
    *(uint4*)(smem + off) = ra[j];
    *(uint4*)(smem + 16384 + off) = rb[j];
  }
  __syncthreads();
  for (int it = 0; it < nk; it++) {
    const bool more = (it + 1) < nk;
    if (more) {
      const int k0 = (it + 1) * 64;
#pragma unroll
      for (int j = 0; j < 4; j++) {
        int row = lrow + 32 * j;
        ra[j] = *(const uint4*)af(row, k0 + lch * 8);
        rb[j] = *(const uint4*)(Bt + (size_t)row * ldb + k0 + lch * 8);
      }
    }
    const char* sa = smem + (it & 1) * 32768;
    const char* sb = sa + 16384;
#pragma unroll
    for (int kk = 0; kk < 4; kk++) {
      bf16x8 a[2], b[2];
#pragma unroll
      for (int mi = 0; mi < 2; mi++) {
        int row = wm * 64 + mi * 32 + r;
        a[mi] = ldfrag(sa + row * 128 + (((kk * 2 + h) ^ ((row >> 1) & 7)) << 4));
      }
#pragma unroll
      for (int ni = 0; ni < 2; ni++) {
        int row = wn * 64 + ni * 32 + r;
        b[ni] = ldfrag(sb + row * 128 + (((kk * 2 + h) ^ ((row >> 1) & 7)) << 4));
      }
#pragma unroll
      for (int mi = 0; mi < 2; mi++)
#pragma unroll
        for (int ni = 0; ni < 2; ni++) acc[mi][ni] = mfma32(a[mi], b[ni], acc[mi][ni]);
    }
    if (more) {
      char* sd = smem + ((it + 1) & 1) * 32768;
#pragma unroll
      for (int j = 0; j < 4; j++) {
        int row = lrow + 32 * j;
        int off = row * 128 + ((lch ^ ((row >> 1) & 7)) << 4);
        *(uint4*)(sd + off) = ra[j];
        *(uint4*)(sd + 16384 + off) = rb[j];
      }
    }
    __syncthreads();
  }
}

__device__ __forceinline__ void zero_acc(f32x16 (&acc)[2][2]) {
#pragma unroll
  for (int a = 0; a < 2; a++)
#pragma unroll
    for (int b = 0; b < 2; b++)
#pragma unroll
      for (int i = 0; i < 16; i++) acc[a][b][i] = 0.f;
}

typedef __attribute__((ext_vector_type(8))) short s16x8;
#define G_TILE_B 32768
#define G_STAGE_B 65536
__device__ __forceinline__ int g_lds_byte(int r, int c) {
  int st = (r >> 4) * 2 + (c >> 5), ob = (r & 15) * 64 + (c & 31) * 2;
  return st * 1024 + (ob ^ (((ob >> 9) & 1) << 5));
}
__device__ __forceinline__ void g_stage_rc(int b, int& R, int& C) {
  int st = b >> 10, sb = b & 1023, swz = sb ^ (((sb >> 9) & 1) << 5);
  R = (st >> 1) * 16 + swz / 64;
  C = (st & 1) * 32 + (swz % 64) / 2;
}
#define G_WAIT_V0() asm volatile("s_waitcnt vmcnt(0)" ::: "memory")

struct GTile { int pm, pn; };
__device__ __forceinline__ bool g_next(int i, int G, int c, int nM, int nN, GTile& u) {
  const int nwg = nM * nN;
  const int L = i * G + c;
  if (L >= nwg) return false;
  int wgid = L;
  { const int q = nwg / 8, r = nwg % 8, xcd = wgid % 8, off = wgid / 8; wgid = (xcd < r ? xcd * (q + 1) : r * (q + 1) + (xcd - r) * q) + off; }
  const int nig = 4 * nN, gid = wgid / nig, fm = gid * 4, gsz = (nM - fm) < 4 ? (nM - fm) : 4;
  u.pm = fm + ((wgid % nig) % gsz);
  u.pn = (wgid % nig) / gsz;
  return true;
}

__device__ __forceinline__ void g_kloop(const u16* __restrict__ Ab, const u16* __restrict__ Bb, const int K, char* smem,
                                        f32x4 (&acc)[8][4], const int tid, const bool pre, const u16* __restrict__ nA,
                                        const u16* __restrict__ nB, const bool has_next) {
  const int wid = tid >> 6, lane = tid & 63, wr = wid >> 2, wc = wid & 3, fr = lane & 15, fq = lane >> 4;
  int sR0, sC0, sR1, sC1, sR2, sC2, sR3, sC3;
  g_stage_rc(wid * 1024 + 0 * 8192 + lane * 16, sR0, sC0);
  g_stage_rc(wid * 1024 + 1 * 8192 + lane * 16, sR1, sC1);
  g_stage_rc(wid * 1024 + 2 * 8192 + lane * 16, sR2, sC2);
  g_stage_rc(wid * 1024 + 3 * 8192 + lane * 16, sR3, sC3);
  const long o0 = (long)sR0 * K + sC0, o1 = (long)sR1 * K + sC1, o2 = (long)sR2 * K + sC2, o3 = (long)sR3 * K + sC3;
#define G_STAGE(buf, kt)                                                                                              \
  {                                                                                                                  \
    char* sa_ = smem + (buf) * G_STAGE_B + wid * 1024;                                                               \
    char* sb_ = sa_ + G_TILE_B;                                                                                      \
    const u16* ga_ = Ab + (kt) * 64;                                                                                 \
    const u16* gb_ = Bb + (kt) * 64;                                                                                 \
    __builtin_amdgcn_global_load_lds((const unsigned*)(ga_ + o0), (unsigned*)(sa_), 16, 0, 0);                       \
    __builtin_amdgcn_global_load_lds((const unsigned*)(gb_ + o0), (unsigned*)(sb_), 16, 0, 0);                       \
    __builtin_amdgcn_global_load_lds((const unsigned*)(ga_ + o1), (unsigned*)(sa_ + 8192), 16, 0, 0);                \
    __builtin_amdgcn_global_load_lds((const unsigned*)(gb_ + o1), (unsigned*)(sb_ + 8192), 16, 0, 0);                \
    __builtin_amdgcn_global_load_lds((const unsigned*)(ga_ + o2), (unsigned*)(sa_ + 16384), 16, 0, 0);               \
    __builtin_amdgcn_global_load_lds((const unsigned*)(gb_ + o2), (unsigned*)(sb_ + 16384), 16, 0, 0);               \
    __builtin_amdgcn_global_load_lds((const unsigned*)(ga_ + o3), (unsigned*)(sa_ + 24576), 16, 0, 0);               \
    __builtin_amdgcn_global_load_lds((const unsigned*)(gb_ + o3), (unsigned*)(sb_ + 24576), 16, 0, 0);               \
  }
  const int nt = K >> 6;
  if (!pre) {
    G_STAGE(0, 0);
    G_WAIT_V0();
    __syncthreads();
  }
  for (int t = 0; t < nt; ++t) {
    const int cur = t & 1;
    if (t + 1 < nt) G_STAGE(cur ^ 1, t + 1)
    else if (has_next) {
      char* sa_ = smem + wid * 1024;
      char* sb_ = sa_ + G_TILE_B;
      __builtin_amdgcn_global_load_lds((const unsigned*)(nA + o0), (unsigned*)(sa_), 16, 0, 0);
      __builtin_amdgcn_global_load_lds((const unsigned*)(nB + o0), (unsigned*)(sb_), 16, 0, 0);
      __builtin_amdgcn_global_load_lds((const unsigned*)(nA + o1), (unsigned*)(sa_ + 8192), 16, 0, 0);
      __builtin_amdgcn_global_load_lds((const unsigned*)(nB + o1), (unsigned*)(sb_ + 8192), 16, 0, 0);
      __builtin_amdgcn_global_load_lds((const unsigned*)(nA + o2), (unsigned*)(sa_ + 16384), 16, 0, 0);
      __builtin_amdgcn_global_load_lds((const unsigned*)(nB + o2), (unsigned*)(sb_ + 16384), 16, 0, 0);
      __builtin_amdgcn_global_load_lds((const unsigned*)(nA + o3), (unsigned*)(sa_ + 24576), 16, 0, 0);
      __builtin_amdgcn_global_load_lds((const unsigned*)(nB + o3), (unsigned*)(sb_ + 24576), 16, 0, 0);
    }
    const char* sa = smem + cur * G_STAGE_B;
    const char* sb = sa + G_TILE_B;
#pragma unroll
    for (int ks = 0; ks < 2; ++ks) {
      s16x8 At[8], Bf[4];
#pragma unroll
      for (int m = 0; m < 8; ++m) At[m] = *(const s16x8*)(sa + g_lds_byte(wr * 128 + m * 16 + fr, ks * 32 + fq * 8));
#pragma unroll
      for (int n = 0; n < 4; ++n) Bf[n] = *(const s16x8*)(sb + g_lds_byte(wc * 64 + n * 16 + fr, ks * 32 + fq * 8));
#pragma unroll
      for (int m = 0; m < 8; ++m)
#pragma unroll
        for (int n = 0; n < 4; ++n)
          acc[m][n] = __builtin_amdgcn_mfma_f32_16x16x32_bf16(__builtin_bit_cast(bf16x8, Bf[n]), __builtin_bit_cast(bf16x8, At[m]), acc[m][n], 0, 0, 0);
    }
    G_WAIT_V0();
    __syncthreads();
  }
}

__device__ __forceinline__ void g_zero(f32x4 (&acc)[8][4]) {
#pragma unroll
  for (int m = 0; m < 8; m++)
#pragma unroll
    for (int n = 0; n < 4; n++) acc[m][n] = (f32x4){0.f, 0.f, 0.f, 0.f};
}
__device__ __forceinline__ uint2 pk4(f32x4 v) { return make_uint2(pk2(v[0], v[1]), pk2(v[2], v[3])); }

__device__ __forceinline__ void wave_store_rows(char* wsm, u16* gbase, const size_t ld, const f32x4 (&acc)[8][4], const int lane) {
  const int fr = lane & 15, fq = lane >> 4;
  const int rr = lane >> 3, ch = lane & 7;
  typedef __attribute__((ext_vector_type(4))) unsigned u32x4_t;
#pragma unroll
  for (int hf = 0; hf < 2; hf++) {
#pragma unroll
    for (int m = 0; m < 4; m++)
#pragma unroll
      for (int n = 0; n < 4; n++) {
        const int row = m * 16 + fr, chunk = n * 2 + (fq >> 1);
        *(uint2*)(wsm + row * 128 + ((chunk ^ (fr & 7)) << 4) + (fq & 1) * 8) = pk4(acc[hf * 4 + m][n]);
      }
#pragma unroll
    for (int i = 0; i < 8; i++) {
      const int row = i * 8 + rr;
      const uint4 v = *(const uint4*)(wsm + row * 128 + ((ch ^ (row & 7)) << 4));
      __builtin_nontemporal_store(__builtin_bit_cast(u32x4_t, v), (u32x4_t*)(gbase + (size_t)(hf * 64 + row) * ld + ch * 8));
    }
  }
}
__device__ __forceinline__ void wave_store_cols(char* wsm, u16* vt, const int vcol0, const int nh, const int bl, const int t0,
                                                const f32x4 (&acc)[8][4], const int lane) {
  const int fr = lane & 15, fq = lane >> 4;
#pragma unroll
  for (int m = 0; m < 8; m++)
#pragma unroll
    for (int n = 0; n < 4; n++)
#pragma unroll
      for (int j = 0; j < 4; j++) {
        const int d = n * 16 + fq * 4 + j, t = m * 16 + fr;
        *(u16*)(wsm + d * 256 + (((t >> 3) ^ (d & 15)) << 4) + (t & 7) * 2) = f2bf(acc[m][n][j]);
      }
  const int dd = lane >> 4, ch = lane & 15;
#pragma unroll
  for (int i = 0; i < 16; i++) {
    const int d = i * 4 + dd;
    const uint4 v = *(const uint4*)(wsm + d * 256 + ((ch ^ (d & 15)) << 4));
    const int vcol = vcol0 + d;
    *(uint4*)(vt + ((size_t)(bl * nh + (vcol >> 6)) * 64 + (vcol & 63)) * TSEQ + t0 + ch * 8) = v;
  }
}

__device__ void gemm1_phase(const Params& P, int layer, char* smem) {
  const int CT = P.NB * TSEQ;
  const int nM = CT >> 8, nN = INCP >> 8;
  const u16* Bt = P.WinT + (size_t)layer * INCP * DM;
  u16* p_qr = P.qr; u16* p_proj = P.proj;
  asm volatile("" : "+s"(p_qr), "+s"(p_proj));
  for (int i = 0;; i++) {
    GTile u, un;
    if (!g_next(i, gridDim.x, blockIdx.x, nM, nN, u)) break;
    const bool hn = g_next(i + 1, gridDim.x, blockIdx.x, nM, nN, un);
    const int tid = opaque_tid(), wid = tid >> 6, lane = tid & 63, wr = wid >> 2, wc = wid & 3, fr = lane & 15, fq = lane >> 4;
    f32x4 acc[8][4];
    g_zero(acc);
    g_kloop(P.h + (size_t)(u.pm * 256) * DM, Bt + (size_t)(u.pn * 256) * DM, DM, smem, acc, tid, i > 0,
            P.h + (size_t)(un.pm * 256) * DM, Bt + (size_t)(un.pn * 256) * DM, hn);
    const int cw = u.pn * 256 + wc * 64;
    const int row0 = u.pm * 256 + wr * 128 + fr;
    char* wsm = smem + G_STAGE_B + wid * 8192;
    const int rowb = u.pm * 256 + wr * 128;
    const bool rope_q = cw < 1024;
    const bool rope_k = (cw >= C_KV + 256 && cw < C_KV + 384) || (cw >= C_KV + 512 && cw < C_KV + 640);
    const bool mixed = (cw == 5888);
    if (cw >= INC) {
    } else if (rope_q || rope_k) {
      if (rope_q) wave_store_rows(wsm, p_proj + (size_t)rowb * INC + cw, INC, acc, lane);
#pragma unroll
      for (int m = 0; m < 8; m++) {
        const int tt = (row0 + m * 16) & (TSEQ - 1);
#pragma unroll
        for (int n = 0; n < 2; n++) {
          const float4 c = *(const float4*)(P.ropec + tt * 32 + n * 16 + fq * 4);
          const float4 sn = *(const float4*)(P.ropes + tt * 32 + n * 16 + fq * 4);
          const f32x4 x1 = acc[m][n], x2 = acc[m][n + 2];
          f32x4 r1, r2;
          r1[0] = x1[0] * c.x - x2[0] * sn.x; r2[0] = x2[0] * c.x + x1[0] * sn.x;
          r1[1] = x1[1] * c.y - x2[1] * sn.y; r2[1] = x2[1] * c.y + x1[1] * sn.y;
          r1[2] = x1[2] * c.z - x2[2] * sn.z; r2[2] = x2[2] * c.z + x1[2] * sn.z;
          r1[3] = x1[3] * c.w - x2[3] * sn.w; r2[3] = x2[3] * c.w + x1[3] * sn.w;
          acc[m][n] = r1; acc[m][n + 2] = r2;
        }
      }
      if (rope_q) wave_store_rows(wsm, p_qr + (size_t)rowb * DM + cw, DM, acc, lane);
      else wave_store_rows(wsm, p_proj + (size_t)rowb * INC + cw, INC, acc, lane);
    } else if (!mixed) {
      wave_store_rows(wsm, p_proj + (size_t)rowb * INC + cw, INC, acc, lane);
    } else {
#pragma unroll
      for (int n = 0; n < 4; n++) {
        const int c0 = cw + n * 16 + fq * 4;
        if (c0 < C_FB) {
#pragma unroll
          for (int m = 0; m < 8; m++) *(uint2*)(p_proj + (size_t)(row0 + m * 16) * INC + c0) = pk4(acc[m][n]);
        } else {
#pragma unroll
          for (int m = 0; m < 8; m++)
            *(float4*)(P.flog + (size_t)(row0 + m * 16) * 16 + (c0 - C_FB)) = make_float4(acc[m][n][0], acc[m][n][1], acc[m][n][2], acc[m][n][3]);
        }
        __builtin_amdgcn_sched_barrier(0);
      }
    }
    __syncthreads();
  }
}

__device__ void gemm2_phase(const Params& P, int layer, char* smem) {
  const int CT = P.NB * TSEQ;
  const int nM = CT >> 8, nN = 4;
  const u16* p_ya = P.ya; const u16* p_yb = P.yb; const u16* p_wa = P.WpaT; const u16* p_wb = P.WpbT;
  for (int i = 0;; i++) {
    GTile u, un;
    if (!g_next(i, gridDim.x, blockIdx.x, nM, nN, u)) break;
    const bool hn = g_next(i + 1, gridDim.x, blockIdx.x, nM, nN, un);
    const int tid = opaque_tid(), wid = tid >> 6, lane = tid & 63, wr = wid >> 2, wc = wid & 3, fr = lane & 15, fq = lane >> 4;
    f32x4 acc[8][4];
    g_zero(acc);
#pragma unroll 1
    for (int pass = 0; pass < 2; pass++) {
      const u16* Ap = (pass ? p_yb : p_ya) + (size_t)(u.pm * 256) * DM;
      const u16* Bp = (pass ? p_wb : p_wa) + (size_t)layer * DM * DM + (size_t)(u.pn * 256) * DM;
      const u16* nAp = pass ? (p_ya + (size_t)(un.pm * 256) * DM) : (p_yb + (size_t)(u.pm * 256) * DM);
      const u16* nBp = pass ? (p_wa + (size_t)layer * DM * DM + (size_t)(un.pn * 256) * DM) : (p_wb + (size_t)layer * DM * DM + (size_t)(u.pn * 256) * DM);
      g_kloop(Ap, Bp, DM, smem, acc, tid, (i > 0) || (pass > 0), nAp, nBp, pass ? hn : true);
      __builtin_amdgcn_sched_barrier(0);
      if (pass == 0) {
        const int tid1 = opaque_tid(), wid1 = tid1 >> 6, lane1 = tid1 & 63, wr1 = wid1 >> 2, wc1 = wid1 & 3, fr1 = lane1 & 15, fq1 = lane1 >> 4;
        const u16* pp = P.proj + (size_t)(u.pm * 256 + wr1 * 128 + fr1) * INC + u.pn * 256 + wc1 * 64 + fq1 * 4;
#pragma unroll
        for (int m = 0; m < 8; m++) {
#pragma unroll
          for (int n = 0; n < 4; n++) {
            const uint2 ra = *(const uint2*)(pp + (size_t)(m * 16) * INC + C_RA + n * 16);
            const uint2 rb = *(const uint2*)(pp + (size_t)(m * 16) * INC + C_RB + n * 16);
            acc[m][n][0] *= (1.f + __expf(-bflo(rb.x))) * __builtin_amdgcn_rcpf(1.f + __expf(-bflo(ra.x)));
            acc[m][n][1] *= (1.f + __expf(-bfhi(rb.x))) * __builtin_amdgcn_rcpf(1.f + __expf(-bfhi(ra.x)));
            acc[m][n][2] *= (1.f + __expf(-bflo(rb.y))) * __builtin_amdgcn_rcpf(1.f + __expf(-bflo(ra.y)));
            acc[m][n][3] *= (1.f + __expf(-bfhi(rb.y))) * __builtin_amdgcn_rcpf(1.f + __expf(-bfhi(ra.y)));
          }
          __builtin_amdgcn_sched_barrier(0);
        }
      }
    }
    {
      const int tid2 = opaque_tid(), wid2 = tid2 >> 6, lane2 = tid2 & 63, wr2 = wid2 >> 2, wc2 = wid2 & 3, fr2 = lane2 & 15, fq2 = lane2 >> 4;
      const u16* pp = P.proj + (size_t)(u.pm * 256 + wr2 * 128 + fr2) * INC + u.pn * 256 + wc2 * 64 + fq2 * 4;
#pragma unroll
      for (int m = 0; m < 8; m++) {
#pragma unroll
        for (int n = 0; n < 4; n++) {
          const uint2 rb = *(const uint2*)(pp + (size_t)(m * 16) * INC + C_RB + n * 16);
          acc[m][n][0] *= sigmoidf_(bflo(rb.x)); acc[m][n][1] *= sigmoidf_(bfhi(rb.x));
          acc[m][n][2] *= sigmoidf_(bflo(rb.y)); acc[m][n][3] *= sigmoidf_(bfhi(rb.y));
        }
        __builtin_amdgcn_sched_barrier(0);
      }
      wave_store_rows(smem + G_STAGE_B + wid2 * 8192, P.h + (size_t)(u.pm * 256 + wr2 * 128) * DM + u.pn * 256 + wc2 * 64, DM, acc, lane2);
    }
    __syncthreads();
  }
}

__device__ void gemm3_phase(const Params& P, int layer, int chunk, char* smem) {
  const int CT = P.NB * TSEQ;
  const int nM = CT >> 8, nN = 4;
  const float* xs = (layer == 0 ? P.x_in : P.out) + (size_t)chunk * CT * DM;
  float* xd = P.out + (size_t)chunk * CT * DM;
  for (int i = 0;; i++) {
    GTile u, un;
    if (!g_next(i, gridDim.x, blockIdx.x, nM, nN, u)) break;
    const bool hn = g_next(i + 1, gridDim.x, blockIdx.x, nM, nN, un);
    const int tid = opaque_tid(), wid = tid >> 6, lane = tid & 63, wr = wid >> 2, wc = wid & 3, fr = lane & 15, fq = lane >> 4;
    f32x4 acc[8][4];
    g_zero(acc);
    g_kloop(P.h + (size_t)(u.pm * 256) * DM, P.WoT + (size_t)layer * DM * DM + (size_t)(u.pn * 256) * DM, DM, smem, acc, tid, i > 0,
            P.h + (size_t)(un.pm * 256) * DM, P.WoT + (size_t)layer * DM * DM + (size_t)(un.pn * 256) * DM, hn);
    const size_t off = (size_t)(u.pm * 256 + wr * 128 + fr) * DM + u.pn * 256 + wc * 64 + fq * 4;
#pragma unroll
    for (int m = 0; m < 8; m++) {
#pragma unroll
      for (int n = 0; n < 4; n++) {
        const float4 xo = *(const float4*)(xs + off + (size_t)(m * 16) * DM + n * 16);
        *(float4*)(xd + off + (size_t)(m * 16) * DM + n * 16) =
            make_float4(xo.x + acc[m][n][0], xo.y + acc[m][n][1], xo.z + acc[m][n][2], xo.w + acc[m][n][3]);
      }
      __builtin_amdgcn_sched_barrier(0);
    }
  }
}

__device__ __forceinline__ void compress_item(const Params& P, const int layer, const int it, char* smem_all, const int tid_all) {
  const int half = tid_all >> 8, tid = tid_all & 255;
  char* smem = smem_all + half * 65536;
  const int lane = tid & 63, r = lane & 31, h = lane >> 5, w = tid >> 6;
  const int wm = w >> 1, wn = w & 1;
  const int unit = it * 2 + half;
  const int bl = unit >> 2, g = (unit >> 1) & 1, kv = unit & 1;
  f32x16 acc[2][2];
  zero_acc(acc);
  ACmp af{P.proj + (size_t)bl * TSEQ * INC + C_KV + kv * 128 + g * 64};
  gemm_mainloop(af, P.W1T + (size_t)(layer * 2 + kv) * 128 * 2048, 2048, 2048, smem, acc, tid);
  const float* bp = P.bias1p + (size_t)((layer * 2 + kv) * 8) * 128;
#pragma unroll
  for (int ni = 0; ni < 2; ni++) {
    int hc = wn * 64 + ni * 32 + r;
    float b1 = 0.f;
#pragma unroll
    for (int q = 0; q < 8; q++) b1 += bp[q * 128 + hc];
#pragma unroll
    for (int mi = 0; mi < 2; mi++)
#pragma unroll
      for (int i = 0; i < 16; i++) {
        int n = wm * 64 + mi * 32 + 8 * (i >> 2) + 4 * h + (i & 3);
        float v = siluf_(acc[mi][ni][i] + b1);
        *(u16*)(smem + n * 256 + (((hc >> 3) ^ (n & 15)) << 4) + (hc & 7) * 2) = f2bf(v);
      }
  }
  __syncthreads();
  const u16* w2t = P.W2T + (size_t)(layer * 2 + kv) * 64 * 128;
  f32x16 o2[2];
#pragma unroll
  for (int dt = 0; dt < 2; dt++)
#pragma unroll
    for (int i = 0; i < 16; i++) o2[dt][i] = 0.f;
#pragma unroll
  for (int kk = 0; kk < 8; kk++) {
    int n = w * 32 + r;
    bf16x8 a = ldfrag(smem + n * 256 + (((kk * 2 + h) ^ (n & 15)) << 4));
#pragma unroll
    for (int dt = 0; dt < 2; dt++) {
      bf16x8 b = ldfrag(w2t + (size_t)(dt * 32 + r) * 128 + kk * 16 + h * 8);
      o2[dt] = mfma32(a, b, o2[dt]);
    }
  }
#pragma unroll
  for (int dt = 0; dt < 2; dt++) {
    int d = dt * 32 + r;
    if (kv == 0) {
#pragma unroll
      for (int i = 0; i < 16; i++) {
        int n = w * 32 + 8 * (i >> 2) + 4 * h + (i & 3);
        P.kcmp[((size_t)(bl * 2 + g) * 128 + n) * 64 + d] = f2bf(o2[dt][i]);
      }
    } else {
#pragma unroll
      for (int gq = 0; gq < 4; gq++) {
        int n0 = w * 32 + 8 * gq + 4 * h;
        uint2 o;
        o.x = pk2(o2[dt][gq * 4 + 0], o2[dt][gq * 4 + 1]);
        o.y = pk2(o2[dt][gq * 4 + 2], o2[dt][gq * 4 + 3]);
        *(uint2*)(P.vcmpt + ((size_t)(bl * 2 + g) * 64 + d) * 128 + n0) = o;
      }
    }
  }
  __syncthreads();
}

__device__ void pb_phase(const Params& P, int layer, char* smem_all) {
  const int tid = opaque_tid();
  const int lane = tid & 63, w = tid >> 6;
  float* wsum = (float*)smem_all;
  const int nScan = P.NB * 16;
  for (int it = blockIdx.x; it < nScan; it += gridDim.x) {
    const int bl = it >> 4, hh = it & 15;
    const float bf = P.b_forget[layer * 16 + hh];
    const float* fl = P.flog + ((size_t)bl * TSEQ + tid * 4) * 16 + hh;
    float ls[4];
#pragma unroll
    for (int j = 0; j < 4; j++) {
      const float x = fl[j * 16] + bf;
      ls[j] = (x >= 0.f) ? -log1pf(__expf(-x)) : (x - log1pf(__expf(x)));
    }
    const float loc = (ls[0] + ls[1]) + (ls[2] + ls[3]);
    float incl = loc;
#pragma unroll
    for (int o = 1; o < 64; o <<= 1) {
      const float v = __shfl_up(incl, o);
      if (lane >= o) incl += v;
    }
    __syncthreads();
    if (lane == 63) wsum[w] = incl;
    __syncthreads();
    float base = 0.f;
#pragma unroll
    for (int q = 0; q < 8; q++) base += (q < w) ? wsum[q] : 0.f;
    float run = base + incl - loc;
    float4 o4;
    run += ls[0]; o4.x = -8.0f * run;
    run += ls[1]; o4.y = -8.0f * run;
    run += ls[2]; o4.z = -8.0f * run;
    run += ls[3]; o4.w = -8.0f * run;
    *(float4*)(P.F2 + ((size_t)bl * 16 + hh) * TSEQ + tid * 4) = o4;
  }
}

__device__ void pc1_phase(const Params& P, char* smem) {
  const int tid = opaque_tid(),  lane = tid & 63, r = lane & 31, h = lane >> 5, w = tid >> 6;
  const int nItems = P.NB * 2 * 8;
  const float c1 = 0.125f * LOG2E;
  for (int it = blockIdx.x; it < nItems; it += gridDim.x) {
    const int qt = it & 7, g = (it >> 3) & 1, bl = it >> 4;
    __syncthreads();
#pragma unroll
    for (int j = 0; j < 2; j++) {
      int c = tid + 512 * j;
      {
        int n = c >> 3, ch = c & 7;
        uint4 v = *(const uint4*)(P.kcmp + ((size_t)(bl * 2 + g) * 128 + n) * 64 + ch * 8);
        *(uint4*)(smem + n * 128 + ((ch ^ ((n >> 1) & 7)) << 4)) = v;
      }
      {
        int d = c >> 4, ch = c & 15;
        uint4 v = *(const uint4*)(P.vcmpt + ((size_t)(bl * 2 + g) * 64 + d) * 128 + ch * 8);
        int sw = d & 31;
        *(uint2*)(smem + 16384 + d * 256 + (((2 * ch) ^ sw) << 3)) = make_uint2(v.x, v.y);
        *(uint2*)(smem + 16384 + d * 256 + (((2 * ch + 1) ^ sw) << 3)) = make_uint2(v.z, v.w);
      }
    }
    __syncthreads();
    const int qw_lo = qt * 256 + w * 32;
    const int qtok = qw_lo + r;
    const size_t rowg = (size_t)bl * TSEQ + qtok;
    const int tq = qtok - 31 - 64 * h;
    float sumacc[16], lastacc[16];
#pragma unroll
    for (int s = 0; s < 16; s++) { sumacc[s] = 0.f; lastacc[s] = 0.f; }
#pragma unroll 1
    for (int hh = 0; hh < 8; hh++) {
      const int head = g * 8 + hh;
      bf16x8 qf[4];
#pragma unroll
      for (int kk = 0; kk < 4; kk++) qf[kk] = ldfrag(P.proj + rowg * INC + C_QA + head * 64 + kk * 16 + h * 8);
      f32x16 s[4];
#pragma unroll
      for (int nt = 0; nt < 4; nt++) {
#pragma unroll
        for (int i = 0; i < 16; i++) s[nt][i] = 0.f;
#pragma unroll
        for (int kk = 0; kk < 4; kk++) {
          int row = nt * 32 + r;
          bf16x8 a = ldfrag(smem + row * 128 + (((kk * 2 + h) ^ ((row >> 1) & 7)) << 4));
          s[nt] = mfma32(a, qf[kk], s[nt]);
        }
        __builtin_amdgcn_sched_barrier(0);
      }
      float mx = -3.0e38f;
#pragma unroll
      for (int nt = 0; nt < 4; nt++)
#pragma unroll
        for (int i = 0; i < 16; i++) {
          bool ok = (16 * (nt * 32 + 8 * (i >> 2) + (i & 3))) <= tq;
          float v = ok ? s[nt][i] * c1 : -3.0e38f;
          s[nt][i] = v;
          mx = fmaxf(mx, v);
        }
      mx = fmaxf(mx, __shfl_xor(mx, 32));
      const bool anyv = mx > -1.0e37f;
      float mref = anyv ? mx : 0.f;
      float l = 0.f;
#pragma unroll
      for (int nt = 0; nt < 4; nt++)
#pragma unroll
        for (int i = 0; i < 16; i++) {
          float p = __builtin_amdgcn_exp2f(s[nt][i] - mref);
          s[nt][i] = p;
          l += p;
        }
      l += __shfl_xor(l, 32);
      const float inv = (anyv && l > 0.f) ? 1.f / l : 0.f;
#pragma unroll
      for (int nt = 0; nt < 4; nt++)
#pragma unroll
        for (int i = 0; i < 16; i++) s[nt][i] *= inv;
#pragma unroll
      for (int nt = 0; nt < 4; nt++)
#pragma unroll
        for (int gq = 0; gq < 4; gq++) {
          sumacc[nt * 4 + gq] += (s[nt][gq * 4] + s[nt][gq * 4 + 1]) + (s[nt][gq * 4 + 2] + s[nt][gq * 4 + 3]);
          lastacc[nt * 4 + gq] += s[nt][gq * 4 + 3];
        }
      uint4 pbv[8];
#pragma unroll
      for (int ks = 0; ks < 8; ks++) {
        const int nt = ks >> 1, hb = (ks & 1) * 8;
        pbv[ks].x = pk2(s[nt][hb + 0], s[nt][hb + 1]); pbv[ks].y = pk2(s[nt][hb + 2], s[nt][hb + 3]);
        pbv[ks].z = pk2(s[nt][hb + 4], s[nt][hb + 5]); pbv[ks].w = pk2(s[nt][hb + 6], s[nt][hb + 7]);
      }
      const float g0 = sigmoidf_(bf2f(P.proj[rowg * INC + C_GA + head]));
#pragma unroll
      for (int dt = 0; dt < 2; dt++) {
        f32x16 o;
#pragma unroll
        for (int i = 0; i < 16; i++) o[i] = 0.f;
        const int d = dt * 32 + r, sw = d & 31;
#pragma unroll
        for (int ks = 0; ks < 8; ks++) {
          uint2 lo = *(const uint2*)(smem + 16384 + d * 256 + (((ks * 4 + h) ^ sw) << 3));
          uint2 hi = *(const uint2*)(smem + 16384 + d * 256 + (((ks * 4 + 2 + h) ^ sw) << 3));
          uint4 au = make_uint4(lo.x, lo.y, hi.x, hi.y);
          o = mfma32(__builtin_bit_cast(bf16x8, au), __builtin_bit_cast(bf16x8, pbv[ks]), o);
        }
#pragma unroll
        for (int gq = 0; gq < 4; gq++) {
          int d0 = dt * 32 + 8 * gq + 4 * h;
          uint2 ov;
          ov.x = pk2(o[gq * 4 + 0] * g0, o[gq * 4 + 1] * g0);
          ov.y = pk2(o[gq * 4 + 2] * g0, o[gq * 4 + 3] * g0);
          *(uint2*)(P.ya + rowg * DM + head * 64 + d0) = ov;
        }
        __builtin_amdgcn_sched_barrier(0);
      }
    }
    float sc[16];
#pragma unroll
    for (int s = 0; s < 16; s++) {
      float prev = (s == 0) ? 0.f : lastacc[s - 1];
      float sendv = h ? prev : lastacc[s];
      float recv = __shfl_xor(sendv, 32);
      float imp = sumacc[s] + recv;
      int j = (s >> 2) * 8 + (s & 3) * 2 + h;
      int cur = qtok >> 6;
      bool forced = (j == 0) || (j == cur) || (j == cur - 1);
      bool valid = j <= cur;
      sc[s] = forced ? 1.0e4f : (valid ? imp : -1.0f);
    }
    unsigned mask = 0u;
#pragma unroll 1
    for (int rd = 0; rd < 8; rd++) {
      float best = -2.0f; int bj = 0;
#pragma unroll
      for (int s = 0; s < 16; s++) {
        int j = (s >> 2) * 8 + (s & 3) * 2 + h;
        if (sc[s] > best) { best = sc[s]; bj = j; }
      }
      float ob = __shfl_xor(best, 32);
      int oj = __shfl_xor(bj, 32);
      bool mine = (best > ob) || (best == ob && bj < oj);
      int wj = mine ? bj : oj;
      mask |= 1u << wj;
#pragma unroll
      for (int s = 0; s < 16; s++) {
        int j = (s >> 2) * 8 + (s & 3) * 2 + h;
        if (j == wj) sc[s] = -3.0f;
      }
    }
    if (h == 0) P.sel[(size_t)(bl * 2 + g) * TSEQ + qtok] = mask;
  }
}

#define A_SLOTB 8192
#define A_LDS_K 0
#define A_LDS_V 24576
#define A_LDS_WS 49152
#define A_LDS_F 51200
#define A_LDS_OST 52224
#define A_THR 8.0f
#define A_C2 (0.125f * LOG2E)
typedef __attribute__((ext_vector_type(4))) short a_s16x4;
typedef __attribute__((ext_vector_type(8))) short a_s16x8;
typedef __attribute__((ext_vector_type(4))) unsigned a_u32x4;
typedef __attribute__((address_space(3))) const char* a_lds_cptr;
typedef short a_v4i16 __attribute__((ext_vector_type(4)));
#define A_SBAR() __builtin_amdgcn_sched_barrier(0)
#define A_PIN(x) asm volatile("" : "+v"(x))
#define A_MFMA(a, b, c) __builtin_amdgcn_mfma_f32_32x32x16_bf16(a, b, c, 0, 0, 0)
template <int N> __device__ __forceinline__ void a_wait_bar() { asm volatile("s_waitcnt vmcnt(%0) lgkmcnt(0)\n\ts_barrier" ::"n"(N) : "memory"); }
__device__ __forceinline__ int a_crow(int r, int hi) { return (r & 3) + 8 * (r >> 2) + 4 * hi; }
__device__ __forceinline__ unsigned a_cvtpk(float lo, float hi) { unsigned r; asm("v_cvt_pk_bf16_f32 %0, %1, %2" : "=v"(r) : "v"(lo), "v"(hi)); return r; }
__device__ __forceinline__ void a_glds16(const void* g, unsigned lds_base) {
  unsigned sv; asm volatile("s_mov_b32 %0, m0\n\ts_mov_b32 m0, %2\n\ts_nop 0\n\tglobal_load_lds_dwordx4 %1, off\n\ts_mov_b32 m0, %0" : "=&s"(sv) : "v"(g), "s"(lds_base) : "memory"); }
__device__ __forceinline__ void a_glds4(const void* g, unsigned lds_base) {
  unsigned sv; asm volatile("s_mov_b32 %0, m0\n\ts_mov_b32 m0, %2\n\ts_nop 0\n\tglobal_load_lds_dword %1, off\n\ts_mov_b32 m0, %0" : "=&s"(sv) : "v"(g), "s"(lds_base) : "memory"); }
__device__ __forceinline__ void a_kload2(bf16x8* kf, a_lds_cptr kp, int d0) {
  kf[2 * d0] = *(const __attribute__((address_space(3))) bf16x8*)(kp + d0 * 2048);
  kf[2 * d0 + 1] = *(const __attribute__((address_space(3))) bf16x8*)(kp + d0 * 2048 + 512); }
__device__ __forceinline__ a_s16x4 a_vtr(a_lds_cptr p) { return __builtin_bit_cast(a_s16x4, __builtin_amdgcn_ds_read_tr16_b64_v4i16((__attribute__((address_space(3))) a_v4i16*)p)); }
#define A_MX3(a, b, c) __builtin_fmaxf(__builtin_fmaxf((a), (b)), (c))
__device__ __forceinline__ float a_rowmax(const f32x16& p0, const f32x16& p1) {
  float a = A_MX3(p0[0], p0[1], p1[0]), b = A_MX3(p0[2], p0[3], p1[1]); a = A_MX3(a, p1[2], p1[3]);
#pragma unroll
  for (int r = 4; r < 16; r += 4) { a = A_MX3(a, p0[r], p0[r + 1]); b = A_MX3(b, p0[r + 2], p0[r + 3]); a = A_MX3(a, p1[r], p1[r + 1]); b = A_MX3(b, p1[r + 2], p1[r + 3]); }
  float m = __builtin_fmaxf(a, b); auto rr = __builtin_amdgcn_permlane32_swap(__float_as_uint(m), __float_as_uint(m), false, false);
  return __builtin_fmaxf(__uint_as_float(rr[0]), __uint_as_float(rr[1])); }
template <int MODE>
__device__ __forceinline__ void a_mask(f32x16& p0, f32x16& p1, int key0, int qabs, int hi) {
  const int kb = key0 + 4 * hi;
#pragma unroll
  for (int r = 0; r < 16; ++r) {
    const int kv = kb + (r & 3) + 8 * (r >> 2);
    bool bad0 = kv > qabs, bad1 = (kv + 32) > qabs;
    if (MODE == 2) { bad0 = bad0 || (kv + 512 <= qabs); bad1 = bad1 || (kv + 32 + 512 <= qabs); }
    if (bad0) p0[r] = -INFINITY;
    if (bad1) p1[r] = -INFINITY;
  } }
__device__ __forceinline__ void a_bias(f32x16& p0, f32x16& p1, const char* fb, int hi) {
#pragma unroll
  for (int g = 0; g < 4; ++g) {
    const float4 b0 = *(const float4*)(fb + (8 * g + 4 * hi) * 4);
    const float4 b1 = *(const float4*)(fb + (32 + 8 * g + 4 * hi) * 4);
    p0[4 * g + 0] += b0.x; p0[4 * g + 1] += b0.y; p0[4 * g + 2] += b0.z; p0[4 * g + 3] += b0.w;
    p1[4 * g + 0] += b1.x; p1[4 * g + 1] += b1.y; p1[4 * g + 2] += b1.z; p1[4 * g + 3] += b1.w;
  } }

template <int MODE>
__device__ __forceinline__ void a_unit(const u16* __restrict__ Qw, const int qp, const u16* __restrict__ Kp, const u16* __restrict__ Vp,
                                       const float* __restrict__ Fp, const int NT, const int key00, const int qabs, const unsigned selm,
                                       const float gate, char* lds, u16* stg, const int tid) {
  constexpr int NK = (MODE == 0) ? 2 : 1;
  const int lane = tid & 63, r32 = lane & 31, hi = lane >> 5; const int wid = __builtin_amdgcn_readfirstlane(tid >> 6);
  const unsigned lds0 = (unsigned)(uintptr_t)lds; float* wsf = (float*)(lds + A_LDS_WS) + wid * 64;
  const u16* ksrc = Kp + (long)lane * INC + wid * 8;
  const u16* vsrc = Vp + (long)(16 * (wid & 3) + (lane >> 2)) * INC + (wid >> 2) * 32 + (lane & 3) * 8;
  const float* fsrc = Fp + lane;
  const unsigned kdst = lds0 + A_LDS_K + wid * 1024, vdst = lds0 + A_LDS_V + wid * 1024, fdst = lds0 + A_LDS_F;
#define A_DMA_K(t, slot) do { a_glds16(ksrc + (long)(t) * 64 * INC, (unsigned)__builtin_amdgcn_readfirstlane(kdst + (slot))); \
    if (MODE == 0) a_glds4(fsrc + (t) * 64, (unsigned)__builtin_amdgcn_readfirstlane(fdst + ((t) & 3) * 256)); } while (0)
#define A_DMA_V(t, slot) a_glds16(vsrc + (long)(t) * 64 * INC, (unsigned)__builtin_amdgcn_readfirstlane(vdst + (slot)))
  const a_lds_cptr vp0 = (a_lds_cptr)lds + A_LDS_V + ((lane >> 4) & 1) * 32 + (lane & 3) * 8 + (4 * hi + ((lane & 15) >> 2)) * 64;
  const a_lds_cptr kp0 = (a_lds_cptr)lds + A_LDS_K + hi * 1024 + r32 * 16;
  const char* fb0 = lds + A_LDS_F;
  A_DMA_K(0, 0); A_DMA_V(0, 0); A_DMA_K(1, A_SLOTB);
  bf16x8 qr[4];
#pragma unroll
  for (int d0 = 0; d0 < 4; ++d0) qr[d0] = ldfrag(Qw + (long)r32 * qp + d0 * 16 + hi * 8);
  float mhat = 0.f, l_reg = 0.f; f32x16 o[2];
#pragma unroll
  for (int r = 0; r < 16; ++r) { o[0][r] = 0.f; o[1][r] = 0.f; }
  const f32x16 zero16 = {0.f, 0.f, 0.f, 0.f, 0.f, 0.f, 0.f, 0.f, 0.f, 0.f, 0.f, 0.f, 0.f, 0.f, 0.f, 0.f};
  bool resc = false;
  f32x16 pA0, pA1, pB0, pB1; bf16x8 kf[8]; a_s16x4 vlo[8], vhi[8]; a_u32x4 pw0, pw1, pw2, pw3;
  int sl_prev = 0, sl_cur = 0, sl_next = A_SLOTB;
#define A_ROT() do { sl_prev = sl_cur; sl_cur = sl_next; sl_next = (sl_next == 2 * A_SLOTB) ? 0 : sl_next + A_SLOTB; } while (0)
#define A_EX(v) __builtin_amdgcn_exp2f(__builtin_fmaf((v), A_C2, nmh))
#define A_RESC() do { if (resc) { _Pragma("unroll") for (int d_ = 0; d_ < 2; ++d_) _Pragma("unroll") for (int r = 0; r < 16; ++r) o[d_][r] *= wsf[a_crow(r, hi)]; } } while (0)
  A_DMA_K(2, 2 * A_SLOTB);
  a_wait_bar<1 + 2 * NK>();
  _Pragma("unroll") for (int d0 = 0; d0 < 4; ++d0) a_kload2(kf, kp0, d0);
  pA0 = A_MFMA(kf[0], qr[0], zero16); pA1 = A_MFMA(kf[1], qr[0], zero16); pA0 = A_MFMA(kf[2], qr[1], pA0); pA1 = A_MFMA(kf[3], qr[1], pA1);
  pA0 = A_MFMA(kf[4], qr[2], pA0); pA1 = A_MFMA(kf[5], qr[2], pA1); pA0 = A_MFMA(kf[6], qr[3], pA0); pA1 = A_MFMA(kf[7], qr[3], pA1);
  if (MODE == 0) a_bias(pA0, pA1, fb0, hi);
  if (MODE == 2 || NT == 4) a_mask<MODE>(pA0, pA1, key00, qabs, hi);
  { const float rm = a_rowmax(pA0, pA1); mhat = __builtin_fmaxf(rm * A_C2, -1.0e30f); const float nmh = -mhat;
#pragma unroll
    for (int r = 0; r < 16; ++r) { pA0[r] = A_EX(pA0[r]); pA1[r] = A_EX(pA1[r]); } }
  a_wait_bar<0>();
  A_DMA_K(3, 0); A_DMA_V(1, A_SLOTB); A_ROT();
  _Pragma("unroll") for (int d0 = 0; d0 < 4; ++d0) a_kload2(kf, kp0 + sl_cur, d0);
  a_wait_bar<NK + 1>();
#define A_PKW(P, i) a_cvtpk(P[i], P[i + 1])
#define A_PAF(k) __builtin_bit_cast(bf16x8, pw##k)
#define A_VFR(i) __builtin_bit_cast(bf16x8, __builtin_shufflevector(vlo[i], vhi[i], 0, 1, 2, 3, 4, 5, 6, 7))
#define A_VRD(i) do { vlo[i] = a_vtr(vp_ + (((i) >> 2) * 4096 + ((i) & 3) * 1024)); vhi[i] = a_vtr(vp_ + (((i) >> 2) * 4096 + ((i) & 3) * 1024 + 512)); } while (0)
#define A_KRD(G, d0) do { if (G) { a_kload2(kf, kp0 + sl_next, d0); A_SBAR(); } } while (0)
#define A_GAPA(MF, a0, a1, a2, a3, W0, W1, PW) do { MF; sacc += a0; sacc += a1; sacc += a2; sacc += a3; W0; W1; A_PIN(PW); A_PIN(sacc); A_SBAR(); } while (0)
#define A_GAPB(MF, X, i) do { MF; X[i] = A_EX(X[i]); X[i + 1] = A_EX(X[i + 1]); X[i + 2] = A_EX(X[i + 2]); X[i + 3] = A_EX(X[i + 3]); A_PIN(X); A_SBAR(); } while (0)
#define A_STEP(C0, C1, P0, P1, t, MASK, GK, GV, GL) do { A_SBAR(); \
    const a_lds_cptr vp_ = vp0 + sl_prev; \
    A_VRD(0); A_SBAR(); float sacc = P0[0] + P0[1]; \
                      A_GAPA(C0 = A_MFMA(kf[0], qr[0], zero16), P0[2], P0[3], P0[4], P0[5],     pw0[0] = A_PKW(P0, 0),  pw0[1] = A_PKW(P0, 2),  pw0); \
    A_VRD(4); A_SBAR(); A_GAPA(C1 = A_MFMA(kf[1], qr[0], zero16), P0[6], P0[7], P0[8], P0[9],     pw0[2] = A_PKW(P0, 4),  pw0[3] = A_PKW(P0, 6),  pw0); \
    A_VRD(1); A_SBAR(); A_GAPA(C0 = A_MFMA(kf[2], qr[1], C0),    P0[10], P0[11], P0[12], P0[13], pw1[0] = A_PKW(P0, 8),  pw1[1] = A_PKW(P0, 10), pw1); \
    A_VRD(5); A_SBAR(); A_GAPA(C1 = A_MFMA(kf[3], qr[1], C1),    P0[14], P0[15], P1[0], P1[1],   pw1[2] = A_PKW(P0, 12), pw1[3] = A_PKW(P0, 14), pw1); \
    A_VRD(2); A_SBAR(); A_GAPA(C0 = A_MFMA(kf[4], qr[2], C0),    P1[2], P1[3], P1[4], P1[5],     pw2[0] = A_PKW(P1, 0),  pw2[1] = A_PKW(P1, 2),  pw2); \
    A_VRD(6); A_SBAR(); A_GAPA(C1 = A_MFMA(kf[5], qr[2], C1),    P1[6], P1[7], P1[8], P1[9],     pw2[2] = A_PKW(P1, 4),  pw2[3] = A_PKW(P1, 6),  pw2); \
    A_VRD(3); A_SBAR(); A_GAPA(C0 = A_MFMA(kf[6], qr[3], C0),    P1[10], P1[11], P1[12], P1[13], pw3[0] = A_PKW(P1, 8),  pw3[1] = A_PKW(P1, 10), pw3); \
    A_VRD(7); A_SBAR(); A_GAPA(C1 = A_MFMA(kf[7], qr[3], C1),    P1[14], P1[15], 0.f, 0.f,       pw3[2] = A_PKW(P1, 12), pw3[3] = A_PKW(P1, 14), pw3); \
    l_reg += sacc; \
    if (GK) A_DMA_K((t) + 3, sl_cur); if (GV) A_DMA_V((t) + 1, sl_next); \
    if (MODE == 0) a_bias(C0, C1, fb0 + ((t) & 3) * 256, hi); \
    if (MASK) a_mask<MODE>(C0, C1, key00 + (t) * 64, qabs, hi); \
    const bool selb_ = (MODE != 1) || (((selm >> ((t) & 31)) & 1u) != 0u); \
    { float rmx = a_rowmax(C0, C1) * A_C2; if (!selb_) rmx = -INFINITY; resc = false; \
      if (__builtin_expect(__any((rmx - mhat) > A_THR), 0)) { const float mnew = __builtin_fmaxf(mhat, rmx); \
          const float f = __builtin_amdgcn_exp2f(mhat - mnew); mhat = mnew; l_reg *= f; if (hi == 0) wsf[r32] = f; resc = true; } } \
    const float nmh = selb_ ? -mhat : -INFINITY; A_SBAR(); \
    A_GAPB(o[0] = A_MFMA(A_PAF(0), A_VFR(0), o[0]), C0, 0);              A_GAPB(o[1] = A_MFMA(A_PAF(0), A_VFR(4), o[1]), C0, 4); \
    A_KRD(GL, 0); A_GAPB(o[0] = A_MFMA(A_PAF(1), A_VFR(1), o[0]), C0, 8);  A_KRD(GL, 1); A_GAPB(o[1] = A_MFMA(A_PAF(1), A_VFR(5), o[1]), C0, 12); \
    A_KRD(GL, 2); A_GAPB(o[0] = A_MFMA(A_PAF(2), A_VFR(2), o[0]), C1, 0);  A_KRD(GL, 3); A_GAPB(o[1] = A_MFMA(A_PAF(2), A_VFR(6), o[1]), C1, 4); \
    A_GAPB(o[0] = A_MFMA(A_PAF(3), A_VFR(3), o[0]), C1, 8);              A_GAPB(o[1] = A_MFMA(A_PAF(3), A_VFR(7), o[1]), C1, 12); \
    } while (0)
  int t = 1;
  if (MODE != 2) {
    for (; t + 5 < NT; t += 2) {
      A_STEP(pB0, pB1, pA0, pA1, t, false, true, true, true);     a_wait_bar<NK + 1>(); A_RESC(); A_ROT();
      A_STEP(pA0, pA1, pB0, pB1, t + 1, false, true, true, true); a_wait_bar<NK + 1>(); A_RESC(); A_ROT();
    }
  }
#define A_ENDW(tt) do { if ((tt) + 3 < NT) { a_wait_bar<NK + 1>(); } else if ((tt) + 2 < NT) { a_wait_bar<1>(); } else { a_wait_bar<0>(); } } while (0)
  for (; t + 1 < NT; t += 2) {
    A_STEP(pB0, pB1, pA0, pA1, t, (MODE != 2 || t < 4 || t + 4 >= NT), (t + 3 < NT), (t + 1 < NT), (t + 1 < NT));             A_ENDW(t);     A_RESC(); A_ROT();
    A_STEP(pA0, pA1, pB0, pB1, t + 1, (MODE != 2 || t + 1 < 4 || t + 5 >= NT), (t + 4 < NT), (t + 2 < NT), (t + 2 < NT));     A_ENDW(t + 1); A_RESC(); A_ROT();
  }
  A_STEP(pB0, pB1, pA0, pA1, NT - 1, true, false, false, false); A_RESC();
  { float sacc = pB0[0] + pB0[1];
#pragma unroll
    for (int r = 2; r < 16; ++r) sacc += pB0[r];
#pragma unroll
    for (int r = 0; r < 16; ++r) sacc += pB1[r];
    l_reg += sacc;
    pw0 = (a_u32x4){A_PKW(pB0, 0), A_PKW(pB0, 2), A_PKW(pB0, 4), A_PKW(pB0, 6)}; pw1 = (a_u32x4){A_PKW(pB0, 8), A_PKW(pB0, 10), A_PKW(pB0, 12), A_PKW(pB0, 14)};
    pw2 = (a_u32x4){A_PKW(pB1, 0), A_PKW(pB1, 2), A_PKW(pB1, 4), A_PKW(pB1, 6)}; pw3 = (a_u32x4){A_PKW(pB1, 8), A_PKW(pB1, 10), A_PKW(pB1, 12), A_PKW(pB1, 14)};
    const a_lds_cptr vp_ = vp0 + sl_cur; _Pragma("unroll") for (int i = 0; i < 8; ++i) A_VRD(i);
    o[0] = A_MFMA(A_PAF(0), A_VFR(0), o[0]); o[1] = A_MFMA(A_PAF(0), A_VFR(4), o[1]); o[0] = A_MFMA(A_PAF(1), A_VFR(1), o[0]); o[1] = A_MFMA(A_PAF(1), A_VFR(5), o[1]);
    o[0] = A_MFMA(A_PAF(2), A_VFR(2), o[0]); o[1] = A_MFMA(A_PAF(2), A_VFR(6), o[1]); o[0] = A_MFMA(A_PAF(3), A_VFR(3), o[0]); o[1] = A_MFMA(A_PAF(3), A_VFR(7), o[1]); }
  { auto rr = __builtin_amdgcn_permlane32_swap(__float_as_uint(l_reg), __float_as_uint(l_reg), false, false); l_reg = __uint_as_float(rr[0]) + __uint_as_float(rr[1]); }
  if (hi == 0) wsf[32 + r32] = gate / l_reg;
  asm volatile("s_waitcnt lgkmcnt(0)" ::: "memory");
  float rli[16];
#pragma unroll
  for (int r = 0; r < 16; ++r) rli[r] = wsf[32 + a_crow(r, hi)];
#pragma unroll
  for (int r = 0; r < 16; ++r) { const int orow = a_crow(r, hi);
#pragma unroll
    for (int d0 = 0; d0 < 2; ++d0) stg[orow * 64 + d0 * 32 + r32] = f2bf(o[d0][r] * rli[r]); }
  asm volatile("s_waitcnt lgkmcnt(0)\n\ts_barrier" ::: "memory");
#undef A_DMA_K
#undef A_DMA_V
#undef A_ROT
#undef A_EX
#undef A_RESC
#undef A_PKW
#undef A_PAF
#undef A_VFR
#undef A_VRD
#undef A_KRD
#undef A_ENDW
#undef A_GAPA
#undef A_GAPB
#undef A_STEP
}

__device__ void pc2_phase(const Params& P, int layer, int chunk, char* smem, int* s_item, const int which) {
  volatile __attribute__((address_space(3))) unsigned* xst = (volatile __attribute__((address_space(3))) unsigned*)(smem + XB_LDS_OFF);
  const int nx = (int)xst[1], xc = (int)xst[3];
  const int nBH = P.NB * 16;
  const int nStr = which ? (P.NB * 2) : nBH;
  const int nLoc = (nStr - xc + nx - 1) / nx;
  const int nCmpAll = which ? 0 : P.NB * 2;
  const int nCmp = which ? 0 : (nCmpAll - xc + nx - 1) / nx;
  const int nItems = nCmp + (which ? nLoc * 64 : ((nLoc + 3) >> 2) * 32);
  unsigned* ctr = P.ctr + ((chunk * 4 + layer) * 2 + which) * 8 + xc;
  while (true) {
    const int tid = opaque_tid(), lane = tid & 63, r32 = lane & 31, w = tid >> 6;
    __syncthreads();
    if (tid == 0) *s_item = (int)atomicAdd(ctr, 1u);
    __syncthreads();
    const int it0 = *s_item;
    if (it0 >= nItems) break;
    if (it0 < nCmp) { compress_item(P, layer, xc + nx * it0, smem, tid); continue; }
    const int it = it0 - nCmp;
    int qt, bh;
    if (which) {
      const int sl = it >> 6, rem = it & 63;
      qt = 7 - (rem >> 3);
      bh = (xc + nx * sl) * 8 + (rem & 7);
    } else {
      const int grp = it >> 5, rem = it & 31;
      const int sl = grp * 4 + (rem & 3);
      qt = 7 - (rem >> 2);
      if (sl >= nLoc) continue;
      bh = xc + nx * sl;
    }
    const int type = which;
    const int bl = bh >> 4, head = bh & 15;
    const int q0w = qt * 256 + w * 32;
    const int qabs = q0w + r32;
    const size_t rowq = (size_t)bl * TSEQ + qabs;
    const size_t roww = (size_t)bl * TSEQ + q0w;
    const u16* pb_ = P.proj + (size_t)bl * TSEQ * INC;
    u16* stg = (u16*)(smem + A_LDS_OST) + w * 4096;
    const int er = lane >> 3, ec = (lane & 7) * 8;
    if (type == 0) {
      a_unit<0>(pb_ + roww * 0 + (size_t)q0w * INC + C_QB + head * 64, INC, pb_ + C_KB + head * 64, pb_ + C_VB + head * 64,
                P.F2 + (size_t)(bl * 16 + head) * TSEQ, 4 * qt + 4, 0, qabs, 0u, 1.0f, smem, stg, tid);
#pragma unroll
      for (int i = 0; i < 4; i++) {
        const int row = i * 8 + er;
        const uint4 ov = *(const uint4*)(stg + row * 64 + ec);
        const uint4 zz = *(const uint4*)(pb_ + (size_t)(q0w + row) * INC + C_ZB + head * 64 + ec);
        uint4 y;
        y.x = pk2(bflo(ov.x) * siluf_(bflo(zz.x)), bfhi(ov.x) * siluf_(bfhi(zz.x)));
        y.y = pk2(bflo(ov.y) * siluf_(bflo(zz.y)), bfhi(ov.y) * siluf_(bfhi(zz.y)));
        y.z = pk2(bflo(ov.z) * siluf_(bflo(zz.z)), bfhi(ov.z) * siluf_(bfhi(zz.z)));
        y.w = pk2(bflo(ov.w) * siluf_(bflo(zz.w)), bfhi(ov.w) * siluf_(bfhi(zz.w)));
        *(uint4*)(P.yb + (roww + row) * DM + head * 64 + ec) = y;
      }
    } else {
      const int g = head >> 3;
      const unsigned selm = P.sel[(size_t)(bl * 2 + g) * TSEQ + qabs];
      const float g1 = sigmoidf_(bf2f(P.proj[rowq * INC + C_GA + 16 + head]));
      const float g2 = sigmoidf_(bf2f(P.proj[rowq * INC + C_GA + 32 + head]));
      const u16* qw = P.qr + roww * DM + head * 64;
      a_unit<1>(qw, DM, pb_ + C_KV + 256 + g * 64, pb_ + C_KV + 384 + g * 64, nullptr, 4 * qt + 4, 0, qabs, selm, g1, smem, stg, tid);
      const int klo = (4 * qt - 8) > 0 ? (4 * qt - 8) : 0;
      a_unit<2>(qw, DM, pb_ + (size_t)(klo * 64) * INC + C_KV + 512 + g * 64, pb_ + (size_t)(klo * 64) * INC + C_KV + 640 + g * 64, nullptr,
                4 * qt + 4 - klo, klo * 64, qabs, 0u, g2, smem, stg + 2048, tid);
#pragma unroll
      for (int i = 0; i < 4; i++) {
        const int row = i * 8 + er;
        const uint4 o1 = *(const uint4*)(stg + row * 64 + ec);
        const uint4 o2 = *(const uint4*)(stg + 2048 + row * 64 + ec);
        const uint4 zz = *(const uint4*)(pb_ + (size_t)(q0w + row) * INC + C_ZA + head * 64 + ec);
        u16* yp = P.ya + (roww + row) * DM + head * 64 + ec;
        const uint4 oc = *(const uint4*)yp;
        uint4 y;
        y.x = pk2((bflo(o1.x) + bflo(o2.x) + bflo(oc.x)) * siluf_(bflo(zz.x)), (bfhi(o1.x) + bfhi(o2.x) + bfhi(oc.x)) * siluf_(bfhi(zz.x)));
        y.y = pk2((bflo(o1.y) + bflo(o2.y) + bflo(oc.y)) * siluf_(bflo(zz.y)), (bfhi(o1.y) + bfhi(o2.y) + bfhi(oc.y)) * siluf_(bfhi(zz.y)));
        y.z = pk2((bflo(o1.z) + bflo(o2.z) + bflo(oc.z)) * siluf_(bflo(zz.z)), (bfhi(o1.z) + bfhi(o2.z) + bfhi(oc.z)) * siluf_(bfhi(zz.z)));
        y.w = pk2((bflo(o1.w) + bflo(o2.w) + bflo(oc.w)) * siluf_(bflo(zz.w)), (bfhi(o1.w) + bfhi(o2.w) + bfhi(oc.w)) * siluf_(bfhi(zz.w)));
        *(uint4*)yp = y;
      }
    }
  }
}

#define XB_XCNT(j) (64 * (j))
#define XB_XSUB(j) (1024 + 64 * (j))
#define XB_XGEN(j) (2048 + 64 * (j))
#define XB_TOP 3072
#define XB_TOPGEN 3136
__device__ __forceinline__ unsigned xb_ld(unsigned* p) { return __hip_atomic_load(p, __ATOMIC_RELAXED, __HIP_MEMORY_SCOPE_AGENT); }
__device__ __forceinline__ unsigned xb_add(unsigned* p, unsigned v) { return __hip_atomic_fetch_add(p, v, __ATOMIC_RELAXED, __HIP_MEMORY_SCOPE_AGENT); }
__device__ __forceinline__ unsigned xb_xcc_id() { return (unsigned)__builtin_amdgcn_s_getreg((3 << 11) | 20) & 0xFu; }
__device__ __forceinline__ void grid_bar(unsigned* bar, char* smem) {
  asm volatile("s_waitcnt vmcnt(0) lgkmcnt(0)" ::: "memory");
  __syncthreads();
  if (threadIdx.x == 0) {
    volatile unsigned* st = (volatile unsigned*)(smem + XB_LDS_OFF);
    const unsigned nloc = st[0], nx = st[1], x = st[2];
    const unsigned old = xb_add(&bar[XB_XSUB(x)], 1u);
    const unsigned gen = old / nloc;
    if (old + 1u == (gen + 1u) * nloc) {
      __builtin_amdgcn_fence(__ATOMIC_RELEASE, "agent");
      asm volatile("s_waitcnt vmcnt(0)" ::: "memory");
      const unsigned og = xb_add(&bar[XB_TOP], 1u);
      const unsigned tg = og / nx;
      if (og + 1u == (tg + 1u) * nx) xb_add(&bar[XB_TOPGEN], 1u);
      else { while (xb_ld(&bar[XB_TOPGEN]) == tg) __builtin_amdgcn_s_sleep(1); }
      __builtin_amdgcn_fence(__ATOMIC_ACQUIRE, "agent");
      xb_add(&bar[XB_XGEN(x)], 1u);
      asm volatile("s_waitcnt vmcnt(0)" ::: "memory");
    } else {
      while (xb_ld(&bar[XB_XGEN(x)]) == gen) __builtin_amdgcn_s_sleep(1);
      __builtin_amdgcn_fence(__ATOMIC_ACQUIRE, "agent");
      asm volatile("s_waitcnt vmcnt(0)" ::: "memory");
    }
  }
  __syncthreads();
}

__global__ void __launch_bounds__(NTHREADS, 2) mega_kernel(Params P) {
  __shared__ __attribute__((aligned(1024))) char smem[163840];
  cg::grid_group grid = cg::this_grid();
  const int CT = P.NB * TSEQ;
  phase0(P, smem);
  grid.sync();
  if (threadIdx.x == 0) (void)xb_add(&P.xbar[XB_XCNT(xb_xcc_id())], 1u);
  grid.sync();
  if (threadIdx.x == 0) {
    unsigned cnt = 0u, mine = 0u, rank = 0u; const unsigned x = xb_xcc_id();
#pragma unroll 1
    for (unsigned j = 0; j < 16; ++j) { const unsigned c = xb_ld(&P.xbar[XB_XCNT(j)]); cnt += (c > 0u) ? 1u : 0u; mine = (j == x) ? c : mine; rank += (c > 0u && j < x) ? 1u : 0u; }
    volatile unsigned* st = (volatile unsigned*)(smem + XB_LDS_OFF);
    st[0] = mine > 0u ? mine : 1u; st[1] = cnt > 0u ? cnt : 1u; st[2] = x; st[3] = rank;
  }
  __syncthreads();
  for (int chunk = 0; chunk < P.nchunk; chunk++) {
    for (int layer = 0; layer < 4; layer++) {
      const float* xs = (layer == 0 ? P.x_in : P.out) + (size_t)chunk * CT * DM;
      norm_phase(xs, P.norm_g + layer * DM, P.h, CT);
      if (layer == 0 && chunk > 0) final_norm_phase(P.out, P.final_g, (chunk - 1) * CT, CT);
      grid_bar(P.xbar, smem);
      gemm1_phase(P, layer, smem);
      grid_bar(P.xbar, smem);
      pb_phase(P, layer, smem);
      grid_bar(P.xbar, smem);
      pc2_phase(P, layer, chunk, smem, (int*)(smem + 140000), 0);
      grid_bar(P.xbar, smem);
      pc1_phase(P, smem);
      grid_bar(P.xbar, smem);
      pc2_phase(P, layer, chunk, smem, (int*)(smem + 140000), 1);
      grid_bar(P.xbar, smem);
      gemm2_phase(P, layer, smem);
      grid_bar(P.xbar, smem);
      gemm3_phase(P, layer, chunk, smem);
      grid_bar(P.xbar, smem);
    }
  }
  final_norm_phase(P.out, P.final_g, (P.nchunk - 1) * CT, CT);
}

static inline size_t al256(size_t x) { return (x + 255) & ~(size_t)255; }

extern "C" void kernel_launch(void* const* d_in, const int* in_sizes, int n_in, void* d_out, int out_size,
                              void* d_ws, size_t ws_size, hipStream_t stream) {
  (void)in_sizes; (void)n_in; (void)out_size;
  Params P{};
  P.x_in = (const float*)d_in[0]; P.norm_g = (const float*)d_in[1]; P.w_in = (const float*)d_in[2];
  P.b_forget = (const float*)d_in[3];
  P.pe_k = (const float*)d_in[4]; P.w1_k = (const float*)d_in[5]; P.w2_k = (const float*)d_in[6];
  P.pe_v = (const float*)d_in[7]; P.w1_v = (const float*)d_in[8]; P.w2_v = (const float*)d_in[9];
  P.w_pa = (const float*)d_in[10]; P.w_pb = (const float*)d_in[11]; P.w_out = (const float*)d_in[12];
  P.final_g = (const float*)d_in[13];
  P.out = (float*)d_out;
  int NB = 16;
  char* base = (char*)d_ws;
  for (;;) {
    const size_t CT = (size_t)NB * TSEQ;
    size_t off = 0;
    auto take = [&](size_t bytes) { size_t o = off; off = al256(off + bytes); return o; };
    size_t oWin = take((size_t)4 * INCP * DM * 2), oWpa = take((size_t)4 * DM * DM * 2), oWpb = take((size_t)4 * DM * DM * 2),
           oWo = take((size_t)4 * DM * DM * 2), oW1 = take((size_t)8 * 128 * 2048 * 2), oW2 = take((size_t)8 * 64 * 128 * 2),
           oB1 = take((size_t)64 * 128 * 4), oRc = take((size_t)TSEQ * 32 * 4), oRs = take((size_t)TSEQ * 32 * 4),
           oH = take(CT * DM * 2), oProj = take(CT * INC * 2 + 4096), oVbt = take(CT * DM * 2),
           oVst = take(CT * 128 * 2), oVwt = take(CT * 128 * 2), oFl = take(CT * 16 * 4), oF2 = take(CT * 16 * 4),
           oKc = take((size_t)NB * 2 * 128 * 64 * 2), oVc = take((size_t)NB * 2 * 64 * 128 * 2), oSel = take(CT * 2 * 4),
           oYa = take(CT * DM * 2), oYb = take(CT * DM * 2), oCtr = take(1024), oXb = take(XB_WORDS * 4);
    if (off > ws_size && NB > 1) { NB >>= 1; continue; }
    P.WinT = (u16*)(base + oWin); P.WpaT = (u16*)(base + oWpa); P.WpbT = (u16*)(base + oWpb); P.WoT = (u16*)(base + oWo);
    P.W1T = (u16*)(base + oW1); P.W2T = (u16*)(base + oW2); P.bias1p = (float*)(base + oB1);
    P.ropec = (float*)(base + oRc); P.ropes = (float*)(base + oRs);
    P.h = (u16*)(base + oH); P.proj = (u16*)(base + oProj); P.qr = (u16*)(base + oVbt);
    P.vst = (u16*)(base + oVst); P.vwt = (u16*)(base + oVwt); P.flog = (float*)(base + oFl); P.F2 = (float*)(base + oF2);
    P.kcmp = (u16*)(base + oKc); P.vcmpt = (u16*)(base + oVc); P.sel = (unsigned*)(base + oSel);
    P.ya = (u16*)(base + oYa); P.yb = (u16*)(base + oYb); P.ctr = (unsigned*)(base + oCtr); P.xbar = (unsigned*)(base + oXb);
    break;
  }
  P.NB = NB; P.nchunk = 32 / NB;
  static int grid_blocks = 0;
  if (!grid_blocks) {
    int dev = 0, cus = 0, per_cu = 0;
    hipGetDevice(&dev);
    hipDeviceGetAttribute(&cus, hipDeviceAttributeMultiprocessorCount, dev);
    hipOccupancyMaxActiveBlocksPerMultiprocessor(&per_cu, mega_kernel, NTHREADS, 0);
    if (per_cu > 1) per_cu = 1;
    if (per_cu < 1) per_cu = 1;
    grid_blocks = cus * per_cu;
  }
  void* args[] = {&P};
  hipError_t e = hipLaunchCooperativeKernel((void*)mega_kernel, dim3(grid_blocks), dim3(NTHREADS), args, 0, stream);
  if (e != hipSuccess) fprintf(stderr, "cooperative launch failed: %s (grid %d)\n", hipGetErrorString(e), grid_blocks);
}
```

```cpp
#include <hip/hip_runtime.h>
#include <hip/hip_cooperative_groups.h>
#include <cstdio>
namespace cg = cooperative_groups;

typedef __attribute__((ext_vector_type(8))) __bf16 bf16x8;
typedef __attribute__((ext_vector_type(16))) float f32x16;
typedef __attribute__((ext_vector_type(4))) float f32x4;
typedef __attribute__((ext_vector_type(2))) float f32x2;
typedef unsigned short u16;

#define TSEQ 2048
#define DM 1024
#define INC 9024
#define INCP 9216
#define C_QA 0
#define C_KV 1024
#define C_GA 1792
#define C_ZA 1840
#define C_QB 2864
#define C_KB 3888
#define C_VB 4912
#define C_QR 4912
#define C_FB 5936
#define C_ZB 5952
#define C_RA 6976
#define C_RB 8000
#define NTHREADS 512
#define ATT_STAGE 33280
#define LOG2E 1.4426950408889634f
#define XB_WORDS 3200
#define XB_LDS_OFF 150000

struct Params {
  const float* x_in; const float* norm_g; const float* w_in; const float* b_forget;
  const float* pe_k; const float* w1_k; const float* w2_k;
  const float* pe_v; const float* w1_v; const float* w2_v;
  const float* w_pa; const float* w_pb; const float* w_out; const float* final_g;
  float* out;
  u16* WinT; u16* WpaT; u16* WpbT; u16* WoT; u16* W1T; u16* W2T;
  float* bias1p; float* ropec; float* ropes;
  u16* h; u16* proj; u16* qr; u16* vst; u16* vwt;
  float* flog; float* F2; u16* kcmp; u16* vcmpt; unsigned* sel;
  u16* ya; u16* yb; unsigned* ctr; unsigned* xbar;
  int NB; int nchunk;
};

__device__ __forceinline__ unsigned pk2(float a, float b) {
  typedef __attribute__((ext_vector_type(2))) float f2_t;
  typedef __attribute__((ext_vector_type(2))) __bf16 b2_t;
  f2_t v = {a, b};
  b2_t r = __builtin_convertvector(v, b2_t);
  return __builtin_bit_cast(unsigned, r);
}
__device__ __forceinline__ u16 f2bf(float a) { return (u16)(pk2(a, 0.f) & 0xffffu); }
__device__ __forceinline__ float bf2f(u16 u) { return __uint_as_float(((unsigned)u) << 16); }
__device__ __forceinline__ float bflo(unsigned u) { return __uint_as_float(u << 16); }
__device__ __forceinline__ float bfhi(unsigned u) { return __uint_as_float(u & 0xffff0000u); }
__device__ __forceinline__ float sigmoidf_(float x) { return __builtin_amdgcn_rcpf(1.f + __expf(-x)); }
__device__ __forceinline__ float siluf_(float x) { return x * __builtin_amdgcn_rcpf(1.f + __expf(-x)); }
__device__ __forceinline__ f32x16 mfma32(bf16x8 a, bf16x8 b, f32x16 c) {
  return __builtin_amdgcn_mfma_f32_32x32x16_bf16(a, b, c, 0, 0, 0);
}
__device__ __forceinline__ int opaque_tid() { int t = threadIdx.x; asm volatile("" : "+v"(t)); return t; }
__device__ __forceinline__ bf16x8 ldfrag(const void* p) {
  return __builtin_bit_cast(bf16x8, *(const uint4*)p);
}

__device__ void transpose_tile(const float* __restrict__ src, u16* __restrict__ dst, int K, int N,
                               int k0, int n0, float* tile, const int tid) {
#pragma unroll
  for (int j = 0; j < 2; j++) {
    int r = (tid >> 4) + 32 * j, c4 = (tid & 15) * 4;
    float4 v = *(const float4*)(src + (size_t)(k0 + r) * N + n0 + c4);
    tile[r * 65 + c4] = v.x; tile[r * 65 + c4 + 1] = v.y; tile[r * 65 + c4 + 2] = v.z; tile[r * 65 + c4 + 3] = v.w;
  }
  __syncthreads();
  {
    int c = tid, n = c >> 3, kc = c & 7;
    const float* tp = tile + (kc * 8) * 65 + n;
    uint4 o;
    o.x = pk2(tp[0], tp[65]); o.y = pk2(tp[130], tp[195]); o.z = pk2(tp[260], tp[325]); o.w = pk2(tp[390], tp[455]);
    *(uint4*)(dst + (size_t)(n0 + n) * K + k0 + kc * 8) = o;
  }
  __syncthreads();
}

__device__ void phase0(const Params& P, char* smem) {
  const int tid = opaque_tid();
  float* tile = (float*)smem;
  const int n0_ = 4 * 16 * 141, n1_ = 4 * 16 * 16, n2_ = 4 * 32 * 2, n3_ = 4 * 2 * 1;
  const int nT = n0_ + 3 * n1_ + 2 * n2_ + 2 * n3_;
  const int nBias = 64, nRope = 128;
  const int total = nT + nBias + nRope + 1;
  for (int it = blockIdx.x; it < total; it += gridDim.x) {
    if (it < nT) {
      int t = it;
      if (t < n0_) {
        int l = t / (16 * 141), rem = t % (16 * 141);
        transpose_tile(P.w_in + (size_t)l * DM * INC, P.WinT + (size_t)l * INCP * DM, DM, INC, (rem / 141) * 64, (rem % 141) * 64, tile, tid);
        continue;
      }
      t -= n0_;
      if (t < 3 * n1_) {
        int which = t / n1_; t %= n1_;
        int l = t / 256, rem = t % 256;
        const float* s = which == 0 ? P.w_pa : (which == 1 ? P.w_pb : P.w_out);
        u16* d = which == 0 ? P.WpaT : (which == 1 ? P.WpbT : P.WoT);
        transpose_tile(s + (size_t)l * DM * DM, d + (size_t)l * DM * DM, DM, DM, (rem >> 4) * 64, (rem & 15) * 64, tile, tid);
        continue;
      }
      t -= 3 * n1_;
      if (t < 2 * n2_) {
        int kv = t / n2_; t %= n2_;
        int l = t / 64, rem = t % 64;
        const float* s = kv ? P.w1_v : P.w1_k;
        transpose_tile(s + (size_t)l * 2048 * 128, P.W1T + (size_t)(l * 2 + kv) * 128 * 2048, 2048, 128, (rem >> 1) * 64, (rem & 1) * 64, tile, tid);
        continue;
      }
      t -= 2 * n2_;
      {
        int kv = t / n3_; t %= n3_;
        int l = t / 2, rem = t % 2;
        const float* s = kv ? P.w2_v : P.w2_k;
        transpose_tile(s + (size_t)l * 128 * 64, P.W2T + (size_t)(l * 2 + kv) * 64 * 128, 128, 64, rem * 64, 0, tile, tid);
      }
    } else if (it < nT + nBias) {
      int j = it - nT;
      int l = j >> 4, kv = (j >> 3) & 1, kq = j & 7;
      const float* pe = (kv ? P.pe_v : P.pe_k) + (size_t)l * 2048;
      const float* w1 = (kv ? P.w1_v : P.w1_k) + (size_t)l * 2048 * 128;
      int hid = tid & 127, kh = tid >> 7;
      int kbeg = kq * 256 + kh * 64;
      float s = 0.f;
#pragma unroll 8
      for (int k = 0; k < 64; k++) s += pe[kbeg + k] * w1[(size_t)(kbeg + k) * 128 + hid];
      float* part = (float*)smem;
      part[tid] = s;
      __syncthreads();
      if (tid < 128) P.bias1p[((l * 2 + kv) * 8 + kq) * 128 + hid] = (part[tid] + part[tid + 128]) + (part[tid + 256] + part[tid + 384]);
      __syncthreads();
    } else if (it < nT + nBias + nRope) {
      int idx = (it - nT - nBias) * 512 + tid;
      int t = idx >> 5, j = idx & 31;
      double inv = 1.0;
      for (int q = 0; q < j; q++) inv *= 0.7498942093324558;
      float invf = (float)inv;
      float angf = (float)t * invf;
      double a = (double)angf;
      double kq = rint(a * 0.15915494309189535);
      double rr = a - kq * 6.283185307179586;
      double r2 = rr * rr;
      double sterm = rr, cterm = 1.0, ssum = rr, csum = 1.0;
#pragma unroll 1
      for (int n = 1; n <= 15; n++) {
        cterm *= -r2 / (double)((2 * n - 1) * (2 * n));
        sterm *= -r2 / (double)((2 * n) * (2 * n + 1));
        csum += cterm; ssum += sterm;
      }
      P.ropec[idx] = (float)csum;
      P.ropes[idx] = (float)ssum;
    } else {
      if (tid < 256) P.ctr[tid] = 0u;
      for (int i = tid; i < XB_WORDS; i += NTHREADS) P.xbar[i] = 0u;
    }
  }
}

__device__ void norm_phase(const float* __restrict__ xsrc, const float* __restrict__ g, u16* __restrict__ hdst, int nrows) {
  const int tid = opaque_tid();
  const int lane = tid & 63;
  const int gw = blockIdx.x * 8 + (tid >> 6), nw = gridDim.x * 8;
  float4 gv[4];
#pragma unroll
  for (int j = 0; j < 4; j++) gv[j] = *(const float4*)(g + lane * 4 + 256 * j);
  for (int row = gw; row < nrows; row += 2 * nw) {
    const float* xr0 = xsrc + (size_t)row * DM;
    const float* xr1 = xsrc + (size_t)(row + nw) * DM;
    float4 v0[4], v1[4];
#pragma unroll
    for (int j = 0; j < 4; j++) { v0[j] = *(const float4*)(xr0 + lane * 4 + 256 * j); v1[j] = *(const float4*)(xr1 + lane * 4 + 256 * j); }
    float s0 = 0.f, s1 = 0.f;
#pragma unroll
    for (int j = 0; j < 4; j++) {
      s0 += v0[j].x * v0[j].x + v0[j].y * v0[j].y + v0[j].z * v0[j].z + v0[j].w * v0[j].w;
      s1 += v1[j].x * v1[j].x + v1[j].y * v1[j].y + v1[j].z * v1[j].z + v1[j].w * v1[j].w;
    }
#pragma unroll
    for (int o = 32; o >= 1; o >>= 1) { s0 += __shfl_xor(s0, o); s1 += __shfl_xor(s1, o); }
    const float r0 = rsqrtf(s0 * (1.f / DM) + 1e-6f), r1 = rsqrtf(s1 * (1.f / DM) + 1e-6f);
#pragma unroll
    for (int j = 0; j < 4; j++) {
      uint2 o;
      o.x = pk2(v0[j].x * r0 * gv[j].x, v0[j].y * r0 * gv[j].y);
      o.y = pk2(v0[j].z * r0 * gv[j].z, v0[j].w * r0 * gv[j].w);
      *(uint2*)(hdst + (size_t)row * DM + lane * 4 + 256 * j) = o;
      o.x = pk2(v1[j].x * r1 * gv[j].x, v1[j].y * r1 * gv[j].y);
      o.y = pk2(v1[j].z * r1 * gv[j].z, v1[j].w * r1 * gv[j].w);
      *(uint2*)(hdst + (size_t)(row + nw) * DM + lane * 4 + 256 * j) = o;
    }
  }
}

__device__ void final_norm_phase(float* __restrict__ x, const float* __restrict__ g, int row0, int nrows) {
  const int tid = opaque_tid();
  const int lane = tid & 63;
  const int gw = blockIdx.x * 8 + (tid >> 6), nw = gridDim.x * 8;
  float4 gv[4];
#pragma unroll
  for (int j = 0; j < 4; j++) gv[j] = *(const float4*)(g + lane * 4 + 256 * j);
  for (int row = gw; row < nrows; row += nw) {
    float* xr = x + (size_t)(row0 + row) * DM;
    float4 v[4];
    float ss = 0.f;
#pragma unroll
    for (int j = 0; j < 4; j++) {
      v[j] = *(const float4*)(xr + lane * 4 + 256 * j);
      ss += v[j].x * v[j].x + v[j].y * v[j].y + v[j].z * v[j].z + v[j].w * v[j].w;
    }
#pragma unroll
    for (int o = 32; o >= 1; o >>= 1) ss += __shfl_xor(ss, o);
    float rstd = rsqrtf(ss * (1.f / DM) + 1e-6f);
#pragma unroll
    for (int j = 0; j < 4; j++) {
      float4 o;
      o.x = v[j].x * rstd * gv[j].x; o.y = v[j].y * rstd * gv[j].y;
      o.z = v[j].z * rstd * gv[j].z; o.w = v[j].w * rstd * gv[j].w;
      *(float4*)(xr + lane * 4 + 256 * j) = o;
    }
  }
}

struct ARow {
  const u16* p; int ld;
  __device__ __forceinline__ const u16* operator()(int row, int k) const { return p + (size_t)row * ld + k; }
};
struct ACmp {
  const u16* p;
  __device__ __forceinline__ const u16* operator()(int row, int k) const {
    int t = 16 * row + (k >> 6); t = t > (TSEQ - 1) ? (TSEQ - 1) : t;
    return p + (size_t)t * INC + (k & 63);
  }
};

template <class AF>
__device__ __forceinline__ void gemm_mainloop(AF af, const u16* __restrict__ Bt, int ldb, int K, char* smem,
                                              f32x16 (&acc)[2][2], const int tid) {
  const int lane = tid & 63, r = lane & 31, h = lane >> 5, w = tid >> 6;
  const int wm = w >> 1, wn = w & 1;
  const int lrow = tid >> 3, lch = tid & 7;
  uint4 ra[4], rb[4];
  const int nk = K >> 6;
#pragma unroll
  for (int j = 0; j < 4; j++) {
    int row = lrow + 32 * j;
    ra[j] = *(const uint4*)af(row, lch * 8);
    rb[j] = *(const uint4*)(Bt + (size_t)row * ldb + lch * 8);
  }
#pragma unroll
  for (int j = 0; j < 4; j++) {
    int row = lrow + 32 * j;
    int off = row * 128 + ((lch ^ ((row >> 1) & 7)) << 4);
    *(uint4*)(smem + off) = ra[j];
    *(uint4*)(smem + 16384 + off) = rb[j];
  }
  __syncthreads();
  for (int it = 0; it < nk; it++) {
    const bool more = (it + 1) < nk;
    if (more) {
      const int k0 = (it + 1) * 64;
#pragma unroll
      for (int j = 0; j < 4; j++) {
        int row = lrow + 32 * j;
        ra[j] = *(const uint4*)af(row, k0 + lch * 8);
        rb[j] = *(const uint4*)(Bt + (size_t)row * ldb + k0 + lch * 8);
      }
    }
    const char* sa = smem + (it & 1) * 32768;
    const char* sb = sa + 16384;
#pragma unroll
    for (int kk = 0; kk < 4; kk++) {
      bf16x8 a[2], b[2];
#pragma unroll
      for (int mi = 0; mi < 2; mi++) {
        int row = wm * 64 + mi * 32 + r;
        a[mi] = ldfrag(sa + row * 128 + (((kk * 2 + h) ^ ((row >> 1) & 7)) << 4));
      }
#pragma unroll
      for (int ni = 0; ni < 2; ni++) {
        int row = wn * 64 + ni * 32 + r;
        b[ni] = ldfrag(sb + row * 128 + (((kk * 2 + h) ^ ((row >> 1) & 7)) << 4));
      }
#pragma unroll
      for (int mi = 0; mi < 2; mi++)
#pragma unroll
        for (int ni = 0; ni < 2; ni++) acc[mi][ni] = mfma32(a[mi], b[ni], acc[mi][ni]);
    }
    if (more) {
      char* sd = smem + ((it + 1) & 1) * 32768;
#pragma unroll
      for (int j = 0; j < 4; j++) {
        int row = lrow + 32 * j;
        int off = row * 128 + ((lch ^ ((row >> 1) & 7)) << 4);
        *(uint4*)(sd + off) = ra[j];
        *(uint4*)(sd + 16384 + off) = rb[j];
      }
    }
    __syncthreads();
  }
}

__device__ __forceinline__ void zero_acc(f32x16 (&acc)[2][2]) {
#pragma unroll
  for (int a = 0; a < 2; a++)
#pragma unroll
    for (int b = 0; b < 2; b++)
#pragma unroll
      for (int i = 0; i < 16; i++) acc[a][b][i] = 0.f;
}

typedef __attribute__((ext_vector_type(8))) short s16x8;
#define G_TILE_B 32768
#define G_STAGE_B 65536
__device__ __forceinline__ int g_lds_byte(int r, int c) {
  int st = (r >> 4) * 2 + (c >> 5), ob = (r & 15) * 64 + (c & 31) * 2;
  return st * 1024 + (ob ^ (((ob >> 9) & 1) << 5));
}
__device__ __forceinline__ void g_stage_rc(int b, int& R, int& C) {
  int st = b >> 10, sb = b & 1023, swz = sb ^ (((sb >> 9) & 1) << 5);
  R = (st >> 1) * 16 + swz / 64;
  C = (st & 1) * 32 + (swz % 64) / 2;
}
#define G_WAIT_V0() asm volatile("s_waitcnt vmcnt(0)" ::: "memory")

struct GTile { int pm, pn; };
__device__ __forceinline__ bool g_next(int i, int G, int c, int nM, int nN, GTile& u) {
  const int nwg = nM * nN;
  const int L = i * G + c;
  if (L >= nwg) return false;
  int wgid = L;
  { const int q = nwg / 8, r = nwg % 8, xcd = wgid % 8, off = wgid / 8; wgid = (xcd < r ? xcd * (q + 1) : r * (q + 1) + (xcd - r) * q) + off; }
  const int nig = 4 * nN, gid = wgid / nig, fm = gid * 4, gsz = (nM - fm) < 4 ? (nM - fm) : 4;
  u.pm = fm + ((wgid % nig) % gsz);
  u.pn = (wgid % nig) / gsz;
  return true;
}

__device__ __forceinline__ void g_kloop(const u16* __restrict__ Ab, const u16* __restrict__ Bb, const int K, char* smem,
                                        f32x4 (&acc)[8][4], const int tid, const bool pre, const u16* __restrict__ nA,
                                        const u16* __restrict__ nB, const bool has_next) {
  const int wid = tid >> 6, lane = tid & 63, wr = wid >> 2, wc = wid & 3, fr = lane & 15, fq = lane >> 4;
  int sR0, sC0, sR1, sC1, sR2, sC2, sR3, sC3;
  g_stage_rc(wid * 1024 + 0 * 8192 + lane * 16, sR0, sC0);
  g_stage_rc(wid * 1024 + 1 * 8192 + lane * 16, sR1, sC1);
  g_stage_rc(wid * 1024 + 2 * 8192 + lane * 16, sR2, sC2);
  g_stage_rc(wid * 1024 + 3 * 8192 + lane * 16, sR3, sC3);
  const long o0 = (long)sR0 * K + sC0, o1 = (long)sR1 * K + sC1, o2 = (long)sR2 * K + sC2, o3 = (long)sR3 * K + sC3;
#define G_STAGE(buf, kt)                                                                                              \
  {                                                                                                                  \
    char* sa_ = smem + (buf) * G_STAGE_B + wid * 1024;                                                               \
    char* sb_ = sa_ + G_TILE_B;                                                                                      \
    const u16* ga_ = Ab + (kt) * 64;                                                                                 \
    const u16* gb_ = Bb + (kt) * 64;                                                                                 \
    __builtin_amdgcn_global_load_lds((const unsigned*)(ga_ + o0), (unsigned*)(sa_), 16, 0, 0);                       \
    __builtin_amdgcn_global_load_lds((const unsigned*)(gb_ + o0), (unsigned*)(sb_), 16, 0, 0);                       \
    __builtin_amdgcn_global_load_lds((const unsigned*)(ga_ + o1), (unsigned*)(sa_ + 8192), 16, 0, 0);                \
    __builtin_amdgcn_global_load_lds((const unsigned*)(gb_ + o1), (unsigned*)(sb_ + 8192), 16, 0, 0);                \
    __builtin_amdgcn_global_load_lds((const unsigned*)(ga_ + o2), (unsigned*)(sa_ + 16384), 16, 0, 0);               \
    __builtin_amdgcn_global_load_lds((const unsigned*)(gb_ + o2), (unsigned*)(sb_ + 16384), 16, 0, 0);               \
    __builtin_amdgcn_global_load_lds((const unsigned*)(ga_ + o3), (unsigned*)(sa_ + 24576), 16, 0, 0);               \
    __builtin_amdgcn_global_load_lds((const unsigned*)(gb_ + o3), (unsigned*)(sb_ + 24576), 16, 0, 0);               \
  }
  const int nt = K >> 6;
  if (!pre) {
    G_STAGE(0, 0);
    G_WAIT_V0();
    __syncthreads();
  }
  for (int t = 0; t < nt; ++t) {
    const int cur = t & 1;
    if (t + 1 < nt) G_STAGE(cur ^ 1, t + 1)
    else if (has_next) {
      char* sa_ = smem + wid * 1024;
      char* sb_ = sa_ + G_TILE_B;
      __builtin_amdgcn_global_load_lds((const unsigned*)(nA + o0), (unsigned*)(sa_), 16, 0, 0);
      __builtin_amdgcn_global_load_lds((const unsigned*)(nB + o0), (unsigned*)(sb_), 16, 0, 0);
      __builtin_amdgcn_global_load_lds((const unsigned*)(nA + o1), (unsigned*)(sa_ + 8192), 16, 0, 0);
      __builtin_amdgcn_global_load_lds((const unsigned*)(nB + o1), (unsigned*)(sb_ + 8192), 16, 0, 0);
      __builtin_amdgcn_global_load_lds((const unsigned*)(nA + o2), (unsigned*)(sa_ + 16384), 16, 0, 0);
      __builtin_amdgcn_global_load_lds((const unsigned*)(nB + o2), (unsigned*)(sb_ + 16384), 16, 0, 0);
      __builtin_amdgcn_global_load_lds((const unsigned*)(nA + o3), (unsigned*)(sa_ + 24576), 16, 0, 0);
      __builtin_amdgcn_global_load_lds((const unsigned*)(nB + o3), (unsigned*)(sb_ + 24576), 16, 0, 0);
    }
    const char* sa = smem + cur * G_STAGE_B;
    const char* sb = sa + G_TILE_B;
#pragma unroll
    for (int ks = 0; ks < 2; ++ks) {
      s16x8 At[8], Bf[4];
#pragma unroll
      for (int m = 0; m < 8; ++m) At[m] = *(const s16x8*)(sa + g_lds_byte(wr * 128 + m * 16 + fr, ks * 32 + fq * 8));
#pragma unroll
      for (int n = 0; n < 4; ++n) Bf[n] = *(const s16x8*)(sb + g_lds_byte(wc * 64 + n * 16 + fr, ks * 32 + fq * 8));
#pragma unroll
      for (int m = 0; m < 8; ++m)
#pragma unroll
        for (int n = 0; n < 4; ++n)
          acc[m][n] = __builtin_amdgcn_mfma_f32_16x16x32_bf16(__builtin_bit_cast(bf16x8, Bf[n]), __builtin_bit_cast(bf16x8, At[m]), acc[m][n], 0, 0, 0);
    }
    G_WAIT_V0();
    __syncthreads();
  }
}

__device__ __forceinline__ void g_zero(f32x4 (&acc)[8][4]) {
#pragma unroll
  for (int m = 0; m < 8; m++)
#pragma unroll
    for (int n = 0; n < 4; n++) acc[m][n] = (f32x4){0.f, 0.f, 0.f, 0.f};
}
__device__ __forceinline__ uint2 pk4(f32x4 v) { return make_uint2(pk2(v[0], v[1]), pk2(v[2], v[3])); }

__device__ __forceinline__ void wave_store_rows(char* wsm, u16* gbase, const size_t ld, const f32x4 (&acc)[8][4], const int lane) {
  const int fr = lane & 15, fq = lane >> 4;
  const int rr = lane >> 3, ch = lane & 7;
  typedef __attribute__((ext_vector_type(4))) unsigned u32x4_t;
#pragma unroll
  for (int hf = 0; hf < 2; hf++) {
#pragma unroll
    for (int m = 0; m < 4; m++)
#pragma unroll
      for (int n = 0; n < 4; n++) {
        const int row = m * 16 + fr, chunk = n * 2 + (fq >> 1);
        *(uint2*)(wsm + row * 128 + ((chunk ^ (fr & 7)) << 4) + (fq & 1) * 8) = pk4(acc[hf * 4 + m][n]);
      }
#pragma unroll
    for (int i = 0; i < 8; i++) {
      const int row = i * 8 + rr;
      const uint4 v = *(const uint4*)(wsm + row * 128 + ((ch ^ (row & 7)) << 4));
      __builtin_nontemporal_store(__builtin_bit_cast(u32x4_t, v), (u32x4_t*)(gbase + (size_t)(hf * 64 + row) * ld + ch * 8));
    }
  }
}
__device__ __forceinline__ void wave_store_cols(char* wsm, u16* vt, const int vcol0, const int nh, const int bl, const int t0,
                                                const f32x4 (&acc)[8][4], const int lane) {
  const int fr = lane & 15, fq = lane >> 4;
#pragma unroll
  for (int m = 0; m < 8; m++)
#pragma unroll
    for (int n = 0; n < 4; n++)
#pragma unroll
      for (int j = 0; j < 4; j++) {
        const int d = n * 16 + fq * 4 + j, t = m * 16 + fr;
        *(u16*)(wsm + d * 256 + (((t >> 3) ^ (d & 15)) << 4) + (t & 7) * 2) = f2bf(acc[m][n][j]);
      }
  const int dd = lane >> 4, ch = lane & 15;
#pragma unroll
  for (int i = 0; i < 16; i++) {
    const int d = i * 4 + dd;
    const uint4 v = *(const uint4*)(wsm + d * 256 + ((ch ^ (d & 15)) << 4));
    const int vcol = vcol0 + d;
    *(uint4*)(vt + ((size_t)(bl * nh + (vcol >> 6)) * 64 + (vcol & 63)) * TSEQ + t0 + ch * 8) = v;
  }
}

__device__ void gemm1_phase(const Params& P, int layer, char* smem) {
  const int CT = P.NB * TSEQ;
  const int nM = CT >> 8, nN = INCP >> 8;
  const u16* Bt = P.WinT + (size_t)layer * INCP * DM;
  u16* p_qr = P.qr; u16* p_proj = P.proj;
  asm volatile("" : "+s"(p_qr), "+s"(p_proj));
  for (int i = 0;; i++) {
    GTile u, un;
    if (!g_next(i, gridDim.x, blockIdx.x, nM, nN, u)) break;
    const bool hn = g_next(i + 1, gridDim.x, blockIdx.x, nM, nN, un);
    const int tid = opaque_tid(), wid = tid >> 6, lane = tid & 63, wr = wid >> 2, wc = wid & 3, fr = lane & 15, fq = lane >> 4;
    f32x4 acc[8][4];
    g_zero(acc);
    g_kloop(P.h + (size_t)(u.pm * 256) * DM, Bt + (size_t)(u.pn * 256) * DM, DM, smem, acc, tid, i > 0,
            P.h + (size_t)(un.pm * 256) * DM, Bt + (size_t)(un.pn * 256) * DM, hn);
    const int cw = u.pn * 256 + wc * 64;
    const int row0 = u.pm * 256 + wr * 128 + fr;
    char* wsm = smem + G_STAGE_B + wid * 8192;
    const int rowb = u.pm * 256 + wr * 128;
    const bool rope_q = cw < 1024;
    const bool rope_k = (cw >= C_KV + 256 && cw < C_KV + 384) || (cw >= C_KV + 512 && cw < C_KV + 640);
    const bool mixed = (cw == 5888);
    if (cw >= INC) {
    } else if (rope_q || rope_k) {
      if (rope_q) wave_store_rows(wsm, p_proj + (size_t)rowb * INC + cw, INC, acc, lane);
#pragma unroll
      for (int m = 0; m < 8; m++) {
        const int tt = (row0 + m * 16) & (TSEQ - 1);
#pragma unroll
        for (int n = 0; n < 2; n++) {
          const float4 c = *(const float4*)(P.ropec + tt * 32 + n * 16 + fq * 4);
          const float4 sn = *(const float4*)(P.ropes + tt * 32 + n * 16 + fq * 4);
          const f32x4 x1 = acc[m][n], x2 = acc[m][n + 2];
          f32x4 r1, r2;
          r1[0] = x1[0] * c.x - x2[0] * sn.x; r2[0] = x2[0] * c.x + x1[0] * sn.x;
          r1[1] = x1[1] * c.y - x2[1] * sn.y; r2[1] = x2[1] * c.y + x1[1] * sn.y;
          r1[2] = x1[2] * c.z - x2[2] * sn.z; r2[2] = x2[2] * c.z + x1[2] * sn.z;
          r1[3] = x1[3] * c.w - x2[3] * sn.w; r2[3] = x2[3] * c.w + x1[3] * sn.w;
          acc[m][n] = r1; acc[m][n + 2] = r2;
        }
      }
      if (rope_q) wave_store_rows(wsm, p_qr + (size_t)rowb * DM + cw, DM, acc, lane);
      else wave_store_rows(wsm, p_proj + (size_t)rowb * INC + cw, INC, acc, lane);
    } else if (!mixed) {
      wave_store_rows(wsm, p_proj + (size_t)rowb * INC + cw, INC, acc, lane);
    } else {
#pragma unroll
      for (int n = 0; n < 4; n++) {
        const int c0 = cw + n * 16 + fq * 4;
        if (c0 < C_FB) {
#pragma unroll
          for (int m = 0; m < 8; m++) *(uint2*)(p_proj + (size_t)(row0 + m * 16) * INC + c0) = pk4(acc[m][n]);
        } else {
#pragma unroll
          for (int m = 0; m < 8; m++)
            *(float4*)(P.flog + (size_t)(row0 + m * 16) * 16 + (c0 - C_FB)) = make_float4(acc[m][n][0], acc[m][n][1], acc[m][n][2], acc[m][n][3]);
        }
        __builtin_amdgcn_sched_barrier(0);
      }
    }
    __syncthreads();
  }
}

__device__ void gemm2_phase(const Params& P, int layer, char* smem) {
  const int CT = P.NB * TSEQ;
  const int nM = CT >> 8, nN = 4;
  const u16* p_ya = P.ya; const u16* p_yb = P.yb; const u16* p_wa = P.WpaT; const u16* p_wb = P.WpbT;
  for (int i = 0;; i++) {
    GTile u, un;
    if (!g_next(i, gridDim.x, blockIdx.x, nM, nN, u)) break;
    const bool hn = g_next(i + 1, gridDim.x, blockIdx.x, nM, nN, un);
    const int tid = opaque_tid(), wid = tid >> 6, lane = tid & 63, wr = wid >> 2, wc = wid & 3, fr = lane & 15, fq = lane >> 4;
    f32x4 acc[8][4];
    g_zero(acc);
#pragma unroll 1
    for (int pass = 0; pass < 2; pass++) {
      const u16* Ap = (pass ? p_yb : p_ya) + (size_t)(u.pm * 256) * DM;
      const u16* Bp = (pass ? p_wb : p_wa) + (size_t)layer * DM * DM + (size_t)(u.pn * 256) * DM;
      const u16* nAp = pass ? (p_ya + (size_t)(un.pm * 256) * DM) : (p_yb + (size_t)(u.pm * 256) * DM);
      const u16* nBp = pass ? (p_wa + (size_t)layer * DM * DM + (size_t)(un.pn * 256) * DM) : (p_wb + (size_t)layer * DM * DM + (size_t)(u.pn * 256) * DM);
      g_kloop(Ap, Bp, DM, smem, acc, tid, (i > 0) || (pass > 0), nAp, nBp, pass ? hn : true);
      __builtin_amdgcn_sched_barrier(0);
      if (pass == 0) {
        const int tid1 = opaque_tid(), wid1 = tid1 >> 6, lane1 = tid1 & 63, wr1 = wid1 >> 2, wc1 = wid1 & 3, fr1 = lane1 & 15, fq1 = lane1 >> 4;
        const u16* pp = P.proj + (size_t)(u.pm * 256 + wr1 * 128 + fr1) * INC + u.pn * 256 + wc1 * 64 + fq1 * 4;
#pragma unroll
        for (int m = 0; m < 8; m++) {
#pragma unroll
          for (int n = 0; n < 4; n++) {
            const uint2 ra = *(const uint2*)(pp + (size_t)(m * 16) * INC + C_RA + n * 16);
            const uint2 rb = *(const uint2*)(pp + (size_t)(m * 16) * INC + C_RB + n * 16);
            acc[m][n][0] *= (1.f + __expf(-bflo(rb.x))) * __builtin_amdgcn_rcpf(1.f + __expf(-bflo(ra.x)));
            acc[m][n][1] *= (1.f + __expf(-bfhi(rb.x))) * __builtin_amdgcn_rcpf(1.f + __expf(-bfhi(ra.x)));
            acc[m][n][2] *= (1.f + __expf(-bflo(rb.y))) * __builtin_amdgcn_rcpf(1.f + __expf(-bflo(ra.y)));
            acc[m][n][3] *= (1.f + __expf(-bfhi(rb.y))) * __builtin_amdgcn_rcpf(1.f + __expf(-bfhi(ra.y)));
          }
          __builtin_amdgcn_sched_barrier(0);
        }
      }
    }
    {
      const int tid2 = opaque_tid(), wid2 = tid2 >> 6, lane2 = tid2 & 63, wr2 = wid2 >> 2, wc2 = wid2 & 3, fr2 = lane2 & 15, fq2 = lane2 >> 4;
      const u16* pp = P.proj + (size_t)(u.pm * 256 + wr2 * 128 + fr2) * INC + u.pn * 256 + wc2 * 64 + fq2 * 4;
#pragma unroll
      for (int m = 0; m < 8; m++) {
#pragma unroll
        for (int n = 0; n < 4; n++) {
          const uint2 rb = *(const uint2*)(pp + (size_t)(m * 16) * INC + C_RB + n * 16);
          acc[m][n][0] *= sigmoidf_(bflo(rb.x)); acc[m][n][1] *= sigmoidf_(bfhi(rb.x));
          acc[m][n][2] *= sigmoidf_(bflo(rb.y)); acc[m][n][3] *= sigmoidf_(bfhi(rb.y));
        }
        __builtin_amdgcn_sched_barrier(0);
      }
      wave_store_rows(smem + G_STAGE_B + wid2 * 8192, P.h + (size_t)(u.pm * 256 + wr2 * 128) * DM + u.pn * 256 + wc2 * 64, DM, acc, lane2);
    }
    __syncthreads();
  }
}

__device__ void gemm3_phase(const Params& P, int layer, int chunk, char* smem) {
  const int CT = P.NB * TSEQ;
  const int nM = CT >> 8, nN = 4;
  const float* xs = (layer == 0 ? P.x_in : P.out) + (size_t)chunk * CT * DM;
  float* xd = P.out + (size_t)chunk * CT * DM;
  for (int i = 0;; i++) {
    GTile u, un;
    if (!g_next(i, gridDim.x, blockIdx.x, nM, nN, u)) break;
    const bool hn = g_next(i + 1, gridDim.x, blockIdx.x, nM, nN, un);
    const int tid = opaque_tid(), wid = tid >> 6, lane = tid & 63, wr = wid >> 2, wc = wid & 3, fr = lane & 15, fq = lane >> 4;
    f32x4 acc[8][4];
    g_zero(acc);
    g_kloop(P.h + (size_t)(u.pm * 256) * DM, P.WoT + (size_t)layer * DM * DM + (size_t)(u.pn * 256) * DM, DM, smem, acc, tid, i > 0,
            P.h + (size_t)(un.pm * 256) * DM, P.WoT + (size_t)layer * DM * DM + (size_t)(un.pn * 256) * DM, hn);
    const size_t off = (size_t)(u.pm * 256 + wr * 128 + fr) * DM + u.pn * 256 + wc * 64 + fq * 4;
#pragma unroll
    for (int m = 0; m < 8; m++) {
#pragma unroll
      for (int n = 0; n < 4; n++) {
        const float4 xo = *(const float4*)(xs + off + (size_t)(m * 16) * DM + n * 16);
        *(float4*)(xd + off + (size_t)(m * 16) * DM + n * 16) =
            make_float4(xo.x + acc[m][n][0], xo.y + acc[m][n][1], xo.z + acc[m][n][2], xo.w + acc[m][n][3]);
      }
      __builtin_amdgcn_sched_barrier(0);
    }
  }
}

__device__ __forceinline__ void compress_item(const Params& P, const int layer, const int it, char* smem_all, const int tid_all) {
  const int half = tid_all >> 8, tid = tid_all & 255;
  char* smem = smem_all + half * 65536;
  const int lane = tid & 63, r = lane & 31, h = lane >> 5, w = tid >> 6;
  const int wm = w >> 1, wn = w & 1;
  const int unit = it * 2 + half;
  const int bl = unit >> 2, g = (unit >> 1) & 1, kv = unit & 1;
  f32x16 acc[2][2];
  zero_acc(acc);
  ACmp af{P.proj + (size_t)bl * TSEQ * INC + C_KV + kv * 128 + g * 64};
  gemm_mainloop(af, P.W1T + (size_t)(layer * 2 + kv) * 128 * 2048, 2048, 2048, smem, acc, tid);
  const float* bp = P.bias1p + (size_t)((layer * 2 + kv) * 8) * 128;
#pragma unroll
  for (int ni = 0; ni < 2; ni++) {
    int hc = wn * 64 + ni * 32 + r;
    float b1 = 0.f;
#pragma unroll
    for (int q = 0; q < 8; q++) b1 += bp[q * 128 + hc];
#pragma unroll
    for (int mi = 0; mi < 2; mi++)
#pragma unroll
      for (int i = 0; i < 16; i++) {
        int n = wm * 64 + mi * 32 + 8 * (i >> 2) + 4 * h + (i & 3);
        float v = siluf_(acc[mi][ni][i] + b1);
        *(u16*)(smem + n * 256 + (((hc >> 3) ^ (n & 15)) << 4) + (hc & 7) * 2) = f2bf(v);
      }
  }
  __syncthreads();
  const u16* w2t = P.W2T + (size_t)(layer * 2 + kv) * 64 * 128;
  f32x16 o2[2];
#pragma unroll
  for (int dt = 0; dt < 2; dt++)
#pragma unroll
    for (int i = 0; i < 16; i++) o2[dt][i] = 0.f;
#pragma unroll
  for (int kk = 0; kk < 8; kk++) {
    int n = w * 32 + r;
    bf16x8 a = ldfrag(smem + n * 256 + (((kk * 2 + h) ^ (n & 15)) << 4));
#pragma unroll
    for (int dt = 0; dt < 2; dt++) {
      bf16x8 b = ldfrag(w2t + (size_t)(dt * 32 + r) * 128 + kk * 16 + h * 8);
      o2[dt] = mfma32(a, b, o2[dt]);
    }
  }
#pragma unroll
  for (int dt = 0; dt < 2; dt++) {
    int d = dt * 32 + r;
    if (kv == 0) {
#pragma unroll
      for (int i = 0; i < 16; i++) {
        int n = w * 32 + 8 * (i >> 2) + 4 * h + (i & 3);
        P.kcmp[((size_t)(bl * 2 + g) * 128 + n) * 64 + d] = f2bf(o2[dt][i]);
      }
    } else {
#pragma unroll
      for (int gq = 0; gq < 4; gq++) {
        int n0 = w * 32 + 8 * gq + 4 * h;
        uint2 o;
        o.x = pk2(o2[dt][gq * 4 + 0], o2[dt][gq * 4 + 1]);
        o.y = pk2(o2[dt][gq * 4 + 2], o2[dt][gq * 4 + 3]);
        *(uint2*)(P.vcmpt + ((size_t)(bl * 2 + g) * 64 + d) * 128 + n0) = o;
      }
    }
  }
  __syncthreads();
}

__device__ void pb_phase(const Params& P, int layer, char* smem_all) {
  const int tid = opaque_tid();
  const int lane = tid & 63, w = tid >> 6;
  float* wsum = (float*)smem_all;
  const int nScan = P.NB * 16;
  for (int it = blockIdx.x; it < nScan; it += gridDim.x) {
    const int bl = it >> 4, hh = it & 15;
    const float bf = P.b_forget[layer * 16 + hh];
    const float* fl = P.flog + ((size_t)bl * TSEQ + tid * 4) * 16 + hh;
    float ls[4];
#pragma unroll
    for (int j = 0; j < 4; j++) {
      const float x = fl[j * 16] + bf;
      ls[j] = (x >= 0.f) ? -log1pf(__expf(-x)) : (x - log1pf(__expf(x)));
    }
    const float loc = (ls[0] + ls[1]) + (ls[2] + ls[3]);
    float incl = loc;
#pragma unroll
    for (int o = 1; o < 64; o <<= 1) {
      const float v = __shfl_up(incl, o);
      if (lane >= o) incl += v;
    }
    __syncthreads();
    if (lane == 63) wsum[w] = incl;
    __syncthreads();
    float base = 0.f;
#pragma unroll
    for (int q = 0; q < 8; q++) base += (q < w) ? wsum[q] : 0.f;
    float run = base + incl - loc;
    float4 o4;
    run += ls[0]; o4.x = -8.0f * run;
    run += ls[1]; o4.y = -8.0f * run;
    run += ls[2]; o4.z = -8.0f * run;
    run += ls[3]; o4.w = -8.0f * run;
    *(float4*)(P.F2 + ((size_t)bl * 16 + hh) * TSEQ + tid * 4) = o4;
  }
}

__device__ void pc1_phase(const Params& P, char* smem) {
  const int tid = opaque_tid(),  lane = tid & 63, r = lane & 31, h = lane >> 5, w = tid >> 6;
  const int nItems = P.NB * 2 * 8;
  const float c1 = 0.125f * LOG2E;
  for (int it = blockIdx.x; it < nItems; it += gridDim.x) {
    const int qt = it & 7, g = (it >> 3) & 1, bl = it >> 4;
    __syncthreads();
#pragma unroll
    for (int j = 0; j < 2; j++) {
      int c = tid + 512 * j;
      {
        int n = c >> 3, ch = c & 7;
        uint4 v = *(const uint4*)(P.kcmp + ((size_t)(bl * 2 + g) * 128 + n) * 64 + ch * 8);
        *(uint4*)(smem + n * 128 + ((ch ^ ((n >> 1) & 7)) << 4)) = v;
      }
      {
        int d = c >> 4, ch = c & 15;
        uint4 v = *(const uint4*)(P.vcmpt + ((size_t)(bl * 2 + g) * 64 + d) * 128 + ch * 8);
        int sw = d & 31;
        *(uint2*)(smem + 16384 + d * 256 + (((2 * ch) ^ sw) << 3)) = make_uint2(v.x, v.y);
        *(uint2*)(smem + 16384 + d * 256 + (((2 * ch + 1) ^ sw) << 3)) = make_uint2(v.z, v.w);
      }
    }
    __syncthreads();
    const int qw_lo = qt * 256 + w * 32;
    const int qtok = qw_lo + r;
    const size_t rowg = (size_t)bl * TSEQ + qtok;
    const int tq = qtok - 31 - 64 * h;
    float sumacc[16], lastacc[16];
#pragma unroll
    for (int s = 0; s < 16; s++) { sumacc[s] = 0.f; lastacc[s] = 0.f; }
#pragma unroll 1
    for (int hh = 0; hh < 8; hh++) {
      const int head = g * 8 + hh;
      bf16x8 qf[4];
#pragma unroll
      for (int kk = 0; kk < 4; kk++) qf[kk] = ldfrag(P.proj + rowg * INC + C_QA + head * 64 + kk * 16 + h * 8);
      f32x16 s[4];
#pragma unroll
      for (int nt = 0; nt < 4; nt++) {
#pragma unroll
        for (int i = 0; i < 16; i++) s[nt][i] = 0.f;
#pragma unroll
        for (int kk = 0; kk < 4; kk++) {
          int row = nt * 32 + r;
          bf16x8 a = ldfrag(smem + row * 128 + (((kk * 2 + h) ^ ((row >> 1) & 7)) << 4));
          s[nt] = mfma32(a, qf[kk], s[nt]);
        }
      }
      float mx = -3.0e38f;
#pragma unroll
      for (int nt = 0; nt < 4; nt++)
#pragma unroll
        for (int i = 0; i < 16; i++) {
          bool ok = (16 * (nt * 32 + 8 * (i >> 2) + (i & 3))) <= tq;
          float v = ok ? s[nt][i] * c1 : -3.0e38f;
          s[nt][i] = v;
          mx = fmaxf(mx, v);
        }
      mx = fmaxf(mx, __shfl_xor(mx, 32));
      const bool anyv = mx > -1.0e37f;
      float mref = anyv ? mx : 0.f;
      float l = 0.f;
#pragma unroll
      for (int nt = 0; nt < 4; nt++)
#pragma unroll
        for (int i = 0; i < 16; i++) {
          float p = __builtin_amdgcn_exp2f(s[nt][i] - mref);
          s[nt][i] = p;
          l += p;
        }
      l += __shfl_xor(l, 32);
      const float inv = (anyv && l > 0.f) ? 1.f / l : 0.f;
#pragma unroll
      for (int nt = 0; nt < 4; nt++)
#pragma unroll
        for (int i = 0; i < 16; i++) s[nt][i] *= inv;
#pragma unroll
      for (int nt = 0; nt < 4; nt++)
#pragma unroll
        for (int gq = 0; gq < 4; gq++) {
          sumacc[nt * 4 + gq] += (s[nt][gq * 4] + s[nt][gq * 4 + 1]) + (s[nt][gq * 4 + 2] + s[nt][gq * 4 + 3]);
          lastacc[nt * 4 + gq] += s[nt][gq * 4 + 3];
        }
      uint4 pbv[8];
#pragma unroll
      for (int ks = 0; ks < 8; ks++) {
        const int nt = ks >> 1, hb = (ks & 1) * 8;
        pbv[ks].x = pk2(s[nt][hb + 0], s[nt][hb + 1]); pbv[ks].y = pk2(s[nt][hb + 2], s[nt][hb + 3]);
        pbv[ks].z = pk2(s[nt][hb + 4], s[nt][hb + 5]); pbv[ks].w = pk2(s[nt][hb + 6], s[nt][hb + 7]);
      }
      const float g0 = sigmoidf_(bf2f(P.proj[rowg * INC + C_GA + head]));
#pragma unroll
      for (int dt = 0; dt < 2; dt++) {
        f32x16 o;
#pragma unroll
        for (int i = 0; i < 16; i++) o[i] = 0.f;
        const int d = dt * 32 + r, sw = d & 31;
#pragma unroll
        for (int ks = 0; ks < 8; ks++) {
          uint2 lo = *(const uint2*)(smem + 16384 + d * 256 + (((ks * 4 + h) ^ sw) << 3));
          uint2 hi = *(const uint2*)(smem + 16384 + d * 256 + (((ks * 4 + 2 + h) ^ sw) << 3));
          uint4 au = make_uint4(lo.x, lo.y, hi.x, hi.y);
          o = mfma32(__builtin_bit_cast(bf16x8, au), __builtin_bit_cast(bf16x8, pbv[ks]), o);
        }
#pragma unroll
        for (int gq = 0; gq < 4; gq++) {
          int d0 = dt * 32 + 8 * gq + 4 * h;
          uint2 ov;
          ov.x = pk2(o[gq * 4 + 0] * g0, o[gq * 4 + 1] * g0);
          ov.y = pk2(o[gq * 4 + 2] * g0, o[gq * 4 + 3] * g0);
          *(uint2*)(P.ya + rowg * DM + head * 64 + d0) = ov;
        }
        __builtin_amdgcn_sched_barrier(0);
      }
    }
    float sc[16];
#pragma unroll
    for (int s = 0; s < 16; s++) {
      float prev = (s == 0) ? 0.f : lastacc[s - 1];
      float sendv = h ? prev : lastacc[s];
      float recv = __shfl_xor(sendv, 32);
      float imp = sumacc[s] + recv;
      int j = (s >> 2) * 8 + (s & 3) * 2 + h;
      int cur = qtok >> 6;
      bool forced = (j == 0) || (j == cur) || (j == cur - 1);
      bool valid = j <= cur;
      sc[s] = forced ? 1.0e4f : (valid ? imp : -1.0f);
    }
    unsigned mask = 0u;
#pragma unroll 1
    for (int rd = 0; rd < 8; rd++) {
      float best = -2.0f; int bj = 0;
#pragma unroll
      for (int s = 0; s < 16; s++) {
        int j = (s >> 2) * 8 + (s & 3) * 2 + h;
        if (sc[s] > best) { best = sc[s]; bj = j; }
      }
      float ob = __shfl_xor(best, 32);
      int oj = __shfl_xor(bj, 32);
      bool mine = (best > ob) || (best == ob && bj < oj);
      int wj = mine ? bj : oj;
      mask |= 1u << wj;
#pragma unroll
      for (int s = 0; s < 16; s++) {
        int j = (s >> 2) * 8 + (s & 3) * 2 + h;
        if (j == wj) sc[s] = -3.0f;
      }
    }
    if (h == 0) P.sel[(size_t)(bl * 2 + g) * TSEQ + qtok] = mask;
  }
}

#define A_SLOTB 8192
#define A_LDS_K 0
#define A_LDS_V 24576
#define A_LDS_WS 49152
#define A_LDS_F 51200
#define A_LDS_OST 52224
#define A_THR 8.0f
#define A_C2 (0.125f * LOG2E)
typedef __attribute__((ext_vector_type(4))) short a_s16x4;
typedef __attribute__((ext_vector_type(8))) short a_s16x8;
typedef __attribute__((ext_vector_type(4))) unsigned a_u32x4;
typedef __attribute__((address_space(3))) const char* a_lds_cptr;
typedef short a_v4i16 __attribute__((ext_vector_type(4)));
#define A_SBAR() __builtin_amdgcn_sched_barrier(0)
#define A_PIN(x) asm volatile("" : "+v"(x))
#define A_MFMA(a, b, c) __builtin_amdgcn_mfma_f32_32x32x16_bf16(a, b, c, 0, 0, 0)
template <int N> __device__ __forceinline__ void a_wait_bar() { asm volatile("s_waitcnt vmcnt(%0) lgkmcnt(0)\n\ts_barrier" ::"n"(N) : "memory"); }
__device__ __forceinline__ int a_crow(int r, int hi) { return (r & 3) + 8 * (r >> 2) + 4 * hi; }
__device__ __forceinline__ unsigned a_cvtpk(float lo, float hi) { unsigned r; asm("v_cvt_pk_bf16_f32 %0, %1, %2" : "=v"(r) : "v"(lo), "v"(hi)); return r; }
__device__ __forceinline__ void a_glds16(const void* g, unsigned lds_base) {
  unsigned sv; asm volatile("s_mov_b32 %0, m0\n\ts_mov_b32 m0, %2\n\ts_nop 0\n\tglobal_load_lds_dwordx4 %1, off\n\ts_mov_b32 m0, %0" : "=&s"(sv) : "v"(g), "s"(lds_base) : "memory"); }
__device__ __forceinline__ void a_glds4(const void* g, unsigned lds_base) {
  unsigned sv; asm volatile("s_mov_b32 %0, m0\n\ts_mov_b32 m0, %2\n\ts_nop 0\n\tglobal_load_lds_dword %1, off\n\ts_mov_b32 m0, %0" : "=&s"(sv) : "v"(g), "s"(lds_base) : "memory"); }
__device__ __forceinline__ void a_kload2(bf16x8* kf, a_lds_cptr kp, int d0) {
  kf[2 * d0] = *(const __attribute__((address_space(3))) bf16x8*)(kp + d0 * 2048);
  kf[2 * d0 + 1] = *(const __attribute__((address_space(3))) bf16x8*)(kp + d0 * 2048 + 512); }
__device__ __forceinline__ a_s16x4 a_vtr(a_lds_cptr p) { return __builtin_bit_cast(a_s16x4, __builtin_amdgcn_ds_read_tr16_b64_v4i16((__attribute__((address_space(3))) a_v4i16*)p)); }
#define A_MX3(a, b, c) __builtin_fmaxf(__builtin_fmaxf((a), (b)), (c))
__device__ __forceinline__ float a_rowmax(const f32x16& p0, const f32x16& p1) {
  float a = A_MX3(p0[0], p0[1], p1[0]), b = A_MX3(p0[2], p0[3], p1[1]); a = A_MX3(a, p1[2], p1[3]);
#pragma unroll
  for (int r = 4; r < 16; r += 4) { a = A_MX3(a, p0[r], p0[r + 1]); b = A_MX3(b, p0[r + 2], p0[r + 3]); a = A_MX3(a, p1[r], p1[r + 1]); b = A_MX3(b, p1[r + 2], p1[r + 3]); }
  float m = __builtin_fmaxf(a, b); auto rr = __builtin_amdgcn_permlane32_swap(__float_as_uint(m), __float_as_uint(m), false, false);
  return __builtin_fmaxf(__uint_as_float(rr[0]), __uint_as_float(rr[1])); }
template <int MODE>
__device__ __forceinline__ void a_mask(f32x16& p0, f32x16& p1, int key0, int qabs, int hi) {
  const int kb = key0 + 4 * hi;
#pragma unroll
  for (int r = 0; r < 16; ++r) {
    const int kv = kb + (r & 3) + 8 * (r >> 2);
    bool bad0 = kv > qabs, bad1 = (kv + 32) > qabs;
    if (MODE == 2) { bad0 = bad0 || (kv + 512 <= qabs); bad1 = bad1 || (kv + 32 + 512 <= qabs); }
    if (bad0) p0[r] = -INFINITY;
    if (bad1) p1[r] = -INFINITY;
  } }
__device__ __forceinline__ void a_bias(f32x16& p0, f32x16& p1, const char* fb, int hi) {
#pragma unroll
  for (int g = 0; g < 4; ++g) {
    const float4 b0 = *(const float4*)(fb + (8 * g + 4 * hi) * 4);
    const float4 b1 = *(const float4*)(fb + (32 + 8 * g + 4 * hi) * 4);
    p0[4 * g + 0] += b0.x; p0[4 * g + 1] += b0.y; p0[4 * g + 2] += b0.z; p0[4 * g + 3] += b0.w;
    p1[4 * g + 0] += b1.x; p1[4 * g + 1] += b1.y; p1[4 * g + 2] += b1.z; p1[4 * g + 3] += b1.w;
  } }

template <int MODE>
__device__ __forceinline__ void a_unit(const u16* __restrict__ Qw, const int qp, const u16* __restrict__ Kp, const u16* __restrict__ Vp,
                                       const float* __restrict__ Fp, const int NT, const int key00, const int qabs, const unsigned selm,
                                       const float gate, char* lds, u16* stg, const int tid) {
  constexpr int NK = (MODE == 0) ? 2 : 1;
  const int lane = tid & 63, r32 = lane & 31, hi = lane >> 5; const int wid = __builtin_amdgcn_readfirstlane(tid >> 6);
  const unsigned lds0 = (unsigned)(uintptr_t)lds; float* wsf = (float*)(lds + A_LDS_WS) + wid * 64;
  const u16* ksrc = Kp + (long)lane * INC + wid * 8;
  const u16* vsrc = Vp + (long)(16 * (wid & 3) + (lane >> 2)) * INC + (wid >> 2) * 32 + (lane & 3) * 8;
  const float* fsrc = Fp + lane;
  const unsigned kdst = lds0 + A_LDS_K + wid * 1024, vdst = lds0 + A_LDS_V + wid * 1024, fdst = lds0 + A_LDS_F;
#define A_DMA_K(t, slot) do { a_glds16(ksrc + (long)(t) * 64 * INC, (unsigned)__builtin_amdgcn_readfirstlane(kdst + (slot))); \
    if (MODE == 0) a_glds4(fsrc + (t) * 64, (unsigned)__builtin_amdgcn_readfirstlane(fdst + ((t) & 3) * 256)); } while (0)
#define A_DMA_V(t, slot) a_glds16(vsrc + (long)(t) * 64 * INC, (unsigned)__builtin_amdgcn_readfirstlane(vdst + (slot)))
  const a_lds_cptr vp0 = (a_lds_cptr)lds + A_LDS_V + ((lane >> 4) & 1) * 32 + (lane & 3) * 8 + (4 * hi + ((lane & 15) >> 2)) * 64;
  const a_lds_cptr kp0 = (a_lds_cptr)lds + A_LDS_K + hi * 1024 + r32 * 16;
  const char* fb0 = lds + A_LDS_F;
  A_DMA_K(0, 0); A_DMA_V(0, 0); A_DMA_K(1, A_SLOTB);
  bf16x8 qr[4];
#pragma unroll
  for (int d0 = 0; d0 < 4; ++d0) qr[d0] = ldfrag(Qw + (long)r32 * qp + d0 * 16 + hi * 8);
  float mhat = 0.f, l_reg = 0.f; f32x16 o[2];
#pragma unroll
  for (int r = 0; r < 16; ++r) { o[0][r] = 0.f; o[1][r] = 0.f; }
  const f32x16 zero16 = {0.f, 0.f, 0.f, 0.f, 0.f, 0.f, 0.f, 0.f, 0.f, 0.f, 0.f, 0.f, 0.f, 0.f, 0.f, 0.f};
  bool resc = false;
  f32x16 pA0, pA1, pB0, pB1; bf16x8 kf[8]; a_s16x4 vlo[8], vhi[8]; a_u32x4 pw0, pw1, pw2, pw3;
  int sl_prev = 0, sl_cur = 0, sl_next = A_SLOTB;
#define A_ROT() do { sl_prev = sl_cur; sl_cur = sl_next; sl_next = (sl_next == 2 * A_SLOTB) ? 0 : sl_next + A_SLOTB; } while (0)
#define A_EX(v) __builtin_amdgcn_exp2f(__builtin_fmaf((v), A_C2, nmh))
#define A_RESC() do { if (resc) { _Pragma("unroll") for (int d_ = 0; d_ < 2; ++d_) _Pragma("unroll") for (int r = 0; r < 16; ++r) o[d_][r] *= wsf[a_crow(r, hi)]; } } while (0)
  A_DMA_K(2, 2 * A_SLOTB);
  a_wait_bar<1 + 2 * NK>();
  _Pragma("unroll") for (int d0 = 0; d0 < 4; ++d0) a_kload2(kf, kp0, d0);
  pA0 = A_MFMA(kf[0], qr[0], zero16); pA1 = A_MFMA(kf[1], qr[0], zero16); pA0 = A_MFMA(kf[2], qr[1], pA0); pA1 = A_MFMA(kf[3], qr[1], pA1);
  pA0 = A_MFMA(kf[4], qr[2], pA0); pA1 = A_MFMA(kf[5], qr[2], pA1); pA0 = A_MFMA(kf[6], qr[3], pA0); pA1 = A_MFMA(kf[7], qr[3], pA1);
  if (MODE == 0) a_bias(pA0, pA1, fb0, hi);
  if (MODE == 2 || NT == 4) a_mask<MODE>(pA0, pA1, key00, qabs, hi);
  { const float rm = a_rowmax(pA0, pA1); mhat = __builtin_fmaxf(rm * A_C2, -1.0e30f); const float nmh = -mhat;
#pragma unroll
    for (int r = 0; r < 16; ++r) { pA0[r] = A_EX(pA0[r]); pA1[r] = A_EX(pA1[r]); } }
  a_wait_bar<0>();
  A_DMA_K(3, 0); A_DMA_V(1, A_SLOTB); A_ROT();
  _Pragma("unroll") for (int d0 = 0; d0 < 4; ++d0) a_kload2(kf, kp0 + sl_cur, d0);
  a_wait_bar<NK + 1>();
#define A_PKW(P, i) a_cvtpk(P[i], P[i + 1])
#define A_PAF(k) __builtin_bit_cast(bf16x8, pw##k)
#define A_VFR(i) __builtin_bit_cast(bf16x8, __builtin_shufflevector(vlo[i], vhi[i], 0, 1, 2, 3, 4, 5, 6, 7))
#define A_VRD(i) do { vlo[i] = a_vtr(vp_ + (((i) >> 2) * 4096 + ((i) & 3) * 1024)); vhi[i] = a_vtr(vp_ + (((i) >> 2) * 4096 + ((i) & 3) * 1024 + 512)); } while (0)
#define A_KRD(G, d0) do { if (G) { a_kload2(kf, kp0 + sl_next, d0); A_SBAR(); } } while (0)
#define A_GAPA(MF, a0, a1, a2, a3, W0, W1, PW) do { MF; sacc += a0; sacc += a1; sacc += a2; sacc += a3; W0; W1; A_PIN(PW); A_PIN(sacc); A_SBAR(); } while (0)
#define A_GAPB(MF, X, i) do { MF; X[i] = A_EX(X[i]); X[i + 1] = A_EX(X[i + 1]); X[i + 2] = A_EX(X[i + 2]); X[i + 3] = A_EX(X[i + 3]); A_PIN(X); A_SBAR(); } while (0)
#define A_STEP(C0, C1, P0, P1, t, MASK, GK, GV, GL) do { A_SBAR(); \
    const a_lds_cptr vp_ = vp0 + sl_prev; \
    A_VRD(0); A_SBAR(); float sacc = P0[0] + P0[1]; \
                      A_GAPA(C0 = A_MFMA(kf[0], qr[0], zero16), P0[2], P0[3], P0[4], P0[5],     pw0[0] = A_PKW(P0, 0),  pw0[1] = A_PKW(P0, 2),  pw0); \
    A_VRD(4); A_SBAR(); A_GAPA(C1 = A_MFMA(kf[1], qr[0], zero16), P0[6], P0[7], P0[8], P0[9],     pw0[2] = A_PKW(P0, 4),  pw0[3] = A_PKW(P0, 6),  pw0); \
    A_VRD(1); A_SBAR(); A_GAPA(C0 = A_MFMA(kf[2], qr[1], C0),    P0[10], P0[11], P0[12], P0[13], pw1[0] = A_PKW(P0, 8),  pw1[1] = A_PKW(P0, 10), pw1); \
    A_VRD(5); A_SBAR(); A_GAPA(C1 = A_MFMA(kf[3], qr[1], C1),    P0[14], P0[15], P1[0], P1[1],   pw1[2] = A_PKW(P0, 12), pw1[3] = A_PKW(P0, 14), pw1); \
    A_VRD(2); A_SBAR(); A_GAPA(C0 = A_MFMA(kf[4], qr[2], C0),    P1[2], P1[3], P1[4], P1[5],     pw2[0] = A_PKW(P1, 0),  pw2[1] = A_PKW(P1, 2),  pw2); \
    A_VRD(6); A_SBAR(); A_GAPA(C1 = A_MFMA(kf[5], qr[2], C1),    P1[6], P1[7], P1[8], P1[9],     pw2[2] = A_PKW(P1, 4),  pw2[3] = A_PKW(P1, 6),  pw2); \
    A_VRD(3); A_SBAR(); A_GAPA(C0 = A_MFMA(kf[6], qr[3], C0),    P1[10], P1[11], P1[12], P1[13], pw3[0] = A_PKW(P1, 8),  pw3[1] = A_PKW(P1, 10), pw3); \
    A_VRD(7); A_SBAR(); A_GAPA(C1 = A_MFMA(kf[7], qr[3], C1),    P1[14], P1[15], 0.f, 0.f,       pw3[2] = A_PKW(P1, 12), pw3[3] = A_PKW(P1, 14), pw3); \
    l_reg += sacc; \
    if (GK) A_DMA_K((t) + 3, sl_cur); if (GV) A_DMA_V((t) + 1, sl_next); \
    if (MODE == 0) a_bias(C0, C1, fb0 + ((t) & 3) * 256, hi); \
    if (MASK) a_mask<MODE>(C0, C1, key00 + (t) * 64, qabs, hi); \
    const bool selb_ = (MODE != 1) || (((selm >> ((t) & 31)) & 1u) != 0u); \
    { float rmx = a_rowmax(C0, C1) * A_C2; if (!selb_) rmx = -INFINITY; resc = false; \
      if (__builtin_expect(__any((rmx - mhat) > A_THR), 0)) { const float mnew = __builtin_fmaxf(mhat, rmx); \
          const float f = __builtin_amdgcn_exp2f(mhat - mnew); mhat = mnew; l_reg *= f; if (hi == 0) wsf[r32] = f; resc = true; } } \
    const float nmh = selb_ ? -mhat : -INFINITY; A_SBAR(); \
    A_GAPB(o[0] = A_MFMA(A_PAF(0), A_VFR(0), o[0]), C0, 0);              A_GAPB(o[1] = A_MFMA(A_PAF(0), A_VFR(4), o[1]), C0, 4); \
    A_KRD(GL, 0); A_GAPB(o[0] = A_MFMA(A_PAF(1), A_VFR(1), o[0]), C0, 8);  A_KRD(GL, 1); A_GAPB(o[1] = A_MFMA(A_PAF(1), A_VFR(5), o[1]), C0, 12); \
    A_KRD(GL, 2); A_GAPB(o[0] = A_MFMA(A_PAF(2), A_VFR(2), o[0]), C1, 0);  A_KRD(GL, 3); A_GAPB(o[1] = A_MFMA(A_PAF(2), A_VFR(6), o[1]), C1, 4); \
    A_GAPB(o[0] = A_MFMA(A_PAF(3), A_VFR(3), o[0]), C1, 8);              A_GAPB(o[1] = A_MFMA(A_PAF(3), A_VFR(7), o[1]), C1, 12); \
    } while (0)
  int t = 1;
  if (MODE != 2) {
    for (; t + 5 < NT; t += 2) {
      A_STEP(pB0, pB1, pA0, pA1, t, false, true, true, true);     a_wait_bar<NK + 1>(); A_RESC(); A_ROT();
      A_STEP(pA0, pA1, pB0, pB1, t + 1, false, true, true, true); a_wait_bar<NK + 1>(); A_RESC(); A_ROT();
    }
  }
#define A_ENDW(tt) do { if ((tt) + 3 < NT) { a_wait_bar<NK + 1>(); } else if ((tt) + 2 < NT) { a_wait_bar<1>(); } else { a_wait_bar<0>(); } } while (0)
  for (; t + 1 < NT; t += 2) {
    A_STEP(pB0, pB1, pA0, pA1, t, (MODE != 2 || t < 4 || t + 4 >= NT), (t + 3 < NT), (t + 1 < NT), (t + 1 < NT));             A_ENDW(t);     A_RESC(); A_ROT();
    A_STEP(pA0, pA1, pB0, pB1, t + 1, (MODE != 2 || t + 1 < 4 || t + 5 >= NT), (t + 4 < NT), (t + 2 < NT), (t + 2 < NT));     A_ENDW(t + 1); A_RESC(); A_ROT();
  }
  A_STEP(pB0, pB1, pA0, pA1, NT - 1, true, false, false, false); A_RESC();
  { float sacc = pB0[0] + pB0[1];
#pragma unroll
    for (int r = 2; r < 16; ++r) sacc += pB0[r];
#pragma unroll
    for (int r = 0; r < 16; ++r) sacc += pB1[r];
    l_reg += sacc;
    pw0 = (a_u32x4){A_PKW(pB0, 0), A_PKW(pB0, 2), A_PKW(pB0, 4), A_PKW(pB0, 6)}; pw1 = (a_u32x4){A_PKW(pB0, 8), A_PKW(pB0, 10), A_PKW(pB0, 12), A_PKW(pB0, 14)};
    pw2 = (a_u32x4){A_PKW(pB1, 0), A_PKW(pB1, 2), A_PKW(pB1, 4), A_PKW(pB1, 6)}; pw3 = (a_u32x4){A_PKW(pB1, 8), A_PKW(pB1, 10), A_PKW(pB1, 12), A_PKW(pB1, 14)};
    const a_lds_cptr vp_ = vp0 + sl_cur; _Pragma("unroll") for (int i = 0; i < 8; ++i) A_VRD(i);
    o[0] = A_MFMA(A_PAF(0), A_VFR(0), o[0]); o[1] = A_MFMA(A_PAF(0), A_VFR(4), o[1]); o[0] = A_MFMA(A_PAF(1), A_VFR(1), o[0]); o[1] = A_MFMA(A_PAF(1), A_VFR(5), o[1]);
    o[0] = A_MFMA(A_PAF(2), A_VFR(2), o[0]); o[1] = A_MFMA(A_PAF(2), A_VFR(6), o[1]); o[0] = A_MFMA(A_PAF(3), A_VFR(3), o[0]); o[1] = A_MFMA(A_PAF(3), A_VFR(7), o[1]); }
  { auto rr = __builtin_amdgcn_permlane32_swap(__float_as_uint(l_reg), __float_as_uint(l_reg), false, false); l_reg = __uint_as_float(rr[0]) + __uint_as_float(rr[1]); }
  if (hi == 0) wsf[32 + r32] = gate / l_reg;
  asm volatile("s_waitcnt lgkmcnt(0)" ::: "memory");
  float rli[16];
#pragma unroll
  for (int r = 0; r < 16; ++r) rli[r] = wsf[32 + a_crow(r, hi)];
#pragma unroll
  for (int r = 0; r < 16; ++r) { const int orow = a_crow(r, hi);
#pragma unroll
    for (int d0 = 0; d0 < 2; ++d0) stg[orow * 64 + d0 * 32 + r32] = f2bf(o[d0][r] * rli[r]); }
  asm volatile("s_waitcnt lgkmcnt(0)\n\ts_barrier" ::: "memory");
#undef A_DMA_K
#undef A_DMA_V
#undef A_ROT
#undef A_EX
#undef A_RESC
#undef A_PKW
#undef A_PAF
#undef A_VFR
#undef A_VRD
#undef A_KRD
#undef A_ENDW
#undef A_GAPA
#undef A_GAPB
#undef A_STEP
}

__device__ void pc2_phase(const Params& P, int layer, int chunk, char* smem, int* s_item, const int which) {
  volatile __attribute__((address_space(3))) unsigned* xst = (volatile __attribute__((address_space(3))) unsigned*)(smem + XB_LDS_OFF);
  const int nx = (int)xst[1], xc = (int)xst[3];
  const int nBH = P.NB * 16;
  const int nStr = which ? (P.NB * 2) : nBH;
  const int nLoc = (nStr - xc + nx - 1) / nx;
  const int nCmpAll = which ? 0 : P.NB * 2;
  const int nCmp = which ? 0 : (nCmpAll - xc + nx - 1) / nx;
  const int nItems = nCmp + (which ? nLoc * 64 : ((nLoc + 3) >> 2) * 32);
  unsigned* ctr = P.ctr + ((chunk * 4 + layer) * 2 + which) * 8 + xc;
  while (true) {
    const int tid = opaque_tid(), lane = tid & 63, r32 = lane & 31, w = tid >> 6;
    __syncthreads();
    if (tid == 0) *s_item = (int)atomicAdd(ctr, 1u);
    __syncthreads();
    const int it0 = *s_item;
    if (it0 >= nItems) break;
    if (it0 < nCmp) { compress_item(P, layer, xc + nx * it0, smem, tid); continue; }
    const int it = it0 - nCmp;
    int qt, bh;
    if (which) {
      const int sl = it >> 6, rem = it & 63;
      qt = 7 - (rem >> 3);
      bh = (xc + nx * sl) * 8 + (rem & 7);
    } else {
      const int grp = it >> 5, rem = it & 31;
      const int sl = grp * 4 + (rem & 3);
      qt = 7 - (rem >> 2);
      if (sl >= nLoc) continue;
      bh = xc + nx * sl;
    }
    const int type = which;
    const int bl = bh >> 4, head = bh & 15;
    const int q0w = qt * 256 + w * 32;
    const int qabs = q0w + r32;
    const size_t rowq = (size_t)bl * TSEQ + qabs;
    const size_t roww = (size_t)bl * TSEQ + q0w;
    const u16* pb_ = P.proj + (size_t)bl * TSEQ * INC;
    u16* stg = (u16*)(smem + A_LDS_OST) + w * 4096;
    const int er = lane >> 3, ec = (lane & 7) * 8;
    if (type == 0) {
      a_unit<0>(pb_ + roww * 0 + (size_t)q0w * INC + C_QB + head * 64, INC, pb_ + C_KB + head * 64, pb_ + C_VB + head * 64,
                P.F2 + (size_t)(bl * 16 + head) * TSEQ, 4 * qt + 4, 0, qabs, 0u, 1.0f, smem, stg, tid);
#pragma unroll
      for (int i = 0; i < 4; i++) {
        const int row = i * 8 + er;
        const uint4 ov = *(const uint4*)(stg + row * 64 + ec);
        const uint4 zz = *(const uint4*)(pb_ + (size_t)(q0w + row) * INC + C_ZB + head * 64 + ec);
        uint4 y;
        y.x = pk2(bflo(ov.x) * siluf_(bflo(zz.x)), bfhi(ov.x) * siluf_(bfhi(zz.x)));
        y.y = pk2(bflo(ov.y) * siluf_(bflo(zz.y)), bfhi(ov.y) * siluf_(bfhi(zz.y)));
        y.z = pk2(bflo(ov.z) * siluf_(bflo(zz.z)), bfhi(ov.z) * siluf_(bfhi(zz.z)));
        y.w = pk2(bflo(ov.w) * siluf_(bflo(zz.w)), bfhi(ov.w) * siluf_(bfhi(zz.w)));
        *(uint4*)(P.yb + (roww + row) * DM + head * 64 + ec) = y;
      }
    } else {
      const int g = head >> 3;
      const unsigned selm = P.sel[(size_t)(bl * 2 + g) * TSEQ + qabs];
      const float g1 = sigmoidf_(bf2f(P.proj[rowq * INC + C_GA + 16 + head]));
      const float g2 = sigmoidf_(bf2f(P.proj[rowq * INC + C_GA + 32 + head]));
      const u16* qw = P.qr + roww * DM + head * 64;
      a_unit<1>(qw, DM, pb_ + C_KV + 256 + g * 64, pb_ + C_KV + 384 + g * 64, nullptr, 4 * qt + 4, 0, qabs, selm, g1, smem, stg, tid);
      const int klo = (4 * qt - 8) > 0 ? (4 * qt - 8) : 0;
      a_unit<2>(qw, DM, pb_ + (size_t)(klo * 64) * INC + C_KV + 512 + g * 64, pb_ + (size_t)(klo * 64) * INC + C_KV + 640 + g * 64, nullptr,
                4 * qt + 4 - klo, klo * 64, qabs, 0u, g2, smem, stg + 2048, tid);
#pragma unroll
      for (int i = 0; i < 4; i++) {
        const int row = i * 8 + er;
        const uint4 o1 = *(const uint4*)(stg + row * 64 + ec);
        const uint4 o2 = *(const uint4*)(stg + 2048 + row * 64 + ec);
        const uint4 zz = *(const uint4*)(pb_ + (size_t)(q0w + row) * INC + C_ZA + head * 64 + ec);
        u16* yp = P.ya + (roww + row) * DM + head * 64 + ec;
        const uint4 oc = *(const uint4*)yp;
        uint4 y;
        y.x = pk2((bflo(o1.x) + bflo(o2.x) + bflo(oc.x)) * siluf_(bflo(zz.x)), (bfhi(o1.x) + bfhi(o2.x) + bfhi(oc.x)) * siluf_(bfhi(zz.x)));
        y.y = pk2((bflo(o1.y) + bflo(o2.y) + bflo(oc.y)) * siluf_(bflo(zz.y)), (bfhi(o1.y) + bfhi(o2.y) + bfhi(oc.y)) * siluf_(bfhi(zz.y)));
        y.z = pk2((bflo(o1.z) + bflo(o2.z) + bflo(oc.z)) * siluf_(bflo(zz.z)), (bfhi(o1.z) + bfhi(o2.z) + bfhi(oc.z)) * siluf_(bfhi(zz.z)));
        y.w = pk2((bflo(o1.w) + bflo(o2.w) + bflo(oc.w)) * siluf_(bflo(zz.w)), (bfhi(o1.w) + bfhi(o2.w) + bfhi(oc.w)) * siluf_(bfhi(zz.w)));
        *(uint4*)yp = y;
      }
    }
  }
}

#define XB_XCNT(j) (64 * (j))
#define XB_XSUB(j) (1024 + 64 * (j))
#define XB_XGEN(j) (2048 + 64 * (j))
#define XB_TOP 3072
#define XB_TOPGEN 3136
__device__ __forceinline__ unsigned xb_ld(unsigned* p) { return __hip_atomic_load(p, __ATOMIC_RELAXED, __HIP_MEMORY_SCOPE_AGENT); }
__device__ __forceinline__ unsigned xb_add(unsigned* p, unsigned v) { return __hip_atomic_fetch_add(p, v, __ATOMIC_RELAXED, __HIP_MEMORY_SCOPE_AGENT); }
__device__ __forceinline__ unsigned xb_xcc_id() { return (unsigned)__builtin_amdgcn_s_getreg((3 << 11) | 20) & 0xFu; }
__device__ __forceinline__ void grid_bar(unsigned* bar, char* smem) {
  asm volatile("s_waitcnt vmcnt(0) lgkmcnt(0)" ::: "memory");
  __syncthreads();
  if (threadIdx.x == 0) {
    volatile unsigned* st = (volatile unsigned*)(smem + XB_LDS_OFF);
    const unsigned nloc = st[0], nx = st[1], x = st[2];
    const unsigned old = xb_add(&bar[XB_XSUB(x)], 1u);
    const unsigned gen = old / nloc;
    if (old + 1u == (gen + 1u) * nloc) {
      __builtin_amdgcn_fence(__ATOMIC_RELEASE, "agent");
      asm volatile("s_waitcnt vmcnt(0)" ::: "memory");
      const unsigned og = xb_add(&bar[XB_TOP], 1u);
      const unsigned tg = og / nx;
      if (og + 1u == (tg + 1u) * nx) xb_add(&bar[XB_TOPGEN], 1u);
      else { while (xb_ld(&bar[XB_TOPGEN]) == tg) __builtin_amdgcn_s_sleep(1); }
      __builtin_amdgcn_fence(__ATOMIC_ACQUIRE, "agent");
      xb_add(&bar[XB_XGEN(x)], 1u);
      asm volatile("s_waitcnt vmcnt(0)" ::: "memory");
    } else {
      while (xb_ld(&bar[XB_XGEN(x)]) == gen) __builtin_amdgcn_s_sleep(1);
      __builtin_amdgcn_fence(__ATOMIC_ACQUIRE, "agent");
      asm volatile("s_waitcnt vmcnt(0)" ::: "memory");
    }
  }
  __syncthreads();
}

__global__ void __launch_bounds__(NTHREADS, 2) mega_kernel(Params P) {
  __shared__ __attribute__((aligned(1024))) char smem[163840];
  cg::grid_group grid = cg::this_grid();
  const int CT = P.NB * TSEQ;
  phase0(P, smem);
  grid.sync();
  if (threadIdx.x == 0) (void)xb_add(&P.xbar[XB_XCNT(xb_xcc_id())], 1u);
  grid.sync();
  if (threadIdx.x == 0) {
    unsigned cnt = 0u, mine = 0u, rank = 0u; const unsigned x = xb_xcc_id();
#pragma unroll 1
    for (unsigned j = 0; j < 16; ++j) { const unsigned c = xb_ld(&P.xbar[XB_XCNT(j)]); cnt += (c > 0u) ? 1u : 0u; mine = (j == x) ? c : mine; rank += (c > 0u && j < x) ? 1u : 0u; }
    volatile unsigned* st = (volatile unsigned*)(smem + XB_LDS_OFF);
    st[0] = mine > 0u ? mine : 1u; st[1] = cnt > 0u ? cnt : 1u; st[2] = x; st[3] = rank;
  }
  __syncthreads();
  for (int chunk = 0; chunk < P.nchunk; chunk++) {
    for (int layer = 0; layer < 4; layer++) {
      const float* xs = (layer == 0 ? P.x_in : P.out) + (size_t)chunk * CT * DM;
      norm_phase(xs, P.norm_g + layer * DM, P.h, CT);
      if (layer == 0 && chunk > 0) final_norm_phase(P.out, P.final_g, (chunk - 1) * CT, CT);
      grid_bar(P.xbar, smem);
      gemm1_phase(P, layer, smem);
      grid_bar(P.xbar, smem);
      pb_phase(P, layer, smem);
      grid_bar(P.xbar, smem);
      pc2_phase(P, layer, chunk, smem, (int*)(smem + 140000), 0);
      grid_bar(P.xbar, smem);
      pc1_phase(P, smem);
      grid_bar(P.xbar, smem);
      pc2_phase(P, layer, chunk, smem, (int*)(smem + 140000), 1);
      grid_bar(P.xbar, smem);
      gemm2_phase(P, layer, smem);
      grid_bar(P.xbar, smem);
      gemm3_phase(P, layer, chunk, smem);
      grid_bar(P.xbar, smem);
    }
  }
  final_norm_phase(P.out, P.final_g, (P.nchunk - 1) * CT, CT);
}

static inline size_t al256(size_t x) { return (x + 255) & ~(size_t)255; }

extern "C" void kernel_launch(void* const* d_in, const int* in_sizes, int n_in, void* d_out, int out_size,
                              void* d_ws, size_t ws_size, hipStream_t stream) {
  (void)in_sizes; (void)n_in; (void)out_size;
  Params P{};
  P.x_in = (const float*)d_in[0]; P.norm_g = (const float*)d_in[1]; P.w_in = (const float*)d_in[2];
  P.b_forget = (const float*)d_in[3];
  P.pe_k = (const float*)d_in[4]; P.w1_k = (const float*)d_in[5]; P.w2_k = (const float*)d_in[6];
  P.pe_v = (const float*)d_in[7]; P.w1_v = (const float*)d_in[8]; P.w2_v = (const float*)d_in[9];
  P.w_pa = (const float*)d_in[10]; P.w_pb = (const float*)d_in[11]; P.w_out = (const float*)d_in[12];
  P.final_g = (const float*)d_in[13];
  P.out = (float*)d_out;
  int NB = 16;
  char* base = (char*)d_ws;
  for (;;) {
    const size_t CT = (size_t)NB * TSEQ;
    size_t off = 0;
    auto take = [&](size_t bytes) { size_t o = off; off = al256(off + bytes); return o; };
    size_t oWin = take((size_t)4 * INCP * DM * 2), oWpa = take((size_t)4 * DM * DM * 2), oWpb = take((size_t)4 * DM * DM * 2),
           oWo = take((size_t)4 * DM * DM * 2), oW1 = take((size_t)8 * 128 * 2048 * 2), oW2 = take((size_t)8 * 64 * 128 * 2),
           oB1 = take((size_t)64 * 128 * 4), oRc = take((size_t)TSEQ * 32 * 4), oRs = take((size_t)TSEQ * 32 * 4),
           oH = take(CT * DM * 2), oProj = take(CT * INC * 2 + 4096), oVbt = take(CT * DM * 2),
           oVst = take(CT * 128 * 2), oVwt = take(CT * 128 * 2), oFl = take(CT * 16 * 4), oF2 = take(CT * 16 * 4),
           oKc = take((size_t)NB * 2 * 128 * 64 * 2), oVc = take((size_t)NB * 2 * 64 * 128 * 2), oSel = take(CT * 2 * 4),
           oYa = take(CT * DM * 2), oYb = take(CT * DM * 2), oCtr = take(1024), oXb = take(XB_WORDS * 4);
    if (off > ws_size && NB > 1) { NB >>= 1; continue; }
    P.WinT = (u16*)(base + oWin); P.WpaT = (u16*)(base + oWpa); P.WpbT = (u16*)(base + oWpb); P.WoT = (u16*)(base + oWo);
    P.W1T = (u16*)(base + oW1); P.W2T = (u16*)(base + oW2); P.bias1p = (float*)(base + oB1);
    P.ropec = (float*)(base + oRc); P.ropes = (float*)(base + oRs);
    P.h = (u16*)(base + oH); P.proj = (u16*)(base + oProj); P.qr = (u16*)(base + oVbt);
    P.vst = (u16*)(base + oVst); P.vwt = (u16*)(base + oVwt); P.flog = (float*)(base + oFl); P.F2 = (float*)(base + oF2);
    P.kcmp = (u16*)(base + oKc); P.vcmpt = (u16*)(base + oVc); P.sel = (unsigned*)(base + oSel);
    P.ya = (u16*)(base + oYa); P.yb = (u16*)(base + oYb); P.ctr = (unsigned*)(base + oCtr); P.xbar = (unsigned*)(base + oXb);
    break;
  }
  P.NB = NB; P.nchunk = 32 / NB;
  static int grid_blocks = 0;
  if (!grid_blocks) {
    int dev = 0, cus = 0, per_cu = 0;
    hipGetDevice(&dev);
    hipDeviceGetAttribute(&cus, hipDeviceAttributeMultiprocessorCount, dev);
    hipOccupancyMaxActiveBlocksPerMultiprocessor(&per_cu, mega_kernel, NTHREADS, 0);
    if (per_cu > 1) per_cu = 1;
    if (per_cu < 1) per_cu = 1;
    grid_blocks = cus * per_cu;
  }
  void* args[] = {&P};
  hipError_t e = hipLaunchCooperativeKernel((void*)mega_kernel, dim3(grid_blocks), dim3(NTHREADS), args, 0, stream);
  if (e != hipSuccess) fprintf(stderr, "cooperative launch failed: %s (grid %d)\n", hipGetErrorString(e), grid_blocks);
}
```

```cpp
#include <hip/hip_runtime.h>
#include <hip/hip_cooperative_groups.h>
#include <cstdio>
namespace cg = cooperative_groups;

typedef __attribute__((ext_vector_type(8))) __bf16 bf16x8;
typedef __attribute__((ext_vector_type(16))) float f32x16;
typedef __attribute__((ext_vector_type(4))) float f32x4;
typedef __attribute__((ext_vector_type(2))) float f32x2;
typedef unsigned short u16;

#define TSEQ 2048
#define DM 1024
#define INC 9024
#define INCP 9216
#define C_QA 0
#define C_KV 1024
#define C_GA 1792
#define C_ZA 1840
#define C_QB 2864
#define C_KB 3888
#define C_VB 4912
#define C_QR 4912
#define C_FB 5936
#define C_ZB 5952
#define C_RA 6976
#define C_RB 8000
#define NTHREADS 512
#define ATT_STAGE 33280
#define LOG2E 1.4426950408889634f
#define XB_WORDS 3200
#define XB_LDS_OFF 150000

struct Params {
  const float* x_in; const float* norm_g; const float* w_in; const float* b_forget;
  const float* pe_k; const float* w1_k; const float* w2_k;
  const float* pe_v; const float* w1_v; const float* w2_v;
  const float* w_pa; const float* w_pb; const float* w_out; const float* final_g;
  float* out;
  u16* WinT; u16* WpaT; u16* WpbT; u16* WoT; u16* W1T; u16* W2T;
  float* bias1p; float* ropec; float* ropes;
  u16* h; u16* proj; u16* qr; u16* vst; u16* vwt;
  float* flog; float* F2; u16* kcmp; u16* vcmpt; unsigned* sel;
  u16* ya; u16* yb; unsigned* ctr; unsigned* xbar;
  int NB; int nchunk;
};

__device__ __forceinline__ unsigned pk2(float a, float b) {
  typedef __attribute__((ext_vector_type(2))) float f2_t;
  typedef __attribute__((ext_vector_type(2))) __bf16 b2_t;
  f2_t v = {a, b};
  b2_t r = __builtin_convertvector(v, b2_t);
  return __builtin_bit_cast(unsigned, r);
}
__device__ __forceinline__ u16 f2bf(float a) { return (u16)(pk2(a, 0.f) & 0xffffu); }
__device__ __forceinline__ float bf2f(u16 u) { return __uint_as_float(((unsigned)u) << 16); }
__device__ __forceinline__ float bflo(unsigned u) { return __uint_as_float(u << 16); }
__device__ __forceinline__ float bfhi(unsigned u) { return __uint_as_float(u & 0xffff0000u); }
__device__ __forceinline__ float sigmoidf_(float x) { return __builtin_amdgcn_rcpf(1.f + __expf(-x)); }
__device__ __forceinline__ float siluf_(float x) { return x * __builtin_amdgcn_rcpf(1.f + __expf(-x)); }
__device__ __forceinline__ f32x16 mfma32(bf16x8 a, bf16x8 b, f32x16 c) {
  return __builtin_amdgcn_mfma_f32_32x32x16_bf16(a, b, c, 0, 0, 0);
}
__device__ __forceinline__ int opaque_tid() { int t = threadIdx.x; asm volatile("" : "+v"(t)); return t; }
__device__ __forceinline__ bf16x8 ldfrag(const void* p) {
  return __builtin_bit_cast(bf16x8, *(const uint4*)p);
}

__device__ void transpose_tile(const float* __restrict__ src, u16* __restrict__ dst, int K, int N,
                               int k0, int n0, float* tile, const int tid) {
#pragma unroll
  for (int j = 0; j < 2; j++) {
    int r = (tid >> 4) + 32 * j, c4 = (tid & 15) * 4;
    float4 v = *(const float4*)(src + (size_t)(k0 + r) * N + n0 + c4);
    tile[r * 65 + c4] = v.x; tile[r * 65 + c4 + 1] = v.y; tile[r * 65 + c4 + 2] = v.z; tile[r * 65 + c4 + 3] = v.w;
  }
  __syncthreads();
  {
    int c = tid, n = c >> 3, kc = c & 7;
    const float* tp = tile + (kc * 8) * 65 + n;
    uint4 o;
    o.x = pk2(tp[0], tp[65]); o.y = pk2(tp[130], tp[195]); o.z = pk2(tp[260], tp[325]); o.w = pk2(tp[390], tp[455]);
    *(uint4*)(dst + (size_t)(n0 + n) * K + k0 + kc * 8) = o;
  }
  __syncthreads();
}

__device__ void phase0(const Params& P, char* smem) {
  const int tid = opaque_tid();
  float* tile = (float*)smem;
  const int n0_ = 4 * 16 * 141, n1_ = 4 * 16 * 16, n2_ = 4 * 32 * 2, n3_ = 4 * 2 * 1;
  const int nT = n0_ + 3 * n1_ + 2 * n2_ + 2 * n3_;
  const int nBias = 64, nRope = 128;
  const int total = nT + nBias + nRope + 1;
  for (int it = blockIdx.x; it < total; it += gridDim.x) {
    if (it < nT) {
      int t = it;
      if (t < n0_) {
        int l = t / (16 * 141), rem = t % (16 * 141);
        transpose_tile(P.w_in + (size_t)l * DM * INC, P.WinT + (size_t)l * INCP * DM, DM, INC, (rem / 141) * 64, (rem % 141) * 64, tile, tid);
        continue;
      }
      t -= n0_;
      if (t < 3 * n1_) {
        int which = t / n1_; t %= n1_;
        int l = t / 256, rem = t % 256;
        const float* s = which == 0 ? P.w_pa : (which == 1 ? P.w_pb : P.w_out);
        u16* d = which == 0 ? P.WpaT : (which == 1 ? P.WpbT : P.WoT);
        transpose_tile(s + (size_t)l * DM * DM, d + (size_t)l * DM * DM, DM, DM, (rem >> 4) * 64, (rem & 15) * 64, tile, tid);
        continue;
      }
      t -= 3 * n1_;
      if (t < 2 * n2_) {
        int kv = t / n2_; t %= n2_;
        int l = t / 64, rem = t % 64;
        const float* s = kv ? P.w1_v : P.w1_k;
        transpose_tile(s + (size_t)l * 2048 * 128, P.W1T + (size_t)(l * 2 + kv) * 128 * 2048, 2048, 128, (rem >> 1) * 64, (rem & 1) * 64, tile, tid);
        continue;
      }
      t -= 2 * n2_;
      {
        int kv = t / n3_; t %= n3_;
        int l = t / 2, rem = t % 2;
        const float* s = kv ? P.w2_v : P.w2_k;
        transpose_tile(s + (size_t)l * 128 * 64, P.W2T + (size_t)(l * 2 + kv) * 64 * 128, 128, 64, rem * 64, 0, tile, tid);
      }
    } else if (it < nT + nBias) {
      int j = it - nT;
      int l = j >> 4, kv = (j >> 3) & 1, kq = j & 7;
      const float* pe = (kv ? P.pe_v : P.pe_k) + (size_t)l * 2048;
      const float* w1 = (kv ? P.w1_v : P.w1_k) + (size_t)l * 2048 * 128;
      int hid = tid & 127, kh = tid >> 7;
      int kbeg = kq * 256 + kh * 64;
      float s = 0.f;
#pragma unroll 8
      for (int k = 0; k < 64; k++) s += pe[kbeg + k] * w1[(size_t)(kbeg + k) * 128 + hid];
      float* part = (float*)smem;
      part[tid] = s;
      __syncthreads();
      if (tid < 128) P.bias1p[((l * 2 + kv) * 8 + kq) * 128 + hid] = (part[tid] + part[tid + 128]) + (part[tid + 256] + part[tid + 384]);
      __syncthreads();
    } else if (it < nT + nBias + nRope) {
      int idx = (it - nT - nBias) * 512 + tid;
      int t = idx >> 5, j = idx & 31;
      double inv = 1.0;
      for (int q = 0; q < j; q++) inv *= 0.7498942093324558;
      float invf = (float)inv;
      float angf = (float)t * invf;
      double a = (double)angf;
      double kq = rint(a * 0.15915494309189535);
      double rr = a - kq * 6.283185307179586;
      double r2 = rr * rr;
      double sterm = rr, cterm = 1.0, ssum = rr, csum = 1.0;
#pragma unroll 1
      for (int n = 1; n <= 15; n++) {
        cterm *= -r2 / (double)((2 * n - 1) * (2 * n));
        sterm *= -r2 / (double)((2 * n) * (2 * n + 1));
        csum += cterm; ssum += sterm;
      }
      P.ropec[idx] = (float)csum;
      P.ropes[idx] = (float)ssum;
    } else {
      if (tid < 256) P.ctr[tid] = 0u;
      for (int i = tid; i < XB_WORDS; i += NTHREADS) P.xbar[i] = 0u;
    }
  }
}

__device__ void norm_phase(const float* __restrict__ xsrc, const float* __restrict__ g, u16* __restrict__ hdst, int nrows) {
  const int tid = opaque_tid();
  const int lane = tid & 63;
  const int gw = blockIdx.x * 8 + (tid >> 6), nw = gridDim.x * 8;
  float4 gv[4];
#pragma unroll
  for (int j = 0; j < 4; j++) gv[j] = *(const float4*)(g + lane * 4 + 256 * j);
  for (int row = gw; row < nrows; row += 2 * nw) {
    const float* xr0 = xsrc + (size_t)row * DM;
    const float* xr1 = xsrc + (size_t)(row + nw) * DM;
    float4 v0[4], v1[4];
#pragma unroll
    for (int j = 0; j < 4; j++) { v0[j] = *(const float4*)(xr0 + lane * 4 + 256 * j); v1[j] = *(const float4*)(xr1 + lane * 4 + 256 * j); }
    float s0 = 0.f, s1 = 0.f;
#pragma unroll
    for (int j = 0; j < 4; j++) {
      s0 += v0[j].x * v0[j].x + v0[j].y * v0[j].y + v0[j].z * v0[j].z + v0[j].w * v0[j].w;
      s1 += v1[j].x * v1[j].x + v1[j].y * v1[j].y + v1[j].z * v1[j].z + v1[j].w * v1[j].w;
    }
#pragma unroll
    for (int o = 32; o >= 1; o >>= 1) { s0 += __shfl_xor(s0, o); s1 += __shfl_xor(s1, o); }
    const float r0 = rsqrtf(s0 * (1.f / DM) + 1e-6f), r1 = rsqrtf(s1 * (1.f / DM) + 1e-6f);
#pragma unroll
    for (int j = 0; j < 4; j++) {
      uint2 o;
      o.x = pk2(v0[j].x * r0 * gv[j].x, v0[j].y * r0 * gv[j].y);
      o.y = pk2(v0[j].z * r0 * gv[j].z, v0[j].w * r0 * gv[j].w);
      *(uint2*)(hdst + (size_t)row * DM + lane * 4 + 256 * j) = o;
      o.x = pk2(v1[j].x * r1 * gv[j].x, v1[j].y * r1 * gv[j].y);
      o.y = pk2(v1[j].z * r1 * gv[j].z, v1[j].w * r1 * gv[j].w);
      *(uint2*)(hdst + (size_t)(row + nw) * DM + lane * 4 + 256 * j) = o;
    }
  }
}

__device__ void final_norm_phase(float* __restrict__ x, const float* __restrict__ g, int row0, int nrows) {
  const int tid = opaque_tid();
  const int lane = tid & 63;
  const int gw = blockIdx.x * 8 + (tid >> 6), nw = gridDim.x * 8;
  float4 gv[4];
#pragma unroll
  for (int j = 0; j < 4; j++) gv[j] = *(const float4*)(g + lane * 4 + 256 * j);
  for (int row = gw; row < nrows; row += nw) {
    float* xr = x + (size_t)(row0 + row) * DM;
    float4 v[4];
    float ss = 0.f;
#pragma unroll
    for (int j = 0; j < 4; j++) {
      v[j] = *(const float4*)(xr + lane * 4 + 256 * j);
      ss += v[j].x * v[j].x + v[j].y * v[j].y + v[j].z * v[j].z + v[j].w * v[j].w;
    }
#pragma unroll
    for (int o = 32; o >= 1; o >>= 1) ss += __shfl_xor(ss, o);
    float rstd = rsqrtf(ss * (1.f / DM) + 1e-6f);
#pragma unroll
    for (int j = 0; j < 4; j++) {
      float4 o;
      o.x = v[j].x * rstd * gv[j].x; o.y = v[j].y * rstd * gv[j].y;
      o.z = v[j].z * rstd * gv[j].z; o.w = v[j].w * rstd * gv[j].w;
      *(float4*)(xr + lane * 4 + 256 * j) = o;
    }
  }
}

struct ARow {
  const u16* p; int ld;
  __device__ __forceinline__ const u16* operator()(int row, int k) const { return p + (size_t)row * ld + k; }
};
struct ACmp {
  const u16* p;
  __device__ __forceinline__ const u16* operator()(int row, int k) const {
    int t = 16 * row + (k >> 6); t = t > (TSEQ - 1) ? (TSEQ - 1) : t;
    return p + (size_t)t * INC + (k & 63);
  }
};

template <class AF>
__device__ __forceinline__ void gemm_mainloop(AF af, const u16* __restrict__ Bt, int ldb, int K, char* smem,
                                              f32x16 (&acc)[2][2], const int tid) {
  const int lane = tid & 63, r = lane & 31, h = lane >> 5, w = tid >> 6;
  const int wm = w >> 1, wn = w & 1;
  const int lrow = tid >> 3, lch = tid & 7;
  uint4 ra[4], rb[4];
  const int nk = K >> 6;
#pragma unroll
  for (int j = 0; j < 4; j++) {
    int row = lrow + 32 * j;
    ra[j] = *(const uint4*)af(row, lch * 8);
    rb[j] = *(const uint4*)(Bt + (size_t)row * ldb + lch * 8);
  }
#pragma unroll
  for (int j = 0; j < 4; j++) {
    int row = lrow + 32 * j;
    int off = row * 128 + ((lch ^ ((row >> 1) & 7)) << 4);
    *(uint4*)(smem + off) = ra[j];
    *(uint4*)(smem + 16384 + off) = rb[j];
  }
  __syncthreads();
  for (int it = 0; it < nk; it++) {
    const bool more = (it + 1) < nk;
    if (more) {
      const int k0 = (it + 1) * 64;
#pragma unroll
      for (int j = 0; j < 4; j++) {
        int row = lrow + 32 * j;
        ra[j] = *(const uint4*)af(row, k0 + lch * 8);
        rb[j] = *(const uint4*)(Bt + (size_t)row * ldb + k0 + lch * 8);
      }
    }
    const char* sa = smem + (it & 1) * 32768;
    const char* sb = sa + 16384;
#pragma unroll
    for (int kk = 0; kk < 4; kk++) {
      bf16x8 a[2], b[2];
#pragma unroll
      for (int mi = 0; mi < 2; mi++) {
        int row = wm * 64 + mi * 32 + r;
        a[mi] = ldfrag(sa + row * 128 + (((kk * 2 + h) ^ ((row >> 1) & 7)) << 4));
      }
#pragma unroll
      for (int ni = 0; ni < 2; ni++) {
        int row = wn * 64 + ni * 32 + r;
        b[ni] = ldfrag(sb + row * 128 + (((kk * 2 + h) ^ ((row >> 1) & 7)) << 4));
      }
#pragma unroll
      for (int mi = 0; mi < 2; mi++)
#pragma unroll
        for (int ni = 0; ni < 2; ni++) acc[mi][ni] = mfma32(a[mi], b[ni], acc[mi][ni]);
    }
    if (more) {
      char* sd = smem + ((it + 1) & 1) * 32768;
#pragma unroll
      for (int j = 0; j < 4; j++) {
        int row = lrow + 32 * j;
        int off = row * 128 + ((lch ^ ((row >> 1) & 7)) << 4);
        *(uint4*)(sd + off) = ra[j];
        *(uint4*)(sd + 16384 + off) = rb[j];
      }
    }
    __syncthreads();
  }
}

__device__ __forceinline__ void zero_acc(f32x16 (&acc)[2][2]) {
#pragma unroll
  for (int a = 0; a < 2; a++)
#pragma unroll
    for (int b = 0; b < 2; b++)
#pragma unroll
      for (int i = 0; i < 16; i++) acc[a][b][i] = 0.f;
}

typedef __attribute__((ext_vector_type(8))) short s16x8;
#define G_TILE_B 32768
#define G_STAGE_B 65536
__device__ __forceinline__ int g_lds_byte(int r, int c) {
  int st = (r >> 4) * 2 + (c >> 5), ob = (r & 15) * 64 + (c & 31) * 2;
  return st * 1024 + (ob ^ (((ob >> 9) & 1) << 5));
}
__device__ __forceinline__ void g_stage_rc(int b, int& R, int& C) {
  int st = b >> 10, sb = b & 1023, swz = sb ^ (((sb >> 9) & 1) << 5);
  R = (st >> 1) * 16 + swz / 64;
  C = (st & 1) * 32 + (swz % 64) / 2;
}
#define G_WAIT_V0() asm volatile("s_waitcnt vmcnt(0)" ::: "memory")

struct GTile { int pm, pn; };
__device__ __forceinline__ bool g_next(int i, int G, int c, int nM, int nN, GTile& u) {
  const int nwg = nM * nN;
  const int L = i * G + c;
  if (L >= nwg) return false;
  int wgid = L;
  { const int q = nwg / 8, r = nwg % 8, xcd = wgid % 8, off = wgid / 8; wgid = (xcd < r ? xcd * (q + 1) : r * (q + 1) + (xcd - r) * q) + off; }
  const int nig = 4 * nN, gid = wgid / nig, fm = gid * 4, gsz = (nM - fm) < 4 ? (nM - fm) : 4;
  u.pm = fm + ((wgid % nig) % gsz);
  u.pn = (wgid % nig) / gsz;
  return true;
}

__device__ __forceinline__ void g_kloop(const u16* __restrict__ Ab, const u16* __restrict__ Bb, const int K, char* smem,
                                        f32x4 (&acc)[8][4], const int tid, const bool pre, const u16* __restrict__ nA,
                                        const u16* __restrict__ nB, const bool has_next) {
  const int wid = tid >> 6, lane = tid & 63, wr = wid >> 2, wc = wid & 3, fr = lane & 15, fq = lane >> 4;
  int sR0, sC0, sR1, sC1, sR2, sC2, sR3, sC3;
  g_stage_rc(wid * 1024 + 0 * 8192 + lane * 16, sR0, sC0);
  g_stage_rc(wid * 1024 + 1 * 8192 + lane * 16, sR1, sC1);
  g_stage_rc(wid * 1024 + 2 * 8192 + lane * 16, sR2, sC2);
  g_stage_rc(wid * 1024 + 3 * 8192 + lane * 16, sR3, sC3);
  const long o0 = (long)sR0 * K + sC0, o1 = (long)sR1 * K + sC1, o2 = (long)sR2 * K + sC2, o3 = (long)sR3 * K + sC3;
#define G_STAGE(buf, kt)                                                                                              \
  {                                                                                                                  \
    char* sa_ = smem + (buf) * G_STAGE_B + wid * 1024;                                                               \
    char* sb_ = sa_ + G_TILE_B;                                                                                      \
    const u16* ga_ = Ab + (kt) * 64;                                                                                 \
    const u16* gb_ = Bb + (kt) * 64;                                                                                 \
    __builtin_amdgcn_global_load_lds((const unsigned*)(ga_ + o0), (unsigned*)(sa_), 16, 0, 0);                       \
    __builtin_amdgcn_global_load_lds((const unsigned*)(gb_ + o0), (unsigned*)(sb_), 16, 0, 0);                       \
    __builtin_amdgcn_global_load_lds((const unsigned*)(ga_ + o1), (unsigned*)(sa_ + 8192), 16, 0, 0);                \
    __builtin_amdgcn_global_load_lds((const unsigned*)(gb_ + o1), (unsigned*)(sb_ + 8192), 16, 0, 0);                \
    __builtin_amdgcn_global_load_lds((const unsigned*)(ga_ + o2), (unsigned*)(sa_ + 16384), 16, 0, 0);               \
    __builtin_amdgcn_global_load_lds((const unsigned*)(gb_ + o2), (unsigned*)(sb_ + 16384), 16, 0, 0);               \
    __builtin_amdgcn_global_load_lds((const unsigned*)(ga_ + o3), (unsigned*)(sa_ + 24576), 16, 0, 0);               \
    __builtin_amdgcn_global_load_lds((const unsigned*)(gb_ + o3), (unsigned*)(sb_ + 24576), 16, 0, 0);               \
  }
  const int nt = K >> 6;
  if (!pre) {
    G_STAGE(0, 0);
    G_WAIT_V0();
    __syncthreads();
  }
  for (int t = 0; t < nt; ++t) {
    const int cur = t & 1;
    if (t + 1 < nt) G_STAGE(cur ^ 1, t + 1)
    else if (has_next) {
      char* sa_ = smem + wid * 1024;
      char* sb_ = sa_ + G_TILE_B;
      __builtin_amdgcn_global_load_lds((const unsigned*)(nA + o0), (unsigned*)(sa_), 16, 0, 0);
      __builtin_amdgcn_global_load_lds((const unsigned*)(nB + o0), (unsigned*)(sb_), 16, 0, 0);
      __builtin_amdgcn_global_load_lds((const unsigned*)(nA + o1), (unsigned*)(sa_ + 8192), 16, 0, 0);
      __builtin_amdgcn_global_load_lds((const unsigned*)(nB + o1), (unsigned*)(sb_ + 8192), 16, 0, 0);
      __builtin_amdgcn_global_load_lds((const unsigned*)(nA + o2), (unsigned*)(sa_ + 16384), 16, 0, 0);
      __builtin_amdgcn_global_load_lds((const unsigned*)(nB + o2), (unsigned*)(sb_ + 16384), 16, 0, 0);
      __builtin_amdgcn_global_load_lds((const unsigned*)(nA + o3), (unsigned*)(sa_ + 24576), 16, 0, 0);
      __builtin_amdgcn_global_load_lds((const unsigned*)(nB + o3), (unsigned*)(sb_ + 24576), 16, 0, 0);
    }
    const char* sa = smem + cur * G_STAGE_B;
    const char* sb = sa + G_TILE_B;
#pragma unroll
    for (int ks = 0; ks < 2; ++ks) {
      s16x8 At[8], Bf[4];
#pragma unroll
      for (int m = 0; m < 8; ++m) At[m] = *(const s16x8*)(sa + g_lds_byte(wr * 128 + m * 16 + fr, ks * 32 + fq * 8));
#pragma unroll
      for (int n = 0; n < 4; ++n) Bf[n] = *(const s16x8*)(sb + g_lds_byte(wc * 64 + n * 16 + fr, ks * 32 + fq * 8));
#pragma unroll
      for (int m = 0; m < 8; ++m)
#pragma unroll
        for (int n = 0; n < 4; ++n)
          acc[m][n] = __builtin_amdgcn_mfma_f32_16x16x32_bf16(__builtin_bit_cast(bf16x8, Bf[n]), __builtin_bit_cast(bf16x8, At[m]), acc[m][n], 0, 0, 0);
    }
    G_WAIT_V0();
    __syncthreads();
  }
}

__device__ __forceinline__ void g_zero(f32x4 (&acc)[8][4]) {
#pragma unroll
  for (int m = 0; m < 8; m++)
#pragma unroll
    for (int n = 0; n < 4; n++) acc[m][n] = (f32x4){0.f, 0.f, 0.f, 0.f};
}
__device__ __forceinline__ uint2 pk4(f32x4 v) { return make_uint2(pk2(v[0], v[1]), pk2(v[2], v[3])); }

__device__ __forceinline__ void wave_store_rows(char* wsm, u16* gbase, const size_t ld, const f32x4 (&acc)[8][4], const int lane) {
  const int fr = lane & 15, fq = lane >> 4;
  const int rr = lane >> 3, ch = lane & 7;
  typedef __attribute__((ext_vector_type(4))) unsigned u32x4_t;
#pragma unroll
  for (int hf = 0; hf < 2; hf++) {
#pragma unroll
    for (int m = 0; m < 4; m++)
#pragma unroll
      for (int n = 0; n < 4; n++) {
        const int row = m * 16 + fr, chunk = n * 2 + (fq >> 1);
        *(uint2*)(wsm + row * 128 + ((chunk ^ (fr & 7)) << 4) + (fq & 1) * 8) = pk4(acc[hf * 4 + m][n]);
      }
#pragma unroll
    for (int i = 0; i < 8; i++) {
      const int row = i * 8 + rr;
      const uint4 v = *(const uint4*)(wsm + row * 128 + ((ch ^ (row & 7)) << 4));
      __builtin_nontemporal_store(__builtin_bit_cast(u32x4_t, v), (u32x4_t*)(gbase + (size_t)(hf * 64 + row) * ld + ch * 8));
    }
  }
}
__device__ __forceinline__ void wave_store_cols(char* wsm, u16* vt, const int vcol0, const int nh, const int bl, const int t0,
                                                const f32x4 (&acc)[8][4], const int lane) {
  const int fr = lane & 15, fq = lane >> 4;
#pragma unroll
  for (int m = 0; m < 8; m++)
#pragma unroll
    for (int n = 0; n < 4; n++)
#pragma unroll
      for (int j = 0; j < 4; j++) {
        const int d = n * 16 + fq * 4 + j, t = m * 16 + fr;
        *(u16*)(wsm + d * 256 + (((t >> 3) ^ (d & 15)) << 4) + (t & 7) * 2) = f2bf(acc[m][n][j]);
      }
  const int dd = lane >> 4, ch = lane & 15;
#pragma unroll
  for (int i = 0; i < 16; i++) {
    const int d = i * 4 + dd;
    const uint4 v = *(const uint4*)(wsm + d * 256 + ((ch ^ (d & 15)) << 4));
    const int vcol = vcol0 + d;
    *(uint4*)(vt + ((size_t)(bl * nh + (vcol >> 6)) * 64 + (vcol & 63)) * TSEQ + t0 + ch * 8) = v;
  }
}

__device__ void gemm1_phase(const Params& P, int layer, char* smem) {
  const int CT = P.NB * TSEQ;
  const int nM = CT >> 8, nN = INCP >> 8;
  const u16* Bt = P.WinT + (size_t)layer * INCP * DM;
  u16* p_qr = P.qr; u16* p_proj = P.proj;
  asm volatile("" : "+s"(p_qr), "+s"(p_proj));
  for (int i = 0;; i++) {
    GTile u, un;
    if (!g_next(i, gridDim.x, blockIdx.x, nM, nN, u)) break;
    const bool hn = g_next(i + 1, gridDim.x, blockIdx.x, nM, nN, un);
    const int tid = opaque_tid(), wid = tid >> 6, lane = tid & 63, wr = wid >> 2, wc = wid & 3, fr = lane & 15, fq = lane >> 4;
    f32x4 acc[8][4];
    g_zero(acc);
    g_kloop(P.h + (size_t)(u.pm * 256) * DM, Bt + (size_t)(u.pn * 256) * DM, DM, smem, acc, tid, i > 0,
            P.h + (size_t)(un.pm * 256) * DM, Bt + (size_t)(un.pn * 256) * DM, hn);
    const int cw = u.pn * 256 + wc * 64;
    const int row0 = u.pm * 256 + wr * 128 + fr;
    char* wsm = smem + G_STAGE_B + wid * 8192;
    const int rowb = u.pm * 256 + wr * 128;
    const bool rope_q = cw < 1024;
    const bool rope_k = (cw >= C_KV + 256 && cw < C_KV + 384) || (cw >= C_KV + 512 && cw < C_KV + 640);
    const bool mixed = (cw == 5888);
    if (cw >= INC) {
    } else if (rope_q || rope_k) {
      if (rope_q) wave_store_rows(wsm, p_proj + (size_t)rowb * INC + cw, INC, acc, lane);
#pragma unroll
      for (int m = 0; m < 8; m++) {
        const int tt = (row0 + m * 16) & (TSEQ - 1);
#pragma unroll
        for (int n = 0; n < 2; n++) {
          const float4 c = *(const float4*)(P.ropec + tt * 32 + n * 16 + fq * 4);
          const float4 sn = *(const float4*)(P.ropes + tt * 32 + n * 16 + fq * 4);
          const f32x4 x1 = acc[m][n], x2 = acc[m][n + 2];
          f32x4 r1, r2;
          r1[0] = x1[0] * c.x - x2[0] * sn.x; r2[0] = x2[0] * c.x + x1[0] * sn.x;
          r1[1] = x1[1] * c.y - x2[1] * sn.y; r2[1] = x2[1] * c.y + x1[1] * sn.y;
          r1[2] = x1[2] * c.z - x2[2] * sn.z; r2[2] = x2[2] * c.z + x1[2] * sn.z;
          r1[3] = x1[3] * c.w - x2[3] * sn.w; r2[3] = x2[3] * c.w + x1[3] * sn.w;
          acc[m][n] = r1; acc[m][n + 2] = r2;
        }
      }
      if (rope_q) wave_store_rows(wsm, p_qr + (size_t)rowb * DM + cw, DM, acc, lane);
      else wave_store_rows(wsm, p_proj + (size_t)rowb * INC + cw, INC, acc, lane);
    } else if (!mixed) {
      wave_store_rows(wsm, p_proj + (size_t)rowb * INC + cw, INC, acc, lane);
    } else {
#pragma unroll
      for (int n = 0; n < 4; n++) {
        const int c0 = cw + n * 16 + fq * 4;
        if (c0 < C_FB) {
#pragma unroll
          for (int m = 0; m < 8; m++) *(uint2*)(p_proj + (size_t)(row0 + m * 16) * INC + c0) = pk4(acc[m][n]);
        } else {
#pragma unroll
          for (int m = 0; m < 8; m++)
            *(float4*)(P.flog + (size_t)(row0 + m * 16) * 16 + (c0 - C_FB)) = make_float4(acc[m][n][0], acc[m][n][1], acc[m][n][2], acc[m][n][3]);
        }
        __builtin_amdgcn_sched_barrier(0);
      }
    }
    __syncthreads();
  }
}

__device__ void gemm2_phase(const Params& P, int layer, char* smem) {
  const int CT = P.NB * TSEQ;
  const int nM = CT >> 8, nN = 4;
  const u16* p_ya = P.ya; const u16* p_yb = P.yb; const u16* p_wa = P.WpaT; const u16* p_wb = P.WpbT;
  for (int i = 0;; i++) {
    GTile u, un;
    if (!g_next(i, gridDim.x, blockIdx.x, nM, nN, u)) break;
    const bool hn = g_next(i + 1, gridDim.x, blockIdx.x, nM, nN, un);
    const int tid = opaque_tid(), wid = tid >> 6, lane = tid & 63, wr = wid >> 2, wc = wid & 3, fr = lane & 15, fq = lane >> 4;
    f32x4 acc[8][4];
    g_zero(acc);
#pragma unroll 1
    for (int pass = 0; pass < 2; pass++) {
      const u16* Ap = (pass ? p_yb : p_ya) + (size_t)(u.pm * 256) * DM;
      const u16* Bp = (pass ? p_wb : p_wa) + (size_t)layer * DM * DM + (size_t)(u.pn * 256) * DM;
      const u16* nAp = pass ? (p_ya + (size_t)(un.pm * 256) * DM) : (p_yb + (size_t)(u.pm * 256) * DM);
      const u16* nBp = pass ? (p_wa + (size_t)layer * DM * DM + (size_t)(un.pn * 256) * DM) : (p_wb + (size_t)layer * DM * DM + (size_t)(u.pn * 256) * DM);
      g_kloop(Ap, Bp, DM, smem, acc, tid, (i > 0) || (pass > 0), nAp, nBp, pass ? hn : true);
      __builtin_amdgcn_sched_barrier(0);
      if (pass == 0) {
        const int tid1 = opaque_tid(), wid1 = tid1 >> 6, lane1 = tid1 & 63, wr1 = wid1 >> 2, wc1 = wid1 & 3, fr1 = lane1 & 15, fq1 = lane1 >> 4;
        const u16* pp = P.proj + (size_t)(u.pm * 256 + wr1 * 128 + fr1) * INC + u.pn * 256 + wc1 * 64 + fq1 * 4;
#pragma unroll
        for (int m = 0; m < 8; m++) {
#pragma unroll
          for (int n = 0; n < 4; n++) {
            const uint2 ra = *(const uint2*)(pp + (size_t)(m * 16) * INC + C_RA + n * 16);
            const uint2 rb = *(const uint2*)(pp + (size_t)(m * 16) * INC + C_RB + n * 16);
            acc[m][n][0] *= (1.f + __expf(-bflo(rb.x))) * __builtin_amdgcn_rcpf(1.f + __expf(-bflo(ra.x)));
            acc[m][n][1] *= (1.f + __expf(-bfhi(rb.x))) * __builtin_amdgcn_rcpf(1.f + __expf(-bfhi(ra.x)));
            acc[m][n][2] *= (1.f + __expf(-bflo(rb.y))) * __builtin_amdgcn_rcpf(1.f + __expf(-bflo(ra.y)));
            acc[m][n][3] *= (1.f + __expf(-bfhi(rb.y))) * __builtin_amdgcn_rcpf(1.f + __expf(-bfhi(ra.y)));
          }
          if (m & 1) __builtin_amdgcn_sched_barrier(0);
        }
      }
    }
    {
      const int tid2 = opaque_tid(), wid2 = tid2 >> 6, lane2 = tid2 & 63, wr2 = wid2 >> 2, wc2 = wid2 & 3, fr2 = lane2 & 15, fq2 = lane2 >> 4;
      const u16* pp = P.proj + (size_t)(u.pm * 256 + wr2 * 128 + fr2) * INC + u.pn * 256 + wc2 * 64 + fq2 * 4;
#pragma unroll
      for (int m = 0; m < 8; m++) {
#pragma unroll
        for (int n = 0; n < 4; n++) {
          const uint2 rb = *(const uint2*)(pp + (size_t)(m * 16) * INC + C_RB + n * 16);
          acc[m][n][0] *= sigmoidf_(bflo(rb.x)); acc[m][n][1] *= sigmoidf_(bfhi(rb.x));
          acc[m][n][2] *= sigmoidf_(bflo(rb.y)); acc[m][n][3] *= sigmoidf_(bfhi(rb.y));
        }
        if (m & 1) __builtin_amdgcn_sched_barrier(0);
      }
      wave_store_rows(smem + G_STAGE_B + wid2 * 8192, P.h + (size_t)(u.pm * 256 + wr2 * 128) * DM + u.pn * 256 + wc2 * 64, DM, acc, lane2);
    }
    __syncthreads();
  }
}

__device__ void gemm3_phase(const Params& P, int layer, int chunk, char* smem) {
  const int CT = P.NB * TSEQ;
  const int nM = CT >> 8, nN = 4;
  const float* xs = (layer == 0 ? P.x_in : P.out) + (size_t)chunk * CT * DM;
  float* xd = P.out + (size_t)chunk * CT * DM;
  for (int i = 0;; i++) {
    GTile u, un;
    if (!g_next(i, gridDim.x, blockIdx.x, nM, nN, u)) break;
    const bool hn = g_next(i + 1, gridDim.x, blockIdx.x, nM, nN, un);
    const int tid = opaque_tid(), wid = tid >> 6, lane = tid & 63, wr = wid >> 2, wc = wid & 3, fr = lane & 15, fq = lane >> 4;
    f32x4 acc[8][4];
    g_zero(acc);
    g_kloop(P.h + (size_t)(u.pm * 256) * DM, P.WoT + (size_t)layer * DM * DM + (size_t)(u.pn * 256) * DM, DM, smem, acc, tid, i > 0,
            P.h + (size_t)(un.pm * 256) * DM, P.WoT + (size_t)layer * DM * DM + (size_t)(un.pn * 256) * DM, hn);
    const size_t off = (size_t)(u.pm * 256 + wr * 128 + fr) * DM + u.pn * 256 + wc * 64 + fq * 4;
#pragma unroll
    for (int m = 0; m < 8; m++) {
#pragma unroll
      for (int n = 0; n < 4; n++) {
        const float4 xo = *(const float4*)(xs + off + (size_t)(m * 16) * DM + n * 16);
        *(float4*)(xd + off + (size_t)(m * 16) * DM + n * 16) =
            make_float4(xo.x + acc[m][n][0], xo.y + acc[m][n][1], xo.z + acc[m][n][2], xo.w + acc[m][n][3]);
      }
      if (m & 1) __builtin_amdgcn_sched_barrier(0);
    }
  }
}

__device__ __forceinline__ void compress_item(const Params& P, const int layer, const int it, char* smem_all, const int tid_all) {
  const int half = tid_all >> 8, tid = tid_all & 255;
  char* smem = smem_all + half * 65536;
  const int lane = tid & 63, r = lane & 31, h = lane >> 5, w = tid >> 6;
  const int wm = w >> 1, wn = w & 1;
  const int unit = it * 2 + half;
  const int bl = unit >> 2, g = (unit >> 1) & 1, kv = unit & 1;
  f32x16 acc[2][2];
  zero_acc(acc);
  ACmp af{P.proj + (size_t)bl * TSEQ * INC + C_KV + kv * 128 + g * 64};
  gemm_mainloop(af, P.W1T + (size_t)(layer * 2 + kv) * 128 * 2048, 2048, 2048, smem, acc, tid);
  const float* bp = P.bias1p + (size_t)((layer * 2 + kv) * 8) * 128;
#pragma unroll
  for (int ni = 0; ni < 2; ni++) {
    int hc = wn * 64 + ni * 32 + r;
    float b1 = 0.f;
#pragma unroll
    for (int q = 0; q < 8; q++) b1 += bp[q * 128 + hc];
#pragma unroll
    for (int mi = 0; mi < 2; mi++)
#pragma unroll
      for (int i = 0; i < 16; i++) {
        int n = wm * 64 + mi * 32 + 8 * (i >> 2) + 4 * h + (i & 3);
        float v = siluf_(acc[mi][ni][i] + b1);
        *(u16*)(smem + n * 256 + (((hc >> 3) ^ (n & 15)) << 4) + (hc & 7) * 2) = f2bf(v);
      }
  }
  __syncthreads();
  const u16* w2t = P.W2T + (size_t)(layer * 2 + kv) * 64 * 128;
  f32x16 o2[2];
#pragma unroll
  for (int dt = 0; dt < 2; dt++)
#pragma unroll
    for (int i = 0; i < 16; i++) o2[dt][i] = 0.f;
#pragma unroll
  for (int kk = 0; kk < 8; kk++) {
    int n = w * 32 + r;
    bf16x8 a = ldfrag(smem + n * 256 + (((kk * 2 + h) ^ (n & 15)) << 4));
#pragma unroll
    for (int dt = 0; dt < 2; dt++) {
      bf16x8 b = ldfrag(w2t + (size_t)(dt * 32 + r) * 128 + kk * 16 + h * 8);
      o2[dt] = mfma32(a, b, o2[dt]);
    }
  }
#pragma unroll
  for (int dt = 0; dt < 2; dt++) {
    int d = dt * 32 + r;
    if (kv == 0) {
#pragma unroll
      for (int i = 0; i < 16; i++) {
        int n = w * 32 + 8 * (i >> 2) + 4 * h + (i & 3);
        P.kcmp[((size_t)(bl * 2 + g) * 128 + n) * 64 + d] = f2bf(o2[dt][i]);
      }
    } else {
#pragma unroll
      for (int gq = 0; gq < 4; gq++) {
        int n0 = w * 32 + 8 * gq + 4 * h;
        uint2 o;
        o.x = pk2(o2[dt][gq * 4 + 0], o2[dt][gq * 4 + 1]);
        o.y = pk2(o2[dt][gq * 4 + 2], o2[dt][gq * 4 + 3]);
        *(uint2*)(P.vcmpt + ((size_t)(bl * 2 + g) * 64 + d) * 128 + n0) = o;
      }
    }
  }
  __syncthreads();
}

__device__ void pb_phase(const Params& P, int layer, char* smem_all) {
  const int tid = opaque_tid();
  const int lane = tid & 63, w = tid >> 6;
  float* wsum = (float*)smem_all;
  const int nScan = P.NB * 16;
  for (int it = blockIdx.x; it < nScan; it += gridDim.x) {
    const int bl = it >> 4, hh = it & 15;
    const float bf = P.b_forget[layer * 16 + hh];
    const float* fl = P.flog + ((size_t)bl * TSEQ + tid * 4) * 16 + hh;
    float ls[4];
#pragma unroll
    for (int j = 0; j < 4; j++) {
      const float x = fl[j * 16] + bf;
      ls[j] = (x >= 0.f) ? -log1pf(__expf(-x)) : (x - log1pf(__expf(x)));
    }
    const float loc = (ls[0] + ls[1]) + (ls[2] + ls[3]);
    float incl = loc;
#pragma unroll
    for (int o = 1; o < 64; o <<= 1) {
      const float v = __shfl_up(incl, o);
      if (lane >= o) incl += v;
    }
    __syncthreads();
    if (lane == 63) wsum[w] = incl;
    __syncthreads();
    float base = 0.f;
#pragma unroll
    for (int q = 0; q < 8; q++) base += (q < w) ? wsum[q] : 0.f;
    float run = base + incl - loc;
    float4 o4;
    run += ls[0]; o4.x = -8.0f * run;
    run += ls[1]; o4.y = -8.0f * run;
    run += ls[2]; o4.z = -8.0f * run;
    run += ls[3]; o4.w = -8.0f * run;
    *(float4*)(P.F2 + ((size_t)bl * 16 + hh) * TSEQ + tid * 4) = o4;
  }
}

__device__ void pc1_phase(const Params& P, char* smem) {
  const int tid = opaque_tid(),  lane = tid & 63, r = lane & 31, h = lane >> 5, w = tid >> 6;
  const int nItems = P.NB * 2 * 8;
  const float c1 = 0.125f * LOG2E;
  for (int it = blockIdx.x; it < nItems; it += gridDim.x) {
    const int qt = it & 7, g = (it >> 3) & 1, bl = it >> 4;
    __syncthreads();
#pragma unroll
    for (int j = 0; j < 2; j++) {
      int c = tid + 512 * j;
      {
        int n = c >> 3, ch = c & 7;
        uint4 v = *(const uint4*)(P.kcmp + ((size_t)(bl * 2 + g) * 128 + n) * 64 + ch * 8);
        *(uint4*)(smem + n * 128 + ((ch ^ ((n >> 1) & 7)) << 4)) = v;
      }
      {
        int d = c >> 4, ch = c & 15;
        uint4 v = *(const uint4*)(P.vcmpt + ((size_t)(bl * 2 + g) * 64 + d) * 128 + ch * 8);
        int sw = d & 31;
        *(uint2*)(smem + 16384 + d * 256 + (((2 * ch) ^ sw) << 3)) = make_uint2(v.x, v.y);
        *(uint2*)(smem + 16384 + d * 256 + (((2 * ch + 1) ^ sw) << 3)) = make_uint2(v.z, v.w);
      }
    }
    __syncthreads();
    const int qw_lo = qt * 256 + w * 32;
    const int qtok = qw_lo + r;
    const size_t rowg = (size_t)bl * TSEQ + qtok;
    const int tq = qtok - 31 - 64 * h;
    float sumacc[16], lastacc[16];
#pragma unroll
    for (int s = 0; s < 16; s++) { sumacc[s] = 0.f; lastacc[s] = 0.f; }
#pragma unroll 1
    for (int hh = 0; hh < 8; hh++) {
      const int head = g * 8 + hh;
      bf16x8 qf[4];
#pragma unroll
      for (int kk = 0; kk < 4; kk++) qf[kk] = ldfrag(P.proj + rowg * INC + C_QA + head * 64 + kk * 16 + h * 8);
      f32x16 s[4];
#pragma unroll
      for (int nt = 0; nt < 4; nt++) {
#pragma unroll
        for (int i = 0; i < 16; i++) s[nt][i] = 0.f;
#pragma unroll
        for (int kk = 0; kk < 4; kk++) {
          int row = nt * 32 + r;
          bf16x8 a = ldfrag(smem + row * 128 + (((kk * 2 + h) ^ ((row >> 1) & 7)) << 4));
          s[nt] = mfma32(a, qf[kk], s[nt]);
        }
      }
      float mx = -3.0e38f;
#pragma unroll
      for (int nt = 0; nt < 4; nt++)
#pragma unroll
        for (int i = 0; i < 16; i++) {
          bool ok = (16 * (nt * 32 + 8 * (i >> 2) + (i & 3))) <= tq;
          float v = ok ? s[nt][i] * c1 : -3.0e38f;
          s[nt][i] = v;
          mx = fmaxf(mx, v);
        }
      mx = fmaxf(mx, __shfl_xor(mx, 32));
      const bool anyv = mx > -1.0e37f;
      float mref = anyv ? mx : 0.f;
      float l = 0.f;
#pragma unroll
      for (int nt = 0; nt < 4; nt++)
#pragma unroll
        for (int i = 0; i < 16; i++) {
          float p = __builtin_amdgcn_exp2f(s[nt][i] - mref);
          s[nt][i] = p;
          l += p;
        }
      l += __shfl_xor(l, 32);
      const float inv = (anyv && l > 0.f) ? 1.f / l : 0.f;
#pragma unroll
      for (int nt = 0; nt < 4; nt++)
#pragma unroll
        for (int i = 0; i < 16; i++) s[nt][i] *= inv;
#pragma unroll
      for (int nt = 0; nt < 4; nt++)
#pragma unroll
        for (int gq = 0; gq < 4; gq++) {
          sumacc[nt * 4 + gq] += (s[nt][gq * 4] + s[nt][gq * 4 + 1]) + (s[nt][gq * 4 + 2] + s[nt][gq * 4 + 3]);
          lastacc[nt * 4 + gq] += s[nt][gq * 4 + 3];
        }
      uint4 pbv[8];
#pragma unroll
      for (int ks = 0; ks < 8; ks++) {
        const int nt = ks >> 1, hb = (ks & 1) * 8;
        pbv[ks].x = pk2(s[nt][hb + 0], s[nt][hb + 1]); pbv[ks].y = pk2(s[nt][hb + 2], s[nt][hb + 3]);
        pbv[ks].z = pk2(s[nt][hb + 4], s[nt][hb + 5]); pbv[ks].w = pk2(s[nt][hb + 6], s[nt][hb + 7]);
      }
      const float g0 = sigmoidf_(bf2f(P.proj[rowg * INC + C_GA + head]));
#pragma unroll
      for (int dt = 0; dt < 2; dt++) {
        f32x16 o;
#pragma unroll
        for (int i = 0; i < 16; i++) o[i] = 0.f;
        const int d = dt * 32 + r, sw = d & 31;
#pragma unroll
        for (int ks = 0; ks < 8; ks++) {
          uint2 lo = *(const uint2*)(smem + 16384 + d * 256 + (((ks * 4 + h) ^ sw) << 3));
          uint2 hi = *(const uint2*)(smem + 16384 + d * 256 + (((ks * 4 + 2 + h) ^ sw) << 3));
          uint4 au = make_uint4(lo.x, lo.y, hi.x, hi.y);
          o = mfma32(__builtin_bit_cast(bf16x8, au), __builtin_bit_cast(bf16x8, pbv[ks]), o);
        }
#pragma unroll
        for (int gq = 0; gq < 4; gq++) {
          int d0 = dt * 32 + 8 * gq + 4 * h;
          uint2 ov;
          ov.x = pk2(o[gq * 4 + 0] * g0, o[gq * 4 + 1] * g0);
          ov.y = pk2(o[gq * 4 + 2] * g0, o[gq * 4 + 3] * g0);
          *(uint2*)(P.ya + rowg * DM + head * 64 + d0) = ov;
        }
        __builtin_amdgcn_sched_barrier(0);
      }
    }
    float sc[16];
#pragma unroll
    for (int s = 0; s < 16; s++) {
      float prev = (s == 0) ? 0.f : lastacc[s - 1];
      float sendv = h ? prev : lastacc[s];
      float recv = __shfl_xor(sendv, 32);
      float imp = sumacc[s] + recv;
      int j = (s >> 2) * 8 + (s & 3) * 2 + h;
      int cur = qtok >> 6;
      bool forced = (j == 0) || (j == cur) || (j == cur - 1);
      bool valid = j <= cur;
      sc[s] = forced ? 1.0e4f : (valid ? imp : -1.0f);
    }
    unsigned mask = 0u;
#pragma unroll 1
    for (int rd = 0; rd < 8; rd++) {
      float best = -2.0f; int bj = 0;
#pragma unroll
      for (int s = 0; s < 16; s++) {
        int j = (s >> 2) * 8 + (s & 3) * 2 + h;
        if (sc[s] > best) { best = sc[s]; bj = j; }
      }
      float ob = __shfl_xor(best, 32);
      int oj = __shfl_xor(bj, 32);
      bool mine = (best > ob) || (best == ob && bj < oj);
      int wj = mine ? bj : oj;
      mask |= 1u << wj;
#pragma unroll
      for (int s = 0; s < 16; s++) {
        int j = (s >> 2) * 8 + (s & 3) * 2 + h;
        if (j == wj) sc[s] = -3.0f;
      }
    }
    if (h == 0) P.sel[(size_t)(bl * 2 + g) * TSEQ + qtok] = mask;
  }
}

#define A_SLOTB 8192
#define A_LDS_K 0
#define A_LDS_V 24576
#define A_LDS_WS 49152
#define A_LDS_F 51200
#define A_LDS_OST 52224
#define A_THR 8.0f
#define A_C2 (0.125f * LOG2E)
typedef __attribute__((ext_vector_type(4))) short a_s16x4;
typedef __attribute__((ext_vector_type(8))) short a_s16x8;
typedef __attribute__((ext_vector_type(4))) unsigned a_u32x4;
typedef __attribute__((address_space(3))) const char* a_lds_cptr;
typedef short a_v4i16 __attribute__((ext_vector_type(4)));
#define A_SBAR() __builtin_amdgcn_sched_barrier(0)
#define A_PIN(x) asm volatile("" : "+v"(x))
#define A_MFMA(a, b, c) __builtin_amdgcn_mfma_f32_32x32x16_bf16(a, b, c, 0, 0, 0)
template <int N> __device__ __forceinline__ void a_wait_bar() { asm volatile("s_waitcnt vmcnt(%0) lgkmcnt(0)\n\ts_barrier" ::"n"(N) : "memory"); }
__device__ __forceinline__ int a_crow(int r, int hi) { return (r & 3) + 8 * (r >> 2) + 4 * hi; }
__device__ __forceinline__ unsigned a_cvtpk(float lo, float hi) { unsigned r; asm("v_cvt_pk_bf16_f32 %0, %1, %2" : "=v"(r) : "v"(lo), "v"(hi)); return r; }
__device__ __forceinline__ void a_glds16(const void* g, unsigned lds_base) {
  unsigned sv; asm volatile("s_mov_b32 %0, m0\n\ts_mov_b32 m0, %2\n\ts_nop 0\n\tglobal_load_lds_dwordx4 %1, off\n\ts_mov_b32 m0, %0" : "=&s"(sv) : "v"(g), "s"(lds_base) : "memory"); }
__device__ __forceinline__ void a_glds4(const void* g, unsigned lds_base) {
  unsigned sv; asm volatile("s_mov_b32 %0, m0\n\ts_mov_b32 m0, %2\n\ts_nop 0\n\tglobal_load_lds_dword %1, off\n\ts_mov_b32 m0, %0" : "=&s"(sv) : "v"(g), "s"(lds_base) : "memory"); }
__device__ __forceinline__ void a_kload2(bf16x8* kf, a_lds_cptr kp, int d0) {
  kf[2 * d0] = *(const __attribute__((address_space(3))) bf16x8*)(kp + d0 * 2048);
  kf[2 * d0 + 1] = *(const __attribute__((address_space(3))) bf16x8*)(kp + d0 * 2048 + 512); }
__device__ __forceinline__ a_s16x4 a_vtr(a_lds_cptr p) { return __builtin_bit_cast(a_s16x4, __builtin_amdgcn_ds_read_tr16_b64_v4i16((__attribute__((address_space(3))) a_v4i16*)p)); }
#define A_MX3(a, b, c) __builtin_fmaxf(__builtin_fmaxf((a), (b)), (c))
__device__ __forceinline__ float a_rowmax(const f32x16& p0, const f32x16& p1) {
  float a = A_MX3(p0[0], p0[1], p1[0]), b = A_MX3(p0[2], p0[3], p1[1]); a = A_MX3(a, p1[2], p1[3]);
#pragma unroll
  for (int r = 4; r < 16; r += 4) { a = A_MX3(a, p0[r], p0[r + 1]); b = A_MX3(b, p0[r + 2], p0[r + 3]); a = A_MX3(a, p1[r], p1[r + 1]); b = A_MX3(b, p1[r + 2], p1[r + 3]); }
  float m = __builtin_fmaxf(a, b); auto rr = __builtin_amdgcn_permlane32_swap(__float_as_uint(m), __float_as_uint(m), false, false);
  return __builtin_fmaxf(__uint_as_float(rr[0]), __uint_as_float(rr[1])); }
template <int MODE>
__device__ __forceinline__ void a_mask(f32x16& p0, f32x16& p1, int key0, int qabs, int hi) {
  const int kb = key0 + 4 * hi;
#pragma unroll
  for (int r = 0; r < 16; ++r) {
    const int kv = kb + (r & 3) + 8 * (r >> 2);
    bool bad0 = kv > qabs, bad1 = (kv + 32) > qabs;
    if (MODE == 2) { bad0 = bad0 || (kv + 512 <= qabs); bad1 = bad1 || (kv + 32 + 512 <= qabs); }
    if (bad0) p0[r] = -INFINITY;
    if (bad1) p1[r] = -INFINITY;
  } }
__device__ __forceinline__ void a_bias(f32x16& p0, f32x16& p1, const char* fb, int hi) {
#pragma unroll
  for (int g = 0; g < 4; ++g) {
    const float4 b0 = *(const float4*)(fb + (8 * g + 4 * hi) * 4);
    const float4 b1 = *(const float4*)(fb + (32 + 8 * g + 4 * hi) * 4);
    p0[4 * g + 0] += b0.x; p0[4 * g + 1] += b0.y; p0[4 * g + 2] += b0.z; p0[4 * g + 3] += b0.w;
    p1[4 * g + 0] += b1.x; p1[4 * g + 1] += b1.y; p1[4 * g + 2] += b1.z; p1[4 * g + 3] += b1.w;
  } }

template <int MODE>
__device__ __forceinline__ void a_unit(const u16* __restrict__ Qw, const int qp, const u16* __restrict__ Kp, const u16* __restrict__ Vp,
                                       const float* __restrict__ Fp, const int NT, const int key00, const int qabs, const unsigned selm,
                                       const float gate, char* lds, u16* stg, const int tid) {
  constexpr int NK = (MODE == 0) ? 2 : 1;
  const int lane = tid & 63, r32 = lane & 31, hi = lane >> 5; const int wid = __builtin_amdgcn_readfirstlane(tid >> 6);
  const unsigned lds0 = (unsigned)(uintptr_t)lds; float* wsf = (float*)(lds + A_LDS_WS) + wid * 64;
  const u16* ksrc = Kp + (long)lane * INC + wid * 8;
  const u16* vsrc = Vp + (long)(16 * (wid & 3) + (lane >> 2)) * INC + (wid >> 2) * 32 + (lane & 3) * 8;
  const float* fsrc = Fp + lane;
  const unsigned kdst = lds0 + A_LDS_K + wid * 1024, vdst = lds0 + A_LDS_V + wid * 1024, fdst = lds0 + A_LDS_F;
#define A_DMA_K(t, slot) do { a_glds16(ksrc + (long)(t) * 64 * INC, (unsigned)__builtin_amdgcn_readfirstlane(kdst + (slot))); \
    if (MODE == 0) a_glds4(fsrc + (t) * 64, (unsigned)__builtin_amdgcn_readfirstlane(fdst + ((t) & 3) * 256)); } while (0)
#define A_DMA_V(t, slot) a_glds16(vsrc + (long)(t) * 64 * INC, (unsigned)__builtin_amdgcn_readfirstlane(vdst + (slot)))
  const a_lds_cptr vp0 = (a_lds_cptr)lds + A_LDS_V + ((lane >> 4) & 1) * 32 + (lane & 3) * 8 + (4 * hi + ((lane & 15) >> 2)) * 64;
  const a_lds_cptr kp0 = (a_lds_cptr)lds + A_LDS_K + hi * 1024 + r32 * 16;
  const char* fb0 = lds + A_LDS_F;
  A_DMA_K(0, 0); A_DMA_V(0, 0); A_DMA_K(1, A_SLOTB);
  bf16x8 qr[4];
#pragma unroll
  for (int d0 = 0; d0 < 4; ++d0) qr[d0] = ldfrag(Qw + (long)r32 * qp + d0 * 16 + hi * 8);
  float mhat = 0.f, l_reg = 0.f; f32x16 o[2];
#pragma unroll
  for (int r = 0; r < 16; ++r) { o[0][r] = 0.f; o[1][r] = 0.f; }
  const f32x16 zero16 = {0.f, 0.f, 0.f, 0.f, 0.f, 0.f, 0.f, 0.f, 0.f, 0.f, 0.f, 0.f, 0.f, 0.f, 0.f, 0.f};
  bool resc = false;
  f32x16 pA0, pA1, pB0, pB1; bf16x8 kf[8]; a_s16x4 vlo[8], vhi[8]; a_u32x4 pw0, pw1, pw2, pw3;
  int sl_prev = 0, sl_cur = 0, sl_next = A_SLOTB;
#define A_ROT() do { sl_prev = sl_cur; sl_cur = sl_next; sl_next = (sl_next == 2 * A_SLOTB) ? 0 : sl_next + A_SLOTB; } while (0)
#define A_EX(v) __builtin_amdgcn_exp2f(__builtin_fmaf((v), A_C2, nmh))
#define A_RESC() do { if (resc) { _Pragma("unroll") for (int d_ = 0; d_ < 2; ++d_) _Pragma("unroll") for (int r = 0; r < 16; ++r) o[d_][r] *= wsf[a_crow(r, hi)]; } } while (0)
  A_DMA_K(2, 2 * A_SLOTB);
  a_wait_bar<1 + 2 * NK>();
  _Pragma("unroll") for (int d0 = 0; d0 < 4; ++d0) a_kload2(kf, kp0, d0);
  pA0 = A_MFMA(kf[0], qr[0], zero16); pA1 = A_MFMA(kf[1], qr[0], zero16); pA0 = A_MFMA(kf[2], qr[1], pA0); pA1 = A_MFMA(kf[3], qr[1], pA1);
  pA0 = A_MFMA(kf[4], qr[2], pA0); pA1 = A_MFMA(kf[5], qr[2], pA1); pA0 = A_MFMA(kf[6], qr[3], pA0); pA1 = A_MFMA(kf[7], qr[3], pA1);
  if (MODE == 0) a_bias(pA0, pA1, fb0, hi);
  if (MODE == 2 || NT == 4) a_mask<MODE>(pA0, pA1, key00, qabs, hi);
  { const float rm = a_rowmax(pA0, pA1); mhat = __builtin_fmaxf(rm * A_C2, -1.0e30f); const float nmh = -mhat;
#pragma unroll
    for (int r = 0; r < 16; ++r) { pA0[r] = A_EX(pA0[r]); pA1[r] = A_EX(pA1[r]); } }
  a_wait_bar<0>();
  A_DMA_K(3, 0); A_DMA_V(1, A_SLOTB); A_ROT();
  _Pragma("unroll") for (int d0 = 0; d0 < 4; ++d0) a_kload2(kf, kp0 + sl_cur, d0);
  a_wait_bar<NK + 1>();
#define A_PKW(P, i) a_cvtpk(P[i], P[i + 1])
#define A_PAF(k) __builtin_bit_cast(bf16x8, pw##k)
#define A_VFR(i) __builtin_bit_cast(bf16x8, __builtin_shufflevector(vlo[i], vhi[i], 0, 1, 2, 3, 4, 5, 6, 7))
#define A_VRD(i) do { vlo[i] = a_vtr(vp_ + (((i) >> 2) * 4096 + ((i) & 3) * 1024)); vhi[i] = a_vtr(vp_ + (((i) >> 2) * 4096 + ((i) & 3) * 1024 + 512)); } while (0)
#define A_KRD(G, d0) do { if (G) { a_kload2(kf, kp0 + sl_next, d0); A_SBAR(); } } while (0)
#define A_GAPA(MF, a0, a1, a2, a3, W0, W1, PW) do { MF; sacc += a0; sacc += a1; sacc += a2; sacc += a3; W0; W1; A_PIN(PW); A_PIN(sacc); A_SBAR(); } while (0)
#define A_GAPB(MF, X, i) do { MF; X[i] = A_EX(X[i]); X[i + 1] = A_EX(X[i + 1]); X[i + 2] = A_EX(X[i + 2]); X[i + 3] = A_EX(X[i + 3]); A_PIN(X); A_SBAR(); } while (0)
#define A_STEP(C0, C1, P0, P1, t, MASK, GK, GV, GL) do { A_SBAR(); \
    const a_lds_cptr vp_ = vp0 + sl_prev; \
    A_VRD(0); A_SBAR(); float sacc = P0[0] + P0[1]; \
                      A_GAPA(C0 = A_MFMA(kf[0], qr[0], zero16), P0[2], P0[3], P0[4], P0[5],     pw0[0] = A_PKW(P0, 0),  pw0[1] = A_PKW(P0, 2),  pw0); \
    A_VRD(4); A_SBAR(); A_GAPA(C1 = A_MFMA(kf[1], qr[0], zero16), P0[6], P0[7], P0[8], P0[9],     pw0[2] = A_PKW(P0, 4),  pw0[3] = A_PKW(P0, 6),  pw0); \
    A_VRD(1); A_SBAR(); A_GAPA(C0 = A_MFMA(kf[2], qr[1], C0),    P0[10], P0[11], P0[12], P0[13], pw1[0] = A_PKW(P0, 8),  pw1[1] = A_PKW(P0, 10), pw1); \
    A_VRD(5); A_SBAR(); A_GAPA(C1 = A_MFMA(kf[3], qr[1], C1),    P0[14], P0[15], P1[0], P1[1],   pw1[2] = A_PKW(P0, 12), pw1[3] = A_PKW(P0, 14), pw1); \
    A_VRD(2); A_SBAR(); A_GAPA(C0 = A_MFMA(kf[4], qr[2], C0),    P1[2], P1[3], P1[4], P1[5],     pw2[0] = A_PKW(P1, 0),  pw2[1] = A_PKW(P1, 2),  pw2); \
    A_VRD(6); A_SBAR(); A_GAPA(C1 = A_MFMA(kf[5], qr[2], C1),    P1[6], P1[7], P1[8], P1[9],     pw2[2] = A_PKW(P1, 4),  pw2[3] = A_PKW(P1, 6),  pw2); \
    A_VRD(3); A_SBAR(); A_GAPA(C0 = A_MFMA(kf[6], qr[3], C0),    P1[10], P1[11], P1[12], P1[13], pw3[0] = A_PKW(P1, 8),  pw3[1] = A_PKW(P1, 10), pw3); \
    A_VRD(7); A_SBAR(); A_GAPA(C1 = A_MFMA(kf[7], qr[3], C1),    P1[14], P1[15], 0.f, 0.f,       pw3[2] = A_PKW(P1, 12), pw3[3] = A_PKW(P1, 14), pw3); \
    l_reg += sacc; \
    if (GK) A_DMA_K((t) + 3, sl_cur); if (GV) A_DMA_V((t) + 1, sl_next); \
    if (MODE == 0) a_bias(C0, C1, fb0 + ((t) & 3) * 256, hi); \
    if (MASK) a_mask<MODE>(C0, C1, key00 + (t) * 64, qabs, hi); \
    const bool selb_ = (MODE != 1) || (((selm >> ((t) & 31)) & 1u) != 0u); \
    { float rmx = a_rowmax(C0, C1) * A_C2; if (!selb_) rmx = -INFINITY; resc = false; \
      if (__builtin_expect(__any((rmx - mhat) > A_THR), 0)) { const float mnew = __builtin_fmaxf(mhat, rmx); \
          const float f = __builtin_amdgcn_exp2f(mhat - mnew); mhat = mnew; l_reg *= f; if (hi == 0) wsf[r32] = f; resc = true; } } \
    const float nmh = selb_ ? -mhat : -INFINITY; A_SBAR(); \
    A_GAPB(o[0] = A_MFMA(A_PAF(0), A_VFR(0), o[0]), C0, 0);              A_GAPB(o[1] = A_MFMA(A_PAF(0), A_VFR(4), o[1]), C0, 4); \
    A_KRD(GL, 0); A_GAPB(o[0] = A_MFMA(A_PAF(1), A_VFR(1), o[0]), C0, 8);  A_KRD(GL, 1); A_GAPB(o[1] = A_MFMA(A_PAF(1), A_VFR(5), o[1]), C0, 12); \
    A_KRD(GL, 2); A_GAPB(o[0] = A_MFMA(A_PAF(2), A_VFR(2), o[0]), C1, 0);  A_KRD(GL, 3); A_GAPB(o[1] = A_MFMA(A_PAF(2), A_VFR(6), o[1]), C1, 4); \
    A_GAPB(o[0] = A_MFMA(A_PAF(3), A_VFR(3), o[0]), C1, 8);              A_GAPB(o[1] = A_MFMA(A_PAF(3), A_VFR(7), o[1]), C1, 12); \
    } while (0)
  int t = 1;
  if (MODE != 2) {
    for (; t + 5 < NT; t += 2) {
      A_STEP(pB0, pB1, pA0, pA1, t, false, true, true, true);     a_wait_bar<NK + 1>(); A_RESC(); A_ROT();
      A_STEP(pA0, pA1, pB0, pB1, t + 1, false, true, true, true); a_wait_bar<NK + 1>(); A_RESC(); A_ROT();
    }
  }
#define A_ENDW(tt) do { if ((tt) + 3 < NT) { a_wait_bar<NK + 1>(); } else if ((tt) + 2 < NT) { a_wait_bar<1>(); } else { a_wait_bar<0>(); } } while (0)
  for (; t + 1 < NT; t += 2) {
    A_STEP(pB0, pB1, pA0, pA1, t, (MODE != 2 || t < 4 || t + 4 >= NT), (t + 3 < NT), (t + 1 < NT), (t + 1 < NT));             A_ENDW(t);     A_RESC(); A_ROT();
    A_STEP(pA0, pA1, pB0, pB1, t + 1, (MODE != 2 || t + 1 < 4 || t + 5 >= NT), (t + 4 < NT), (t + 2 < NT), (t + 2 < NT));     A_ENDW(t + 1); A_RESC(); A_ROT();
  }
  A_STEP(pB0, pB1, pA0, pA1, NT - 1, true, false, false, false); A_RESC();
  { float sacc = pB0[0] + pB0[1];
#pragma unroll
    for (int r = 2; r < 16; ++r) sacc += pB0[r];
#pragma unroll
    for (int r = 0; r < 16; ++r) sacc += pB1[r];
    l_reg += sacc;
    pw0 = (a_u32x4){A_PKW(pB0, 0), A_PKW(pB0, 2), A_PKW(pB0, 4), A_PKW(pB0, 6)}; pw1 = (a_u32x4){A_PKW(pB0, 8), A_PKW(pB0, 10), A_PKW(pB0, 12), A_PKW(pB0, 14)};
    pw2 = (a_u32x4){A_PKW(pB1, 0), A_PKW(pB1, 2), A_PKW(pB1, 4), A_PKW(pB1, 6)}; pw3 = (a_u32x4){A_PKW(pB1, 8), A_PKW(pB1, 10), A_PKW(pB1, 12), A_PKW(pB1, 14)};
    const a_lds_cptr vp_ = vp0 + sl_cur; _Pragma("unroll") for (int i = 0; i < 8; ++i) A_VRD(i);
    o[0] = A_MFMA(A_PAF(0), A_VFR(0), o[0]); o[1] = A_MFMA(A_PAF(0), A_VFR(4), o[1]); o[0] = A_MFMA(A_PAF(1), A_VFR(1), o[0]); o[1] = A_MFMA(A_PAF(1), A_VFR(5), o[1]);
    o[0] = A_MFMA(A_PAF(2), A_VFR(2), o[0]); o[1] = A_MFMA(A_PAF(2), A_VFR(6), o[1]); o[0] = A_MFMA(A_PAF(3), A_VFR(3), o[0]); o[1] = A_MFMA(A_PAF(3), A_VFR(7), o[1]); }
  { auto rr = __builtin_amdgcn_permlane32_swap(__float_as_uint(l_reg), __float_as_uint(l_reg), false, false); l_reg = __uint_as_float(rr[0]) + __uint_as_float(rr[1]); }
  if (hi == 0) wsf[32 + r32] = gate / l_reg;
  asm volatile("s_waitcnt lgkmcnt(0)" ::: "memory");
  float rli[16];
#pragma unroll
  for (int r = 0; r < 16; ++r) rli[r] = wsf[32 + a_crow(r, hi)];
#pragma unroll
  for (int r = 0; r < 16; ++r) { const int orow = a_crow(r, hi);
#pragma unroll
    for (int d0 = 0; d0 < 2; ++d0) stg[orow * 64 + d0 * 32 + r32] = f2bf(o[d0][r] * rli[r]); }
  asm volatile("s_waitcnt lgkmcnt(0)\n\ts_barrier" ::: "memory");
#undef A_DMA_K
#undef A_DMA_V
#undef A_ROT
#undef A_EX
#undef A_RESC
#undef A_PKW
#undef A_PAF
#undef A_VFR
#undef A_VRD
#undef A_KRD
#undef A_ENDW
#undef A_GAPA
#undef A_GAPB
#undef A_STEP
}

__device__ void pc2_phase(const Params& P, int layer, int chunk, char* smem, int* s_item, const int which) {
  volatile __attribute__((address_space(3))) unsigned* xst = (volatile __attribute__((address_space(3))) unsigned*)(smem + XB_LDS_OFF);
  const int nx = (int)xst[1], xc = (int)xst[3];
  const int nBH = P.NB * 16;
  const int nStr = which ? (P.NB * 2) : nBH;
  const int nLoc = (nStr - xc + nx - 1) / nx;
  const int nCmpAll = which ? 0 : P.NB * 2;
  const int nCmp = which ? 0 : (nCmpAll - xc + nx - 1) / nx;
  const int nItems = nCmp + (which ? nLoc * 64 : ((nLoc + 3) >> 2) * 32);
  unsigned* ctr = P.ctr + ((chunk * 4 + layer) * 2 + which) * 8 + xc;
  while (true) {
    const int tid = opaque_tid(), lane = tid & 63, r32 = lane & 31, w = tid >> 6;
    __syncthreads();
    if (tid == 0) *s_item = (int)atomicAdd(ctr, 1u);
    __syncthreads();
    const int it0 = *s_item;
    if (it0 >= nItems) break;
    if (it0 < nCmp) { compress_item(P, layer, xc + nx * it0, smem, tid); continue; }
    const int it = it0 - nCmp;
    int qt, bh;
    if (which) {
      const int sl = it >> 6, rem = it & 63;
      qt = 7 - (rem >> 3);
      bh = (xc + nx * sl) * 8 + (rem & 7);
    } else {
      const int grp = it >> 5, rem = it & 31;
      const int sl = grp * 4 + (rem & 3);
      qt = 7 - (rem >> 2);
      if (sl >= nLoc) continue;
      bh = xc + nx * sl;
    }
    const int type = which;
    const int bl = bh >> 4, head = bh & 15;
    const int q0w = qt * 256 + w * 32;
    const int qabs = q0w + r32;
    const size_t rowq = (size_t)bl * TSEQ + qabs;
    const size_t roww = (size_t)bl * TSEQ + q0w;
    const u16* pb_ = P.proj + (size_t)bl * TSEQ * INC;
    u16* stg = (u16*)(smem + A_LDS_OST) + w * 4096;
    const int er = lane >> 3, ec = (lane & 7) * 8;
    if (type == 0) {
      a_unit<0>(pb_ + roww * 0 + (size_t)q0w * INC + C_QB + head * 64, INC, pb_ + C_KB + head * 64, pb_ + C_VB + head * 64,
                P.F2 + (size_t)(bl * 16 + head) * TSEQ, 4 * qt + 4, 0, qabs, 0u, 1.0f, smem, stg, tid);
#pragma unroll
      for (int i = 0; i < 4; i++) {
        const int row = i * 8 + er;
        const uint4 ov = *(const uint4*)(stg + row * 64 + ec);
        const uint4 zz = *(const uint4*)(pb_ + (size_t)(q0w + row) * INC + C_ZB + head * 64 + ec);
        uint4 y;
        y.x = pk2(bflo(ov.x) * siluf_(bflo(zz.x)), bfhi(ov.x) * siluf_(bfhi(zz.x)));
        y.y = pk2(bflo(ov.y) * siluf_(bflo(zz.y)), bfhi(ov.y) * siluf_(bfhi(zz.y)));
        y.z = pk2(bflo(ov.z) * siluf_(bflo(zz.z)), bfhi(ov.z) * siluf_(bfhi(zz.z)));
        y.w = pk2(bflo(ov.w) * siluf_(bflo(zz.w)), bfhi(ov.w) * siluf_(bfhi(zz.w)));
        *(uint4*)(P.yb + (roww + row) * DM + head * 64 + ec) = y;
      }
    } else {
      const int g = head >> 3;
      const unsigned selm = P.sel[(size_t)(bl * 2 + g) * TSEQ + qabs];
      const float g1 = sigmoidf_(bf2f(P.proj[rowq * INC + C_GA + 16 + head]));
      const float g2 = sigmoidf_(bf2f(P.proj[rowq * INC + C_GA + 32 + head]));
      const u16* qw = P.qr + roww * DM + head * 64;
      a_unit<1>(qw, DM, pb_ + C_KV + 256 + g * 64, pb_ + C_KV + 384 + g * 64, nullptr, 4 * qt + 4, 0, qabs, selm, g1, smem, stg, tid);
      const int klo = (4 * qt - 8) > 0 ? (4 * qt - 8) : 0;
      a_unit<2>(qw, DM, pb_ + (size_t)(klo * 64) * INC + C_KV + 512 + g * 64, pb_ + (size_t)(klo * 64) * INC + C_KV + 640 + g * 64, nullptr,
                4 * qt + 4 - klo, klo * 64, qabs, 0u, g2, smem, stg + 2048, tid);
#pragma unroll
      for (int i = 0; i < 4; i++) {
        const int row = i * 8 + er;
        const uint4 o1 = *(const uint4*)(stg + row * 64 + ec);
        const uint4 o2 = *(const uint4*)(stg + 2048 + row * 64 + ec);
        const uint4 zz = *(const uint4*)(pb_ + (size_t)(q0w + row) * INC + C_ZA + head * 64 + ec);
        u16* yp = P.ya + (roww + row) * DM + head * 64 + ec;
        const uint4 oc = *(const uint4*)yp;
        uint4 y;
        y.x = pk2((bflo(o1.x) + bflo(o2.x) + bflo(oc.x)) * siluf_(bflo(zz.x)), (bfhi(o1.x) + bfhi(o2.x) + bfhi(oc.x)) * siluf_(bfhi(zz.x)));
        y.y = pk2((bflo(o1.y) + bflo(o2.y) + bflo(oc.y)) * siluf_(bflo(zz.y)), (bfhi(o1.y) + bfhi(o2.y) + bfhi(oc.y)) * siluf_(bfhi(zz.y)));
        y.z = pk2((bflo(o1.z) + bflo(o2.z) + bflo(oc.z)) * siluf_(bflo(zz.z)), (bfhi(o1.z) + bfhi(o2.z) + bfhi(oc.z)) * siluf_(bfhi(zz.z)));
        y.w = pk2((bflo(o1.w) + bflo(o2.w) + bflo(oc.w)) * siluf_(bflo(zz.w)), (bfhi(o1.w) + bfhi(o2.w) + bfhi(oc.w)) * siluf_(bfhi(zz.w)));
        *(uint4*)yp = y;
      }
    }
  }
}

#define XB_XCNT(j) (64 * (j))
#define XB_XSUB(j) (1024 + 64 * (j))
#define XB_XGEN(j) (2048 + 64 * (j))
#define XB_TOP 3072
#define XB_TOPGEN 3136
__device__ __forceinline__ unsigned xb_ld(unsigned* p) { return __hip_atomic_load(p, __ATOMIC_RELAXED, __HIP_MEMORY_SCOPE_AGENT); }
__device__ __forceinline__ unsigned xb_add(unsigned* p, unsigned v) { return __hip_atomic_fetch_add(p, v, __ATOMIC_RELAXED, __HIP_MEMORY_SCOPE_AGENT); }
__device__ __forceinline__ unsigned xb_xcc_id() { return (unsigned)__builtin_amdgcn_s_getreg((3 << 11) | 20) & 0xFu; }
__device__ __forceinline__ void grid_bar(unsigned* bar, char* smem) {
  asm volatile("s_waitcnt vmcnt(0) lgkmcnt(0)" ::: "memory");
  __syncthreads();
  if (threadIdx.x == 0) {
    volatile unsigned* st = (volatile unsigned*)(smem + XB_LDS_OFF);
    const unsigned nloc = st[0], nx = st[1], x = st[2];
    const unsigned old = xb_add(&bar[XB_XSUB(x)], 1u);
    const unsigned gen = old / nloc;
    if (old + 1u == (gen + 1u) * nloc) {
      __builtin_amdgcn_fence(__ATOMIC_RELEASE, "agent");
      asm volatile("s_waitcnt vmcnt(0)" ::: "memory");
      const unsigned og = xb_add(&bar[XB_TOP], 1u);
      const unsigned tg = og / nx;
      if (og + 1u == (tg + 1u) * nx) xb_add(&bar[XB_TOPGEN], 1u);
      else { while (xb_ld(&bar[XB_TOPGEN]) == tg) __builtin_amdgcn_s_sleep(1); }
      __builtin_amdgcn_fence(__ATOMIC_ACQUIRE, "agent");
      xb_add(&bar[XB_XGEN(x)], 1u);
      asm volatile("s_waitcnt vmcnt(0)" ::: "memory");
    } else {
      while (xb_ld(&bar[XB_XGEN(x)]) == gen) __builtin_amdgcn_s_sleep(1);
      __builtin_amdgcn_fence(__ATOMIC_ACQUIRE, "agent");
      asm volatile("s_waitcnt vmcnt(0)" ::: "memory");
    }
  }
  __syncthreads();
}

__global__ void __launch_bounds__(NTHREADS, 2) mega_kernel(Params P) {
  __shared__ __attribute__((aligned(1024))) char smem[163840];
  cg::grid_group grid = cg::this_grid();
  const int CT = P.NB * TSEQ;
  phase0(P, smem);
  grid.sync();
  if (threadIdx.x == 0) (void)xb_add(&P.xbar[XB_XCNT(xb_xcc_id())], 1u);
  grid.sync();
  if (threadIdx.x == 0) {
    unsigned cnt = 0u, mine = 0u, rank = 0u; const unsigned x = xb_xcc_id();
#pragma unroll 1
    for (unsigned j = 0; j < 16; ++j) { const unsigned c = xb_ld(&P.xbar[XB_XCNT(j)]); cnt += (c > 0u) ? 1u : 0u; mine = (j == x) ? c : mine; rank += (c > 0u && j < x) ? 1u : 0u; }
    volatile unsigned* st = (volatile unsigned*)(smem + XB_LDS_OFF);
    st[0] = mine > 0u ? mine : 1u; st[1] = cnt > 0u ? cnt : 1u; st[2] = x; st[3] = rank;
  }
  __syncthreads();
  for (int chunk = 0; chunk < P.nchunk; chunk++) {
    for (int layer = 0; layer < 4; layer++) {
      const float* xs = (layer == 0 ? P.x_in : P.out) + (size_t)chunk * CT * DM;
      norm_phase(xs, P.norm_g + layer * DM, P.h, CT);
      if (layer == 0 && chunk > 0) final_norm_phase(P.out, P.final_g, (chunk - 1) * CT, CT);
      grid_bar(P.xbar, smem);
      gemm1_phase(P, layer, smem);
      grid_bar(P.xbar, smem);
      pb_phase(P, layer, smem);
      grid_bar(P.xbar, smem);
      pc2_phase(P, layer, chunk, smem, (int*)(smem + 140000), 0);
      grid_bar(P.xbar, smem);
      pc1_phase(P, smem);
      grid_bar(P.xbar, smem);
      pc2_phase(P, layer, chunk, smem, (int*)(smem + 140000), 1);
      grid_bar(P.xbar, smem);
      gemm2_phase(P, layer, smem);
      grid_bar(P.xbar, smem);
      gemm3_phase(P, layer, chunk, smem);
      grid_bar(P.xbar, smem);
    }
  }
  final_norm_phase(P.out, P.final_g, (P.nchunk - 1) * CT, CT);
}

static inline size_t al256(size_t x) { return (x + 255) & ~(size_t)255; }

extern "C" void kernel_launch(void* const* d_in, const int* in_sizes, int n_in, void* d_out, int out_size,
                              void* d_ws, size_t ws_size, hipStream_t stream) {
  (void)in_sizes; (void)n_in; (void)out_size;
  Params P{};
  P.x_in = (const float*)d_in[0]; P.norm_g = (const float*)d_in[1]; P.w_in = (const float*)d_in[2];
  P.b_forget = (const float*)d_in[3];
  P.pe_k = (const float*)d_in[4]; P.w1_k = (const float*)d_in[5]; P.w2_k = (const float*)d_in[6];
  P.pe_v = (const float*)d_in[7]; P.w1_v = (const float*)d_in[8]; P.w2_v = (const float*)d_in[9];
  P.w_pa = (const float*)d_in[10]; P.w_pb = (const float*)d_in[11]; P.w_out = (const float*)d_in[12];
  P.final_g = (const float*)d_in[13];
  P.out = (float*)d_out;
  int NB = 16;
  char* base = (char*)d_ws;
  for (;;) {
    const size_t CT = (size_t)NB * TSEQ;
    size_t off = 0;
    auto take = [&](size_t bytes) { size_t o = off; off = al256(off + bytes); return o; };
    size_t oWin = take((size_t)4 * INCP * DM * 2), oWpa = take((size_t)4 * DM * DM * 2), oWpb = take((size_t)4 * DM * DM * 2),
           oWo = take((size_t)4 * DM * DM * 2), oW1 = take((size_t)8 * 128 * 2048 * 2), oW2 = take((size_t)8 * 64 * 128 * 2),
           oB1 = take((size_t)64 * 128 * 4), oRc = take((size_t)TSEQ * 32 * 4), oRs = take((size_t)TSEQ * 32 * 4),
           oH = take(CT * DM * 2), oProj = take(CT * INC * 2 + 4096), oVbt = take(CT * DM * 2),
           oVst = take(CT * 128 * 2), oVwt = take(CT * 128 * 2), oFl = take(CT * 16 * 4), oF2 = take(CT * 16 * 4),
           oKc = take((size_t)NB * 2 * 128 * 64 * 2), oVc = take((size_t)NB * 2 * 64 * 128 * 2), oSel = take(CT * 2 * 4),
           oYa = take(CT * DM * 2), oYb = take(CT * DM * 2), oCtr = take(1024), oXb = take(XB_WORDS * 4);
    if (off > ws_size && NB > 1) { NB >>= 1; continue; }
    P.WinT = (u16*)(base + oWin); P.WpaT = (u16*)(base + oWpa); P.WpbT = (u16*)(base + oWpb); P.WoT = (u16*)(base + oWo);
    P.W1T = (u16*)(base + oW1); P.W2T = (u16*)(base + oW2); P.bias1p = (float*)(base + oB1);
    P.ropec = (float*)(base + oRc); P.ropes = (float*)(base + oRs);
    P.h = (u16*)(base + oH); P.proj = (u16*)(base + oProj); P.qr = (u16*)(base + oVbt);
    P.vst = (u16*)(base + oVst); P.vwt = (u16*)(base + oVwt); P.flog = (float*)(base + oFl); P.F2 = (float*)(base + oF2);
    P.kcmp = (u16*)(base + oKc); P.vcmpt = (u16*)(base + oVc); P.sel = (unsigned*)(base + oSel);
    P.ya = (u16*)(base + oYa); P.yb = (u16*)(base + oYb); P.ctr = (unsigned*)(base + oCtr); P.xbar = (unsigned*)(base + oXb);
    break;
  }
  P.NB = NB; P.nchunk = 32 / NB;
  static int grid_blocks = 0;
  if (!grid_blocks) {
    int dev = 0, cus = 0, per_cu = 0;
    hipGetDevice(&dev);
    hipDeviceGetAttribute(&cus, hipDeviceAttributeMultiprocessorCount, dev);
    hipOccupancyMaxActiveBlocksPerMultiprocessor(&per_cu, mega_kernel, NTHREADS, 0);
    if (per_cu > 1) per_cu = 1;
    if (per_cu < 1) per_cu = 1;
    grid_blocks = cus * per_cu;
  }
  void* args[] = {&P};
  hipError_t e = hipLaunchCooperativeKernel((void*)mega_kernel, dim3(grid_blocks), dim3(NTHREADS), args, 0, stream);
  if (e != hipSuccess) fprintf(stderr, "cooperative launch failed: %s (grid %d)\n", hipGetErrorString(e), grid_blocks);
}
```
